# Optimizing an MI355X kernel written in HIP

```python
import jax, jax.numpy as jnp
from jax import lax
import numpy as np

D_MODEL = 2048
BATCH = 4
SEQ = 4096
DEPTH = 1

N_META = 16
HG_HEADS = 8
HG_DK = 128
HG_DV = D_MODEL // 2 // HG_HEADS
HG_F = HG_HEADS * HG_DK
HG_V = HG_HEADS * HG_DV
CHUNK = 64
SC_WIDTH = D_MODEL // 2
CONV_K = 3
N_BRANCH = 2
IN_COLS = 2 * HG_F + 2 * HG_V + 3 * SC_WIDTH + N_BRANCH * D_MODEL
N_EXPERTS = 32
TOP_K = 4
D_FF = D_MODEL
SWIGLU_LIMIT = 7.0
SWIGLU_ALPHA = 1.702
MOE_BLOCK = 128
EPS = 1e-6

kernel_name = "hybrid_hgrn2_shortconv_moe_block"


def _rmsnorm(x, w):
    xf = x.astype(jnp.float32)
    y = xf * lax.rsqrt(jnp.mean(xf * xf, axis=-1, keepdims=True) + EPS) * w.astype(jnp.float32)
    return y.astype(x.dtype)


def _hgrn2_chunked(q, log_f, k, v):
    bsz, l = q.shape[:2]
    pad = (-N_META) % CHUNK

    def prep(t):
        t = jnp.pad(t.astype(jnp.float32), ((0, 0), (pad, 0), (0, 0), (0, 0)))
        n_chunks = t.shape[1] // CHUNK
        t = t.reshape(bsz, n_chunks, CHUNK, t.shape[2], t.shape[3])
        return jnp.transpose(t, (1, 0, 3, 2, 4))

    xs = (prep(q), prep(log_f), prep(k), prep(v))
    causal = jnp.tril(jnp.ones((CHUNK, CHUNK), dtype=bool))

    def step(state, chunk):
        qc, lfc, kc, vc = chunk
        bc = jnp.cumsum(lfc, axis=2)
        diff = bc[:, :, :, None, :] - bc[:, :, None, :, :]
        decay = jnp.exp(jnp.where(causal[:, :, None], diff, -jnp.inf))
        scores = jnp.einsum('bhtd,bhsd,bhtsd->bhts', qc, kc, decay)
        o = (jnp.einsum('bhts,bhsv->bhtv', scores, vc)
             + jnp.einsum('bhtd,bhdv->bhtv', qc * jnp.exp(bc), state))
        b_last = bc[:, :, -1:, :]
        state = (jnp.exp(b_last[:, :, 0, :])[..., None] * state
                 + jnp.einsum('bhsd,bhsv->bhdv', kc * jnp.exp(b_last - bc), vc))
        return state, o

    s0 = jnp.zeros((bsz, HG_HEADS, HG_DK, HG_DV), jnp.float32)
    _, o = lax.scan(step, s0, xs)
    o = jnp.transpose(o, (1, 0, 3, 2, 4)).reshape(bsz, -1, HG_HEADS, HG_DV)
    return o[:, pad:]


def _short_conv(u, w):
    return lax.conv_general_dilated(
        u, w[:, None, :].astype(u.dtype), window_strides=(1,), padding=[(CONV_K - 1, 0)],
        dimension_numbers=('NWC', 'WIO', 'NWC'), feature_group_count=u.shape[-1])


def _mixer(h, lower_bound, w_in, g_norm_w, w_hgrn_out, conv_w, w_conv_out, w_o):
    bsz, l, _ = h.shape
    sizes = (HG_F, HG_F, HG_V, HG_V, SC_WIDTH, SC_WIDTH, SC_WIDTH, D_MODEL, D_MODEL)
    split_at = np.cumsum(sizes[:-1]).tolist()
    proj = h @ w_in
    q, f_pre, v, g, sc_v, sc_b, sc_c, gate_a, gate_b = jnp.split(proj, split_at, axis=-1)

    f = lower_bound + (1.0 - lower_bound) * jax.nn.sigmoid(f_pre.astype(jnp.float32))
    log_f = jnp.log(f)
    k = 1.0 - f
    heads = lambda t, d: t.reshape(bsz, l, HG_HEADS, d)
    o = _hgrn2_chunked(heads(jax.nn.silu(q), HG_DK), heads(log_f, HG_DK), heads(k, HG_DK), heads(v, HG_DV))
    o = _rmsnorm(o, g_norm_w).astype(h.dtype).reshape(bsz, l, HG_V) * jax.nn.silu(g)
    y_a = o @ w_hgrn_out

    y_b = (sc_b * _short_conv(sc_c * sc_v, conv_w)) @ w_conv_out

    merged = jax.nn.sigmoid(gate_a) * y_a + jax.nn.sigmoid(gate_b) * y_b
    return merged @ w_o


def _moe(h, w_router, b_router, w_up, b_up, w_down, b_down):
    bsz, l, d = h.shape
    xt = h.reshape(-1, d)
    n = xt.shape[0]
    logits = (xt @ w_router + b_router).astype(jnp.float32)
    top_logits, top_idx = lax.top_k(logits, TOP_K)
    gate = jax.nn.softmax(top_logits, axis=-1)
    flat_e = top_idx.reshape(-1)
    flat_tok = jnp.repeat(jnp.arange(n, dtype=jnp.int32), TOP_K)
    flat_w = gate.reshape(-1)
    order = jnp.argsort(flat_e)
    se, stok, sw = flat_e[order], flat_tok[order], flat_w[order]
    counts = jnp.zeros((N_EXPERTS,), jnp.int32).at[flat_e].add(1)
    padded = (counts + MOE_BLOCK - 1) // MOE_BLOCK * MOE_BLOCK
    pad_end = jnp.cumsum(padded)
    pad_start = pad_end - padded
    sort_start = jnp.cumsum(counts) - counts
    rows = pad_start[se] + (jnp.arange(n * TOP_K, dtype=jnp.int32) - sort_start[se])
    n_rows = -(-(n * TOP_K + N_EXPERTS * (MOE_BLOCK - 1)) // MOE_BLOCK) * MOE_BLOCK
    n_blocks = n_rows // MOE_BLOCK
    row_tok = jnp.full((n_rows,), n, jnp.int32).at[rows].set(stok)
    row_w = jnp.zeros((n_rows,), jnp.float32).at[rows].set(sw)
    block_e = jnp.minimum(
        jnp.searchsorted(pad_end, jnp.arange(n_blocks, dtype=jnp.int32) * MOE_BLOCK, side='right'),
        N_EXPERTS - 1)
    x_rows = jnp.concatenate([xt, jnp.zeros((1, d), xt.dtype)], axis=0)[row_tok]
    x_rows = x_rows.reshape(n_blocks, MOE_BLOCK, d)

    def expert_block(args):
        xb, e = args
        hu = xb @ w_up[e] + b_up[e]
        g, u = jnp.split(hu, 2, axis=-1)
        g = jnp.minimum(g, SWIGLU_LIMIT)
        u = jnp.clip(u, -SWIGLU_LIMIT, SWIGLU_LIMIT)
        return ((u + 1.0) * (g * jax.nn.sigmoid(SWIGLU_ALPHA * g))) @ w_down[e] + b_down[e]

    y_rows = lax.map(expert_block, (x_rows, block_e)).reshape(n_rows, d)
    y = jax.ops.segment_sum(y_rows * row_w[:, None].astype(y_rows.dtype), row_tok, num_segments=n + 1)[:n]
    return y.reshape(bsz, l, d)


def setup_inputs(seed: int = 0) -> dict:
    key = jax.random.key(seed)
    ks = jax.random.split(key, 19)
    nrm = lambda k, shape, scale: jax.random.normal(k, shape, jnp.float32) * scale
    return {
        'x': nrm(ks[0], (BATCH, SEQ, D_MODEL), 1.0),
        'meta_tokens': nrm(ks[1], (N_META, D_MODEL), 1.0),
        'norm_mix_w': 1.0 + nrm(ks[2], (DEPTH, D_MODEL), 0.02),
        'w_in': nrm(ks[3], (DEPTH, D_MODEL, IN_COLS), D_MODEL ** -0.5),
        'lb_logits': nrm(ks[4], (DEPTH + 1, HG_F), 0.5),
        'g_norm_w': 1.0 + nrm(ks[5], (DEPTH, HG_DV), 0.02),
        'w_hgrn_out': nrm(ks[6], (DEPTH, HG_V, D_MODEL), HG_V ** -0.5),
        'conv_w': nrm(ks[7], (DEPTH, CONV_K, SC_WIDTH), CONV_K ** -0.5),
        'w_conv_out': nrm(ks[8], (DEPTH, SC_WIDTH, D_MODEL), SC_WIDTH ** -0.5),
        'w_o': nrm(ks[9], (DEPTH, D_MODEL, D_MODEL), D_MODEL ** -0.5),
        'norm_ffn_w': 1.0 + nrm(ks[10], (DEPTH, D_MODEL), 0.02),
        'w_router': nrm(ks[11], (DEPTH, D_MODEL, N_EXPERTS), D_MODEL ** -0.5),
        'b_router': nrm(ks[12], (DEPTH, N_EXPERTS), 0.01),
        'w_up': nrm(ks[13], (DEPTH, N_EXPERTS, D_MODEL, 2 * D_FF), D_MODEL ** -0.5),
        'b_up': nrm(ks[14], (DEPTH, N_EXPERTS, 2 * D_FF), 0.02),
        'w_down': nrm(ks[15], (DEPTH, N_EXPERTS, D_FF, D_MODEL), D_FF ** -0.5),
        'b_down': nrm(ks[16], (DEPTH, N_EXPERTS, D_MODEL), 0.02),
        'final_norm_w': 1.0 + nrm(ks[17], (D_MODEL,), 0.02),
    }


def reference(x, meta_tokens, norm_mix_w, w_in, lb_logits, g_norm_w, w_hgrn_out, conv_w, w_conv_out,
              w_o, norm_ffn_w, w_router, b_router, w_up, b_up, w_down, b_down, final_norm_w):
    bsz = x.shape[0]
    meta = jnp.broadcast_to(meta_tokens[None].astype(x.dtype), (bsz, N_META, D_MODEL))
    h = jnp.concatenate([meta, x], axis=1)
    lower_bounds = jnp.cumsum(jax.nn.softmax(lb_logits.astype(jnp.float32), axis=0), axis=0)
    for layer in range(DEPTH):
        h = h + _mixer(_rmsnorm(h, norm_mix_w[layer]), lower_bounds[layer], w_in[layer], g_norm_w[layer],
                       w_hgrn_out[layer], conv_w[layer], w_conv_out[layer], w_o[layer])
        h = h + _moe(_rmsnorm(h, norm_ffn_w[layer]), w_router[layer], b_router[layer], w_up[layer],
                     b_up[layer], w_down[layer], b_down[layer])
    out = _rmsnorm(h, final_norm_w)
    return out[:, N_META:]
```

```cpp
#include <hip/hip_runtime.h>
#include <cstdio>
namespace nv {
constexpr int D = 2048, NB = 4, SEQ = 4096, NMETA = 16, L = SEQ + NMETA, R = NB * L;
constexpr int HF = 1024, INC = 11264, NE = 32, TOPK = 4, DFF = 2048;
constexpr int C_Q = 0, C_F = 1024, C_V = 2048, C_G = 3072, C_SV = 4096, C_SB = 5120, C_SC = 6144, C_GA = 7168, C_GB = 9216;
constexpr float EPS = 1e-6f;
constexpr int CAP = R;

__device__ __forceinline__ float sigmoidf_(float x) { return 1.f / (1.f + __expf(-x)); }
__device__ __forceinline__ float siluf_(float x) { return x * sigmoidf_(x); }
__device__ __forceinline__ float block_sum_256(float v, float* red) {
    for (int o = 32; o >= 1; o >>= 1) v += __shfl_xor(v, o);
    __syncthreads();
    if ((threadIdx.x & 63) == 0) red[threadIdx.x >> 6] = v;
    __syncthreads();
    return red[0] + red[1] + red[2] + red[3];
}

__global__ void k_build(const float* x, const float* meta, const float* w, float* H0, float* HN) {
    __shared__ float red[4];
    const int r = blockIdx.x, b = r / L, p = r % L;
    const float* src = p < NMETA ? meta + (size_t)p * D : x + ((size_t)b * SEQ + (p - NMETA)) * D;
    float v[8]; float ss = 0.f;
    for (int i = 0; i < 8; ++i) { v[i] = src[threadIdx.x + 256 * i]; ss += v[i] * v[i]; }
    ss = block_sum_256(ss, red);
    const float rs = rsqrtf(ss / D + EPS);
    for (int i = 0; i < 8; ++i) { const int c = threadIdx.x + 256 * i; H0[(size_t)r * D + c] = v[i]; HN[(size_t)r * D + c] = v[i] * rs * w[c]; }
}

struct GArgs {
    const float* A; const float* B; const float* bias; const float* resid; float* C;
    const int* counts; const int* offs; const int* list;
    long strideB; long strideBias;
    int lda, ldb, ldc, ldr, M, N, K, cap;
};
template <bool GROUPED, bool GATHER>
__global__ void __launch_bounds__(256) k_sgemm(GArgs g) {
    __shared__ float As[8][128 + 4];
    __shared__ float Bs[8][128 + 4];
    const int t = threadIdx.x;
    int M = g.M; const float* B = g.B; const float* bias = g.bias; int coff = 0;
    if (GROUPED) { const int e = blockIdx.z; M = g.counts[e]; B += (size_t)e * g.strideB; if (bias) bias += (size_t)e * g.strideBias; coff = g.offs[e]; }
    const int m0 = blockIdx.y * 128, n0 = blockIdx.x * 128;
    if (m0 >= M) return;
    const int ar = t >> 1, ak = (t & 1) * 4;
    long arow = -1;
    if (m0 + ar < M) {
        if (GROUPED) { if (GATHER) arow = (long)(g.list[(size_t)blockIdx.z * g.cap + m0 + ar] >> 2); else arow = (long)coff + m0 + ar; }
        else arow = m0 + ar;
    }
    const int bk = t >> 5, bn = (t & 31) * 4;
    const int ty = t >> 4, tx = t & 15;
    float acc[8][8];
    for (int i = 0; i < 8; ++i) for (int j = 0; j < 8; ++j) acc[i][j] = 0.f;
    for (int k0 = 0; k0 < g.K; k0 += 8) {
        float4 av = make_float4(0.f, 0.f, 0.f, 0.f);
        if (arow >= 0) av = *(const float4*)(g.A + (size_t)arow * g.lda + k0 + ak);
        const float4 bv = *(const float4*)(B + (size_t)(k0 + bk) * g.ldb + n0 + bn);
        __syncthreads();
        As[ak + 0][ar] = av.x; As[ak + 1][ar] = av.y; As[ak + 2][ar] = av.z; As[ak + 3][ar] = av.w;
        *(float4*)&Bs[bk][bn] = bv;
        __syncthreads();
#pragma unroll
        for (int k = 0; k < 8; ++k) {
            float a[8], b[8];
            *(float4*)&a[0] = *(const float4*)&As[k][ty * 4]; *(float4*)&a[4] = *(const float4*)&As[k][64 + ty * 4];
            *(float4*)&b[0] = *(const float4*)&Bs[k][tx * 4]; *(float4*)&b[4] = *(const float4*)&Bs[k][64 + tx * 4];
#pragma unroll
            for (int i = 0; i < 8; ++i)
#pragma unroll
                for (int j = 0; j < 8; ++j) acc[i][j] = fmaf(a[i], b[j], acc[i][j]);
        }
    }
    for (int i = 0; i < 8; ++i) {
        const int ml = (i < 4 ? ty * 4 + i : 64 + ty * 4 + (i - 4));
        if (m0 + ml >= M) continue;
        const long crow = (GROUPED ? (long)coff : 0L) + m0 + ml;
        for (int jj = 0; jj < 2; ++jj) {
            const int n = n0 + jj * 64 + tx * 4;
            float4 o = make_float4(acc[i][jj * 4 + 0], acc[i][jj * 4 + 1], acc[i][jj * 4 + 2], acc[i][jj * 4 + 3]);
            if (bias) { o.x += bias[n]; o.y += bias[n + 1]; o.z += bias[n + 2]; o.w += bias[n + 3]; }
            if (g.resid) { const float4 rv = *(const float4*)(g.resid + (size_t)crow * g.ldr + n); o.x += rv.x; o.y += rv.y; o.z += rv.z; o.w += rv.w; }
            *(float4*)(g.C + (size_t)crow * g.ldc + n) = o;
        }
    }
}

__global__ void __launch_bounds__(256) k_hgrn(const float* PROJ, const float* lb_logits, float* O) {
    __shared__ float red[16][17];
    const int blk = blockIdx.x, vs = blk & 7, h = (blk >> 3) & 7, b = blk >> 6;
    const int t = threadIdx.x, vloc = t & 15, dg = t >> 4, d0 = h * 128 + dg * 8;
    float s[8], lb[8];
    for (int i = 0; i < 8; ++i) { s[i] = 0.f; const float l0 = lb_logits[d0 + i], l1 = lb_logits[HF + d0 + i]; lb[i] = 1.f / (1.f + __expf(l1 - l0)); }
    const int vcol = C_V + h * 128 + vs * 16 + vloc;
    for (int p = 0; p < L; ++p) {
        const float* base = PROJ + (size_t)(b * L + p) * INC;
        const float vv = base[vcol];
        float part = 0.f;
#pragma unroll
        for (int i = 0; i < 8; ++i) {
            const float qv = siluf_(base[C_Q + d0 + i]);
            const float f = lb[i] + (1.f - lb[i]) * sigmoidf_(base[C_F + d0 + i]);
            s[i] = f * s[i] + (1.f - f) * vv;
            part += s[i] * qv;
        }
        red[dg][vloc] = part;
        __syncthreads();
        if (t < 16) { float o = 0.f; for (int j = 0; j < 16; ++j) o += red[j][t]; O[(size_t)(b * L + p) * HF + h * 128 + vs * 16 + t] = o; }
        __syncthreads();
    }
}

__global__ void __launch_bounds__(256) k_mixelem(const float* PROJ, const float* O, const float* gw, const float* cw, float* OA, float* CB) {
    const int r = blockIdx.x, p = r % L, t = threadIdx.x;
    const float* pr = PROJ + (size_t)r * INC;
    float o[4]; float ss = 0.f;
    for (int i = 0; i < 4; ++i) { o[i] = O[(size_t)r * HF + t * 4 + i]; ss += o[i] * o[i]; }
    for (int m = 16; m >= 1; m >>= 1) ss += __shfl_xor(ss, m);
    const float rs = rsqrtf(ss / 128.f + EPS);
    for (int i = 0; i < 4; ++i) { const int c = t * 4 + i; OA[(size_t)r * HF + c] = o[i] * rs * gw[c & 127] * siluf_(pr[C_G + c]); }
    for (int i = 0; i < 4; ++i) {
        const int c = t * 4 + i; float acc = 0.f;
        for (int j = 0; j < 3; ++j) { const int pp = p - 2 + j; if (pp >= 0) { const float* q = pr + (long)(pp - p) * INC; acc += cw[j * HF + c] * q[C_SC + c] * q[C_SV + c]; } }
        CB[(size_t)r * HF + c] = pr[C_SB + c] * acc;
    }
}
__global__ void k_merge(const float* PROJ, const float* YA, const float* YB, float* MG) {
    const size_t i = (size_t)blockIdx.x * 256 + threadIdx.x; const size_t r = i / D; const int n = (int)(i % D);
    MG[i] = sigmoidf_(PROJ[r * INC + C_GA + n]) * YA[i] + sigmoidf_(PROJ[r * INC + C_GB + n]) * YB[i];
}
__global__ void __launch_bounds__(256) k_router(const float* H1, const float* w, const float* wr, const float* br, float* HN2,
                                                int* topk_e, float* topk_w, int* slot_pos, int* counts, int* list) {
    __shared__ float red[4]; __shared__ float hn[D]; __shared__ float part[8][32]; __shared__ float lg[32];
    const int r = blockIdx.x, t = threadIdx.x;
    float v[8]; float ss = 0.f;
    for (int i = 0; i < 8; ++i) { v[i] = H1[(size_t)r * D + t + 256 * i]; ss += v[i] * v[i]; }
    ss = block_sum_256(ss, red);
    const float rs = rsqrtf(ss / D + EPS);
    for (int i = 0; i < 8; ++i) { const int c = t + 256 * i; const float y = v[i] * rs * w[c]; hn[c] = y; HN2[(size_t)r * D + c] = y; }
    __syncthreads();
    const int e = t & 31, sl = t >> 5; float a = 0.f;
    for (int k = sl * 256; k < sl * 256 + 256; ++k) a = fmaf(hn[k], wr[(size_t)k * NE + e], a);
    part[sl][e] = a;
    __syncthreads();
    if (t < 32) { float s = br[t]; for (int j = 0; j < 8; ++j) s += part[j][t]; lg[t] = s; }
    __syncthreads();
    if (t == 0) {
        int idx[4]; float val[4]; unsigned used = 0u;
        for (int k = 0; k < 4; ++k) { int bi = -1; float bv = -3.0e38f; for (int j = 0; j < 32; ++j) if (!((used >> j) & 1u) && lg[j] > bv) { bv = lg[j]; bi = j; } used |= 1u << bi; idx[k] = bi; val[k] = bv; }
        float den = 0.f, ex[4]; for (int k = 0; k < 4; ++k) { ex[k] = __expf(val[k] - val[0]); den += ex[k]; }
        for (int k = 0; k < 4; ++k) {
            topk_e[r * 4 + k] = idx[k]; topk_w[r * 4 + k] = ex[k] / den;
            const int pos = atomicAdd(&counts[idx[k]], 1); slot_pos[r * 4 + k] = pos; list[(size_t)idx[k] * CAP + pos] = r * 4 + k;
        }
    }
}
__global__ void k_offsets(const int* counts, int* offs) { if (threadIdx.x == 0) { int a = 0; for (int e = 0; e < NE; ++e) { offs[e] = a; a += counts[e]; } offs[NE] = a; } }
__global__ void k_act(const float* HU, float* ACT, const int* offs) {
    const size_t i = (size_t)blockIdx.x * 256 + threadIdx.x; const size_t row = i / DFF; const int j = (int)(i % DFF);
    if ((long)row >= (long)offs[NE]) return;
    float g = HU[row * 4096 + j], u = HU[row * 4096 + 2048 + j];
    g = fminf(g, 7.f); u = fminf(fmaxf(u, -7.f), 7.f);
    ACT[i] = (u + 1.f) * (g * sigmoidf_(1.702f * g));
}
__global__ void __launch_bounds__(256) k_combine(const float* H1, const float* Y, const int* topk_e, const float* topk_w, const int* slot_pos, const int* offs, const float* fw, float* out) {
    __shared__ float red[4];
    const int tok = blockIdx.x, b = tok / SEQ, p = tok % SEQ, r = b * L + NMETA + p, t = threadIdx.x;
    float v[8]; float ss = 0.f;
    for (int i = 0; i < 8; ++i) v[i] = H1[(size_t)r * D + t + 256 * i];
    for (int k = 0; k < 4; ++k) { const int e = topk_e[r * 4 + k]; const float wk = topk_w[r * 4 + k]; const size_t row = (size_t)offs[e] + slot_pos[r * 4 + k];
        for (int i = 0; i < 8; ++i) v[i] += wk * Y[row * D + t + 256 * i]; }
    for (int i = 0; i < 8; ++i) ss += v[i] * v[i];
    ss = block_sum_256(ss, red);
    const float rs = rsqrtf(ss / D + EPS);
    for (int i = 0; i < 8; ++i) { const int c = t + 256 * i; out[(size_t)tok * D + c] = v[i] * rs * fw[c]; }
}

struct Bufs {
    float *H1, *HN, *PROJ, *O, *OA, *CB, *YA, *YB, *MG, *HN2, *HU, *ACT, *Y, *topk_w; int *topk_e, *slot_pos, *counts, *offs, *list;
};
inline size_t carve(unsigned char* ws, size_t base, Bufs& b) {
    size_t o = base; auto A = [&](size_t bytes) { size_t r = o; o += (bytes + 255) & ~(size_t)255; return ws + r; };
    b.counts = (int*)A(256); b.offs = (int*)A(256);
    b.topk_e = (int*)A((size_t)R * 4 * 4); b.topk_w = (float*)A((size_t)R * 4 * 4); b.slot_pos = (int*)A((size_t)R * 4 * 4); b.list = (int*)A((size_t)NE * CAP * 4);
    b.H1 = (float*)A((size_t)R * D * 4); b.HN2 = (float*)A((size_t)R * D * 4);
    const size_t era = o;
    b.HN = (float*)A((size_t)R * D * 4); b.PROJ = (float*)A((size_t)R * INC * 4); b.O = (float*)A((size_t)R * HF * 4); b.OA = (float*)A((size_t)R * HF * 4); b.CB = (float*)A((size_t)R * HF * 4);
    b.YA = (float*)A((size_t)R * D * 4); b.YB = (float*)A((size_t)R * D * 4); b.MG = (float*)A((size_t)R * D * 4);
    const size_t end1 = o; o = era;
    b.HU = (float*)A((size_t)R * 4 * 4096 * 4); b.ACT = (float*)A((size_t)R * 4 * DFF * 4); b.Y = (float*)A((size_t)R * 4 * D * 4);
    return o > end1 ? o : end1;
}
template <bool GR, bool GA> inline void sgemm(hipStream_t st, const GArgs& g, int mtiles, int groups) {
    hipLaunchKernelGGL((k_sgemm<GR, GA>), dim3(g.N / 128, mtiles, groups), dim3(256), 0, st, g);
}
inline void run(hipStream_t st, void* const* in, float* out, const Bufs& b, bool stop_after_mixer = false) {
    const float *x = (const float*)in[0], *meta = (const float*)in[1], *nmw = (const float*)in[2], *w_in = (const float*)in[3], *lbl = (const float*)in[4], *gnw = (const float*)in[5],
                *w_ho = (const float*)in[6], *cw = (const float*)in[7], *w_co = (const float*)in[8], *w_o = (const float*)in[9], *nfw = (const float*)in[10], *w_r = (const float*)in[11],
                *b_r = (const float*)in[12], *w_up = (const float*)in[13], *b_up = (const float*)in[14], *w_dn = (const float*)in[15], *b_dn = (const float*)in[16], *fnw = (const float*)in[17];
    const int MT = (R + 127) / 128;
    hipLaunchKernelGGL(k_build, dim3(R), dim3(256), 0, st, x, meta, nmw, b.H1, b.HN);
    { GArgs g{}; g.A = b.HN; g.lda = D; g.B = w_in; g.ldb = INC; g.C = b.PROJ; g.ldc = INC; g.M = R; g.N = INC; g.K = D; sgemm<false, false>(st, g, MT, 1); }
    hipLaunchKernelGGL(k_hgrn, dim3(NB * 64), dim3(256), 0, st, b.PROJ, lbl, b.O);
    hipLaunchKernelGGL(k_mixelem, dim3(R), dim3(256), 0, st, b.PROJ, b.O, gnw, cw, b.OA, b.CB);
    { GArgs g{}; g.A = b.OA; g.lda = HF; g.B = w_ho; g.ldb = D; g.C = b.YA; g.ldc = D; g.M = R; g.N = D; g.K = HF; sgemm<false, false>(st, g, MT, 1); }
    { GArgs g{}; g.A = b.CB; g.lda = HF; g.B = w_co; g.ldb = D; g.C = b.YB; g.ldc = D; g.M = R; g.N = D; g.K = HF; sgemm<false, false>(st, g, MT, 1); }
    hipLaunchKernelGGL(k_merge, dim3((unsigned)((size_t)R * D / 256)), dim3(256), 0, st, b.PROJ, b.YA, b.YB, b.MG);
    { GArgs g{}; g.A = b.MG; g.lda = D; g.B = w_o; g.ldb = D; g.C = b.H1; g.ldc = D; g.M = R; g.N = D; g.K = D; g.resid = b.H1; g.ldr = D; sgemm<false, false>(st, g, MT, 1); }
    if (stop_after_mixer) return;
    hipMemsetAsync(b.counts, 0, 256, st);
    hipLaunchKernelGGL(k_router, dim3(R), dim3(256), 0, st, b.H1, nfw, w_r, b_r, b.HN2, b.topk_e, b.topk_w, b.slot_pos, b.counts, b.list);
    hipLaunchKernelGGL(k_offsets, dim3(1), dim3(64), 0, st, b.counts, b.offs);
    { GArgs g{}; g.A = b.HN2; g.lda = D; g.B = w_up; g.ldb = 4096; g.C = b.HU; g.ldc = 4096; g.M = 0; g.N = 4096; g.K = D; g.bias = b_up; g.counts = b.counts; g.offs = b.offs; g.list = b.list;
      g.strideB = (long)D * 4096; g.strideBias = 4096; g.cap = CAP; sgemm<true, true>(st, g, MT, NE); }
    hipLaunchKernelGGL(k_act, dim3((unsigned)((size_t)R * 4 * DFF / 256)), dim3(256), 0, st, b.HU, b.ACT, b.offs);
    { GArgs g{}; g.A = b.ACT; g.lda = DFF; g.B = w_dn; g.ldb = D; g.C = b.Y; g.ldc = D; g.M = 0; g.N = D; g.K = DFF; g.bias = b_dn; g.counts = b.counts; g.offs = b.offs; g.list = nullptr;
      g.strideB = (long)DFF * D; g.strideBias = D; g.cap = CAP; sgemm<true, false>(st, g, MT, NE); }
    hipLaunchKernelGGL(k_combine, dim3(NB * SEQ), dim3(256), 0, st, b.H1, b.Y, b.topk_e, b.topk_w, b.slot_pos, b.offs, fnw, out);
}
}
extern "C" void kernel_launch(void* const* d_in, const int* in_sizes, int n_in, void* d_out, int out_size, void* d_ws, size_t ws_size, hipStream_t stream) {
    nv::Bufs b; const size_t end = nv::carve((unsigned char*)d_ws, 0, b);
    if (end > ws_size || n_in != 18) { fprintf(stderr, "kernel_launch: ws too small (%zu > %zu) or n_in %d\n", end, ws_size, n_in); return; }
    nv::run(stream, d_in, (float*)d_out, b);
}
```

```cpp
#include <hip/hip_runtime.h>
#include <cstdio>
#define FK_LAUNCHES 11
namespace fk {
#define LAS __attribute__((address_space(3)))
#define GAS __attribute__((address_space(1)))
typedef unsigned short bf16_t;
typedef short bf16x8 __attribute__((ext_vector_type(8)));
typedef float f32x4 __attribute__((ext_vector_type(4)));
typedef float f32x2 __attribute__((ext_vector_type(2)));
typedef unsigned u32x4 __attribute__((ext_vector_type(4)));
typedef unsigned u32x2 __attribute__((ext_vector_type(2)));
typedef GAS unsigned gu32;
#define RLX_AGENT __ATOMIC_RELAXED, __HIP_MEMORY_SCOPE_AGENT
#define LDS_WAIT() asm volatile("s_waitcnt lgkmcnt(0)" ::: "memory")
#define VM_WAIT() asm volatile("s_waitcnt vmcnt(0)" ::: "memory")

constexpr int D = 2048, NB = 4, SEQ = 4096, M = NB * SEQ, NMETA = 16;
constexpr int HF = 1024, INC = 11264, NE = 32, DFF = 2048, NCH = SEQ / 64;
constexpr int C_Q = 0, C_F = 1024, C_V = 2048, C_G = 3072, C_SV = 4096, C_SB = 5120, C_SC = 6144, C_GA = 7168, C_GB = 9216;
constexpr float EPS = 1e-6f;
constexpr int CAPF = M;
constexpr int MAXRT = 288;
constexpr int NWAVES = 8, NTHR = 512;

constexpr size_t al(size_t x) { return (x + 0xFFFFF) & ~(size_t)0xFFFFF; }
constexpr size_t WS_CTL = 0, CTL_BYTES = 65536;
constexpr size_t WS_LB = 65536, WS_RS1 = WS_LB + 4096, WS_RS2 = WS_RS1 + 65536, WS_WRH = WS_RS2 + 65536, WS_WRL = WS_WRH + 131072;
constexpr size_t WS_LFM = WS_WRL + 131072, WS_VVM = WS_LFM + 64 * 1024 * 4, WS_UUM = WS_VVM + 64 * 1024 * 2, WS_SMALL_END = WS_UUM + 16 * 1024 * 2;
constexpr size_t WS_TOPE = al(WS_SMALL_END), WS_TOPP = WS_TOPE + (size_t)M * 16, WS_TOPW = WS_TOPP + (size_t)M * 16, WS_LIST = WS_TOPW + (size_t)M * 16;
constexpr size_t WS_DEC = al(WS_LIST + (size_t)NE * CAPF * 4);
constexpr size_t WS_WIN = al(WS_DEC + (size_t)33 * 64 * 128 * 4);
constexpr size_t WS_WAB = al(WS_WIN + (size_t)INC * D * 2);
constexpr size_t WS_WO = al(WS_WAB + (size_t)D * D * 2);
constexpr size_t WS_WUP = al(WS_WO + (size_t)D * D * 2);
constexpr size_t WS_WDN = al(WS_WUP + (size_t)NE * 4096 * D * 2);
constexpr size_t WS_XB = al(WS_WDN + (size_t)NE * D * DFF * 2);
constexpr size_t WS_QS = al(WS_XB + (size_t)M * D * 2);
constexpr size_t WS_LF = al(WS_QS + (size_t)M * HF * 2);
constexpr size_t WS_VV = al(WS_LF + (size_t)M * HF * 4);
constexpr size_t WS_GS = al(WS_VV + (size_t)M * HF * 2);
constexpr size_t WS_UU = al(WS_GS + (size_t)M * HF * 2);
constexpr size_t WS_SB = al(WS_UU + (size_t)M * HF * 2);
constexpr size_t WS_RT = al(WS_SB + (size_t)M * HF * 2);
constexpr size_t WS_GBS = al(WS_RT + (size_t)M * D * 2);
constexpr size_t WS_UC = al(WS_GBS + (size_t)M * D * 2);
constexpr size_t WS_SS = al(WS_UC + (size_t)(32 * 64 + 8) * 16384 * 2);
constexpr size_t WS_A2 = al(WS_SS + (size_t)32 * 64 * 16384 * 2);
constexpr size_t WS_MG = al(WS_A2 + (size_t)M * D * 2);
constexpr size_t WS_H1 = al(WS_MG + (size_t)M * D * 2);
constexpr size_t WS_H1B = al(WS_H1 + (size_t)M * D * 4);
constexpr size_t WS_ACT = al(WS_H1B + (size_t)M * D * 2);
constexpr size_t WS_YR = al(WS_ACT + (size_t)MAXRT * 256 * DFF * 2);
constexpr size_t WS_FAST_END = al(WS_YR + (size_t)MAXRT * 256 * D * 2);
constexpr int CW_TMO = 0;
constexpr int CW_CNT = 1024;
constexpr int CW_BAR = 4096;
constexpr int RING_BYTES = 131072;
constexpr int TOK_OFF = RING_BYTES, TOK_BYTES = 18 * 1024;
constexpr int MISC_OFF = TOK_OFF + TOK_BYTES;
constexpr int LDS_BYTES = MISC_OFF + 1024;
static_assert(LDS_BYTES <= 160 * 1024, "LDS");

__device__ __forceinline__ float sigmoidf_(float x) { return 1.f / (1.f + __expf(-x)); }
__device__ __forceinline__ unsigned f2bf(float f) { unsigned u = __builtin_bit_cast(unsigned, f); return (u + 0x7fffu + ((u >> 16) & 1u)) >> 16; }
__device__ __forceinline__ unsigned pk2(float lo, float hi) { return f2bf(lo) | (f2bf(hi) << 16); }
__device__ __forceinline__ float bf2f(unsigned short b) { return __builtin_bit_cast(float, ((unsigned)b) << 16); }
__device__ __forceinline__ float bflo(unsigned w) { return __builtin_bit_cast(float, w << 16); }
__device__ __forceinline__ float bfhi(unsigned w) { return __builtin_bit_cast(float, w & 0xffff0000u); }
__device__ __forceinline__ unsigned cvt_pk_bf16(float lo, float hi) { unsigned r; asm volatile("v_cvt_pk_bf16_f32 %0, %1, %2" : "=v"(r) : "v"(lo), "v"(hi)); return r; }
__device__ __forceinline__ int lane_id() { int l; asm volatile("v_mbcnt_lo_u32_b32 %0, -1, 0\n\tv_mbcnt_hi_u32_b32 %0, -1, %0" : "=v"(l)); return l; }
__device__ __forceinline__ float wave_sum(float v) {
#pragma unroll
    for (int o = 1; o < 64; o <<= 1) v += __shfl_xor(v, o);
    return v;
}

#define XB_TMO      128
#define XB_XCNT(j)  (256  + 64 * (j))
#define XB_XSUB(j)  (1280 + 64 * (j))
#define XB_XGEN(j)  (2304 + 64 * (j))
#define XB_TOP      3328
#define XB_TOPGEN   3392
#define XCD_BAR_WORDS 3456
#define XB_SPIN_CAP (1u << 18)
__device__ __forceinline__ unsigned xb_ld(unsigned* p)              { return __hip_atomic_load(p, __ATOMIC_RELAXED, __HIP_MEMORY_SCOPE_AGENT); }
__device__ __forceinline__ unsigned xb_add(unsigned* p, unsigned v) { return __hip_atomic_fetch_add(p, v, __ATOMIC_RELAXED, __HIP_MEMORY_SCOPE_AGENT); }
__device__ __forceinline__ unsigned xb_xcc_id() { return (unsigned)__builtin_amdgcn_s_getreg((3 << 11) | 20) & 0xFu; }
#define XB_SPIN(cond, bar) do { unsigned _sp = 0; while (cond) { __builtin_amdgcn_s_sleep(1); \
    if ((++_sp & 255u) == 0u) { if (xb_ld(&(bar)[XB_TMO])) break; if (_sp > XB_SPIN_CAP) { atomicAdd(&(bar)[XB_TMO], 1u); break; } } } } while (0)
struct XcdBarrier { unsigned* bar; unsigned x; volatile LAS unsigned* st; };
__device__ __forceinline__ XcdBarrier xcd_barrier_post(unsigned* bar, volatile LAS unsigned* st, int tid) {
    XcdBarrier b; b.bar = bar; b.x = xb_xcc_id(); b.st = st;
    if (tid == 0) (void)xb_add(&bar[XB_XCNT(b.x)], 1u);
    return b;
}
__device__ __forceinline__ void xcd_barrier_complete(unsigned* bar, unsigned x, unsigned& nloc, unsigned& nx) {
    const unsigned G = gridDim.x * gridDim.y * gridDim.z;
    unsigned sum, cnt, mine, sp = 0u;
    for (;;) {
        sum = 0u; cnt = 0u; mine = 0u;
#pragma unroll
        for (unsigned j = 0; j < 16; ++j) { const unsigned c = xb_ld(&bar[XB_XCNT(j)]); sum += c; cnt += (c > 0u) ? 1u : 0u; mine = (j == x) ? c : mine; }
        if (sum == G) break;
        __builtin_amdgcn_s_sleep(1);
        if ((++sp & 255u) == 0u) { if (xb_ld(&bar[XB_TMO])) break; if (sp > XB_SPIN_CAP) { atomicAdd(&bar[XB_TMO], 1u); break; } }
    }
    nloc = mine > 0u ? mine : 1u; nx = cnt > 0u ? cnt : 1u;
}
__device__ __forceinline__ void xcd_barrier(const XcdBarrier& b, int tid) {
    asm volatile("s_waitcnt vmcnt(0)" ::: "memory");
    __syncthreads();
    if (tid == 0) {
        unsigned* bar = b.bar;
        __builtin_amdgcn_s_waitcnt(0);
        unsigned nloc = b.st[0], nx = b.st[1];
        if (nloc == 0u) { xcd_barrier_complete(bar, b.x, nloc, nx); b.st[0] = nloc; b.st[1] = nx; }
        const unsigned old = xb_add(&bar[XB_XSUB(b.x)], 1u);
        const unsigned gen = old / nloc;
        if (old + 1u == (gen + 1u) * nloc) {
            __builtin_amdgcn_fence(__ATOMIC_RELEASE, "agent");
            asm volatile("s_waitcnt vmcnt(0)" ::: "memory");
            const unsigned og = xb_add(&bar[XB_TOP], 1u);
            const unsigned tg = og / nx;
            if (og + 1u == (tg + 1u) * nx) xb_add(&bar[XB_TOPGEN], 1u);
            else XB_SPIN(xb_ld(&bar[XB_TOPGEN]) == tg, bar);
            __builtin_amdgcn_fence(__ATOMIC_ACQUIRE, "agent");
            xb_add(&bar[XB_XGEN(b.x)], 1u);
            asm volatile("s_waitcnt vmcnt(0)" ::: "memory");
        } else {
            XB_SPIN(xb_ld(&bar[XB_XGEN(b.x)]) == gen, bar);
            __builtin_amdgcn_fence(__ATOMIC_ACQUIRE, "agent");
            asm volatile("s_waitcnt vmcnt(0)" ::: "memory");
        }
    }
    __syncthreads();
}

constexpr int BM = 256, BK = 64, HALF = 128, HTB = HALF * BK * 2, NXCD = 8, WGM = 8;
__host__ __device__ __forceinline__ int lds_byte(int r, int c) { const int st = (r >> 4) * 2 + (c >> 5), rr = r & 15, cc = c & 31, ob = rr * 64 + cc * 2; return st * 1024 + (ob ^ (((ob >> 9) & 1) << 5)); }
__host__ __device__ __forceinline__ void stage_rc(int b, int& R, int& C) { const int st = b / 1024, sb = b % 1024, swz = sb ^ (((sb >> 9) & 1) << 5); R = (st >> 1) * 16 + swz / 64; C = (st & 1) * 32 + (swz % 64) / 2; }
__host__ __device__ __forceinline__ int perm32(int rho) { const int n = rho >> 4, i = rho & 15; return 8 * (i >> 2) + 4 * n + (i & 3); }

struct Unit { int pm, pn, e, ui; };

struct StaticOrder {
    int nM, nN, nwg, G, c;
    __device__ void init(int M_, int N_, int G_, int c_) { nM = M_ / BM; nN = N_ / BM; nwg = nM * nN; G = G_; c = c_; }
    __device__ __forceinline__ bool next(int i, Unit& u) const {
        const long L = (long)i * G + c; if (L >= nwg) return false;
        int wgid = (int)L; { const int q = nwg / NXCD, r = nwg % NXCD, xcd = wgid % NXCD, off = wgid / NXCD; wgid = (xcd < r ? xcd * (q + 1) : r * (q + 1) + (xcd - r) * q) + off; }
        const int nig = WGM * nN, gid = wgid / nig, fm = gid * WGM, gsz = (nM - fm) < WGM ? (nM - fm) : WGM;
        u.pm = fm + ((wgid % nig) % gsz); u.pn = (wgid % nig) / gsz; u.e = 0; u.ui = i; return true;
    }
};
struct MoeOrder {
    int nct, total, G, c; const volatile LAS int* pref;
    __device__ void init(int nct_, int G_, int c_, const volatile LAS int* pref_) { nct = nct_; G = G_; c = c_; pref = pref_; total = pref_[NE] * nct_; }
    __device__ __forceinline__ bool next(int i, Unit& u) const {
        const int U = i * G + c; if (U >= total) return false;
        const int rtg = U / nct; u.pn = U - rtg * nct; u.pm = rtg; u.ui = i;
        int e = 0;
#pragma unroll 1
        for (int j = 1; j < NE; ++j) e = (pref[j] <= rtg) ? j : e;
        u.e = e; return true;
    }
};

struct GemmDesc { const bf16_t* A; const bf16_t* Bt; int K; int nct; };

template <class Epi, class Sched, bool GATHER, bool ALIGN_EPI>
__device__ __forceinline__ void gemm_phase(LAS unsigned char* lds, const GemmDesc g, const Sched& S, const Epi& E, const LAS int* tok, int wid) {
    const int lane = lane_id(), tid = wid * 64 + lane, wr = wid >> 2, wc = wid & 3, fr = lane & 15, fq = lane >> 4;
    const int K = g.K, nt = K / BK;
    int Rl[2], Cl[2];
    unsigned voffA[2], voffB[2];
#pragma unroll
    for (int i = 0; i < 2; ++i) { stage_rc(tid * 16 + i * 8192, Rl[i], Cl[i]); voffA[i] = (unsigned)(Rl[i] * K + Cl[i]) * 2u; voffB[i] = voffA[i]; }
    const size_t kstep = (size_t)(BK * 2);
    const size_t hstep = (size_t)HALF * K * 2;
    const size_t tstep = 2 * hstep;
    const unsigned ldsw = (unsigned)wid * 1024u;
    const int aoff = lds_byte(wr * 64 + fr, fq * 8), boff = lds_byte(wc * 32 + fr, fq * 8);
#define PG8_SA(b, h) (((b) * 2 + (h)) * HTB)
#define PG8_SB(b, h) ((4 + (b) * 2 + (h)) * HTB)
#define PG8_STAGE(bufoff, gbase, voff) do { _Pragma("unroll") for (int _i = 0; _i < 2; ++_i) \
        __builtin_amdgcn_global_load_lds((const unsigned*)((const char*)(gbase) + (voff)[_i]), (LAS unsigned*)(lds + (bufoff) + ldsw + _i * 8192), 16, 0, 0); } while (0)
#define PG8_STAGE_A(bufoff, ptr, half, o0, o1) do { if constexpr (GATHER) { PG8_STAGE(bufoff, ptr, (half) ? o1 : o0); } else { PG8_STAGE(bufoff, (ptr) + (half) * hstep, voffA); } } while (0)
#define PG8_LDA(dst, b, h) do { _Pragma("unroll") for (int m = 0; m < 4; ++m) _Pragma("unroll") for (int k = 0; k < 2; ++k) dst[m][k] = *(const LAS bf16x8*)(lds + PG8_SA(b, h) + aoff + m * 2048 + k * 1024); } while (0)
#define PG8_LDB(dst, b, h) do { _Pragma("unroll") for (int n = 0; n < 2; ++n) _Pragma("unroll") for (int k = 0; k < 2; ++k) dst[n][k] = *(const LAS bf16x8*)(lds + PG8_SB(b, h) + boff + n * 2048 + k * 1024); } while (0)
#define PG8_MMA(ai, bj, At, Bt) do { __builtin_amdgcn_s_setprio(1); _Pragma("unroll") for (int m = 0; m < 4; ++m) _Pragma("unroll") for (int n = 0; n < 2; ++n) _Pragma("unroll") for (int k = 0; k < 2; ++k) \
        acc[ai][bj][m][n] = __builtin_amdgcn_mfma_f32_16x16x32_bf16(Bt[n][k], At[m][k], acc[ai][bj][m][n], 0, 0, 0); __builtin_amdgcn_s_setprio(0); } while (0)
#define PG8_WAIT_V(n) asm volatile("s_waitcnt vmcnt(" #n ")" ::: "memory")
#define PG8_WAIT_L(n) asm volatile("s_waitcnt lgkmcnt(" #n ")" ::: "memory")
#define PG8_BAR __builtin_amdgcn_s_barrier()
#define PG8_SCHED __builtin_amdgcn_sched_barrier(0)
    Unit cur, nxt; int ui = 0;
    if (!S.next(0, cur)) return;
    f32x4 acc[2][2][4][2];
#pragma unroll
    for (int a = 0; a < 2; ++a)
#pragma unroll
        for (int b = 0; b < 2; ++b)
#pragma unroll
            for (int m = 0; m < 4; ++m)
#pragma unroll
                for (int n = 0; n < 2; ++n) acc[a][b][m][n] = (f32x4){0.f, 0.f, 0.f, 0.f};
    bf16x8 At[4][2], B0[2][2], B1[2][2];
    unsigned vA0[2] = {0u, 0u}, vA1[2] = {0u, 0u}, nA0[2] = {0u, 0u}, nA1[2] = {0u, 0u};
    const char* cA; const char* cB = (const char*)g.Bt + (size_t)(cur.e * g.nct + cur.pn) * tstep;
    if constexpr (GATHER) {
        cA = (const char*)g.A;
#pragma unroll
        for (int i = 0; i < 2; ++i) { vA0[i] = (unsigned)(tok[cur.ui * 256 + Rl[i]] * K + Cl[i]) * 2u; vA1[i] = (unsigned)(tok[cur.ui * 256 + 128 + Rl[i]] * K + Cl[i]) * 2u; nA0[i] = vA0[i]; nA1[i] = vA1[i]; }
    } else cA = (const char*)g.A + (size_t)cur.pm * tstep;
    PG8_STAGE(PG8_SB(0, 0), cB, voffB); PG8_STAGE(PG8_SB(0, 1), cB + hstep, voffB); PG8_STAGE_A(PG8_SA(0, 0), cA, 0, vA0, vA1); PG8_STAGE_A(PG8_SA(0, 1), cA, 1, vA0, vA1);
    if (wr == 1) PG8_BAR;
    PG8_WAIT_V(2); PG8_BAR;
    PG8_STAGE(PG8_SB(1, 0), cB + kstep, voffB); PG8_STAGE_A(PG8_SA(1, 0), cA + kstep, 0, vA0, vA1); PG8_STAGE(PG8_SB(1, 1), cB + hstep + kstep, voffB);
    PG8_WAIT_V(6); PG8_BAR;
    for (;;) {
        const bool has_next = S.next(ui + 1, nxt);
        const char* nAp; const char* nB;
        if (has_next) {
            nB = (const char*)g.Bt + (size_t)(nxt.e * g.nct + nxt.pn) * tstep;
            if constexpr (GATHER) { nAp = cA;
#pragma unroll
                for (int i = 0; i < 2; ++i) { nA0[i] = (unsigned)(tok[nxt.ui * 256 + Rl[i]] * K + Cl[i]) * 2u; nA1[i] = (unsigned)(tok[nxt.ui * 256 + 128 + Rl[i]] * K + Cl[i]) * 2u; }
            } else nAp = (const char*)g.A + (size_t)nxt.pm * tstep;
        } else { nAp = cA; nB = cB; }
        for (int t = 0; t < nt; t += 2) {
            const bool last = (t == nt - 2);
            const char* a1 = cA + (size_t)(t + 1) * kstep;
            const char* a2 = last ? nAp : cA + (size_t)(t + 2) * kstep; const char* b2 = last ? nB : cB + (size_t)(t + 2) * kstep;
            const char* a3 = a2 + kstep; const char* b3 = b2 + kstep;
            unsigned w0[2] = {0u, 0u}, w1[2] = {0u, 0u};
            if constexpr (GATHER) {
#pragma unroll
                for (int i = 0; i < 2; ++i) { w0[i] = last ? nA0[i] : vA0[i]; w1[i] = last ? nA1[i] : vA1[i]; } }
            if constexpr (Epi::MIDHOOK) { if (t == nt / 2) E.mid(acc, cur, wr, wc, fr, fq); }
            PG8_LDB(B0, 0, 0); PG8_LDB(B1, 0, 1); PG8_SCHED; PG8_LDA(At, 0, 0); PG8_STAGE_A(PG8_SA(1, 1), a1, 1, vA0, vA1);
            PG8_WAIT_V(8); PG8_WAIT_L(0); PG8_BAR; PG8_MMA(0, 0, At, B0); PG8_MMA(0, 1, At, B1); PG8_BAR; PG8_SCHED;
            PG8_LDA(At, 0, 1); PG8_STAGE(PG8_SB(0, 0), b2, voffB); PG8_STAGE(PG8_SB(0, 1), b2 + hstep, voffB); PG8_STAGE_A(PG8_SA(0, 0), a2, 0, w0, w1);
            PG8_WAIT_V(8); PG8_WAIT_L(0); PG8_BAR; PG8_MMA(1, 0, At, B0); PG8_MMA(1, 1, At, B1); PG8_BAR; PG8_SCHED;
            PG8_LDB(B0, 1, 0); PG8_LDB(B1, 1, 1); PG8_SCHED; PG8_LDA(At, 1, 0); PG8_STAGE_A(PG8_SA(0, 1), a2, 1, w0, w1);
            PG8_WAIT_V(8); PG8_WAIT_L(0); PG8_BAR; PG8_MMA(0, 0, At, B0); PG8_MMA(0, 1, At, B1); PG8_BAR; PG8_SCHED;
            PG8_LDA(At, 1, 1); PG8_STAGE(PG8_SB(1, 0), b3, voffB); PG8_STAGE(PG8_SB(1, 1), b3 + hstep, voffB); PG8_STAGE_A(PG8_SA(1, 0), a3, 0, w0, w1);
            PG8_WAIT_V(8); PG8_WAIT_L(0); PG8_BAR; PG8_MMA(1, 0, At, B0); PG8_MMA(1, 1, At, B1); PG8_BAR; PG8_SCHED;
        }
        if constexpr (ALIGN_EPI) { if (wr == 0) PG8_BAR; }
        E(acc, cur, wr, wc, fr, fq);
        if (!has_next) break;
#pragma unroll
        for (int a = 0; a < 2; ++a)
#pragma unroll
            for (int b = 0; b < 2; ++b)
#pragma unroll
                for (int m = 0; m < 4; ++m)
#pragma unroll
                    for (int n = 0; n < 2; ++n) acc[a][b][m][n] = (f32x4){0.f, 0.f, 0.f, 0.f};
        cur = nxt; cA = nAp; cB = nB; ++ui;
        if constexpr (GATHER) {
#pragma unroll
            for (int i = 0; i < 2; ++i) { vA0[i] = nA0[i]; vA1[i] = nA1[i]; } }
        if constexpr (ALIGN_EPI) { if (wr == 1) PG8_BAR; }
    }
    PG8_WAIT_V(0);
    if constexpr (!ALIGN_EPI) { if (wr == 0) PG8_BAR; }
    PG8_BAR;
#undef PG8_SA
#undef PG8_SB
#undef PG8_STAGE
#undef PG8_STAGE_A
#undef PG8_LDA
#undef PG8_LDB
#undef PG8_MMA
#undef PG8_WAIT_V
#undef PG8_WAIT_L
#undef PG8_BAR
#undef PG8_SCHED
}
typedef f32x4 Acc[2][2][4][2];
__device__ __forceinline__ float silu_(float x) { return x * __builtin_amdgcn_rcpf(1.f + __expf(-x)); }
__device__ __forceinline__ float sigm_(float x) { return __builtin_amdgcn_rcpf(1.f + __expf(-x)); }
__device__ __forceinline__ u32x4 pack8(const f32x4 a, const f32x4 b) { u32x4 w; w.x = cvt_pk_bf16(a[0], a[1]); w.y = cvt_pk_bf16(a[2], a[3]); w.z = cvt_pk_bf16(b[0], b[1]); w.w = cvt_pk_bf16(b[2], b[3]); return w; }
__device__ __forceinline__ void unpack8(const u32x4 w, f32x4& a, f32x4& b) { a = (f32x4){bflo(w.x), bfhi(w.x), bflo(w.y), bfhi(w.y)}; b = (f32x4){bflo(w.z), bfhi(w.z), bflo(w.w), bfhi(w.w)}; }

struct EpiInproj {
    static constexpr bool MIDHOOK = false;
    const float* rs1; const float* lb; bf16_t *QS, *VV, *GS, *UU, *SBb, *RT, *GBS; float* LF;
    __device__ __forceinline__ void mid(Acc&, const Unit&, int, int, int, int) const {}
    template <int ACT> __device__ __forceinline__ void plain(const Acc& acc, const float (&rs)[2][4], bf16_t* O, int pt, int row0, int wc, int fq) const {
#pragma unroll
        for (int ai = 0; ai < 2; ++ai)
#pragma unroll
            for (int m = 0; m < 4; ++m) { bf16_t* rowp = O + (size_t)(row0 + ai * HALF + m * 16) * HF + pt * 256 + wc * 32 + 8 * fq; const float r = rs[ai][m];
#pragma unroll
                for (int bj = 0; bj < 2; ++bj) { f32x4 v0 = acc[ai][bj][m][0] * r, v1 = acc[ai][bj][m][1] * r;
                    if (ACT == 1) {
#pragma unroll
                        for (int j = 0; j < 4; ++j) { v0[j] = silu_(v0[j]); v1[j] = silu_(v1[j]); } }
                    *(u32x4*)(rowp + bj * HALF) = pack8(v0, v1); } }
    }
    __device__ __forceinline__ void operator()(const Acc& acc, const Unit& u, int wr, int wc, int fr, int fq) const {
        const int row0 = u.pm * BM + wr * 64 + fr, pn = u.pn;
        float rs[2][4];
#pragma unroll
        for (int ai = 0; ai < 2; ++ai)
#pragma unroll
            for (int m = 0; m < 4; ++m) rs[ai][m] = rs1[row0 + ai * HALF + m * 16];
        asm volatile("" : "+v"(rs[0][0]), "+v"(rs[0][1]), "+v"(rs[0][2]), "+v"(rs[0][3]), "+v"(rs[1][0]), "+v"(rs[1][1]), "+v"(rs[1][2]), "+v"(rs[1][3]));
        if (pn < 4) plain<1>(acc, rs, QS, pn, row0, wc, fq);
        else if (pn < 8) {
            const int c0 = (pn - 4) * 256 + wc * 32 + 4 * fq;
            f32x4 lbv[2][2];
#pragma unroll
            for (int bj = 0; bj < 2; ++bj)
#pragma unroll
                for (int n = 0; n < 2; ++n) lbv[bj][n] = *(const f32x4*)(lb + c0 + bj * HALF + n * 16);
#pragma unroll
            for (int ai = 0; ai < 2; ++ai)
#pragma unroll
                for (int m = 0; m < 4; ++m) { float* rowp = LF + (size_t)(row0 + ai * HALF + m * 16) * HF + c0; const float r = rs[ai][m];
#pragma unroll
                    for (int bj = 0; bj < 2; ++bj)
#pragma unroll
                        for (int n = 0; n < 2; ++n) { f32x4 v = acc[ai][bj][m][n] * r; const f32x4 l = lbv[bj][n];
#pragma unroll
                            for (int j = 0; j < 4; ++j) v[j] = __logf(l[j] + (1.f - l[j]) * sigm_(v[j]));
                            *(f32x4*)(rowp + bj * HALF + n * 16) = v; } }
        }
        else if (pn < 12) plain<0>(acc, rs, VV, pn - 8, row0, wc, fq);
        else if (pn < 16) plain<1>(acc, rs, GS, pn - 12, row0, wc, fq);
        else if (pn < 24) {
            const int c0 = (pn - 16) * 128 + wc * 32 + 8 * fq;
#pragma unroll
            for (int ai = 0; ai < 2; ++ai)
#pragma unroll
                for (int m = 0; m < 4; ++m) { const float r2 = rs[ai][m] * rs[ai][m];
                    const f32x4 v0 = acc[ai][0][m][0] * acc[ai][1][m][0] * r2, v1 = acc[ai][0][m][1] * acc[ai][1][m][1] * r2;
                    *(u32x4*)(UU + (size_t)(row0 + ai * HALF + m * 16) * HF + c0) = pack8(v0, v1); }
        }
        else if (pn < 28) plain<0>(acc, rs, SBb, pn - 24, row0, wc, fq);
        else {
            const int c0 = (pn - 28) * 128 + wc * 32 + 8 * fq;
#pragma unroll
            for (int ai = 0; ai < 2; ++ai)
#pragma unroll
                for (int m = 0; m < 4; ++m) { const float r = rs[ai][m]; f32x4 q0, q1, b0, b1;
#pragma unroll
                    for (int j = 0; j < 4; ++j) { const float ea = 1.f + __expf(-acc[ai][0][m][0][j] * r), eb = 1.f + __expf(-acc[ai][1][m][0][j] * r); b0[j] = __builtin_amdgcn_rcpf(eb); q0[j] = eb * __builtin_amdgcn_rcpf(ea);
                                                  const float fa = 1.f + __expf(-acc[ai][0][m][1][j] * r), fb = 1.f + __expf(-acc[ai][1][m][1][j] * r); b1[j] = __builtin_amdgcn_rcpf(fb); q1[j] = fb * __builtin_amdgcn_rcpf(fa); }
                    const size_t o = (size_t)(row0 + ai * HALF + m * 16) * D + c0;
                    *(u32x4*)(RT + o) = pack8(q0, q1); *(u32x4*)(GBS + o) = pack8(b0, b1); }
        }
    }
};

struct EpiMerge {
    static constexpr bool MIDHOOK = true;
    const bf16_t *RT, *GBS; bf16_t* MG;
    __device__ __forceinline__ void mid(Acc& acc, const Unit& u, int wr, int wc, int fr, int fq) const {
        const int row0 = u.pm * BM + wr * 64 + fr, c0 = u.pn * BM + wc * 32 + 8 * fq;
#pragma unroll
        for (int ai = 0; ai < 2; ++ai)
#pragma unroll
            for (int m = 0; m < 4; ++m)
#pragma unroll
                for (int bj = 0; bj < 2; ++bj) { const u32x4 w = *(const u32x4*)(RT + (size_t)(row0 + ai * HALF + m * 16) * D + c0 + bj * HALF); f32x4 a, b; unpack8(w, a, b);
                    acc[ai][bj][m][0] *= a; acc[ai][bj][m][1] *= b; if (bj == 1 && (m & 1)) asm volatile("" ::: "memory"); }
    }
    __device__ __forceinline__ void operator()(const Acc& acc, const Unit& u, int wr, int wc, int fr, int fq) const {
        const int row0 = u.pm * BM + wr * 64 + fr, c0 = u.pn * BM + wc * 32 + 8 * fq;
#pragma unroll
        for (int ai = 0; ai < 2; ++ai)
#pragma unroll
            for (int m = 0; m < 4; ++m)
#pragma unroll
                for (int bj = 0; bj < 2; ++bj) { const size_t o = (size_t)(row0 + ai * HALF + m * 16) * D + c0 + bj * HALF; const u32x4 w = *(const u32x4*)(GBS + o); f32x4 a, b; unpack8(w, a, b);
                    *(u32x4*)(MG + o) = pack8(acc[ai][bj][m][0] * a, acc[ai][bj][m][1] * b); }
    }
};

struct EpiWo {
    static constexpr bool MIDHOOK = false;
    const float* X; float* H1; bf16_t* H1B;
    __device__ __forceinline__ void mid(Acc&, const Unit&, int, int, int, int) const {}
    __device__ __forceinline__ void operator()(const Acc& acc, const Unit& u, int wr, int wc, int fr, int fq) const {
        const int row0 = u.pm * BM + wr * 64 + fr, c0 = u.pn * BM + wc * 32 + 8 * fq;
#pragma unroll
        for (int ai = 0; ai < 2; ++ai)
#pragma unroll
            for (int m = 0; m < 4; ++m)
#pragma unroll
                for (int bj = 0; bj < 2; ++bj) { const size_t o = (size_t)(row0 + ai * HALF + m * 16) * D + c0 + bj * HALF;
                    const f32x4 h0 = *(const f32x4*)(X + o) + acc[ai][bj][m][0], h1 = *(const f32x4*)(X + o + 4) + acc[ai][bj][m][1];
                    *(f32x4*)(H1 + o) = h0; *(f32x4*)(H1 + o + 4) = h1; *(u32x4*)(H1B + o) = pack8(h0, h1); }
    }
};

struct EpiUp {
    static constexpr bool MIDHOOK = false;
    const float* rs2; const LAS int* tok; const float* b_up; bf16_t* ACT;
    __device__ __forceinline__ void mid(Acc&, const Unit&, int, int, int, int) const {}
    __device__ __forceinline__ void operator()(const Acc& acc, const Unit& u, int wr, int wc, int fr, int fq) const {
        const int rl0 = wr * 64 + fr, c0 = u.pn * 128 + wc * 32 + 8 * fq;
        float rs[2][4];
#pragma unroll
        for (int ai = 0; ai < 2; ++ai)
#pragma unroll
            for (int m = 0; m < 4; ++m) rs[ai][m] = rs2[tok[u.ui * 256 + rl0 + ai * HALF + m * 16]];
        const float* bp = b_up + (size_t)u.e * 4096 + c0;
        const f32x4 bg0 = *(const f32x4*)(bp), bg1 = *(const f32x4*)(bp + 4), bu0 = *(const f32x4*)(bp + 2048), bu1 = *(const f32x4*)(bp + 2052);
#pragma unroll
        for (int ai = 0; ai < 2; ++ai)
#pragma unroll
            for (int m = 0; m < 4; ++m) { const float r = rs[ai][m]; f32x4 a0, a1;
#pragma unroll
                for (int j = 0; j < 4; ++j) {
                    float g = fminf(acc[ai][0][m][0][j] * r + bg0[j], 7.f), uu = fminf(fmaxf(acc[ai][1][m][0][j] * r + bu0[j], -7.f), 7.f); a0[j] = (uu + 1.f) * g * sigm_(1.702f * g);
                    g = fminf(acc[ai][0][m][1][j] * r + bg1[j], 7.f); uu = fminf(fmaxf(acc[ai][1][m][1][j] * r + bu1[j], -7.f), 7.f); a1[j] = (uu + 1.f) * g * sigm_(1.702f * g); }
                *(u32x4*)(ACT + (size_t)(u.pm * BM + rl0 + ai * HALF + m * 16) * DFF + c0) = pack8(a0, a1); }
    }
};

struct EpiDown {
    static constexpr bool MIDHOOK = false;
    const float* b_dn; bf16_t* YR;
    __device__ __forceinline__ void mid(Acc&, const Unit&, int, int, int, int) const {}
    __device__ __forceinline__ void operator()(const Acc& acc, const Unit& u, int wr, int wc, int fr, int fq) const {
        const int rl0 = wr * 64 + fr, c0 = u.pn * BM + wc * 32 + 8 * fq;
        const float* bp = b_dn + (size_t)u.e * D + c0;
        f32x4 bv[2][2];
#pragma unroll
        for (int bj = 0; bj < 2; ++bj)
#pragma unroll
            for (int n = 0; n < 2; ++n) bv[bj][n] = *(const f32x4*)(bp + bj * HALF + 4 * n);
#pragma unroll
        for (int ai = 0; ai < 2; ++ai)
#pragma unroll
            for (int m = 0; m < 4; ++m)
#pragma unroll
                for (int bj = 0; bj < 2; ++bj)
                    *(u32x4*)(YR + (size_t)(u.pm * BM + rl0 + ai * HALF + m * 16) * D + c0 + bj * HALF) = pack8(acc[ai][bj][m][0] + bv[bj][0], acc[ai][bj][m][1] + bv[bj][1]);
    }
};
struct Frame {
    LAS unsigned char* lds; volatile LAS unsigned* MISC; gu32* ctl; unsigned char* ws;
    int tid, lane, wave, vcu, G;
    const float *x, *meta, *nmw, *w_in, *lbl, *gnw, *w_ho, *cw, *w_co, *w_o, *nfw, *w_r, *b_r, *w_up, *b_up, *w_dn, *b_dn, *fnw; float* out;
};
template <class T> __device__ __forceinline__ T* wsp(const Frame& F, size_t off) { return (T*)(F.ws + off); }

__device__ __forceinline__ void tr_item(const float* W, int ldw, int k0, int ncol0, const float* kscale, bool perm, bf16_t* dst, int dpitch, int drow0, int dk0, LAS float* scr, int lane) {
#pragma unroll 8
    for (int i = 0; i < 32; ++i) { const int kk = 2 * i + (lane >> 5); float v = W[(size_t)(k0 + kk) * ldw + ncol0 + (lane & 31)]; if (kscale) v *= kscale[k0 + kk]; scr[kk * 33 + (lane & 31)] = v; }
    LDS_WAIT(); asm volatile("" ::: "memory");
    const int c = lane & 7;
#pragma unroll
    for (int j = 0; j < 4; ++j) { const int n = (lane >> 3) + 8 * j; const int sn = perm ? perm32(n) : n; const LAS float* s = scr + (8 * c) * 33 + sn;
        u32x4 o; o.x = pk2(s[0 * 33], s[1 * 33]); o.y = pk2(s[2 * 33], s[3 * 33]); o.z = pk2(s[4 * 33], s[5 * 33]); o.w = pk2(s[6 * 33], s[7 * 33]);
        *(GAS u32x4*)(dst + (size_t)(drow0 + n) * dpitch + dk0 + k0 + 8 * c) = o; }
    LDS_WAIT(); asm volatile("" ::: "memory");
}
__device__ __forceinline__ int win_src(int G, bool& perm) {
    const int pn = G >> 3, gi = G & 7; perm = true;
    if (pn < 4) return C_Q + pn * 256 + gi * 32;
    if (pn < 8) { perm = false; return C_F + (pn - 4) * 256 + gi * 32; }
    if (pn < 12) return C_V + (pn - 8) * 256 + gi * 32;
    if (pn < 16) return C_G + (pn - 12) * 256 + gi * 32;
    if (pn < 24) return (gi < 4 ? C_SV : C_SC) + (pn - 16) * 128 + (gi & 3) * 32;
    if (pn < 28) return C_SB + (pn - 24) * 256 + gi * 32;
    return (gi < 4 ? C_GA : C_GB) + (pn - 28) * 128 + (gi & 3) * 32;
}
__device__ __forceinline__ void p0_prologue(Frame& F) {
    const int gw = F.vcu * NWAVES + F.wave, NGW = F.G * NWAVES, gt = F.vcu * NTHR + F.tid, NGT = F.G * NTHR;
    for (int i = gt; i < HF; i += NGT) wsp<float>(F, WS_LB)[i] = 1.f / (1.f + __expf(F.lbl[HF + i] - F.lbl[i]));
    for (int i = gt; i < D * NE; i += NGT) { const int k = i >> 5, e = i & 31; const float v = F.w_r[i] * F.nfw[k]; const unsigned h = f2bf(v); const float lo = v - bf2f((unsigned short)h);
        wsp<bf16_t>(F, WS_WRH)[e * D + k] = (bf16_t)h; wsp<bf16_t>(F, WS_WRL)[e * D + k] = (bf16_t)f2bf(lo); }
    for (int i = gt; i < 48 * HF; i += NGT) { wsp<float>(F, WS_LFM)[i] = 0.f; wsp<bf16_t>(F, WS_VVM)[i] = 0; }
    {
        LAS float* hnm = (LAS float*)F.lds;
        for (int r = F.wave * 2; r < F.wave * 2 + 2; ++r) {
            const f32x4* xr = (const f32x4*)(F.meta + (size_t)r * D) + F.lane; f32x4 v[8]; float s = 0.f;
#pragma unroll
            for (int j = 0; j < 8; ++j) { v[j] = xr[64 * j]; s += (v[j].x * v[j].x + v[j].y * v[j].y) + (v[j].z * v[j].z + v[j].w * v[j].w); }
            const float rs = rsqrtf(wave_sum(s) * (1.f / D) + EPS);
#pragma unroll
            for (int j = 0; j < 8; ++j) { const f32x4 w = ((const f32x4*)F.nmw)[F.lane + 64 * j]; *(LAS f32x4*)(hnm + r * D + 4 * F.lane + 256 * j) = v[j] * rs * w; }
        }
        __syncthreads();
        LAS float* red = (LAS float*)(F.lds + TOK_OFF);
        for (int cb = F.vcu; cb < 256; cb += F.G) {
            const int col = F.tid & 15, ks = F.tid >> 4;
            int gcol;
            if (cb < 64) gcol = C_F + 16 * cb + col; else if (cb < 128) gcol = C_V + 16 * (cb - 64) + col; else gcol = (col < 8 ? C_SV : C_SC) + 8 * (cb - 128) + (col & 7);
            float a[16];
#pragma unroll
            for (int r = 0; r < 16; ++r) a[r] = 0.f;
            for (int k = ks * 64; k < ks * 64 + 64; ++k) { const float w = F.w_in[(size_t)k * INC + gcol];
#pragma unroll
                for (int r = 0; r < 16; ++r) a[r] = fmaf(hnm[r * D + k], w, a[r]); }
#pragma unroll
            for (int r = 0; r < 16; ++r) { a[r] += __shfl_xor(a[r], 16); a[r] += __shfl_xor(a[r], 32); }
            if (F.lane < 16) {
#pragma unroll
                for (int r = 0; r < 16; ++r) red[(F.wave * 16 + r) * 16 + col] = a[r]; }
            __syncthreads();
            if (F.tid < 256) { const int r = F.tid >> 4, c = F.tid & 15; float v = 0.f;
#pragma unroll
                for (int w = 0; w < 8; ++w) v += red[(w * 16 + r) * 16 + c];
                if (cb < 64) { const int ch = 16 * cb + c; const float l = 1.f / (1.f + __expf(F.lbl[HF + ch] - F.lbl[ch])); wsp<float>(F, WS_LFM)[(48 + r) * HF + ch] = __logf(l + (1.f - l) * sigmoidf_(v)); }
                else if (cb < 128) wsp<bf16_t>(F, WS_VVM)[(48 + r) * HF + 16 * (cb - 64) + c] = (bf16_t)f2bf(v);
                else red[2048 + r * 16 + c] = v; }
            __syncthreads();
            if (cb >= 128 && F.tid < 128) { const int r = F.tid >> 3, c = F.tid & 7; wsp<bf16_t>(F, WS_UUM)[r * HF + 8 * (cb - 128) + c] = (bf16_t)f2bf(red[2048 + r * 16 + c] * red[2048 + r * 16 + c + 8]); }
            __syncthreads();
        }
        __syncthreads();
    }
    {
        LAS float* scr = (LAS float*)(F.lds + F.wave * 16384);
        constexpr int I_IN = 32 * 352, I_AB = 16 * 64, I_O = 32 * 64, I_UP1 = 32 * 128, I_DN1 = 32 * 64;
        constexpr int NIT = I_IN + 2 * I_AB + I_O + NE * I_UP1 + NE * I_DN1;
        for (int it = gw; it < NIT; it += NGW) {
            int r = it;
            if (r < I_IN) { const int kb = r / 352, G = r % 352; bool pm; const int sc = win_src(G, pm); tr_item(F.w_in, INC, kb * 64, sc, F.nmw, pm, wsp<bf16_t>(F, WS_WIN), D, G * 32, 0, scr, F.lane); continue; } r -= I_IN;
            if (r < I_AB) { const int kb = r / 64, G = r % 64; tr_item(F.w_ho, D, kb * 64, G * 32, nullptr, true, wsp<bf16_t>(F, WS_WAB), D, G * 32, 0, scr, F.lane); continue; } r -= I_AB;
            if (r < I_AB) { const int kb = r / 64, G = r % 64; tr_item(F.w_co, D, kb * 64, G * 32, nullptr, true, wsp<bf16_t>(F, WS_WAB), D, G * 32, HF, scr, F.lane); continue; } r -= I_AB;
            if (r < I_O) { const int kb = r / 64, G = r % 64; tr_item(F.w_o, D, kb * 64, G * 32, nullptr, true, wsp<bf16_t>(F, WS_WO), D, G * 32, 0, scr, F.lane); continue; } r -= I_O;
            if (r < NE * I_UP1) { const int e = r / I_UP1, q = r % I_UP1, kb = q / 128, G = q % 128, pn = G >> 3, gi = G & 7; const int sc = (gi < 4 ? 0 : 2048) + pn * 128 + (gi & 3) * 32;
                tr_item(F.w_up + (size_t)e * D * 4096, 4096, kb * 64, sc, F.nfw, true, wsp<bf16_t>(F, WS_WUP) + (size_t)e * 4096 * D, D, G * 32, 0, scr, F.lane); continue; } r -= NE * I_UP1;
            { const int e = r / I_DN1, q = r % I_DN1, kb = q / 64, G = q % 64;
              tr_item(F.w_dn + (size_t)e * DFF * D, D, kb * 64, G * 32, nullptr, true, wsp<bf16_t>(F, WS_WDN) + (size_t)e * D * DFF, DFF, G * 32, 0, scr, F.lane); }
        }
    }
    for (int m = gw; m < M; m += NGW) {
        const GAS f32x4* xr = (const GAS f32x4*)(F.x + (size_t)m * D) + F.lane; f32x4 v[8]; float s = 0.f;
#pragma unroll
        for (int j = 0; j < 8; ++j) { v[j] = xr[64 * j]; s += (v[j].x * v[j].x + v[j].y * v[j].y) + (v[j].z * v[j].z + v[j].w * v[j].w); }
        s = wave_sum(s);
        GAS u32x2* o8 = (GAS u32x2*)(wsp<bf16_t>(F, WS_XB) + (size_t)m * D) + F.lane;
#pragma unroll
        for (int j = 0; j < 8; ++j) { u32x2 w; w.x = pk2(v[j].x, v[j].y); w.y = pk2(v[j].z, v[j].w); o8[64 * j] = w; }
        if (F.lane == 0) wsp<float>(F, WS_RS1)[m] = rsqrtf(s * (1.f / D) + EPS);
    }
}

constexpr int KTP = 72;
constexpr int QP_ = 136;
__device__ __forceinline__ void load_vt(const Frame& F, const bf16_t* Vb, size_t row0, int h, LAS bf16_t* VT) {
#pragma unroll
    for (int q = 0; q < 2; ++q) { const int id = F.tid + 512 * q, t = id >> 4, v8 = (id & 15) * 8; const u32x4 w = *(const GAS u32x4*)(Vb + (row0 + t) * HF + h * 128 + v8);
        const unsigned ww[4] = {w.x, w.y, w.z, w.w};
#pragma unroll
        for (int i = 0; i < 4; ++i) { VT[(v8 + 2 * i) * KTP + t] = (bf16_t)(ww[i] & 0xffffu); VT[(v8 + 2 * i + 1) * KTP + t] = (bf16_t)(ww[i] >> 16); } }
}
__device__ __forceinline__ void p2a_unit(Frame& F, int u) {
    LAS bf16_t* KT = (LAS bf16_t*)F.lds; LAS bf16_t* VT = KT + 128 * KTP; LAS float* TOT = (LAS float*)(F.lds + 2 * 128 * KTP * 2);
    const float* Lb; const bf16_t* Vb; size_t row0; int h, slot;
    if (u < 8) { Lb = wsp<float>(F, WS_LFM); Vb = wsp<bf16_t>(F, WS_VVM); row0 = 0; h = u; slot = 32 * 64 + u; }
    else { const int bh = (u - 8) >> 6, c = (u - 8) & 63, b = bh >> 3; h = bh & 7; Lb = wsp<float>(F, WS_LF); Vb = wsp<bf16_t>(F, WS_VV); row0 = (size_t)b * SEQ + 64 * c; slot = bh * 64 + c; }
    const int d = F.tid & 127, tq = F.tid >> 7;
    float L[16], cs[16]; float run = 0.f;
#pragma unroll
    for (int i = 0; i < 16; ++i) L[i] = Lb[(row0 + 16 * tq + i) * HF + h * 128 + d];
#pragma unroll
    for (int i = 0; i < 16; ++i) { run += L[i]; cs[i] = run; }
    TOT[tq * 128 + d] = run;
    load_vt(F, Vb, row0, h, VT);
    __syncthreads();
    float off = 0.f, total = 0.f;
#pragma unroll
    for (int q = 0; q < 4; ++q) { const float tv = TOT[q * 128 + d]; total += tv; if (q < tq) off += tv; }
#pragma unroll
    for (int i = 0; i < 16; i += 2) { const float k0 = (1.f - __expf(L[i])) * __expf(total - off - cs[i]), k1 = (1.f - __expf(L[i + 1])) * __expf(total - off - cs[i + 1]);
        *(LAS unsigned*)(KT + d * KTP + 16 * tq + i) = pk2(k0, k1); }
    if (tq == 0) wsp<float>(F, WS_DEC)[(size_t)slot * 128 + d] = __expf(total);
    __syncthreads();
    {
        const int w = F.wave, fr = F.lane & 15, fq = F.lane >> 4;
        bf16x8 a[2];
#pragma unroll
        for (int ks = 0; ks < 2; ++ks) a[ks] = *(const LAS bf16x8*)(KT + (16 * w + fr) * KTP + 32 * ks + 8 * fq);
        bf16_t* Ub = wsp<bf16_t>(F, WS_UC) + (size_t)slot * 16384;
#pragma unroll
        for (int vb = 0; vb < 8; ++vb) { f32x4 c = (f32x4){0.f, 0.f, 0.f, 0.f};
#pragma unroll
            for (int ks = 0; ks < 2; ++ks) { const bf16x8 bv = *(const LAS bf16x8*)(VT + (16 * vb + fr) * KTP + 32 * ks + 8 * fq); c = __builtin_amdgcn_mfma_f32_16x16x32_bf16(a[ks], bv, c, 0, 0, 0); }
            u32x2 o; o.x = pk2(c[0], c[1]); o.y = pk2(c[2], c[3]);
            *(GAS u32x2*)(Ub + (16 * vb + fr) * 128 + 16 * w + 4 * fq) = o; }
    }
    __syncthreads();
}
__device__ __forceinline__ void p2a_conv(Frame& F, int item) {
    const int c8 = (F.tid & 127) * 8, tq = F.tid >> 7, r0 = item * 64 + tq * 16, p0 = r0 & (SEQ - 1);
    const bf16_t* UU = wsp<bf16_t>(F, WS_UU); const bf16_t* UUM = wsp<bf16_t>(F, WS_UUM); const bf16_t* SBb = wsp<bf16_t>(F, WS_SB); bf16_t* A2 = wsp<bf16_t>(F, WS_A2);
    f32x4 w0a = *(const f32x4*)(F.cw + c8), w0b = *(const f32x4*)(F.cw + c8 + 4), w1a = *(const f32x4*)(F.cw + HF + c8), w1b = *(const f32x4*)(F.cw + HF + c8 + 4), w2a = *(const f32x4*)(F.cw + 2 * HF + c8), w2b = *(const f32x4*)(F.cw + 2 * HF + c8 + 4);
    f32x4 um2a, um2b, um1a, um1b;
    { const u32x4 a = (p0 >= 2) ? *(const GAS u32x4*)(UU + (size_t)(r0 - 2) * HF + c8) : *(const GAS u32x4*)(UUM + (14 + p0) * HF + c8); unpack8(a, um2a, um2b);
      const u32x4 b = (p0 >= 1) ? *(const GAS u32x4*)(UU + (size_t)(r0 - 1) * HF + c8) : *(const GAS u32x4*)(UUM + 15 * HF + c8); unpack8(b, um1a, um1b); }
#pragma unroll 4
    for (int i = 0; i < 16; ++i) { f32x4 ua, ub, sa, sb; unpack8(*(const GAS u32x4*)(UU + (size_t)(r0 + i) * HF + c8), ua, ub); unpack8(*(const GAS u32x4*)(SBb + (size_t)(r0 + i) * HF + c8), sa, sb);
        const f32x4 oa = sa * (w0a * um2a + w1a * um1a + w2a * ua), ob = sb * (w0b * um2b + w1b * um1b + w2b * ub);
        *(GAS u32x4*)(A2 + (size_t)(r0 + i) * D + HF + c8) = pack8(oa, ob);
        um2a = um1a; um2b = um1b; um1a = ua; um1b = ub; }
}
__device__ __forceinline__ void p2b_scan(Frame& F) {
    const int gw = F.vcu * NWAVES + F.wave;
    for (int it = gw; it < 1024; it += F.G * NWAVES) {
        const int item = it * 64 + F.lane, bh = item >> 11, e8 = item & 2047, h = bh & 7, d0 = (e8 & 15) * 8;
        const bf16_t* Ub = wsp<bf16_t>(F, WS_UC) + (size_t)bh * 64 * 16384 + e8 * 8; bf16_t* Sb = wsp<bf16_t>(F, WS_SS) + (size_t)bh * 64 * 16384 + e8 * 8;
        const float* Db = wsp<float>(F, WS_DEC) + (size_t)bh * 64 * 128 + d0;
        f32x4 s0, s1; unpack8(*(const GAS u32x4*)(wsp<bf16_t>(F, WS_UC) + (size_t)(32 * 64 + h) * 16384 + e8 * 8), s0, s1);
#pragma unroll 8
        for (int c = 0; c < 64; ++c) {
            *(GAS u32x4*)(Sb + (size_t)c * 16384) = pack8(s0, s1);
            f32x4 u0, u1; unpack8(*(const GAS u32x4*)(Ub + (size_t)c * 16384), u0, u1);
            const f32x4 g0 = *(const GAS f32x4*)(Db + c * 128), g1 = *(const GAS f32x4*)(Db + c * 128 + 4);
            s0 = g0 * s0 + u0; s1 = g1 * s1 + u1;
        }
    }
}
__device__ __forceinline__ void p2c_unit(Frame& F, int u) {
    const int bh = u >> 6, c = u & 63, b = bh >> 3, h = bh & 7; const size_t row0 = (size_t)b * SEQ + 64 * c;
    LAS bf16_t* QPl = (LAS bf16_t*)F.lds; LAS bf16_t* QD = QPl + 64 * QP_; LAS bf16_t* KI = QD + 64 * QP_; LAS bf16_t* VT = KI + 160 * QP_; LAS bf16_t* PL = VT + 128 * KTP;
    LAS float* TOT8 = (LAS float*)(PL + 64 * KTP); LAS float* SSQ = TOT8 + 8 * 128;
    const int dp = (F.tid & 63) * 2, t8 = F.tid >> 6;
    const float* Lb = wsp<float>(F, WS_LF) + (row0 + 8 * t8) * HF + h * 128 + dp; const bf16_t* Qb = wsp<bf16_t>(F, WS_QS) + (row0 + 8 * t8) * HF + h * 128 + dp;
    f32x2 L[8], cs[8], q[8]; f32x2 run = (f32x2){0.f, 0.f};
#pragma unroll
    for (int i = 0; i < 8; ++i) { L[i] = *(const GAS f32x2*)(Lb + (size_t)i * HF); const unsigned w = *(const GAS unsigned*)(Qb + (size_t)i * HF); q[i] = (f32x2){bflo(w), bfhi(w)}; }
#pragma unroll
    for (int i = 0; i < 8; ++i) { run += L[i]; cs[i] = run; }
    *(LAS f32x2*)(TOT8 + t8 * 128 + dp) = run;
    load_vt(F, wsp<bf16_t>(F, WS_VV), row0, h, VT);
    for (int i = F.tid; i < 64 * KTP / 2; i += NTHR) ((LAS unsigned*)PL)[i] = 0u;
    __syncthreads();
    {
        f32x2 pre[9]; pre[0] = (f32x2){0.f, 0.f};
#pragma unroll
        for (int j = 0; j < 8; ++j) pre[j + 1] = pre[j] + *(const LAS f32x2*)(TOT8 + j * 128 + dp);
        f32x2 off = (f32x2){0.f, 0.f};
#pragma unroll
        for (int j = 0; j < 8; ++j) if (j == t8) off = pre[j];
        const int si = t8 >> 1;
        f32x2 st[4];
#pragma unroll
        for (int j = 0; j < 4; ++j) st[j] = pre[2 * j];
        f32x2 sti = st[0];
#pragma unroll
        for (int j = 1; j < 4; ++j) if (j == si) sti = st[j];
#pragma unroll
        for (int i = 0; i < 8; ++i) { const int t = 8 * t8 + i; const f32x2 bc = off + cs[i];
            *(LAS unsigned*)(QPl + t * QP_ + dp) = pk2(q[i].x * __expf(bc.x), q[i].y * __expf(bc.y));
            *(LAS unsigned*)(QD + t * QP_ + dp) = pk2(q[i].x * __expf(bc.x - sti.x), q[i].y * __expf(bc.y - sti.y));
            const f32x2 k = (f32x2){1.f - __expf(L[i].x), 1.f - __expf(L[i].y)};
#pragma unroll
            for (int j = 0; j < 4; ++j) if (j >= si) {
                *(LAS unsigned*)(KI + (8 * j * (j + 1) + t) * QP_ + dp) = pk2(k.x * __expf(fminf(st[j].x - bc.x, 80.f)), k.y * __expf(fminf(st[j].y - bc.y, 80.f))); }
        }
    }
    __syncthreads();
    const int w = F.wave, fr = F.lane & 15, fq = F.lane >> 4;
    for (int bi = w; bi < 10; bi += 8) {
        const int i = bi < 1 ? 0 : bi < 3 ? 1 : bi < 6 ? 2 : 3, j = bi - (i * (i + 1)) / 2;
        f32x4 cacc = (f32x4){0.f, 0.f, 0.f, 0.f};
#pragma unroll
        for (int ks = 0; ks < 4; ++ks) { const bf16x8 a = *(const LAS bf16x8*)(KI + (8 * i * (i + 1) + 16 * j + fr) * QP_ + 32 * ks + 8 * fq), bq = *(const LAS bf16x8*)(QD + (16 * i + fr) * QP_ + 32 * ks + 8 * fq);
            cacc = __builtin_amdgcn_mfma_f32_16x16x32_bf16(a, bq, cacc, 0, 0, 0); }
        if (i == j) {
#pragma unroll
            for (int r = 0; r < 4; ++r) if (4 * fq + r > fr) cacc[r] = 0.f; }
        u32x2 o; o.x = pk2(cacc[0], cacc[1]); o.y = pk2(cacc[2], cacc[3]);
        *(LAS u32x2*)(PL + (16 * i + fr) * KTP + 16 * j + 4 * fq) = o;
    }
    __syncthreads();
    f32x4 acc[4];
#pragma unroll
    for (int tb = 0; tb < 4; ++tb) acc[tb] = (f32x4){0.f, 0.f, 0.f, 0.f};
    {
        const bf16_t* Sb = wsp<bf16_t>(F, WS_SS) + ((size_t)bh * 64 + c) * 16384 + (16 * w + fr) * 128 + 8 * fq;
        bf16x8 sa[4];
#pragma unroll
        for (int ks = 0; ks < 4; ++ks) sa[ks] = *(const GAS bf16x8*)(Sb + 32 * ks);
#pragma unroll
        for (int ks = 0; ks < 4; ++ks)
#pragma unroll
            for (int tb = 0; tb < 4; ++tb) { const bf16x8 bq = *(const LAS bf16x8*)(QPl + (16 * tb + fr) * QP_ + 32 * ks + 8 * fq); acc[tb] = __builtin_amdgcn_mfma_f32_16x16x32_bf16(sa[ks], bq, acc[tb], 0, 0, 0); }
#pragma unroll
        for (int ks = 0; ks < 2; ++ks) { const bf16x8 va = *(const LAS bf16x8*)(VT + (16 * w + fr) * KTP + 32 * ks + 8 * fq);
#pragma unroll
            for (int tb = 0; tb < 4; ++tb) { const bf16x8 bp = *(const LAS bf16x8*)(PL + (16 * tb + fr) * KTP + 32 * ks + 8 * fq); acc[tb] = __builtin_amdgcn_mfma_f32_16x16x32_bf16(va, bp, acc[tb], 0, 0, 0); } }
    }
#pragma unroll
    for (int tb = 0; tb < 4; ++tb) { float p = (acc[tb][0] * acc[tb][0] + acc[tb][1] * acc[tb][1]) + (acc[tb][2] * acc[tb][2] + acc[tb][3] * acc[tb][3]); p += __shfl_xor(p, 16); p += __shfl_xor(p, 32);
        if (fq == 0) SSQ[w * 64 + 16 * tb + fr] = p; }
    __syncthreads();
    {
        const f32x4 gw4 = *(const f32x4*)(F.gnw + 16 * w + 4 * fq);
        const bf16_t* GSb = wsp<bf16_t>(F, WS_GS); bf16_t* A2 = wsp<bf16_t>(F, WS_A2);
#pragma unroll
        for (int tb = 0; tb < 4; ++tb) { const int t = 16 * tb + fr; float ss = 0.f;
#pragma unroll
            for (int ww = 0; ww < 8; ++ww) ss += SSQ[ww * 64 + t];
            const float rs = rsqrtf(ss * (1.f / 128.f) + EPS);
            const u32x2 gv = *(const GAS u32x2*)(GSb + (row0 + t) * HF + h * 128 + 16 * w + 4 * fq);
            const f32x4 o = acc[tb] * rs * gw4 * (f32x4){bflo(gv.x), bfhi(gv.x), bflo(gv.y), bfhi(gv.y)};
            u32x2 ov; ov.x = pk2(o[0], o[1]); ov.y = pk2(o[2], o[3]);
            *(GAS u32x2*)(A2 + (row0 + t) * D + h * 128 + 16 * w + 4 * fq) = ov; }
    }
    __syncthreads();
}

__device__ __forceinline__ void split8(const f32x4 a, const f32x4 b, bf16x8& hi, bf16x8& lo) {
    const float v[8] = {a[0], a[1], a[2], a[3], b[0], b[1], b[2], b[3]};
#pragma unroll
    for (int j = 0; j < 8; ++j) { const unsigned h = f2bf(v[j]); hi[j] = (short)h; lo[j] = (short)f2bf(v[j] - bf2f((unsigned short)h)); }
}
__device__ __forceinline__ void p5_router(Frame& F) {
    const int gw = F.vcu * NWAVES + F.wave, fr = F.lane & 15, fq = F.lane >> 4;
    LAS float* lg = (LAS float*)(F.lds + F.wave * 4096);
    const float* H1 = wsp<float>(F, WS_H1); const bf16_t* WH = wsp<bf16_t>(F, WS_WRH); const bf16_t* WL = wsp<bf16_t>(F, WS_WRL);
    for (int it = gw; it < M / 16; it += F.G * NWAVES) {
        const int row0 = it * 16;
        const float* hp = H1 + (size_t)(row0 + fr) * D + 8 * fq;
        const bf16_t* wh0 = WH + (size_t)fr * D + 8 * fq; const bf16_t* wl0 = WL + (size_t)fr * D + 8 * fq;
        f32x4 a0 = (f32x4){0.f, 0.f, 0.f, 0.f}, a1 = a0; float ss = 0.f;
#pragma unroll 4
        for (int ks = 0; ks < 64; ++ks) {
            const f32x4 xa = *(const GAS f32x4*)(hp + 32 * ks), xb = *(const GAS f32x4*)(hp + 32 * ks + 4);
            ss += (xa[0] * xa[0] + xa[1] * xa[1]) + (xa[2] * xa[2] + xa[3] * xa[3]) + (xb[0] * xb[0] + xb[1] * xb[1]) + (xb[2] * xb[2] + xb[3] * xb[3]);
            bf16x8 xh, xl; split8(xa, xb, xh, xl);
            const bf16x8 bh0 = *(const GAS bf16x8*)(wh0 + 32 * ks), bl0 = *(const GAS bf16x8*)(wl0 + 32 * ks), bh1 = *(const GAS bf16x8*)(wh0 + 16 * D + 32 * ks), bl1 = *(const GAS bf16x8*)(wl0 + 16 * D + 32 * ks);
            a0 = __builtin_amdgcn_mfma_f32_16x16x32_bf16(xh, bh0, a0, 0, 0, 0); a0 = __builtin_amdgcn_mfma_f32_16x16x32_bf16(xh, bl0, a0, 0, 0, 0);
            a0 = __builtin_amdgcn_mfma_f32_16x16x32_bf16(xl, bh0, a0, 0, 0, 0); a0 = __builtin_amdgcn_mfma_f32_16x16x32_bf16(xl, bl0, a0, 0, 0, 0);
            a1 = __builtin_amdgcn_mfma_f32_16x16x32_bf16(xh, bh1, a1, 0, 0, 0); a1 = __builtin_amdgcn_mfma_f32_16x16x32_bf16(xh, bl1, a1, 0, 0, 0);
            a1 = __builtin_amdgcn_mfma_f32_16x16x32_bf16(xl, bh1, a1, 0, 0, 0); a1 = __builtin_amdgcn_mfma_f32_16x16x32_bf16(xl, bl1, a1, 0, 0, 0);
        }
        ss += __shfl_xor(ss, 16); ss += __shfl_xor(ss, 32);
#pragma unroll
        for (int r = 0; r < 4; ++r) { lg[(4 * fq + r) * 33 + fr] = a0[r]; lg[(4 * fq + r) * 33 + 16 + fr] = a1[r]; }
        LDS_WAIT(); asm volatile("" ::: "memory");
        if (F.lane < 16) {
            const int tokn = row0 + F.lane; const float rs = rsqrtf(ss * (1.f / D) + EPS);
            float v[32];
#pragma unroll
            for (int e = 0; e < 32; ++e) v[e] = lg[F.lane * 33 + e] * rs + F.b_r[e];
            int idx[4]; float val[4];
#pragma unroll
            for (int k = 0; k < 4; ++k) { float bv = -3.0e38f; int bi = 0;
#pragma unroll
                for (int e = 0; e < 32; ++e) { const bool tk = v[e] > bv; bv = tk ? v[e] : bv; bi = tk ? e : bi; }
                idx[k] = bi; val[k] = bv;
#pragma unroll
                for (int e = 0; e < 32; ++e) v[e] = (e == bi) ? -3.0e38f : v[e]; }
            float ex[4], den = 0.f;
#pragma unroll
            for (int k = 0; k < 4; ++k) { ex[k] = __expf(val[k] - val[0]); den += ex[k]; }
            const float inv = 1.f / den;
            wsp<float>(F, WS_RS2)[tokn] = rs;
#pragma unroll
            for (int k = 0; k < 4; ++k) { const int pos = (int)atomicAdd((unsigned*)(F.ctl + CW_CNT + 64 * idx[k]), 1u);
                wsp<int>(F, WS_TOPE)[tokn * 4 + k] = idx[k]; wsp<int>(F, WS_TOPP)[tokn * 4 + k] = pos; wsp<float>(F, WS_TOPW)[tokn * 4 + k] = ex[k] * inv;
                wsp<int>(F, WS_LIST)[(size_t)idx[k] * CAPF + pos] = tokn; }
        }
        LDS_WAIT(); asm volatile("" ::: "memory");
    }
}
__device__ __forceinline__ void build_pref(Frame& F) {
    if (F.tid == 0) { int a = 0;
        for (int e = 0; e < NE; ++e) { F.MISC[16 + e] = (unsigned)a; const unsigned c = __hip_atomic_load(F.ctl + CW_CNT + 64 * e, RLX_AGENT); a += (int)((c + 255u) >> 8); }
        F.MISC[16 + NE] = (unsigned)(a < MAXRT ? a : MAXRT); }
    __syncthreads();
}
__device__ __forceinline__ void build_tok(Frame& F, const MoeOrder& S) {
    LAS int* tokt = (LAS int*)(F.lds + TOK_OFF);
    Unit u;
    for (int i = 0; i < 18 && S.next(i, u); ++i) {
        const int rt = u.pm - (int)F.MISC[16 + u.e]; const int cnt = (int)__hip_atomic_load(F.ctl + CW_CNT + 64 * u.e, RLX_AGENT);
        if (F.tid < 256) { const int r = rt * 256 + F.tid; tokt[i * 256 + F.tid] = (r < cnt) ? wsp<int>(F, WS_LIST)[(size_t)u.e * CAPF + r] : 0; }
    }
    __syncthreads();
}
__device__ __forceinline__ void p9_combine(Frame& F) {
    const int gw = F.vcu * NWAVES + F.wave;
    const float* H1 = wsp<float>(F, WS_H1); const bf16_t* YR = wsp<bf16_t>(F, WS_YR);
    for (int m = gw; m < M; m += F.G * NWAVES) {
        f32x4 v[4][2];
#pragma unroll
        for (int j = 0; j < 4; ++j) { v[j][0] = *(const GAS f32x4*)(H1 + (size_t)m * D + 8 * F.lane + 512 * j); v[j][1] = *(const GAS f32x4*)(H1 + (size_t)m * D + 8 * F.lane + 512 * j + 4); }
#pragma unroll
        for (int k = 0; k < 4; ++k) {
            const int e = wsp<int>(F, WS_TOPE)[m * 4 + k], pos = wsp<int>(F, WS_TOPP)[m * 4 + k]; const float wk = wsp<float>(F, WS_TOPW)[m * 4 + k];
            const size_t row = (size_t)F.MISC[16 + e] * 256 + pos;
#pragma unroll
            for (int j = 0; j < 4; ++j) { f32x4 a, b; unpack8(*(const GAS u32x4*)(YR + row * D + 8 * F.lane + 512 * j), a, b); v[j][0] += a * wk; v[j][1] += b * wk; }
        }
        float s = 0.f;
#pragma unroll
        for (int j = 0; j < 4; ++j)
#pragma unroll
            for (int q = 0; q < 2; ++q) s += (v[j][q][0] * v[j][q][0] + v[j][q][1] * v[j][q][1]) + (v[j][q][2] * v[j][q][2] + v[j][q][3] * v[j][q][3]);
        const float rs = rsqrtf(wave_sum(s) * (1.f / D) + EPS);
#pragma unroll
        for (int j = 0; j < 4; ++j)
#pragma unroll
            for (int q = 0; q < 2; ++q) { const f32x4 w = *(const f32x4*)(F.fnw + 8 * F.lane + 512 * j + 4 * q); *(GAS f32x4*)(F.out + (size_t)m * D + 8 * F.lane + 512 * j + 4 * q) = v[j][q] * rs * w; }
    }
}
constexpr int NPH = 11;
struct Args { const float* in[18]; float* out; unsigned char* ws; int ph_lo, ph_hi; };

__global__ void __launch_bounds__(NTHR, 2) fwd_kernel(Args args) {
    extern __shared__ __attribute__((aligned(16))) unsigned char lds_raw[];
    Frame F;
    F.lds = (LAS unsigned char*)lds_raw; F.MISC = (volatile LAS unsigned*)(F.lds + MISC_OFF);
    F.wave = __builtin_amdgcn_readfirstlane((int)threadIdx.x >> 6);
#define REFRESH() do { F.lane = lane_id(); F.tid = F.wave * 64 + F.lane; } while (0)
    REFRESH();
    F.G = gridDim.x; { const int bx = blockIdx.x; F.vcu = (F.G % 8 == 0) ? (bx % 8) * (F.G / 8) + bx / 8 : bx; }
    F.ws = args.ws; F.ctl = (gu32*)(args.ws + WS_CTL); F.out = args.out;
    F.x = args.in[0]; F.meta = args.in[1]; F.nmw = args.in[2]; F.w_in = args.in[3]; F.lbl = args.in[4]; F.gnw = args.in[5]; F.w_ho = args.in[6]; F.cw = args.in[7]; F.w_co = args.in[8]; F.w_o = args.in[9];
    F.nfw = args.in[10]; F.w_r = args.in[11]; F.b_r = args.in[12]; F.w_up = args.in[13]; F.b_up = args.in[14]; F.w_dn = args.in[15]; F.b_dn = args.in[16]; F.fnw = args.in[17];
    for (int u = F.tid; u < 256; u += NTHR) F.MISC[u] = 0u;
    __syncthreads();
    const int lo = args.ph_lo, hi = args.ph_hi;
    const bool multi = (hi - lo) > 1;
    XcdBarrier bar; bar.bar = (unsigned*)(F.ctl + CW_BAR); bar.x = 0; bar.st = nullptr;
    if (multi) bar = xcd_barrier_post((unsigned*)(F.ctl + CW_BAR), F.MISC, F.tid);
#define IN(k) (lo <= (k) && (k) < hi)
#define SEAM(k) do { REFRESH(); if (IN(k) && IN((k) + 1)) xcd_barrier(bar, F.tid); } while (0)
    const int c = blockIdx.x;

    if (IN(0)) { p0_prologue(F); } SEAM(0);

    if (IN(1)) {
        GemmDesc g{wsp<bf16_t>(F, WS_XB), wsp<bf16_t>(F, WS_WIN), D, INC / 256}; StaticOrder S; S.init(M, INC, F.G, c);
        EpiInproj E{wsp<float>(F, WS_RS1), wsp<float>(F, WS_LB), wsp<bf16_t>(F, WS_QS), wsp<bf16_t>(F, WS_VV), wsp<bf16_t>(F, WS_GS), wsp<bf16_t>(F, WS_UU), wsp<bf16_t>(F, WS_SB), wsp<bf16_t>(F, WS_RT), wsp<bf16_t>(F, WS_GBS), wsp<float>(F, WS_LF)};
        gemm_phase<EpiInproj, StaticOrder, false, true>(F.lds, g, S, E, nullptr, F.wave);
    } SEAM(1);

    if (IN(2)) { for (int u = c; u < 2048 + 8; u += F.G) p2a_unit(F, u); for (int it = c; it < M / 64; it += F.G) p2a_conv(F, it); } SEAM(2);
    if (IN(3)) { p2b_scan(F); } SEAM(3);
    if (IN(4)) { for (int u = c; u < 2048; u += F.G) p2c_unit(F, u); } SEAM(4);

    if (IN(5)) {
        GemmDesc g{wsp<bf16_t>(F, WS_A2), wsp<bf16_t>(F, WS_WAB), D, D / 256}; StaticOrder S; S.init(M, D, F.G, c);
        EpiMerge E{wsp<bf16_t>(F, WS_RT), wsp<bf16_t>(F, WS_GBS), wsp<bf16_t>(F, WS_MG)};
        gemm_phase<EpiMerge, StaticOrder, false, true>(F.lds, g, S, E, nullptr, F.wave);
    } SEAM(5);

    if (IN(6)) {
        GemmDesc g{wsp<bf16_t>(F, WS_MG), wsp<bf16_t>(F, WS_WO), D, D / 256}; StaticOrder S; S.init(M, D, F.G, c);
        EpiWo E{F.x, wsp<float>(F, WS_H1), wsp<bf16_t>(F, WS_H1B)};
        gemm_phase<EpiWo, StaticOrder, false, true>(F.lds, g, S, E, nullptr, F.wave);
    } SEAM(6);

    if (IN(7)) { p5_router(F); } SEAM(7);

    if (IN(8)) {
        build_pref(F);
        MoeOrder S; S.init(16, F.G, c, (const volatile LAS int*)(F.MISC + 16));
        build_tok(F, S);
        GemmDesc g{wsp<bf16_t>(F, WS_H1B), wsp<bf16_t>(F, WS_WUP), D, 16};
        EpiUp E{wsp<float>(F, WS_RS2), (const LAS int*)(F.lds + TOK_OFF), F.b_up, wsp<bf16_t>(F, WS_ACT)};
        gemm_phase<EpiUp, MoeOrder, true, true>(F.lds, g, S, E, (const LAS int*)(F.lds + TOK_OFF), F.wave);
    } SEAM(8);

    if (IN(9)) {
        build_pref(F);
        MoeOrder S; S.init(8, F.G, c, (const volatile LAS int*)(F.MISC + 16));
        GemmDesc g{wsp<bf16_t>(F, WS_ACT), wsp<bf16_t>(F, WS_WDN), DFF, 8};
        EpiDown E{F.b_dn, wsp<bf16_t>(F, WS_YR)};
        gemm_phase<EpiDown, MoeOrder, false, true>(F.lds, g, S, E, nullptr, F.wave);
    } SEAM(9);

    if (IN(10)) { build_pref(F); p9_combine(F); }
#undef IN
#undef SEAM
#undef REFRESH
}

inline void launch_fast(hipStream_t stream, void* const* d_in, float* out, unsigned char* ws, int n_launches) {
    static int grid = 0;
    if (grid == 0) {
        int dev = 0, cus = 0, per_cu = 0;
        if (hipGetDevice(&dev) != hipSuccess || hipDeviceGetAttribute(&cus, hipDeviceAttributeMultiprocessorCount, dev) != hipSuccess) { fprintf(stderr, "kernel_launch: device query failed\n"); grid = -1; return; }
        if (hipFuncSetAttribute((const void*)fwd_kernel, hipFuncAttributeMaxDynamicSharedMemorySize, LDS_BYTES) != hipSuccess) { fprintf(stderr, "kernel_launch: hipFuncSetAttribute failed\n"); grid = -1; return; }
        if (hipOccupancyMaxActiveBlocksPerMultiprocessor(&per_cu, (const void*)fwd_kernel, NTHR, LDS_BYTES) != hipSuccess || per_cu < 1) fprintf(stderr, "kernel_launch: note: occupancy query says %d blocks per CU\n", per_cu);
        (void)hipGetLastError();
        grid = cus;
    }
    if (grid < 0) return;
    (void)hipMemsetAsync(ws + WS_CTL, 0, CTL_BYTES, stream);
    Args a{};
    for (int i = 0; i < 18; ++i) a.in[i] = (const float*)d_in[i];
    a.out = out; a.ws = ws;
    for (int li = 0; li < n_launches; ++li) {
        a.ph_lo = (n_launches == 1) ? 0 : li; a.ph_hi = (n_launches == 1) ? NPH : li + 1;
        hipLaunchKernelGGL(fwd_kernel, dim3(grid), dim3(NTHR), LDS_BYTES, stream, a);
        const hipError_t le = hipPeekAtLastError();
        if (le != hipSuccess) { fprintf(stderr, "kernel_launch: launch %d failed: %s\n", li, hipGetErrorName(le)); break; }
    }
}
}
#ifndef FK_LAUNCHES
#define FK_LAUNCHES 1
#endif
extern "C" void kernel_launch(void* const* d_in, const int* in_sizes, int n_in, void* d_out, int out_size, void* d_ws, size_t ws_size, hipStream_t stream) {
    if (n_in != 18 || ws_size < fk::WS_FAST_END) { fprintf(stderr, "kernel_launch: n_in %d, ws %zu < %zu\n", n_in, ws_size, (size_t)fk::WS_FAST_END); return; }
    fk::launch_fast(stream, d_in, (float*)d_out, (unsigned char*)d_ws, FK_LAUNCHES);
}
```

```cpp
#include <hip/hip_runtime.h>
#include <cstdio>
#define FK_LAUNCHES 1
namespace fk {
#define LAS __attribute__((address_space(3)))
#define GAS __attribute__((address_space(1)))
typedef unsigned short bf16_t;
typedef short bf16x8 __attribute__((ext_vector_type(8)));
typedef float f32x4 __attribute__((ext_vector_type(4)));
typedef float f32x2 __attribute__((ext_vector_type(2)));
typedef unsigned u32x4 __attribute__((ext_vector_type(4)));
typedef unsigned u32x2 __attribute__((ext_vector_type(2)));
typedef GAS unsigned gu32;
#define RLX_AGENT __ATOMIC_RELAXED, __HIP_MEMORY_SCOPE_AGENT
#define LDS_WAIT() asm volatile("s_waitcnt lgkmcnt(0)" ::: "memory")
#define VM_WAIT() asm volatile("s_waitcnt vmcnt(0)" ::: "memory")

constexpr int D = 2048, NB = 4, SEQ = 4096, M = NB * SEQ, NMETA = 16;
constexpr int HF = 1024, INC = 11264, NE = 32, DFF = 2048, NCH = SEQ / 64;
constexpr int C_Q = 0, C_F = 1024, C_V = 2048, C_G = 3072, C_SV = 4096, C_SB = 5120, C_SC = 6144, C_GA = 7168, C_GB = 9216;
constexpr float EPS = 1e-6f;
constexpr int CAPF = M;
constexpr int MAXRT = 288;
constexpr int NWAVES = 8, NTHR = 512;

constexpr size_t al(size_t x) { return (x + 0xFFFFF) & ~(size_t)0xFFFFF; }
constexpr size_t WS_CTL = 0, CTL_BYTES = 65536;
constexpr size_t WS_LB = 65536, WS_RS1 = WS_LB + 4096, WS_RS2 = WS_RS1 + 65536, WS_WRH = WS_RS2 + 65536, WS_WRL = WS_WRH + 131072;
constexpr size_t WS_LFM = WS_WRL + 131072, WS_VVM = WS_LFM + 64 * 1024 * 4, WS_UUM = WS_VVM + 64 * 1024 * 2, WS_SMALL_END = WS_UUM + 16 * 1024 * 2;
constexpr size_t WS_TOPE = al(WS_SMALL_END), WS_TOPP = WS_TOPE + (size_t)M * 16, WS_TOPW = WS_TOPP + (size_t)M * 16, WS_LIST = WS_TOPW + (size_t)M * 16;
constexpr size_t WS_DEC = al(WS_LIST + (size_t)NE * CAPF * 4);
constexpr size_t WS_WIN = al(WS_DEC + (size_t)33 * 64 * 128 * 4);
constexpr size_t WS_WAB = al(WS_WIN + (size_t)INC * D * 2);
constexpr size_t WS_WO = al(WS_WAB + (size_t)D * D * 2);
constexpr size_t WS_WUP = al(WS_WO + (size_t)D * D * 2);
constexpr size_t WS_WDN = al(WS_WUP + (size_t)NE * 4096 * D * 2);
constexpr size_t WS_XB = al(WS_WDN + (size_t)NE * D * DFF * 2);
constexpr size_t WS_QS = al(WS_XB + (size_t)M * D * 2);
constexpr size_t WS_LF = al(WS_QS + (size_t)M * HF * 2);
constexpr size_t WS_VV = al(WS_LF + (size_t)M * HF * 4);
constexpr size_t WS_GS = al(WS_VV + (size_t)M * HF * 2);
constexpr size_t WS_UU = al(WS_GS + (size_t)M * HF * 2);
constexpr size_t WS_SB = al(WS_UU + (size_t)M * HF * 2);
constexpr size_t WS_RT = al(WS_SB + (size_t)M * HF * 2);
constexpr size_t WS_GBS = al(WS_RT + (size_t)M * D * 2);
constexpr size_t WS_UC = al(WS_GBS + (size_t)M * D * 2);
constexpr size_t WS_SS = al(WS_UC + (size_t)(32 * 64 + 8) * 16384 * 2);
constexpr size_t WS_A2 = al(WS_SS + (size_t)32 * 64 * 16384 * 2);
constexpr size_t WS_MG = al(WS_A2 + (size_t)M * D * 2);
constexpr size_t WS_H1 = al(WS_MG + (size_t)M * D * 2);
constexpr size_t WS_H1B = al(WS_H1 + (size_t)M * D * 4);
constexpr size_t WS_ACT = al(WS_H1B + (size_t)M * D * 2);
constexpr size_t WS_YR = al(WS_ACT + (size_t)MAXRT * 256 * DFF * 2);
constexpr size_t WS_FAST_END = al(WS_YR + (size_t)MAXRT * 256 * D * 2);
constexpr int CW_TMO = 0;
constexpr int CW_CNT = 1024;
constexpr int CW_BAR = 4096;
constexpr int RING_BYTES = 131072;
constexpr int TOK_OFF = RING_BYTES, TOK_BYTES = 18 * 1024;
constexpr int MISC_OFF = TOK_OFF + TOK_BYTES;
constexpr int LDS_BYTES = MISC_OFF + 1024;
static_assert(LDS_BYTES <= 160 * 1024, "LDS");

__device__ __forceinline__ float sigmoidf_(float x) { return 1.f / (1.f + __expf(-x)); }
__device__ __forceinline__ unsigned f2bf(float f) { unsigned u = __builtin_bit_cast(unsigned, f); return (u + 0x7fffu + ((u >> 16) & 1u)) >> 16; }
__device__ __forceinline__ unsigned pk2(float lo, float hi) { return f2bf(lo) | (f2bf(hi) << 16); }
__device__ __forceinline__ float bf2f(unsigned short b) { return __builtin_bit_cast(float, ((unsigned)b) << 16); }
__device__ __forceinline__ float bflo(unsigned w) { return __builtin_bit_cast(float, w << 16); }
__device__ __forceinline__ float bfhi(unsigned w) { return __builtin_bit_cast(float, w & 0xffff0000u); }
__device__ __forceinline__ unsigned cvt_pk_bf16(float lo, float hi) { unsigned r; asm volatile("v_cvt_pk_bf16_f32 %0, %1, %2" : "=v"(r) : "v"(lo), "v"(hi)); return r; }
__device__ __forceinline__ int lane_id() { int l; asm volatile("v_mbcnt_lo_u32_b32 %0, -1, 0\n\tv_mbcnt_hi_u32_b32 %0, -1, %0" : "=v"(l)); return l; }
__device__ __forceinline__ float wave_sum(float v) {
#pragma unroll
    for (int o = 1; o < 64; o <<= 1) v += __shfl_xor(v, o);
    return v;
}

#define XB_TMO      128
#define XB_XCNT(j)  (256  + 64 * (j))
#define XB_XSUB(j)  (1280 + 64 * (j))
#define XB_XGEN(j)  (2304 + 64 * (j))
#define XB_TOP      3328
#define XB_TOPGEN   3392
#define XCD_BAR_WORDS 3456
#define XB_SPIN_CAP (1u << 18)
__device__ __forceinline__ unsigned xb_ld(unsigned* p)              { return __hip_atomic_load(p, __ATOMIC_RELAXED, __HIP_MEMORY_SCOPE_AGENT); }
__device__ __forceinline__ unsigned xb_add(unsigned* p, unsigned v) { return __hip_atomic_fetch_add(p, v, __ATOMIC_RELAXED, __HIP_MEMORY_SCOPE_AGENT); }
__device__ __forceinline__ unsigned xb_xcc_id() { return (unsigned)__builtin_amdgcn_s_getreg((3 << 11) | 20) & 0xFu; }
#define XB_SPIN(cond, bar) do { unsigned _sp = 0; while (cond) { __builtin_amdgcn_s_sleep(1); \
    if ((++_sp & 255u) == 0u) { if (xb_ld(&(bar)[XB_TMO])) break; if (_sp > XB_SPIN_CAP) { atomicAdd(&(bar)[XB_TMO], 1u); break; } } } } while (0)
struct XcdBarrier { unsigned* bar; unsigned x; volatile LAS unsigned* st; };
__device__ __forceinline__ XcdBarrier xcd_barrier_post(unsigned* bar, volatile LAS unsigned* st, int tid) {
    XcdBarrier b; b.bar = bar; b.x = xb_xcc_id(); b.st = st;
    if (tid == 0) (void)xb_add(&bar[XB_XCNT(b.x)], 1u);
    return b;
}
__device__ __forceinline__ void xcd_barrier_complete(unsigned* bar, unsigned x, unsigned& nloc, unsigned& nx) {
    const unsigned G = gridDim.x * gridDim.y * gridDim.z;
    unsigned sum, cnt, mine, sp = 0u;
    for (;;) {
        sum = 0u; cnt = 0u; mine = 0u;
#pragma unroll
        for (unsigned j = 0; j < 16; ++j) { const unsigned c = xb_ld(&bar[XB_XCNT(j)]); sum += c; cnt += (c > 0u) ? 1u : 0u; mine = (j == x) ? c : mine; }
        if (sum == G) break;
        __builtin_amdgcn_s_sleep(1);
        if ((++sp & 255u) == 0u) { if (xb_ld(&bar[XB_TMO])) break; if (sp > XB_SPIN_CAP) { atomicAdd(&bar[XB_TMO], 1u); break; } }
    }
    nloc = mine > 0u ? mine : 1u; nx = cnt > 0u ? cnt : 1u;
}
__device__ __forceinline__ void xcd_barrier(const XcdBarrier& b, int tid) {
    asm volatile("s_waitcnt vmcnt(0)" ::: "memory");
    __syncthreads();
    if (tid == 0) {
        unsigned* bar = b.bar;
        __builtin_amdgcn_s_waitcnt(0);
        unsigned nloc = b.st[0], nx = b.st[1];
        if (nloc == 0u) { xcd_barrier_complete(bar, b.x, nloc, nx); b.st[0] = nloc; b.st[1] = nx; }
        const unsigned old = xb_add(&bar[XB_XSUB(b.x)], 1u);
        const unsigned gen = old / nloc;
        if (old + 1u == (gen + 1u) * nloc) {
            __builtin_amdgcn_fence(__ATOMIC_RELEASE, "agent");
            asm volatile("s_waitcnt vmcnt(0)" ::: "memory");
            const unsigned og = xb_add(&bar[XB_TOP], 1u);
            const unsigned tg = og / nx;
            if (og + 1u == (tg + 1u) * nx) xb_add(&bar[XB_TOPGEN], 1u);
            else XB_SPIN(xb_ld(&bar[XB_TOPGEN]) == tg, bar);
            __builtin_amdgcn_fence(__ATOMIC_ACQUIRE, "agent");
            xb_add(&bar[XB_XGEN(b.x)], 1u);
            asm volatile("s_waitcnt vmcnt(0)" ::: "memory");
        } else {
            XB_SPIN(xb_ld(&bar[XB_XGEN(b.x)]) == gen, bar);
            __builtin_amdgcn_fence(__ATOMIC_ACQUIRE, "agent");
            asm volatile("s_waitcnt vmcnt(0)" ::: "memory");
        }
    }
    __syncthreads();
}

constexpr int BM = 256, BK = 64, HALF = 128, HTB = HALF * BK * 2, NXCD = 8, WGM = 8;
__host__ __device__ __forceinline__ int lds_byte(int r, int c) { const int st = (r >> 4) * 2 + (c >> 5), rr = r & 15, cc = c & 31, ob = rr * 64 + cc * 2; return st * 1024 + (ob ^ (((ob >> 9) & 1) << 5)); }
__host__ __device__ __forceinline__ void stage_rc(int b, int& R, int& C) { const int st = b / 1024, sb = b % 1024, swz = sb ^ (((sb >> 9) & 1) << 5); R = (st >> 1) * 16 + swz / 64; C = (st & 1) * 32 + (swz % 64) / 2; }
__host__ __device__ __forceinline__ int perm32(int rho) { const int n = rho >> 4, i = rho & 15; return 8 * (i >> 2) + 4 * n + (i & 3); }

struct Unit { int pm, pn, e, ui; };

struct StaticOrder {
    int nM, nN, nwg, G, c;
    __device__ void init(int M_, int N_, int G_, int c_) { nM = M_ / BM; nN = N_ / BM; nwg = nM * nN; G = G_; c = c_; }
    __device__ __forceinline__ bool next(int i, Unit& u) const {
        const long L = (long)i * G + c; if (L >= nwg) return false;
        int wgid = (int)L; { const int q = nwg / NXCD, r = nwg % NXCD, xcd = wgid % NXCD, off = wgid / NXCD; wgid = (xcd < r ? xcd * (q + 1) : r * (q + 1) + (xcd - r) * q) + off; }
        const int nig = WGM * nN, gid = wgid / nig, fm = gid * WGM, gsz = (nM - fm) < WGM ? (nM - fm) : WGM;
        u.pm = fm + ((wgid % nig) % gsz); u.pn = (wgid % nig) / gsz; u.e = 0; u.ui = i; return true;
    }
};
struct MoeOrder {
    int nct, total, G, c; const volatile LAS int* pref;
    __device__ void init(int nct_, int G_, int c_, const volatile LAS int* pref_) { nct = nct_; G = G_; c = c_; pref = pref_; total = pref_[NE] * nct_; }
    __device__ __forceinline__ bool next(int i, Unit& u) const {
        const int U = i * G + c; if (U >= total) return false;
        const int rtg = U / nct; u.pn = U - rtg * nct; u.pm = rtg; u.ui = i;
        int e = 0;
#pragma unroll 1
        for (int j = 1; j < NE; ++j) e = (pref[j] <= rtg) ? j : e;
        u.e = e; return true;
    }
};

struct GemmDesc { const bf16_t* A; const bf16_t* Bt; int K; int nct; };

template <class Epi, class Sched, bool GATHER, bool ALIGN_EPI>
__device__ __forceinline__ void gemm_phase(LAS unsigned char* lds, const GemmDesc g, const Sched& S, const Epi& E, const LAS int* tok, int wid) {
    const int lane = lane_id(), tid = wid * 64 + lane, wr = wid >> 2, wc = wid & 3, fr = lane & 15, fq = lane >> 4;
    const int K = g.K, nt = K / BK;
    int Rl[2], Cl[2];
    unsigned voffA[2], voffB[2];
#pragma unroll
    for (int i = 0; i < 2; ++i) { stage_rc(tid * 16 + i * 8192, Rl[i], Cl[i]); voffA[i] = (unsigned)(Rl[i] * K + Cl[i]) * 2u; voffB[i] = voffA[i]; }
    const size_t kstep = (size_t)(BK * 2);
    const size_t hstep = (size_t)HALF * K * 2;
    const size_t tstep = 2 * hstep;
    const unsigned ldsw = (unsigned)wid * 1024u;
    const int aoff = lds_byte(wr * 64 + fr, fq * 8), boff = lds_byte(wc * 32 + fr, fq * 8);
#define PG8_SA(b, h) (((b) * 2 + (h)) * HTB)
#define PG8_SB(b, h) ((4 + (b) * 2 + (h)) * HTB)
#define PG8_STAGE(bufoff, gbase, voff) do { _Pragma("unroll") for (int _i = 0; _i < 2; ++_i) \
        __builtin_amdgcn_global_load_lds((const unsigned*)((const char*)(gbase) + (voff)[_i]), (LAS unsigned*)(lds + (bufoff) + ldsw + _i * 8192), 16, 0, 0); } while (0)
#define PG8_STAGE_A(bufoff, ptr, half, o0, o1) do { if constexpr (GATHER) { PG8_STAGE(bufoff, ptr, (half) ? o1 : o0); } else { PG8_STAGE(bufoff, (ptr) + (half) * hstep, voffA); } } while (0)
#define PG8_LDA(dst, b, h) do { _Pragma("unroll") for (int m = 0; m < 4; ++m) _Pragma("unroll") for (int k = 0; k < 2; ++k) dst[m][k] = *(const LAS bf16x8*)(lds + PG8_SA(b, h) + aoff + m * 2048 + k * 1024); } while (0)
#define PG8_LDB(dst, b, h) do { _Pragma("unroll") for (int n = 0; n < 2; ++n) _Pragma("unroll") for (int k = 0; k < 2; ++k) dst[n][k] = *(const LAS bf16x8*)(lds + PG8_SB(b, h) + boff + n * 2048 + k * 1024); } while (0)
#define PG8_MMA(ai, bj, At, Bt) do { __builtin_amdgcn_s_setprio(1); _Pragma("unroll") for (int m = 0; m < 4; ++m) _Pragma("unroll") for (int n = 0; n < 2; ++n) _Pragma("unroll") for (int k = 0; k < 2; ++k) \
        acc[ai][bj][m][n] = __builtin_amdgcn_mfma_f32_16x16x32_bf16(Bt[n][k], At[m][k], acc[ai][bj][m][n], 0, 0, 0); __builtin_amdgcn_s_setprio(0); } while (0)
#define PG8_WAIT_V(n) asm volatile("s_waitcnt vmcnt(" #n ")" ::: "memory")
#define PG8_WAIT_L(n) asm volatile("s_waitcnt lgkmcnt(" #n ")" ::: "memory")
#define PG8_BAR __builtin_amdgcn_s_barrier()
#define PG8_SCHED __builtin_amdgcn_sched_barrier(0)
    Unit cur, nxt; int ui = 0;
    if (!S.next(0, cur)) return;
    f32x4 acc[2][2][4][2];
#pragma unroll
    for (int a = 0; a < 2; ++a)
#pragma unroll
        for (int b = 0; b < 2; ++b)
#pragma unroll
            for (int m = 0; m < 4; ++m)
#pragma unroll
                for (int n = 0; n < 2; ++n) acc[a][b][m][n] = (f32x4){0.f, 0.f, 0.f, 0.f};
    bf16x8 At[4][2], B0[2][2], B1[2][2];
    unsigned vA0[2] = {0u, 0u}, vA1[2] = {0u, 0u}, nA0[2] = {0u, 0u}, nA1[2] = {0u, 0u};
    const char* cA; const char* cB = (const char*)g.Bt + (size_t)(cur.e * g.nct + cur.pn) * tstep;
    if constexpr (GATHER) {
        cA = (const char*)g.A;
#pragma unroll
        for (int i = 0; i < 2; ++i) { vA0[i] = (unsigned)(tok[cur.ui * 256 + Rl[i]] * K + Cl[i]) * 2u; vA1[i] = (unsigned)(tok[cur.ui * 256 + 128 + Rl[i]] * K + Cl[i]) * 2u; nA0[i] = vA0[i]; nA1[i] = vA1[i]; }
    } else cA = (const char*)g.A + (size_t)cur.pm * tstep;
    PG8_STAGE(PG8_SB(0, 0), cB, voffB); PG8_STAGE(PG8_SB(0, 1), cB + hstep, voffB); PG8_STAGE_A(PG8_SA(0, 0), cA, 0, vA0, vA1); PG8_STAGE_A(PG8_SA(0, 1), cA, 1, vA0, vA1);
    if (wr == 1) PG8_BAR;
    PG8_WAIT_V(2); PG8_BAR;
    PG8_STAGE(PG8_SB(1, 0), cB + kstep, voffB); PG8_STAGE_A(PG8_SA(1, 0), cA + kstep, 0, vA0, vA1); PG8_STAGE(PG8_SB(1, 1), cB + hstep + kstep, voffB);
    PG8_WAIT_V(6); PG8_BAR;
    for (;;) {
        const bool has_next = S.next(ui + 1, nxt);
        const char* nAp; const char* nB;
        if (has_next) {
            nB = (const char*)g.Bt + (size_t)(nxt.e * g.nct + nxt.pn) * tstep;
            if constexpr (GATHER) { nAp = cA;
#pragma unroll
                for (int i = 0; i < 2; ++i) { nA0[i] = (unsigned)(tok[nxt.ui * 256 + Rl[i]] * K + Cl[i]) * 2u; nA1[i] = (unsigned)(tok[nxt.ui * 256 + 128 + Rl[i]] * K + Cl[i]) * 2u; }
            } else nAp = (const char*)g.A + (size_t)nxt.pm * tstep;
        } else { nAp = cA; nB = cB; }
        for (int t = 0; t < nt; t += 2) {
            const bool last = (t == nt - 2);
            const char* a1 = cA + (size_t)(t + 1) * kstep;
            const char* a2 = last ? nAp : cA + (size_t)(t + 2) * kstep; const char* b2 = last ? nB : cB + (size_t)(t + 2) * kstep;
            const char* a3 = a2 + kstep; const char* b3 = b2 + kstep;
            unsigned w0[2] = {0u, 0u}, w1[2] = {0u, 0u};
            if constexpr (GATHER) {
#pragma unroll
                for (int i = 0; i < 2; ++i) { w0[i] = last ? nA0[i] : vA0[i]; w1[i] = last ? nA1[i] : vA1[i]; } }
            if constexpr (Epi::MIDHOOK) { if (t == nt / 2) E.mid(acc, cur, wr, wc, fr, fq); }
            PG8_LDB(B0, 0, 0); PG8_LDB(B1, 0, 1); PG8_SCHED; PG8_LDA(At, 0, 0); PG8_STAGE_A(PG8_SA(1, 1), a1, 1, vA0, vA1);
            PG8_WAIT_V(8); PG8_WAIT_L(0); PG8_BAR; PG8_MMA(0, 0, At, B0); PG8_MMA(0, 1, At, B1); PG8_BAR; PG8_SCHED;
            PG8_LDA(At, 0, 1); PG8_STAGE(PG8_SB(0, 0), b2, voffB); PG8_STAGE(PG8_SB(0, 1), b2 + hstep, voffB); PG8_STAGE_A(PG8_SA(0, 0), a2, 0, w0, w1);
            PG8_WAIT_V(8); PG8_WAIT_L(0); PG8_BAR; PG8_MMA(1, 0, At, B0); PG8_MMA(1, 1, At, B1); PG8_BAR; PG8_SCHED;
            PG8_LDB(B0, 1, 0); PG8_LDB(B1, 1, 1); PG8_SCHED; PG8_LDA(At, 1, 0); PG8_STAGE_A(PG8_SA(0, 1), a2, 1, w0, w1);
            PG8_WAIT_V(8); PG8_WAIT_L(0); PG8_BAR; PG8_MMA(0, 0, At, B0); PG8_MMA(0, 1, At, B1); PG8_BAR; PG8_SCHED;
            PG8_LDA(At, 1, 1); PG8_STAGE(PG8_SB(1, 0), b3, voffB); PG8_STAGE(PG8_SB(1, 1), b3 + hstep, voffB); PG8_STAGE_A(PG8_SA(1, 0), a3, 0, w0, w1);
            PG8_WAIT_V(8); PG8_WAIT_L(0); PG8_BAR; PG8_MMA(1, 0, At, B0); PG8_MMA(1, 1, At, B1); PG8_BAR; PG8_SCHED;
        }
        if constexpr (ALIGN_EPI) { if (wr == 0) PG8_BAR; }
        E(acc, cur, wr, wc, fr, fq);
        if (!has_next) break;
#pragma unroll
        for (int a = 0; a < 2; ++a)
#pragma unroll
            for (int b = 0; b < 2; ++b)
#pragma unroll
                for (int m = 0; m < 4; ++m)
#pragma unroll
                    for (int n = 0; n < 2; ++n) acc[a][b][m][n] = (f32x4){0.f, 0.f, 0.f, 0.f};
        cur = nxt; cA = nAp; cB = nB; ++ui;
        if constexpr (GATHER) {
#pragma unroll
            for (int i = 0; i < 2; ++i) { vA0[i] = nA0[i]; vA1[i] = nA1[i]; } }
        if constexpr (ALIGN_EPI) { if (wr == 1) PG8_BAR; }
    }
    PG8_WAIT_V(0);
    if constexpr (!ALIGN_EPI) { if (wr == 0) PG8_BAR; }
    PG8_BAR;
#undef PG8_SA
#undef PG8_SB
#undef PG8_STAGE
#undef PG8_STAGE_A
#undef PG8_LDA
#undef PG8_LDB
#undef PG8_MMA
#undef PG8_WAIT_V
#undef PG8_WAIT_L
#undef PG8_BAR
#undef PG8_SCHED
}
typedef f32x4 Acc[2][2][4][2];
__device__ __forceinline__ float silu_(float x) { return x * __builtin_amdgcn_rcpf(1.f + __expf(-x)); }
__device__ __forceinline__ float sigm_(float x) { return __builtin_amdgcn_rcpf(1.f + __expf(-x)); }
__device__ __forceinline__ u32x4 pack8(const f32x4 a, const f32x4 b) { u32x4 w; w.x = cvt_pk_bf16(a[0], a[1]); w.y = cvt_pk_bf16(a[2], a[3]); w.z = cvt_pk_bf16(b[0], b[1]); w.w = cvt_pk_bf16(b[2], b[3]); return w; }
__device__ __forceinline__ void unpack8(const u32x4 w, f32x4& a, f32x4& b) { a = (f32x4){bflo(w.x), bfhi(w.x), bflo(w.y), bfhi(w.y)}; b = (f32x4){bflo(w.z), bfhi(w.z), bflo(w.w), bfhi(w.w)}; }

struct EpiInproj {
    static constexpr bool MIDHOOK = false;
    const float* rs1; const float* lb; bf16_t *QS, *VV, *GS, *UU, *SBb, *RT, *GBS; float* LF;
    __device__ __forceinline__ void mid(Acc&, const Unit&, int, int, int, int) const {}
    template <int ACT> __device__ __forceinline__ void plain(const Acc& acc, const float (&rs)[2][4], bf16_t* O, int pt, int row0, int wc, int fq) const {
#pragma unroll
        for (int ai = 0; ai < 2; ++ai)
#pragma unroll
            for (int m = 0; m < 4; ++m) { bf16_t* rowp = O + (size_t)(row0 + ai * HALF + m * 16) * HF + pt * 256 + wc * 32 + 8 * fq; const float r = rs[ai][m];
#pragma unroll
                for (int bj = 0; bj < 2; ++bj) { f32x4 v0 = acc[ai][bj][m][0] * r, v1 = acc[ai][bj][m][1] * r;
                    if (ACT == 1) {
#pragma unroll
                        for (int j = 0; j < 4; ++j) { v0[j] = silu_(v0[j]); v1[j] = silu_(v1[j]); } }
                    *(u32x4*)(rowp + bj * HALF) = pack8(v0, v1); } }
    }
    __device__ __forceinline__ void operator()(const Acc& acc, const Unit& u, int wr, int wc, int fr, int fq) const {
        const int row0 = u.pm * BM + wr * 64 + fr, pn = u.pn;
        float rs[2][4];
#pragma unroll
        for (int ai = 0; ai < 2; ++ai)
#pragma unroll
            for (int m = 0; m < 4; ++m) rs[ai][m] = rs1[row0 + ai * HALF + m * 16];
        asm volatile("" : "+v"(rs[0][0]), "+v"(rs[0][1]), "+v"(rs[0][2]), "+v"(rs[0][3]), "+v"(rs[1][0]), "+v"(rs[1][1]), "+v"(rs[1][2]), "+v"(rs[1][3]));
        if (pn < 4) plain<1>(acc, rs, QS, pn, row0, wc, fq);
        else if (pn < 8) {
            const int c0 = (pn - 4) * 256 + wc * 32 + 4 * fq;
            f32x4 lbv[2][2];
#pragma unroll
            for (int bj = 0; bj < 2; ++bj)
#pragma unroll
                for (int n = 0; n < 2; ++n) lbv[bj][n] = *(const f32x4*)(lb + c0 + bj * HALF + n * 16);
#pragma unroll
            for (int ai = 0; ai < 2; ++ai)
#pragma unroll
                for (int m = 0; m < 4; ++m) { float* rowp = LF + (size_t)(row0 + ai * HALF + m * 16) * HF + c0; const float r = rs[ai][m];
#pragma unroll
                    for (int bj = 0; bj < 2; ++bj)
#pragma unroll
                        for (int n = 0; n < 2; ++n) { f32x4 v = acc[ai][bj][m][n] * r; const f32x4 l = lbv[bj][n];
#pragma unroll
                            for (int j = 0; j < 4; ++j) v[j] = __logf(l[j] + (1.f - l[j]) * sigm_(v[j]));
                            *(f32x4*)(rowp + bj * HALF + n * 16) = v; } }
        }
        else if (pn < 12) plain<0>(acc, rs, VV, pn - 8, row0, wc, fq);
        else if (pn < 16) plain<1>(acc, rs, GS, pn - 12, row0, wc, fq);
        else if (pn < 24) {
            const int c0 = (pn - 16) * 128 + wc * 32 + 8 * fq;
#pragma unroll
            for (int ai = 0; ai < 2; ++ai)
#pragma unroll
                for (int m = 0; m < 4; ++m) { const float r2 = rs[ai][m] * rs[ai][m];
                    const f32x4 v0 = acc[ai][0][m][0] * acc[ai][1][m][0] * r2, v1 = acc[ai][0][m][1] * acc[ai][1][m][1] * r2;
                    *(u32x4*)(UU + (size_t)(row0 + ai * HALF + m * 16) * HF + c0) = pack8(v0, v1); }
        }
        else if (pn < 28) plain<0>(acc, rs, SBb, pn - 24, row0, wc, fq);
        else {
            const int c0 = (pn - 28) * 128 + wc * 32 + 8 * fq;
#pragma unroll
            for (int ai = 0; ai < 2; ++ai)
#pragma unroll
                for (int m = 0; m < 4; ++m) { const float r = rs[ai][m]; f32x4 q0, q1, b0, b1;
#pragma unroll
                    for (int j = 0; j < 4; ++j) { const float ea = 1.f + __expf(-acc[ai][0][m][0][j] * r), eb = 1.f + __expf(-acc[ai][1][m][0][j] * r); b0[j] = __builtin_amdgcn_rcpf(eb); q0[j] = eb * __builtin_amdgcn_rcpf(ea);
                                                  const float fa = 1.f + __expf(-acc[ai][0][m][1][j] * r), fb = 1.f + __expf(-acc[ai][1][m][1][j] * r); b1[j] = __builtin_amdgcn_rcpf(fb); q1[j] = fb * __builtin_amdgcn_rcpf(fa); }
                    const size_t o = (size_t)(row0 + ai * HALF + m * 16) * D + c0;
                    *(u32x4*)(RT + o) = pack8(q0, q1); *(u32x4*)(GBS + o) = pack8(b0, b1); }
        }
    }
};

struct EpiMerge {
    static constexpr bool MIDHOOK = true;
    const bf16_t *RT, *GBS; bf16_t* MG;
    __device__ __forceinline__ void mid(Acc& acc, const Unit& u, int wr, int wc, int fr, int fq) const {
        const int row0 = u.pm * BM + wr * 64 + fr, c0 = u.pn * BM + wc * 32 + 8 * fq;
#pragma unroll
        for (int ai = 0; ai < 2; ++ai)
#pragma unroll
            for (int m = 0; m < 4; ++m)
#pragma unroll
                for (int bj = 0; bj < 2; ++bj) { const u32x4 w = *(const u32x4*)(RT + (size_t)(row0 + ai * HALF + m * 16) * D + c0 + bj * HALF); f32x4 a, b; unpack8(w, a, b);
                    acc[ai][bj][m][0] *= a; acc[ai][bj][m][1] *= b; if (bj == 1 && (m & 1)) asm volatile("" ::: "memory"); }
    }
    __device__ __forceinline__ void operator()(const Acc& acc, const Unit& u, int wr, int wc, int fr, int fq) const {
        const int row0 = u.pm * BM + wr * 64 + fr, c0 = u.pn * BM + wc * 32 + 8 * fq;
#pragma unroll
        for (int ai = 0; ai < 2; ++ai)
#pragma unroll
            for (int m = 0; m < 4; ++m)
#pragma unroll
                for (int bj = 0; bj < 2; ++bj) { const size_t o = (size_t)(row0 + ai * HALF + m * 16) * D + c0 + bj * HALF; const u32x4 w = *(const u32x4*)(GBS + o); f32x4 a, b; unpack8(w, a, b);
                    *(u32x4*)(MG + o) = pack8(acc[ai][bj][m][0] * a, acc[ai][bj][m][1] * b); }
    }
};

struct EpiWo {
    static constexpr bool MIDHOOK = false;
    const float* X; float* H1; bf16_t* H1B;
    __device__ __forceinline__ void mid(Acc&, const Unit&, int, int, int, int) const {}
    __device__ __forceinline__ void operator()(const Acc& acc, const Unit& u, int wr, int wc, int fr, int fq) const {
        const int row0 = u.pm * BM + wr * 64 + fr, c0 = u.pn * BM + wc * 32 + 8 * fq;
#pragma unroll
        for (int ai = 0; ai < 2; ++ai)
#pragma unroll
            for (int m = 0; m < 4; ++m)
#pragma unroll
                for (int bj = 0; bj < 2; ++bj) { const size_t o = (size_t)(row0 + ai * HALF + m * 16) * D + c0 + bj * HALF;
                    const f32x4 h0 = *(const f32x4*)(X + o) + acc[ai][bj][m][0], h1 = *(const f32x4*)(X + o + 4) + acc[ai][bj][m][1];
                    *(f32x4*)(H1 + o) = h0; *(f32x4*)(H1 + o + 4) = h1; *(u32x4*)(H1B + o) = pack8(h0, h1); }
    }
};

struct EpiUp {
    static constexpr bool MIDHOOK = false;
    const float* rs2; const LAS int* tok; const float* b_up; bf16_t* ACT;
    __device__ __forceinline__ void mid(Acc&, const Unit&, int, int, int, int) const {}
    __device__ __forceinline__ void operator()(const Acc& acc, const Unit& u, int wr, int wc, int fr, int fq) const {
        const int rl0 = wr * 64 + fr, c0 = u.pn * 128 + wc * 32 + 8 * fq;
        float rs[2][4];
#pragma unroll
        for (int ai = 0; ai < 2; ++ai)
#pragma unroll
            for (int m = 0; m < 4; ++m) rs[ai][m] = rs2[tok[u.ui * 256 + rl0 + ai * HALF + m * 16]];
        const float* bp = b_up + (size_t)u.e * 4096 + c0;
        const f32x4 bg0 = *(const f32x4*)(bp), bg1 = *(const f32x4*)(bp + 4), bu0 = *(const f32x4*)(bp + 2048), bu1 = *(const f32x4*)(bp + 2052);
#pragma unroll
        for (int ai = 0; ai < 2; ++ai)
#pragma unroll
            for (int m = 0; m < 4; ++m) { const float r = rs[ai][m]; f32x4 a0, a1;
#pragma unroll
                for (int j = 0; j < 4; ++j) {
                    float g = fminf(acc[ai][0][m][0][j] * r + bg0[j], 7.f), uu = fminf(fmaxf(acc[ai][1][m][0][j] * r + bu0[j], -7.f), 7.f); a0[j] = (uu + 1.f) * g * sigm_(1.702f * g);
                    g = fminf(acc[ai][0][m][1][j] * r + bg1[j], 7.f); uu = fminf(fmaxf(acc[ai][1][m][1][j] * r + bu1[j], -7.f), 7.f); a1[j] = (uu + 1.f) * g * sigm_(1.702f * g); }
                *(u32x4*)(ACT + (size_t)(u.pm * BM + rl0 + ai * HALF + m * 16) * DFF + c0) = pack8(a0, a1); }
    }
};

struct EpiDown {
    static constexpr bool MIDHOOK = false;
    const float* b_dn; bf16_t* YR;
    __device__ __forceinline__ void mid(Acc&, const Unit&, int, int, int, int) const {}
    __device__ __forceinline__ void operator()(const Acc& acc, const Unit& u, int wr, int wc, int fr, int fq) const {
        const int rl0 = wr * 64 + fr, c0 = u.pn * BM + wc * 32 + 8 * fq;
        const float* bp = b_dn + (size_t)u.e * D + c0;
        f32x4 bv[2][2];
#pragma unroll
        for (int bj = 0; bj < 2; ++bj)
#pragma unroll
            for (int n = 0; n < 2; ++n) bv[bj][n] = *(const f32x4*)(bp + bj * HALF + 4 * n);
#pragma unroll
        for (int ai = 0; ai < 2; ++ai)
#pragma unroll
            for (int m = 0; m < 4; ++m)
#pragma unroll
                for (int bj = 0; bj < 2; ++bj)
                    *(u32x4*)(YR + (size_t)(u.pm * BM + rl0 + ai * HALF + m * 16) * D + c0 + bj * HALF) = pack8(acc[ai][bj][m][0] + bv[bj][0], acc[ai][bj][m][1] + bv[bj][1]);
    }
};
struct Frame {
    LAS unsigned char* lds; volatile LAS unsigned* MISC; gu32* ctl; unsigned char* ws;
    int tid, lane, wave, vcu, G;
    const float *x, *meta, *nmw, *w_in, *lbl, *gnw, *w_ho, *cw, *w_co, *w_o, *nfw, *w_r, *b_r, *w_up, *b_up, *w_dn, *b_dn, *fnw; float* out;
};
template <class T> __device__ __forceinline__ T* wsp(const Frame& F, size_t off) { return (T*)(F.ws + off); }

__device__ __forceinline__ void tr_item(const float* W, int ldw, int k0, int ncol0, const float* kscale, bool perm, bf16_t* dst, int dpitch, int drow0, int dk0, LAS float* scr, int lane) {
#pragma unroll 8
    for (int i = 0; i < 32; ++i) { const int kk = 2 * i + (lane >> 5); float v = W[(size_t)(k0 + kk) * ldw + ncol0 + (lane & 31)]; if (kscale) v *= kscale[k0 + kk]; scr[kk * 33 + (lane & 31)] = v; }
    LDS_WAIT(); asm volatile("" ::: "memory");
    const int c = lane & 7;
#pragma unroll
    for (int j = 0; j < 4; ++j) { const int n = (lane >> 3) + 8 * j; const int sn = perm ? perm32(n) : n; const LAS float* s = scr + (8 * c) * 33 + sn;
        u32x4 o; o.x = pk2(s[0 * 33], s[1 * 33]); o.y = pk2(s[2 * 33], s[3 * 33]); o.z = pk2(s[4 * 33], s[5 * 33]); o.w = pk2(s[6 * 33], s[7 * 33]);
        *(GAS u32x4*)(dst + (size_t)(drow0 + n) * dpitch + dk0 + k0 + 8 * c) = o; }
    LDS_WAIT(); asm volatile("" ::: "memory");
}
__device__ __forceinline__ int win_src(int G, bool& perm) {
    const int pn = G >> 3, gi = G & 7; perm = true;
    if (pn < 4) return C_Q + pn * 256 + gi * 32;
    if (pn < 8) { perm = false; return C_F + (pn - 4) * 256 + gi * 32; }
    if (pn < 12) return C_V + (pn - 8) * 256 + gi * 32;
    if (pn < 16) return C_G + (pn - 12) * 256 + gi * 32;
    if (pn < 24) return (gi < 4 ? C_SV : C_SC) + (pn - 16) * 128 + (gi & 3) * 32;
    if (pn < 28) return C_SB + (pn - 24) * 256 + gi * 32;
    return (gi < 4 ? C_GA : C_GB) + (pn - 28) * 128 + (gi & 3) * 32;
}
__device__ __forceinline__ void p0_prologue(Frame& F) {
    const int gw = F.vcu * NWAVES + F.wave, NGW = F.G * NWAVES, gt = F.vcu * NTHR + F.tid, NGT = F.G * NTHR;
    for (int i = gt; i < HF; i += NGT) wsp<float>(F, WS_LB)[i] = 1.f / (1.f + __expf(F.lbl[HF + i] - F.lbl[i]));
    for (int i = gt; i < D * NE; i += NGT) { const int k = i >> 5, e = i & 31; const float v = F.w_r[i] * F.nfw[k]; const unsigned h = f2bf(v); const float lo = v - bf2f((unsigned short)h);
        wsp<bf16_t>(F, WS_WRH)[e * D + k] = (bf16_t)h; wsp<bf16_t>(F, WS_WRL)[e * D + k] = (bf16_t)f2bf(lo); }
    for (int i = gt; i < 48 * HF; i += NGT) { wsp<float>(F, WS_LFM)[i] = 0.f; wsp<bf16_t>(F, WS_VVM)[i] = 0; }
    {
        LAS float* hnm = (LAS float*)F.lds;
        for (int r = F.wave * 2; r < F.wave * 2 + 2; ++r) {
            const f32x4* xr = (const f32x4*)(F.meta + (size_t)r * D) + F.lane; f32x4 v[8]; float s = 0.f;
#pragma unroll
            for (int j = 0; j < 8; ++j) { v[j] = xr[64 * j]; s += (v[j].x * v[j].x + v[j].y * v[j].y) + (v[j].z * v[j].z + v[j].w * v[j].w); }
            const float rs = rsqrtf(wave_sum(s) * (1.f / D) + EPS);
#pragma unroll
            for (int j = 0; j < 8; ++j) { const f32x4 w = ((const f32x4*)F.nmw)[F.lane + 64 * j]; *(LAS f32x4*)(hnm + r * D + 4 * F.lane + 256 * j) = v[j] * rs * w; }
        }
        __syncthreads();
        LAS float* red = (LAS float*)(F.lds + TOK_OFF);
        for (int cb = F.vcu; cb < 256; cb += F.G) {
            const int col = F.tid & 15, ks = F.tid >> 4;
            int gcol;
            if (cb < 64) gcol = C_F + 16 * cb + col; else if (cb < 128) gcol = C_V + 16 * (cb - 64) + col; else gcol = (col < 8 ? C_SV : C_SC) + 8 * (cb - 128) + (col & 7);
            float a[16];
#pragma unroll
            for (int r = 0; r < 16; ++r) a[r] = 0.f;
            for (int k = ks * 64; k < ks * 64 + 64; ++k) { const float w = F.w_in[(size_t)k * INC + gcol];
#pragma unroll
                for (int r = 0; r < 16; ++r) a[r] = fmaf(hnm[r * D + k], w, a[r]); }
#pragma unroll
            for (int r = 0; r < 16; ++r) { a[r] += __shfl_xor(a[r], 16); a[r] += __shfl_xor(a[r], 32); }
            if (F.lane < 16) {
#pragma unroll
                for (int r = 0; r < 16; ++r) red[(F.wave * 16 + r) * 16 + col] = a[r]; }
            __syncthreads();
            if (F.tid < 256) { const int r = F.tid >> 4, c = F.tid & 15; float v = 0.f;
#pragma unroll
                for (int w = 0; w < 8; ++w) v += red[(w * 16 + r) * 16 + c];
                if (cb < 64) { const int ch = 16 * cb + c; const float l = 1.f / (1.f + __expf(F.lbl[HF + ch] - F.lbl[ch])); wsp<float>(F, WS_LFM)[(48 + r) * HF + ch] = __logf(l + (1.f - l) * sigmoidf_(v)); }
                else if (cb < 128) wsp<bf16_t>(F, WS_VVM)[(48 + r) * HF + 16 * (cb - 64) + c] = (bf16_t)f2bf(v);
                else red[2048 + r * 16 + c] = v; }
            __syncthreads();
            if (cb >= 128 && F.tid < 128) { const int r = F.tid >> 3, c = F.tid & 7; wsp<bf16_t>(F, WS_UUM)[r * HF + 8 * (cb - 128) + c] = (bf16_t)f2bf(red[2048 + r * 16 + c] * red[2048 + r * 16 + c + 8]); }
            __syncthreads();
        }
        __syncthreads();
    }
    {
        LAS float* scr = (LAS float*)(F.lds + F.wave * 16384);
        constexpr int I_IN = 32 * 352, I_AB = 16 * 64, I_O = 32 * 64, I_UP1 = 32 * 128, I_DN1 = 32 * 64;
        constexpr int NIT = I_IN + 2 * I_AB + I_O + NE * I_UP1 + NE * I_DN1;
        for (int it = gw; it < NIT; it += NGW) {
            int r = it;
            if (r < I_IN) { const int kb = r / 352, G = r % 352; bool pm; const int sc = win_src(G, pm); tr_item(F.w_in, INC, kb * 64, sc, F.nmw, pm, wsp<bf16_t>(F, WS_WIN), D, G * 32, 0, scr, F.lane); continue; } r -= I_IN;
            if (r < I_AB) { const int kb = r / 64, G = r % 64; tr_item(F.w_ho, D, kb * 64, G * 32, nullptr, true, wsp<bf16_t>(F, WS_WAB), D, G * 32, 0, scr, F.lane); continue; } r -= I_AB;
            if (r < I_AB) { const int kb = r / 64, G = r % 64; tr_item(F.w_co, D, kb * 64, G * 32, nullptr, true, wsp<bf16_t>(F, WS_WAB), D, G * 32, HF, scr, F.lane); continue; } r -= I_AB;
            if (r < I_O) { const int kb = r / 64, G = r % 64; tr_item(F.w_o, D, kb * 64, G * 32, nullptr, true, wsp<bf16_t>(F, WS_WO), D, G * 32, 0, scr, F.lane); continue; } r -= I_O;
            if (r < NE * I_UP1) { const int e = r / I_UP1, q = r % I_UP1, kb = q / 128, G = q % 128, pn = G >> 3, gi = G & 7; const int sc = (gi < 4 ? 0 : 2048) + pn * 128 + (gi & 3) * 32;
                tr_item(F.w_up + (size_t)e * D * 4096, 4096, kb * 64, sc, F.nfw, true, wsp<bf16_t>(F, WS_WUP) + (size_t)e * 4096 * D, D, G * 32, 0, scr, F.lane); continue; } r -= NE * I_UP1;
            { const int e = r / I_DN1, q = r % I_DN1, kb = q / 64, G = q % 64;
              tr_item(F.w_dn + (size_t)e * DFF * D, D, kb * 64, G * 32, nullptr, true, wsp<bf16_t>(F, WS_WDN) + (size_t)e * D * DFF, DFF, G * 32, 0, scr, F.lane); }
        }
    }
    for (int m = gw; m < M; m += NGW) {
        const GAS f32x4* xr = (const GAS f32x4*)(F.x + (size_t)m * D) + F.lane; f32x4 v[8]; float s = 0.f;
#pragma unroll
        for (int j = 0; j < 8; ++j) { v[j] = xr[64 * j]; s += (v[j].x * v[j].x + v[j].y * v[j].y) + (v[j].z * v[j].z + v[j].w * v[j].w); }
        s = wave_sum(s);
        GAS u32x2* o8 = (GAS u32x2*)(wsp<bf16_t>(F, WS_XB) + (size_t)m * D) + F.lane;
#pragma unroll
        for (int j = 0; j < 8; ++j) { u32x2 w; w.x = pk2(v[j].x, v[j].y); w.y = pk2(v[j].z, v[j].w); o8[64 * j] = w; }
        if (F.lane == 0) wsp<float>(F, WS_RS1)[m] = rsqrtf(s * (1.f / D) + EPS);
    }
}

constexpr int KTP = 72;
constexpr int QP_ = 136;
__device__ __forceinline__ void load_vt(const Frame& F, const bf16_t* Vb, size_t row0, int h, LAS bf16_t* VT) {
#pragma unroll
    for (int q = 0; q < 2; ++q) { const int id = F.tid + 512 * q, t = id >> 4, v8 = (id & 15) * 8; const u32x4 w = *(const GAS u32x4*)(Vb + (row0 + t) * HF + h * 128 + v8);
        const unsigned ww[4] = {w.x, w.y, w.z, w.w};
#pragma unroll
        for (int i = 0; i < 4; ++i) { VT[(v8 + 2 * i) * KTP + t] = (bf16_t)(ww[i] & 0xffffu); VT[(v8 + 2 * i + 1) * KTP + t] = (bf16_t)(ww[i] >> 16); } }
}
__device__ __forceinline__ void p2a_unit(Frame& F, int u) {
    LAS bf16_t* KT = (LAS bf16_t*)F.lds; LAS bf16_t* VT = KT + 128 * KTP; LAS float* TOT = (LAS float*)(F.lds + 2 * 128 * KTP * 2);
    const float* Lb; const bf16_t* Vb; size_t row0; int h, slot;
    if (u < 8) { Lb = wsp<float>(F, WS_LFM); Vb = wsp<bf16_t>(F, WS_VVM); row0 = 0; h = u; slot = 32 * 64 + u; }
    else { const int bh = (u - 8) >> 6, c = (u - 8) & 63, b = bh >> 3; h = bh & 7; Lb = wsp<float>(F, WS_LF); Vb = wsp<bf16_t>(F, WS_VV); row0 = (size_t)b * SEQ + 64 * c; slot = bh * 64 + c; }
    const int d = F.tid & 127, tq = F.tid >> 7;
    float L[16], cs[16]; float run = 0.f;
#pragma unroll
    for (int i = 0; i < 16; ++i) L[i] = Lb[(row0 + 16 * tq + i) * HF + h * 128 + d];
#pragma unroll
    for (int i = 0; i < 16; ++i) { run += L[i]; cs[i] = run; }
    TOT[tq * 128 + d] = run;
    load_vt(F, Vb, row0, h, VT);
    __syncthreads();
    float off = 0.f, total = 0.f;
#pragma unroll
    for (int q = 0; q < 4; ++q) { const float tv = TOT[q * 128 + d]; total += tv; if (q < tq) off += tv; }
#pragma unroll
    for (int i = 0; i < 16; i += 2) { const float k0 = (1.f - __expf(L[i])) * __expf(total - off - cs[i]), k1 = (1.f - __expf(L[i + 1])) * __expf(total - off - cs[i + 1]);
        *(LAS unsigned*)(KT + d * KTP + 16 * tq + i) = pk2(k0, k1); }
    if (tq == 0) wsp<float>(F, WS_DEC)[(size_t)slot * 128 + d] = __expf(total);
    __syncthreads();
    {
        const int w = F.wave, fr = F.lane & 15, fq = F.lane >> 4;
        bf16x8 a[2];
#pragma unroll
        for (int ks = 0; ks < 2; ++ks) a[ks] = *(const LAS bf16x8*)(KT + (16 * w + fr) * KTP + 32 * ks + 8 * fq);
        bf16_t* Ub = wsp<bf16_t>(F, WS_UC) + (size_t)slot * 16384;
#pragma unroll
        for (int vb = 0; vb < 8; ++vb) { f32x4 c = (f32x4){0.f, 0.f, 0.f, 0.f};
#pragma unroll
            for (int ks = 0; ks < 2; ++ks) { const bf16x8 bv = *(const LAS bf16x8*)(VT + (16 * vb + fr) * KTP + 32 * ks + 8 * fq); c = __builtin_amdgcn_mfma_f32_16x16x32_bf16(a[ks], bv, c, 0, 0, 0); }
            u32x2 o; o.x = pk2(c[0], c[1]); o.y = pk2(c[2], c[3]);
            *(GAS u32x2*)(Ub + (16 * vb + fr) * 128 + 16 * w + 4 * fq) = o; }
    }
    __syncthreads();
}
__device__ __forceinline__ void p2a_conv(Frame& F, int item) {
    const int c8 = (F.tid & 127) * 8, tq = F.tid >> 7, r0 = item * 64 + tq * 16, p0 = r0 & (SEQ - 1);
    const bf16_t* UU = wsp<bf16_t>(F, WS_UU); const bf16_t* UUM = wsp<bf16_t>(F, WS_UUM); const bf16_t* SBb = wsp<bf16_t>(F, WS_SB); bf16_t* A2 = wsp<bf16_t>(F, WS_A2);
    f32x4 w0a = *(const f32x4*)(F.cw + c8), w0b = *(const f32x4*)(F.cw + c8 + 4), w1a = *(const f32x4*)(F.cw + HF + c8), w1b = *(const f32x4*)(F.cw + HF + c8 + 4), w2a = *(const f32x4*)(F.cw + 2 * HF + c8), w2b = *(const f32x4*)(F.cw + 2 * HF + c8 + 4);
    f32x4 um2a, um2b, um1a, um1b;
    { const u32x4 a = (p0 >= 2) ? *(const GAS u32x4*)(UU + (size_t)(r0 - 2) * HF + c8) : *(const GAS u32x4*)(UUM + (14 + p0) * HF + c8); unpack8(a, um2a, um2b);
      const u32x4 b = (p0 >= 1) ? *(const GAS u32x4*)(UU + (size_t)(r0 - 1) * HF + c8) : *(const GAS u32x4*)(UUM + 15 * HF + c8); unpack8(b, um1a, um1b); }
#pragma unroll 4
    for (int i = 0; i < 16; ++i) { f32x4 ua, ub, sa, sb; unpack8(*(const GAS u32x4*)(UU + (size_t)(r0 + i) * HF + c8), ua, ub); unpack8(*(const GAS u32x4*)(SBb + (size_t)(r0 + i) * HF + c8), sa, sb);
        const f32x4 oa = sa * (w0a * um2a + w1a * um1a + w2a * ua), ob = sb * (w0b * um2b + w1b * um1b + w2b * ub);
        *(GAS u32x4*)(A2 + (size_t)(r0 + i) * D + HF + c8) = pack8(oa, ob);
        um2a = um1a; um2b = um1b; um1a = ua; um1b = ub; }
}
__device__ __forceinline__ void p2b_scan(Frame& F) {
    const int gw = F.vcu * NWAVES + F.wave;
    for (int it = gw; it < 1024; it += F.G * NWAVES) {
        const int item = it * 64 + F.lane, bh = item >> 11, e8 = item & 2047, h = bh & 7, d0 = (e8 & 15) * 8;
        const bf16_t* Ub = wsp<bf16_t>(F, WS_UC) + (size_t)bh * 64 * 16384 + e8 * 8; bf16_t* Sb = wsp<bf16_t>(F, WS_SS) + (size_t)bh * 64 * 16384 + e8 * 8;
        const float* Db = wsp<float>(F, WS_DEC) + (size_t)bh * 64 * 128 + d0;
        f32x4 s0, s1; unpack8(*(const GAS u32x4*)(wsp<bf16_t>(F, WS_UC) + (size_t)(32 * 64 + h) * 16384 + e8 * 8), s0, s1);
#pragma unroll 8
        for (int c = 0; c < 64; ++c) {
            *(GAS u32x4*)(Sb + (size_t)c * 16384) = pack8(s0, s1);
            f32x4 u0, u1; unpack8(*(const GAS u32x4*)(Ub + (size_t)c * 16384), u0, u1);
            const f32x4 g0 = *(const GAS f32x4*)(Db + c * 128), g1 = *(const GAS f32x4*)(Db + c * 128 + 4);
            s0 = g0 * s0 + u0; s1 = g1 * s1 + u1;
        }
    }
}
__device__ __forceinline__ void p2c_unit(Frame& F, int u) {
    const int bh = u >> 6, c = u & 63, b = bh >> 3, h = bh & 7; const size_t row0 = (size_t)b * SEQ + 64 * c;
    LAS bf16_t* QPl = (LAS bf16_t*)F.lds; LAS bf16_t* QD = QPl + 64 * QP_; LAS bf16_t* KI = QD + 64 * QP_; LAS bf16_t* VT = KI + 160 * QP_; LAS bf16_t* PL = VT + 128 * KTP;
    LAS float* TOT8 = (LAS float*)(PL + 64 * KTP); LAS float* SSQ = TOT8 + 8 * 128;
    const int dp = (F.tid & 63) * 2, t8 = F.tid >> 6;
    const float* Lb = wsp<float>(F, WS_LF) + (row0 + 8 * t8) * HF + h * 128 + dp; const bf16_t* Qb = wsp<bf16_t>(F, WS_QS) + (row0 + 8 * t8) * HF + h * 128 + dp;
    f32x2 L[8], cs[8], q[8]; f32x2 run = (f32x2){0.f, 0.f};
#pragma unroll
    for (int i = 0; i < 8; ++i) { L[i] = *(const GAS f32x2*)(Lb + (size_t)i * HF); const unsigned w = *(const GAS unsigned*)(Qb + (size_t)i * HF); q[i] = (f32x2){bflo(w), bfhi(w)}; }
#pragma unroll
    for (int i = 0; i < 8; ++i) { run += L[i]; cs[i] = run; }
    *(LAS f32x2*)(TOT8 + t8 * 128 + dp) = run;
    load_vt(F, wsp<bf16_t>(F, WS_VV), row0, h, VT);
    for (int i = F.tid; i < 64 * KTP / 2; i += NTHR) ((LAS unsigned*)PL)[i] = 0u;
    __syncthreads();
    {
        f32x2 pre[9]; pre[0] = (f32x2){0.f, 0.f};
#pragma unroll
        for (int j = 0; j < 8; ++j) pre[j + 1] = pre[j] + *(const LAS f32x2*)(TOT8 + j * 128 + dp);
        f32x2 off = (f32x2){0.f, 0.f};
#pragma unroll
        for (int j = 0; j < 8; ++j) if (j == t8) off = pre[j];
        const int si = t8 >> 1;
        f32x2 st[4];
#pragma unroll
        for (int j = 0; j < 4; ++j) st[j] = pre[2 * j];
        f32x2 sti = st[0];
#pragma unroll
        for (int j = 1; j < 4; ++j) if (j == si) sti = st[j];
#pragma unroll
        for (int i = 0; i < 8; ++i) { const int t = 8 * t8 + i; const f32x2 bc = off + cs[i];
            *(LAS unsigned*)(QPl + t * QP_ + dp) = pk2(q[i].x * __expf(bc.x), q[i].y * __expf(bc.y));
            *(LAS unsigned*)(QD + t * QP_ + dp) = pk2(q[i].x * __expf(bc.x - sti.x), q[i].y * __expf(bc.y - sti.y));
            const f32x2 k = (f32x2){1.f - __expf(L[i].x), 1.f - __expf(L[i].y)};
#pragma unroll
            for (int j = 0; j < 4; ++j) if (j >= si) {
                *(LAS unsigned*)(KI + (8 * j * (j + 1) + t) * QP_ + dp) = pk2(k.x * __expf(fminf(st[j].x - bc.x, 80.f)), k.y * __expf(fminf(st[j].y - bc.y, 80.f))); }
        }
    }
    __syncthreads();
    const int w = F.wave, fr = F.lane & 15, fq = F.lane >> 4;
    for (int bi = w; bi < 10; bi += 8) {
        const int i = bi < 1 ? 0 : bi < 3 ? 1 : bi < 6 ? 2 : 3, j = bi - (i * (i + 1)) / 2;
        f32x4 cacc = (f32x4){0.f, 0.f, 0.f, 0.f};
#pragma unroll
        for (int ks = 0; ks < 4; ++ks) { const bf16x8 a = *(const LAS bf16x8*)(KI + (8 * i * (i + 1) + 16 * j + fr) * QP_ + 32 * ks + 8 * fq), bq = *(const LAS bf16x8*)(QD + (16 * i + fr) * QP_ + 32 * ks + 8 * fq);
            cacc = __builtin_amdgcn_mfma_f32_16x16x32_bf16(a, bq, cacc, 0, 0, 0); }
        if (i == j) {
#pragma unroll
            for (int r = 0; r < 4; ++r) if (4 * fq + r > fr) cacc[r] = 0.f; }
        u32x2 o; o.x = pk2(cacc[0], cacc[1]); o.y = pk2(cacc[2], cacc[3]);
        *(LAS u32x2*)(PL + (16 * i + fr) * KTP + 16 * j + 4 * fq) = o;
    }
    __syncthreads();
    f32x4 acc[4];
#pragma unroll
    for (int tb = 0; tb < 4; ++tb) acc[tb] = (f32x4){0.f, 0.f, 0.f, 0.f};
    {
        const bf16_t* Sb = wsp<bf16_t>(F, WS_SS) + ((size_t)bh * 64 + c) * 16384 + (16 * w + fr) * 128 + 8 * fq;
        bf16x8 sa[4];
#pragma unroll
        for (int ks = 0; ks < 4; ++ks) sa[ks] = *(const GAS bf16x8*)(Sb + 32 * ks);
#pragma unroll
        for (int ks = 0; ks < 4; ++ks)
#pragma unroll
            for (int tb = 0; tb < 4; ++tb) { const bf16x8 bq = *(const LAS bf16x8*)(QPl + (16 * tb + fr) * QP_ + 32 * ks + 8 * fq); acc[tb] = __builtin_amdgcn_mfma_f32_16x16x32_bf16(sa[ks], bq, acc[tb], 0, 0, 0); }
#pragma unroll
        for (int ks = 0; ks < 2; ++ks) { const bf16x8 va = *(const LAS bf16x8*)(VT + (16 * w + fr) * KTP + 32 * ks + 8 * fq);
#pragma unroll
            for (int tb = 0; tb < 4; ++tb) { const bf16x8 bp = *(const LAS bf16x8*)(PL + (16 * tb + fr) * KTP + 32 * ks + 8 * fq); acc[tb] = __builtin_amdgcn_mfma_f32_16x16x32_bf16(va, bp, acc[tb], 0, 0, 0); } }
    }
#pragma unroll
    for (int tb = 0; tb < 4; ++tb) { float p = (acc[tb][0] * acc[tb][0] + acc[tb][1] * acc[tb][1]) + (acc[tb][2] * acc[tb][2] + acc[tb][3] * acc[tb][3]); p += __shfl_xor(p, 16); p += __shfl_xor(p, 32);
        if (fq == 0) SSQ[w * 64 + 16 * tb + fr] = p; }
    __syncthreads();
    {
        const f32x4 gw4 = *(const f32x4*)(F.gnw + 16 * w + 4 * fq);
        const bf16_t* GSb = wsp<bf16_t>(F, WS_GS); bf16_t* A2 = wsp<bf16_t>(F, WS_A2);
#pragma unroll
        for (int tb = 0; tb < 4; ++tb) { const int t = 16 * tb + fr; float ss = 0.f;
#pragma unroll
            for (int ww = 0; ww < 8; ++ww) ss += SSQ[ww * 64 + t];
            const float rs = rsqrtf(ss * (1.f / 128.f) + EPS);
            const u32x2 gv = *(const GAS u32x2*)(GSb + (row0 + t) * HF + h * 128 + 16 * w + 4 * fq);
            const f32x4 o = acc[tb] * rs * gw4 * (f32x4){bflo(gv.x), bfhi(gv.x), bflo(gv.y), bfhi(gv.y)};
            u32x2 ov; ov.x = pk2(o[0], o[1]); ov.y = pk2(o[2], o[3]);
            *(GAS u32x2*)(A2 + (row0 + t) * D + h * 128 + 16 * w + 4 * fq) = ov; }
    }
    __syncthreads();
}

__device__ __forceinline__ void split8(const f32x4 a, const f32x4 b, bf16x8& hi, bf16x8& lo) {
    const float v[8] = {a[0], a[1], a[2], a[3], b[0], b[1], b[2], b[3]};
#pragma unroll
    for (int j = 0; j < 8; ++j) { const unsigned h = f2bf(v[j]); hi[j] = (short)h; lo[j] = (short)f2bf(v[j] - bf2f((unsigned short)h)); }
}
__device__ __forceinline__ void p5_router(Frame& F) {
    const int gw = F.vcu * NWAVES + F.wave, fr = F.lane & 15, fq = F.lane >> 4;
    LAS float* lg = (LAS float*)(F.lds + F.wave * 4096);
    const float* H1 = wsp<float>(F, WS_H1); const bf16_t* WH = wsp<bf16_t>(F, WS_WRH); const bf16_t* WL = wsp<bf16_t>(F, WS_WRL);
    for (int it = gw; it < M / 16; it += F.G * NWAVES) {
        const int row0 = it * 16;
        const float* hp = H1 + (size_t)(row0 + fr) * D + 8 * fq;
        const bf16_t* wh0 = WH + (size_t)fr * D + 8 * fq; const bf16_t* wl0 = WL + (size_t)fr * D + 8 * fq;
        f32x4 a0 = (f32x4){0.f, 0.f, 0.f, 0.f}, a1 = a0; float ss = 0.f;
#pragma unroll 4
        for (int ks = 0; ks < 64; ++ks) {
            const f32x4 xa = *(const GAS f32x4*)(hp + 32 * ks), xb = *(const GAS f32x4*)(hp + 32 * ks + 4);
            ss += (xa[0] * xa[0] + xa[1] * xa[1]) + (xa[2] * xa[2] + xa[3] * xa[3]) + (xb[0] * xb[0] + xb[1] * xb[1]) + (xb[2] * xb[2] + xb[3] * xb[3]);
            bf16x8 xh, xl; split8(xa, xb, xh, xl);
            const bf16x8 bh0 = *(const GAS bf16x8*)(wh0 + 32 * ks), bl0 = *(const GAS bf16x8*)(wl0 + 32 * ks), bh1 = *(const GAS bf16x8*)(wh0 + 16 * D + 32 * ks), bl1 = *(const GAS bf16x8*)(wl0 + 16 * D + 32 * ks);
            a0 = __builtin_amdgcn_mfma_f32_16x16x32_bf16(xh, bh0, a0, 0, 0, 0); a0 = __builtin_amdgcn_mfma_f32_16x16x32_bf16(xh, bl0, a0, 0, 0, 0);
            a0 = __builtin_amdgcn_mfma_f32_16x16x32_bf16(xl, bh0, a0, 0, 0, 0); a0 = __builtin_amdgcn_mfma_f32_16x16x32_bf16(xl, bl0, a0, 0, 0, 0);
            a1 = __builtin_amdgcn_mfma_f32_16x16x32_bf16(xh, bh1, a1, 0, 0, 0); a1 = __builtin_amdgcn_mfma_f32_16x16x32_bf16(xh, bl1, a1, 0, 0, 0);
            a1 = __builtin_amdgcn_mfma_f32_16x16x32_bf16(xl, bh1, a1, 0, 0, 0); a1 = __builtin_amdgcn_mfma_f32_16x16x32_bf16(xl, bl1, a1, 0, 0, 0);
        }
        ss += __shfl_xor(ss, 16); ss += __shfl_xor(ss, 32);
#pragma unroll
        for (int r = 0; r < 4; ++r) { lg[(4 * fq + r) * 33 + fr] = a0[r]; lg[(4 * fq + r) * 33 + 16 + fr] = a1[r]; }
        LDS_WAIT(); asm volatile("" ::: "memory");
        if (F.lane < 16) {
            const int tokn = row0 + F.lane; const float rs = rsqrtf(ss * (1.f / D) + EPS);
            float v[32];
#pragma unroll
            for (int e = 0; e < 32; ++e) v[e] = lg[F.lane * 33 + e] * rs + F.b_r[e];
            int idx[4]; float val[4];
#pragma unroll
            for (int k = 0; k < 4; ++k) { float bv = -3.0e38f; int bi = 0;
#pragma unroll
                for (int e = 0; e < 32; ++e) { const bool tk = v[e] > bv; bv = tk ? v[e] : bv; bi = tk ? e : bi; }
                idx[k] = bi; val[k] = bv;
#pragma unroll
                for (int e = 0; e < 32; ++e) v[e] = (e == bi) ? -3.0e38f : v[e]; }
            float ex[4], den = 0.f;
#pragma unroll
            for (int k = 0; k < 4; ++k) { ex[k] = __expf(val[k] - val[0]); den += ex[k]; }
            const float inv = 1.f / den;
            wsp<float>(F, WS_RS2)[tokn] = rs;
#pragma unroll
            for (int k = 0; k < 4; ++k) { const int pos = (int)atomicAdd((unsigned*)(F.ctl + CW_CNT + 64 * idx[k]), 1u);
                wsp<int>(F, WS_TOPE)[tokn * 4 + k] = idx[k]; wsp<int>(F, WS_TOPP)[tokn * 4 + k] = pos; wsp<float>(F, WS_TOPW)[tokn * 4 + k] = ex[k] * inv;
                wsp<int>(F, WS_LIST)[(size_t)idx[k] * CAPF + pos] = tokn; }
        }
        LDS_WAIT(); asm volatile("" ::: "memory");
    }
}
__device__ __forceinline__ void build_pref(Frame& F) {
    if (F.tid == 0) { int a = 0;
        for (int e = 0; e < NE; ++e) { F.MISC[16 + e] = (unsigned)a; const unsigned c = __hip_atomic_load(F.ctl + CW_CNT + 64 * e, RLX_AGENT); a += (int)((c + 255u) >> 8); }
        F.MISC[16 + NE] = (unsigned)(a < MAXRT ? a : MAXRT); }
    __syncthreads();
}
__device__ __forceinline__ void build_tok(Frame& F, const MoeOrder& S) {
    LAS int* tokt = (LAS int*)(F.lds + TOK_OFF);
    Unit u;
    for (int i = 0; i < 18 && S.next(i, u); ++i) {
        const int rt = u.pm - (int)F.MISC[16 + u.e]; const int cnt = (int)__hip_atomic_load(F.ctl + CW_CNT + 64 * u.e, RLX_AGENT);
        if (F.tid < 256) { const int r = rt * 256 + F.tid; tokt[i * 256 + F.tid] = (r < cnt) ? wsp<int>(F, WS_LIST)[(size_t)u.e * CAPF + r] : 0; }
    }
    __syncthreads();
}
__device__ __forceinline__ void p9_combine(Frame& F) {
    const int gw = F.vcu * NWAVES + F.wave;
    const float* H1 = wsp<float>(F, WS_H1); const bf16_t* YR = wsp<bf16_t>(F, WS_YR);
    for (int m = gw; m < M; m += F.G * NWAVES) {
        f32x4 v[4][2];
#pragma unroll
        for (int j = 0; j < 4; ++j) { v[j][0] = *(const GAS f32x4*)(H1 + (size_t)m * D + 8 * F.lane + 512 * j); v[j][1] = *(const GAS f32x4*)(H1 + (size_t)m * D + 8 * F.lane + 512 * j + 4); }
#pragma unroll
        for (int k = 0; k < 4; ++k) {
            const int e = wsp<int>(F, WS_TOPE)[m * 4 + k], pos = wsp<int>(F, WS_TOPP)[m * 4 + k]; const float wk = wsp<float>(F, WS_TOPW)[m * 4 + k];
            const size_t row = (size_t)F.MISC[16 + e] * 256 + pos;
#pragma unroll
            for (int j = 0; j < 4; ++j) { f32x4 a, b; unpack8(*(const GAS u32x4*)(YR + row * D + 8 * F.lane + 512 * j), a, b); v[j][0] += a * wk; v[j][1] += b * wk; }
        }
        float s = 0.f;
#pragma unroll
        for (int j = 0; j < 4; ++j)
#pragma unroll
            for (int q = 0; q < 2; ++q) s += (v[j][q][0] * v[j][q][0] + v[j][q][1] * v[j][q][1]) + (v[j][q][2] * v[j][q][2] + v[j][q][3] * v[j][q][3]);
        const float rs = rsqrtf(wave_sum(s) * (1.f / D) + EPS);
#pragma unroll
        for (int j = 0; j < 4; ++j)
#pragma unroll
            for (int q = 0; q < 2; ++q) { const f32x4 w = *(const f32x4*)(F.fnw + 8 * F.lane + 512 * j + 4 * q); *(GAS f32x4*)(F.out + (size_t)m * D + 8 * F.lane + 512 * j + 4 * q) = v[j][q] * rs * w; }
    }
}
constexpr int NPH = 11;
struct Args { const float* in[18]; float* out; unsigned char* ws; int ph_lo, ph_hi; };

__global__ void __launch_bounds__(NTHR, 2) fwd_kernel(Args args) {
    extern __shared__ __attribute__((aligned(16))) unsigned char lds_raw[];
    Frame F;
    F.lds = (LAS unsigned char*)lds_raw; F.MISC = (volatile LAS unsigned*)(F.lds + MISC_OFF);
    F.wave = __builtin_amdgcn_readfirstlane((int)threadIdx.x >> 6);
#define REFRESH() do { F.lane = lane_id(); F.tid = F.wave * 64 + F.lane; } while (0)
    REFRESH();
    F.G = gridDim.x; { const int bx = blockIdx.x; F.vcu = (F.G % 8 == 0) ? (bx % 8) * (F.G / 8) + bx / 8 : bx; }
    F.ws = args.ws; F.ctl = (gu32*)(args.ws + WS_CTL); F.out = args.out;
    F.x = args.in[0]; F.meta = args.in[1]; F.nmw = args.in[2]; F.w_in = args.in[3]; F.lbl = args.in[4]; F.gnw = args.in[5]; F.w_ho = args.in[6]; F.cw = args.in[7]; F.w_co = args.in[8]; F.w_o = args.in[9];
    F.nfw = args.in[10]; F.w_r = args.in[11]; F.b_r = args.in[12]; F.w_up = args.in[13]; F.b_up = args.in[14]; F.w_dn = args.in[15]; F.b_dn = args.in[16]; F.fnw = args.in[17];
    for (int u = F.tid; u < 256; u += NTHR) F.MISC[u] = 0u;
    __syncthreads();
    const int lo = args.ph_lo, hi = args.ph_hi;
    const bool multi = (hi - lo) > 1;
    XcdBarrier bar; bar.bar = (unsigned*)(F.ctl + CW_BAR); bar.x = 0; bar.st = nullptr;
    if (multi) bar = xcd_barrier_post((unsigned*)(F.ctl + CW_BAR), F.MISC, F.tid);
#define IN(k) (lo <= (k) && (k) < hi)
#define SEAM(k) do { REFRESH(); if (IN(k) && IN((k) + 1)) xcd_barrier(bar, F.tid); } while (0)
    const int c = blockIdx.x;

    if (IN(0)) { p0_prologue(F); } SEAM(0);

    if (IN(1)) {
        GemmDesc g{wsp<bf16_t>(F, WS_XB), wsp<bf16_t>(F, WS_WIN), D, INC / 256}; StaticOrder S; S.init(M, INC, F.G, c);
        EpiInproj E{wsp<float>(F, WS_RS1), wsp<float>(F, WS_LB), wsp<bf16_t>(F, WS_QS), wsp<bf16_t>(F, WS_VV), wsp<bf16_t>(F, WS_GS), wsp<bf16_t>(F, WS_UU), wsp<bf16_t>(F, WS_SB), wsp<bf16_t>(F, WS_RT), wsp<bf16_t>(F, WS_GBS), wsp<float>(F, WS_LF)};
        gemm_phase<EpiInproj, StaticOrder, false, true>(F.lds, g, S, E, nullptr, F.wave);
    } SEAM(1);

    if (IN(2)) { for (int u = c; u < 2048 + 8; u += F.G) p2a_unit(F, u); for (int it = c; it < M / 64; it += F.G) p2a_conv(F, it); } SEAM(2);
    if (IN(3)) { p2b_scan(F); } SEAM(3);
    if (IN(4)) { for (int u = c; u < 2048; u += F.G) p2c_unit(F, u); } SEAM(4);

    if (IN(5)) {
        GemmDesc g{wsp<bf16_t>(F, WS_A2), wsp<bf16_t>(F, WS_WAB), D, D / 256}; StaticOrder S; S.init(M, D, F.G, c);
        EpiMerge E{wsp<bf16_t>(F, WS_RT), wsp<bf16_t>(F, WS_GBS), wsp<bf16_t>(F, WS_MG)};
        gemm_phase<EpiMerge, StaticOrder, false, true>(F.lds, g, S, E, nullptr, F.wave);
    } SEAM(5);

    if (IN(6)) {
        GemmDesc g{wsp<bf16_t>(F, WS_MG), wsp<bf16_t>(F, WS_WO), D, D / 256}; StaticOrder S; S.init(M, D, F.G, c);
        EpiWo E{F.x, wsp<float>(F, WS_H1), wsp<bf16_t>(F, WS_H1B)};
        gemm_phase<EpiWo, StaticOrder, false, true>(F.lds, g, S, E, nullptr, F.wave);
    } SEAM(6);

    if (IN(7)) { p5_router(F); } SEAM(7);

    if (IN(8)) {
        build_pref(F);
        MoeOrder S; S.init(16, F.G, c, (const volatile LAS int*)(F.MISC + 16));
        build_tok(F, S);
        GemmDesc g{wsp<bf16_t>(F, WS_H1B), wsp<bf16_t>(F, WS_WUP), D, 16};
        EpiUp E{wsp<float>(F, WS_RS2), (const LAS int*)(F.lds + TOK_OFF), F.b_up, wsp<bf16_t>(F, WS_ACT)};
        gemm_phase<EpiUp, MoeOrder, true, true>(F.lds, g, S, E, (const LAS int*)(F.lds + TOK_OFF), F.wave);
    } SEAM(8);

    if (IN(9)) {
        build_pref(F);
        MoeOrder S; S.init(8, F.G, c, (const volatile LAS int*)(F.MISC + 16));
        GemmDesc g{wsp<bf16_t>(F, WS_ACT), wsp<bf16_t>(F, WS_WDN), DFF, 8};
        EpiDown E{F.b_dn, wsp<bf16_t>(F, WS_YR)};
        gemm_phase<EpiDown, MoeOrder, false, true>(F.lds, g, S, E, nullptr, F.wave);
    } SEAM(9);

    if (IN(10)) { build_pref(F); p9_combine(F); }
#undef IN
#undef SEAM
#undef REFRESH
}

inline void launch_fast(hipStream_t stream, void* const* d_in, float* out, unsigned char* ws, int n_launches) {
    static int grid = 0;
    if (grid == 0) {
        int dev = 0, cus = 0, per_cu = 0;
        if (hipGetDevice(&dev) != hipSuccess || hipDeviceGetAttribute(&cus, hipDeviceAttributeMultiprocessorCount, dev) != hipSuccess) { fprintf(stderr, "kernel_launch: device query failed\n"); grid = -1; return; }
        if (hipFuncSetAttribute((const void*)fwd_kernel, hipFuncAttributeMaxDynamicSharedMemorySize, LDS_BYTES) != hipSuccess) { fprintf(stderr, "kernel_launch: hipFuncSetAttribute failed\n"); grid = -1; return; }
        if (hipOccupancyMaxActiveBlocksPerMultiprocessor(&per_cu, (const void*)fwd_kernel, NTHR, LDS_BYTES) != hipSuccess || per_cu < 1) fprintf(stderr, "kernel_launch: note: occupancy query says %d blocks per CU\n", per_cu);
        (void)hipGetLastError();
        grid = cus;
    }
    if (grid < 0) return;
    (void)hipMemsetAsync(ws + WS_CTL, 0, CTL_BYTES, stream);
    Args a{};
    for (int i = 0; i < 18; ++i) a.in[i] = (const float*)d_in[i];
    a.out = out; a.ws = ws;
    for (int li = 0; li < n_launches; ++li) {
        a.ph_lo = (n_launches == 1) ? 0 : li; a.ph_hi = (n_launches == 1) ? NPH : li + 1;
        hipLaunchKernelGGL(fwd_kernel, dim3(grid), dim3(NTHR), LDS_BYTES, stream, a);
        const hipError_t le = hipPeekAtLastError();
        if (le != hipSuccess) { fprintf(stderr, "kernel_launch: launch %d failed: %s\n", li, hipGetErrorName(le)); break; }
    }
}
}
#ifndef FK_LAUNCHES
#define FK_LAUNCHES 1
#endif
extern "C" void kernel_launch(void* const* d_in, const int* in_sizes, int n_in, void* d_out, int out_size, void* d_ws, size_t ws_size, hipStream_t stream) {
    if (n_in != 18 || ws_size < fk::WS_FAST_END) { fprintf(stderr, "kernel_launch: n_in %d, ws %zu < %zu\n", n_in, ws_size, (size_t)fk::WS_FAST_END); return; }
    fk::launch_fast(stream, d_in, (float*)d_out, (unsigned char*)d_ws, FK_LAUNCHES);
}
```

```cpp
#include <hip/hip_runtime.h>
#include <cstdio>
#define FK_LAUNCHES 1
#define FK_IN8_MASK 0xFFFF000F0FFull
namespace fk {
#define LAS __attribute__((address_space(3)))
#define GAS __attribute__((address_space(1)))
typedef unsigned short bf16_t;
typedef short bf16x8 __attribute__((ext_vector_type(8)));
typedef float f32x4 __attribute__((ext_vector_type(4)));
typedef float f32x2 __attribute__((ext_vector_type(2)));
typedef unsigned u32x4 __attribute__((ext_vector_type(4)));
typedef unsigned u32x2 __attribute__((ext_vector_type(2)));
typedef GAS unsigned gu32;
typedef _Float16 h16_t;
typedef _Float16 h16x4 __attribute__((ext_vector_type(4)));
typedef _Float16 h16x2 __attribute__((ext_vector_type(2)));
#define RLX_AGENT __ATOMIC_RELAXED, __HIP_MEMORY_SCOPE_AGENT
#define LDS_WAIT() asm volatile("s_waitcnt lgkmcnt(0)" ::: "memory")
#define VM_WAIT() asm volatile("s_waitcnt vmcnt(0)" ::: "memory")

constexpr int D = 2048, NB = 4, SEQ = 4096, M = NB * SEQ, NMETA = 16;
constexpr int HF = 1024, INC = 11264, NE = 32, DFF = 2048, NCH = SEQ / 64;
constexpr int C_Q = 0, C_F = 1024, C_V = 2048, C_G = 3072, C_SV = 4096, C_SB = 5120, C_SC = 6144, C_GA = 7168, C_GB = 9216;
constexpr float EPS = 1e-6f;
constexpr int CAPF = M;
constexpr int MAXRT = 288;
constexpr int NWAVES = 8, NTHR = 512;

constexpr size_t al(size_t x) { return (x + 0xFFFFF) & ~(size_t)0xFFFFF; }
constexpr size_t WS_CTL = 0, CTL_BYTES = 65536;
constexpr size_t WS_LB = 65536, WS_RS1 = WS_LB + 4096, WS_RS2 = WS_RS1 + 65536, WS_WRH = WS_RS2 + 65536, WS_WRL = WS_WRH + 131072;
constexpr size_t WS_LFM = WS_WRL + 131072, WS_VVM = WS_LFM + 64 * 1024 * 4, WS_UUM = WS_VVM + 64 * 1024 * 2, WS_SMALL_END = WS_UUM + 16 * 1024 * 2;
constexpr size_t WS_TOPE = al(WS_SMALL_END), WS_TOPP = WS_TOPE + (size_t)M * 16, WS_TOPW = WS_TOPP + (size_t)M * 16, WS_LIST = WS_TOPW + (size_t)M * 16;
constexpr size_t WS_DEC = al(WS_LIST + (size_t)NE * CAPF * 4);
constexpr size_t WS_WIN = al(WS_DEC + (size_t)33 * 64 * 128 * 4);
constexpr size_t WS_WAB = al(WS_WIN + (size_t)INC * D * 2);
constexpr size_t WS_WO = al(WS_WAB + (size_t)D * D * 2);
constexpr size_t WS_WUP = al(WS_WO + (size_t)D * D * 2);
constexpr size_t WS_WDN = al(WS_WUP + (size_t)NE * 4096 * D);
constexpr size_t WS_XB = al(WS_WDN + (size_t)NE * D * DFF);
constexpr size_t WS_QS = al(WS_XB + (size_t)M * D * 2);
constexpr size_t WS_LF = al(WS_QS + (size_t)M * HF * 2);
constexpr size_t WS_VV = al(WS_LF + (size_t)M * HF * 2);
constexpr size_t WS_GS = al(WS_VV + (size_t)M * HF * 2);
constexpr size_t WS_UU = al(WS_GS + (size_t)M * HF * 2);
constexpr size_t WS_SB = al(WS_UU + (size_t)M * HF * 2);
constexpr size_t WS_RT = al(WS_SB + (size_t)M * HF * 2);
constexpr size_t WS_GBS = al(WS_RT + (size_t)M * D * 2);
constexpr size_t WS_UC = al(WS_GBS + (size_t)M * D * 2);
constexpr size_t WS_SS = al(WS_UC + (size_t)(32 * 64 + 8) * 16384 * 2);
constexpr size_t WS_A2 = al(WS_SS + (size_t)32 * 64 * 16384 * 2);
constexpr size_t WS_MG = al(WS_A2 + (size_t)M * D * 2);
constexpr size_t WS_H1 = al(WS_MG + (size_t)M * D * 2);
constexpr size_t WS_H1B = al(WS_H1 + (size_t)M * D * 2);
constexpr size_t WS_ACT = al(WS_H1B + (size_t)M * D);
constexpr size_t WS_YR = al(WS_ACT + (size_t)MAXRT * 256 * DFF);
constexpr size_t WS_WIN8 = al(WS_YR + (size_t)MAXRT * 256 * D);
constexpr size_t WS_XB8 = al(WS_WIN8 + (size_t)INC * D);
constexpr size_t WS_FAST_END = al(WS_XB8 + (size_t)M * D);
#ifndef FK_IN8_MASK
#define FK_IN8_MASK 0xFFFF00000F0ull
#endif
constexpr unsigned long long IN8_MASK = FK_IN8_MASK;
constexpr unsigned long long INB_MASK = ((1ull << 44) - 1) & ~IN8_MASK;
constexpr int cpop(unsigned long long m) { int n = 0; while (m) { m &= m - 1; ++n; } return n; }
constexpr int N_IN8 = cpop(IN8_MASK), N_INB = 44 - N_IN8;
__device__ __forceinline__ int nth_bit(unsigned long long m, int n) { for (int i = 0; i < n; ++i) m &= m - 1; return __builtin_ctzll(m); }
constexpr int CW_TMO = 0;
constexpr int CW_CNT = 1024;
constexpr int CW_Q = 3400;
constexpr int CW_TS = 3200;
constexpr int CW_BAR = 4096;
constexpr int RING_BYTES = 131072;
constexpr int TOK_OFF = RING_BYTES, TOK_BYTES = 18 * 1024;
constexpr int MISC_OFF = TOK_OFF + TOK_BYTES;
constexpr int LDS_BYTES = MISC_OFF + 1024;
static_assert(LDS_BYTES <= 160 * 1024, "LDS");

__device__ __forceinline__ float sigmoidf_(float x) { return 1.f / (1.f + __expf(-x)); }
__device__ __forceinline__ unsigned f2bf(float f) { unsigned u = __builtin_bit_cast(unsigned, f); return (u + 0x7fffu + ((u >> 16) & 1u)) >> 16; }
__device__ __forceinline__ unsigned pk2(float lo, float hi) { return f2bf(lo) | (f2bf(hi) << 16); }
__device__ __forceinline__ float bf2f(unsigned short b) { return __builtin_bit_cast(float, ((unsigned)b) << 16); }
__device__ __forceinline__ float bflo(unsigned w) { return __builtin_bit_cast(float, w << 16); }
__device__ __forceinline__ float bfhi(unsigned w) { return __builtin_bit_cast(float, w & 0xffff0000u); }
__device__ __forceinline__ unsigned cvt_pk_bf16(float lo, float hi) { unsigned r; asm volatile("v_cvt_pk_bf16_f32 %0, %1, %2" : "=v"(r) : "v"(lo), "v"(hi)); return r; }
__device__ __forceinline__ unsigned pk4_fp8(float a, float b, float c, float d) { int w = 0; w = __builtin_amdgcn_cvt_pk_fp8_f32(a, b, w, false); w = __builtin_amdgcn_cvt_pk_fp8_f32(c, d, w, true); return (unsigned)w; }
constexpr float W8_SCALE = 64.f, W8_INV = 1.f / 64.f;
__device__ __forceinline__ int lane_id() { int l; asm volatile("v_mbcnt_lo_u32_b32 %0, -1, 0\n\tv_mbcnt_hi_u32_b32 %0, -1, %0" : "=v"(l)); return l; }
__device__ __forceinline__ float wave_sum(float v) {
#pragma unroll
    for (int o = 1; o < 64; o <<= 1) v += __shfl_xor(v, o);
    return v;
}

#define XB_TMO      128
#define XB_XCNT(j)  (256  + 64 * (j))
#define XB_XSUB(j)  (1280 + 64 * (j))
#define XB_XGEN(j)  (2304 + 64 * (j))
#define XB_TOP      3328
#define XB_TOPGEN   3392
#define XCD_BAR_WORDS 3456
#define XB_SPIN_CAP (1u << 18)
__device__ __forceinline__ unsigned xb_ld(unsigned* p)              { return __hip_atomic_load(p, __ATOMIC_RELAXED, __HIP_MEMORY_SCOPE_AGENT); }
__device__ __forceinline__ unsigned xb_add(unsigned* p, unsigned v) { return __hip_atomic_fetch_add(p, v, __ATOMIC_RELAXED, __HIP_MEMORY_SCOPE_AGENT); }
__device__ __forceinline__ unsigned xb_xcc_id() { return (unsigned)__builtin_amdgcn_s_getreg((3 << 11) | 20) & 0xFu; }
#define XB_SPIN(cond, bar) do { unsigned _sp = 0; while (cond) { __builtin_amdgcn_s_sleep(1); \
    if ((++_sp & 255u) == 0u) { if (xb_ld(&(bar)[XB_TMO])) break; if (_sp > XB_SPIN_CAP) { atomicAdd(&(bar)[XB_TMO], 1u); break; } } } } while (0)
struct XcdBarrier { unsigned* bar; unsigned x; volatile LAS unsigned* st; };
__device__ __forceinline__ XcdBarrier xcd_barrier_post(unsigned* bar, volatile LAS unsigned* st, int tid) {
    XcdBarrier b; b.bar = bar; b.x = xb_xcc_id(); b.st = st;
    if (tid == 0) (void)xb_add(&bar[XB_XCNT(b.x)], 1u);
    return b;
}
__device__ __forceinline__ void xcd_barrier_complete(unsigned* bar, unsigned x, unsigned& nloc, unsigned& nx) {
    const unsigned G = gridDim.x * gridDim.y * gridDim.z;
    unsigned sum, cnt, mine, sp = 0u;
    for (;;) {
        sum = 0u; cnt = 0u; mine = 0u;
#pragma unroll
        for (unsigned j = 0; j < 16; ++j) { const unsigned c = xb_ld(&bar[XB_XCNT(j)]); sum += c; cnt += (c > 0u) ? 1u : 0u; mine = (j == x) ? c : mine; }
        if (sum == G) break;
        __builtin_amdgcn_s_sleep(1);
        if ((++sp & 255u) == 0u) { if (xb_ld(&bar[XB_TMO])) break; if (sp > XB_SPIN_CAP) { atomicAdd(&bar[XB_TMO], 1u); break; } }
    }
    nloc = mine > 0u ? mine : 1u; nx = cnt > 0u ? cnt : 1u;
}
__device__ __forceinline__ void xcd_barrier(const XcdBarrier& b, int tid) {
    asm volatile("s_waitcnt vmcnt(0)" ::: "memory");
    __syncthreads();
    if (tid == 0) {
        unsigned* bar = b.bar;
        __builtin_amdgcn_s_waitcnt(0);
        unsigned nloc = b.st[0], nx = b.st[1];
        if (nloc == 0u) { xcd_barrier_complete(bar, b.x, nloc, nx); b.st[0] = nloc; b.st[1] = nx; }
        const unsigned old = xb_add(&bar[XB_XSUB(b.x)], 1u);
        const unsigned gen = old / nloc;
        if (old + 1u == (gen + 1u) * nloc) {
            __builtin_amdgcn_fence(__ATOMIC_RELEASE, "agent");
            asm volatile("s_waitcnt vmcnt(0)" ::: "memory");
            const unsigned og = xb_add(&bar[XB_TOP], 1u);
            const unsigned tg = og / nx;
            if (og + 1u == (tg + 1u) * nx) xb_add(&bar[XB_TOPGEN], 1u);
            else XB_SPIN(xb_ld(&bar[XB_TOPGEN]) == tg, bar);
            __builtin_amdgcn_fence(__ATOMIC_ACQUIRE, "agent");
            xb_add(&bar[XB_XGEN(b.x)], 1u);
            asm volatile("s_waitcnt vmcnt(0)" ::: "memory");
        } else {
            XB_SPIN(xb_ld(&bar[XB_XGEN(b.x)]) == gen, bar);
            __builtin_amdgcn_fence(__ATOMIC_ACQUIRE, "agent");
            asm volatile("s_waitcnt vmcnt(0)" ::: "memory");
        }
    }
    __syncthreads();
}

constexpr int BM = 256, BK = 64, HALF = 128, HTB = HALF * BK * 2, NXCD = 8, WGM = 8;
__host__ __device__ __forceinline__ int lds_byte(int r, int c) { const int st = (r >> 4) * 2 + (c >> 5), rr = r & 15, cc = c & 31, ob = rr * 64 + cc * 2; return st * 1024 + (ob ^ (((ob >> 9) & 1) << 5)); }
__host__ __device__ __forceinline__ void stage_rc(int b, int& R, int& C) { const int st = b / 1024, sb = b % 1024, swz = sb ^ (((sb >> 9) & 1) << 5); R = (st >> 1) * 16 + swz / 64; C = (st & 1) * 32 + (swz % 64) / 2; }
__host__ __device__ __forceinline__ int perm32(int rho) { const int n = rho >> 4, i = rho & 15; return 8 * (i >> 2) + 4 * n + (i & 3); }

typedef int i32x8 __attribute__((ext_vector_type(8)));
typedef int i32x4v __attribute__((ext_vector_type(4)));
__device__ __forceinline__ i32x8 cat8(const bf16x8 a, const bf16x8 b) { const i32x4v x = __builtin_bit_cast(i32x4v, a), y = __builtin_bit_cast(i32x4v, b); return __builtin_shufflevector(x, y, 0, 1, 2, 3, 4, 5, 6, 7); }
__device__ __forceinline__ void mfma8(f32x4& acc, const i32x8 a, const i32x8 b, const int sc) {
    asm volatile("s_nop 1\n\tv_mfma_scale_f32_16x16x128_f8f6f4 %0, %1, %2, %0, %3, %3 op_sel_hi:[0,0,0]" : "+v"(acc) : "v"(a), "v"(b), "v"(sc));
}
struct Unit { int pm, pn, e, ui; };

struct StaticOrder {
    int nM, nN, nwg, G, c;
    __device__ void init(int M_, int N_, int G_, int c_) { nM = M_ / BM; nN = N_ / BM; nwg = nM * nN; G = G_; c = c_; }
    __device__ __forceinline__ bool next(int i, Unit& u) const {
        const long L = (long)i * G + c; if (L >= nwg) return false;
        int wgid = (int)L; { const int q = nwg / NXCD, r = nwg % NXCD, xcd = wgid % NXCD, off = wgid / NXCD; wgid = (xcd < r ? xcd * (q + 1) : r * (q + 1) + (xcd - r) * q) + off; }
        const int nig = WGM * nN, gid = wgid / nig, fm = gid * WGM, gsz = (nM - fm) < WGM ? (nM - fm) : WGM;
        u.pm = fm + ((wgid % nig) % gsz); u.pn = (wgid % nig) / gsz; u.e = 0; u.ui = i; return true;
    }
};
struct DynOrder {
    int nM, nN, nwg, x; unsigned* head; volatile LAS unsigned* slot; int tid; unsigned long long mask;
    __device__ void init(int M_, unsigned long long mask_, int nN_, int c_, unsigned* head_, volatile LAS unsigned* slot_, int tid_) { nM = M_ / BM; nN = nN_; mask = mask_; nwg = nM * nN; x = c_ & 7; head = head_; slot = slot_; tid = tid_; }
    __device__ __forceinline__ bool next(int i, Unit& u) const {
        if (tid == 0) slot[i & 1] = __hip_atomic_fetch_add(head, 1u, __ATOMIC_RELAXED, __HIP_MEMORY_SCOPE_AGENT);
        asm volatile("s_waitcnt lgkmcnt(0)" ::: "memory"); __builtin_amdgcn_s_barrier(); asm volatile("" ::: "memory");
        const int j = (int)slot[i & 1], q = nwg / NXCD;
        if (j >= q) return false;
        const int wgid = x * q + j;
        const int nig = WGM * nN, gid = wgid / nig, fm = gid * WGM, gsz = (nM - fm) < WGM ? (nM - fm) : WGM;
        u.pm = fm + ((wgid % nig) % gsz); u.pn = nth_bit(mask, (wgid % nig) / gsz); u.e = 0; u.ui = i; return true;
    }
};
struct MoeOrder {
    int nct, NT, G, c; const volatile LAS int* pref;
    __device__ void init(int nct_, int G_, int c_, const volatile LAS int* pref_) { nct = nct_; G = G_; c = c_; pref = pref_; NT = pref_[NE]; }
    __device__ __forceinline__ bool next(int i, Unit& u) const {
        int rtg, pn;
        if (G == 256) { const int x = c & 7, jj = c >> 3;
            if (nct == 16) { rtg = 16 * i + 8 * (x & 1) + (jj & 7); pn = 4 * (x >> 1) + (jj >> 3); }
            else           { rtg = 32 * i + 8 * (x & 3) + (jj & 7); pn = 4 * (x >> 2) + (jj >> 3); } }
        else { const int U = i * G + c; rtg = U / nct; pn = U - rtg * nct; }
        if (rtg >= NT) return false;
        u.pn = pn; u.pm = rtg; u.ui = i;
        int e = 0;
#pragma unroll 1
        for (int j = 1; j < NE; ++j) e = (pref[j] <= rtg) ? j : e;
        u.e = e; return true;
    }
};

struct GemmDesc { const bf16_t* A; const bf16_t* Bt; int K; int nct; };

template <class Epi, class Sched, bool GATHER, bool ALIGN_EPI, bool FP8>
__device__ __forceinline__ void gemm_phase(LAS unsigned char* lds, const GemmDesc g, const Sched& S, const Epi& E, const LAS int* tok, int wid) {
    const int lane = lane_id(), tid = wid * 64 + lane, wr = wid >> 2, wc = wid & 3, fr = lane & 15, fq = lane >> 4;
    const int K = g.K, KB = FP8 ? K : 2 * K  , nt = FP8 ? K / 128 : K / BK;
    int Rl[2], Cl[2];
    unsigned voffA[2], voffB[2];
#pragma unroll
    for (int i = 0; i < 2; ++i) { int Cc; stage_rc(tid * 16 + i * 8192, Rl[i], Cc); const int p = Cc >> 3; Cl[i] = FP8 ? 16 * (2 * (p & 3) + (p >> 2)) : 2 * Cc; voffA[i] = (unsigned)(Rl[i] * KB + Cl[i]); voffB[i] = voffA[i]; }
    const size_t kstep = (size_t)(BK * 2);
    const size_t hstep = (size_t)HALF * KB;
    const size_t tstep = 2 * hstep;
    const unsigned ldsw = (unsigned)wid * 1024u;
    const int aoff = lds_byte(wr * 64 + fr, fq * 8), boff = lds_byte(wc * 32 + fr, fq * 8);
#define PG8_SA(b, h) (((b) * 2 + (h)) * HTB)
#define PG8_SB(b, h) ((4 + (b) * 2 + (h)) * HTB)
#define PG8_STAGE(bufoff, gbase, voff) do { _Pragma("unroll") for (int _i = 0; _i < 2; ++_i) \
        __builtin_amdgcn_global_load_lds((const unsigned*)((const char*)(gbase) + (voff)[_i]), (LAS unsigned*)(lds + (bufoff) + ldsw + _i * 8192), 16, 0, 0); } while (0)
#define PG8_STAGE_A(bufoff, ptr, half, o0, o1) do { if constexpr (GATHER) { PG8_STAGE(bufoff, ptr, (half) ? o1 : o0); } else { PG8_STAGE(bufoff, (ptr) + (half) * hstep, voffA); } } while (0)
#define PG8_LDA(dst, b, h) do { _Pragma("unroll") for (int m = 0; m < 4; ++m) _Pragma("unroll") for (int k = 0; k < 2; ++k) dst[m][k] = *(const LAS bf16x8*)(lds + PG8_SA(b, h) + aoff + m * 2048 + k * 1024); } while (0)
#define PG8_LDB(dst, b, h) do { _Pragma("unroll") for (int n = 0; n < 2; ++n) _Pragma("unroll") for (int k = 0; k < 2; ++k) dst[n][k] = *(const LAS bf16x8*)(lds + PG8_SB(b, h) + boff + n * 2048 + k * 1024); } while (0)
#define PG8_MMA(ai, bj, At, Bt) do { __builtin_amdgcn_s_setprio(1); _Pragma("unroll") for (int m = 0; m < 4; ++m) _Pragma("unroll") for (int n = 0; n < 2; ++n) _Pragma("unroll") for (int k = 0; k < 2; ++k) \
        acc[ai][bj][m][n] = __builtin_amdgcn_mfma_f32_16x16x32_bf16(Bt[n][k], At[m][k], acc[ai][bj][m][n], 0, 0, 0); __builtin_amdgcn_s_setprio(0); } while (0)
#define PG8_MMA8(ai, bj, At, Bt) do { __builtin_amdgcn_s_setprio(1); _Pragma("unroll") for (int m = 0; m < 4; ++m) _Pragma("unroll") for (int n = 0; n < 2; ++n) \
        mfma8(acc[ai][bj][m][n], cat8(Bt[n][0], Bt[n][1]), cat8(At[m][0], At[m][1]), sc8); __builtin_amdgcn_s_setprio(0); } while (0)
#define PG8_MM(ai, bj, At, Bt) do { if constexpr (FP8) PG8_MMA8(ai, bj, At, Bt); else PG8_MMA(ai, bj, At, Bt); } while (0)
#define PG8_WAIT_V(n) asm volatile("s_waitcnt vmcnt(" #n ")" ::: "memory")
#define PG8_WAIT_L(n) asm volatile("s_waitcnt lgkmcnt(" #n ")" ::: "memory")
#define PG8_BAR __builtin_amdgcn_s_barrier()
#define PG8_SCHED __builtin_amdgcn_sched_barrier(0)
    Unit cur, nxt; int ui = 0;
    if (!S.next(0, cur)) return;
    const int sc8 = 0x7F7F7F7F;
    f32x4 acc[2][2][4][2];
#pragma unroll
    for (int a = 0; a < 2; ++a)
#pragma unroll
        for (int b = 0; b < 2; ++b)
#pragma unroll
            for (int m = 0; m < 4; ++m)
#pragma unroll
                for (int n = 0; n < 2; ++n) acc[a][b][m][n] = (f32x4){0.f, 0.f, 0.f, 0.f};
    bf16x8 At[4][2], B0[2][2], B1[2][2];
    unsigned vA0[2] = {0u, 0u}, vA1[2] = {0u, 0u}, nA0[2] = {0u, 0u}, nA1[2] = {0u, 0u};
    const char* cA; const char* cB = (const char*)g.Bt + (size_t)(cur.e * g.nct + cur.pn) * tstep;
    if constexpr (GATHER) {
        cA = (const char*)g.A;
#pragma unroll
        for (int i = 0; i < 2; ++i) { vA0[i] = (unsigned)(tok[cur.ui * 256 + Rl[i]] * KB + Cl[i]); vA1[i] = (unsigned)(tok[cur.ui * 256 + 128 + Rl[i]] * KB + Cl[i]); nA0[i] = vA0[i]; nA1[i] = vA1[i]; }
    } else cA = (const char*)g.A + (size_t)cur.pm * tstep;
    PG8_STAGE(PG8_SB(0, 0), cB, voffB); PG8_STAGE(PG8_SB(0, 1), cB + hstep, voffB); PG8_STAGE_A(PG8_SA(0, 0), cA, 0, vA0, vA1); PG8_STAGE_A(PG8_SA(0, 1), cA, 1, vA0, vA1);
    if (wr == 1) PG8_BAR;
    PG8_WAIT_V(2); PG8_BAR;
    PG8_STAGE(PG8_SB(1, 0), cB + kstep, voffB); PG8_STAGE_A(PG8_SA(1, 0), cA + kstep, 0, vA0, vA1); PG8_STAGE(PG8_SB(1, 1), cB + hstep + kstep, voffB);
    PG8_WAIT_V(6); PG8_BAR;
    for (;;) {
        const bool has_next = S.next(ui + 1, nxt);
        const char* nAp; const char* nB;
        if (has_next) {
            nB = (const char*)g.Bt + (size_t)(nxt.e * g.nct + nxt.pn) * tstep;
            if constexpr (GATHER) { nAp = cA;
#pragma unroll
                for (int i = 0; i < 2; ++i) { nA0[i] = (unsigned)(tok[nxt.ui * 256 + Rl[i]] * KB + Cl[i]); nA1[i] = (unsigned)(tok[nxt.ui * 256 + 128 + Rl[i]] * KB + Cl[i]); }
            } else nAp = (const char*)g.A + (size_t)nxt.pm * tstep;
        } else { nAp = cA; nB = cB; }
        for (int t = 0; t < nt; t += 2) {
            const bool last = (t == nt - 2);
            const char* a1 = cA + (size_t)(t + 1) * kstep;
            const char* a2 = last ? nAp : cA + (size_t)(t + 2) * kstep; const char* b2 = last ? nB : cB + (size_t)(t + 2) * kstep;
            const char* a3 = a2 + kstep; const char* b3 = b2 + kstep;
            unsigned w0[2] = {0u, 0u}, w1[2] = {0u, 0u};
            if constexpr (GATHER) {
#pragma unroll
                for (int i = 0; i < 2; ++i) { w0[i] = last ? nA0[i] : vA0[i]; w1[i] = last ? nA1[i] : vA1[i]; } }
            if constexpr (Epi::MIDHOOK) { if (t == nt / 2) E.mid(acc, cur, wr, wc, fr, fq); }
            PG8_LDB(B0, 0, 0); PG8_LDB(B1, 0, 1); PG8_SCHED; PG8_LDA(At, 0, 0); PG8_STAGE_A(PG8_SA(1, 1), a1, 1, vA0, vA1);
            PG8_WAIT_V(8); PG8_WAIT_L(0); PG8_BAR; PG8_MM(0, 0, At, B0); PG8_MM(0, 1, At, B1); PG8_BAR; PG8_SCHED;
            PG8_LDA(At, 0, 1); PG8_STAGE(PG8_SB(0, 0), b2, voffB); PG8_STAGE(PG8_SB(0, 1), b2 + hstep, voffB); PG8_STAGE_A(PG8_SA(0, 0), a2, 0, w0, w1);
            PG8_WAIT_V(8); PG8_WAIT_L(0); PG8_BAR; PG8_MM(1, 0, At, B0); PG8_MM(1, 1, At, B1); PG8_BAR; PG8_SCHED;
            PG8_LDB(B0, 1, 0); PG8_LDB(B1, 1, 1); PG8_SCHED; PG8_LDA(At, 1, 0); PG8_STAGE_A(PG8_SA(0, 1), a2, 1, w0, w1);
            PG8_WAIT_V(8); PG8_WAIT_L(0); PG8_BAR; PG8_MM(0, 0, At, B0); PG8_MM(0, 1, At, B1); PG8_BAR; PG8_SCHED;
            PG8_LDA(At, 1, 1); PG8_STAGE(PG8_SB(1, 0), b3, voffB); PG8_STAGE(PG8_SB(1, 1), b3 + hstep, voffB); PG8_STAGE_A(PG8_SA(1, 0), a3, 0, w0, w1);
            PG8_WAIT_V(8); PG8_WAIT_L(0); PG8_BAR; PG8_MM(1, 0, At, B0); PG8_MM(1, 1, At, B1); PG8_BAR; PG8_SCHED;
        }
        if constexpr (ALIGN_EPI) { if (wr == 0) PG8_BAR; }
        E(acc, cur, wr, wc, fr, fq);
        if (!has_next) break;
#pragma unroll
        for (int a = 0; a < 2; ++a)
#pragma unroll
            for (int b = 0; b < 2; ++b)
#pragma unroll
                for (int m = 0; m < 4; ++m)
#pragma unroll
                    for (int n = 0; n < 2; ++n) acc[a][b][m][n] = (f32x4){0.f, 0.f, 0.f, 0.f};
        cur = nxt; cA = nAp; cB = nB; ++ui;
        if constexpr (GATHER) {
#pragma unroll
            for (int i = 0; i < 2; ++i) { vA0[i] = nA0[i]; vA1[i] = nA1[i]; } }
        if constexpr (ALIGN_EPI) { if (wr == 1) PG8_BAR; }
    }
    PG8_WAIT_V(0);
    if constexpr (!ALIGN_EPI) { if (wr == 0) PG8_BAR; }
    PG8_BAR;
#undef PG8_SA
#undef PG8_SB
#undef PG8_STAGE
#undef PG8_STAGE_A
#undef PG8_LDA
#undef PG8_LDB
#undef PG8_MMA
#undef PG8_MMA8
#undef PG8_MM
#undef PG8_WAIT_V
#undef PG8_WAIT_L
#undef PG8_BAR
#undef PG8_SCHED
}
typedef f32x4 Acc[2][2][4][2];
__device__ __forceinline__ float silu_(float x) { return x * __builtin_amdgcn_rcpf(1.f + __expf(-x)); }
__device__ __forceinline__ float sigm_(float x) { return __builtin_amdgcn_rcpf(1.f + __expf(-x)); }
__device__ __forceinline__ u32x4 pack8(const f32x4 a, const f32x4 b) { u32x4 w; w.x = cvt_pk_bf16(a[0], a[1]); w.y = cvt_pk_bf16(a[2], a[3]); w.z = cvt_pk_bf16(b[0], b[1]); w.w = cvt_pk_bf16(b[2], b[3]); return w; }
__device__ __forceinline__ u32x2 pack8_fp8(const f32x4 a, const f32x4 b) { u32x2 w; w.x = pk4_fp8(a[0], a[1], a[2], a[3]); w.y = pk4_fp8(b[0], b[1], b[2], b[3]); return w; }
__device__ __forceinline__ void unpack8(const u32x4 w, f32x4& a, f32x4& b) { a = (f32x4){bflo(w.x), bfhi(w.x), bflo(w.y), bfhi(w.y)}; b = (f32x4){bflo(w.z), bfhi(w.z), bflo(w.w), bfhi(w.w)}; }

struct EpiInproj {
    static constexpr bool MIDHOOK = false;
    const float* rs1; const float* lb; bf16_t *QS, *VV, *GS, *UU, *SBb, *RT, *GBS; h16_t* LF; float osc;
    __device__ __forceinline__ void mid(Acc&, const Unit&, int, int, int, int) const {}
    template <int ACT> __device__ __forceinline__ void plain(const Acc& acc, const float (&rs)[2][4], bf16_t* O, int pt, int row0, int wc, int fq) const {
#pragma unroll
        for (int ai = 0; ai < 2; ++ai)
#pragma unroll
            for (int m = 0; m < 4; ++m) { bf16_t* rowp = O + (size_t)(row0 + ai * HALF + m * 16) * HF + pt * 256 + wc * 32 + 8 * fq; const float r = rs[ai][m];
#pragma unroll
                for (int bj = 0; bj < 2; ++bj) { f32x4 v0 = acc[ai][bj][m][0] * r, v1 = acc[ai][bj][m][1] * r;
                    if (ACT == 1) {
#pragma unroll
                        for (int j = 0; j < 4; ++j) { v0[j] = silu_(v0[j]); v1[j] = silu_(v1[j]); } }
                    *(u32x4*)(rowp + bj * HALF) = pack8(v0, v1); } }
    }
    __device__ __forceinline__ void operator()(const Acc& acc, const Unit& u, int wr, int wc, int fr, int fq) const {
        const int row0 = u.pm * BM + wr * 64 + fr, pn = u.pn;
        float rs[2][4];
#pragma unroll
        for (int ai = 0; ai < 2; ++ai)
#pragma unroll
            for (int m = 0; m < 4; ++m) rs[ai][m] = rs1[row0 + ai * HALF + m * 16] * osc;
        asm volatile("" : "+v"(rs[0][0]), "+v"(rs[0][1]), "+v"(rs[0][2]), "+v"(rs[0][3]), "+v"(rs[1][0]), "+v"(rs[1][1]), "+v"(rs[1][2]), "+v"(rs[1][3]));
        if (pn < 4) plain<1>(acc, rs, QS, pn, row0, wc, fq);
        else if (pn < 8) {
            const int c0 = (pn - 4) * 256 + wc * 32 + 4 * fq;
            f32x4 lbv[2][2];
#pragma unroll
            for (int bj = 0; bj < 2; ++bj)
#pragma unroll
                for (int n = 0; n < 2; ++n) lbv[bj][n] = *(const f32x4*)(lb + c0 + bj * HALF + n * 16);
#pragma unroll
            for (int ai = 0; ai < 2; ++ai)
#pragma unroll
                for (int m = 0; m < 4; ++m) { h16_t* rowp = LF + (size_t)(row0 + ai * HALF + m * 16) * HF + c0; const float r = rs[ai][m];
#pragma unroll
                    for (int bj = 0; bj < 2; ++bj)
#pragma unroll
                        for (int n = 0; n < 2; ++n) { f32x4 v = acc[ai][bj][m][n] * r; const f32x4 l = lbv[bj][n];
#pragma unroll
                            for (int j = 0; j < 4; ++j) v[j] = __logf(l[j] + (1.f - l[j]) * sigm_(v[j]));
                            *(h16x4*)(rowp + bj * HALF + n * 16) = (h16x4){(h16_t)v[0], (h16_t)v[1], (h16_t)v[2], (h16_t)v[3]}; } }
        }
        else if (pn < 12) plain<0>(acc, rs, VV, pn - 8, row0, wc, fq);
        else if (pn < 16) plain<1>(acc, rs, GS, pn - 12, row0, wc, fq);
        else if (pn < 24) {
            const int c0 = (pn - 16) * 128 + wc * 32 + 8 * fq;
#pragma unroll
            for (int ai = 0; ai < 2; ++ai)
#pragma unroll
                for (int m = 0; m < 4; ++m) { const float r2 = rs[ai][m] * rs[ai][m];
                    const f32x4 v0 = acc[ai][0][m][0] * acc[ai][1][m][0] * r2, v1 = acc[ai][0][m][1] * acc[ai][1][m][1] * r2;
                    *(u32x4*)(UU + (size_t)(row0 + ai * HALF + m * 16) * HF + c0) = pack8(v0, v1); }
        }
        else if (pn < 28) plain<0>(acc, rs, SBb, pn - 24, row0, wc, fq);
        else {
            const int c0 = (pn - 28) * 128 + wc * 32 + 8 * fq;
#pragma unroll
            for (int ai = 0; ai < 2; ++ai)
#pragma unroll
                for (int m = 0; m < 4; ++m) { const float r = rs[ai][m]; f32x4 q0, q1, b0, b1;
#pragma unroll
                    for (int j = 0; j < 4; ++j) { const float ea = 1.f + __expf(-acc[ai][0][m][0][j] * r), eb = 1.f + __expf(-acc[ai][1][m][0][j] * r); b0[j] = __builtin_amdgcn_rcpf(eb); q0[j] = eb * __builtin_amdgcn_rcpf(ea);
                                                  const float fa = 1.f + __expf(-acc[ai][0][m][1][j] * r), fb = 1.f + __expf(-acc[ai][1][m][1][j] * r); b1[j] = __builtin_amdgcn_rcpf(fb); q1[j] = fb * __builtin_amdgcn_rcpf(fa); }
                    const size_t o = (size_t)(row0 + ai * HALF + m * 16) * D + c0;
                    *(u32x4*)(RT + o) = pack8(q0, q1); *(u32x4*)(GBS + o) = pack8(b0, b1); }
        }
    }
};

struct EpiMerge {
    static constexpr bool MIDHOOK = true;
    const bf16_t *RT, *GBS; bf16_t* MG;
    __device__ __forceinline__ void mid(Acc& acc, const Unit& u, int wr, int wc, int fr, int fq) const {
        unsigned o0 = ((unsigned)(u.pm * BM + wr * 64 + fr) * D + (unsigned)(u.pn * BM + wc * 32 + 8 * fq)) * 2u;
        asm volatile("" : "+v"(o0));
#pragma unroll
        for (int ai = 0; ai < 2; ++ai)
#pragma unroll
            for (int m = 0; m < 4; ++m)
#pragma unroll
                for (int bj = 0; bj < 2; ++bj) { const u32x4 w = *(const GAS u32x4*)((const GAS char*)RT + (o0 + (unsigned)((ai * HALF + m * 16) * D + bj * HALF) * 2u)); f32x4 a, b; unpack8(w, a, b);
                    acc[ai][bj][m][0] *= a; acc[ai][bj][m][1] *= b; }
    }
    __device__ __forceinline__ void operator()(const Acc& acc, const Unit& u, int wr, int wc, int fr, int fq) const {
        unsigned o0 = ((unsigned)(u.pm * BM + wr * 64 + fr) * D + (unsigned)(u.pn * BM + wc * 32 + 8 * fq)) * 2u;
        asm volatile("" : "+v"(o0));
#pragma unroll
        for (int ai = 0; ai < 2; ++ai)
#pragma unroll
            for (int m = 0; m < 4; ++m)
#pragma unroll
                for (int bj = 0; bj < 2; ++bj) { const unsigned o = o0 + (unsigned)((ai * HALF + m * 16) * D + bj * HALF) * 2u; const u32x4 w = *(const GAS u32x4*)((const GAS char*)GBS + o); f32x4 a, b; unpack8(w, a, b);
                    *(GAS u32x4*)((GAS char*)MG + o) = pack8(acc[ai][bj][m][0] * a, acc[ai][bj][m][1] * b); if (bj == 1 && m == 3) asm volatile("" ::: "memory"); }
    }
};

struct EpiWo {
    static constexpr bool MIDHOOK = false;
    bf16_t* DL;
    __device__ __forceinline__ void mid(Acc&, const Unit&, int, int, int, int) const {}
    __device__ __forceinline__ void operator()(const Acc& acc, const Unit& u, int wr, int wc, int fr, int fq) const {
        const int row0 = u.pm * BM + wr * 64 + fr, c0 = u.pn * BM + wc * 32 + 8 * fq;
#pragma unroll
        for (int ai = 0; ai < 2; ++ai)
#pragma unroll
            for (int m = 0; m < 4; ++m)
#pragma unroll
                for (int bj = 0; bj < 2; ++bj) *(u32x4*)(DL + (size_t)(row0 + ai * HALF + m * 16) * D + c0 + bj * HALF) = pack8(acc[ai][bj][m][0], acc[ai][bj][m][1]);
    }
};

struct EpiUp {
    static constexpr bool MIDHOOK = false;
    const float* rs2; const LAS int* tok; const float* b_up; unsigned char* ACT;
    __device__ __forceinline__ void mid(Acc&, const Unit&, int, int, int, int) const {}
    __device__ __forceinline__ void operator()(const Acc& acc, const Unit& u, int wr, int wc, int fr, int fq) const {
        const int rl0 = wr * 64 + fr, c0 = u.pn * 128 + wc * 32 + 8 * fq;
        float rs[2][4];
#pragma unroll
        for (int ai = 0; ai < 2; ++ai)
#pragma unroll
            for (int m = 0; m < 4; ++m) rs[ai][m] = rs2[tok[u.ui * 256 + rl0 + ai * HALF + m * 16]] * W8_INV;
        const float* bp = b_up + (size_t)u.e * 4096 + c0;
        const f32x4 bg0 = *(const f32x4*)(bp), bg1 = *(const f32x4*)(bp + 4), bu0 = *(const f32x4*)(bp + 2048), bu1 = *(const f32x4*)(bp + 2052);
#pragma unroll
        for (int ai = 0; ai < 2; ++ai)
#pragma unroll
            for (int m = 0; m < 4; ++m) { const float r = rs[ai][m]; f32x4 a0, a1;
#pragma unroll
                for (int n = 0; n < 2; ++n)
#pragma unroll
                    for (int jp = 0; jp < 2; ++jp) {
                        const f32x4 ag = acc[ai][0][m][n], au = acc[ai][1][m][n], bgv = n ? bg1 : bg0, buv = n ? bu1 : bu0;
                        f32x2 g = (f32x2){ag[2 * jp], ag[2 * jp + 1]} * r + (f32x2){bgv[2 * jp], bgv[2 * jp + 1]};
                        f32x2 uu = (f32x2){au[2 * jp], au[2 * jp + 1]} * r + (f32x2){buv[2 * jp], buv[2 * jp + 1]};
                        g.x = fminf(g.x, 7.f); g.y = fminf(g.y, 7.f);
                        uu.x = __builtin_amdgcn_fmed3f(uu.x, -7.f, 7.f); uu.y = __builtin_amdgcn_fmed3f(uu.y, -7.f, 7.f);
                        const f32x2 t = g * (-1.702f * 1.44269504f);
                        f32x2 den; den.x = __builtin_amdgcn_exp2f(t.x); den.y = __builtin_amdgcn_exp2f(t.y); den = den + 1.f;
                        f32x2 s; s.x = __builtin_amdgcn_rcpf(den.x); s.y = __builtin_amdgcn_rcpf(den.y);
                        const f32x2 a = (uu + 1.f) * (g * s);
                        if (n == 0) { a0[2 * jp] = a.x; a0[2 * jp + 1] = a.y; } else { a1[2 * jp] = a.x; a1[2 * jp + 1] = a.y; }
                    }
                *(u32x2*)(ACT + (size_t)(u.pm * BM + rl0 + ai * HALF + m * 16) * DFF + c0) = pack8_fp8(a0, a1); }
    }
};

struct EpiDown {
    static constexpr bool MIDHOOK = false;
    const float* b_dn; unsigned char* YR;
    __device__ __forceinline__ void mid(Acc&, const Unit&, int, int, int, int) const {}
    __device__ __forceinline__ void operator()(const Acc& acc, const Unit& u, int wr, int wc, int fr, int fq) const {
        const int rl0 = wr * 64 + fr, c0 = u.pn * BM + wc * 32 + 8 * fq;
        const float* bp = b_dn + (size_t)u.e * D + c0;
        f32x4 bv[2][2];
#pragma unroll
        for (int bj = 0; bj < 2; ++bj)
#pragma unroll
            for (int n = 0; n < 2; ++n) bv[bj][n] = *(const f32x4*)(bp + bj * HALF + 4 * n);
#pragma unroll
        for (int ai = 0; ai < 2; ++ai)
#pragma unroll
            for (int m = 0; m < 4; ++m)
#pragma unroll
                for (int bj = 0; bj < 2; ++bj)
                    *(u32x2*)(YR + (size_t)(u.pm * BM + rl0 + ai * HALF + m * 16) * D + c0 + bj * HALF) = pack8_fp8(acc[ai][bj][m][0] * W8_INV + bv[bj][0], acc[ai][bj][m][1] * W8_INV + bv[bj][1]);
    }
};

struct EpiDummy {
    static constexpr bool MIDHOOK = false;
    bf16_t* O; int nostore;
    __device__ __forceinline__ void mid(Acc&, const Unit&, int, int, int, int) const {}
    __device__ __forceinline__ void operator()(const Acc& acc, const Unit& u, int wr, int wc, int fr, int fq) const {
        const int row0 = (u.pm & 63) * BM + wr * 64 + fr, c0 = (u.pn & 7) * BM + wc * 32 + 8 * fq;
        if (nostore) {
#pragma unroll
            for (int ai = 0; ai < 2; ++ai)
#pragma unroll
                for (int m = 0; m < 4; ++m)
#pragma unroll
                    for (int bj = 0; bj < 2; ++bj) asm volatile("" :: "v"(acc[ai][bj][m][0]), "v"(acc[ai][bj][m][1]));
            return; }
#pragma unroll
        for (int ai = 0; ai < 2; ++ai)
#pragma unroll
            for (int m = 0; m < 4; ++m)
#pragma unroll
                for (int bj = 0; bj < 2; ++bj) *(u32x4*)(O + (size_t)(row0 + ai * HALF + m * 16) * D + c0 + bj * HALF) = pack8(acc[ai][bj][m][0], acc[ai][bj][m][1]);
    }
};
struct ProbeOrder {
    StaticOrder S; int mode, c;
    __device__ __forceinline__ bool next(int i, Unit& u) const {
        if (mode == 3) { if (c & 1) return false; StaticOrder H = S; H.G = S.G / 2; H.c = c >> 1; H.nwg = S.nwg / 2; return H.next(i, u); }
        if (!S.next(i, u)) return false; if (mode >= 1) u.pn = 0; if (mode >= 2) u.pm = c & 63; return true; }
};

struct ProbeMoe {
    MoeOrder S; int mode;
    __device__ __forceinline__ bool next(int i, Unit& u) const { if (!S.next(i, u)) return false; if (mode & 1) { u.e = 0; u.pn = 0; } if (mode & 2) u.pm = 0; return true; }
};
struct Frame {
    LAS unsigned char* lds; volatile LAS unsigned* MISC; gu32* ctl; unsigned char* ws;
    int tid, lane, wave, vcu, G;
    const float *x, *meta, *nmw, *w_in, *lbl, *gnw, *w_ho, *cw, *w_co, *w_o, *nfw, *w_r, *b_r, *w_up, *b_up, *w_dn, *b_dn, *fnw; float* out;
};
template <class T> __device__ __forceinline__ T* wsp(const Frame& F, size_t off) { return (T*)(F.ws + off); }

__device__ __forceinline__ void tr_tile(const float* W, int ldw, int k0, int src0, int src1, bool perm0, bool perm1, const float* kscale, bf16_t* dst, int dpitch, int drow0, int dk0, LAS unsigned* T, int lane) {
    const int ln = lane & 15, kr = lane >> 4, srcc = (ln < 8 ? src0 : src1) + 4 * (ln & 7);
    const float* wp = W + (size_t)(k0 + 2 * kr) * ldw + srcc;
    f32x4 va[8], vb[8]; f32x2 sc[8];
#pragma unroll
    for (int s = 0; s < 8; ++s) { va[s] = __builtin_nontemporal_load((const GAS f32x4*)(wp + (size_t)(8 * s) * ldw)); vb[s] = __builtin_nontemporal_load((const GAS f32x4*)(wp + (size_t)(8 * s + 1) * ldw));
        sc[s] = kscale ? *(const GAS f32x2*)(kscale + k0 + 8 * s + 2 * kr) : (f32x2){1.f, 1.f}; }
    __builtin_amdgcn_sched_barrier(0);
#pragma unroll
    for (int s = 0; s < 8; ++s) { const int col = (4 * s + kr) ^ (2 * ln);
#pragma unroll
        for (int i = 0; i < 4; ++i) T[(4 * ln + i) * 32 + col] = cvt_pk_bf16(va[s][i] * sc[s].x, vb[s][i] * sc[s].y); }
    LDS_WAIT(); asm volatile("" ::: "memory");
    const int c = lane & 7;
#pragma unroll
    for (int j = 0; j < 8; ++j) { const int rho = (lane >> 3) + 8 * j, h = rho >> 5, r32 = rho & 31; const bool pm = h ? perm1 : perm0; const int n = h * 32 + (pm ? perm32(r32) : r32);
        u32x4 v = *(const LAS u32x4*)(T + n * 32 + 4 * (c ^ (n >> 3)));
        if ((n >> 2) & 1) v = (u32x4){v.z, v.w, v.x, v.y};
        *(GAS u32x4*)(dst + (size_t)(drow0 + rho) * dpitch + dk0 + k0 + 8 * c) = v; }
    LDS_WAIT(); asm volatile("" ::: "memory");
}
template <int PMODE = 0> __device__ __forceinline__ void tr_tile_fp8(const float* W, int ldw, int k0, int src0, int src1, const float* kscale, unsigned char* dst, int dpitch, int drow0, LAS unsigned* T, int lane, bool perm = true) {
    const int ln = lane & 15, kr = lane >> 4, srcc = (ln < 8 ? src0 : src1) + 4 * (ln & 7);
    f32x4 v[2][4][4];
#pragma unroll
    for (int half = 0; half < 2; ++half) {
        const float* wp = W + (size_t)(k0 + 64 * half + 4 * kr) * ldw + srcc;
#pragma unroll
        for (int s = 0; s < 4; ++s) {
#pragma unroll
            for (int q = 0; q < 4; ++q) v[half][s][q] = __builtin_nontemporal_load((const GAS f32x4*)(wp + (size_t)(16 * s + q) * ldw)); }
    }
    __builtin_amdgcn_sched_barrier(0);
    if (PMODE == 1) {
#pragma unroll
        for (int half = 0; half < 2; ++half)
#pragma unroll
            for (int s = 0; s < 4; ++s)
#pragma unroll
                for (int q = 0; q < 4; ++q) asm volatile("" :: "v"(v[half][s][q]));
        return; }
#pragma unroll
    for (int half = 0; half < 2; ++half)
#pragma unroll
        for (int s = 0; s < 4; ++s) { const int col = (16 * half + 4 * s + kr) ^ (2 * ln);
            const f32x4 sc = kscale ? *(const GAS f32x4*)(kscale + k0 + 64 * half + 16 * s + 4 * kr) * W8_SCALE : (f32x4){W8_SCALE, W8_SCALE, W8_SCALE, W8_SCALE};
#pragma unroll
            for (int i = 0; i < 4; ++i) T[(4 * ln + i) * 32 + col] = pk4_fp8(v[half][s][0][i] * sc[0], v[half][s][1][i] * sc[1], v[half][s][2][i] * sc[2], v[half][s][3][i] * sc[3]); }
    LDS_WAIT(); asm volatile("" ::: "memory");
    const int c = lane & 7;
#pragma unroll
    for (int j = 0; j < 8; ++j) { const int rho = (lane >> 3) + 8 * j, h = rho >> 5, r32 = rho & 31; const int n = h * 32 + (perm ? perm32(r32) : r32);
        u32x4 v4 = *(const LAS u32x4*)(T + n * 32 + 4 * (c ^ (n >> 3)));
        if ((n >> 2) & 1) v4 = (u32x4){v4.z, v4.w, v4.x, v4.y};
        if (PMODE == 2) asm volatile("" :: "v"(v4)); else *(GAS u32x4*)(dst + (size_t)(drow0 + rho) * dpitch + k0 + 16 * c) = v4; }
    LDS_WAIT(); asm volatile("" ::: "memory");
}
__device__ __forceinline__ int win_src(int G, bool& perm) {
    const int pn = G >> 3, gi = G & 7; perm = true;
    if (pn < 4) return C_Q + pn * 256 + gi * 32;
    if (pn < 8) { perm = false; return C_F + (pn - 4) * 256 + gi * 32; }
    if (pn < 12) return C_V + (pn - 8) * 256 + gi * 32;
    if (pn < 16) return C_G + (pn - 12) * 256 + gi * 32;
    if (pn < 24) return (gi < 4 ? C_SV : C_SC) + (pn - 16) * 128 + (gi & 3) * 32;
    if (pn < 28) return C_SB + (pn - 24) * 256 + gi * 32;
    return (gi < 4 ? C_GA : C_GB) + (pn - 28) * 128 + (gi & 3) * 32;
}
__device__ __forceinline__ void p0_prologue(Frame& F) {
    const int gw = F.vcu * NWAVES + F.wave, NGW = F.G * NWAVES, gt = F.vcu * NTHR + F.tid, NGT = F.G * NTHR;
    for (int i = gt; i < HF; i += NGT) wsp<float>(F, WS_LB)[i] = 1.f / (1.f + __expf(F.lbl[HF + i] - F.lbl[i]));
    for (int i = gt; i < D * NE; i += NGT) { const int k = i >> 5, e = i & 31; const float v = F.w_r[i] * F.nfw[k]; const unsigned h = f2bf(v); const float lo = v - bf2f((unsigned short)h);
        wsp<bf16_t>(F, WS_WRH)[e * D + k] = (bf16_t)h; wsp<bf16_t>(F, WS_WRL)[e * D + k] = (bf16_t)f2bf(lo); }
    for (int i = gt; i < 48 * HF; i += NGT) { wsp<h16_t>(F, WS_LFM)[i] = (h16_t)0.f; wsp<bf16_t>(F, WS_VVM)[i] = 0; }
    {
        LAS float* hnm = (LAS float*)F.lds;
        for (int r = F.wave * 2; r < F.wave * 2 + 2; ++r) {
            const f32x4* xr = (const f32x4*)(F.meta + (size_t)r * D) + F.lane; f32x4 v[8]; float s = 0.f;
#pragma unroll
            for (int j = 0; j < 8; ++j) { v[j] = xr[64 * j]; s += (v[j].x * v[j].x + v[j].y * v[j].y) + (v[j].z * v[j].z + v[j].w * v[j].w); }
            const float rs = rsqrtf(wave_sum(s) * (1.f / D) + EPS);
#pragma unroll
            for (int j = 0; j < 8; ++j) { const f32x4 w = ((const f32x4*)F.nmw)[F.lane + 64 * j]; *(LAS f32x4*)(hnm + r * D + 4 * F.lane + 256 * j) = v[j] * rs * w; }
        }
        __syncthreads();
        LAS float* red = (LAS float*)(F.lds + TOK_OFF);
        for (int cb = F.vcu; cb < 256; cb += F.G) {
            const int col = F.tid & 15, ks = F.tid >> 4;
            int gcol;
            if (cb < 64) gcol = C_F + 16 * cb + col; else if (cb < 128) gcol = C_V + 16 * (cb - 64) + col; else gcol = (col < 8 ? C_SV : C_SC) + 8 * (cb - 128) + (col & 7);
            float a[16];
#pragma unroll
            for (int r = 0; r < 16; ++r) a[r] = 0.f;
            for (int k = ks * 64; k < ks * 64 + 64; ++k) { const float w = F.w_in[(size_t)k * INC + gcol];
#pragma unroll
                for (int r = 0; r < 16; ++r) a[r] = fmaf(hnm[r * D + k], w, a[r]); }
#pragma unroll
            for (int r = 0; r < 16; ++r) { a[r] += __shfl_xor(a[r], 16); a[r] += __shfl_xor(a[r], 32); }
            if (F.lane < 16) {
#pragma unroll
                for (int r = 0; r < 16; ++r) red[(F.wave * 16 + r) * 16 + col] = a[r]; }
            __syncthreads();
            if (F.tid < 256) { const int r = F.tid >> 4, c = F.tid & 15; float v = 0.f;
#pragma unroll
                for (int w = 0; w < 8; ++w) v += red[(w * 16 + r) * 16 + c];
                if (cb < 64) { const int ch = 16 * cb + c; const float l = 1.f / (1.f + __expf(F.lbl[HF + ch] - F.lbl[ch])); wsp<h16_t>(F, WS_LFM)[(48 + r) * HF + ch] = (h16_t)__logf(l + (1.f - l) * sigmoidf_(v)); }
                else if (cb < 128) wsp<bf16_t>(F, WS_VVM)[(48 + r) * HF + 16 * (cb - 64) + c] = (bf16_t)f2bf(v);
                else red[2048 + r * 16 + c] = v; }
            __syncthreads();
            if (cb >= 128 && F.tid < 128) { const int r = F.tid >> 3, c = F.tid & 7; wsp<bf16_t>(F, WS_UUM)[r * HF + 8 * (cb - 128) + c] = (bf16_t)f2bf(red[2048 + r * 16 + c] * red[2048 + r * 16 + c + 8]); }
            __syncthreads();
        }
        __syncthreads();
    }
    {
        LAS unsigned* T = (LAS unsigned*)(F.lds + F.wave * 16384);
        constexpr int I_IN = 32 * 4 * N_INB, I_AB = 16 * 32, I_O = 32 * 32, I_UP1 = 16 * 64, I_DN1 = 16 * 32;
        constexpr int I_IN8 = 16 * 4 * N_IN8;
        constexpr int NIT = I_IN + I_IN8 + 2 * I_AB + I_O;
        for (int it = gw; it < NIT; it += NGW) {
            int r = it;
            if (r < I_IN) { const int kb = r / (4 * N_INB), ntl = r % (4 * N_INB), nt = 4 * nth_bit(INB_MASK, ntl >> 2) + (ntl & 3); bool p0, p1; const int s0 = win_src(2 * nt, p0), s1 = win_src(2 * nt + 1, p1); tr_tile(F.w_in, INC, kb * 64, s0, s1, p0, p1, F.nmw, wsp<bf16_t>(F, WS_WIN), D, nt * 64, 0, T, F.lane); continue; } r -= I_IN;
            if (r < I_IN8) { const int kb = r / (4 * N_IN8), ntl = r % (4 * N_IN8), nt = 4 * nth_bit(IN8_MASK, ntl >> 2) + (ntl & 3); bool p0, p1; const int s0 = win_src(2 * nt, p0), s1 = win_src(2 * nt + 1, p1);
                tr_tile_fp8<0>(F.w_in, INC, kb * 128, s0, s1, F.nmw, wsp<unsigned char>(F, WS_WIN8), D, nt * 64, T, F.lane, p0); continue; } r -= I_IN8;
            if (r < I_AB) { const int kb = r / 32, nt = r % 32; tr_tile(F.w_ho, D, kb * 64, nt * 64, nt * 64 + 32, true, true, nullptr, wsp<bf16_t>(F, WS_WAB), D, nt * 64, 0, T, F.lane); continue; } r -= I_AB;
            if (r < I_AB) { const int kb = r / 32, nt = r % 32; tr_tile(F.w_co, D, kb * 64, nt * 64, nt * 64 + 32, true, true, nullptr, wsp<bf16_t>(F, WS_WAB), D, nt * 64, HF, T, F.lane); continue; } r -= I_AB;
            if (r < I_O) { const int kb = r / 32, nt = r % 32; tr_tile(F.w_o, D, kb * 64, nt * 64, nt * 64 + 32, true, true, nullptr, wsp<bf16_t>(F, WS_WO), D, nt * 64, 0, T, F.lane); continue; } r -= I_O;
        }
    }
    for (int m = gw; m < M; m += NGW) {
        const GAS f32x4* xr = (const GAS f32x4*)(F.x + (size_t)m * D) + F.lane; f32x4 v[8]; float s = 0.f;
#pragma unroll
        for (int j = 0; j < 8; ++j) v[j] = xr[64 * j];
        __builtin_amdgcn_sched_barrier(0);
#pragma unroll
        for (int j = 0; j < 8; ++j) s += (v[j].x * v[j].x + v[j].y * v[j].y) + (v[j].z * v[j].z + v[j].w * v[j].w);
        s = wave_sum(s);
        GAS u32x2* o8 = (GAS u32x2*)(wsp<bf16_t>(F, WS_XB) + (size_t)m * D) + F.lane;
#pragma unroll
        for (int j = 0; j < 8; ++j) { u32x2 w; w.x = pk2(v[j].x, v[j].y); w.y = pk2(v[j].z, v[j].w); o8[64 * j] = w; }
        GAS unsigned* o4 = (GAS unsigned*)(wsp<unsigned char>(F, WS_XB8) + (size_t)m * D) + F.lane;
#pragma unroll
        for (int j = 0; j < 8; ++j) o4[64 * j] = pk4_fp8(v[j].x, v[j].y, v[j].z, v[j].w);
        if (F.lane == 0) wsp<float>(F, WS_RS1)[m] = rsqrtf(s * (1.f / D) + EPS);
    }
}

template <int PMODE = 0> __device__ __forceinline__ void p1_convert(Frame& F, int rank, int nconv) {
    LAS unsigned* T = (LAS unsigned*)(F.lds + F.wave * 16384);
    constexpr int I_UP1 = 16 * 64, I_DN1 = 16 * 32, NIT = NE * (I_UP1 + I_DN1);
    for (int it = rank * NWAVES + F.wave; it < NIT; it += nconv * NWAVES) {
        int r = it;
        if (r < NE * I_UP1) { const int e = r / I_UP1, q = r % I_UP1, kb = q / 64, nt = q % 64, G0 = 2 * nt, pn = G0 >> 3, gi = G0 & 7; const int s0 = (gi < 4 ? 0 : 2048) + pn * 128 + (gi & 3) * 32;
            tr_tile_fp8<PMODE>(F.w_up + (size_t)e * D * 4096, 4096, kb * 128, s0, s0 + 32, F.nfw, wsp<unsigned char>(F, WS_WUP) + (size_t)e * 4096 * D, D, nt * 64, T, F.lane); continue; } r -= NE * I_UP1;
        { const int e = r / I_DN1, q = r % I_DN1, kb = q / 32, nt = q % 32;
          tr_tile_fp8<PMODE>(F.w_dn + (size_t)e * DFF * D, D, kb * 128, nt * 64, nt * 64 + 32, nullptr, wsp<unsigned char>(F, WS_WDN) + (size_t)e * D * DFF, DFF, nt * 64, T, F.lane); }
    }
}

constexpr int KTP = 72;
constexpr int QP_ = 136;
__device__ __forceinline__ void vt_load(const Frame& F, const bf16_t* Vb, size_t row0, int h, u32x4 (&w)[2]) {
#pragma unroll
    for (int q = 0; q < 2; ++q) { const int id = F.tid + 512 * q, t = id >> 4, v8 = (id & 15) * 8; w[q] = *(const GAS u32x4*)(Vb + (row0 + t) * HF + h * 128 + v8); }
}
__device__ __forceinline__ void vt_store(const Frame& F, const u32x4 (&w)[2], LAS bf16_t* VT) {
#pragma unroll
    for (int q = 0; q < 2; ++q) { const int id = F.tid + 512 * q, t = id >> 4, v8 = (id & 15) * 8; const unsigned ww[4] = {w[q].x, w[q].y, w[q].z, w[q].w};
        const int ts = t ^ (v8 & 24);
#pragma unroll
        for (int i = 0; i < 4; ++i) { VT[(v8 + 2 * i) * KTP + ts] = (bf16_t)(ww[i] & 0xffffu); VT[(v8 + 2 * i + 1) * KTP + ts] = (bf16_t)(ww[i] >> 16); } }
}
__device__ __forceinline__ int vt_off(int v, int t0) { return v * KTP + (t0 ^ (v & 24)); }
struct P2aRegs { float L[16]; u32x4 vw[2]; };
__device__ __forceinline__ void p2a_where(const Frame& F, int u, const h16_t*& Lb, const bf16_t*& Vb, size_t& row0, int& h, int& slot) {
    if (u < 8) { Lb = wsp<h16_t>(F, WS_LFM); Vb = wsp<bf16_t>(F, WS_VVM); row0 = 0; h = u; slot = 32 * 64 + u; }
    else { const int bh = (u - 8) >> 6, c = (u - 8) & 63, b = bh >> 3; h = bh & 7; Lb = wsp<h16_t>(F, WS_LF); Vb = wsp<bf16_t>(F, WS_VV); row0 = (size_t)b * SEQ + 64 * c; slot = bh * 64 + c; }
}
__device__ __forceinline__ void p2a_load(const Frame& F, int u, P2aRegs& R) {
    const h16_t* Lb; const bf16_t* Vb; size_t row0; int h, slot; p2a_where(F, u, Lb, Vb, row0, h, slot);
    const int d = F.tid & 127, tq = F.tid >> 7;
#pragma unroll
    for (int i = 0; i < 16; ++i) R.L[i] = (float)Lb[(row0 + 16 * tq + i) * HF + h * 128 + d];
    vt_load(F, Vb, row0, h, R.vw);
}
__device__ __forceinline__ void p2a_compute(Frame& F, int u, const P2aRegs& R) {
    LAS bf16_t* KT = (LAS bf16_t*)F.lds; LAS bf16_t* VT = KT + 128 * KTP; LAS float* TOT = (LAS float*)(F.lds + 2 * 128 * KTP * 2);
    const h16_t* Lb; const bf16_t* Vb; size_t row0; int h, slot; p2a_where(F, u, Lb, Vb, row0, h, slot);
    const int d = F.tid & 127, tq = F.tid >> 7;
    float cs[16]; float run = 0.f;
#pragma unroll
    for (int i = 0; i < 16; ++i) { run += R.L[i]; cs[i] = run; }
    TOT[tq * 128 + d] = run;
    vt_store(F, R.vw, VT);
    __syncthreads();
    float off = 0.f, total = 0.f;
#pragma unroll
    for (int q = 0; q < 4; ++q) { const float tv = TOT[q * 128 + d]; total += tv; if (q < tq) off += tv; }
#pragma unroll
    for (int i = 0; i < 16; i += 2) { const float k0 = (1.f - __expf(R.L[i])) * __expf(total - off - cs[i]), k1 = (1.f - __expf(R.L[i + 1])) * __expf(total - off - cs[i + 1]);
        *(LAS unsigned*)(KT + d * KTP + 16 * tq + i) = pk2(k0, k1); }
    if (tq == 0) wsp<float>(F, WS_DEC)[(size_t)slot * 128 + d] = __expf(total);
    __syncthreads();
    {
        const int w = F.wave, fr = F.lane & 15, fq = F.lane >> 4;
        bf16x8 a[2];
#pragma unroll
        for (int ks = 0; ks < 2; ++ks) a[ks] = *(const LAS bf16x8*)(KT + (16 * w + fr) * KTP + 32 * ks + 8 * fq);
        bf16_t* Ub = wsp<bf16_t>(F, WS_UC) + (size_t)slot * 16384;
#pragma unroll
        for (int vb = 0; vb < 8; ++vb) { f32x4 c = (f32x4){0.f, 0.f, 0.f, 0.f};
#pragma unroll
            for (int ks = 0; ks < 2; ++ks) { const bf16x8 bv = *(const LAS bf16x8*)(VT + vt_off(16 * vb + fr, 32 * ks + 8 * fq)); c = __builtin_amdgcn_mfma_f32_16x16x32_bf16(a[ks], bv, c, 0, 0, 0); }
            u32x2 o; o.x = pk2(c[0], c[1]); o.y = pk2(c[2], c[3]);
            *(GAS u32x2*)(Ub + (16 * vb + fr) * 128 + 16 * w + 4 * fq) = o; }
    }
    __syncthreads();
}
__device__ __forceinline__ void p2a_units(Frame& F, int c) {
    constexpr int NU = 2048 + 8;
    if (c >= NU) return;
    P2aRegs R; p2a_load(F, c, R);
    for (int u = c; u < NU; u += F.G) {
        P2aRegs N; const int un = u + F.G; if (un < NU) p2a_load(F, un, N); else N = R;
        p2a_compute(F, u, R);
        R = N;
    }
}
__device__ __forceinline__ void p2a_conv(Frame& F, int item) {
    const int c8 = (F.tid & 127) * 8, tq = F.tid >> 7, r0 = item * 64 + tq * 16, p0 = r0 & (SEQ - 1);
    const bf16_t* UU = wsp<bf16_t>(F, WS_UU); const bf16_t* UUM = wsp<bf16_t>(F, WS_UUM); const bf16_t* SBb = wsp<bf16_t>(F, WS_SB); bf16_t* A2 = wsp<bf16_t>(F, WS_A2);
    f32x4 w0a = *(const f32x4*)(F.cw + c8), w0b = *(const f32x4*)(F.cw + c8 + 4), w1a = *(const f32x4*)(F.cw + HF + c8), w1b = *(const f32x4*)(F.cw + HF + c8 + 4), w2a = *(const f32x4*)(F.cw + 2 * HF + c8), w2b = *(const f32x4*)(F.cw + 2 * HF + c8 + 4);
    f32x4 um2a, um2b, um1a, um1b;
    { const u32x4 a = (p0 >= 2) ? *(const GAS u32x4*)(UU + (size_t)(r0 - 2) * HF + c8) : *(const GAS u32x4*)(UUM + (14 + p0) * HF + c8); unpack8(a, um2a, um2b);
      const u32x4 b = (p0 >= 1) ? *(const GAS u32x4*)(UU + (size_t)(r0 - 1) * HF + c8) : *(const GAS u32x4*)(UUM + 15 * HF + c8); unpack8(b, um1a, um1b); }
#pragma unroll 4
    for (int i = 0; i < 16; ++i) { f32x4 ua, ub, sa, sb; unpack8(*(const GAS u32x4*)(UU + (size_t)(r0 + i) * HF + c8), ua, ub); unpack8(*(const GAS u32x4*)(SBb + (size_t)(r0 + i) * HF + c8), sa, sb);
        const f32x4 oa = sa * (w0a * um2a + w1a * um1a + w2a * ua), ob = sb * (w0b * um2b + w1b * um1b + w2b * ub);
        *(GAS u32x4*)(A2 + (size_t)(r0 + i) * D + HF + c8) = pack8(oa, ob);
        um2a = um1a; um2b = um1b; um1a = ua; um1b = ub; }
}
__device__ __forceinline__ void p2b_scan(Frame& F) {
    const int gw = F.vcu * NWAVES + F.wave;
    for (int it = gw; it < 1024; it += F.G * NWAVES) {
        const int item = it * 64 + F.lane, bh = item >> 11, e8 = item & 2047, h = bh & 7, d0 = (e8 & 15) * 8;
        const bf16_t* Ub = wsp<bf16_t>(F, WS_UC) + (size_t)bh * 64 * 16384 + e8 * 8; bf16_t* Sb = wsp<bf16_t>(F, WS_SS) + (size_t)bh * 64 * 16384 + e8 * 8;
        const float* Db = wsp<float>(F, WS_DEC) + (size_t)bh * 64 * 128 + d0;
        f32x4 s0, s1; unpack8(*(const GAS u32x4*)(wsp<bf16_t>(F, WS_UC) + (size_t)(32 * 64 + h) * 16384 + e8 * 8), s0, s1);
#pragma unroll 8
        for (int c = 0; c < 64; ++c) {
            *(GAS u32x4*)(Sb + (size_t)c * 16384) = pack8(s0, s1);
            f32x4 u0, u1; unpack8(*(const GAS u32x4*)(Ub + (size_t)c * 16384), u0, u1);
            const f32x4 g0 = *(const GAS f32x4*)(Db + c * 128), g1 = *(const GAS f32x4*)(Db + c * 128 + 4);
            s0 = g0 * s0 + u0; s1 = g1 * s1 + u1;
        }
    }
}
struct P2cRegs { f32x2 L[8]; unsigned qw[8]; u32x4 vw[2]; bf16x8 sa[4]; u32x2 gv[4]; };
__device__ __forceinline__ void p2c_load(const Frame& F, int u, P2cRegs& R) {
    const int bh = u >> 6, c = u & 63, b = bh >> 3, h = bh & 7; const size_t row0 = (size_t)b * SEQ + 64 * c;
    const int dp = (F.tid & 63) * 2, t8 = F.tid >> 6, w = F.wave, fr = F.lane & 15, fq = F.lane >> 4;
    const h16_t* Lb = wsp<h16_t>(F, WS_LF) + (row0 + 8 * t8) * HF + h * 128 + dp; const bf16_t* Qb = wsp<bf16_t>(F, WS_QS) + (row0 + 8 * t8) * HF + h * 128 + dp;
#pragma unroll
    for (int i = 0; i < 8; ++i) { const h16x2 lh = *(const GAS h16x2*)(Lb + (size_t)i * HF); R.L[i] = (f32x2){(float)lh.x, (float)lh.y}; R.qw[i] = *(const GAS unsigned*)(Qb + (size_t)i * HF); }
    vt_load(F, wsp<bf16_t>(F, WS_VV), row0, h, R.vw);
    const bf16_t* Sb = wsp<bf16_t>(F, WS_SS) + ((size_t)bh * 64 + c) * 16384 + (16 * w + fr) * 128 + 8 * fq;
#pragma unroll
    for (int ks = 0; ks < 4; ++ks) R.sa[ks] = *(const GAS bf16x8*)(Sb + 32 * ks);
    const bf16_t* GSb = wsp<bf16_t>(F, WS_GS);
#pragma unroll
    for (int tb = 0; tb < 4; ++tb) R.gv[tb] = *(const GAS u32x2*)(GSb + (row0 + 16 * tb + fr) * HF + h * 128 + 16 * w + 4 * fq);
}
__device__ __forceinline__ void p2c_compute(Frame& F, int u, const P2cRegs& R) {
    const int bh = u >> 6, c = u & 63, b = bh >> 3, h = bh & 7; const size_t row0 = (size_t)b * SEQ + 64 * c;
    LAS bf16_t* QPl = (LAS bf16_t*)F.lds; LAS bf16_t* QD = QPl + 64 * QP_; LAS bf16_t* KI = QD + 64 * QP_; LAS bf16_t* VT = KI + 160 * QP_; LAS bf16_t* PL = VT + 128 * KTP;
    LAS float* TOT8 = (LAS float*)(PL + 64 * KTP); LAS float* SSQ = TOT8 + 8 * 128;
    const int dp = (F.tid & 63) * 2, t8 = F.tid >> 6;
    f32x2 L[8], cs[8], q[8]; f32x2 run = (f32x2){0.f, 0.f};
#pragma unroll
    for (int i = 0; i < 8; ++i) { L[i] = R.L[i]; q[i] = (f32x2){bflo(R.qw[i]), bfhi(R.qw[i])}; }
#pragma unroll
    for (int i = 0; i < 8; ++i) { run += L[i]; cs[i] = run; }
    *(LAS f32x2*)(TOT8 + t8 * 128 + dp) = run;
    vt_store(F, R.vw, VT);
    for (int i = F.tid; i < 64 * KTP / 2; i += NTHR) ((LAS unsigned*)PL)[i] = 0u;
    __syncthreads();
    {
        f32x2 pre[9]; pre[0] = (f32x2){0.f, 0.f};
#pragma unroll
        for (int j = 0; j < 8; ++j) pre[j + 1] = pre[j] + *(const LAS f32x2*)(TOT8 + j * 128 + dp);
        f32x2 off = (f32x2){0.f, 0.f};
#pragma unroll
        for (int j = 0; j < 8; ++j) if (j == t8) off = pre[j];
        const int si = t8 >> 1;
        f32x2 st[4];
#pragma unroll
        for (int j = 0; j < 4; ++j) st[j] = pre[2 * j];
        f32x2 sti = st[0];
#pragma unroll
        for (int j = 1; j < 4; ++j) if (j == si) sti = st[j];
#pragma unroll
        for (int i = 0; i < 8; ++i) { const int t = 8 * t8 + i; const f32x2 bc = off + cs[i];
            *(LAS unsigned*)(QPl + t * QP_ + dp) = pk2(q[i].x * __expf(bc.x), q[i].y * __expf(bc.y));
            *(LAS unsigned*)(QD + t * QP_ + dp) = pk2(q[i].x * __expf(bc.x - sti.x), q[i].y * __expf(bc.y - sti.y));
            const f32x2 k = (f32x2){1.f - __expf(L[i].x), 1.f - __expf(L[i].y)};
#pragma unroll
            for (int j = 0; j < 4; ++j) if (j >= si) {
                *(LAS unsigned*)(KI + (8 * j * (j + 1) + t) * QP_ + dp) = pk2(k.x * __expf(fminf(st[j].x - bc.x, 80.f)), k.y * __expf(fminf(st[j].y - bc.y, 80.f))); }
        }
    }
    __syncthreads();
    const int w = F.wave, fr = F.lane & 15, fq = F.lane >> 4;
    for (int bi = w; bi < 10; bi += 8) {
        const int i = bi < 1 ? 0 : bi < 3 ? 1 : bi < 6 ? 2 : 3, j = bi - (i * (i + 1)) / 2;
        f32x4 cacc = (f32x4){0.f, 0.f, 0.f, 0.f};
#pragma unroll
        for (int ks = 0; ks < 4; ++ks) { const bf16x8 a = *(const LAS bf16x8*)(KI + (8 * i * (i + 1) + 16 * j + fr) * QP_ + 32 * ks + 8 * fq), bq = *(const LAS bf16x8*)(QD + (16 * i + fr) * QP_ + 32 * ks + 8 * fq);
            cacc = __builtin_amdgcn_mfma_f32_16x16x32_bf16(a, bq, cacc, 0, 0, 0); }
        if (i == j) {
#pragma unroll
            for (int r = 0; r < 4; ++r) if (4 * fq + r > fr) cacc[r] = 0.f; }
        u32x2 o; o.x = pk2(cacc[0], cacc[1]); o.y = pk2(cacc[2], cacc[3]);
        *(LAS u32x2*)(PL + (16 * i + fr) * KTP + 16 * j + 4 * fq) = o;
    }
    __syncthreads();
    f32x4 acc[4];
#pragma unroll
    for (int tb = 0; tb < 4; ++tb) acc[tb] = (f32x4){0.f, 0.f, 0.f, 0.f};
    {
#pragma unroll
        for (int ks = 0; ks < 4; ++ks)
#pragma unroll
            for (int tb = 0; tb < 4; ++tb) { const bf16x8 bq = *(const LAS bf16x8*)(QPl + (16 * tb + fr) * QP_ + 32 * ks + 8 * fq); acc[tb] = __builtin_amdgcn_mfma_f32_16x16x32_bf16(R.sa[ks], bq, acc[tb], 0, 0, 0); }
#pragma unroll
        for (int ks = 0; ks < 2; ++ks) { const bf16x8 va = *(const LAS bf16x8*)(VT + vt_off(16 * w + fr, 32 * ks + 8 * fq));
#pragma unroll
            for (int tb = 0; tb < 4; ++tb) { const bf16x8 bp = *(const LAS bf16x8*)(PL + (16 * tb + fr) * KTP + 32 * ks + 8 * fq); acc[tb] = __builtin_amdgcn_mfma_f32_16x16x32_bf16(va, bp, acc[tb], 0, 0, 0); } }
    }
#pragma unroll
    for (int tb = 0; tb < 4; ++tb) { float p = (acc[tb][0] * acc[tb][0] + acc[tb][1] * acc[tb][1]) + (acc[tb][2] * acc[tb][2] + acc[tb][3] * acc[tb][3]); p += __shfl_xor(p, 16); p += __shfl_xor(p, 32);
        if (fq == 0) SSQ[w * 64 + 16 * tb + fr] = p; }
    __syncthreads();
    {
        const f32x4 gw4 = *(const f32x4*)(F.gnw + 16 * w + 4 * fq);
        bf16_t* A2 = wsp<bf16_t>(F, WS_A2);
#pragma unroll
        for (int tb = 0; tb < 4; ++tb) { const int t = 16 * tb + fr; float ss = 0.f;
#pragma unroll
            for (int ww = 0; ww < 8; ++ww) ss += SSQ[ww * 64 + t];
            const float rs = rsqrtf(ss * (1.f / 128.f) + EPS);
            const u32x2 gv = R.gv[tb];
            const f32x4 o = acc[tb] * rs * gw4 * (f32x4){bflo(gv.x), bfhi(gv.x), bflo(gv.y), bfhi(gv.y)};
            u32x2 ov; ov.x = pk2(o[0], o[1]); ov.y = pk2(o[2], o[3]);
            *(GAS u32x2*)(A2 + (row0 + t) * D + h * 128 + 16 * w + 4 * fq) = ov; }
    }
    __syncthreads();
}
__device__ __forceinline__ void p2c_units(Frame& F, int c) {
    constexpr int NU = 2048;
    if (c >= NU) return;
    P2cRegs R; p2c_load(F, c, R);
    for (int u = c; u < NU; u += F.G) {
        P2cRegs N; const int un = u + F.G; if (un < NU) p2c_load(F, un, N); else N = R;
        p2c_compute(F, u, R);
        R = N;
    }
}

__device__ __forceinline__ void split8(const f32x4 a, const f32x4 b, bf16x8& hi, bf16x8& lo) {
    u32x4 h, l;
    h.x = cvt_pk_bf16(a[0], a[1]); h.y = cvt_pk_bf16(a[2], a[3]); h.z = cvt_pk_bf16(b[0], b[1]); h.w = cvt_pk_bf16(b[2], b[3]);
    l.x = cvt_pk_bf16(a[0] - bflo(h.x), a[1] - bfhi(h.x)); l.y = cvt_pk_bf16(a[2] - bflo(h.y), a[3] - bfhi(h.y)); l.z = cvt_pk_bf16(b[0] - bflo(h.z), b[1] - bfhi(h.z)); l.w = cvt_pk_bf16(b[2] - bflo(h.w), b[3] - bfhi(h.w));
    hi = __builtin_bit_cast(bf16x8, h); lo = __builtin_bit_cast(bf16x8, l);
}
__device__ __forceinline__ void p5_router(Frame& F) {
    const int fr = F.lane & 15, fq = F.lane >> 4, wq = F.wave & 3, kh = F.wave >> 2;
    LAS float* lg = (LAS float*)(F.lds + F.wave * 4096);
    LAS float* pa = (LAS float*)(F.lds + 32768) + (wq * 64 + F.lane) * 9;
    const bf16_t* DL = wsp<bf16_t>(F, WS_H1); unsigned char* H1B = wsp<unsigned char>(F, WS_H1B); const bf16_t* WH = wsp<bf16_t>(F, WS_WRH); const bf16_t* WL = wsp<bf16_t>(F, WS_WRL);
    for (int it = F.vcu * 4 + wq; it < M / 16; it += F.G * 4) {
        const int row0 = it * 16, kofs = 1024 * kh;
        const float* hp = F.x + (size_t)(row0 + fr) * D + kofs + 8 * fq; const bf16_t* dp_ = DL + (size_t)(row0 + fr) * D + kofs + 8 * fq; unsigned char* qp = H1B + (size_t)(row0 + fr) * D + kofs + 8 * fq;
        const bf16_t* wh0 = WH + (size_t)fr * D + kofs + 8 * fq; const bf16_t* wl0 = WL + (size_t)fr * D + kofs + 8 * fq;
        f32x4 a0 = (f32x4){0.f, 0.f, 0.f, 0.f}, a1 = a0; float ss = 0.f;
#pragma unroll 4
        for (int ks = 0; ks < 32; ++ks) {
            f32x4 xa = *(const GAS f32x4*)(hp + 32 * ks), xb = *(const GAS f32x4*)(hp + 32 * ks + 4); { f32x4 da, db; unpack8(*(const GAS u32x4*)(dp_ + 32 * ks), da, db); xa += da; xb += db; }
            *(GAS u32x2*)(qp + 32 * ks) = pack8_fp8(xa, xb);
            ss += (xa[0] * xa[0] + xa[1] * xa[1]) + (xa[2] * xa[2] + xa[3] * xa[3]) + (xb[0] * xb[0] + xb[1] * xb[1]) + (xb[2] * xb[2] + xb[3] * xb[3]);
            bf16x8 xh, xl; split8(xa, xb, xh, xl);
            const bf16x8 bh0 = *(const GAS bf16x8*)(wh0 + 32 * ks), bl0 = *(const GAS bf16x8*)(wl0 + 32 * ks), bh1 = *(const GAS bf16x8*)(wh0 + 16 * D + 32 * ks), bl1 = *(const GAS bf16x8*)(wl0 + 16 * D + 32 * ks);
            a0 = __builtin_amdgcn_mfma_f32_16x16x32_bf16(xh, bh0, a0, 0, 0, 0); a0 = __builtin_amdgcn_mfma_f32_16x16x32_bf16(xh, bl0, a0, 0, 0, 0);
            a0 = __builtin_amdgcn_mfma_f32_16x16x32_bf16(xl, bh0, a0, 0, 0, 0); a0 = __builtin_amdgcn_mfma_f32_16x16x32_bf16(xl, bl0, a0, 0, 0, 0);
            a1 = __builtin_amdgcn_mfma_f32_16x16x32_bf16(xh, bh1, a1, 0, 0, 0); a1 = __builtin_amdgcn_mfma_f32_16x16x32_bf16(xh, bl1, a1, 0, 0, 0);
            a1 = __builtin_amdgcn_mfma_f32_16x16x32_bf16(xl, bh1, a1, 0, 0, 0); a1 = __builtin_amdgcn_mfma_f32_16x16x32_bf16(xl, bl1, a1, 0, 0, 0);
        }
        if (kh == 1) {
#pragma unroll
            for (int r = 0; r < 4; ++r) { pa[r] = a0[r]; pa[4 + r] = a1[r]; }
            pa[8] = ss; }
        __syncthreads();
        if (kh == 0) {
#pragma unroll
            for (int r = 0; r < 4; ++r) { a0[r] += pa[r]; a1[r] += pa[4 + r]; }
            ss += pa[8];
            ss += __shfl_xor(ss, 16); ss += __shfl_xor(ss, 32);
#pragma unroll
            for (int r = 0; r < 4; ++r) { lg[(4 * fq + r) * 33 + fr] = a0[r]; lg[(4 * fq + r) * 33 + 16 + fr] = a1[r]; }
            LDS_WAIT(); asm volatile("" ::: "memory");
            if (F.lane < 16) {
                const int tokn = row0 + F.lane; const float rs = rsqrtf(ss * (1.f / D) + EPS);
                float v[32];
#pragma unroll
                for (int e = 0; e < 32; ++e) v[e] = lg[F.lane * 33 + e] * rs + F.b_r[e];
                int idx[4]; float val[4];
#pragma unroll
                for (int k = 0; k < 4; ++k) { float bv = -3.0e38f; int bi = 0;
#pragma unroll
                    for (int e = 0; e < 32; ++e) { const bool tk = v[e] > bv; bv = tk ? v[e] : bv; bi = tk ? e : bi; }
                    idx[k] = bi; val[k] = bv;
#pragma unroll
                    for (int e = 0; e < 32; ++e) v[e] = (e == bi) ? -3.0e38f : v[e]; }
                float ex[4], den = 0.f;
#pragma unroll
                for (int k = 0; k < 4; ++k) { ex[k] = __expf(val[k] - val[0]); den += ex[k]; }
                const float inv = 1.f / den;
                wsp<float>(F, WS_RS2)[tokn] = rs;
#pragma unroll
                for (int k = 0; k < 4; ++k) { const int pos = (int)atomicAdd((unsigned*)(F.ctl + CW_CNT + 64 * idx[k]), 1u);
                    wsp<int>(F, WS_TOPE)[tokn * 4 + k] = idx[k]; wsp<int>(F, WS_TOPP)[tokn * 4 + k] = pos; wsp<float>(F, WS_TOPW)[tokn * 4 + k] = ex[k] * inv;
                    wsp<int>(F, WS_LIST)[(size_t)idx[k] * CAPF + pos] = tokn; }
            }
        }
        __syncthreads();
    }
}
__device__ __forceinline__ void build_pref(Frame& F) {
    if (F.tid == 0) { int a = 0;
        for (int e = 0; e < NE; ++e) { F.MISC[16 + e] = (unsigned)a; const unsigned c = __hip_atomic_load(F.ctl + CW_CNT + 64 * e, RLX_AGENT); a += (int)((c + 255u) >> 8); }
        F.MISC[16 + NE] = (unsigned)(a < MAXRT ? a : MAXRT); }
    __syncthreads();
}
__device__ __forceinline__ void build_tok(Frame& F, const MoeOrder& S) {
    LAS int* tokt = (LAS int*)(F.lds + TOK_OFF);
    Unit u;
    for (int i = 0; i < 18 && S.next(i, u); ++i) {
        const int rt = u.pm - (int)F.MISC[16 + u.e]; const int cnt = (int)__hip_atomic_load(F.ctl + CW_CNT + 64 * u.e, RLX_AGENT);
        if (F.tid < 256) { const int r = rt * 256 + F.tid; tokt[i * 256 + F.tid] = (r < cnt) ? wsp<int>(F, WS_LIST)[(size_t)u.e * CAPF + r] : 0; }
    }
    __syncthreads();
}
struct P9Tok { f32x4 v[8]; unsigned y[4][8]; f32x4 tw; };
template <int PM> __device__ __forceinline__ void p9_issue(const Frame& F, int m, P9Tok& T) {
    typedef int i32x4 __attribute__((ext_vector_type(4)));
    const bf16_t* DL = wsp<bf16_t>(F, WS_H1); const unsigned char* YR = wsp<unsigned char>(F, WS_YR);
    const i32x4 te = *(const GAS i32x4*)(wsp<int>(F, WS_TOPE) + m * 4), tp = *(const GAS i32x4*)(wsp<int>(F, WS_TOPP) + m * 4); T.tw = *(const GAS f32x4*)(wsp<float>(F, WS_TOPW) + m * 4);
#pragma unroll
    for (int j = 0; j < 8; ++j) { const u32x2 dw = (PM == 4) ? (u32x2){(unsigned)m, 0u} : *(const GAS u32x2*)(DL + (size_t)m * D + 4 * F.lane + 256 * j);
        const f32x4 xv = (PM == 3) ? (f32x4){1.f, 2.f, 3.f, (float)m} : *(const GAS f32x4*)(F.x + (size_t)m * D + 4 * F.lane + 256 * j);
        T.v[j] = xv + (f32x4){bflo(dw.x), bfhi(dw.x), bflo(dw.y), bfhi(dw.y)}; }
#pragma unroll
    for (int k = 0; k < 4; ++k) { const size_t row = (size_t)((const LAS unsigned*)F.MISC)[16 + te[k]] * 256 + tp[k];
#pragma unroll
        for (int j = 0; j < 8; ++j) T.y[k][j] = (PM == 1) ? (unsigned)row : *(const GAS unsigned*)(YR + row * D + 4 * F.lane + 256 * j); }
}
template <int PM> __device__ __forceinline__ void p9_finish(const Frame& F, int m, P9Tok& T, float* outp) {
#pragma unroll
    for (int k = 0; k < 4; ++k)
#pragma unroll
        for (int j = 0; j < 8; ++j) { const f32x2 p0 = __builtin_amdgcn_cvt_pk_f32_fp8((int)T.y[k][j], false), p1 = __builtin_amdgcn_cvt_pk_f32_fp8((int)T.y[k][j], true); T.v[j] += (f32x4){p0.x, p0.y, p1.x, p1.y} * T.tw[k]; }
    float s = 0.f;
#pragma unroll
    for (int j = 0; j < 8; ++j) s += (T.v[j][0] * T.v[j][0] + T.v[j][1] * T.v[j][1]) + (T.v[j][2] * T.v[j][2] + T.v[j][3] * T.v[j][3]);
    const float rs = rsqrtf(wave_sum(s) * (1.f / D) + EPS);
#pragma unroll
    for (int j = 0; j < 8; ++j) { const f32x4 w = *(const f32x4*)(F.fnw + 4 * F.lane + 256 * j); const f32x4 o = T.v[j] * rs * w;
        if (PM == 2) asm volatile("" :: "v"(o)); else *(GAS f32x4*)(outp + (size_t)m * D + 4 * F.lane + 256 * j) = o; }
}
template <int PM> __device__ __forceinline__ void p9_combine_t(Frame& F, float* outp) {
    const int gw = F.vcu * NWAVES + F.wave, NGW9 = F.G * NWAVES;
    for (int m = gw; m < M; m += 2 * NGW9) {
        const int m2 = m + NGW9; const bool two = m2 < M;
        P9Tok A, B; p9_issue<PM>(F, m, A); p9_issue<PM>(F, two ? m2 : m, B);
        __builtin_amdgcn_sched_barrier(0);
        p9_finish<PM>(F, m, A, outp); if (two) p9_finish<PM>(F, m2, B, outp);
    }
}
__device__ __forceinline__ void p9_combine(Frame& F) { p9_combine_t<0>(F, F.out); }
constexpr int NPH = 11;
struct Args { const float* in[18]; float* out; unsigned char* ws; int ph_lo, ph_hi; };

__global__ void __launch_bounds__(NTHR, 2) fwd_kernel(Args args) {
    extern __shared__ __attribute__((aligned(16))) unsigned char lds_raw[];
    Frame F;
    F.lds = (LAS unsigned char*)lds_raw; F.MISC = (volatile LAS unsigned*)(F.lds + MISC_OFF);
    F.wave = __builtin_amdgcn_readfirstlane((int)threadIdx.x >> 6);
#define REFRESH() do { F.lane = lane_id(); F.tid = F.wave * 64 + F.lane; } while (0)
    REFRESH();
    F.G = gridDim.x; { const int bx = blockIdx.x; F.vcu = (F.G % 8 == 0) ? (bx % 8) * (F.G / 8) + bx / 8 : bx; }
    F.ws = args.ws; F.ctl = (gu32*)(args.ws + WS_CTL); F.out = args.out;
    F.x = args.in[0]; F.meta = args.in[1]; F.nmw = args.in[2]; F.w_in = args.in[3]; F.lbl = args.in[4]; F.gnw = args.in[5]; F.w_ho = args.in[6]; F.cw = args.in[7]; F.w_co = args.in[8]; F.w_o = args.in[9];
    F.nfw = args.in[10]; F.w_r = args.in[11]; F.b_r = args.in[12]; F.w_up = args.in[13]; F.b_up = args.in[14]; F.w_dn = args.in[15]; F.b_dn = args.in[16]; F.fnw = args.in[17];
    for (int u = F.tid; u < 256; u += NTHR) F.MISC[u] = 0u;
    __syncthreads();
    const int lo = args.ph_lo, hi = args.ph_hi;
    const bool multi = (hi - lo) > 1;
    XcdBarrier bar; bar.bar = (unsigned*)(F.ctl + CW_BAR); bar.x = 0; bar.st = nullptr;
    if (multi) bar = xcd_barrier_post((unsigned*)(F.ctl + CW_BAR), F.MISC, F.tid);
#define IN(k) (lo <= (k) && (k) < hi)
#if defined(FK_STAMP_A)
#define STAMP(k) do { if (blockIdx.x == 0 && F.tid == 0) __hip_atomic_store(F.ctl + CW_TS + (k), (unsigned)__builtin_amdgcn_s_memrealtime(), RLX_AGENT); } while (0)
#else
#define STAMP(k) do { } while (0)
#endif
#if defined(FK_PROBE_BAR)
#define SEAM(k) do { REFRESH(); if (IN(k) && IN((k) + 1)) { xcd_barrier(bar, F.tid); xcd_barrier(bar, F.tid); xcd_barrier(bar, F.tid); } STAMP((k) + 1); } while (0)
#else
#define SEAM(k) do { REFRESH(); if (IN(k) && IN((k) + 1)) xcd_barrier(bar, F.tid); STAMP((k) + 1); } while (0)
#endif
    STAMP(0);
    const int c = blockIdx.x;
#ifndef FK_DUP_MASK
#define FK_DUP_MASK 0
#endif
#ifndef FK_DUP_REPS
#define FK_DUP_REPS 1
#endif
#define DUP(k) for (int _rep = 0; _rep < 1 + FK_DUP_REPS * ((FK_DUP_MASK >> (k)) & 1); ++_rep)
#define REDO(k) do { if (((FK_DUP_MASK >> (k)) & 1) && _rep < FK_DUP_REPS) { REFRESH(); xcd_barrier(bar, F.tid); } } while (0)

    if (IN(0)) DUP(0) { p0_prologue(F); REDO(0); } SEAM(0);

    if (IN(1)) DUP(1) {
        constexpr int NCONV_PER8 = 3;
        const int cq = c >> 3; const bool conv = (F.G % 64 == 0) && ((cq & 7) < NCONV_PER8) && (_rep == 0);
        if (F.G % 64 != 0 && _rep == 0) { if (c == 0) p1_convert(F, 0, 1); }
        if (conv) { const int nconv = (F.G / 64) * 8 * NCONV_PER8, rank = ((cq >> 3) * NCONV_PER8 + (cq & 7)) * 8 + (c & 7); p1_convert(F, rank, nconv);
#if defined(FK_PROBE_CONV2)
            __syncthreads(); p1_convert<FK_PROBE_CONV2 - 1>(F, rank, nconv);
#endif
        }
        __syncthreads();
        EpiInproj E{wsp<float>(F, WS_RS1), wsp<float>(F, WS_LB), wsp<bf16_t>(F, WS_QS), wsp<bf16_t>(F, WS_VV), wsp<bf16_t>(F, WS_GS), wsp<bf16_t>(F, WS_UU), wsp<bf16_t>(F, WS_SB), wsp<bf16_t>(F, WS_RT), wsp<bf16_t>(F, WS_GBS), wsp<h16_t>(F, WS_LF), 1.f};
        if (N_INB > 0) {
            GemmDesc g{wsp<bf16_t>(F, WS_XB), wsp<bf16_t>(F, WS_WIN), D, INC / 256};
            DynOrder S; S.init(M, INB_MASK, N_INB, c, (unsigned*)(F.ctl + CW_Q + 64 * (c & 7) + 8 * _rep), F.MISC + 4, F.tid);
            gemm_phase<EpiInproj, DynOrder, false, true, false>(F.lds, g, S, E, nullptr, F.wave); }
        if (N_IN8 > 0) {
            REFRESH(); E.osc = 1.f / W8_SCALE;
            GemmDesc g{(const bf16_t*)wsp<unsigned char>(F, WS_XB8), (const bf16_t*)wsp<unsigned char>(F, WS_WIN8), D, INC / 256};
            DynOrder S; S.init(M, IN8_MASK, N_IN8, c, (unsigned*)(F.ctl + CW_Q + 64 * (c & 7) + 8 * _rep + 4), F.MISC + 6, F.tid);
            gemm_phase<EpiInproj, DynOrder, false, true, true>(F.lds, g, S, E, nullptr, F.wave); }
        REDO(1);
    } SEAM(1);

#if defined(FK_PROBE_GEMM)
    if (IN(1)) {
        GemmDesc g{wsp<bf16_t>(F, WS_XB), wsp<bf16_t>(F, WS_WIN), D, INC / 256}; ProbeOrder S; S.S.init(M, INC, F.G, c); S.mode = FK_PROBE_GEMM & 3; S.c = c;
        EpiDummy E{wsp<bf16_t>(F, WS_ACT), (FK_PROBE_GEMM >> 2) & 1};
        gemm_phase<EpiDummy, ProbeOrder, false, true, false>(F.lds, g, S, E, nullptr, F.wave);
        REFRESH(); xcd_barrier(bar, F.tid);
    }
#endif
    if (IN(2)) DUP(2) { p2a_units(F, c); for (int it = c; it < M / 64; it += F.G) p2a_conv(F, it); REDO(2); } SEAM(2);
    if (IN(3)) DUP(3) { p2b_scan(F); REDO(3); } SEAM(3);
    if (IN(4)) DUP(4) { p2c_units(F, c); REDO(4); } SEAM(4);

    if (IN(5)) DUP(5) {
        GemmDesc g{wsp<bf16_t>(F, WS_A2), wsp<bf16_t>(F, WS_WAB), D, D / 256}; StaticOrder S; S.init(M, D, F.G, c);
        EpiMerge E{wsp<bf16_t>(F, WS_RT), wsp<bf16_t>(F, WS_GBS), wsp<bf16_t>(F, WS_MG)};
        gemm_phase<EpiMerge, StaticOrder, false, true, false>(F.lds, g, S, E, nullptr, F.wave); REDO(5);
    } SEAM(5);

    if (IN(6)) DUP(6) {
        GemmDesc g{wsp<bf16_t>(F, WS_MG), wsp<bf16_t>(F, WS_WO), D, D / 256}; StaticOrder S; S.init(M, D, F.G, c);
        EpiWo E{wsp<bf16_t>(F, WS_H1)};
        gemm_phase<EpiWo, StaticOrder, false, true, false>(F.lds, g, S, E, nullptr, F.wave); REDO(6);
    } SEAM(6);

    if (IN(7)) { p5_router(F); } SEAM(7);

    if (IN(8)) DUP(8) {
        build_pref(F);
        MoeOrder S; S.init(16, F.G, c, (const volatile LAS int*)(F.MISC + 16));
        build_tok(F, S);
        GemmDesc g{wsp<bf16_t>(F, WS_H1B), wsp<bf16_t>(F, WS_WUP), D, 16};
        EpiUp E{wsp<float>(F, WS_RS2), (const LAS int*)(F.lds + TOK_OFF), F.b_up, wsp<unsigned char>(F, WS_ACT)};
        gemm_phase<EpiUp, MoeOrder, true, true, true>(F.lds, g, S, E, (const LAS int*)(F.lds + TOK_OFF), F.wave); REDO(8);
    } SEAM(8);

    if (IN(9)) DUP(9) {
        build_pref(F);
        MoeOrder S; S.init(8, F.G, c, (const volatile LAS int*)(F.MISC + 16));
        GemmDesc g{wsp<bf16_t>(F, WS_ACT), wsp<bf16_t>(F, WS_WDN), DFF, 8};
        EpiDown E{F.b_dn, wsp<unsigned char>(F, WS_YR)};
        gemm_phase<EpiDown, MoeOrder, false, true, true>(F.lds, g, S, E, nullptr, F.wave); REDO(9);
    } SEAM(9);

#if defined(FK_PROBE_P8)
    if (IN(10)) {
        build_pref(F);
        ProbeMoe S; S.S.init(8, F.G, c, (const volatile LAS int*)(F.MISC + 16)); S.mode = FK_PROBE_P8 & 3;
        GemmDesc g{wsp<bf16_t>(F, WS_ACT), wsp<bf16_t>(F, WS_WDN), DFF, 8};
        EpiDummy E{wsp<bf16_t>(F, WS_XB), 1};
        for (int r = 0; r < 2; ++r) { gemm_phase<EpiDummy, ProbeMoe, false, true, true>(F.lds, g, S, E, nullptr, F.wave); REFRESH(); xcd_barrier(bar, F.tid); }
    }
#endif
    if (IN(10)) DUP(10) { build_pref(F); p9_combine(F); REDO(10); }
#if defined(FK_PROBE_P9)
    if (IN(10)) { for (int r = 0; r < 4; ++r) { REFRESH(); xcd_barrier(bar, F.tid); p9_combine_t<FK_PROBE_P9 - 1>(F, wsp<float>(F, WS_XB)); } }
#endif
#undef IN
#undef DUP
#undef REDO
#undef SEAM
#undef STAMP
#undef REFRESH
}

inline void launch_fast(hipStream_t stream, void* const* d_in, float* out, unsigned char* ws, int n_launches) {
    static int grid = 0;
    if (grid == 0) {
        int dev = 0, cus = 0, per_cu = 0;
        if (hipGetDevice(&dev) != hipSuccess || hipDeviceGetAttribute(&cus, hipDeviceAttributeMultiprocessorCount, dev) != hipSuccess) { fprintf(stderr, "kernel_launch: device query failed\n"); grid = -1; return; }
        if (hipFuncSetAttribute((const void*)fwd_kernel, hipFuncAttributeMaxDynamicSharedMemorySize, LDS_BYTES) != hipSuccess) { fprintf(stderr, "kernel_launch: hipFuncSetAttribute failed\n"); grid = -1; return; }
        if (hipOccupancyMaxActiveBlocksPerMultiprocessor(&per_cu, (const void*)fwd_kernel, NTHR, LDS_BYTES) != hipSuccess || per_cu < 1) fprintf(stderr, "kernel_launch: note: occupancy query says %d blocks per CU\n", per_cu);
        (void)hipGetLastError();
        grid = cus;
    }
    if (grid < 0) return;
    (void)hipMemsetAsync(ws + WS_CTL, 0, CTL_BYTES, stream);
    Args a{};
    for (int i = 0; i < 18; ++i) a.in[i] = (const float*)d_in[i];
    a.out = out; a.ws = ws;
    for (int li = 0; li < n_launches; ++li) {
        a.ph_lo = (n_launches == 1) ? 0 : li; a.ph_hi = (n_launches == 1) ? NPH : li + 1;
        hipLaunchKernelGGL(fwd_kernel, dim3(grid), dim3(NTHR), LDS_BYTES, stream, a);
        const hipError_t le = hipPeekAtLastError();
        if (le != hipSuccess) { fprintf(stderr, "kernel_launch: launch %d failed: %s\n", li, hipGetErrorName(le)); break; }
    }
}
}
#ifndef FK_LAUNCHES
#define FK_LAUNCHES 1
#endif
extern "C" void kernel_launch(void* const* d_in, const int* in_sizes, int n_in, void* d_out, int out_size, void* d_ws, size_t ws_size, hipStream_t stream) {
    if (n_in != 18 || ws_size < fk::WS_FAST_END) { fprintf(stderr, "kernel_launch: n_in %d, ws %zu < %zu\n", n_in, ws_size, (size_t)fk::WS_FAST_END); return; }
    fk::launch_fast(stream, d_in, (float*)d_out, (unsigned char*)d_ws, FK_LAUNCHES);
}
```

```cpp
#include <hip/hip_runtime.h>
#include <cstdio>
#define FK_LAUNCHES 1
#define FK_IN8_MASK 0xFFFF000F0FFull
#define FK_WO8 0
namespace fk {
#define LAS __attribute__((address_space(3)))
#define GAS __attribute__((address_space(1)))
typedef unsigned short bf16_t;
typedef short bf16x8 __attribute__((ext_vector_type(8)));
typedef float f32x4 __attribute__((ext_vector_type(4)));
typedef float f32x2 __attribute__((ext_vector_type(2)));
typedef unsigned u32x4 __attribute__((ext_vector_type(4)));
typedef unsigned u32x2 __attribute__((ext_vector_type(2)));
typedef GAS unsigned gu32;
typedef _Float16 h16_t;
typedef _Float16 h16x4 __attribute__((ext_vector_type(4)));
typedef _Float16 h16x2 __attribute__((ext_vector_type(2)));
#define RLX_AGENT __ATOMIC_RELAXED, __HIP_MEMORY_SCOPE_AGENT
#define LDS_WAIT() asm volatile("s_waitcnt lgkmcnt(0)" ::: "memory")
#define VM_WAIT() asm volatile("s_waitcnt vmcnt(0)" ::: "memory")

constexpr int D = 2048, NB = 4, SEQ = 4096, M = NB * SEQ, NMETA = 16;
constexpr int HF = 1024, INC = 11264, NE = 32, DFF = 2048, NCH = SEQ / 64;
constexpr int C_Q = 0, C_F = 1024, C_V = 2048, C_G = 3072, C_SV = 4096, C_SB = 5120, C_SC = 6144, C_GA = 7168, C_GB = 9216;
constexpr float EPS = 1e-6f;
constexpr int CAPF = M;
constexpr int MAXRT = 288;
constexpr int NWAVES = 8, NTHR = 512;

constexpr size_t al(size_t x) { return (x + 0xFFFFF) & ~(size_t)0xFFFFF; }
constexpr size_t WS_CTL = 0, CTL_BYTES = 65536;
constexpr size_t WS_LB = 65536, WS_RS1 = WS_LB + 4096, WS_RS2 = WS_RS1 + 65536, WS_WRH = WS_RS2 + 65536, WS_WRL = WS_WRH + 131072;
constexpr size_t WS_LFM = WS_WRL + 131072, WS_VVM = WS_LFM + 64 * 1024 * 4, WS_UUM = WS_VVM + 64 * 1024 * 2, WS_SMALL_END = WS_UUM + 16 * 1024 * 2;
constexpr size_t WS_TOPE = al(WS_SMALL_END), WS_TOPP = WS_TOPE + (size_t)M * 16, WS_TOPW = WS_TOPP + (size_t)M * 16, WS_LIST = WS_TOPW + (size_t)M * 16;
constexpr size_t WS_DEC = al(WS_LIST + (size_t)NE * CAPF * 4);
constexpr size_t WS_WIN = al(WS_DEC + (size_t)33 * 64 * 128 * 4);
constexpr size_t WS_WAB = al(WS_WIN + (size_t)INC * D * 2);
constexpr size_t WS_WO = al(WS_WAB + (size_t)D * D * 2);
constexpr size_t WS_WUP = al(WS_WO + (size_t)D * D * 2);
constexpr size_t WS_WDN = al(WS_WUP + (size_t)NE * 4096 * D);
constexpr size_t WS_XB = al(WS_WDN + (size_t)NE * D * DFF);
constexpr size_t WS_QS = al(WS_XB + (size_t)M * D * 2);
constexpr size_t WS_LF = al(WS_QS + (size_t)M * HF * 2);
constexpr size_t WS_VV = al(WS_LF + (size_t)M * HF * 2);
constexpr size_t WS_GS = al(WS_VV + (size_t)M * HF * 2);
constexpr size_t WS_UU = al(WS_GS + (size_t)M * HF * 2);
constexpr size_t WS_SB = al(WS_UU + (size_t)M * HF * 2);
constexpr size_t WS_RT = al(WS_SB + (size_t)M * HF * 2);
constexpr size_t WS_GBS = al(WS_RT + (size_t)M * D * 2);
constexpr size_t WS_UC = al(WS_GBS + (size_t)M * D * 2);
constexpr size_t WS_SS = al(WS_UC + (size_t)(32 * 64 + 8) * 16384 * 2);
constexpr size_t WS_A2 = al(WS_SS + (size_t)32 * 64 * 16384 * 2);
constexpr size_t WS_MG = al(WS_A2 + (size_t)M * D * 2);
constexpr size_t WS_H1 = al(WS_MG + (size_t)M * D * 2);
constexpr size_t WS_H1B = al(WS_H1 + (size_t)M * D * 2);
constexpr size_t WS_ACT = al(WS_H1B + (size_t)M * D);
constexpr size_t WS_YR = al(WS_ACT + (size_t)MAXRT * 256 * DFF);
constexpr size_t WS_WIN8 = al(WS_YR + (size_t)MAXRT * 256 * D);
constexpr size_t WS_XB8 = al(WS_WIN8 + (size_t)INC * D);
constexpr size_t WS_FAST_END = al(WS_XB8 + (size_t)M * D);
#ifndef FK_IN8_MASK
#define FK_IN8_MASK 0xFFFF00000F0ull
#endif
constexpr unsigned long long IN8_MASK = FK_IN8_MASK;
constexpr unsigned long long INB_MASK = ((1ull << 44) - 1) & ~IN8_MASK;
constexpr int cpop(unsigned long long m) { int n = 0; while (m) { m &= m - 1; ++n; } return n; }
constexpr int N_IN8 = cpop(IN8_MASK), N_INB = 44 - N_IN8;
__device__ __forceinline__ int nth_bit(unsigned long long m, int n) { for (int i = 0; i < n; ++i) m &= m - 1; return __builtin_ctzll(m); }
constexpr int CW_TMO = 0;
constexpr int CW_CNT = 1024;
constexpr int CW_Q = 3400;
constexpr int CW_TS = 3200;
constexpr int CW_BAR = 4096;
constexpr int RING_BYTES = 131072;
constexpr int TOK_OFF = RING_BYTES, TOK_BYTES = 18 * 1024;
constexpr int MISC_OFF = TOK_OFF + TOK_BYTES;
constexpr int LDS_BYTES = MISC_OFF + 1024;
static_assert(LDS_BYTES <= 160 * 1024, "LDS");

__device__ __forceinline__ float sigmoidf_(float x) { return 1.f / (1.f + __expf(-x)); }
__device__ __forceinline__ unsigned f2bf(float f) { unsigned u = __builtin_bit_cast(unsigned, f); return (u + 0x7fffu + ((u >> 16) & 1u)) >> 16; }
__device__ __forceinline__ unsigned pk2(float lo, float hi) { return f2bf(lo) | (f2bf(hi) << 16); }
__device__ __forceinline__ float bf2f(unsigned short b) { return __builtin_bit_cast(float, ((unsigned)b) << 16); }
__device__ __forceinline__ float bflo(unsigned w) { return __builtin_bit_cast(float, w << 16); }
__device__ __forceinline__ float bfhi(unsigned w) { return __builtin_bit_cast(float, w & 0xffff0000u); }
__device__ __forceinline__ unsigned cvt_pk_bf16(float lo, float hi) { unsigned r; asm volatile("v_cvt_pk_bf16_f32 %0, %1, %2" : "=v"(r) : "v"(lo), "v"(hi)); return r; }
__device__ __forceinline__ unsigned pk4_fp8(float a, float b, float c, float d) { int w = 0; w = __builtin_amdgcn_cvt_pk_fp8_f32(a, b, w, false); w = __builtin_amdgcn_cvt_pk_fp8_f32(c, d, w, true); return (unsigned)w; }
constexpr float W8_SCALE = 64.f, W8_INV = 1.f / 64.f;
__device__ __forceinline__ int lane_id() { int l; asm volatile("v_mbcnt_lo_u32_b32 %0, -1, 0\n\tv_mbcnt_hi_u32_b32 %0, -1, %0" : "=v"(l)); return l; }
__device__ __forceinline__ float wave_sum(float v) {
#pragma unroll
    for (int o = 1; o < 64; o <<= 1) v += __shfl_xor(v, o);
    return v;
}

#define XB_TMO      128
#define XB_XCNT(j)  (256  + 64 * (j))
#define XB_XSUB(j)  (1280 + 64 * (j))
#define XB_XGEN(j)  (2304 + 64 * (j))
#define XB_TOP      3328
#define XB_TOPGEN   3392
#define XCD_BAR_WORDS 3456
#define XB_SPIN_CAP (1u << 18)
__device__ __forceinline__ unsigned xb_ld(unsigned* p)              { return __hip_atomic_load(p, __ATOMIC_RELAXED, __HIP_MEMORY_SCOPE_AGENT); }
__device__ __forceinline__ unsigned xb_add(unsigned* p, unsigned v) { return __hip_atomic_fetch_add(p, v, __ATOMIC_RELAXED, __HIP_MEMORY_SCOPE_AGENT); }
__device__ __forceinline__ unsigned xb_xcc_id() { return (unsigned)__builtin_amdgcn_s_getreg((3 << 11) | 20) & 0xFu; }
#define XB_SPIN(cond, bar) do { unsigned _sp = 0; while (cond) { __builtin_amdgcn_s_sleep(1); \
    if ((++_sp & 255u) == 0u) { if (xb_ld(&(bar)[XB_TMO])) break; if (_sp > XB_SPIN_CAP) { atomicAdd(&(bar)[XB_TMO], 1u); break; } } } } while (0)
struct XcdBarrier { unsigned* bar; unsigned x; volatile LAS unsigned* st; };
__device__ __forceinline__ XcdBarrier xcd_barrier_post(unsigned* bar, volatile LAS unsigned* st, int tid) {
    XcdBarrier b; b.bar = bar; b.x = xb_xcc_id(); b.st = st;
    if (tid == 0) (void)xb_add(&bar[XB_XCNT(b.x)], 1u);
    return b;
}
__device__ __forceinline__ void xcd_barrier_complete(unsigned* bar, unsigned x, unsigned& nloc, unsigned& nx) {
    const unsigned G = gridDim.x * gridDim.y * gridDim.z;
    unsigned sum, cnt, mine, sp = 0u;
    for (;;) {
        sum = 0u; cnt = 0u; mine = 0u;
#pragma unroll
        for (unsigned j = 0; j < 16; ++j) { const unsigned c = xb_ld(&bar[XB_XCNT(j)]); sum += c; cnt += (c > 0u) ? 1u : 0u; mine = (j == x) ? c : mine; }
        if (sum == G) break;
        __builtin_amdgcn_s_sleep(1);
        if ((++sp & 255u) == 0u) { if (xb_ld(&bar[XB_TMO])) break; if (sp > XB_SPIN_CAP) { atomicAdd(&bar[XB_TMO], 1u); break; } }
    }
    nloc = mine > 0u ? mine : 1u; nx = cnt > 0u ? cnt : 1u;
}
__device__ __forceinline__ void xcd_barrier(const XcdBarrier& b, int tid) {
    asm volatile("s_waitcnt vmcnt(0)" ::: "memory");
    __syncthreads();
    if (tid == 0) {
        unsigned* bar = b.bar;
        __builtin_amdgcn_s_waitcnt(0);
        unsigned nloc = b.st[0], nx = b.st[1];
        if (nloc == 0u) { xcd_barrier_complete(bar, b.x, nloc, nx); b.st[0] = nloc; b.st[1] = nx; }
        const unsigned old = xb_add(&bar[XB_XSUB(b.x)], 1u);
        const unsigned gen = old / nloc;
        if (old + 1u == (gen + 1u) * nloc) {
            __builtin_amdgcn_fence(__ATOMIC_RELEASE, "agent");
            asm volatile("s_waitcnt vmcnt(0)" ::: "memory");
            const unsigned og = xb_add(&bar[XB_TOP], 1u);
            const unsigned tg = og / nx;
            if (og + 1u == (tg + 1u) * nx) xb_add(&bar[XB_TOPGEN], 1u);
            else XB_SPIN(xb_ld(&bar[XB_TOPGEN]) == tg, bar);
            __builtin_amdgcn_fence(__ATOMIC_ACQUIRE, "agent");
            xb_add(&bar[XB_XGEN(b.x)], 1u);
            asm volatile("s_waitcnt vmcnt(0)" ::: "memory");
        } else {
            XB_SPIN(xb_ld(&bar[XB_XGEN(b.x)]) == gen, bar);
            __builtin_amdgcn_fence(__ATOMIC_ACQUIRE, "agent");
            asm volatile("s_waitcnt vmcnt(0)" ::: "memory");
        }
    }
    __syncthreads();
}

constexpr int BM = 256, BK = 64, HALF = 128, HTB = HALF * BK * 2, NXCD = 8, WGM = 8;
__host__ __device__ __forceinline__ int lds_byte(int r, int c) { const int st = (r >> 4) * 2 + (c >> 5), rr = r & 15, cc = c & 31, ob = rr * 64 + cc * 2; return st * 1024 + (ob ^ (((ob >> 9) & 1) << 5)); }
__host__ __device__ __forceinline__ void stage_rc(int b, int& R, int& C) { const int st = b / 1024, sb = b % 1024, swz = sb ^ (((sb >> 9) & 1) << 5); R = (st >> 1) * 16 + swz / 64; C = (st & 1) * 32 + (swz % 64) / 2; }
__host__ __device__ __forceinline__ int perm32(int rho) { const int n = rho >> 4, i = rho & 15; return 8 * (i >> 2) + 4 * n + (i & 3); }

typedef int i32x8 __attribute__((ext_vector_type(8)));
typedef int i32x4v __attribute__((ext_vector_type(4)));
__device__ __forceinline__ i32x8 cat8(const bf16x8 a, const bf16x8 b) { const i32x4v x = __builtin_bit_cast(i32x4v, a), y = __builtin_bit_cast(i32x4v, b); return __builtin_shufflevector(x, y, 0, 1, 2, 3, 4, 5, 6, 7); }
__device__ __forceinline__ void mfma8(f32x4& acc, const i32x8 a, const i32x8 b, const int sc) {
    asm volatile("s_nop 1\n\tv_mfma_scale_f32_16x16x128_f8f6f4 %0, %1, %2, %0, %3, %3 op_sel_hi:[0,0,0]" : "+v"(acc) : "v"(a), "v"(b), "v"(sc));
}
struct Unit { int pm, pn, e, ui; };

struct StaticOrder {
    int nM, nN, nwg, G, c;
    __device__ void init(int M_, int N_, int G_, int c_) { nM = M_ / BM; nN = N_ / BM; nwg = nM * nN; G = G_; c = c_; }
    __device__ __forceinline__ bool next(int i, Unit& u) const {
        const long L = (long)i * G + c; if (L >= nwg) return false;
        int wgid = (int)L; { const int q = nwg / NXCD, r = nwg % NXCD, xcd = wgid % NXCD, off = wgid / NXCD; wgid = (xcd < r ? xcd * (q + 1) : r * (q + 1) + (xcd - r) * q) + off; }
        const int nig = WGM * nN, gid = wgid / nig, fm = gid * WGM, gsz = (nM - fm) < WGM ? (nM - fm) : WGM;
        u.pm = fm + ((wgid % nig) % gsz); u.pn = (wgid % nig) / gsz; u.e = 0; u.ui = i; return true;
    }
};
struct DynOrder {
    int nM, nN, nwg, x; unsigned* head; volatile LAS unsigned* slot; int tid; unsigned long long mask;
    __device__ void init(int M_, unsigned long long mask_, int nN_, int c_, unsigned* head_, volatile LAS unsigned* slot_, int tid_) { nM = M_ / BM; nN = nN_; mask = mask_; nwg = nM * nN; x = c_ & 7; head = head_; slot = slot_; tid = tid_; }
    __device__ __forceinline__ bool next(int i, Unit& u) const {
        if (tid == 0) slot[i & 1] = __hip_atomic_fetch_add(head, 1u, __ATOMIC_RELAXED, __HIP_MEMORY_SCOPE_AGENT);
        asm volatile("s_waitcnt lgkmcnt(0)" ::: "memory"); __builtin_amdgcn_s_barrier(); asm volatile("" ::: "memory");
        const int j = (int)slot[i & 1], q = nwg / NXCD;
        if (j >= q) return false;
        const int wgid = x * q + j;
        const int nig = WGM * nN, gid = wgid / nig, fm = gid * WGM, gsz = (nM - fm) < WGM ? (nM - fm) : WGM;
        u.pm = fm + ((wgid % nig) % gsz); u.pn = nth_bit(mask, (wgid % nig) / gsz); u.e = 0; u.ui = i; return true;
    }
};
struct MoeOrder {
    int nct, NT, G, c; const volatile LAS int* pref;
    __device__ void init(int nct_, int G_, int c_, const volatile LAS int* pref_) { nct = nct_; G = G_; c = c_; pref = pref_; NT = pref_[NE]; }
    __device__ __forceinline__ bool next(int i, Unit& u) const {
        int rtg, pn;
        if (G == 256) { const int x = c & 7, jj = c >> 3;
            if (nct == 16) { rtg = 16 * i + 8 * (x & 1) + (jj & 7); pn = 4 * (x >> 1) + (jj >> 3); }
            else           { rtg = 32 * i + 8 * (x & 3) + (jj & 7); pn = 4 * (x >> 2) + (jj >> 3); } }
        else { const int U = i * G + c; rtg = U / nct; pn = U - rtg * nct; }
        if (rtg >= NT) return false;
        u.pn = pn; u.pm = rtg; u.ui = i;
        int e = 0;
#pragma unroll 1
        for (int j = 1; j < NE; ++j) e = (pref[j] <= rtg) ? j : e;
        u.e = e; return true;
    }
};

struct GemmDesc { const bf16_t* A; const bf16_t* Bt; int K; int nct; };

template <class Epi, class Sched, bool GATHER, bool ALIGN_EPI, bool FP8>
__device__ __forceinline__ void gemm_phase(LAS unsigned char* lds, const GemmDesc g, const Sched& S, const Epi& E, const LAS int* tok, int wid) {
    const int lane = lane_id(), tid = wid * 64 + lane, wr = wid >> 2, wc = wid & 3, fr = lane & 15, fq = lane >> 4;
    const int K = g.K, KB = FP8 ? K : 2 * K  , nt = FP8 ? K / 128 : K / BK;
    int Rl[2], Cl[2];
    unsigned voffA[2], voffB[2];
#pragma unroll
    for (int i = 0; i < 2; ++i) { int Cc; stage_rc(tid * 16 + i * 8192, Rl[i], Cc); const int p = Cc >> 3; Cl[i] = FP8 ? 16 * (2 * (p & 3) + (p >> 2)) : 2 * Cc; voffA[i] = (unsigned)(Rl[i] * KB + Cl[i]); voffB[i] = voffA[i]; }
    const size_t kstep = (size_t)(BK * 2);
    const size_t hstep = (size_t)HALF * KB;
    const size_t tstep = 2 * hstep;
    const unsigned ldsw = (unsigned)wid * 1024u;
    const int aoff = lds_byte(wr * 64 + fr, fq * 8), boff = lds_byte(wc * 32 + fr, fq * 8);
#define PG8_SA(b, h) (((b) * 2 + (h)) * HTB)
#define PG8_SB(b, h) ((4 + (b) * 2 + (h)) * HTB)
#define PG8_STAGE(bufoff, gbase, voff) do { _Pragma("unroll") for (int _i = 0; _i < 2; ++_i) \
        __builtin_amdgcn_global_load_lds((const unsigned*)((const char*)(gbase) + (voff)[_i]), (LAS unsigned*)(lds + (bufoff) + ldsw + _i * 8192), 16, 0, 0); } while (0)
#define PG8_STAGE_A(bufoff, ptr, half, o0, o1) do { if constexpr (GATHER) { PG8_STAGE(bufoff, ptr, (half) ? o1 : o0); } else { PG8_STAGE(bufoff, (ptr) + (half) * hstep, voffA); } } while (0)
#define PG8_LDA(dst, b, h) do { _Pragma("unroll") for (int m = 0; m < 4; ++m) _Pragma("unroll") for (int k = 0; k < 2; ++k) dst[m][k] = *(const LAS bf16x8*)(lds + PG8_SA(b, h) + aoff + m * 2048 + k * 1024); } while (0)
#define PG8_LDB(dst, b, h) do { _Pragma("unroll") for (int n = 0; n < 2; ++n) _Pragma("unroll") for (int k = 0; k < 2; ++k) dst[n][k] = *(const LAS bf16x8*)(lds + PG8_SB(b, h) + boff + n * 2048 + k * 1024); } while (0)
#define PG8_MMA(ai, bj, At, Bt) do { __builtin_amdgcn_s_setprio(1); _Pragma("unroll") for (int m = 0; m < 4; ++m) _Pragma("unroll") for (int n = 0; n < 2; ++n) _Pragma("unroll") for (int k = 0; k < 2; ++k) \
        acc[ai][bj][m][n] = __builtin_amdgcn_mfma_f32_16x16x32_bf16(Bt[n][k], At[m][k], acc[ai][bj][m][n], 0, 0, 0); __builtin_amdgcn_s_setprio(0); } while (0)
#define PG8_MMA8(ai, bj, At, Bt) do { __builtin_amdgcn_s_setprio(1); _Pragma("unroll") for (int m = 0; m < 4; ++m) _Pragma("unroll") for (int n = 0; n < 2; ++n) \
        mfma8(acc[ai][bj][m][n], cat8(Bt[n][0], Bt[n][1]), cat8(At[m][0], At[m][1]), sc8); __builtin_amdgcn_s_setprio(0); } while (0)
#define PG8_MM(ai, bj, At, Bt) do { if constexpr (FP8) PG8_MMA8(ai, bj, At, Bt); else PG8_MMA(ai, bj, At, Bt); } while (0)
#define PG8_WAIT_V(n) asm volatile("s_waitcnt vmcnt(" #n ")" ::: "memory")
#define PG8_WAIT_L(n) asm volatile("s_waitcnt lgkmcnt(" #n ")" ::: "memory")
#define PG8_BAR __builtin_amdgcn_s_barrier()
#define PG8_SCHED __builtin_amdgcn_sched_barrier(0)
    Unit cur, nxt; int ui = 0;
    if (!S.next(0, cur)) return;
    const int sc8 = 0x7F7F7F7F;
    f32x4 acc[2][2][4][2];
#pragma unroll
    for (int a = 0; a < 2; ++a)
#pragma unroll
        for (int b = 0; b < 2; ++b)
#pragma unroll
            for (int m = 0; m < 4; ++m)
#pragma unroll
                for (int n = 0; n < 2; ++n) acc[a][b][m][n] = (f32x4){0.f, 0.f, 0.f, 0.f};
    bf16x8 At[4][2], B0[2][2], B1[2][2];
    unsigned vA0[2] = {0u, 0u}, vA1[2] = {0u, 0u}, nA0[2] = {0u, 0u}, nA1[2] = {0u, 0u};
    const char* cA; const char* cB = (const char*)g.Bt + (size_t)(cur.e * g.nct + cur.pn) * tstep;
    if constexpr (GATHER) {
        cA = (const char*)g.A;
#pragma unroll
        for (int i = 0; i < 2; ++i) { vA0[i] = (unsigned)(tok[cur.ui * 256 + Rl[i]] * KB + Cl[i]); vA1[i] = (unsigned)(tok[cur.ui * 256 + 128 + Rl[i]] * KB + Cl[i]); nA0[i] = vA0[i]; nA1[i] = vA1[i]; }
    } else cA = (const char*)g.A + (size_t)cur.pm * tstep;
    PG8_STAGE(PG8_SB(0, 0), cB, voffB); PG8_STAGE(PG8_SB(0, 1), cB + hstep, voffB); PG8_STAGE_A(PG8_SA(0, 0), cA, 0, vA0, vA1); PG8_STAGE_A(PG8_SA(0, 1), cA, 1, vA0, vA1);
    if (wr == 1) PG8_BAR;
    PG8_WAIT_V(2); PG8_BAR;
    PG8_STAGE(PG8_SB(1, 0), cB + kstep, voffB); PG8_STAGE_A(PG8_SA(1, 0), cA + kstep, 0, vA0, vA1); PG8_STAGE(PG8_SB(1, 1), cB + hstep + kstep, voffB);
    PG8_WAIT_V(6); PG8_BAR;
    for (;;) {
        const bool has_next = S.next(ui + 1, nxt);
        const char* nAp; const char* nB;
        if (has_next) {
            nB = (const char*)g.Bt + (size_t)(nxt.e * g.nct + nxt.pn) * tstep;
            if constexpr (GATHER) { nAp = cA;
#pragma unroll
                for (int i = 0; i < 2; ++i) { nA0[i] = (unsigned)(tok[nxt.ui * 256 + Rl[i]] * KB + Cl[i]); nA1[i] = (unsigned)(tok[nxt.ui * 256 + 128 + Rl[i]] * KB + Cl[i]); }
            } else nAp = (const char*)g.A + (size_t)nxt.pm * tstep;
        } else { nAp = cA; nB = cB; }
        for (int t = 0; t < nt; t += 2) {
            const bool last = (t == nt - 2);
            const char* a1 = cA + (size_t)(t + 1) * kstep;
            const char* a2 = last ? nAp : cA + (size_t)(t + 2) * kstep; const char* b2 = last ? nB : cB + (size_t)(t + 2) * kstep;
            const char* a3 = a2 + kstep; const char* b3 = b2 + kstep;
            unsigned w0[2] = {0u, 0u}, w1[2] = {0u, 0u};
            if constexpr (GATHER) {
#pragma unroll
                for (int i = 0; i < 2; ++i) { w0[i] = last ? nA0[i] : vA0[i]; w1[i] = last ? nA1[i] : vA1[i]; } }
            if constexpr (Epi::MIDHOOK) { if (t == nt / 2) E.mid(acc, cur, wr, wc, fr, fq); }
            PG8_LDB(B0, 0, 0); PG8_LDB(B1, 0, 1); PG8_SCHED; PG8_LDA(At, 0, 0); PG8_STAGE_A(PG8_SA(1, 1), a1, 1, vA0, vA1);
            PG8_WAIT_V(8); PG8_WAIT_L(0); PG8_BAR; PG8_MM(0, 0, At, B0); PG8_MM(0, 1, At, B1); PG8_BAR; PG8_SCHED;
            PG8_LDA(At, 0, 1); PG8_STAGE(PG8_SB(0, 0), b2, voffB); PG8_STAGE(PG8_SB(0, 1), b2 + hstep, voffB); PG8_STAGE_A(PG8_SA(0, 0), a2, 0, w0, w1);
            PG8_WAIT_V(8); PG8_WAIT_L(0); PG8_BAR; PG8_MM(1, 0, At, B0); PG8_MM(1, 1, At, B1); PG8_BAR; PG8_SCHED;
            PG8_LDB(B0, 1, 0); PG8_LDB(B1, 1, 1); PG8_SCHED; PG8_LDA(At, 1, 0); PG8_STAGE_A(PG8_SA(0, 1), a2, 1, w0, w1);
            PG8_WAIT_V(8); PG8_WAIT_L(0); PG8_BAR; PG8_MM(0, 0, At, B0); PG8_MM(0, 1, At, B1); PG8_BAR; PG8_SCHED;
            PG8_LDA(At, 1, 1); PG8_STAGE(PG8_SB(1, 0), b3, voffB); PG8_STAGE(PG8_SB(1, 1), b3 + hstep, voffB); PG8_STAGE_A(PG8_SA(1, 0), a3, 0, w0, w1);
            PG8_WAIT_V(8); PG8_WAIT_L(0); PG8_BAR; PG8_MM(1, 0, At, B0); PG8_MM(1, 1, At, B1); PG8_BAR; PG8_SCHED;
        }
        if constexpr (ALIGN_EPI) { if (wr == 0) PG8_BAR; }
        E(acc, cur, wr, wc, fr, fq);
        if (!has_next) break;
#pragma unroll
        for (int a = 0; a < 2; ++a)
#pragma unroll
            for (int b = 0; b < 2; ++b)
#pragma unroll
                for (int m = 0; m < 4; ++m)
#pragma unroll
                    for (int n = 0; n < 2; ++n) acc[a][b][m][n] = (f32x4){0.f, 0.f, 0.f, 0.f};
        cur = nxt; cA = nAp; cB = nB; ++ui;
        if constexpr (GATHER) {
#pragma unroll
            for (int i = 0; i < 2; ++i) { vA0[i] = nA0[i]; vA1[i] = nA1[i]; } }
        if constexpr (ALIGN_EPI) { if (wr == 1) PG8_BAR; }
    }
    PG8_WAIT_V(0);
    if constexpr (!ALIGN_EPI) { if (wr == 0) PG8_BAR; }
    PG8_BAR;
#undef PG8_SA
#undef PG8_SB
#undef PG8_STAGE
#undef PG8_STAGE_A
#undef PG8_LDA
#undef PG8_LDB
#undef PG8_MMA
#undef PG8_MMA8
#undef PG8_MM
#undef PG8_WAIT_V
#undef PG8_WAIT_L
#undef PG8_BAR
#undef PG8_SCHED
}
typedef f32x4 Acc[2][2][4][2];
__device__ __forceinline__ float silu_(float x) { return x * __builtin_amdgcn_rcpf(1.f + __expf(-x)); }
__device__ __forceinline__ float sigm_(float x) { return __builtin_amdgcn_rcpf(1.f + __expf(-x)); }
__device__ __forceinline__ u32x4 pack8(const f32x4 a, const f32x4 b) { u32x4 w; w.x = cvt_pk_bf16(a[0], a[1]); w.y = cvt_pk_bf16(a[2], a[3]); w.z = cvt_pk_bf16(b[0], b[1]); w.w = cvt_pk_bf16(b[2], b[3]); return w; }
__device__ __forceinline__ u32x2 pack8_fp8(const f32x4 a, const f32x4 b) { u32x2 w; w.x = pk4_fp8(a[0], a[1], a[2], a[3]); w.y = pk4_fp8(b[0], b[1], b[2], b[3]); return w; }
__device__ __forceinline__ void unpack8(const u32x4 w, f32x4& a, f32x4& b) { a = (f32x4){bflo(w.x), bfhi(w.x), bflo(w.y), bfhi(w.y)}; b = (f32x4){bflo(w.z), bfhi(w.z), bflo(w.w), bfhi(w.w)}; }

struct EpiInproj {
    static constexpr bool MIDHOOK = false;
    const float* rs1; const float* lb; bf16_t *QS, *VV, *GS, *UU, *SBb, *RT, *GBS; h16_t* LF; float osc;
    __device__ __forceinline__ void mid(Acc&, const Unit&, int, int, int, int) const {}
    template <int ACT> __device__ __forceinline__ void plain(const Acc& acc, const float (&rs)[2][4], bf16_t* O, int pt, int row0, int wc, int fq) const {
#pragma unroll
        for (int ai = 0; ai < 2; ++ai)
#pragma unroll
            for (int m = 0; m < 4; ++m) { bf16_t* rowp = O + (size_t)(row0 + ai * HALF + m * 16) * HF + pt * 256 + wc * 32 + 8 * fq; const float r = rs[ai][m];
#pragma unroll
                for (int bj = 0; bj < 2; ++bj) { f32x4 v0 = acc[ai][bj][m][0] * r, v1 = acc[ai][bj][m][1] * r;
                    if (ACT == 1) {
#pragma unroll
                        for (int j = 0; j < 4; ++j) { v0[j] = silu_(v0[j]); v1[j] = silu_(v1[j]); } }
                    *(u32x4*)(rowp + bj * HALF) = pack8(v0, v1); } }
    }
    __device__ __forceinline__ void operator()(const Acc& acc, const Unit& u, int wr, int wc, int fr, int fq) const {
        const int row0 = u.pm * BM + wr * 64 + fr, pn = u.pn;
        float rs[2][4];
#pragma unroll
        for (int ai = 0; ai < 2; ++ai)
#pragma unroll
            for (int m = 0; m < 4; ++m) rs[ai][m] = rs1[row0 + ai * HALF + m * 16] * osc;
        asm volatile("" : "+v"(rs[0][0]), "+v"(rs[0][1]), "+v"(rs[0][2]), "+v"(rs[0][3]), "+v"(rs[1][0]), "+v"(rs[1][1]), "+v"(rs[1][2]), "+v"(rs[1][3]));
        if (pn < 4) plain<1>(acc, rs, QS, pn, row0, wc, fq);
        else if (pn < 8) {
            const int c0 = (pn - 4) * 256 + wc * 32 + 4 * fq;
            f32x4 lbv[2][2];
#pragma unroll
            for (int bj = 0; bj < 2; ++bj)
#pragma unroll
                for (int n = 0; n < 2; ++n) lbv[bj][n] = *(const f32x4*)(lb + c0 + bj * HALF + n * 16);
#pragma unroll
            for (int ai = 0; ai < 2; ++ai)
#pragma unroll
                for (int m = 0; m < 4; ++m) { h16_t* rowp = LF + (size_t)(row0 + ai * HALF + m * 16) * HF + c0; const float r = rs[ai][m];
#pragma unroll
                    for (int bj = 0; bj < 2; ++bj)
#pragma unroll
                        for (int n = 0; n < 2; ++n) { f32x4 v = acc[ai][bj][m][n] * r; const f32x4 l = lbv[bj][n];
#pragma unroll
                            for (int j = 0; j < 4; ++j) v[j] = __logf(l[j] + (1.f - l[j]) * sigm_(v[j]));
                            *(h16x4*)(rowp + bj * HALF + n * 16) = (h16x4){(h16_t)v[0], (h16_t)v[1], (h16_t)v[2], (h16_t)v[3]}; } }
        }
        else if (pn < 12) plain<0>(acc, rs, VV, pn - 8, row0, wc, fq);
        else if (pn < 16) plain<1>(acc, rs, GS, pn - 12, row0, wc, fq);
        else if (pn < 24) {
            const int c0 = (pn - 16) * 128 + wc * 32 + 8 * fq;
#pragma unroll
            for (int ai = 0; ai < 2; ++ai)
#pragma unroll
                for (int m = 0; m < 4; ++m) { const float r2 = rs[ai][m] * rs[ai][m];
                    const f32x4 v0 = acc[ai][0][m][0] * acc[ai][1][m][0] * r2, v1 = acc[ai][0][m][1] * acc[ai][1][m][1] * r2;
                    *(u32x4*)(UU + (size_t)(row0 + ai * HALF + m * 16) * HF + c0) = pack8(v0, v1); }
        }
        else if (pn < 28) plain<0>(acc, rs, SBb, pn - 24, row0, wc, fq);
        else {
            const int c0 = (pn - 28) * 128 + wc * 32 + 8 * fq;
#pragma unroll
            for (int ai = 0; ai < 2; ++ai)
#pragma unroll
                for (int m = 0; m < 4; ++m) { const float r = rs[ai][m]; f32x4 q0, q1, b0, b1;
#pragma unroll
                    for (int j = 0; j < 4; ++j) { const float ea = 1.f + __expf(-acc[ai][0][m][0][j] * r), eb = 1.f + __expf(-acc[ai][1][m][0][j] * r); b0[j] = __builtin_amdgcn_rcpf(eb); q0[j] = eb * __builtin_amdgcn_rcpf(ea);
                                                  const float fa = 1.f + __expf(-acc[ai][0][m][1][j] * r), fb = 1.f + __expf(-acc[ai][1][m][1][j] * r); b1[j] = __builtin_amdgcn_rcpf(fb); q1[j] = fb * __builtin_amdgcn_rcpf(fa); }
                    const size_t o = (size_t)(row0 + ai * HALF + m * 16) * D + c0;
                    *(u32x4*)(RT + o) = pack8(q0, q1); *(u32x4*)(GBS + o) = pack8(b0, b1); }
        }
    }
};

struct EpiMerge {
    static constexpr bool MIDHOOK = true;
    const bf16_t *RT, *GBS; bf16_t* MG;
    __device__ __forceinline__ void mid(Acc& acc, const Unit& u, int wr, int wc, int fr, int fq) const {
        unsigned o0 = ((unsigned)(u.pm * BM + wr * 64 + fr) * D + (unsigned)(u.pn * BM + wc * 32 + 8 * fq)) * 2u;
        asm volatile("" : "+v"(o0));
#pragma unroll
        for (int ai = 0; ai < 2; ++ai)
#pragma unroll
            for (int m = 0; m < 4; ++m)
#pragma unroll
                for (int bj = 0; bj < 2; ++bj) { const u32x4 w = *(const GAS u32x4*)((const GAS char*)RT + (o0 + (unsigned)((ai * HALF + m * 16) * D + bj * HALF) * 2u)); f32x4 a, b; unpack8(w, a, b);
                    acc[ai][bj][m][0] *= a; acc[ai][bj][m][1] *= b; }
    }
    __device__ __forceinline__ void operator()(const Acc& acc, const Unit& u, int wr, int wc, int fr, int fq) const {
        unsigned o0 = ((unsigned)(u.pm * BM + wr * 64 + fr) * D + (unsigned)(u.pn * BM + wc * 32 + 8 * fq)) * 2u;
        asm volatile("" : "+v"(o0));
#pragma unroll
        for (int ai = 0; ai < 2; ++ai)
#pragma unroll
            for (int m = 0; m < 4; ++m)
#pragma unroll
                for (int bj = 0; bj < 2; ++bj) { const unsigned o = o0 + (unsigned)((ai * HALF + m * 16) * D + bj * HALF) * 2u; const u32x4 w = *(const GAS u32x4*)((const GAS char*)GBS + o); f32x4 a, b; unpack8(w, a, b);
                    *(GAS u32x4*)((GAS char*)MG + o) = pack8(acc[ai][bj][m][0] * a, acc[ai][bj][m][1] * b); if (bj == 1 && m == 3) asm volatile("" ::: "memory"); }
    }
};

struct EpiWo {
    static constexpr bool MIDHOOK = false;
    bf16_t* DL;
    __device__ __forceinline__ void mid(Acc&, const Unit&, int, int, int, int) const {}
    __device__ __forceinline__ void operator()(const Acc& acc, const Unit& u, int wr, int wc, int fr, int fq) const {
        const int row0 = u.pm * BM + wr * 64 + fr, c0 = u.pn * BM + wc * 32 + 8 * fq;
#pragma unroll
        for (int ai = 0; ai < 2; ++ai)
#pragma unroll
            for (int m = 0; m < 4; ++m)
#pragma unroll
                for (int bj = 0; bj < 2; ++bj) *(u32x4*)(DL + (size_t)(row0 + ai * HALF + m * 16) * D + c0 + bj * HALF) = pack8(acc[ai][bj][m][0], acc[ai][bj][m][1]);
    }
};

struct EpiUp {
    static constexpr bool MIDHOOK = false;
    const float* rs2; const LAS int* tok; const float* b_up; unsigned char* ACT;
    __device__ __forceinline__ void mid(Acc&, const Unit&, int, int, int, int) const {}
    __device__ __forceinline__ void operator()(const Acc& acc, const Unit& u, int wr, int wc, int fr, int fq) const {
        const int rl0 = wr * 64 + fr, c0 = u.pn * 128 + wc * 32 + 8 * fq;
        float rs[2][4];
#pragma unroll
        for (int ai = 0; ai < 2; ++ai)
#pragma unroll
            for (int m = 0; m < 4; ++m) rs[ai][m] = rs2[tok[u.ui * 256 + rl0 + ai * HALF + m * 16]] * W8_INV;
        const float* bp = b_up + (size_t)u.e * 4096 + c0;
        const f32x4 bg0 = *(const f32x4*)(bp), bg1 = *(const f32x4*)(bp + 4), bu0 = *(const f32x4*)(bp + 2048), bu1 = *(const f32x4*)(bp + 2052);
#pragma unroll
        for (int ai = 0; ai < 2; ++ai)
#pragma unroll
            for (int m = 0; m < 4; ++m) { const float r = rs[ai][m]; f32x4 a0, a1;
#pragma unroll
                for (int n = 0; n < 2; ++n)
#pragma unroll
                    for (int jp = 0; jp < 2; ++jp) {
                        const f32x4 ag = acc[ai][0][m][n], au = acc[ai][1][m][n], bgv = n ? bg1 : bg0, buv = n ? bu1 : bu0;
                        f32x2 g = (f32x2){ag[2 * jp], ag[2 * jp + 1]} * r + (f32x2){bgv[2 * jp], bgv[2 * jp + 1]};
                        f32x2 uu = (f32x2){au[2 * jp], au[2 * jp + 1]} * r + (f32x2){buv[2 * jp], buv[2 * jp + 1]};
                        g.x = fminf(g.x, 7.f); g.y = fminf(g.y, 7.f);
                        uu.x = __builtin_amdgcn_fmed3f(uu.x, -7.f, 7.f); uu.y = __builtin_amdgcn_fmed3f(uu.y, -7.f, 7.f);
                        const f32x2 t = g * (-1.702f * 1.44269504f);
                        f32x2 den; den.x = __builtin_amdgcn_exp2f(t.x); den.y = __builtin_amdgcn_exp2f(t.y); den = den + 1.f;
                        f32x2 s; s.x = __builtin_amdgcn_rcpf(den.x); s.y = __builtin_amdgcn_rcpf(den.y);
                        const f32x2 a = (uu + 1.f) * (g * s);
                        if (n == 0) { a0[2 * jp] = a.x; a0[2 * jp + 1] = a.y; } else { a1[2 * jp] = a.x; a1[2 * jp + 1] = a.y; }
                    }
                *(u32x2*)(ACT + (size_t)(u.pm * BM + rl0 + ai * HALF + m * 16) * DFF + c0) = pack8_fp8(a0, a1); }
    }
};

struct EpiDown {
    static constexpr bool MIDHOOK = false;
    const float* b_dn; unsigned char* YR;
    __device__ __forceinline__ void mid(Acc&, const Unit&, int, int, int, int) const {}
    __device__ __forceinline__ void operator()(const Acc& acc, const Unit& u, int wr, int wc, int fr, int fq) const {
        const int rl0 = wr * 64 + fr, c0 = u.pn * BM + wc * 32 + 8 * fq;
        const float* bp = b_dn + (size_t)u.e * D + c0;
        f32x4 bv[2][2];
#pragma unroll
        for (int bj = 0; bj < 2; ++bj)
#pragma unroll
            for (int n = 0; n < 2; ++n) bv[bj][n] = *(const f32x4*)(bp + bj * HALF + 4 * n);
#pragma unroll
        for (int ai = 0; ai < 2; ++ai)
#pragma unroll
            for (int m = 0; m < 4; ++m)
#pragma unroll
                for (int bj = 0; bj < 2; ++bj)
                    *(u32x2*)(YR + (size_t)(u.pm * BM + rl0 + ai * HALF + m * 16) * D + c0 + bj * HALF) = pack8_fp8(acc[ai][bj][m][0] * W8_INV + bv[bj][0], acc[ai][bj][m][1] * W8_INV + bv[bj][1]);
    }
};

struct EpiDummy {
    static constexpr bool MIDHOOK = false;
    bf16_t* O; int nostore;
    __device__ __forceinline__ void mid(Acc&, const Unit&, int, int, int, int) const {}
    __device__ __forceinline__ void operator()(const Acc& acc, const Unit& u, int wr, int wc, int fr, int fq) const {
        const int row0 = (u.pm & 63) * BM + wr * 64 + fr, c0 = (u.pn & 7) * BM + wc * 32 + 8 * fq;
        if (nostore) {
#pragma unroll
            for (int ai = 0; ai < 2; ++ai)
#pragma unroll
                for (int m = 0; m < 4; ++m)
#pragma unroll
                    for (int bj = 0; bj < 2; ++bj) asm volatile("" :: "v"(acc[ai][bj][m][0]), "v"(acc[ai][bj][m][1]));
            return; }
#pragma unroll
        for (int ai = 0; ai < 2; ++ai)
#pragma unroll
            for (int m = 0; m < 4; ++m)
#pragma unroll
                for (int bj = 0; bj < 2; ++bj) *(u32x4*)(O + (size_t)(row0 + ai * HALF + m * 16) * D + c0 + bj * HALF) = pack8(acc[ai][bj][m][0], acc[ai][bj][m][1]);
    }
};
struct ProbeOrder {
    StaticOrder S; int mode, c;
    __device__ __forceinline__ bool next(int i, Unit& u) const {
        if (mode == 3) { if (c & 1) return false; StaticOrder H = S; H.G = S.G / 2; H.c = c >> 1; H.nwg = S.nwg / 2; return H.next(i, u); }
        if (!S.next(i, u)) return false; if (mode >= 1) u.pn = 0; if (mode >= 2) u.pm = c & 63; return true; }
};

struct ProbeMoe {
    MoeOrder S; int mode;
    __device__ __forceinline__ bool next(int i, Unit& u) const { if (!S.next(i, u)) return false; if (mode & 1) { u.e = 0; u.pn = 0; } if (mode & 2) u.pm = 0; return true; }
};
struct Frame {
    LAS unsigned char* lds; volatile LAS unsigned* MISC; gu32* ctl; unsigned char* ws;
    int tid, lane, wave, vcu, G;
    const float *x, *meta, *nmw, *w_in, *lbl, *gnw, *w_ho, *cw, *w_co, *w_o, *nfw, *w_r, *b_r, *w_up, *b_up, *w_dn, *b_dn, *fnw; float* out;
};
template <class T> __device__ __forceinline__ T* wsp(const Frame& F, size_t off) { return (T*)(F.ws + off); }

__device__ __forceinline__ void tr_tile(const float* W, int ldw, int k0, int src0, int src1, bool perm0, bool perm1, const float* kscale, bf16_t* dst, int dpitch, int drow0, int dk0, LAS unsigned* T, int lane) {
    const int ln = lane & 15, kr = lane >> 4, srcc = (ln < 8 ? src0 : src1) + 4 * (ln & 7);
    const float* wp = W + (size_t)(k0 + 2 * kr) * ldw + srcc;
    f32x4 va[8], vb[8]; f32x2 sc[8];
#pragma unroll
    for (int s = 0; s < 8; ++s) { va[s] = __builtin_nontemporal_load((const GAS f32x4*)(wp + (size_t)(8 * s) * ldw)); vb[s] = __builtin_nontemporal_load((const GAS f32x4*)(wp + (size_t)(8 * s + 1) * ldw));
        sc[s] = kscale ? *(const GAS f32x2*)(kscale + k0 + 8 * s + 2 * kr) : (f32x2){1.f, 1.f}; }
    __builtin_amdgcn_sched_barrier(0);
#pragma unroll
    for (int s = 0; s < 8; ++s) { const int col = (4 * s + kr) ^ (2 * ln);
#pragma unroll
        for (int i = 0; i < 4; ++i) T[(4 * ln + i) * 32 + col] = cvt_pk_bf16(va[s][i] * sc[s].x, vb[s][i] * sc[s].y); }
    LDS_WAIT(); asm volatile("" ::: "memory");
    const int c = lane & 7;
#pragma unroll
    for (int j = 0; j < 8; ++j) { const int rho = (lane >> 3) + 8 * j, h = rho >> 5, r32 = rho & 31; const bool pm = h ? perm1 : perm0; const int n = h * 32 + (pm ? perm32(r32) : r32);
        u32x4 v = *(const LAS u32x4*)(T + n * 32 + 4 * (c ^ (n >> 3)));
        if ((n >> 2) & 1) v = (u32x4){v.z, v.w, v.x, v.y};
        *(GAS u32x4*)(dst + (size_t)(drow0 + rho) * dpitch + dk0 + k0 + 8 * c) = v; }
    LDS_WAIT(); asm volatile("" ::: "memory");
}
template <int PMODE = 0> __device__ __forceinline__ void tr_tile_fp8(const float* W, int ldw, int k0, int src0, int src1, const float* kscale, unsigned char* dst, int dpitch, int drow0, LAS unsigned* T, int lane, bool perm = true) {
    const int ln = lane & 15, kr = lane >> 4, srcc = (ln < 8 ? src0 : src1) + 4 * (ln & 7);
    f32x4 v[2][4][4];
#pragma unroll
    for (int half = 0; half < 2; ++half) {
        const float* wp = W + (size_t)(k0 + 64 * half + 4 * kr) * ldw + srcc;
#pragma unroll
        for (int s = 0; s < 4; ++s) {
#pragma unroll
            for (int q = 0; q < 4; ++q) v[half][s][q] = __builtin_nontemporal_load((const GAS f32x4*)(wp + (size_t)(16 * s + q) * ldw)); }
    }
    __builtin_amdgcn_sched_barrier(0);
    if (PMODE == 1) {
#pragma unroll
        for (int half = 0; half < 2; ++half)
#pragma unroll
            for (int s = 0; s < 4; ++s)
#pragma unroll
                for (int q = 0; q < 4; ++q) asm volatile("" :: "v"(v[half][s][q]));
        return; }
#pragma unroll
    for (int half = 0; half < 2; ++half)
#pragma unroll
        for (int s = 0; s < 4; ++s) { const int col = (16 * half + 4 * s + kr) ^ (2 * ln);
            const f32x4 sc = kscale ? *(const GAS f32x4*)(kscale + k0 + 64 * half + 16 * s + 4 * kr) * W8_SCALE : (f32x4){W8_SCALE, W8_SCALE, W8_SCALE, W8_SCALE};
#pragma unroll
            for (int i = 0; i < 4; ++i) T[(4 * ln + i) * 32 + col] = pk4_fp8(v[half][s][0][i] * sc[0], v[half][s][1][i] * sc[1], v[half][s][2][i] * sc[2], v[half][s][3][i] * sc[3]); }
    LDS_WAIT(); asm volatile("" ::: "memory");
    const int c = lane & 7;
#pragma unroll
    for (int j = 0; j < 8; ++j) { const int rho = (lane >> 3) + 8 * j, h = rho >> 5, r32 = rho & 31; const int n = h * 32 + (perm ? perm32(r32) : r32);
        u32x4 v4 = *(const LAS u32x4*)(T + n * 32 + 4 * (c ^ (n >> 3)));
        if ((n >> 2) & 1) v4 = (u32x4){v4.z, v4.w, v4.x, v4.y};
        if (PMODE == 2) asm volatile("" :: "v"(v4)); else *(GAS u32x4*)(dst + (size_t)(drow0 + rho) * dpitch + k0 + 16 * c) = v4; }
    LDS_WAIT(); asm volatile("" ::: "memory");
}
__device__ __forceinline__ int win_src(int G, bool& perm) {
    const int pn = G >> 3, gi = G & 7; perm = true;
    if (pn < 4) return C_Q + pn * 256 + gi * 32;
    if (pn < 8) { perm = false; return C_F + (pn - 4) * 256 + gi * 32; }
    if (pn < 12) return C_V + (pn - 8) * 256 + gi * 32;
    if (pn < 16) return C_G + (pn - 12) * 256 + gi * 32;
    if (pn < 24) return (gi < 4 ? C_SV : C_SC) + (pn - 16) * 128 + (gi & 3) * 32;
    if (pn < 28) return C_SB + (pn - 24) * 256 + gi * 32;
    return (gi < 4 ? C_GA : C_GB) + (pn - 28) * 128 + (gi & 3) * 32;
}
__device__ __forceinline__ void p0_prologue(Frame& F) {
    const int gw = F.vcu * NWAVES + F.wave, NGW = F.G * NWAVES, gt = F.vcu * NTHR + F.tid, NGT = F.G * NTHR;
    for (int i = gt; i < HF; i += NGT) wsp<float>(F, WS_LB)[i] = 1.f / (1.f + __expf(F.lbl[HF + i] - F.lbl[i]));
    for (int i = gt; i < D * NE; i += NGT) { const int k = i >> 5, e = i & 31; const float v = F.w_r[i] * F.nfw[k]; const unsigned h = f2bf(v); const float lo = v - bf2f((unsigned short)h);
        wsp<bf16_t>(F, WS_WRH)[e * D + k] = (bf16_t)h; wsp<bf16_t>(F, WS_WRL)[e * D + k] = (bf16_t)f2bf(lo); }
    for (int i = gt; i < 48 * HF; i += NGT) { wsp<h16_t>(F, WS_LFM)[i] = (h16_t)0.f; wsp<bf16_t>(F, WS_VVM)[i] = 0; }
    {
        LAS float* hnm = (LAS float*)F.lds;
        for (int r = F.wave * 2; r < F.wave * 2 + 2; ++r) {
            const f32x4* xr = (const f32x4*)(F.meta + (size_t)r * D) + F.lane; f32x4 v[8]; float s = 0.f;
#pragma unroll
            for (int j = 0; j < 8; ++j) { v[j] = xr[64 * j]; s += (v[j].x * v[j].x + v[j].y * v[j].y) + (v[j].z * v[j].z + v[j].w * v[j].w); }
            const float rs = rsqrtf(wave_sum(s) * (1.f / D) + EPS);
#pragma unroll
            for (int j = 0; j < 8; ++j) { const f32x4 w = ((const f32x4*)F.nmw)[F.lane + 64 * j]; *(LAS f32x4*)(hnm + r * D + 4 * F.lane + 256 * j) = v[j] * rs * w; }
        }
        __syncthreads();
        LAS float* red = (LAS float*)(F.lds + TOK_OFF);
        for (int cb = F.vcu; cb < 256; cb += F.G) {
            const int col = F.tid & 15, ks = F.tid >> 4;
            int gcol;
            if (cb < 64) gcol = C_F + 16 * cb + col; else if (cb < 128) gcol = C_V + 16 * (cb - 64) + col; else gcol = (col < 8 ? C_SV : C_SC) + 8 * (cb - 128) + (col & 7);
            float a[16];
#pragma unroll
            for (int r = 0; r < 16; ++r) a[r] = 0.f;
            for (int k = ks * 64; k < ks * 64 + 64; ++k) { const float w = F.w_in[(size_t)k * INC + gcol];
#pragma unroll
                for (int r = 0; r < 16; ++r) a[r] = fmaf(hnm[r * D + k], w, a[r]); }
#pragma unroll
            for (int r = 0; r < 16; ++r) { a[r] += __shfl_xor(a[r], 16); a[r] += __shfl_xor(a[r], 32); }
            if (F.lane < 16) {
#pragma unroll
                for (int r = 0; r < 16; ++r) red[(F.wave * 16 + r) * 16 + col] = a[r]; }
            __syncthreads();
            if (F.tid < 256) { const int r = F.tid >> 4, c = F.tid & 15; float v = 0.f;
#pragma unroll
                for (int w = 0; w < 8; ++w) v += red[(w * 16 + r) * 16 + c];
                if (cb < 64) { const int ch = 16 * cb + c; const float l = 1.f / (1.f + __expf(F.lbl[HF + ch] - F.lbl[ch])); wsp<h16_t>(F, WS_LFM)[(48 + r) * HF + ch] = (h16_t)__logf(l + (1.f - l) * sigmoidf_(v)); }
                else if (cb < 128) wsp<bf16_t>(F, WS_VVM)[(48 + r) * HF + 16 * (cb - 64) + c] = (bf16_t)f2bf(v);
                else red[2048 + r * 16 + c] = v; }
            __syncthreads();
            if (cb >= 128 && F.tid < 128) { const int r = F.tid >> 3, c = F.tid & 7; wsp<bf16_t>(F, WS_UUM)[r * HF + 8 * (cb - 128) + c] = (bf16_t)f2bf(red[2048 + r * 16 + c] * red[2048 + r * 16 + c + 8]); }
            __syncthreads();
        }
        __syncthreads();
    }
    {
        LAS unsigned* T = (LAS unsigned*)(F.lds + F.wave * 16384);
        constexpr int I_IN = 32 * 4 * N_INB, I_AB = 16 * 32, I_O = 32 * 32, I_UP1 = 16 * 64, I_DN1 = 16 * 32;
        constexpr int I_IN8 = 16 * 4 * N_IN8;
        constexpr int NIT = I_IN + I_IN8 + 2 * I_AB + I_O;
        for (int it = gw; it < NIT; it += NGW) {
            int r = it;
            if (r < I_IN) { const int kb = r / (4 * N_INB), ntl = r % (4 * N_INB), nt = 4 * nth_bit(INB_MASK, ntl >> 2) + (ntl & 3); bool p0, p1; const int s0 = win_src(2 * nt, p0), s1 = win_src(2 * nt + 1, p1); tr_tile(F.w_in, INC, kb * 64, s0, s1, p0, p1, F.nmw, wsp<bf16_t>(F, WS_WIN), D, nt * 64, 0, T, F.lane); continue; } r -= I_IN;
            if (r < I_IN8) { const int kb = r / (4 * N_IN8), ntl = r % (4 * N_IN8), nt = 4 * nth_bit(IN8_MASK, ntl >> 2) + (ntl & 3); bool p0, p1; const int s0 = win_src(2 * nt, p0), s1 = win_src(2 * nt + 1, p1);
                tr_tile_fp8<0>(F.w_in, INC, kb * 128, s0, s1, F.nmw, wsp<unsigned char>(F, WS_WIN8), D, nt * 64, T, F.lane, p0); continue; } r -= I_IN8;
            if (r < I_AB) { const int kb = r / 32, nt = r % 32; tr_tile(F.w_ho, D, kb * 64, nt * 64, nt * 64 + 32, true, true, nullptr, wsp<bf16_t>(F, WS_WAB), D, nt * 64, 0, T, F.lane); continue; } r -= I_AB;
            if (r < I_AB) { const int kb = r / 32, nt = r % 32; tr_tile(F.w_co, D, kb * 64, nt * 64, nt * 64 + 32, true, true, nullptr, wsp<bf16_t>(F, WS_WAB), D, nt * 64, HF, T, F.lane); continue; } r -= I_AB;
            if (r < I_O) { const int kb = r / 32, nt = r % 32; tr_tile(F.w_o, D, kb * 64, nt * 64, nt * 64 + 32, true, true, nullptr, wsp<bf16_t>(F, WS_WO), D, nt * 64, 0, T, F.lane); continue; } r -= I_O;
        }
    }
    for (int m = gw; m < M; m += NGW) {
        const GAS f32x4* xr = (const GAS f32x4*)(F.x + (size_t)m * D) + F.lane; f32x4 v[8]; float s = 0.f;
#pragma unroll
        for (int j = 0; j < 8; ++j) v[j] = xr[64 * j];
        __builtin_amdgcn_sched_barrier(0);
#pragma unroll
        for (int j = 0; j < 8; ++j) s += (v[j].x * v[j].x + v[j].y * v[j].y) + (v[j].z * v[j].z + v[j].w * v[j].w);
        s = wave_sum(s);
        GAS u32x2* o8 = (GAS u32x2*)(wsp<bf16_t>(F, WS_XB) + (size_t)m * D) + F.lane;
#pragma unroll
        for (int j = 0; j < 8; ++j) { u32x2 w; w.x = pk2(v[j].x, v[j].y); w.y = pk2(v[j].z, v[j].w); o8[64 * j] = w; }
        GAS unsigned* o4 = (GAS unsigned*)(wsp<unsigned char>(F, WS_XB8) + (size_t)m * D) + F.lane;
#pragma unroll
        for (int j = 0; j < 8; ++j) o4[64 * j] = pk4_fp8(v[j].x, v[j].y, v[j].z, v[j].w);
        if (F.lane == 0) wsp<float>(F, WS_RS1)[m] = rsqrtf(s * (1.f / D) + EPS);
    }
}

template <int PMODE = 0> __device__ __forceinline__ void p1_convert(Frame& F, int rank, int nconv) {
    LAS unsigned* T = (LAS unsigned*)(F.lds + F.wave * 16384);
    constexpr int I_UP1 = 16 * 64, I_DN1 = 16 * 32, NIT = NE * (I_UP1 + I_DN1);
    for (int it = rank * NWAVES + F.wave; it < NIT; it += nconv * NWAVES) {
        int r = it;
        if (r < NE * I_UP1) { const int e = r / I_UP1, q = r % I_UP1, kb = q / 64, nt = q % 64, G0 = 2 * nt, pn = G0 >> 3, gi = G0 & 7; const int s0 = (gi < 4 ? 0 : 2048) + pn * 128 + (gi & 3) * 32;
            tr_tile_fp8<PMODE>(F.w_up + (size_t)e * D * 4096, 4096, kb * 128, s0, s0 + 32, F.nfw, wsp<unsigned char>(F, WS_WUP) + (size_t)e * 4096 * D, D, nt * 64, T, F.lane); continue; } r -= NE * I_UP1;
        { const int e = r / I_DN1, q = r % I_DN1, kb = q / 32, nt = q % 32;
          tr_tile_fp8<PMODE>(F.w_dn + (size_t)e * DFF * D, D, kb * 128, nt * 64, nt * 64 + 32, nullptr, wsp<unsigned char>(F, WS_WDN) + (size_t)e * D * DFF, DFF, nt * 64, T, F.lane); }
    }
}

constexpr int KTP = 72;
constexpr int QP_ = 136;
__device__ __forceinline__ void vt_load(const Frame& F, const bf16_t* Vb, size_t row0, int h, u32x4 (&w)[2]) {
#pragma unroll
    for (int q = 0; q < 2; ++q) { const int id = F.tid + 512 * q, t = id >> 4, v8 = (id & 15) * 8; w[q] = *(const GAS u32x4*)(Vb + (row0 + t) * HF + h * 128 + v8); }
}
__device__ __forceinline__ void vt_store(const Frame& F, const u32x4 (&w)[2], LAS bf16_t* VT) {
#pragma unroll
    for (int q = 0; q < 2; ++q) { const int id = F.tid + 512 * q, t = id >> 4, v8 = (id & 15) * 8; const unsigned ww[4] = {w[q].x, w[q].y, w[q].z, w[q].w};
        const int ts = t ^ (v8 & 24);
#pragma unroll
        for (int i = 0; i < 4; ++i) { VT[(v8 + 2 * i) * KTP + ts] = (bf16_t)(ww[i] & 0xffffu); VT[(v8 + 2 * i + 1) * KTP + ts] = (bf16_t)(ww[i] >> 16); } }
}
__device__ __forceinline__ int vt_off(int v, int t0) { return v * KTP + (t0 ^ (v & 24)); }
struct P2aRegs { float L[16]; u32x4 vw[2]; };
__device__ __forceinline__ void p2a_where(const Frame& F, int u, const h16_t*& Lb, const bf16_t*& Vb, size_t& row0, int& h, int& slot) {
    if (u < 8) { Lb = wsp<h16_t>(F, WS_LFM); Vb = wsp<bf16_t>(F, WS_VVM); row0 = 0; h = u; slot = 32 * 64 + u; }
    else { const int bh = (u - 8) >> 6, c = (u - 8) & 63, b = bh >> 3; h = bh & 7; Lb = wsp<h16_t>(F, WS_LF); Vb = wsp<bf16_t>(F, WS_VV); row0 = (size_t)b * SEQ + 64 * c; slot = bh * 64 + c; }
}
__device__ __forceinline__ void p2a_load(const Frame& F, int u, P2aRegs& R) {
    const h16_t* Lb; const bf16_t* Vb; size_t row0; int h, slot; p2a_where(F, u, Lb, Vb, row0, h, slot);
    const int d = F.tid & 127, tq = F.tid >> 7;
#pragma unroll
    for (int i = 0; i < 16; ++i) R.L[i] = (float)Lb[(row0 + 16 * tq + i) * HF + h * 128 + d];
    vt_load(F, Vb, row0, h, R.vw);
}
__device__ __forceinline__ void p2a_compute(Frame& F, int u, const P2aRegs& R) {
    LAS bf16_t* KT = (LAS bf16_t*)F.lds; LAS bf16_t* VT = KT + 128 * KTP; LAS float* TOT = (LAS float*)(F.lds + 2 * 128 * KTP * 2);
    const h16_t* Lb; const bf16_t* Vb; size_t row0; int h, slot; p2a_where(F, u, Lb, Vb, row0, h, slot);
    const int d = F.tid & 127, tq = F.tid >> 7;
    float cs[16]; float run = 0.f;
#pragma unroll
    for (int i = 0; i < 16; ++i) { run += R.L[i]; cs[i] = run; }
    TOT[tq * 128 + d] = run;
    vt_store(F, R.vw, VT);
    __syncthreads();
    float off = 0.f, total = 0.f;
#pragma unroll
    for (int q = 0; q < 4; ++q) { const float tv = TOT[q * 128 + d]; total += tv; if (q < tq) off += tv; }
#pragma unroll
    for (int i = 0; i < 16; i += 2) { const float k0 = (1.f - __expf(R.L[i])) * __expf(total - off - cs[i]), k1 = (1.f - __expf(R.L[i + 1])) * __expf(total - off - cs[i + 1]);
        *(LAS unsigned*)(KT + d * KTP + 16 * tq + i) = pk2(k0, k1); }
    if (tq == 0) wsp<float>(F, WS_DEC)[(size_t)slot * 128 + d] = __expf(total);
    __syncthreads();
    {
        const int w = F.wave, fr = F.lane & 15, fq = F.lane >> 4;
        bf16x8 a[2];
#pragma unroll
        for (int ks = 0; ks < 2; ++ks) a[ks] = *(const LAS bf16x8*)(KT + (16 * w + fr) * KTP + 32 * ks + 8 * fq);
        bf16_t* Ub = wsp<bf16_t>(F, WS_UC) + (size_t)slot * 16384;
#pragma unroll
        for (int vb = 0; vb < 8; ++vb) { f32x4 c = (f32x4){0.f, 0.f, 0.f, 0.f};
#pragma unroll
            for (int ks = 0; ks < 2; ++ks) { const bf16x8 bv = *(const LAS bf16x8*)(VT + vt_off(16 * vb + fr, 32 * ks + 8 * fq)); c = __builtin_amdgcn_mfma_f32_16x16x32_bf16(a[ks], bv, c, 0, 0, 0); }
            u32x2 o; o.x = pk2(c[0], c[1]); o.y = pk2(c[2], c[3]);
            *(GAS u32x2*)(Ub + (16 * vb + fr) * 128 + 16 * w + 4 * fq) = o; }
    }
    __syncthreads();
}
__device__ __forceinline__ void p2a_units(Frame& F, int c) {
    constexpr int NU = 2048 + 8;
    if (c >= NU) return;
    P2aRegs R; p2a_load(F, c, R);
    for (int u = c; u < NU; u += F.G) {
        P2aRegs N; const int un = u + F.G; if (un < NU) p2a_load(F, un, N); else N = R;
        p2a_compute(F, u, R);
        R = N;
    }
}
__device__ __forceinline__ void p2a_conv(Frame& F, int item) {
    const int c8 = (F.tid & 127) * 8, tq = F.tid >> 7, r0 = item * 64 + tq * 16, p0 = r0 & (SEQ - 1);
    const bf16_t* UU = wsp<bf16_t>(F, WS_UU); const bf16_t* UUM = wsp<bf16_t>(F, WS_UUM); const bf16_t* SBb = wsp<bf16_t>(F, WS_SB); bf16_t* A2 = wsp<bf16_t>(F, WS_A2);
    f32x4 w0a = *(const f32x4*)(F.cw + c8), w0b = *(const f32x4*)(F.cw + c8 + 4), w1a = *(const f32x4*)(F.cw + HF + c8), w1b = *(const f32x4*)(F.cw + HF + c8 + 4), w2a = *(const f32x4*)(F.cw + 2 * HF + c8), w2b = *(const f32x4*)(F.cw + 2 * HF + c8 + 4);
    f32x4 um2a, um2b, um1a, um1b;
    { const u32x4 a = (p0 >= 2) ? *(const GAS u32x4*)(UU + (size_t)(r0 - 2) * HF + c8) : *(const GAS u32x4*)(UUM + (14 + p0) * HF + c8); unpack8(a, um2a, um2b);
      const u32x4 b = (p0 >= 1) ? *(const GAS u32x4*)(UU + (size_t)(r0 - 1) * HF + c8) : *(const GAS u32x4*)(UUM + 15 * HF + c8); unpack8(b, um1a, um1b); }
#pragma unroll 4
    for (int i = 0; i < 16; ++i) { f32x4 ua, ub, sa, sb; unpack8(*(const GAS u32x4*)(UU + (size_t)(r0 + i) * HF + c8), ua, ub); unpack8(*(const GAS u32x4*)(SBb + (size_t)(r0 + i) * HF + c8), sa, sb);
        const f32x4 oa = sa * (w0a * um2a + w1a * um1a + w2a * ua), ob = sb * (w0b * um2b + w1b * um1b + w2b * ub);
        *(GAS u32x4*)(A2 + (size_t)(r0 + i) * D + HF + c8) = pack8(oa, ob);
        um2a = um1a; um2b = um1b; um1a = ua; um1b = ub; }
}
__device__ __forceinline__ void p2b_scan(Frame& F) {
    const int gw = F.vcu * NWAVES + F.wave;
    for (int it = gw; it < 1024; it += F.G * NWAVES) {
        const int item = it * 64 + F.lane, bh = item >> 11, e8 = item & 2047, h = bh & 7, d0 = (e8 & 15) * 8;
        const bf16_t* Ub = wsp<bf16_t>(F, WS_UC) + (size_t)bh * 64 * 16384 + e8 * 8; bf16_t* Sb = wsp<bf16_t>(F, WS_SS) + (size_t)bh * 64 * 16384 + e8 * 8;
        const float* Db = wsp<float>(F, WS_DEC) + (size_t)bh * 64 * 128 + d0;
        f32x4 s0, s1; unpack8(*(const GAS u32x4*)(wsp<bf16_t>(F, WS_UC) + (size_t)(32 * 64 + h) * 16384 + e8 * 8), s0, s1);
#pragma unroll 8
        for (int c = 0; c < 64; ++c) {
            *(GAS u32x4*)(Sb + (size_t)c * 16384) = pack8(s0, s1);
            f32x4 u0, u1; unpack8(*(const GAS u32x4*)(Ub + (size_t)c * 16384), u0, u1);
            const f32x4 g0 = *(const GAS f32x4*)(Db + c * 128), g1 = *(const GAS f32x4*)(Db + c * 128 + 4);
            s0 = g0 * s0 + u0; s1 = g1 * s1 + u1;
        }
    }
}
struct P2cRegs { f32x2 L[8]; unsigned qw[8]; u32x4 vw[2]; bf16x8 sa[4]; u32x2 gv[4]; };
__device__ __forceinline__ void p2c_load(const Frame& F, int u, P2cRegs& R) {
    const int bh = u >> 6, c = u & 63, b = bh >> 3, h = bh & 7; const size_t row0 = (size_t)b * SEQ + 64 * c;
    const int dp = (F.tid & 63) * 2, t8 = F.tid >> 6, w = F.wave, fr = F.lane & 15, fq = F.lane >> 4;
    const h16_t* Lb = wsp<h16_t>(F, WS_LF) + (row0 + 8 * t8) * HF + h * 128 + dp; const bf16_t* Qb = wsp<bf16_t>(F, WS_QS) + (row0 + 8 * t8) * HF + h * 128 + dp;
#pragma unroll
    for (int i = 0; i < 8; ++i) { const h16x2 lh = *(const GAS h16x2*)(Lb + (size_t)i * HF); R.L[i] = (f32x2){(float)lh.x, (float)lh.y}; R.qw[i] = *(const GAS unsigned*)(Qb + (size_t)i * HF); }
    vt_load(F, wsp<bf16_t>(F, WS_VV), row0, h, R.vw);
    const bf16_t* Sb = wsp<bf16_t>(F, WS_SS) + ((size_t)bh * 64 + c) * 16384 + (16 * w + fr) * 128 + 8 * fq;
#pragma unroll
    for (int ks = 0; ks < 4; ++ks) R.sa[ks] = *(const GAS bf16x8*)(Sb + 32 * ks);
    const bf16_t* GSb = wsp<bf16_t>(F, WS_GS);
#pragma unroll
    for (int tb = 0; tb < 4; ++tb) R.gv[tb] = *(const GAS u32x2*)(GSb + (row0 + 16 * tb + fr) * HF + h * 128 + 16 * w + 4 * fq);
}
__device__ __forceinline__ void p2c_compute(Frame& F, int u, const P2cRegs& R) {
    const int bh = u >> 6, c = u & 63, b = bh >> 3, h = bh & 7; const size_t row0 = (size_t)b * SEQ + 64 * c;
    LAS bf16_t* QPl = (LAS bf16_t*)F.lds; LAS bf16_t* QD = QPl + 64 * QP_; LAS bf16_t* KI = QD + 64 * QP_; LAS bf16_t* VT = KI + 160 * QP_; LAS bf16_t* PL = VT + 128 * KTP;
    LAS float* TOT8 = (LAS float*)(PL + 64 * KTP); LAS float* SSQ = TOT8 + 8 * 128;
    const int dp = (F.tid & 63) * 2, t8 = F.tid >> 6;
    f32x2 L[8], cs[8], q[8]; f32x2 run = (f32x2){0.f, 0.f};
#pragma unroll
    for (int i = 0; i < 8; ++i) { L[i] = R.L[i]; q[i] = (f32x2){bflo(R.qw[i]), bfhi(R.qw[i])}; }
#pragma unroll
    for (int i = 0; i < 8; ++i) { run += L[i]; cs[i] = run; }
    *(LAS f32x2*)(TOT8 + t8 * 128 + dp) = run;
    vt_store(F, R.vw, VT);
    for (int i = F.tid; i < 64 * KTP / 2; i += NTHR) ((LAS unsigned*)PL)[i] = 0u;
    __syncthreads();
    {
        f32x2 pre[9]; pre[0] = (f32x2){0.f, 0.f};
#pragma unroll
        for (int j = 0; j < 8; ++j) pre[j + 1] = pre[j] + *(const LAS f32x2*)(TOT8 + j * 128 + dp);
        f32x2 off = (f32x2){0.f, 0.f};
#pragma unroll
        for (int j = 0; j < 8; ++j) if (j == t8) off = pre[j];
        const int si = t8 >> 1;
        f32x2 st[4];
#pragma unroll
        for (int j = 0; j < 4; ++j) st[j] = pre[2 * j];
        f32x2 sti = st[0];
#pragma unroll
        for (int j = 1; j < 4; ++j) if (j == si) sti = st[j];
#pragma unroll
        for (int i = 0; i < 8; ++i) { const int t = 8 * t8 + i; const f32x2 bc = off + cs[i];
            *(LAS unsigned*)(QPl + t * QP_ + dp) = pk2(q[i].x * __expf(bc.x), q[i].y * __expf(bc.y));
            *(LAS unsigned*)(QD + t * QP_ + dp) = pk2(q[i].x * __expf(bc.x - sti.x), q[i].y * __expf(bc.y - sti.y));
            const f32x2 k = (f32x2){1.f - __expf(L[i].x), 1.f - __expf(L[i].y)};
#pragma unroll
            for (int j = 0; j < 4; ++j) if (j >= si) {
                *(LAS unsigned*)(KI + (8 * j * (j + 1) + t) * QP_ + dp) = pk2(k.x * __expf(fminf(st[j].x - bc.x, 80.f)), k.y * __expf(fminf(st[j].y - bc.y, 80.f))); }
        }
    }
    __syncthreads();
    const int w = F.wave, fr = F.lane & 15, fq = F.lane >> 4;
    for (int bi = w; bi < 10; bi += 8) {
        const int i = bi < 1 ? 0 : bi < 3 ? 1 : bi < 6 ? 2 : 3, j = bi - (i * (i + 1)) / 2;
        f32x4 cacc = (f32x4){0.f, 0.f, 0.f, 0.f};
#pragma unroll
        for (int ks = 0; ks < 4; ++ks) { const bf16x8 a = *(const LAS bf16x8*)(KI + (8 * i * (i + 1) + 16 * j + fr) * QP_ + 32 * ks + 8 * fq), bq = *(const LAS bf16x8*)(QD + (16 * i + fr) * QP_ + 32 * ks + 8 * fq);
            cacc = __builtin_amdgcn_mfma_f32_16x16x32_bf16(a, bq, cacc, 0, 0, 0); }
        if (i == j) {
#pragma unroll
            for (int r = 0; r < 4; ++r) if (4 * fq + r > fr) cacc[r] = 0.f; }
        u32x2 o; o.x = pk2(cacc[0], cacc[1]); o.y = pk2(cacc[2], cacc[3]);
        *(LAS u32x2*)(PL + (16 * i + fr) * KTP + 16 * j + 4 * fq) = o;
    }
    __syncthreads();
    f32x4 acc[4];
#pragma unroll
    for (int tb = 0; tb < 4; ++tb) acc[tb] = (f32x4){0.f, 0.f, 0.f, 0.f};
    {
#pragma unroll
        for (int ks = 0; ks < 4; ++ks)
#pragma unroll
            for (int tb = 0; tb < 4; ++tb) { const bf16x8 bq = *(const LAS bf16x8*)(QPl + (16 * tb + fr) * QP_ + 32 * ks + 8 * fq); acc[tb] = __builtin_amdgcn_mfma_f32_16x16x32_bf16(R.sa[ks], bq, acc[tb], 0, 0, 0); }
#pragma unroll
        for (int ks = 0; ks < 2; ++ks) { const bf16x8 va = *(const LAS bf16x8*)(VT + vt_off(16 * w + fr, 32 * ks + 8 * fq));
#pragma unroll
            for (int tb = 0; tb < 4; ++tb) { const bf16x8 bp = *(const LAS bf16x8*)(PL + (16 * tb + fr) * KTP + 32 * ks + 8 * fq); acc[tb] = __builtin_amdgcn_mfma_f32_16x16x32_bf16(va, bp, acc[tb], 0, 0, 0); } }
    }
#pragma unroll
    for (int tb = 0; tb < 4; ++tb) { float p = (acc[tb][0] * acc[tb][0] + acc[tb][1] * acc[tb][1]) + (acc[tb][2] * acc[tb][2] + acc[tb][3] * acc[tb][3]); p += __shfl_xor(p, 16); p += __shfl_xor(p, 32);
        if (fq == 0) SSQ[w * 64 + 16 * tb + fr] = p; }
    __syncthreads();
    {
        const f32x4 gw4 = *(const f32x4*)(F.gnw + 16 * w + 4 * fq);
        bf16_t* A2 = wsp<bf16_t>(F, WS_A2);
#pragma unroll
        for (int tb = 0; tb < 4; ++tb) { const int t = 16 * tb + fr; float ss = 0.f;
#pragma unroll
            for (int ww = 0; ww < 8; ++ww) ss += SSQ[ww * 64 + t];
            const float rs = rsqrtf(ss * (1.f / 128.f) + EPS);
            const u32x2 gv = R.gv[tb];
            const f32x4 o = acc[tb] * rs * gw4 * (f32x4){bflo(gv.x), bfhi(gv.x), bflo(gv.y), bfhi(gv.y)};
            u32x2 ov; ov.x = pk2(o[0], o[1]); ov.y = pk2(o[2], o[3]);
            *(GAS u32x2*)(A2 + (row0 + t) * D + h * 128 + 16 * w + 4 * fq) = ov; }
    }
    __syncthreads();
}
__device__ __forceinline__ void p2c_units(Frame& F, int c) {
    constexpr int NU = 2048;
    if (c >= NU) return;
    P2cRegs R; p2c_load(F, c, R);
    for (int u = c; u < NU; u += F.G) {
        P2cRegs N; const int un = u + F.G; if (un < NU) p2c_load(F, un, N); else N = R;
        p2c_compute(F, u, R);
        R = N;
    }
}

__device__ __forceinline__ void split8(const f32x4 a, const f32x4 b, bf16x8& hi, bf16x8& lo) {
    u32x4 h, l;
    h.x = cvt_pk_bf16(a[0], a[1]); h.y = cvt_pk_bf16(a[2], a[3]); h.z = cvt_pk_bf16(b[0], b[1]); h.w = cvt_pk_bf16(b[2], b[3]);
    l.x = cvt_pk_bf16(a[0] - bflo(h.x), a[1] - bfhi(h.x)); l.y = cvt_pk_bf16(a[2] - bflo(h.y), a[3] - bfhi(h.y)); l.z = cvt_pk_bf16(b[0] - bflo(h.z), b[1] - bfhi(h.z)); l.w = cvt_pk_bf16(b[2] - bflo(h.w), b[3] - bfhi(h.w));
    hi = __builtin_bit_cast(bf16x8, h); lo = __builtin_bit_cast(bf16x8, l);
}
__device__ __forceinline__ void p5_router(Frame& F) {
    const int fr = F.lane & 15, fq = F.lane >> 4, wq = F.wave & 3, kh = F.wave >> 2;
    LAS float* lg = (LAS float*)(F.lds + F.wave * 4096);
    LAS float* pa = (LAS float*)(F.lds + 32768) + (wq * 64 + F.lane) * 9;
    const bf16_t* DL = wsp<bf16_t>(F, WS_H1); unsigned char* H1B = wsp<unsigned char>(F, WS_H1B); const bf16_t* WH = wsp<bf16_t>(F, WS_WRH); const bf16_t* WL = wsp<bf16_t>(F, WS_WRL);
    for (int it = F.vcu * 4 + wq; it < M / 16; it += F.G * 4) {
        const int row0 = it * 16, kofs = 1024 * kh;
        const float* hp = F.x + (size_t)(row0 + fr) * D + kofs + 8 * fq; const bf16_t* dp_ = DL + (size_t)(row0 + fr) * D + kofs + 8 * fq; unsigned char* qp = H1B + (size_t)(row0 + fr) * D + kofs + 8 * fq;
        const bf16_t* wh0 = WH + (size_t)fr * D + kofs + 8 * fq; const bf16_t* wl0 = WL + (size_t)fr * D + kofs + 8 * fq;
        f32x4 a0 = (f32x4){0.f, 0.f, 0.f, 0.f}, a1 = a0; float ss = 0.f;
#pragma unroll 4
        for (int ks = 0; ks < 32; ++ks) {
            f32x4 xa = *(const GAS f32x4*)(hp + 32 * ks), xb = *(const GAS f32x4*)(hp + 32 * ks + 4); { f32x4 da, db; unpack8(*(const GAS u32x4*)(dp_ + 32 * ks), da, db); xa += da; xb += db; }
            *(GAS u32x2*)(qp + 32 * ks) = pack8_fp8(xa, xb);
            *(GAS u32x4*)((bf16_t*)dp_ + 32 * ks) = pack8(xa, xb);
            ss += (xa[0] * xa[0] + xa[1] * xa[1]) + (xa[2] * xa[2] + xa[3] * xa[3]) + (xb[0] * xb[0] + xb[1] * xb[1]) + (xb[2] * xb[2] + xb[3] * xb[3]);
            bf16x8 xh, xl; split8(xa, xb, xh, xl);
            const bf16x8 bh0 = *(const GAS bf16x8*)(wh0 + 32 * ks), bl0 = *(const GAS bf16x8*)(wl0 + 32 * ks), bh1 = *(const GAS bf16x8*)(wh0 + 16 * D + 32 * ks), bl1 = *(const GAS bf16x8*)(wl0 + 16 * D + 32 * ks);
            a0 = __builtin_amdgcn_mfma_f32_16x16x32_bf16(xh, bh0, a0, 0, 0, 0); a0 = __builtin_amdgcn_mfma_f32_16x16x32_bf16(xh, bl0, a0, 0, 0, 0);
            a0 = __builtin_amdgcn_mfma_f32_16x16x32_bf16(xl, bh0, a0, 0, 0, 0); a0 = __builtin_amdgcn_mfma_f32_16x16x32_bf16(xl, bl0, a0, 0, 0, 0);
            a1 = __builtin_amdgcn_mfma_f32_16x16x32_bf16(xh, bh1, a1, 0, 0, 0); a1 = __builtin_amdgcn_mfma_f32_16x16x32_bf16(xh, bl1, a1, 0, 0, 0);
            a1 = __builtin_amdgcn_mfma_f32_16x16x32_bf16(xl, bh1, a1, 0, 0, 0); a1 = __builtin_amdgcn_mfma_f32_16x16x32_bf16(xl, bl1, a1, 0, 0, 0);
        }
        if (kh == 1) {
#pragma unroll
            for (int r = 0; r < 4; ++r) { pa[r] = a0[r]; pa[4 + r] = a1[r]; }
            pa[8] = ss; }
        __syncthreads();
        if (kh == 0) {
#pragma unroll
            for (int r = 0; r < 4; ++r) { a0[r] += pa[r]; a1[r] += pa[4 + r]; }
            ss += pa[8];
            ss += __shfl_xor(ss, 16); ss += __shfl_xor(ss, 32);
#pragma unroll
            for (int r = 0; r < 4; ++r) { lg[(4 * fq + r) * 33 + fr] = a0[r]; lg[(4 * fq + r) * 33 + 16 + fr] = a1[r]; }
            LDS_WAIT(); asm volatile("" ::: "memory");
            if (F.lane < 16) {
                const int tokn = row0 + F.lane; const float rs = rsqrtf(ss * (1.f / D) + EPS);
                float v[32];
#pragma unroll
                for (int e = 0; e < 32; ++e) v[e] = lg[F.lane * 33 + e] * rs + F.b_r[e];
                int idx[4]; float val[4];
#pragma unroll
                for (int k = 0; k < 4; ++k) { float bv = -3.0e38f; int bi = 0;
#pragma unroll
                    for (int e = 0; e < 32; ++e) { const bool tk = v[e] > bv; bv = tk ? v[e] : bv; bi = tk ? e : bi; }
                    idx[k] = bi; val[k] = bv;
#pragma unroll
                    for (int e = 0; e < 32; ++e) v[e] = (e == bi) ? -3.0e38f : v[e]; }
                float ex[4], den = 0.f;
#pragma unroll
                for (int k = 0; k < 4; ++k) { ex[k] = __expf(val[k] - val[0]); den += ex[k]; }
                const float inv = 1.f / den;
                wsp<float>(F, WS_RS2)[tokn] = rs;
#pragma unroll
                for (int k = 0; k < 4; ++k) { const int pos = (int)atomicAdd((unsigned*)(F.ctl + CW_CNT + 64 * idx[k]), 1u);
                    wsp<int>(F, WS_TOPE)[tokn * 4 + k] = idx[k]; wsp<int>(F, WS_TOPP)[tokn * 4 + k] = pos; wsp<float>(F, WS_TOPW)[tokn * 4 + k] = ex[k] * inv;
                    wsp<int>(F, WS_LIST)[(size_t)idx[k] * CAPF + pos] = tokn; }
            }
        }
        __syncthreads();
    }
}
__device__ __forceinline__ void build_pref(Frame& F) {
    if (F.tid == 0) { int a = 0;
        for (int e = 0; e < NE; ++e) { F.MISC[16 + e] = (unsigned)a; const unsigned c = __hip_atomic_load(F.ctl + CW_CNT + 64 * e, RLX_AGENT); a += (int)((c + 255u) >> 8); }
        F.MISC[16 + NE] = (unsigned)(a < MAXRT ? a : MAXRT); }
    __syncthreads();
}
__device__ __forceinline__ void build_tok(Frame& F, const MoeOrder& S) {
    LAS int* tokt = (LAS int*)(F.lds + TOK_OFF);
    Unit u;
    for (int i = 0; i < 18 && S.next(i, u); ++i) {
        const int rt = u.pm - (int)F.MISC[16 + u.e]; const int cnt = (int)__hip_atomic_load(F.ctl + CW_CNT + 64 * u.e, RLX_AGENT);
        if (F.tid < 256) { const int r = rt * 256 + F.tid; tokt[i * 256 + F.tid] = (r < cnt) ? wsp<int>(F, WS_LIST)[(size_t)u.e * CAPF + r] : 0; }
    }
    __syncthreads();
}
struct P9Tok { f32x4 v[8]; unsigned y[4][8]; f32x4 tw; };
template <int PM> __device__ __forceinline__ void p9_issue(const Frame& F, int m, P9Tok& T) {
    typedef int i32x4 __attribute__((ext_vector_type(4)));
    const bf16_t* DL = wsp<bf16_t>(F, WS_H1); const unsigned char* YR = wsp<unsigned char>(F, WS_YR);
    const i32x4 te = *(const GAS i32x4*)(wsp<int>(F, WS_TOPE) + m * 4), tp = *(const GAS i32x4*)(wsp<int>(F, WS_TOPP) + m * 4); T.tw = *(const GAS f32x4*)(wsp<float>(F, WS_TOPW) + m * 4);
#pragma unroll
    for (int j = 0; j < 8; ++j) { const u32x2 dw = (PM == 4) ? (u32x2){(unsigned)m, 0u} : *(const GAS u32x2*)(DL + (size_t)m * D + 4 * F.lane + 256 * j);
        T.v[j] = (f32x4){bflo(dw.x), bfhi(dw.x), bflo(dw.y), bfhi(dw.y)}; }
#pragma unroll
    for (int k = 0; k < 4; ++k) { const size_t row = (size_t)((const LAS unsigned*)F.MISC)[16 + te[k]] * 256 + tp[k];
#pragma unroll
        for (int j = 0; j < 8; ++j) T.y[k][j] = (PM == 1) ? (unsigned)row : *(const GAS unsigned*)(YR + row * D + 4 * F.lane + 256 * j); }
}
template <int PM> __device__ __forceinline__ void p9_finish(const Frame& F, int m, P9Tok& T, float* outp) {
#pragma unroll
    for (int k = 0; k < 4; ++k)
#pragma unroll
        for (int j = 0; j < 8; ++j) { const f32x2 p0 = __builtin_amdgcn_cvt_pk_f32_fp8((int)T.y[k][j], false), p1 = __builtin_amdgcn_cvt_pk_f32_fp8((int)T.y[k][j], true); T.v[j] += (f32x4){p0.x, p0.y, p1.x, p1.y} * T.tw[k]; }
    float s = 0.f;
#pragma unroll
    for (int j = 0; j < 8; ++j) s += (T.v[j][0] * T.v[j][0] + T.v[j][1] * T.v[j][1]) + (T.v[j][2] * T.v[j][2] + T.v[j][3] * T.v[j][3]);
    const float rs = rsqrtf(wave_sum(s) * (1.f / D) + EPS);
#pragma unroll
    for (int j = 0; j < 8; ++j) { const f32x4 w = *(const f32x4*)(F.fnw + 4 * F.lane + 256 * j); const f32x4 o = T.v[j] * rs * w;
        if (PM == 2) asm volatile("" :: "v"(o)); else *(GAS f32x4*)(outp + (size_t)m * D + 4 * F.lane + 256 * j) = o; }
}
template <int PM> __device__ __forceinline__ void p9_combine_t(Frame& F, float* outp) {
    const int gw = F.vcu * NWAVES + F.wave, NGW9 = F.G * NWAVES;
    for (int m = gw; m < M; m += 2 * NGW9) {
        const int m2 = m + NGW9; const bool two = m2 < M;
        P9Tok A, B; p9_issue<PM>(F, m, A); p9_issue<PM>(F, two ? m2 : m, B);
        __builtin_amdgcn_sched_barrier(0);
        p9_finish<PM>(F, m, A, outp); if (two) p9_finish<PM>(F, m2, B, outp);
    }
}
__device__ __forceinline__ void p9_combine(Frame& F) { p9_combine_t<0>(F, F.out); }
constexpr int NPH = 11;
struct Args { const float* in[18]; float* out; unsigned char* ws; int ph_lo, ph_hi; };

__global__ void __launch_bounds__(NTHR, 2) fwd_kernel(Args args) {
    extern __shared__ __attribute__((aligned(16))) unsigned char lds_raw[];
    Frame F;
    F.lds = (LAS unsigned char*)lds_raw; F.MISC = (volatile LAS unsigned*)(F.lds + MISC_OFF);
    F.wave = __builtin_amdgcn_readfirstlane((int)threadIdx.x >> 6);
#define REFRESH() do { F.lane = lane_id(); F.tid = F.wave * 64 + F.lane; } while (0)
    REFRESH();
    F.G = gridDim.x; { const int bx = blockIdx.x; F.vcu = (F.G % 8 == 0) ? (bx % 8) * (F.G / 8) + bx / 8 : bx; }
    F.ws = args.ws; F.ctl = (gu32*)(args.ws + WS_CTL); F.out = args.out;
    F.x = args.in[0]; F.meta = args.in[1]; F.nmw = args.in[2]; F.w_in = args.in[3]; F.lbl = args.in[4]; F.gnw = args.in[5]; F.w_ho = args.in[6]; F.cw = args.in[7]; F.w_co = args.in[8]; F.w_o = args.in[9];
    F.nfw = args.in[10]; F.w_r = args.in[11]; F.b_r = args.in[12]; F.w_up = args.in[13]; F.b_up = args.in[14]; F.w_dn = args.in[15]; F.b_dn = args.in[16]; F.fnw = args.in[17];
    for (int u = F.tid; u < 256; u += NTHR) F.MISC[u] = 0u;
    __syncthreads();
    const int lo = args.ph_lo, hi = args.ph_hi;
    const bool multi = (hi - lo) > 1;
    XcdBarrier bar; bar.bar = (unsigned*)(F.ctl + CW_BAR); bar.x = 0; bar.st = nullptr;
    if (multi) bar = xcd_barrier_post((unsigned*)(F.ctl + CW_BAR), F.MISC, F.tid);
#define IN(k) (lo <= (k) && (k) < hi)
#if defined(FK_STAMP_A)
#define STAMP(k) do { if (blockIdx.x == 0 && F.tid == 0) __hip_atomic_store(F.ctl + CW_TS + (k), (unsigned)__builtin_amdgcn_s_memrealtime(), RLX_AGENT); } while (0)
#else
#define STAMP(k) do { } while (0)
#endif
#if defined(FK_PROBE_BAR)
#define SEAM(k) do { REFRESH(); if (IN(k) && IN((k) + 1)) { xcd_barrier(bar, F.tid); xcd_barrier(bar, F.tid); xcd_barrier(bar, F.tid); } STAMP((k) + 1); } while (0)
#else
#define SEAM(k) do { REFRESH(); if (IN(k) && IN((k) + 1)) xcd_barrier(bar, F.tid); STAMP((k) + 1); } while (0)
#endif
    STAMP(0);
    const int c = blockIdx.x;
#ifndef FK_DUP_MASK
#define FK_DUP_MASK 0
#endif
#ifndef FK_DUP_REPS
#define FK_DUP_REPS 1
#endif
#define DUP(k) for (int _rep = 0; _rep < 1 + FK_DUP_REPS * ((FK_DUP_MASK >> (k)) & 1); ++_rep)
#define REDO(k) do { if (((FK_DUP_MASK >> (k)) & 1) && _rep < FK_DUP_REPS) { REFRESH(); xcd_barrier(bar, F.tid); } } while (0)

    if (IN(0)) DUP(0) { p0_prologue(F); REDO(0); } SEAM(0);

    if (IN(1)) DUP(1) {
        constexpr int NCONV_PER8 = 3;
        const int cq = c >> 3; const bool conv = (F.G % 64 == 0) && ((cq & 7) < NCONV_PER8) && (_rep == 0);
        if (F.G % 64 != 0 && _rep == 0) { if (c == 0) p1_convert(F, 0, 1); }
        if (conv) { const int nconv = (F.G / 64) * 8 * NCONV_PER8, rank = ((cq >> 3) * NCONV_PER8 + (cq & 7)) * 8 + (c & 7); p1_convert(F, rank, nconv);
#if defined(FK_PROBE_CONV2)
            __syncthreads(); p1_convert<FK_PROBE_CONV2 - 1>(F, rank, nconv);
#endif
        }
        __syncthreads();
        EpiInproj E{wsp<float>(F, WS_RS1), wsp<float>(F, WS_LB), wsp<bf16_t>(F, WS_QS), wsp<bf16_t>(F, WS_VV), wsp<bf16_t>(F, WS_GS), wsp<bf16_t>(F, WS_UU), wsp<bf16_t>(F, WS_SB), wsp<bf16_t>(F, WS_RT), wsp<bf16_t>(F, WS_GBS), wsp<h16_t>(F, WS_LF), 1.f};
        if (N_INB > 0) {
            GemmDesc g{wsp<bf16_t>(F, WS_XB), wsp<bf16_t>(F, WS_WIN), D, INC / 256};
            DynOrder S; S.init(M, INB_MASK, N_INB, c, (unsigned*)(F.ctl + CW_Q + 64 * (c & 7) + 8 * _rep), F.MISC + 4, F.tid);
            gemm_phase<EpiInproj, DynOrder, false, true, false>(F.lds, g, S, E, nullptr, F.wave); }
        if (N_IN8 > 0) {
            REFRESH(); E.osc = 1.f / W8_SCALE;
            GemmDesc g{(const bf16_t*)wsp<unsigned char>(F, WS_XB8), (const bf16_t*)wsp<unsigned char>(F, WS_WIN8), D, INC / 256};
            DynOrder S; S.init(M, IN8_MASK, N_IN8, c, (unsigned*)(F.ctl + CW_Q + 64 * (c & 7) + 8 * _rep + 4), F.MISC + 6, F.tid);
            gemm_phase<EpiInproj, DynOrder, false, true, true>(F.lds, g, S, E, nullptr, F.wave); }
        REDO(1);
    } SEAM(1);

#if defined(FK_PROBE_GEMM)
    if (IN(1)) {
        GemmDesc g{wsp<bf16_t>(F, WS_XB), wsp<bf16_t>(F, WS_WIN), D, INC / 256}; ProbeOrder S; S.S.init(M, INC, F.G, c); S.mode = FK_PROBE_GEMM & 3; S.c = c;
        EpiDummy E{wsp<bf16_t>(F, WS_ACT), (FK_PROBE_GEMM >> 2) & 1};
        gemm_phase<EpiDummy, ProbeOrder, false, true, false>(F.lds, g, S, E, nullptr, F.wave);
        REFRESH(); xcd_barrier(bar, F.tid);
    }
#endif
    if (IN(2)) DUP(2) { p2a_units(F, c); for (int it = c; it < M / 64; it += F.G) p2a_conv(F, it); REDO(2); } SEAM(2);
    if (IN(3)) DUP(3) { p2b_scan(F); REDO(3); } SEAM(3);
    if (IN(4)) DUP(4) { p2c_units(F, c); REDO(4); } SEAM(4);

    if (IN(5)) DUP(5) {
        GemmDesc g{wsp<bf16_t>(F, WS_A2), wsp<bf16_t>(F, WS_WAB), D, D / 256}; StaticOrder S; S.init(M, D, F.G, c);
        EpiMerge E{wsp<bf16_t>(F, WS_RT), wsp<bf16_t>(F, WS_GBS), wsp<bf16_t>(F, WS_MG)};
        gemm_phase<EpiMerge, StaticOrder, false, true, false>(F.lds, g, S, E, nullptr, F.wave); REDO(5);
    } SEAM(5);

    if (IN(6)) DUP(6) {
        GemmDesc g{wsp<bf16_t>(F, WS_MG), wsp<bf16_t>(F, WS_WO), D, D / 256}; StaticOrder S; S.init(M, D, F.G, c);
        EpiWo E{wsp<bf16_t>(F, WS_H1)};
        gemm_phase<EpiWo, StaticOrder, false, true, false>(F.lds, g, S, E, nullptr, F.wave); REDO(6);
    } SEAM(6);

    if (IN(7)) { p5_router(F); } SEAM(7);

    if (IN(8)) DUP(8) {
        build_pref(F);
        MoeOrder S; S.init(16, F.G, c, (const volatile LAS int*)(F.MISC + 16));
        build_tok(F, S);
        GemmDesc g{wsp<bf16_t>(F, WS_H1B), wsp<bf16_t>(F, WS_WUP), D, 16};
        EpiUp E{wsp<float>(F, WS_RS2), (const LAS int*)(F.lds + TOK_OFF), F.b_up, wsp<unsigned char>(F, WS_ACT)};
        gemm_phase<EpiUp, MoeOrder, true, true, true>(F.lds, g, S, E, (const LAS int*)(F.lds + TOK_OFF), F.wave); REDO(8);
    } SEAM(8);

    if (IN(9)) DUP(9) {
        build_pref(F);
        MoeOrder S; S.init(8, F.G, c, (const volatile LAS int*)(F.MISC + 16));
        GemmDesc g{wsp<bf16_t>(F, WS_ACT), wsp<bf16_t>(F, WS_WDN), DFF, 8};
        EpiDown E{F.b_dn, wsp<unsigned char>(F, WS_YR)};
        gemm_phase<EpiDown, MoeOrder, false, true, true>(F.lds, g, S, E, nullptr, F.wave); REDO(9);
    } SEAM(9);

#if defined(FK_PROBE_P8)
    if (IN(10)) {
        build_pref(F);
        ProbeMoe S; S.S.init(8, F.G, c, (const volatile LAS int*)(F.MISC + 16)); S.mode = FK_PROBE_P8 & 3;
        GemmDesc g{wsp<bf16_t>(F, WS_ACT), wsp<bf16_t>(F, WS_WDN), DFF, 8};
        EpiDummy E{wsp<bf16_t>(F, WS_XB), 1};
        for (int r = 0; r < 2; ++r) { gemm_phase<EpiDummy, ProbeMoe, false, true, true>(F.lds, g, S, E, nullptr, F.wave); REFRESH(); xcd_barrier(bar, F.tid); }
    }
#endif
    if (IN(10)) DUP(10) { build_pref(F); p9_combine(F); REDO(10); }
#if defined(FK_PROBE_P9)
    if (IN(10)) { for (int r = 0; r < 4; ++r) { REFRESH(); xcd_barrier(bar, F.tid); p9_combine_t<FK_PROBE_P9 - 1>(F, wsp<float>(F, WS_XB)); } }
#endif
#undef IN
#undef DUP
#undef REDO
#undef SEAM
#undef STAMP
#undef REFRESH
}

inline void launch_fast(hipStream_t stream, void* const* d_in, float* out, unsigned char* ws, int n_launches) {
    static int grid = 0;
    if (grid == 0) {
        int dev = 0, cus = 0, per_cu = 0;
        if (hipGetDevice(&dev) != hipSuccess || hipDeviceGetAttribute(&cus, hipDeviceAttributeMultiprocessorCount, dev) != hipSuccess) { fprintf(stderr, "kernel_launch: device query failed\n"); grid = -1; return; }
        if (hipFuncSetAttribute((const void*)fwd_kernel, hipFuncAttributeMaxDynamicSharedMemorySize, LDS_BYTES) != hipSuccess) { fprintf(stderr, "kernel_launch: hipFuncSetAttribute failed\n"); grid = -1; return; }
        if (hipOccupancyMaxActiveBlocksPerMultiprocessor(&per_cu, (const void*)fwd_kernel, NTHR, LDS_BYTES) != hipSuccess || per_cu < 1) fprintf(stderr, "kernel_launch: note: occupancy query says %d blocks per CU\n", per_cu);
        (void)hipGetLastError();
        grid = cus;
    }
    if (grid < 0) return;
    (void)hipMemsetAsync(ws + WS_CTL, 0, CTL_BYTES, stream);
    Args a{};
    for (int i = 0; i < 18; ++i) a.in[i] = (const float*)d_in[i];
    a.out = out; a.ws = ws;
    for (int li = 0; li < n_launches; ++li) {
        a.ph_lo = (n_launches == 1) ? 0 : li; a.ph_hi = (n_launches == 1) ? NPH : li + 1;
        hipLaunchKernelGGL(fwd_kernel, dim3(grid), dim3(NTHR), LDS_BYTES, stream, a);
        const hipError_t le = hipPeekAtLastError();
        if (le != hipSuccess) { fprintf(stderr, "kernel_launch: launch %d failed: %s\n", li, hipGetErrorName(le)); break; }
    }
}
}
#ifndef FK_LAUNCHES
#define FK_LAUNCHES 1
#endif
extern "C" void kernel_launch(void* const* d_in, const int* in_sizes, int n_in, void* d_out, int out_size, void* d_ws, size_t ws_size, hipStream_t stream) {
    if (n_in != 18 || ws_size < fk::WS_FAST_END) { fprintf(stderr, "kernel_launch: n_in %d, ws %zu < %zu\n", n_in, ws_size, (size_t)fk::WS_FAST_END); return; }
    fk::launch_fast(stream, d_in, (float*)d_out, (unsigned char*)d_ws, FK_LAUNCHES);
}
```

```cpp
#include <hip/hip_runtime.h>
#include <cstdio>
#define FK_LAUNCHES 1
#define FK_IN8_MASK 0xFFFF000F0FFull
#define FK_WO8 0
namespace fk {
#define LAS __attribute__((address_space(3)))
#define GAS __attribute__((address_space(1)))
typedef unsigned short bf16_t;
typedef short bf16x8 __attribute__((ext_vector_type(8)));
typedef float f32x4 __attribute__((ext_vector_type(4)));
typedef float f32x2 __attribute__((ext_vector_type(2)));
typedef unsigned u32x4 __attribute__((ext_vector_type(4)));
typedef unsigned u32x2 __attribute__((ext_vector_type(2)));
typedef GAS unsigned gu32;
typedef _Float16 h16_t;
typedef _Float16 h16x4 __attribute__((ext_vector_type(4)));
typedef _Float16 h16x2 __attribute__((ext_vector_type(2)));
#define RLX_AGENT __ATOMIC_RELAXED, __HIP_MEMORY_SCOPE_AGENT
#define LDS_WAIT() asm volatile("s_waitcnt lgkmcnt(0)" ::: "memory")
#define VM_WAIT() asm volatile("s_waitcnt vmcnt(0)" ::: "memory")

constexpr int D = 2048, NB = 4, SEQ = 4096, M = NB * SEQ, NMETA = 16;
constexpr int HF = 1024, INC = 11264, NE = 32, DFF = 2048, NCH = SEQ / 64;
constexpr int C_Q = 0, C_F = 1024, C_V = 2048, C_G = 3072, C_SV = 4096, C_SB = 5120, C_SC = 6144, C_GA = 7168, C_GB = 9216;
constexpr float EPS = 1e-6f;
constexpr int CAPF = M;
constexpr int MAXRT = 288;
constexpr int NWAVES = 8, NTHR = 512;

constexpr size_t al(size_t x) { return (x + 0xFFFFF) & ~(size_t)0xFFFFF; }
constexpr size_t WS_CTL = 0, CTL_BYTES = 65536;
constexpr size_t WS_LB = 65536, WS_RS1 = WS_LB + 4096, WS_RS2 = WS_RS1 + 65536, WS_WRH = WS_RS2 + 65536, WS_WRL = WS_WRH + 131072;
constexpr size_t WS_LFM = WS_WRL + 131072, WS_VVM = WS_LFM + 64 * 1024 * 4, WS_UUM = WS_VVM + 64 * 1024 * 2, WS_SMALL_END = WS_UUM + 16 * 1024 * 2;
constexpr size_t WS_TOPE = al(WS_SMALL_END), WS_TOPP = WS_TOPE + (size_t)M * 16, WS_TOPW = WS_TOPP + (size_t)M * 16, WS_LIST = WS_TOPW + (size_t)M * 16;
constexpr size_t WS_DEC = al(WS_LIST + (size_t)NE * CAPF * 4);
constexpr size_t WS_WIN = al(WS_DEC + (size_t)33 * 64 * 128 * 4);
constexpr size_t WS_WAB = al(WS_WIN + (size_t)INC * D * 2);
constexpr size_t WS_WO = al(WS_WAB + (size_t)D * D * 2);
constexpr size_t WS_WUP = al(WS_WO + (size_t)D * D * 2);
constexpr size_t WS_WDN = al(WS_WUP + (size_t)NE * 4096 * D);
constexpr size_t WS_XB = al(WS_WDN + (size_t)NE * D * DFF);
constexpr size_t WS_QS = al(WS_XB + (size_t)M * D * 2);
constexpr size_t WS_LF = al(WS_QS + (size_t)M * HF * 2);
constexpr size_t WS_VV = al(WS_LF + (size_t)M * HF * 2);
constexpr size_t WS_GS = al(WS_VV + (size_t)M * HF * 2);
constexpr size_t WS_UU = al(WS_GS + (size_t)M * HF * 2);
constexpr size_t WS_SB = al(WS_UU + (size_t)M * HF * 2);
constexpr size_t WS_RT = al(WS_SB + (size_t)M * HF * 2);
constexpr size_t WS_GBS = al(WS_RT + (size_t)M * D * 2);
constexpr size_t WS_UC = al(WS_GBS + (size_t)M * D * 2);
constexpr size_t WS_SS = al(WS_UC + (size_t)(32 * 64 + 8) * 16384 * 2);
constexpr size_t WS_A2 = al(WS_SS + (size_t)32 * 64 * 16384 * 2);
constexpr size_t WS_MG = al(WS_A2 + (size_t)M * D * 2);
constexpr size_t WS_H1 = al(WS_MG + (size_t)M * D * 2);
constexpr size_t WS_H1B = al(WS_H1 + (size_t)M * D * 2);
constexpr size_t WS_ACT = al(WS_H1B + (size_t)M * D);
constexpr size_t WS_YR = al(WS_ACT + (size_t)MAXRT * 256 * DFF);
constexpr size_t WS_WIN8 = al(WS_YR + (size_t)MAXRT * 256 * D);
constexpr size_t WS_XB8 = al(WS_WIN8 + (size_t)INC * D);
constexpr size_t WS_FAST_END = al(WS_XB8 + (size_t)M * D);
#ifndef FK_IN8_MASK
#define FK_IN8_MASK 0xFFFF00000F0ull
#endif
constexpr unsigned long long IN8_MASK = FK_IN8_MASK;
constexpr unsigned long long INB_MASK = ((1ull << 44) - 1) & ~IN8_MASK;
constexpr int cpop(unsigned long long m) { int n = 0; while (m) { m &= m - 1; ++n; } return n; }
constexpr int N_IN8 = cpop(IN8_MASK), N_INB = 44 - N_IN8;
__device__ __forceinline__ int nth_bit(unsigned long long m, int n) { for (int i = 0; i < n; ++i) m &= m - 1; return __builtin_ctzll(m); }
constexpr int CW_TMO = 0;
constexpr int CW_CNT = 1024;
constexpr int CW_Q = 3400;
constexpr int CW_TS = 3200;
constexpr int CW_BAR = 4096;
constexpr int RING_BYTES = 131072;
constexpr int TOK_OFF = RING_BYTES, TOK_BYTES = 18 * 1024;
constexpr int MISC_OFF = TOK_OFF + TOK_BYTES;
constexpr int LDS_BYTES = MISC_OFF + 1024;
static_assert(LDS_BYTES <= 160 * 1024, "LDS");

__device__ __forceinline__ float sigmoidf_(float x) { return 1.f / (1.f + __expf(-x)); }
__device__ __forceinline__ unsigned f2bf(float f) { unsigned u = __builtin_bit_cast(unsigned, f); return (u + 0x7fffu + ((u >> 16) & 1u)) >> 16; }
__device__ __forceinline__ unsigned pk2(float lo, float hi) { return f2bf(lo) | (f2bf(hi) << 16); }
__device__ __forceinline__ float bf2f(unsigned short b) { return __builtin_bit_cast(float, ((unsigned)b) << 16); }
__device__ __forceinline__ float bflo(unsigned w) { return __builtin_bit_cast(float, w << 16); }
__device__ __forceinline__ float bfhi(unsigned w) { return __builtin_bit_cast(float, w & 0xffff0000u); }
__device__ __forceinline__ unsigned cvt_pk_bf16(float lo, float hi) { unsigned r; asm volatile("v_cvt_pk_bf16_f32 %0, %1, %2" : "=v"(r) : "v"(lo), "v"(hi)); return r; }
__device__ __forceinline__ unsigned pk4_fp8(float a, float b, float c, float d) { int w = 0; w = __builtin_amdgcn_cvt_pk_fp8_f32(a, b, w, false); w = __builtin_amdgcn_cvt_pk_fp8_f32(c, d, w, true); return (unsigned)w; }
constexpr float W8_SCALE = 64.f, W8_INV = 1.f / 64.f;
__device__ __forceinline__ int lane_id() { int l; asm volatile("v_mbcnt_lo_u32_b32 %0, -1, 0\n\tv_mbcnt_hi_u32_b32 %0, -1, %0" : "=v"(l)); return l; }
__device__ __forceinline__ float wave_sum(float v) {
#pragma unroll
    for (int o = 1; o < 64; o <<= 1) v += __shfl_xor(v, o);
    return v;
}

#define XB_TMO      128
#define XB_XCNT(j)  (256  + 64 * (j))
#define XB_XSUB(j)  (1280 + 64 * (j))
#define XB_XGEN(j)  (2304 + 64 * (j))
#define XB_TOP      3328
#define XB_TOPGEN   3392
#define XCD_BAR_WORDS 3456
#define XB_SPIN_CAP (1u << 18)
__device__ __forceinline__ unsigned xb_ld(unsigned* p)              { return __hip_atomic_load(p, __ATOMIC_RELAXED, __HIP_MEMORY_SCOPE_AGENT); }
__device__ __forceinline__ unsigned xb_add(unsigned* p, unsigned v) { return __hip_atomic_fetch_add(p, v, __ATOMIC_RELAXED, __HIP_MEMORY_SCOPE_AGENT); }
__device__ __forceinline__ unsigned xb_xcc_id() { return (unsigned)__builtin_amdgcn_s_getreg((3 << 11) | 20) & 0xFu; }
#define XB_SPIN(cond, bar) do { unsigned _sp = 0; while (cond) { __builtin_amdgcn_s_sleep(1); \
    if ((++_sp & 255u) == 0u) { if (xb_ld(&(bar)[XB_TMO])) break; if (_sp > XB_SPIN_CAP) { atomicAdd(&(bar)[XB_TMO], 1u); break; } } } } while (0)
struct XcdBarrier { unsigned* bar; unsigned x; volatile LAS unsigned* st; };
__device__ __forceinline__ XcdBarrier xcd_barrier_post(unsigned* bar, volatile LAS unsigned* st, int tid) {
    XcdBarrier b; b.bar = bar; b.x = xb_xcc_id(); b.st = st;
    if (tid == 0) (void)xb_add(&bar[XB_XCNT(b.x)], 1u);
    return b;
}
__device__ __forceinline__ void xcd_barrier_complete(unsigned* bar, unsigned x, unsigned& nloc, unsigned& nx) {
    const unsigned G = gridDim.x * gridDim.y * gridDim.z;
    unsigned sum, cnt, mine, sp = 0u;
    for (;;) {
        sum = 0u; cnt = 0u; mine = 0u;
#pragma unroll
        for (unsigned j = 0; j < 16; ++j) { const unsigned c = xb_ld(&bar[XB_XCNT(j)]); sum += c; cnt += (c > 0u) ? 1u : 0u; mine = (j == x) ? c : mine; }
        if (sum == G) break;
        __builtin_amdgcn_s_sleep(1);
        if ((++sp & 255u) == 0u) { if (xb_ld(&bar[XB_TMO])) break; if (sp > XB_SPIN_CAP) { atomicAdd(&bar[XB_TMO], 1u); break; } }
    }
    nloc = mine > 0u ? mine : 1u; nx = cnt > 0u ? cnt : 1u;
}
__device__ __forceinline__ void xcd_barrier(const XcdBarrier& b, int tid) {
    asm volatile("s_waitcnt vmcnt(0)" ::: "memory");
    __syncthreads();
    if (tid == 0) {
        unsigned* bar = b.bar;
        __builtin_amdgcn_s_waitcnt(0);
        unsigned nloc = b.st[0], nx = b.st[1];
        if (nloc == 0u) { xcd_barrier_complete(bar, b.x, nloc, nx); b.st[0] = nloc; b.st[1] = nx; }
        const unsigned old = xb_add(&bar[XB_XSUB(b.x)], 1u);
        const unsigned gen = old / nloc;
        if (old + 1u == (gen + 1u) * nloc) {
            __builtin_amdgcn_fence(__ATOMIC_RELEASE, "agent");
            asm volatile("s_waitcnt vmcnt(0)" ::: "memory");
            const unsigned og = xb_add(&bar[XB_TOP], 1u);
            const unsigned tg = og / nx;
            if (og + 1u == (tg + 1u) * nx) xb_add(&bar[XB_TOPGEN], 1u);
            else XB_SPIN(xb_ld(&bar[XB_TOPGEN]) == tg, bar);
            __builtin_amdgcn_fence(__ATOMIC_ACQUIRE, "agent");
            xb_add(&bar[XB_XGEN(b.x)], 1u);
            asm volatile("s_waitcnt vmcnt(0)" ::: "memory");
        } else {
            XB_SPIN(xb_ld(&bar[XB_XGEN(b.x)]) == gen, bar);
            __builtin_amdgcn_fence(__ATOMIC_ACQUIRE, "agent");
            asm volatile("s_waitcnt vmcnt(0)" ::: "memory");
        }
    }
    __syncthreads();
}

constexpr int BM = 256, BK = 64, HALF = 128, HTB = HALF * BK * 2, NXCD = 8, WGM = 8;
__host__ __device__ __forceinline__ int lds_byte(int r, int c) { const int st = (r >> 4) * 2 + (c >> 5), rr = r & 15, cc = c & 31, ob = rr * 64 + cc * 2; return st * 1024 + (ob ^ (((ob >> 9) & 1) << 5)); }
__host__ __device__ __forceinline__ void stage_rc(int b, int& R, int& C) { const int st = b / 1024, sb = b % 1024, swz = sb ^ (((sb >> 9) & 1) << 5); R = (st >> 1) * 16 + swz / 64; C = (st & 1) * 32 + (swz % 64) / 2; }
__host__ __device__ __forceinline__ int perm32(int rho) { const int n = rho >> 4, i = rho & 15; return 8 * (i >> 2) + 4 * n + (i & 3); }

typedef int i32x8 __attribute__((ext_vector_type(8)));
typedef int i32x4v __attribute__((ext_vector_type(4)));
__device__ __forceinline__ i32x8 cat8(const bf16x8 a, const bf16x8 b) { const i32x4v x = __builtin_bit_cast(i32x4v, a), y = __builtin_bit_cast(i32x4v, b); return __builtin_shufflevector(x, y, 0, 1, 2, 3, 4, 5, 6, 7); }
__device__ __forceinline__ void mfma8(f32x4& acc, const i32x8 a, const i32x8 b, const int sc) {
    asm volatile("s_nop 1\n\tv_mfma_scale_f32_16x16x128_f8f6f4 %0, %1, %2, %0, %3, %3 op_sel_hi:[0,0,0]" : "+v"(acc) : "v"(a), "v"(b), "v"(sc));
}
struct Unit { int pm, pn, e, ui; };

struct StaticOrder {
    int nM, nN, nwg, G, c;
    __device__ void init(int M_, int N_, int G_, int c_) { nM = M_ / BM; nN = N_ / BM; nwg = nM * nN; G = G_; c = c_; }
    __device__ __forceinline__ bool next(int i, Unit& u) const {
        const long L = (long)i * G + c; if (L >= nwg) return false;
        int wgid = (int)L; { const int q = nwg / NXCD, r = nwg % NXCD, xcd = wgid % NXCD, off = wgid / NXCD; wgid = (xcd < r ? xcd * (q + 1) : r * (q + 1) + (xcd - r) * q) + off; }
        const int nig = WGM * nN, gid = wgid / nig, fm = gid * WGM, gsz = (nM - fm) < WGM ? (nM - fm) : WGM;
        u.pm = fm + ((wgid % nig) % gsz); u.pn = (wgid % nig) / gsz; u.e = 0; u.ui = i; return true;
    }
};
struct DynOrder {
    int nM, nN, nwg, x; unsigned* head; volatile LAS unsigned* slot; int tid; unsigned long long mask;
    __device__ void init(int M_, unsigned long long mask_, int nN_, int c_, unsigned* head_, volatile LAS unsigned* slot_, int tid_) { nM = M_ / BM; nN = nN_; mask = mask_; nwg = nM * nN; x = c_ & 7; head = head_; slot = slot_; tid = tid_; }
    __device__ __forceinline__ bool next(int i, Unit& u) const {
        if (tid == 0) slot[i & 1] = __hip_atomic_fetch_add(head, 1u, __ATOMIC_RELAXED, __HIP_MEMORY_SCOPE_AGENT);
        asm volatile("s_waitcnt lgkmcnt(0)" ::: "memory"); __builtin_amdgcn_s_barrier(); asm volatile("" ::: "memory");
        const int j = (int)slot[i & 1], q = nwg / NXCD;
        if (j >= q) return false;
        const int wgid = x * q + j;
        const int nig = WGM * nN, gid = wgid / nig, fm = gid * WGM, gsz = (nM - fm) < WGM ? (nM - fm) : WGM;
        u.pm = fm + ((wgid % nig) % gsz); u.pn = nth_bit(mask, (wgid % nig) / gsz); u.e = 0; u.ui = i; return true;
    }
};
struct MoeOrder {
    int nct, NT, G, c; const volatile LAS int* pref;
    __device__ void init(int nct_, int G_, int c_, const volatile LAS int* pref_) { nct = nct_; G = G_; c = c_; pref = pref_; NT = pref_[NE]; }
    __device__ __forceinline__ bool next(int i, Unit& u) const {
        int rtg, pn;
        if (G == 256) { const int x = c & 7, jj = c >> 3;
            if (nct == 16) { rtg = 16 * i + 8 * (x & 1) + (jj & 7); pn = 4 * (x >> 1) + (jj >> 3); }
            else           { rtg = 32 * i + 8 * (x & 3) + (jj & 7); pn = 4 * (x >> 2) + (jj >> 3); } }
        else { const int U = i * G + c; rtg = U / nct; pn = U - rtg * nct; }
        if (rtg >= NT) return false;
        u.pn = pn; u.pm = rtg; u.ui = i;
        int e = 0;
#pragma unroll 1
        for (int j = 1; j < NE; ++j) e = (pref[j] <= rtg) ? j : e;
        u.e = e; return true;
    }
};

struct GemmDesc { const bf16_t* A; const bf16_t* Bt; int K; int nct; };

template <class Epi, class Sched, bool GATHER, bool ALIGN_EPI, bool FP8>
__device__ __forceinline__ void gemm_phase(LAS unsigned char* lds, const GemmDesc g, const Sched& S, const Epi& E, const LAS int* tok, int wid) {
    const int lane = lane_id(), tid = wid * 64 + lane, wr = wid >> 2, wc = wid & 3, fr = lane & 15, fq = lane >> 4;
    const int K = g.K, KB = FP8 ? K : 2 * K  , nt = FP8 ? K / 128 : K / BK;
    int Rl[2], Cl[2];
    unsigned voffA[2], voffB[2];
#pragma unroll
    for (int i = 0; i < 2; ++i) { int Cc; stage_rc(tid * 16 + i * 8192, Rl[i], Cc); const int p = Cc >> 3; Cl[i] = FP8 ? 16 * (2 * (p & 3) + (p >> 2)) : 2 * Cc; voffA[i] = (unsigned)(Rl[i] * KB + Cl[i]); voffB[i] = voffA[i]; }
    const size_t kstep = (size_t)(BK * 2);
    const size_t hstep = (size_t)HALF * KB;
    const size_t tstep = 2 * hstep;
    const unsigned ldsw = (unsigned)wid * 1024u;
    const int aoff = lds_byte(wr * 64 + fr, fq * 8), boff = lds_byte(wc * 32 + fr, fq * 8);
#define PG8_SA(b, h) (((b) * 2 + (h)) * HTB)
#define PG8_SB(b, h) ((4 + (b) * 2 + (h)) * HTB)
#define PG8_STAGE(bufoff, gbase, voff) do { _Pragma("unroll") for (int _i = 0; _i < 2; ++_i) \
        __builtin_amdgcn_global_load_lds((const unsigned*)((const char*)(gbase) + (voff)[_i]), (LAS unsigned*)(lds + (bufoff) + ldsw + _i * 8192), 16, 0, 0); } while (0)
#define PG8_STAGE_A(bufoff, ptr, half, o0, o1) do { if constexpr (GATHER) { PG8_STAGE(bufoff, ptr, (half) ? o1 : o0); } else { PG8_STAGE(bufoff, (ptr) + (half) * hstep, voffA); } } while (0)
#define PG8_LDA(dst, b, h) do { _Pragma("unroll") for (int m = 0; m < 4; ++m) _Pragma("unroll") for (int k = 0; k < 2; ++k) dst[m][k] = *(const LAS bf16x8*)(lds + PG8_SA(b, h) + aoff + m * 2048 + k * 1024); } while (0)
#define PG8_LDB(dst, b, h) do { _Pragma("unroll") for (int n = 0; n < 2; ++n) _Pragma("unroll") for (int k = 0; k < 2; ++k) dst[n][k] = *(const LAS bf16x8*)(lds + PG8_SB(b, h) + boff + n * 2048 + k * 1024); } while (0)
#define PG8_MMA(ai, bj, At, Bt) do { __builtin_amdgcn_s_setprio(1); _Pragma("unroll") for (int m = 0; m < 4; ++m) _Pragma("unroll") for (int n = 0; n < 2; ++n) _Pragma("unroll") for (int k = 0; k < 2; ++k) \
        acc[ai][bj][m][n] = __builtin_amdgcn_mfma_f32_16x16x32_bf16(Bt[n][k], At[m][k], acc[ai][bj][m][n], 0, 0, 0); __builtin_amdgcn_s_setprio(0); } while (0)
#define PG8_MMA8(ai, bj, At, Bt) do { __builtin_amdgcn_s_setprio(1); _Pragma("unroll") for (int m = 0; m < 4; ++m) _Pragma("unroll") for (int n = 0; n < 2; ++n) \
        mfma8(acc[ai][bj][m][n], cat8(Bt[n][0], Bt[n][1]), cat8(At[m][0], At[m][1]), sc8); __builtin_amdgcn_s_setprio(0); } while (0)
#define PG8_MM(ai, bj, At, Bt) do { if constexpr (FP8) PG8_MMA8(ai, bj, At, Bt); else PG8_MMA(ai, bj, At, Bt); } while (0)
#define PG8_WAIT_V(n) asm volatile("s_waitcnt vmcnt(" #n ")" ::: "memory")
#define PG8_WAIT_L(n) asm volatile("s_waitcnt lgkmcnt(" #n ")" ::: "memory")
#define PG8_BAR __builtin_amdgcn_s_barrier()
#define PG8_SCHED __builtin_amdgcn_sched_barrier(0)
    Unit cur, nxt; int ui = 0;
    if (!S.next(0, cur)) return;
    const int sc8 = 0x7F7F7F7F;
    f32x4 acc[2][2][4][2];
#pragma unroll
    for (int a = 0; a < 2; ++a)
#pragma unroll
        for (int b = 0; b < 2; ++b)
#pragma unroll
            for (int m = 0; m < 4; ++m)
#pragma unroll
                for (int n = 0; n < 2; ++n) acc[a][b][m][n] = (f32x4){0.f, 0.f, 0.f, 0.f};
    bf16x8 At[4][2], B0[2][2], B1[2][2];
    unsigned vA0[2] = {0u, 0u}, vA1[2] = {0u, 0u}, nA0[2] = {0u, 0u}, nA1[2] = {0u, 0u};
    const char* cA; const char* cB = (const char*)g.Bt + (size_t)(cur.e * g.nct + cur.pn) * tstep;
    if constexpr (GATHER) {
        cA = (const char*)g.A;
#pragma unroll
        for (int i = 0; i < 2; ++i) { vA0[i] = (unsigned)(tok[cur.ui * 256 + Rl[i]] * KB + Cl[i]); vA1[i] = (unsigned)(tok[cur.ui * 256 + 128 + Rl[i]] * KB + Cl[i]); nA0[i] = vA0[i]; nA1[i] = vA1[i]; }
    } else cA = (const char*)g.A + (size_t)cur.pm * tstep;
    PG8_STAGE(PG8_SB(0, 0), cB, voffB); PG8_STAGE(PG8_SB(0, 1), cB + hstep, voffB); PG8_STAGE_A(PG8_SA(0, 0), cA, 0, vA0, vA1); PG8_STAGE_A(PG8_SA(0, 1), cA, 1, vA0, vA1);
    if (wr == 1) PG8_BAR;
    PG8_WAIT_V(2); PG8_BAR;
    PG8_STAGE(PG8_SB(1, 0), cB + kstep, voffB); PG8_STAGE_A(PG8_SA(1, 0), cA + kstep, 0, vA0, vA1); PG8_STAGE(PG8_SB(1, 1), cB + hstep + kstep, voffB);
    PG8_WAIT_V(6); PG8_BAR;
    for (;;) {
        const bool has_next = S.next(ui + 1, nxt);
        const char* nAp; const char* nB;
        if (has_next) {
            nB = (const char*)g.Bt + (size_t)(nxt.e * g.nct + nxt.pn) * tstep;
            if constexpr (GATHER) { nAp = cA;
#pragma unroll
                for (int i = 0; i < 2; ++i) { nA0[i] = (unsigned)(tok[nxt.ui * 256 + Rl[i]] * KB + Cl[i]); nA1[i] = (unsigned)(tok[nxt.ui * 256 + 128 + Rl[i]] * KB + Cl[i]); }
            } else nAp = (const char*)g.A + (size_t)nxt.pm * tstep;
        } else { nAp = cA; nB = cB; }
        for (int t = 0; t < nt; t += 2) {
            const bool last = (t == nt - 2);
            const char* a1 = cA + (size_t)(t + 1) * kstep;
            const char* a2 = last ? nAp : cA + (size_t)(t + 2) * kstep; const char* b2 = last ? nB : cB + (size_t)(t + 2) * kstep;
            const char* a3 = a2 + kstep; const char* b3 = b2 + kstep;
            unsigned w0[2] = {0u, 0u}, w1[2] = {0u, 0u};
            if constexpr (GATHER) {
#pragma unroll
                for (int i = 0; i < 2; ++i) { w0[i] = last ? nA0[i] : vA0[i]; w1[i] = last ? nA1[i] : vA1[i]; } }
            if constexpr (Epi::MIDHOOK) { if (t == nt / 2) E.mid(acc, cur, wr, wc, fr, fq); }
            PG8_LDB(B0, 0, 0); PG8_LDB(B1, 0, 1); PG8_SCHED; PG8_LDA(At, 0, 0); PG8_STAGE_A(PG8_SA(1, 1), a1, 1, vA0, vA1);
            PG8_WAIT_V(8); PG8_WAIT_L(0); PG8_BAR; PG8_MM(0, 0, At, B0); PG8_MM(0, 1, At, B1); PG8_BAR; PG8_SCHED;
            PG8_LDA(At, 0, 1); PG8_STAGE(PG8_SB(0, 0), b2, voffB); PG8_STAGE(PG8_SB(0, 1), b2 + hstep, voffB); PG8_STAGE_A(PG8_SA(0, 0), a2, 0, w0, w1);
            PG8_WAIT_V(8); PG8_WAIT_L(0); PG8_BAR; PG8_MM(1, 0, At, B0); PG8_MM(1, 1, At, B1); PG8_BAR; PG8_SCHED;
            PG8_LDB(B0, 1, 0); PG8_LDB(B1, 1, 1); PG8_SCHED; PG8_LDA(At, 1, 0); PG8_STAGE_A(PG8_SA(0, 1), a2, 1, w0, w1);
            PG8_WAIT_V(8); PG8_WAIT_L(0); PG8_BAR; PG8_MM(0, 0, At, B0); PG8_MM(0, 1, At, B1); PG8_BAR; PG8_SCHED;
            PG8_LDA(At, 1, 1); PG8_STAGE(PG8_SB(1, 0), b3, voffB); PG8_STAGE(PG8_SB(1, 1), b3 + hstep, voffB); PG8_STAGE_A(PG8_SA(1, 0), a3, 0, w0, w1);
            PG8_WAIT_V(8); PG8_WAIT_L(0); PG8_BAR; PG8_MM(1, 0, At, B0); PG8_MM(1, 1, At, B1); PG8_BAR; PG8_SCHED;
        }
        if constexpr (ALIGN_EPI) { if (wr == 0) PG8_BAR; }
        E(acc, cur, wr, wc, fr, fq);
        if (!has_next) break;
#pragma unroll
        for (int a = 0; a < 2; ++a)
#pragma unroll
            for (int b = 0; b < 2; ++b)
#pragma unroll
                for (int m = 0; m < 4; ++m)
#pragma unroll
                    for (int n = 0; n < 2; ++n) acc[a][b][m][n] = (f32x4){0.f, 0.f, 0.f, 0.f};
        cur = nxt; cA = nAp; cB = nB; ++ui;
        if constexpr (GATHER) {
#pragma unroll
            for (int i = 0; i < 2; ++i) { vA0[i] = nA0[i]; vA1[i] = nA1[i]; } }
        if constexpr (ALIGN_EPI) { if (wr == 1) PG8_BAR; }
    }
    PG8_WAIT_V(0);
    if constexpr (!ALIGN_EPI) { if (wr == 0) PG8_BAR; }
    PG8_BAR;
#undef PG8_SA
#undef PG8_SB
#undef PG8_STAGE
#undef PG8_STAGE_A
#undef PG8_LDA
#undef PG8_LDB
#undef PG8_MMA
#undef PG8_MMA8
#undef PG8_MM
#undef PG8_WAIT_V
#undef PG8_WAIT_L
#undef PG8_BAR
#undef PG8_SCHED
}
typedef f32x4 Acc[2][2][4][2];
__device__ __forceinline__ float silu_(float x) { return x * __builtin_amdgcn_rcpf(1.f + __expf(-x)); }
__device__ __forceinline__ float sigm_(float x) { return __builtin_amdgcn_rcpf(1.f + __expf(-x)); }
__device__ __forceinline__ u32x4 pack8(const f32x4 a, const f32x4 b) { u32x4 w; w.x = cvt_pk_bf16(a[0], a[1]); w.y = cvt_pk_bf16(a[2], a[3]); w.z = cvt_pk_bf16(b[0], b[1]); w.w = cvt_pk_bf16(b[2], b[3]); return w; }
__device__ __forceinline__ u32x2 pack8_fp8(const f32x4 a, const f32x4 b) { u32x2 w; w.x = pk4_fp8(a[0], a[1], a[2], a[3]); w.y = pk4_fp8(b[0], b[1], b[2], b[3]); return w; }
__device__ __forceinline__ void unpack8(const u32x4 w, f32x4& a, f32x4& b) { a = (f32x4){bflo(w.x), bfhi(w.x), bflo(w.y), bfhi(w.y)}; b = (f32x4){bflo(w.z), bfhi(w.z), bflo(w.w), bfhi(w.w)}; }

struct EpiInproj {
    static constexpr bool MIDHOOK = false;
    const float* rs1; const float* lb; bf16_t *QS, *VV, *GS, *UU, *SBb, *RT, *GBS; h16_t* LF; float osc;
    __device__ __forceinline__ void mid(Acc&, const Unit&, int, int, int, int) const {}
    template <int ACT> __device__ __forceinline__ void plain(const Acc& acc, const float (&rs)[2][4], bf16_t* O, int pt, int row0, int wc, int fq) const {
#pragma unroll
        for (int ai = 0; ai < 2; ++ai)
#pragma unroll
            for (int m = 0; m < 4; ++m) { bf16_t* rowp = O + (size_t)(row0 + ai * HALF + m * 16) * HF + pt * 256 + wc * 32 + 8 * fq; const float r = rs[ai][m];
#pragma unroll
                for (int bj = 0; bj < 2; ++bj) { f32x4 v0 = acc[ai][bj][m][0] * r, v1 = acc[ai][bj][m][1] * r;
                    if (ACT == 1) {
#pragma unroll
                        for (int j = 0; j < 4; ++j) { v0[j] = silu_(v0[j]); v1[j] = silu_(v1[j]); } }
                    *(u32x4*)(rowp + bj * HALF) = pack8(v0, v1); } }
    }
    __device__ __forceinline__ void operator()(const Acc& acc, const Unit& u, int wr, int wc, int fr, int fq) const {
        const int row0 = u.pm * BM + wr * 64 + fr, pn = u.pn;
        float rs[2][4];
#pragma unroll
        for (int ai = 0; ai < 2; ++ai)
#pragma unroll
            for (int m = 0; m < 4; ++m) rs[ai][m] = rs1[row0 + ai * HALF + m * 16] * osc;
        asm volatile("" : "+v"(rs[0][0]), "+v"(rs[0][1]), "+v"(rs[0][2]), "+v"(rs[0][3]), "+v"(rs[1][0]), "+v"(rs[1][1]), "+v"(rs[1][2]), "+v"(rs[1][3]));
        if (pn < 4) plain<1>(acc, rs, QS, pn, row0, wc, fq);
        else if (pn < 8) {
            const int c0 = (pn - 4) * 256 + wc * 32 + 4 * fq;
            f32x4 lbv[2][2];
#pragma unroll
            for (int bj = 0; bj < 2; ++bj)
#pragma unroll
                for (int n = 0; n < 2; ++n) lbv[bj][n] = *(const f32x4*)(lb + c0 + bj * HALF + n * 16);
#pragma unroll
            for (int ai = 0; ai < 2; ++ai)
#pragma unroll
                for (int m = 0; m < 4; ++m) { h16_t* rowp = LF + (size_t)(row0 + ai * HALF + m * 16) * HF + c0; const float r = rs[ai][m];
#pragma unroll
                    for (int bj = 0; bj < 2; ++bj)
#pragma unroll
                        for (int n = 0; n < 2; ++n) { f32x4 v = acc[ai][bj][m][n] * r; const f32x4 l = lbv[bj][n];
#pragma unroll
                            for (int j = 0; j < 4; ++j) v[j] = __logf(l[j] + (1.f - l[j]) * sigm_(v[j]));
                            *(h16x4*)(rowp + bj * HALF + n * 16) = (h16x4){(h16_t)v[0], (h16_t)v[1], (h16_t)v[2], (h16_t)v[3]}; } }
        }
        else if (pn < 12) plain<0>(acc, rs, VV, pn - 8, row0, wc, fq);
        else if (pn < 16) plain<1>(acc, rs, GS, pn - 12, row0, wc, fq);
        else if (pn < 24) {
            const int c0 = (pn - 16) * 128 + wc * 32 + 8 * fq;
#pragma unroll
            for (int ai = 0; ai < 2; ++ai)
#pragma unroll
                for (int m = 0; m < 4; ++m) { const float r2 = rs[ai][m] * rs[ai][m];
                    const f32x4 v0 = acc[ai][0][m][0] * acc[ai][1][m][0] * r2, v1 = acc[ai][0][m][1] * acc[ai][1][m][1] * r2;
                    *(u32x4*)(UU + (size_t)(row0 + ai * HALF + m * 16) * HF + c0) = pack8(v0, v1); }
        }
        else if (pn < 28) plain<0>(acc, rs, SBb, pn - 24, row0, wc, fq);
        else {
            const int c0 = (pn - 28) * 128 + wc * 32 + 8 * fq;
#pragma unroll
            for (int ai = 0; ai < 2; ++ai)
#pragma unroll
                for (int m = 0; m < 4; ++m) { const float r = rs[ai][m]; f32x4 q0, q1, b0, b1;
#pragma unroll
                    for (int j = 0; j < 4; ++j) { const float ea = 1.f + __expf(-acc[ai][0][m][0][j] * r), eb = 1.f + __expf(-acc[ai][1][m][0][j] * r); b0[j] = __builtin_amdgcn_rcpf(eb); q0[j] = eb * __builtin_amdgcn_rcpf(ea);
                                                  const float fa = 1.f + __expf(-acc[ai][0][m][1][j] * r), fb = 1.f + __expf(-acc[ai][1][m][1][j] * r); b1[j] = __builtin_amdgcn_rcpf(fb); q1[j] = fb * __builtin_amdgcn_rcpf(fa); }
                    const size_t o = (size_t)(row0 + ai * HALF + m * 16) * D + c0;
                    *(u32x4*)(RT + o) = pack8(q0, q1); *(u32x4*)(GBS + o) = pack8(b0, b1); }
        }
    }
};

struct EpiMerge {
    static constexpr bool MIDHOOK = true;
    const bf16_t *RT, *GBS; bf16_t* MG;
    __device__ __forceinline__ void mid(Acc& acc, const Unit& u, int wr, int wc, int fr, int fq) const {
        unsigned o0 = ((unsigned)(u.pm * BM + wr * 64 + fr) * D + (unsigned)(u.pn * BM + wc * 32 + 8 * fq)) * 2u;
        asm volatile("" : "+v"(o0));
#pragma unroll
        for (int ai = 0; ai < 2; ++ai)
#pragma unroll
            for (int m = 0; m < 4; ++m)
#pragma unroll
                for (int bj = 0; bj < 2; ++bj) { const u32x4 w = *(const GAS u32x4*)((const GAS char*)RT + (o0 + (unsigned)((ai * HALF + m * 16) * D + bj * HALF) * 2u)); f32x4 a, b; unpack8(w, a, b);
                    acc[ai][bj][m][0] *= a; acc[ai][bj][m][1] *= b; }
    }
    __device__ __forceinline__ void operator()(const Acc& acc, const Unit& u, int wr, int wc, int fr, int fq) const {
        unsigned o0 = ((unsigned)(u.pm * BM + wr * 64 + fr) * D + (unsigned)(u.pn * BM + wc * 32 + 8 * fq)) * 2u;
        asm volatile("" : "+v"(o0));
#pragma unroll
        for (int ai = 0; ai < 2; ++ai)
#pragma unroll
            for (int m = 0; m < 4; ++m)
#pragma unroll
                for (int bj = 0; bj < 2; ++bj) { const unsigned o = o0 + (unsigned)((ai * HALF + m * 16) * D + bj * HALF) * 2u; const u32x4 w = *(const GAS u32x4*)((const GAS char*)GBS + o); f32x4 a, b; unpack8(w, a, b);
                    *(GAS u32x4*)((GAS char*)MG + o) = pack8(acc[ai][bj][m][0] * a, acc[ai][bj][m][1] * b); if (bj == 1 && m == 3) asm volatile("" ::: "memory"); }
    }
};

struct EpiWo {
    static constexpr bool MIDHOOK = false;
    bf16_t* DL;
    __device__ __forceinline__ void mid(Acc&, const Unit&, int, int, int, int) const {}
    __device__ __forceinline__ void operator()(const Acc& acc, const Unit& u, int wr, int wc, int fr, int fq) const {
        const int row0 = u.pm * BM + wr * 64 + fr, c0 = u.pn * BM + wc * 32 + 8 * fq;
#pragma unroll
        for (int ai = 0; ai < 2; ++ai)
#pragma unroll
            for (int m = 0; m < 4; ++m)
#pragma unroll
                for (int bj = 0; bj < 2; ++bj) *(u32x4*)(DL + (size_t)(row0 + ai * HALF + m * 16) * D + c0 + bj * HALF) = pack8(acc[ai][bj][m][0], acc[ai][bj][m][1]);
    }
};

struct EpiUp {
    static constexpr bool MIDHOOK = false;
    const float* rs2; const LAS int* tok; const float* b_up; unsigned char* ACT;
    __device__ __forceinline__ void mid(Acc&, const Unit&, int, int, int, int) const {}
    __device__ __forceinline__ void operator()(const Acc& acc, const Unit& u, int wr, int wc, int fr, int fq) const {
        const int rl0 = wr * 64 + fr, c0 = u.pn * 128 + wc * 32 + 8 * fq;
        float rs[2][4];
#pragma unroll
        for (int ai = 0; ai < 2; ++ai)
#pragma unroll
            for (int m = 0; m < 4; ++m) rs[ai][m] = rs2[tok[u.ui * 256 + rl0 + ai * HALF + m * 16]] * W8_INV;
        const float* bp = b_up + (size_t)u.e * 4096 + c0;
        const f32x4 bg0 = *(const f32x4*)(bp), bg1 = *(const f32x4*)(bp + 4), bu0 = *(const f32x4*)(bp + 2048), bu1 = *(const f32x4*)(bp + 2052);
#pragma unroll
        for (int ai = 0; ai < 2; ++ai)
#pragma unroll
            for (int m = 0; m < 4; ++m) { const float r = rs[ai][m]; f32x4 a0, a1;
#pragma unroll
                for (int n = 0; n < 2; ++n)
#pragma unroll
                    for (int jp = 0; jp < 2; ++jp) {
                        const f32x4 ag = acc[ai][0][m][n], au = acc[ai][1][m][n], bgv = n ? bg1 : bg0, buv = n ? bu1 : bu0;
                        f32x2 g = (f32x2){ag[2 * jp], ag[2 * jp + 1]} * r + (f32x2){bgv[2 * jp], bgv[2 * jp + 1]};
                        f32x2 uu = (f32x2){au[2 * jp], au[2 * jp + 1]} * r + (f32x2){buv[2 * jp], buv[2 * jp + 1]};
                        g.x = fminf(g.x, 7.f); g.y = fminf(g.y, 7.f);
                        uu.x = __builtin_amdgcn_fmed3f(uu.x, -7.f, 7.f); uu.y = __builtin_amdgcn_fmed3f(uu.y, -7.f, 7.f);
                        const f32x2 t = g * (-1.702f * 1.44269504f);
                        f32x2 den; den.x = __builtin_amdgcn_exp2f(t.x); den.y = __builtin_amdgcn_exp2f(t.y); den = den + 1.f;
                        f32x2 s; s.x = __builtin_amdgcn_rcpf(den.x); s.y = __builtin_amdgcn_rcpf(den.y);
                        const f32x2 a = (uu + 1.f) * (g * s);
                        if (n == 0) { a0[2 * jp] = a.x; a0[2 * jp + 1] = a.y; } else { a1[2 * jp] = a.x; a1[2 * jp + 1] = a.y; }
                    }
                *(u32x2*)(ACT + (size_t)(u.pm * BM + rl0 + ai * HALF + m * 16) * DFF + c0) = pack8_fp8(a0, a1); }
    }
};

struct EpiDown {
    static constexpr bool MIDHOOK = false;
    const float* b_dn; unsigned char* YR;
    __device__ __forceinline__ void mid(Acc&, const Unit&, int, int, int, int) const {}
    __device__ __forceinline__ void operator()(const Acc& acc, const Unit& u, int wr, int wc, int fr, int fq) const {
        const int rl0 = wr * 64 + fr, c0 = u.pn * BM + wc * 32 + 8 * fq;
        const float* bp = b_dn + (size_t)u.e * D + c0;
        f32x4 bv[2][2];
#pragma unroll
        for (int bj = 0; bj < 2; ++bj)
#pragma unroll
            for (int n = 0; n < 2; ++n) bv[bj][n] = *(const f32x4*)(bp + bj * HALF + 4 * n);
#pragma unroll
        for (int ai = 0; ai < 2; ++ai)
#pragma unroll
            for (int m = 0; m < 4; ++m)
#pragma unroll
                for (int bj = 0; bj < 2; ++bj)
                    *(u32x2*)(YR + (size_t)(u.pm * BM + rl0 + ai * HALF + m * 16) * D + c0 + bj * HALF) = pack8_fp8(acc[ai][bj][m][0] * W8_INV + bv[bj][0], acc[ai][bj][m][1] * W8_INV + bv[bj][1]);
    }
};

struct EpiDummy {
    static constexpr bool MIDHOOK = false;
    bf16_t* O; int nostore;
    __device__ __forceinline__ void mid(Acc&, const Unit&, int, int, int, int) const {}
    __device__ __forceinline__ void operator()(const Acc& acc, const Unit& u, int wr, int wc, int fr, int fq) const {
        const int row0 = (u.pm & 63) * BM + wr * 64 + fr, c0 = (u.pn & 7) * BM + wc * 32 + 8 * fq;
        if (nostore) {
#pragma unroll
            for (int ai = 0; ai < 2; ++ai)
#pragma unroll
                for (int m = 0; m < 4; ++m)
#pragma unroll
                    for (int bj = 0; bj < 2; ++bj) asm volatile("" :: "v"(acc[ai][bj][m][0]), "v"(acc[ai][bj][m][1]));
            return; }
#pragma unroll
        for (int ai = 0; ai < 2; ++ai)
#pragma unroll
            for (int m = 0; m < 4; ++m)
#pragma unroll
                for (int bj = 0; bj < 2; ++bj) *(u32x4*)(O + (size_t)(row0 + ai * HALF + m * 16) * D + c0 + bj * HALF) = pack8(acc[ai][bj][m][0], acc[ai][bj][m][1]);
    }
};
struct ProbeOrder {
    StaticOrder S; int mode, c;
    __device__ __forceinline__ bool next(int i, Unit& u) const {
        if (mode == 3) { if (c & 1) return false; StaticOrder H = S; H.G = S.G / 2; H.c = c >> 1; H.nwg = S.nwg / 2; return H.next(i, u); }
        if (!S.next(i, u)) return false; if (mode >= 1) u.pn = 0; if (mode >= 2) u.pm = c & 63; return true; }
};

struct ProbeMoe {
    MoeOrder S; int mode;
    __device__ __forceinline__ bool next(int i, Unit& u) const { if (!S.next(i, u)) return false; if (mode & 1) { u.e = 0; u.pn = 0; } if (mode & 2) u.pm = 0; return true; }
};
struct Frame {
    LAS unsigned char* lds; volatile LAS unsigned* MISC; gu32* ctl; unsigned char* ws;
    int tid, lane, wave, vcu, G;
    const float *x, *meta, *nmw, *w_in, *lbl, *gnw, *w_ho, *cw, *w_co, *w_o, *nfw, *w_r, *b_r, *w_up, *b_up, *w_dn, *b_dn, *fnw; float* out;
};
template <class T> __device__ __forceinline__ T* wsp(const Frame& F, size_t off) { return (T*)(F.ws + off); }

__device__ __forceinline__ void tr_tile(const float* W, int ldw, int k0, int src0, int src1, bool perm0, bool perm1, const float* kscale, bf16_t* dst, int dpitch, int drow0, int dk0, LAS unsigned* T, int lane) {
    const int ln = lane & 15, kr = lane >> 4, srcc = (ln < 8 ? src0 : src1) + 4 * (ln & 7);
    const float* wp = W + (size_t)(k0 + 2 * kr) * ldw + srcc;
    f32x4 va[8], vb[8]; f32x2 sc[8];
#pragma unroll
    for (int s = 0; s < 8; ++s) { va[s] = __builtin_nontemporal_load((const GAS f32x4*)(wp + (size_t)(8 * s) * ldw)); vb[s] = __builtin_nontemporal_load((const GAS f32x4*)(wp + (size_t)(8 * s + 1) * ldw));
        sc[s] = kscale ? *(const GAS f32x2*)(kscale + k0 + 8 * s + 2 * kr) : (f32x2){1.f, 1.f}; }
    __builtin_amdgcn_sched_barrier(0);
#pragma unroll
    for (int s = 0; s < 8; ++s) { const int col = (4 * s + kr) ^ (2 * ln);
#pragma unroll
        for (int i = 0; i < 4; ++i) T[(4 * ln + i) * 32 + col] = cvt_pk_bf16(va[s][i] * sc[s].x, vb[s][i] * sc[s].y); }
    LDS_WAIT(); asm volatile("" ::: "memory");
    const int c = lane & 7;
#pragma unroll
    for (int j = 0; j < 8; ++j) { const int rho = (lane >> 3) + 8 * j, h = rho >> 5, r32 = rho & 31; const bool pm = h ? perm1 : perm0; const int n = h * 32 + (pm ? perm32(r32) : r32);
        u32x4 v = *(const LAS u32x4*)(T + n * 32 + 4 * (c ^ (n >> 3)));
        if ((n >> 2) & 1) v = (u32x4){v.z, v.w, v.x, v.y};
        *(GAS u32x4*)(dst + (size_t)(drow0 + rho) * dpitch + dk0 + k0 + 8 * c) = v; }
    LDS_WAIT(); asm volatile("" ::: "memory");
}
template <int PMODE = 0> __device__ __forceinline__ void tr_tile_fp8(const float* W, int ldw, int k0, int src0, int src1, const float* kscale, unsigned char* dst, int dpitch, int drow0, LAS unsigned* T, int lane, bool perm = true) {
    const int ln = lane & 15, kr = lane >> 4, srcc = (ln < 8 ? src0 : src1) + 4 * (ln & 7);
    f32x4 v[2][4][4];
#pragma unroll
    for (int half = 0; half < 2; ++half) {
        const float* wp = W + (size_t)(k0 + 64 * half + 4 * kr) * ldw + srcc;
#pragma unroll
        for (int s = 0; s < 4; ++s) {
#pragma unroll
            for (int q = 0; q < 4; ++q) v[half][s][q] = __builtin_nontemporal_load((const GAS f32x4*)(wp + (size_t)(16 * s + q) * ldw)); }
    }
    __builtin_amdgcn_sched_barrier(0);
    if (PMODE == 1) {
#pragma unroll
        for (int half = 0; half < 2; ++half)
#pragma unroll
            for (int s = 0; s < 4; ++s)
#pragma unroll
                for (int q = 0; q < 4; ++q) asm volatile("" :: "v"(v[half][s][q]));
        return; }
#pragma unroll
    for (int half = 0; half < 2; ++half)
#pragma unroll
        for (int s = 0; s < 4; ++s) { const int col = (16 * half + 4 * s + kr) ^ (2 * ln);
            const f32x4 sc = kscale ? *(const GAS f32x4*)(kscale + k0 + 64 * half + 16 * s + 4 * kr) * W8_SCALE : (f32x4){W8_SCALE, W8_SCALE, W8_SCALE, W8_SCALE};
#pragma unroll
            for (int i = 0; i < 4; ++i) T[(4 * ln + i) * 32 + col] = pk4_fp8(v[half][s][0][i] * sc[0], v[half][s][1][i] * sc[1], v[half][s][2][i] * sc[2], v[half][s][3][i] * sc[3]); }
    LDS_WAIT(); asm volatile("" ::: "memory");
    const int c = lane & 7;
#pragma unroll
    for (int j = 0; j < 8; ++j) { const int rho = (lane >> 3) + 8 * j, h = rho >> 5, r32 = rho & 31; const int n = h * 32 + (perm ? perm32(r32) : r32);
        u32x4 v4 = *(const LAS u32x4*)(T + n * 32 + 4 * (c ^ (n >> 3)));
        if ((n >> 2) & 1) v4 = (u32x4){v4.z, v4.w, v4.x, v4.y};
        if (PMODE == 2) asm volatile("" :: "v"(v4)); else *(GAS u32x4*)(dst + (size_t)(drow0 + rho) * dpitch + k0 + 16 * c) = v4; }
    LDS_WAIT(); asm volatile("" ::: "memory");
}
__device__ __forceinline__ int win_src(int G, bool& perm) {
    const int pn = G >> 3, gi = G & 7; perm = true;
    if (pn < 4) return C_Q + pn * 256 + gi * 32;
    if (pn < 8) { perm = false; return C_F + (pn - 4) * 256 + gi * 32; }
    if (pn < 12) return C_V + (pn - 8) * 256 + gi * 32;
    if (pn < 16) return C_G + (pn - 12) * 256 + gi * 32;
    if (pn < 24) return (gi < 4 ? C_SV : C_SC) + (pn - 16) * 128 + (gi & 3) * 32;
    if (pn < 28) return C_SB + (pn - 24) * 256 + gi * 32;
    return (gi < 4 ? C_GA : C_GB) + (pn - 28) * 128 + (gi & 3) * 32;
}
__device__ __forceinline__ void p0_prologue(Frame& F) {
    const int gw = F.vcu * NWAVES + F.wave, NGW = F.G * NWAVES, gt = F.vcu * NTHR + F.tid, NGT = F.G * NTHR;
    for (int i = gt; i < HF; i += NGT) wsp<float>(F, WS_LB)[i] = 1.f / (1.f + __expf(F.lbl[HF + i] - F.lbl[i]));
    for (int i = gt; i < D * NE; i += NGT) { const int k = i >> 5, e = i & 31; const float v = F.w_r[i] * F.nfw[k]; const unsigned h = f2bf(v); const float lo = v - bf2f((unsigned short)h);
        wsp<bf16_t>(F, WS_WRH)[e * D + k] = (bf16_t)h; wsp<bf16_t>(F, WS_WRL)[e * D + k] = (bf16_t)f2bf(lo); }
    for (int i = gt; i < 48 * HF; i += NGT) { wsp<h16_t>(F, WS_LFM)[i] = (h16_t)0.f; wsp<bf16_t>(F, WS_VVM)[i] = 0; }
    {
        LAS float* hnm = (LAS float*)F.lds;
        for (int r = F.wave * 2; r < F.wave * 2 + 2; ++r) {
            const f32x4* xr = (const f32x4*)(F.meta + (size_t)r * D) + F.lane; f32x4 v[8]; float s = 0.f;
#pragma unroll
            for (int j = 0; j < 8; ++j) { v[j] = xr[64 * j]; s += (v[j].x * v[j].x + v[j].y * v[j].y) + (v[j].z * v[j].z + v[j].w * v[j].w); }
            const float rs = rsqrtf(wave_sum(s) * (1.f / D) + EPS);
#pragma unroll
            for (int j = 0; j < 8; ++j) { const f32x4 w = ((const f32x4*)F.nmw)[F.lane + 64 * j]; *(LAS f32x4*)(hnm + r * D + 4 * F.lane + 256 * j) = v[j] * rs * w; }
        }
        __syncthreads();
        LAS float* red = (LAS float*)(F.lds + TOK_OFF);
        for (int cb = F.vcu; cb < 256; cb += F.G) {
            const int col = F.tid & 15, ks = F.tid >> 4;
            int gcol;
            if (cb < 64) gcol = C_F + 16 * cb + col; else if (cb < 128) gcol = C_V + 16 * (cb - 64) + col; else gcol = (col < 8 ? C_SV : C_SC) + 8 * (cb - 128) + (col & 7);
            float a[16];
#pragma unroll
            for (int r = 0; r < 16; ++r) a[r] = 0.f;
#pragma unroll 8
            for (int k = ks * 64; k < ks * 64 + 64; ++k) { const float w = F.w_in[(size_t)k * INC + gcol];
#pragma unroll
                for (int r = 0; r < 16; ++r) a[r] = fmaf(hnm[r * D + k], w, a[r]); }
#pragma unroll
            for (int r = 0; r < 16; ++r) { a[r] += __shfl_xor(a[r], 16); a[r] += __shfl_xor(a[r], 32); }
            if (F.lane < 16) {
#pragma unroll
                for (int r = 0; r < 16; ++r) red[(F.wave * 16 + r) * 16 + col] = a[r]; }
            __syncthreads();
            if (F.tid < 256) { const int r = F.tid >> 4, c = F.tid & 15; float v = 0.f;
#pragma unroll
                for (int w = 0; w < 8; ++w) v += red[(w * 16 + r) * 16 + c];
                if (cb < 64) { const int ch = 16 * cb + c; const float l = 1.f / (1.f + __expf(F.lbl[HF + ch] - F.lbl[ch])); wsp<h16_t>(F, WS_LFM)[(48 + r) * HF + ch] = (h16_t)__logf(l + (1.f - l) * sigmoidf_(v)); }
                else if (cb < 128) wsp<bf16_t>(F, WS_VVM)[(48 + r) * HF + 16 * (cb - 64) + c] = (bf16_t)f2bf(v);
                else red[2048 + r * 16 + c] = v; }
            __syncthreads();
            if (cb >= 128 && F.tid < 128) { const int r = F.tid >> 3, c = F.tid & 7; wsp<bf16_t>(F, WS_UUM)[r * HF + 8 * (cb - 128) + c] = (bf16_t)f2bf(red[2048 + r * 16 + c] * red[2048 + r * 16 + c + 8]); }
            __syncthreads();
        }
        __syncthreads();
    }
    {
        LAS unsigned* T = (LAS unsigned*)(F.lds + F.wave * 16384);
        constexpr int I_IN = 32 * 4 * N_INB, I_AB = 16 * 32, I_O = 32 * 32, I_UP1 = 16 * 64, I_DN1 = 16 * 32;
        constexpr int I_IN8 = 16 * 4 * N_IN8;
        constexpr int NIT = I_IN + I_IN8 + 2 * I_AB + I_O;
        for (int it = gw; it < NIT; it += NGW) {
            int r = it;
            if (r < I_IN) { const int kb = r / (4 * N_INB), ntl = r % (4 * N_INB), nt = 4 * nth_bit(INB_MASK, ntl >> 2) + (ntl & 3); bool p0, p1; const int s0 = win_src(2 * nt, p0), s1 = win_src(2 * nt + 1, p1); tr_tile(F.w_in, INC, kb * 64, s0, s1, p0, p1, F.nmw, wsp<bf16_t>(F, WS_WIN), D, nt * 64, 0, T, F.lane); continue; } r -= I_IN;
            if (r < I_IN8) { const int kb = r / (4 * N_IN8), ntl = r % (4 * N_IN8), nt = 4 * nth_bit(IN8_MASK, ntl >> 2) + (ntl & 3); bool p0, p1; const int s0 = win_src(2 * nt, p0), s1 = win_src(2 * nt + 1, p1);
                tr_tile_fp8<0>(F.w_in, INC, kb * 128, s0, s1, F.nmw, wsp<unsigned char>(F, WS_WIN8), D, nt * 64, T, F.lane, p0); continue; } r -= I_IN8;
            if (r < I_AB) { const int kb = r / 32, nt = r % 32; tr_tile(F.w_ho, D, kb * 64, nt * 64, nt * 64 + 32, true, true, nullptr, wsp<bf16_t>(F, WS_WAB), D, nt * 64, 0, T, F.lane); continue; } r -= I_AB;
            if (r < I_AB) { const int kb = r / 32, nt = r % 32; tr_tile(F.w_co, D, kb * 64, nt * 64, nt * 64 + 32, true, true, nullptr, wsp<bf16_t>(F, WS_WAB), D, nt * 64, HF, T, F.lane); continue; } r -= I_AB;
            if (r < I_O) { const int kb = r / 32, nt = r % 32; tr_tile(F.w_o, D, kb * 64, nt * 64, nt * 64 + 32, true, true, nullptr, wsp<bf16_t>(F, WS_WO), D, nt * 64, 0, T, F.lane); continue; } r -= I_O;
        }
    }
    for (int m = gw; m < M; m += NGW) {
        const GAS f32x4* xr = (const GAS f32x4*)(F.x + (size_t)m * D) + F.lane; f32x4 v[8]; float s = 0.f;
#pragma unroll
        for (int j = 0; j < 8; ++j) v[j] = xr[64 * j];
        __builtin_amdgcn_sched_barrier(0);
#pragma unroll
        for (int j = 0; j < 8; ++j) s += (v[j].x * v[j].x + v[j].y * v[j].y) + (v[j].z * v[j].z + v[j].w * v[j].w);
        s = wave_sum(s);
        GAS u32x2* o8 = (GAS u32x2*)(wsp<bf16_t>(F, WS_XB) + (size_t)m * D) + F.lane;
#pragma unroll
        for (int j = 0; j < 8; ++j) { u32x2 w; w.x = pk2(v[j].x, v[j].y); w.y = pk2(v[j].z, v[j].w); o8[64 * j] = w; }
        GAS unsigned* o4 = (GAS unsigned*)(wsp<unsigned char>(F, WS_XB8) + (size_t)m * D) + F.lane;
#pragma unroll
        for (int j = 0; j < 8; ++j) o4[64 * j] = pk4_fp8(v[j].x, v[j].y, v[j].z, v[j].w);
        if (F.lane == 0) wsp<float>(F, WS_RS1)[m] = rsqrtf(s * (1.f / D) + EPS);
    }
}

template <int PMODE = 0> __device__ __forceinline__ void p1_convert(Frame& F, int rank, int nconv) {
    LAS unsigned* T = (LAS unsigned*)(F.lds + F.wave * 16384);
    constexpr int I_UP1 = 16 * 64, I_DN1 = 16 * 32, NIT = NE * (I_UP1 + I_DN1);
    for (int it = rank * NWAVES + F.wave; it < NIT; it += nconv * NWAVES) {
        int r = it;
        if (r < NE * I_UP1) { const int e = r / I_UP1, q = r % I_UP1, kb = q / 64, nt = q % 64, G0 = 2 * nt, pn = G0 >> 3, gi = G0 & 7; const int s0 = (gi < 4 ? 0 : 2048) + pn * 128 + (gi & 3) * 32;
            tr_tile_fp8<PMODE>(F.w_up + (size_t)e * D * 4096, 4096, kb * 128, s0, s0 + 32, F.nfw, wsp<unsigned char>(F, WS_WUP) + (size_t)e * 4096 * D, D, nt * 64, T, F.lane); continue; } r -= NE * I_UP1;
        { const int e = r / I_DN1, q = r % I_DN1, kb = q / 32, nt = q % 32;
          tr_tile_fp8<PMODE>(F.w_dn + (size_t)e * DFF * D, D, kb * 128, nt * 64, nt * 64 + 32, nullptr, wsp<unsigned char>(F, WS_WDN) + (size_t)e * D * DFF, DFF, nt * 64, T, F.lane); }
    }
}

constexpr int KTP = 72;
constexpr int QP_ = 136;
__device__ __forceinline__ void vt_load(const Frame& F, const bf16_t* Vb, size_t row0, int h, u32x4 (&w)[2]) {
#pragma unroll
    for (int q = 0; q < 2; ++q) { const int id = F.tid + 512 * q, t = id >> 4, v8 = (id & 15) * 8; w[q] = *(const GAS u32x4*)(Vb + (row0 + t) * HF + h * 128 + v8); }
}
__device__ __forceinline__ void vt_store(const Frame& F, const u32x4 (&w)[2], LAS bf16_t* VT) {
#pragma unroll
    for (int q = 0; q < 2; ++q) { const int id = F.tid + 512 * q, t = id >> 4, v8 = (id & 15) * 8; const unsigned ww[4] = {w[q].x, w[q].y, w[q].z, w[q].w};
        const int ts = t ^ (v8 & 24);
#pragma unroll
        for (int i = 0; i < 4; ++i) { VT[(v8 + 2 * i) * KTP + ts] = (bf16_t)(ww[i] & 0xffffu); VT[(v8 + 2 * i + 1) * KTP + ts] = (bf16_t)(ww[i] >> 16); } }
}
__device__ __forceinline__ int vt_off(int v, int t0) { return v * KTP + (t0 ^ (v & 24)); }
struct P2aRegs { float L[16]; u32x4 vw[2]; };
__device__ __forceinline__ void p2a_where(const Frame& F, int u, const h16_t*& Lb, const bf16_t*& Vb, size_t& row0, int& h, int& slot) {
    if (u < 8) { Lb = wsp<h16_t>(F, WS_LFM); Vb = wsp<bf16_t>(F, WS_VVM); row0 = 0; h = u; slot = 32 * 64 + u; }
    else { const int bh = (u - 8) >> 6, c = (u - 8) & 63, b = bh >> 3; h = bh & 7; Lb = wsp<h16_t>(F, WS_LF); Vb = wsp<bf16_t>(F, WS_VV); row0 = (size_t)b * SEQ + 64 * c; slot = bh * 64 + c; }
}
__device__ __forceinline__ void p2a_load(const Frame& F, int u, P2aRegs& R) {
    const h16_t* Lb; const bf16_t* Vb; size_t row0; int h, slot; p2a_where(F, u, Lb, Vb, row0, h, slot);
    const int d = F.tid & 127, tq = F.tid >> 7;
#pragma unroll
    for (int i = 0; i < 16; ++i) R.L[i] = (float)Lb[(row0 + 16 * tq + i) * HF + h * 128 + d];
    vt_load(F, Vb, row0, h, R.vw);
}
__device__ __forceinline__ void p2a_compute(Frame& F, int u, const P2aRegs& R) {
    LAS bf16_t* KT = (LAS bf16_t*)F.lds; LAS bf16_t* VT = KT + 128 * KTP; LAS float* TOT = (LAS float*)(F.lds + 2 * 128 * KTP * 2);
    const h16_t* Lb; const bf16_t* Vb; size_t row0; int h, slot; p2a_where(F, u, Lb, Vb, row0, h, slot);
    const int d = F.tid & 127, tq = F.tid >> 7;
    float cs[16]; float run = 0.f;
#pragma unroll
    for (int i = 0; i < 16; ++i) { run += R.L[i]; cs[i] = run; }
    TOT[tq * 128 + d] = run;
    vt_store(F, R.vw, VT);
    __syncthreads();
    float off = 0.f, total = 0.f;
#pragma unroll
    for (int q = 0; q < 4; ++q) { const float tv = TOT[q * 128 + d]; total += tv; if (q < tq) off += tv; }
#pragma unroll
    for (int i = 0; i < 16; i += 2) { const float k0 = (1.f - __expf(R.L[i])) * __expf(total - off - cs[i]), k1 = (1.f - __expf(R.L[i + 1])) * __expf(total - off - cs[i + 1]);
        *(LAS unsigned*)(KT + d * KTP + 16 * tq + i) = pk2(k0, k1); }
    if (tq == 0) wsp<float>(F, WS_DEC)[(size_t)slot * 128 + d] = __expf(total);
    __syncthreads();
    {
        const int w = F.wave, fr = F.lane & 15, fq = F.lane >> 4;
        bf16x8 a[2];
#pragma unroll
        for (int ks = 0; ks < 2; ++ks) a[ks] = *(const LAS bf16x8*)(KT + (16 * w + fr) * KTP + 32 * ks + 8 * fq);
        bf16_t* Ub = wsp<bf16_t>(F, WS_UC) + (size_t)slot * 16384;
#pragma unroll
        for (int vb = 0; vb < 8; ++vb) { f32x4 c = (f32x4){0.f, 0.f, 0.f, 0.f};
#pragma unroll
            for (int ks = 0; ks < 2; ++ks) { const bf16x8 bv = *(const LAS bf16x8*)(VT + vt_off(16 * vb + fr, 32 * ks + 8 * fq)); c = __builtin_amdgcn_mfma_f32_16x16x32_bf16(a[ks], bv, c, 0, 0, 0); }
            u32x2 o; o.x = pk2(c[0], c[1]); o.y = pk2(c[2], c[3]);
            *(GAS u32x2*)(Ub + (16 * vb + fr) * 128 + 16 * w + 4 * fq) = o; }
    }
    __syncthreads();
}
__device__ __forceinline__ void p2a_units(Frame& F, int c) {
    constexpr int NU = 2048 + 8;
    if (c >= NU) return;
    P2aRegs R; p2a_load(F, c, R);
    for (int u = c; u < NU; u += F.G) {
        P2aRegs N; const int un = u + F.G; if (un < NU) p2a_load(F, un, N); else N = R;
        p2a_compute(F, u, R);
        R = N;
    }
}
__device__ __forceinline__ void p2a_conv(Frame& F, int item) {
    const int c8 = (F.tid & 127) * 8, tq = F.tid >> 7, r0 = item * 64 + tq * 16, p0 = r0 & (SEQ - 1);
    const bf16_t* UU = wsp<bf16_t>(F, WS_UU); const bf16_t* UUM = wsp<bf16_t>(F, WS_UUM); const bf16_t* SBb = wsp<bf16_t>(F, WS_SB); bf16_t* A2 = wsp<bf16_t>(F, WS_A2);
    f32x4 w0a = *(const f32x4*)(F.cw + c8), w0b = *(const f32x4*)(F.cw + c8 + 4), w1a = *(const f32x4*)(F.cw + HF + c8), w1b = *(const f32x4*)(F.cw + HF + c8 + 4), w2a = *(const f32x4*)(F.cw + 2 * HF + c8), w2b = *(const f32x4*)(F.cw + 2 * HF + c8 + 4);
    f32x4 um2a, um2b, um1a, um1b;
    { const u32x4 a = (p0 >= 2) ? *(const GAS u32x4*)(UU + (size_t)(r0 - 2) * HF + c8) : *(const GAS u32x4*)(UUM + (14 + p0) * HF + c8); unpack8(a, um2a, um2b);
      const u32x4 b = (p0 >= 1) ? *(const GAS u32x4*)(UU + (size_t)(r0 - 1) * HF + c8) : *(const GAS u32x4*)(UUM + 15 * HF + c8); unpack8(b, um1a, um1b); }
#pragma unroll 4
    for (int i = 0; i < 16; ++i) { f32x4 ua, ub, sa, sb; unpack8(*(const GAS u32x4*)(UU + (size_t)(r0 + i) * HF + c8), ua, ub); unpack8(*(const GAS u32x4*)(SBb + (size_t)(r0 + i) * HF + c8), sa, sb);
        const f32x4 oa = sa * (w0a * um2a + w1a * um1a + w2a * ua), ob = sb * (w0b * um2b + w1b * um1b + w2b * ub);
        *(GAS u32x4*)(A2 + (size_t)(r0 + i) * D + HF + c8) = pack8(oa, ob);
        um2a = um1a; um2b = um1b; um1a = ua; um1b = ub; }
}
__device__ __forceinline__ void p2b_scan(Frame& F) {
    const int gw = F.vcu * NWAVES + F.wave;
    for (int it = gw; it < 1024; it += F.G * NWAVES) {
        const int item = it * 64 + F.lane, bh = item >> 11, e8 = item & 2047, h = bh & 7, d0 = (e8 & 15) * 8;
        const bf16_t* Ub = wsp<bf16_t>(F, WS_UC) + (size_t)bh * 64 * 16384 + e8 * 8; bf16_t* Sb = wsp<bf16_t>(F, WS_SS) + (size_t)bh * 64 * 16384 + e8 * 8;
        const float* Db = wsp<float>(F, WS_DEC) + (size_t)bh * 64 * 128 + d0;
        f32x4 s0, s1; unpack8(*(const GAS u32x4*)(wsp<bf16_t>(F, WS_UC) + (size_t)(32 * 64 + h) * 16384 + e8 * 8), s0, s1);
#pragma unroll 8
        for (int c = 0; c < 64; ++c) {
            *(GAS u32x4*)(Sb + (size_t)c * 16384) = pack8(s0, s1);
            f32x4 u0, u1; unpack8(*(const GAS u32x4*)(Ub + (size_t)c * 16384), u0, u1);
            const f32x4 g0 = *(const GAS f32x4*)(Db + c * 128), g1 = *(const GAS f32x4*)(Db + c * 128 + 4);
            s0 = g0 * s0 + u0; s1 = g1 * s1 + u1;
        }
    }
}
struct P2cRegs { f32x2 L[8]; unsigned qw[8]; u32x4 vw[2]; bf16x8 sa[4]; u32x2 gv[4]; };
__device__ __forceinline__ void p2c_load(const Frame& F, int u, P2cRegs& R) {
    const int bh = u >> 6, c = u & 63, b = bh >> 3, h = bh & 7; const size_t row0 = (size_t)b * SEQ + 64 * c;
    const int dp = (F.tid & 63) * 2, t8 = F.tid >> 6, w = F.wave, fr = F.lane & 15, fq = F.lane >> 4;
    const h16_t* Lb = wsp<h16_t>(F, WS_LF) + (row0 + 8 * t8) * HF + h * 128 + dp; const bf16_t* Qb = wsp<bf16_t>(F, WS_QS) + (row0 + 8 * t8) * HF + h * 128 + dp;
#pragma unroll
    for (int i = 0; i < 8; ++i) { const h16x2 lh = *(const GAS h16x2*)(Lb + (size_t)i * HF); R.L[i] = (f32x2){(float)lh.x, (float)lh.y}; R.qw[i] = *(const GAS unsigned*)(Qb + (size_t)i * HF); }
    vt_load(F, wsp<bf16_t>(F, WS_VV), row0, h, R.vw);
    const bf16_t* Sb = wsp<bf16_t>(F, WS_SS) + ((size_t)bh * 64 + c) * 16384 + (16 * w + fr) * 128 + 8 * fq;
#pragma unroll
    for (int ks = 0; ks < 4; ++ks) R.sa[ks] = *(const GAS bf16x8*)(Sb + 32 * ks);
    const bf16_t* GSb = wsp<bf16_t>(F, WS_GS);
#pragma unroll
    for (int tb = 0; tb < 4; ++tb) R.gv[tb] = *(const GAS u32x2*)(GSb + (row0 + 16 * tb + fr) * HF + h * 128 + 16 * w + 4 * fq);
}
__device__ __forceinline__ void p2c_compute(Frame& F, int u, const P2cRegs& R) {
    const int bh = u >> 6, c = u & 63, b = bh >> 3, h = bh & 7; const size_t row0 = (size_t)b * SEQ + 64 * c;
    LAS bf16_t* QPl = (LAS bf16_t*)F.lds; LAS bf16_t* QD = QPl + 64 * QP_; LAS bf16_t* KI = QD + 64 * QP_; LAS bf16_t* VT = KI + 160 * QP_; LAS bf16_t* PL = VT + 128 * KTP;
    LAS float* TOT8 = (LAS float*)(PL + 64 * KTP); LAS float* SSQ = TOT8 + 8 * 128;
    const int dp = (F.tid & 63) * 2, t8 = F.tid >> 6;
    f32x2 L[8], cs[8], q[8]; f32x2 run = (f32x2){0.f, 0.f};
#pragma unroll
    for (int i = 0; i < 8; ++i) { L[i] = R.L[i]; q[i] = (f32x2){bflo(R.qw[i]), bfhi(R.qw[i])}; }
#pragma unroll
    for (int i = 0; i < 8; ++i) { run += L[i]; cs[i] = run; }
    *(LAS f32x2*)(TOT8 + t8 * 128 + dp) = run;
    vt_store(F, R.vw, VT);
    for (int i = F.tid; i < 64 * KTP / 2; i += NTHR) ((LAS unsigned*)PL)[i] = 0u;
    __syncthreads();
    {
        f32x2 pre[9]; pre[0] = (f32x2){0.f, 0.f};
#pragma unroll
        for (int j = 0; j < 8; ++j) pre[j + 1] = pre[j] + *(const LAS f32x2*)(TOT8 + j * 128 + dp);
        f32x2 off = (f32x2){0.f, 0.f};
#pragma unroll
        for (int j = 0; j < 8; ++j) if (j == t8) off = pre[j];
        const int si = t8 >> 1;
        f32x2 st[4];
#pragma unroll
        for (int j = 0; j < 4; ++j) st[j] = pre[2 * j];
        f32x2 sti = st[0];
#pragma unroll
        for (int j = 1; j < 4; ++j) if (j == si) sti = st[j];
#pragma unroll
        for (int i = 0; i < 8; ++i) { const int t = 8 * t8 + i; const f32x2 bc = off + cs[i];
            *(LAS unsigned*)(QPl + t * QP_ + dp) = pk2(q[i].x * __expf(bc.x), q[i].y * __expf(bc.y));
            *(LAS unsigned*)(QD + t * QP_ + dp) = pk2(q[i].x * __expf(bc.x - sti.x), q[i].y * __expf(bc.y - sti.y));
            const f32x2 k = (f32x2){1.f - __expf(L[i].x), 1.f - __expf(L[i].y)};
#pragma unroll
            for (int j = 0; j < 4; ++j) if (j >= si) {
                *(LAS unsigned*)(KI + (8 * j * (j + 1) + t) * QP_ + dp) = pk2(k.x * __expf(fminf(st[j].x - bc.x, 80.f)), k.y * __expf(fminf(st[j].y - bc.y, 80.f))); }
        }
    }
    __syncthreads();
    const int w = F.wave, fr = F.lane & 15, fq = F.lane >> 4;
    for (int bi = w; bi < 10; bi += 8) {
        const int i = bi < 1 ? 0 : bi < 3 ? 1 : bi < 6 ? 2 : 3, j = bi - (i * (i + 1)) / 2;
        f32x4 cacc = (f32x4){0.f, 0.f, 0.f, 0.f};
#pragma unroll
        for (int ks = 0; ks < 4; ++ks) { const bf16x8 a = *(const LAS bf16x8*)(KI + (8 * i * (i + 1) + 16 * j + fr) * QP_ + 32 * ks + 8 * fq), bq = *(const LAS bf16x8*)(QD + (16 * i + fr) * QP_ + 32 * ks + 8 * fq);
            cacc = __builtin_amdgcn_mfma_f32_16x16x32_bf16(a, bq, cacc, 0, 0, 0); }
        if (i == j) {
#pragma unroll
            for (int r = 0; r < 4; ++r) if (4 * fq + r > fr) cacc[r] = 0.f; }
        u32x2 o; o.x = pk2(cacc[0], cacc[1]); o.y = pk2(cacc[2], cacc[3]);
        *(LAS u32x2*)(PL + (16 * i + fr) * KTP + 16 * j + 4 * fq) = o;
    }
    __syncthreads();
    f32x4 acc[4];
#pragma unroll
    for (int tb = 0; tb < 4; ++tb) acc[tb] = (f32x4){0.f, 0.f, 0.f, 0.f};
    {
#pragma unroll
        for (int ks = 0; ks < 4; ++ks)
#pragma unroll
            for (int tb = 0; tb < 4; ++tb) { const bf16x8 bq = *(const LAS bf16x8*)(QPl + (16 * tb + fr) * QP_ + 32 * ks + 8 * fq); acc[tb] = __builtin_amdgcn_mfma_f32_16x16x32_bf16(R.sa[ks], bq, acc[tb], 0, 0, 0); }
#pragma unroll
        for (int ks = 0; ks < 2; ++ks) { const bf16x8 va = *(const LAS bf16x8*)(VT + vt_off(16 * w + fr, 32 * ks + 8 * fq));
#pragma unroll
            for (int tb = 0; tb < 4; ++tb) { const bf16x8 bp = *(const LAS bf16x8*)(PL + (16 * tb + fr) * KTP + 32 * ks + 8 * fq); acc[tb] = __builtin_amdgcn_mfma_f32_16x16x32_bf16(va, bp, acc[tb], 0, 0, 0); } }
    }
#pragma unroll
    for (int tb = 0; tb < 4; ++tb) { float p = (acc[tb][0] * acc[tb][0] + acc[tb][1] * acc[tb][1]) + (acc[tb][2] * acc[tb][2] + acc[tb][3] * acc[tb][3]); p += __shfl_xor(p, 16); p += __shfl_xor(p, 32);
        if (fq == 0) SSQ[w * 64 + 16 * tb + fr] = p; }
    __syncthreads();
    {
        const f32x4 gw4 = *(const f32x4*)(F.gnw + 16 * w + 4 * fq);
        bf16_t* A2 = wsp<bf16_t>(F, WS_A2);
#pragma unroll
        for (int tb = 0; tb < 4; ++tb) { const int t = 16 * tb + fr; float ss = 0.f;
#pragma unroll
            for (int ww = 0; ww < 8; ++ww) ss += SSQ[ww * 64 + t];
            const float rs = rsqrtf(ss * (1.f / 128.f) + EPS);
            const u32x2 gv = R.gv[tb];
            const f32x4 o = acc[tb] * rs * gw4 * (f32x4){bflo(gv.x), bfhi(gv.x), bflo(gv.y), bfhi(gv.y)};
            u32x2 ov; ov.x = pk2(o[0], o[1]); ov.y = pk2(o[2], o[3]);
            *(GAS u32x2*)(A2 + (row0 + t) * D + h * 128 + 16 * w + 4 * fq) = ov; }
    }
    __syncthreads();
}
__device__ __forceinline__ void p2c_units(Frame& F, int c) {
    constexpr int NU = 2048;
    if (c >= NU) return;
    P2cRegs R; p2c_load(F, c, R);
    for (int u = c; u < NU; u += F.G) {
        P2cRegs N; const int un = u + F.G; if (un < NU) p2c_load(F, un, N); else N = R;
        p2c_compute(F, u, R);
        R = N;
    }
}

__device__ __forceinline__ void split8(const f32x4 a, const f32x4 b, bf16x8& hi, bf16x8& lo) {
    u32x4 h, l;
    h.x = cvt_pk_bf16(a[0], a[1]); h.y = cvt_pk_bf16(a[2], a[3]); h.z = cvt_pk_bf16(b[0], b[1]); h.w = cvt_pk_bf16(b[2], b[3]);
    l.x = cvt_pk_bf16(a[0] - bflo(h.x), a[1] - bfhi(h.x)); l.y = cvt_pk_bf16(a[2] - bflo(h.y), a[3] - bfhi(h.y)); l.z = cvt_pk_bf16(b[0] - bflo(h.z), b[1] - bfhi(h.z)); l.w = cvt_pk_bf16(b[2] - bflo(h.w), b[3] - bfhi(h.w));
    hi = __builtin_bit_cast(bf16x8, h); lo = __builtin_bit_cast(bf16x8, l);
}
__device__ __forceinline__ void p5_router(Frame& F) {
    const int fr = F.lane & 15, fq = F.lane >> 4, wq = F.wave & 3, kh = F.wave >> 2;
    LAS float* lg = (LAS float*)(F.lds + F.wave * 4096);
    LAS float* pa = (LAS float*)(F.lds + 32768) + (wq * 64 + F.lane) * 9;
    const bf16_t* DL = wsp<bf16_t>(F, WS_H1); unsigned char* H1B = wsp<unsigned char>(F, WS_H1B); const bf16_t* WH = wsp<bf16_t>(F, WS_WRH); const bf16_t* WL = wsp<bf16_t>(F, WS_WRL);
    for (int it = F.vcu * 4 + wq; it < M / 16; it += F.G * 4) {
        const int row0 = it * 16, kofs = 1024 * kh;
        const float* hp = F.x + (size_t)(row0 + fr) * D + kofs + 8 * fq; const bf16_t* dp_ = DL + (size_t)(row0 + fr) * D + kofs + 8 * fq; unsigned char* qp = H1B + (size_t)(row0 + fr) * D + kofs + 8 * fq;
        const bf16_t* wh0 = WH + (size_t)fr * D + kofs + 8 * fq; const bf16_t* wl0 = WL + (size_t)fr * D + kofs + 8 * fq;
        f32x4 a0 = (f32x4){0.f, 0.f, 0.f, 0.f}, a1 = a0; float ss = 0.f;
#pragma unroll 4
        for (int ks = 0; ks < 32; ++ks) {
            f32x4 xa = *(const GAS f32x4*)(hp + 32 * ks), xb = *(const GAS f32x4*)(hp + 32 * ks + 4); { f32x4 da, db; unpack8(*(const GAS u32x4*)(dp_ + 32 * ks), da, db); xa += da; xb += db; }
            *(GAS u32x2*)(qp + 32 * ks) = pack8_fp8(xa, xb);
            *(GAS u32x4*)((bf16_t*)dp_ + 32 * ks) = pack8(xa, xb);
            ss += (xa[0] * xa[0] + xa[1] * xa[1]) + (xa[2] * xa[2] + xa[3] * xa[3]) + (xb[0] * xb[0] + xb[1] * xb[1]) + (xb[2] * xb[2] + xb[3] * xb[3]);
            bf16x8 xh, xl; split8(xa, xb, xh, xl);
            const bf16x8 bh0 = *(const GAS bf16x8*)(wh0 + 32 * ks), bl0 = *(const GAS bf16x8*)(wl0 + 32 * ks), bh1 = *(const GAS bf16x8*)(wh0 + 16 * D + 32 * ks), bl1 = *(const GAS bf16x8*)(wl0 + 16 * D + 32 * ks);
            a0 = __builtin_amdgcn_mfma_f32_16x16x32_bf16(xh, bh0, a0, 0, 0, 0); a0 = __builtin_amdgcn_mfma_f32_16x16x32_bf16(xh, bl0, a0, 0, 0, 0);
            a0 = __builtin_amdgcn_mfma_f32_16x16x32_bf16(xl, bh0, a0, 0, 0, 0); a0 = __builtin_amdgcn_mfma_f32_16x16x32_bf16(xl, bl0, a0, 0, 0, 0);
            a1 = __builtin_amdgcn_mfma_f32_16x16x32_bf16(xh, bh1, a1, 0, 0, 0); a1 = __builtin_amdgcn_mfma_f32_16x16x32_bf16(xh, bl1, a1, 0, 0, 0);
            a1 = __builtin_amdgcn_mfma_f32_16x16x32_bf16(xl, bh1, a1, 0, 0, 0); a1 = __builtin_amdgcn_mfma_f32_16x16x32_bf16(xl, bl1, a1, 0, 0, 0);
        }
        if (kh == 1) {
#pragma unroll
            for (int r = 0; r < 4; ++r) { pa[r] = a0[r]; pa[4 + r] = a1[r]; }
            pa[8] = ss; }
        __syncthreads();
        if (kh == 0) {
#pragma unroll
            for (int r = 0; r < 4; ++r) { a0[r] += pa[r]; a1[r] += pa[4 + r]; }
            ss += pa[8];
            ss += __shfl_xor(ss, 16); ss += __shfl_xor(ss, 32);
#pragma unroll
            for (int r = 0; r < 4; ++r) { lg[(4 * fq + r) * 33 + fr] = a0[r]; lg[(4 * fq + r) * 33 + 16 + fr] = a1[r]; }
            LDS_WAIT(); asm volatile("" ::: "memory");
            if (F.lane < 16) {
                const int tokn = row0 + F.lane; const float rs = rsqrtf(ss * (1.f / D) + EPS);
                float v[32];
#pragma unroll
                for (int e = 0; e < 32; ++e) v[e] = lg[F.lane * 33 + e] * rs + F.b_r[e];
                int idx[4]; float val[4];
#pragma unroll
                for (int k = 0; k < 4; ++k) { float bv = -3.0e38f; int bi = 0;
#pragma unroll
                    for (int e = 0; e < 32; ++e) { const bool tk = v[e] > bv; bv = tk ? v[e] : bv; bi = tk ? e : bi; }
                    idx[k] = bi; val[k] = bv;
#pragma unroll
                    for (int e = 0; e < 32; ++e) v[e] = (e == bi) ? -3.0e38f : v[e]; }
                float ex[4], den = 0.f;
#pragma unroll
                for (int k = 0; k < 4; ++k) { ex[k] = __expf(val[k] - val[0]); den += ex[k]; }
                const float inv = 1.f / den;
                wsp<float>(F, WS_RS2)[tokn] = rs;
                int pos[4];
#pragma unroll
                for (int k = 0; k < 4; ++k) pos[k] = (int)__hip_atomic_fetch_add(F.ctl + CW_CNT + 64 * idx[k], 1u, __ATOMIC_RELAXED, __HIP_MEMORY_SCOPE_AGENT);
#pragma unroll
                for (int k = 0; k < 4; ++k) {
                    wsp<int>(F, WS_TOPE)[tokn * 4 + k] = idx[k]; wsp<int>(F, WS_TOPP)[tokn * 4 + k] = pos[k]; wsp<float>(F, WS_TOPW)[tokn * 4 + k] = ex[k] * inv;
                    wsp<int>(F, WS_LIST)[(size_t)idx[k] * CAPF + pos[k]] = tokn; }
            }
        }
        __syncthreads();
    }
}
__device__ __forceinline__ void build_pref(Frame& F) {
    if (F.wave == 0) {
        int tl = 0;
        if (F.lane < NE) { const unsigned c = __hip_atomic_load(F.ctl + CW_CNT + 64 * F.lane, RLX_AGENT); tl = (int)((c + 255u) >> 8); }
        int s = tl;
#pragma unroll
        for (int d = 1; d < 32; d <<= 1) { const int v = __shfl_up(s, d); if (F.lane >= d) s += v; }
        if (F.lane < NE) F.MISC[16 + F.lane] = (unsigned)(s - tl);
        if (F.lane == NE - 1) F.MISC[16 + NE] = (unsigned)(s < MAXRT ? s : MAXRT); }
    __syncthreads();
}
__device__ __forceinline__ void build_tok(Frame& F, const MoeOrder& S) {
    LAS int* tokt = (LAS int*)(F.lds + TOK_OFF);
    volatile LAS int* um = (volatile LAS int*)(F.MISC + 64);
    if (F.tid < 18) { Unit u; int base = -1, nv = 0;
        if (S.next(F.tid, u)) { const int rt = u.pm - (int)F.MISC[16 + u.e]; const int cnt = (int)__hip_atomic_load(F.ctl + CW_CNT + 64 * u.e, RLX_AGENT);
            base = u.e * CAPF + rt * 256; nv = cnt - rt * 256; nv = nv < 0 ? 0 : (nv > 256 ? 256 : nv); }
        um[2 * F.tid] = base; um[2 * F.tid + 1] = nv; }
    __syncthreads();
    if (F.tid < 256) { int t[18]; const int* LIST = wsp<int>(F, WS_LIST);
#pragma unroll
        for (int i = 0; i < 18; ++i) { const int base = um[2 * i], nv = um[2 * i + 1]; t[i] = (base >= 0 && F.tid < nv) ? LIST[base + F.tid] : 0; }
#pragma unroll
        for (int i = 0; i < 18; ++i) if (um[2 * i] >= 0) tokt[i * 256 + F.tid] = t[i]; }
    __syncthreads();
}
struct P9Tok { f32x4 v[8]; unsigned y[4][8]; f32x4 tw; };
template <int PM> __device__ __forceinline__ void p9_issue(const Frame& F, int m, P9Tok& T) {
    typedef int i32x4 __attribute__((ext_vector_type(4)));
    const bf16_t* DL = wsp<bf16_t>(F, WS_H1); const unsigned char* YR = wsp<unsigned char>(F, WS_YR);
    const i32x4 te = *(const GAS i32x4*)(wsp<int>(F, WS_TOPE) + m * 4), tp = *(const GAS i32x4*)(wsp<int>(F, WS_TOPP) + m * 4); T.tw = *(const GAS f32x4*)(wsp<float>(F, WS_TOPW) + m * 4);
#pragma unroll
    for (int j = 0; j < 8; ++j) { const u32x2 dw = (PM == 4) ? (u32x2){(unsigned)m, 0u} : *(const GAS u32x2*)(DL + (size_t)m * D + 4 * F.lane + 256 * j);
        T.v[j] = (f32x4){bflo(dw.x), bfhi(dw.x), bflo(dw.y), bfhi(dw.y)}; }
#pragma unroll
    for (int k = 0; k < 4; ++k) { const size_t row = (size_t)((const LAS unsigned*)F.MISC)[16 + te[k]] * 256 + tp[k];
#pragma unroll
        for (int j = 0; j < 8; ++j) T.y[k][j] = (PM == 1) ? (unsigned)row : *(const GAS unsigned*)(YR + row * D + 4 * F.lane + 256 * j); }
}
template <int PM> __device__ __forceinline__ void p9_finish(const Frame& F, int m, P9Tok& T, float* outp) {
#pragma unroll
    for (int k = 0; k < 4; ++k)
#pragma unroll
        for (int j = 0; j < 8; ++j) { const f32x2 p0 = __builtin_amdgcn_cvt_pk_f32_fp8((int)T.y[k][j], false), p1 = __builtin_amdgcn_cvt_pk_f32_fp8((int)T.y[k][j], true); T.v[j] += (f32x4){p0.x, p0.y, p1.x, p1.y} * T.tw[k]; }
    float s = 0.f;
#pragma unroll
    for (int j = 0; j < 8; ++j) s += (T.v[j][0] * T.v[j][0] + T.v[j][1] * T.v[j][1]) + (T.v[j][2] * T.v[j][2] + T.v[j][3] * T.v[j][3]);
    const float rs = rsqrtf(wave_sum(s) * (1.f / D) + EPS);
#pragma unroll
    for (int j = 0; j < 8; ++j) { const f32x4 w = *(const f32x4*)(F.fnw + 4 * F.lane + 256 * j); const f32x4 o = T.v[j] * rs * w;
        if (PM == 2) asm volatile("" :: "v"(o)); else *(GAS f32x4*)(outp + (size_t)m * D + 4 * F.lane + 256 * j) = o; }
}
template <int PM> __device__ __forceinline__ void p9_combine_t(Frame& F, float* outp) {
    const int gw = F.vcu * NWAVES + F.wave, NGW9 = F.G * NWAVES;
    for (int m = gw; m < M; m += 2 * NGW9) {
        const int m2 = m + NGW9; const bool two = m2 < M;
        P9Tok A, B; p9_issue<PM>(F, m, A); p9_issue<PM>(F, two ? m2 : m, B);
        __builtin_amdgcn_sched_barrier(0);
        p9_finish<PM>(F, m, A, outp); if (two) p9_finish<PM>(F, m2, B, outp);
    }
}
__device__ __forceinline__ void p9_combine(Frame& F) { p9_combine_t<0>(F, F.out); }
constexpr int NPH = 11;
struct Args { const float* in[18]; float* out; unsigned char* ws; int ph_lo, ph_hi; };

__global__ void __launch_bounds__(NTHR, 2) fwd_kernel(Args args) {
    extern __shared__ __attribute__((aligned(16))) unsigned char lds_raw[];
    Frame F;
    F.lds = (LAS unsigned char*)lds_raw; F.MISC = (volatile LAS unsigned*)(F.lds + MISC_OFF);
    F.wave = __builtin_amdgcn_readfirstlane((int)threadIdx.x >> 6);
#define REFRESH() do { F.lane = lane_id(); F.tid = F.wave * 64 + F.lane; } while (0)
    REFRESH();
    F.G = gridDim.x; { const int bx = blockIdx.x; F.vcu = (F.G % 8 == 0) ? (bx % 8) * (F.G / 8) + bx / 8 : bx; }
    F.ws = args.ws; F.ctl = (gu32*)(args.ws + WS_CTL); F.out = args.out;
    F.x = args.in[0]; F.meta = args.in[1]; F.nmw = args.in[2]; F.w_in = args.in[3]; F.lbl = args.in[4]; F.gnw = args.in[5]; F.w_ho = args.in[6]; F.cw = args.in[7]; F.w_co = args.in[8]; F.w_o = args.in[9];
    F.nfw = args.in[10]; F.w_r = args.in[11]; F.b_r = args.in[12]; F.w_up = args.in[13]; F.b_up = args.in[14]; F.w_dn = args.in[15]; F.b_dn = args.in[16]; F.fnw = args.in[17];
    for (int u = F.tid; u < 256; u += NTHR) F.MISC[u] = 0u;
    __syncthreads();
    const int lo = args.ph_lo, hi = args.ph_hi;
    const bool multi = (hi - lo) > 1;
    XcdBarrier bar; bar.bar = (unsigned*)(F.ctl + CW_BAR); bar.x = 0; bar.st = nullptr;
    if (multi) bar = xcd_barrier_post((unsigned*)(F.ctl + CW_BAR), F.MISC, F.tid);
#define IN(k) (lo <= (k) && (k) < hi)
#if defined(FK_STAMP_A)
#define STAMP(k) do { if (blockIdx.x == 0 && F.tid == 0) __hip_atomic_store(F.ctl + CW_TS + (k), (unsigned)__builtin_amdgcn_s_memrealtime(), RLX_AGENT); } while (0)
#else
#define STAMP(k) do { } while (0)
#endif
#if defined(FK_PROBE_BAR)
#define SEAM(k) do { REFRESH(); if (IN(k) && IN((k) + 1)) { xcd_barrier(bar, F.tid); xcd_barrier(bar, F.tid); xcd_barrier(bar, F.tid); } STAMP((k) + 1); } while (0)
#else
#define SEAM(k) do { REFRESH(); if (IN(k) && IN((k) + 1)) xcd_barrier(bar, F.tid); STAMP((k) + 1); } while (0)
#endif
    STAMP(0);
    const int c = blockIdx.x;
#ifndef FK_DUP_MASK
#define FK_DUP_MASK 0
#endif
#ifndef FK_DUP_REPS
#define FK_DUP_REPS 1
#endif
#define DUP(k) for (int _rep = 0; _rep < 1 + FK_DUP_REPS * ((FK_DUP_MASK >> (k)) & 1); ++_rep)
#define REDO(k) do { if (((FK_DUP_MASK >> (k)) & 1) && _rep < FK_DUP_REPS) { REFRESH(); xcd_barrier(bar, F.tid); } } while (0)

    if (IN(0)) DUP(0) { p0_prologue(F); REDO(0); } SEAM(0);

    if (IN(1)) DUP(1) {
        constexpr int NCONV_PER8 = 3;
        const int cq = c >> 3; const bool conv = (F.G % 64 == 0) && ((cq & 7) < NCONV_PER8) && (_rep == 0);
        if (F.G % 64 != 0 && _rep == 0) { if (c == 0) p1_convert(F, 0, 1); }
        if (conv) { const int nconv = (F.G / 64) * 8 * NCONV_PER8, rank = ((cq >> 3) * NCONV_PER8 + (cq & 7)) * 8 + (c & 7); p1_convert(F, rank, nconv);
#if defined(FK_PROBE_CONV2)
            __syncthreads(); p1_convert<FK_PROBE_CONV2 - 1>(F, rank, nconv);
#endif
        }
        __syncthreads();
        EpiInproj E{wsp<float>(F, WS_RS1), wsp<float>(F, WS_LB), wsp<bf16_t>(F, WS_QS), wsp<bf16_t>(F, WS_VV), wsp<bf16_t>(F, WS_GS), wsp<bf16_t>(F, WS_UU), wsp<bf16_t>(F, WS_SB), wsp<bf16_t>(F, WS_RT), wsp<bf16_t>(F, WS_GBS), wsp<h16_t>(F, WS_LF), 1.f};
        if (N_INB > 0) {
            GemmDesc g{wsp<bf16_t>(F, WS_XB), wsp<bf16_t>(F, WS_WIN), D, INC / 256};
            DynOrder S; S.init(M, INB_MASK, N_INB, c, (unsigned*)(F.ctl + CW_Q + 64 * (c & 7) + 8 * _rep), F.MISC + 4, F.tid);
            gemm_phase<EpiInproj, DynOrder, false, true, false>(F.lds, g, S, E, nullptr, F.wave); }
        if (N_IN8 > 0) {
            REFRESH(); E.osc = 1.f / W8_SCALE;
            GemmDesc g{(const bf16_t*)wsp<unsigned char>(F, WS_XB8), (const bf16_t*)wsp<unsigned char>(F, WS_WIN8), D, INC / 256};
            DynOrder S; S.init(M, IN8_MASK, N_IN8, c, (unsigned*)(F.ctl + CW_Q + 64 * (c & 7) + 8 * _rep + 4), F.MISC + 6, F.tid);
            gemm_phase<EpiInproj, DynOrder, false, true, true>(F.lds, g, S, E, nullptr, F.wave); }
        REDO(1);
    } SEAM(1);

#if defined(FK_PROBE_GEMM)
    if (IN(1)) {
        GemmDesc g{wsp<bf16_t>(F, WS_XB), wsp<bf16_t>(F, WS_WIN), D, INC / 256}; ProbeOrder S; S.S.init(M, INC, F.G, c); S.mode = FK_PROBE_GEMM & 3; S.c = c;
        EpiDummy E{wsp<bf16_t>(F, WS_ACT), (FK_PROBE_GEMM >> 2) & 1};
        gemm_phase<EpiDummy, ProbeOrder, false, true, false>(F.lds, g, S, E, nullptr, F.wave);
        REFRESH(); xcd_barrier(bar, F.tid);
    }
#endif
    if (IN(2)) DUP(2) { p2a_units(F, c); for (int it = c; it < M / 64; it += F.G) p2a_conv(F, it); REDO(2); } SEAM(2);
    if (IN(3)) DUP(3) { p2b_scan(F); REDO(3); } SEAM(3);
    if (IN(4)) DUP(4) { p2c_units(F, c); REDO(4); } SEAM(4);

    if (IN(5)) DUP(5) {
        GemmDesc g{wsp<bf16_t>(F, WS_A2), wsp<bf16_t>(F, WS_WAB), D, D / 256}; StaticOrder S; S.init(M, D, F.G, c);
        EpiMerge E{wsp<bf16_t>(F, WS_RT), wsp<bf16_t>(F, WS_GBS), wsp<bf16_t>(F, WS_MG)};
        gemm_phase<EpiMerge, StaticOrder, false, true, false>(F.lds, g, S, E, nullptr, F.wave); REDO(5);
    } SEAM(5);

    if (IN(6)) DUP(6) {
        GemmDesc g{wsp<bf16_t>(F, WS_MG), wsp<bf16_t>(F, WS_WO), D, D / 256}; StaticOrder S; S.init(M, D, F.G, c);
        EpiWo E{wsp<bf16_t>(F, WS_H1)};
        gemm_phase<EpiWo, StaticOrder, false, true, false>(F.lds, g, S, E, nullptr, F.wave); REDO(6);
    } SEAM(6);

    if (IN(7)) { p5_router(F); } SEAM(7);

    if (IN(8)) DUP(8) {
        build_pref(F);
        MoeOrder S; S.init(16, F.G, c, (const volatile LAS int*)(F.MISC + 16));
        build_tok(F, S);
        GemmDesc g{wsp<bf16_t>(F, WS_H1B), wsp<bf16_t>(F, WS_WUP), D, 16};
        EpiUp E{wsp<float>(F, WS_RS2), (const LAS int*)(F.lds + TOK_OFF), F.b_up, wsp<unsigned char>(F, WS_ACT)};
        gemm_phase<EpiUp, MoeOrder, true, true, true>(F.lds, g, S, E, (const LAS int*)(F.lds + TOK_OFF), F.wave); REDO(8);
    } SEAM(8);

    if (IN(9)) DUP(9) {
        build_pref(F);
        MoeOrder S; S.init(8, F.G, c, (const volatile LAS int*)(F.MISC + 16));
        GemmDesc g{wsp<bf16_t>(F, WS_ACT), wsp<bf16_t>(F, WS_WDN), DFF, 8};
        EpiDown E{F.b_dn, wsp<unsigned char>(F, WS_YR)};
        gemm_phase<EpiDown, MoeOrder, false, true, true>(F.lds, g, S, E, nullptr, F.wave); REDO(9);
    } SEAM(9);

#if defined(FK_PROBE_P8)
    if (IN(10)) {
        build_pref(F);
        ProbeMoe S; S.S.init(8, F.G, c, (const volatile LAS int*)(F.MISC + 16)); S.mode = FK_PROBE_P8 & 3;
        GemmDesc g{wsp<bf16_t>(F, WS_ACT), wsp<bf16_t>(F, WS_WDN), DFF, 8};
        EpiDummy E{wsp<bf16_t>(F, WS_XB), 1};
        for (int r = 0; r < 2; ++r) { gemm_phase<EpiDummy, ProbeMoe, false, true, true>(F.lds, g, S, E, nullptr, F.wave); REFRESH(); xcd_barrier(bar, F.tid); }
    }
#endif
    if (IN(10)) DUP(10) { build_pref(F); p9_combine(F); REDO(10); }
#if defined(FK_PROBE_P9)
    if (IN(10)) { for (int r = 0; r < 4; ++r) { REFRESH(); xcd_barrier(bar, F.tid); p9_combine_t<FK_PROBE_P9 - 1>(F, wsp<float>(F, WS_XB)); } }
#endif
#undef IN
#undef DUP
#undef REDO
#undef SEAM
#undef STAMP
#undef REFRESH
}

inline void launch_fast(hipStream_t stream, void* const* d_in, float* out, unsigned char* ws, int n_launches) {
    static int grid = 0;
    if (grid == 0) {
        int dev = 0, cus = 0, per_cu = 0;
        if (hipGetDevice(&dev) != hipSuccess || hipDeviceGetAttribute(&cus, hipDeviceAttributeMultiprocessorCount, dev) != hipSuccess) { fprintf(stderr, "kernel_launch: device query failed\n"); grid = -1; return; }
        if (hipFuncSetAttribute((const void*)fwd_kernel, hipFuncAttributeMaxDynamicSharedMemorySize, LDS_BYTES) != hipSuccess) { fprintf(stderr, "kernel_launch: hipFuncSetAttribute failed\n"); grid = -1; return; }
        if (hipOccupancyMaxActiveBlocksPerMultiprocessor(&per_cu, (const void*)fwd_kernel, NTHR, LDS_BYTES) != hipSuccess || per_cu < 1) fprintf(stderr, "kernel_launch: note: occupancy query says %d blocks per CU\n", per_cu);
        (void)hipGetLastError();
        grid = cus;
    }
    if (grid < 0) return;
    (void)hipMemsetAsync(ws + WS_CTL, 0, CTL_BYTES, stream);
    Args a{};
    for (int i = 0; i < 18; ++i) a.in[i] = (const float*)d_in[i];
    a.out = out; a.ws = ws;
    for (int li = 0; li < n_launches; ++li) {
        a.ph_lo = (n_launches == 1) ? 0 : li; a.ph_hi = (n_launches == 1) ? NPH : li + 1;
        hipLaunchKernelGGL(fwd_kernel, dim3(grid), dim3(NTHR), LDS_BYTES, stream, a);
        const hipError_t le = hipPeekAtLastError();
        if (le != hipSuccess) { fprintf(stderr, "kernel_launch: launch %d failed: %s\n", li, hipGetErrorName(le)); break; }
    }
}
}
#ifndef FK_LAUNCHES
#define FK_LAUNCHES 1
#endif
extern "C" void kernel_launch(void* const* d_in, const int* in_sizes, int n_in, void* d_out, int out_size, void* d_ws, size_t ws_size, hipStream_t stream) {
    if (n_in != 18 || ws_size < fk::WS_FAST_END) { fprintf(stderr, "kernel_launch: n_in %d, ws %zu < %zu\n", n_in, ws_size, (size_t)fk::WS_FAST_END); return; }
    fk::launch_fast(stream, d_in, (float*)d_out, (unsigned char*)d_ws, FK_LAUNCHES);
}
```

```cpp
#include <hip/hip_runtime.h>
#include <cstdio>
#define FK_LAUNCHES 1
#define FK_IN8_MASK 0xFFFF000F0FFull
#define FK_WO8 0
namespace fk {
#define LAS __attribute__((address_space(3)))
#define GAS __attribute__((address_space(1)))
typedef unsigned short bf16_t;
typedef short bf16x8 __attribute__((ext_vector_type(8)));
typedef float f32x4 __attribute__((ext_vector_type(4)));
typedef float f32x2 __attribute__((ext_vector_type(2)));
typedef unsigned u32x4 __attribute__((ext_vector_type(4)));
typedef unsigned u32x2 __attribute__((ext_vector_type(2)));
typedef GAS unsigned gu32;
typedef _Float16 h16_t;
typedef _Float16 h16x4 __attribute__((ext_vector_type(4)));
typedef _Float16 h16x2 __attribute__((ext_vector_type(2)));
#define RLX_AGENT __ATOMIC_RELAXED, __HIP_MEMORY_SCOPE_AGENT
#define LDS_WAIT() asm volatile("s_waitcnt lgkmcnt(0)" ::: "memory")
#define VM_WAIT() asm volatile("s_waitcnt vmcnt(0)" ::: "memory")

constexpr int D = 2048, NB = 4, SEQ = 4096, M = NB * SEQ, NMETA = 16;
constexpr int HF = 1024, INC = 11264, NE = 32, DFF = 2048, NCH = SEQ / 64;
constexpr int C_Q = 0, C_F = 1024, C_V = 2048, C_G = 3072, C_SV = 4096, C_SB = 5120, C_SC = 6144, C_GA = 7168, C_GB = 9216;
constexpr float EPS = 1e-6f;
constexpr int CAPF = M;
constexpr int MAXRT = 288;
constexpr int NWAVES = 8, NTHR = 512;

constexpr size_t al(size_t x) { return (x + 0xFFFFF) & ~(size_t)0xFFFFF; }
constexpr size_t WS_CTL = 0, CTL_BYTES = 65536;
constexpr size_t WS_LB = 65536, WS_RS1 = WS_LB + 4096, WS_RS2 = WS_RS1 + 65536, WS_WRH = WS_RS2 + 65536, WS_WRL = WS_WRH + 131072;
constexpr size_t WS_LFM = WS_WRL + 131072, WS_VVM = WS_LFM + 64 * 1024 * 4, WS_UUM = WS_VVM + 64 * 1024 * 2, WS_SMALL_END = WS_UUM + 16 * 1024 * 2;
constexpr size_t WS_TOPE = al(WS_SMALL_END), WS_TOPP = WS_TOPE + (size_t)M * 16, WS_TOPW = WS_TOPP + (size_t)M * 16, WS_LIST = WS_TOPW + (size_t)M * 16;
constexpr size_t WS_DEC = al(WS_LIST + (size_t)NE * CAPF * 4);
constexpr size_t WS_WIN = al(WS_DEC + (size_t)33 * 64 * 128 * 4);
constexpr size_t WS_WAB = al(WS_WIN + (size_t)INC * D * 2);
constexpr size_t WS_WO = al(WS_WAB + (size_t)D * D * 2);
constexpr size_t WS_WUP = al(WS_WO + (size_t)D * D * 2);
constexpr size_t WS_WDN = al(WS_WUP + (size_t)NE * 4096 * D);
constexpr size_t WS_XB = al(WS_WDN + (size_t)NE * D * DFF);
constexpr size_t WS_QS = al(WS_XB + (size_t)M * D * 2);
constexpr size_t WS_LF = al(WS_QS + (size_t)M * HF * 2);
constexpr size_t WS_VV = al(WS_LF + (size_t)M * HF * 2);
constexpr size_t WS_GS = al(WS_VV + (size_t)M * HF * 2);
constexpr size_t WS_UU = al(WS_GS + (size_t)M * HF * 2);
constexpr size_t WS_SB = al(WS_UU + (size_t)M * HF * 2);
constexpr size_t WS_RT = al(WS_SB + (size_t)M * HF * 2);
constexpr size_t WS_GBS = al(WS_RT + (size_t)M * D * 2);
constexpr size_t WS_UC = al(WS_GBS + (size_t)M * D * 2);
constexpr size_t WS_SS = al(WS_UC + (size_t)(32 * 64 + 8) * 16384 * 2);
constexpr size_t WS_A2 = al(WS_SS + (size_t)32 * 64 * 16384 * 2);
constexpr size_t WS_MG = al(WS_A2 + (size_t)M * D * 2);
constexpr size_t WS_H1 = al(WS_MG + (size_t)M * D * 2);
constexpr size_t WS_H1B = al(WS_H1 + (size_t)M * D * 2);
constexpr size_t WS_ACT = al(WS_H1B + (size_t)M * D);
constexpr size_t WS_YR = al(WS_ACT + (size_t)MAXRT * 256 * DFF);
constexpr size_t WS_WIN8 = al(WS_YR + (size_t)MAXRT * 256 * D);
constexpr size_t WS_XB8 = al(WS_WIN8 + (size_t)INC * D);
constexpr size_t WS_FAST_END = al(WS_XB8 + (size_t)M * D);
#ifndef FK_IN8_MASK
#define FK_IN8_MASK 0xFFFF00000F0ull
#endif
constexpr unsigned long long IN8_MASK = FK_IN8_MASK;
constexpr unsigned long long INB_MASK = ((1ull << 44) - 1) & ~IN8_MASK;
constexpr int cpop(unsigned long long m) { int n = 0; while (m) { m &= m - 1; ++n; } return n; }
constexpr int N_IN8 = cpop(IN8_MASK), N_INB = 44 - N_IN8;
__device__ __forceinline__ int nth_bit(unsigned long long m, int n) { for (int i = 0; i < n; ++i) m &= m - 1; return __builtin_ctzll(m); }
constexpr int CW_TMO = 0;
constexpr int CW_CNT = 1024;
constexpr int CW_Q = 3400;
constexpr int CW_TS = 3200;
constexpr int CW_BAR = 4096;
constexpr int RING_BYTES = 131072;
constexpr int TOK_OFF = RING_BYTES, TOK_BYTES = 18 * 1024;
constexpr int MISC_OFF = TOK_OFF + TOK_BYTES;
constexpr int LDS_BYTES = MISC_OFF + 1024;
static_assert(LDS_BYTES <= 160 * 1024, "LDS");

__device__ __forceinline__ float sigmoidf_(float x) { return 1.f / (1.f + __expf(-x)); }
__device__ __forceinline__ unsigned f2bf(float f) { unsigned u = __builtin_bit_cast(unsigned, f); return (u + 0x7fffu + ((u >> 16) & 1u)) >> 16; }
__device__ __forceinline__ unsigned pk2(float lo, float hi) { return f2bf(lo) | (f2bf(hi) << 16); }
__device__ __forceinline__ float bf2f(unsigned short b) { return __builtin_bit_cast(float, ((unsigned)b) << 16); }
__device__ __forceinline__ float bflo(unsigned w) { return __builtin_bit_cast(float, w << 16); }
__device__ __forceinline__ float bfhi(unsigned w) { return __builtin_bit_cast(float, w & 0xffff0000u); }
__device__ __forceinline__ unsigned cvt_pk_bf16(float lo, float hi) { unsigned r; asm volatile("v_cvt_pk_bf16_f32 %0, %1, %2" : "=v"(r) : "v"(lo), "v"(hi)); return r; }
__device__ __forceinline__ unsigned pk4_fp8(float a, float b, float c, float d) { int w = 0; w = __builtin_amdgcn_cvt_pk_fp8_f32(a, b, w, false); w = __builtin_amdgcn_cvt_pk_fp8_f32(c, d, w, true); return (unsigned)w; }
constexpr float W8_SCALE = 64.f, W8_INV = 1.f / 64.f;
__device__ __forceinline__ int lane_id() { int l; asm volatile("v_mbcnt_lo_u32_b32 %0, -1, 0\n\tv_mbcnt_hi_u32_b32 %0, -1, %0" : "=v"(l)); return l; }
__device__ __forceinline__ float wave_sum(float v) {
#pragma unroll
    for (int o = 1; o < 64; o <<= 1) v += __shfl_xor(v, o);
    return v;
}

#define XB_TMO      128
#define XB_XCNT(j)  (256  + 64 * (j))
#define XB_XSUB(j)  (1280 + 64 * (j))
#define XB_XGEN(j)  (2304 + 64 * (j))
#define XB_TOP      3328
#define XB_TOPGEN   3392
#define XCD_BAR_WORDS 3456
#define XB_SPIN_CAP (1u << 18)
__device__ __forceinline__ unsigned xb_ld(unsigned* p)              { return __hip_atomic_load(p, __ATOMIC_RELAXED, __HIP_MEMORY_SCOPE_AGENT); }
__device__ __forceinline__ unsigned xb_add(unsigned* p, unsigned v) { return __hip_atomic_fetch_add(p, v, __ATOMIC_RELAXED, __HIP_MEMORY_SCOPE_AGENT); }
__device__ __forceinline__ unsigned xb_xcc_id() { return (unsigned)__builtin_amdgcn_s_getreg((3 << 11) | 20) & 0xFu; }
#define XB_SPIN(cond, bar) do { unsigned _sp = 0; while (cond) { __builtin_amdgcn_s_sleep(1); \
    if ((++_sp & 255u) == 0u) { if (xb_ld(&(bar)[XB_TMO])) break; if (_sp > XB_SPIN_CAP) { atomicAdd(&(bar)[XB_TMO], 1u); break; } } } } while (0)
struct XcdBarrier { unsigned* bar; unsigned x; volatile LAS unsigned* st; };
__device__ __forceinline__ XcdBarrier xcd_barrier_post(unsigned* bar, volatile LAS unsigned* st, int tid) {
    XcdBarrier b; b.bar = bar; b.x = xb_xcc_id(); b.st = st;
    if (tid == 0) (void)xb_add(&bar[XB_XCNT(b.x)], 1u);
    return b;
}
__device__ __forceinline__ void xcd_barrier_complete(unsigned* bar, unsigned x, unsigned& nloc, unsigned& nx) {
    const unsigned G = gridDim.x * gridDim.y * gridDim.z;
    unsigned sum, cnt, mine, sp = 0u;
    for (;;) {
        sum = 0u; cnt = 0u; mine = 0u;
#pragma unroll
        for (unsigned j = 0; j < 16; ++j) { const unsigned c = xb_ld(&bar[XB_XCNT(j)]); sum += c; cnt += (c > 0u) ? 1u : 0u; mine = (j == x) ? c : mine; }
        if (sum == G) break;
        __builtin_amdgcn_s_sleep(1);
        if ((++sp & 255u) == 0u) { if (xb_ld(&bar[XB_TMO])) break; if (sp > XB_SPIN_CAP) { atomicAdd(&bar[XB_TMO], 1u); break; } }
    }
    nloc = mine > 0u ? mine : 1u; nx = cnt > 0u ? cnt : 1u;
}
__device__ __forceinline__ void xcd_barrier(const XcdBarrier& b, int tid) {
    asm volatile("s_waitcnt vmcnt(0)" ::: "memory");
    __syncthreads();
    if (tid == 0) {
        unsigned* bar = b.bar;
        __builtin_amdgcn_s_waitcnt(0);
        unsigned nloc = b.st[0], nx = b.st[1];
        if (nloc == 0u) { xcd_barrier_complete(bar, b.x, nloc, nx); b.st[0] = nloc; b.st[1] = nx; }
        const unsigned old = xb_add(&bar[XB_XSUB(b.x)], 1u);
        const unsigned gen = old / nloc;
        if (old + 1u == (gen + 1u) * nloc) {
            __builtin_amdgcn_fence(__ATOMIC_RELEASE, "agent");
            asm volatile("s_waitcnt vmcnt(0)" ::: "memory");
            const unsigned og = xb_add(&bar[XB_TOP], 1u);
            const unsigned tg = og / nx;
            if (og + 1u == (tg + 1u) * nx) xb_add(&bar[XB_TOPGEN], 1u);
            else XB_SPIN(xb_ld(&bar[XB_TOPGEN]) == tg, bar);
            __builtin_amdgcn_fence(__ATOMIC_ACQUIRE, "agent");
            xb_add(&bar[XB_XGEN(b.x)], 1u);
            asm volatile("s_waitcnt vmcnt(0)" ::: "memory");
        } else {
            XB_SPIN(xb_ld(&bar[XB_XGEN(b.x)]) == gen, bar);
            __builtin_amdgcn_fence(__ATOMIC_ACQUIRE, "agent");
            asm volatile("s_waitcnt vmcnt(0)" ::: "memory");
        }
    }
    __syncthreads();
}

constexpr int BM = 256, BK = 64, HALF = 128, HTB = HALF * BK * 2, NXCD = 8, WGM = 8;
__host__ __device__ __forceinline__ int lds_byte(int r, int c) { const int st = (r >> 4) * 2 + (c >> 5), rr = r & 15, cc = c & 31, ob = rr * 64 + cc * 2; return st * 1024 + (ob ^ (((ob >> 9) & 1) << 5)); }
__host__ __device__ __forceinline__ void stage_rc(int b, int& R, int& C) { const int st = b / 1024, sb = b % 1024, swz = sb ^ (((sb >> 9) & 1) << 5); R = (st >> 1) * 16 + swz / 64; C = (st & 1) * 32 + (swz % 64) / 2; }
__host__ __device__ __forceinline__ int perm32(int rho) { const int n = rho >> 4, i = rho & 15; return 8 * (i >> 2) + 4 * n + (i & 3); }

typedef int i32x8 __attribute__((ext_vector_type(8)));
typedef int i32x4v __attribute__((ext_vector_type(4)));
__device__ __forceinline__ i32x8 cat8(const bf16x8 a, const bf16x8 b) { const i32x4v x = __builtin_bit_cast(i32x4v, a), y = __builtin_bit_cast(i32x4v, b); return __builtin_shufflevector(x, y, 0, 1, 2, 3, 4, 5, 6, 7); }
__device__ __forceinline__ void mfma8(f32x4& acc, const i32x8 a, const i32x8 b, const int sc) {
    asm volatile("s_nop 1\n\tv_mfma_scale_f32_16x16x128_f8f6f4 %0, %1, %2, %0, %3, %3 op_sel_hi:[0,0,0]" : "+v"(acc) : "v"(a), "v"(b), "v"(sc));
}
struct Unit { int pm, pn, e, ui; };

struct StaticOrder {
    int nM, nN, nwg, G, c;
    __device__ void init(int M_, int N_, int G_, int c_) { nM = M_ / BM; nN = N_ / BM; nwg = nM * nN; G = G_; c = c_; }
    __device__ __forceinline__ bool next(int i, Unit& u) const {
        const long L = (long)i * G + c; if (L >= nwg) return false;
        int wgid = (int)L; { const int q = nwg / NXCD, r = nwg % NXCD, xcd = wgid % NXCD, off = wgid / NXCD; wgid = (xcd < r ? xcd * (q + 1) : r * (q + 1) + (xcd - r) * q) + off; }
        const int nig = WGM * nN, gid = wgid / nig, fm = gid * WGM, gsz = (nM - fm) < WGM ? (nM - fm) : WGM;
        u.pm = fm + ((wgid % nig) % gsz); u.pn = (wgid % nig) / gsz; u.e = 0; u.ui = i; return true;
    }
};
struct DynOrder {
    int nM, nN, nwg, x; unsigned* head; volatile LAS unsigned* slot; int tid; unsigned long long mask;
    __device__ void init(int M_, unsigned long long mask_, int nN_, int c_, unsigned* head_, volatile LAS unsigned* slot_, int tid_) { nM = M_ / BM; nN = nN_; mask = mask_; nwg = nM * nN; x = c_ & 7; head = head_; slot = slot_; tid = tid_; }
    __device__ __forceinline__ bool next(int i, Unit& u) const {
        if (tid == 0) slot[i & 1] = __hip_atomic_fetch_add(head, 1u, __ATOMIC_RELAXED, __HIP_MEMORY_SCOPE_AGENT);
        asm volatile("s_waitcnt lgkmcnt(0)" ::: "memory"); __builtin_amdgcn_s_barrier(); asm volatile("" ::: "memory");
        const int j = (int)slot[i & 1], q = nwg / NXCD;
        if (j >= q) return false;
        const int wgid = x * q + j;
        const int nig = WGM * nN, gid = wgid / nig, fm = gid * WGM, gsz = (nM - fm) < WGM ? (nM - fm) : WGM;
        u.pm = fm + ((wgid % nig) % gsz); u.pn = nth_bit(mask, (wgid % nig) / gsz); u.e = 0; u.ui = i; return true;
    }
};
struct MoeOrder {
    int nct, NT, G, c; const volatile LAS int* pref;
    __device__ void init(int nct_, int G_, int c_, const volatile LAS int* pref_) { nct = nct_; G = G_; c = c_; pref = pref_; NT = pref_[NE]; }
    template <bool UNIFORM = true> __device__ __forceinline__ bool next(int i, Unit& u) const {
        int rtg, pn;
        if (G == 256) { const int x = c & 7, jj = c >> 3;
            if (nct == 16) { rtg = 16 * i + 8 * (x & 1) + (jj & 7); pn = 4 * (x >> 1) + (jj >> 3); }
            else           { rtg = 32 * i + 8 * (x & 3) + (jj & 7); pn = 4 * (x >> 2) + (jj >> 3); } }
        else { const int U = i * G + c; rtg = U / nct; pn = U - rtg * nct; }
        if (rtg >= NT) return false;
        u.pn = pn; u.pm = rtg; u.ui = i;
        int e = 0;
        if constexpr (UNIFORM) { const int l = lane_id(); const int pv = (l >= 1 && l < NE) ? pref[l] : 0x7fffffff; e = (int)__builtin_popcountll(__ballot(pv <= rtg)); }
        else {
#pragma unroll 1
            for (int j = 1; j < NE; ++j) e = (pref[j] <= rtg) ? j : e; }
        u.e = e; return true;
    }
};

struct GemmDesc { const bf16_t* A; const bf16_t* Bt; int K; int nct; };

template <class Epi, class Sched, bool GATHER, bool ALIGN_EPI, bool FP8>
__device__ __forceinline__ void gemm_phase(LAS unsigned char* lds, const GemmDesc g, const Sched& S, const Epi& E, const LAS int* tok, int wid) {
    const int lane = lane_id(), tid = wid * 64 + lane, wr = wid >> 2, wc = wid & 3, fr = lane & 15, fq = lane >> 4;
    const int K = g.K, KB = FP8 ? K : 2 * K  , nt = FP8 ? K / 128 : K / BK;
    int Rl[2], Cl[2];
    unsigned voffA[2], voffB[2];
#pragma unroll
    for (int i = 0; i < 2; ++i) { int Cc; stage_rc(tid * 16 + i * 8192, Rl[i], Cc); const int p = Cc >> 3; Cl[i] = FP8 ? 16 * (2 * (p & 3) + (p >> 2)) : 2 * Cc; voffA[i] = (unsigned)(Rl[i] * KB + Cl[i]); voffB[i] = voffA[i]; }
    const size_t kstep = (size_t)(BK * 2);
    const size_t hstep = (size_t)HALF * KB;
    const size_t tstep = 2 * hstep;
    const unsigned ldsw = (unsigned)wid * 1024u;
    const int aoff = lds_byte(wr * 64 + fr, fq * 8), boff = lds_byte(wc * 32 + fr, fq * 8);
#define PG8_SA(b, h) (((b) * 2 + (h)) * HTB)
#define PG8_SB(b, h) ((4 + (b) * 2 + (h)) * HTB)
#define PG8_STAGE(bufoff, gbase, voff) do { _Pragma("unroll") for (int _i = 0; _i < 2; ++_i) \
        __builtin_amdgcn_global_load_lds((const unsigned*)((const char*)(gbase) + (voff)[_i]), (LAS unsigned*)(lds + (bufoff) + ldsw + _i * 8192), 16, 0, 0); } while (0)
#define PG8_STAGE_A(bufoff, ptr, half, o0, o1) do { if constexpr (GATHER) { PG8_STAGE(bufoff, ptr, (half) ? o1 : o0); } else { PG8_STAGE(bufoff, (ptr) + (half) * hstep, voffA); } } while (0)
#define PG8_LDA(dst, b, h) do { _Pragma("unroll") for (int m = 0; m < 4; ++m) _Pragma("unroll") for (int k = 0; k < 2; ++k) dst[m][k] = *(const LAS bf16x8*)(lds + PG8_SA(b, h) + aoff + m * 2048 + k * 1024); } while (0)
#define PG8_LDB(dst, b, h) do { _Pragma("unroll") for (int n = 0; n < 2; ++n) _Pragma("unroll") for (int k = 0; k < 2; ++k) dst[n][k] = *(const LAS bf16x8*)(lds + PG8_SB(b, h) + boff + n * 2048 + k * 1024); } while (0)
#define PG8_MMA(ai, bj, At, Bt) do { __builtin_amdgcn_s_setprio(1); _Pragma("unroll") for (int m = 0; m < 4; ++m) _Pragma("unroll") for (int n = 0; n < 2; ++n) _Pragma("unroll") for (int k = 0; k < 2; ++k) \
        acc[ai][bj][m][n] = __builtin_amdgcn_mfma_f32_16x16x32_bf16(Bt[n][k], At[m][k], acc[ai][bj][m][n], 0, 0, 0); __builtin_amdgcn_s_setprio(0); } while (0)
#define PG8_MMA8(ai, bj, At, Bt) do { __builtin_amdgcn_s_setprio(1); _Pragma("unroll") for (int m = 0; m < 4; ++m) _Pragma("unroll") for (int n = 0; n < 2; ++n) \
        mfma8(acc[ai][bj][m][n], cat8(Bt[n][0], Bt[n][1]), cat8(At[m][0], At[m][1]), sc8); __builtin_amdgcn_s_setprio(0); } while (0)
#define PG8_MM(ai, bj, At, Bt) do { if constexpr (FP8) PG8_MMA8(ai, bj, At, Bt); else PG8_MMA(ai, bj, At, Bt); } while (0)
#define PG8_WAIT_V(n) asm volatile("s_waitcnt vmcnt(" #n ")" ::: "memory")
#define PG8_WAIT_L(n) asm volatile("s_waitcnt lgkmcnt(" #n ")" ::: "memory")
#define PG8_BAR __builtin_amdgcn_s_barrier()
#define PG8_SCHED __builtin_amdgcn_sched_barrier(0)
    Unit cur, nxt; int ui = 0;
    if (!S.next(0, cur)) return;
    const int sc8 = 0x7F7F7F7F;
    f32x4 acc[2][2][4][2];
#pragma unroll
    for (int a = 0; a < 2; ++a)
#pragma unroll
        for (int b = 0; b < 2; ++b)
#pragma unroll
            for (int m = 0; m < 4; ++m)
#pragma unroll
                for (int n = 0; n < 2; ++n) acc[a][b][m][n] = (f32x4){0.f, 0.f, 0.f, 0.f};
    bf16x8 At[4][2], B0[2][2], B1[2][2];
    unsigned vA0[2] = {0u, 0u}, vA1[2] = {0u, 0u}, nA0[2] = {0u, 0u}, nA1[2] = {0u, 0u};
    const char* cA; const char* cB = (const char*)g.Bt + (size_t)(cur.e * g.nct + cur.pn) * tstep;
    if constexpr (GATHER) {
        cA = (const char*)g.A;
#pragma unroll
        for (int i = 0; i < 2; ++i) { vA0[i] = (unsigned)(tok[cur.ui * 256 + Rl[i]] * KB + Cl[i]); vA1[i] = (unsigned)(tok[cur.ui * 256 + 128 + Rl[i]] * KB + Cl[i]); nA0[i] = vA0[i]; nA1[i] = vA1[i]; }
    } else cA = (const char*)g.A + (size_t)cur.pm * tstep;
    PG8_STAGE(PG8_SB(0, 0), cB, voffB); PG8_STAGE(PG8_SB(0, 1), cB + hstep, voffB); PG8_STAGE_A(PG8_SA(0, 0), cA, 0, vA0, vA1); PG8_STAGE_A(PG8_SA(0, 1), cA, 1, vA0, vA1);
    if (wr == 1) PG8_BAR;
    PG8_WAIT_V(2); PG8_BAR;
    PG8_STAGE(PG8_SB(1, 0), cB + kstep, voffB); PG8_STAGE_A(PG8_SA(1, 0), cA + kstep, 0, vA0, vA1); PG8_STAGE(PG8_SB(1, 1), cB + hstep + kstep, voffB);
    PG8_WAIT_V(6); PG8_BAR;
    for (;;) {
        const bool has_next = S.next(ui + 1, nxt);
        const char* nAp; const char* nB;
        if (has_next) {
            nB = (const char*)g.Bt + (size_t)(nxt.e * g.nct + nxt.pn) * tstep;
            if constexpr (GATHER) { nAp = cA;
#pragma unroll
                for (int i = 0; i < 2; ++i) { nA0[i] = (unsigned)(tok[nxt.ui * 256 + Rl[i]] * KB + Cl[i]); nA1[i] = (unsigned)(tok[nxt.ui * 256 + 128 + Rl[i]] * KB + Cl[i]); }
            } else nAp = (const char*)g.A + (size_t)nxt.pm * tstep;
        } else { nAp = cA; nB = cB; }
        for (int t = 0; t < nt; t += 2) {
            const bool last = (t == nt - 2);
            const char* a1 = cA + (size_t)(t + 1) * kstep;
            const char* a2 = last ? nAp : cA + (size_t)(t + 2) * kstep; const char* b2 = last ? nB : cB + (size_t)(t + 2) * kstep;
            const char* a3 = a2 + kstep; const char* b3 = b2 + kstep;
            unsigned w0[2] = {0u, 0u}, w1[2] = {0u, 0u};
            if constexpr (GATHER) {
#pragma unroll
                for (int i = 0; i < 2; ++i) { w0[i] = last ? nA0[i] : vA0[i]; w1[i] = last ? nA1[i] : vA1[i]; } }
            if constexpr (Epi::MIDHOOK) { if (t == nt / 2) E.mid(acc, cur, wr, wc, fr, fq); }
            PG8_LDB(B0, 0, 0); PG8_LDB(B1, 0, 1); PG8_SCHED; PG8_LDA(At, 0, 0); PG8_STAGE_A(PG8_SA(1, 1), a1, 1, vA0, vA1);
            PG8_WAIT_V(8); PG8_WAIT_L(0); PG8_BAR; PG8_MM(0, 0, At, B0); PG8_MM(0, 1, At, B1); PG8_BAR; PG8_SCHED;
            PG8_LDA(At, 0, 1); PG8_STAGE(PG8_SB(0, 0), b2, voffB); PG8_STAGE(PG8_SB(0, 1), b2 + hstep, voffB); PG8_STAGE_A(PG8_SA(0, 0), a2, 0, w0, w1);
            PG8_WAIT_V(8); PG8_WAIT_L(0); PG8_BAR; PG8_MM(1, 0, At, B0); PG8_MM(1, 1, At, B1); PG8_BAR; PG8_SCHED;
            PG8_LDB(B0, 1, 0); PG8_LDB(B1, 1, 1); PG8_SCHED; PG8_LDA(At, 1, 0); PG8_STAGE_A(PG8_SA(0, 1), a2, 1, w0, w1);
            PG8_WAIT_V(8); PG8_WAIT_L(0); PG8_BAR; PG8_MM(0, 0, At, B0); PG8_MM(0, 1, At, B1); PG8_BAR; PG8_SCHED;
            PG8_LDA(At, 1, 1); PG8_STAGE(PG8_SB(1, 0), b3, voffB); PG8_STAGE(PG8_SB(1, 1), b3 + hstep, voffB); PG8_STAGE_A(PG8_SA(1, 0), a3, 0, w0, w1);
            PG8_WAIT_V(8); PG8_WAIT_L(0); PG8_BAR; PG8_MM(1, 0, At, B0); PG8_MM(1, 1, At, B1); PG8_BAR; PG8_SCHED;
        }
        if constexpr (ALIGN_EPI) { if (wr == 0) PG8_BAR; }
        E(acc, cur, wr, wc, fr, fq);
        if (!has_next) break;
#pragma unroll
        for (int a = 0; a < 2; ++a)
#pragma unroll
            for (int b = 0; b < 2; ++b)
#pragma unroll
                for (int m = 0; m < 4; ++m)
#pragma unroll
                    for (int n = 0; n < 2; ++n) acc[a][b][m][n] = (f32x4){0.f, 0.f, 0.f, 0.f};
        cur = nxt; cA = nAp; cB = nB; ++ui;
        if constexpr (GATHER) {
#pragma unroll
            for (int i = 0; i < 2; ++i) { vA0[i] = nA0[i]; vA1[i] = nA1[i]; } }
        if constexpr (ALIGN_EPI) { if (wr == 1) PG8_BAR; }
    }
    PG8_WAIT_V(0);
    if constexpr (!ALIGN_EPI) { if (wr == 0) PG8_BAR; }
    PG8_BAR;
#undef PG8_SA
#undef PG8_SB
#undef PG8_STAGE
#undef PG8_STAGE_A
#undef PG8_LDA
#undef PG8_LDB
#undef PG8_MMA
#undef PG8_MMA8
#undef PG8_MM
#undef PG8_WAIT_V
#undef PG8_WAIT_L
#undef PG8_BAR
#undef PG8_SCHED
}
typedef f32x4 Acc[2][2][4][2];
__device__ __forceinline__ float silu_(float x) { return x * __builtin_amdgcn_rcpf(1.f + __expf(-x)); }
__device__ __forceinline__ float sigm_(float x) { return __builtin_amdgcn_rcpf(1.f + __expf(-x)); }
__device__ __forceinline__ u32x4 pack8(const f32x4 a, const f32x4 b) { u32x4 w; w.x = cvt_pk_bf16(a[0], a[1]); w.y = cvt_pk_bf16(a[2], a[3]); w.z = cvt_pk_bf16(b[0], b[1]); w.w = cvt_pk_bf16(b[2], b[3]); return w; }
__device__ __forceinline__ u32x2 pack8_fp8(const f32x4 a, const f32x4 b) { u32x2 w; w.x = pk4_fp8(a[0], a[1], a[2], a[3]); w.y = pk4_fp8(b[0], b[1], b[2], b[3]); return w; }
__device__ __forceinline__ void unpack8(const u32x4 w, f32x4& a, f32x4& b) { a = (f32x4){bflo(w.x), bfhi(w.x), bflo(w.y), bfhi(w.y)}; b = (f32x4){bflo(w.z), bfhi(w.z), bflo(w.w), bfhi(w.w)}; }

struct EpiInproj {
    static constexpr bool MIDHOOK = false;
    const float* rs1; const float* lb; bf16_t *QS, *VV, *GS, *UU, *SBb, *RT, *GBS; h16_t* LF; float osc;
    __device__ __forceinline__ void mid(Acc&, const Unit&, int, int, int, int) const {}
    template <int ACT> __device__ __forceinline__ void plain(const Acc& acc, const float (&rs)[2][4], bf16_t* O, int pt, int row0, int wc, int fq) const {
#pragma unroll
        for (int ai = 0; ai < 2; ++ai)
#pragma unroll
            for (int m = 0; m < 4; ++m) { bf16_t* rowp = O + (size_t)(row0 + ai * HALF + m * 16) * HF + pt * 256 + wc * 32 + 8 * fq; const float r = rs[ai][m];
#pragma unroll
                for (int bj = 0; bj < 2; ++bj) { f32x4 v0 = acc[ai][bj][m][0] * r, v1 = acc[ai][bj][m][1] * r;
                    if (ACT == 1) {
#pragma unroll
                        for (int j = 0; j < 4; ++j) { v0[j] = silu_(v0[j]); v1[j] = silu_(v1[j]); } }
                    *(u32x4*)(rowp + bj * HALF) = pack8(v0, v1); } }
    }
    __device__ __forceinline__ void operator()(const Acc& acc, const Unit& u, int wr, int wc, int fr, int fq) const {
        const int row0 = u.pm * BM + wr * 64 + fr, pn = u.pn;
        float rs[2][4];
#pragma unroll
        for (int ai = 0; ai < 2; ++ai)
#pragma unroll
            for (int m = 0; m < 4; ++m) rs[ai][m] = rs1[row0 + ai * HALF + m * 16] * osc;
        asm volatile("" : "+v"(rs[0][0]), "+v"(rs[0][1]), "+v"(rs[0][2]), "+v"(rs[0][3]), "+v"(rs[1][0]), "+v"(rs[1][1]), "+v"(rs[1][2]), "+v"(rs[1][3]));
        if (pn < 4) plain<1>(acc, rs, QS, pn, row0, wc, fq);
        else if (pn < 8) {
            const int c0 = (pn - 4) * 256 + wc * 32 + 4 * fq;
            f32x4 lbv[2][2];
#pragma unroll
            for (int bj = 0; bj < 2; ++bj)
#pragma unroll
                for (int n = 0; n < 2; ++n) lbv[bj][n] = *(const f32x4*)(lb + c0 + bj * HALF + n * 16);
#pragma unroll
            for (int ai = 0; ai < 2; ++ai)
#pragma unroll
                for (int m = 0; m < 4; ++m) { h16_t* rowp = LF + (size_t)(row0 + ai * HALF + m * 16) * HF + c0; const float r = rs[ai][m];
#pragma unroll
                    for (int bj = 0; bj < 2; ++bj)
#pragma unroll
                        for (int n = 0; n < 2; ++n) { f32x4 v = acc[ai][bj][m][n] * r; const f32x4 l = lbv[bj][n];
#pragma unroll
                            for (int j = 0; j < 4; ++j) v[j] = __logf(l[j] + (1.f - l[j]) * sigm_(v[j]));
                            *(h16x4*)(rowp + bj * HALF + n * 16) = (h16x4){(h16_t)v[0], (h16_t)v[1], (h16_t)v[2], (h16_t)v[3]}; } }
        }
        else if (pn < 12) plain<0>(acc, rs, VV, pn - 8, row0, wc, fq);
        else if (pn < 16) plain<1>(acc, rs, GS, pn - 12, row0, wc, fq);
        else if (pn < 24) {
            const int c0 = (pn - 16) * 128 + wc * 32 + 8 * fq;
#pragma unroll
            for (int ai = 0; ai < 2; ++ai)
#pragma unroll
                for (int m = 0; m < 4; ++m) { const float r2 = rs[ai][m] * rs[ai][m];
                    const f32x4 v0 = acc[ai][0][m][0] * acc[ai][1][m][0] * r2, v1 = acc[ai][0][m][1] * acc[ai][1][m][1] * r2;
                    *(u32x4*)(UU + (size_t)(row0 + ai * HALF + m * 16) * HF + c0) = pack8(v0, v1); }
        }
        else if (pn < 28) plain<0>(acc, rs, SBb, pn - 24, row0, wc, fq);
        else {
            const int c0 = (pn - 28) * 128 + wc * 32 + 8 * fq;
#pragma unroll
            for (int ai = 0; ai < 2; ++ai)
#pragma unroll
                for (int m = 0; m < 4; ++m) { const float r = rs[ai][m]; f32x4 q0, q1, b0, b1;
#pragma unroll
                    for (int j = 0; j < 4; ++j) { const float ea = 1.f + __expf(-acc[ai][0][m][0][j] * r), eb = 1.f + __expf(-acc[ai][1][m][0][j] * r); b0[j] = __builtin_amdgcn_rcpf(eb); q0[j] = eb * __builtin_amdgcn_rcpf(ea);
                                                  const float fa = 1.f + __expf(-acc[ai][0][m][1][j] * r), fb = 1.f + __expf(-acc[ai][1][m][1][j] * r); b1[j] = __builtin_amdgcn_rcpf(fb); q1[j] = fb * __builtin_amdgcn_rcpf(fa); }
                    const size_t o = (size_t)(row0 + ai * HALF + m * 16) * D + c0;
                    *(u32x4*)(RT + o) = pack8(q0, q1); *(u32x4*)(GBS + o) = pack8(b0, b1); }
        }
    }
};

struct EpiMerge {
    static constexpr bool MIDHOOK = true;
    const bf16_t *RT, *GBS; bf16_t* MG;
    __device__ __forceinline__ void mid(Acc& acc, const Unit& u, int wr, int wc, int fr, int fq) const {
        unsigned o0 = ((unsigned)(u.pm * BM + wr * 64 + fr) * D + (unsigned)(u.pn * BM + wc * 32 + 8 * fq)) * 2u;
        asm volatile("" : "+v"(o0));
#pragma unroll
        for (int ai = 0; ai < 2; ++ai)
#pragma unroll
            for (int m = 0; m < 4; ++m)
#pragma unroll
                for (int bj = 0; bj < 2; ++bj) { const u32x4 w = *(const GAS u32x4*)((const GAS char*)RT + (o0 + (unsigned)((ai * HALF + m * 16) * D + bj * HALF) * 2u)); f32x4 a, b; unpack8(w, a, b);
                    acc[ai][bj][m][0] *= a; acc[ai][bj][m][1] *= b; }
    }
    __device__ __forceinline__ void operator()(const Acc& acc, const Unit& u, int wr, int wc, int fr, int fq) const {
        unsigned o0 = ((unsigned)(u.pm * BM + wr * 64 + fr) * D + (unsigned)(u.pn * BM + wc * 32 + 8 * fq)) * 2u;
        asm volatile("" : "+v"(o0));
#pragma unroll
        for (int ai = 0; ai < 2; ++ai)
#pragma unroll
            for (int m = 0; m < 4; ++m)
#pragma unroll
                for (int bj = 0; bj < 2; ++bj) { const unsigned o = o0 + (unsigned)((ai * HALF + m * 16) * D + bj * HALF) * 2u; const u32x4 w = *(const GAS u32x4*)((const GAS char*)GBS + o); f32x4 a, b; unpack8(w, a, b);
                    *(GAS u32x4*)((GAS char*)MG + o) = pack8(acc[ai][bj][m][0] * a, acc[ai][bj][m][1] * b); if (bj == 1 && m == 3) asm volatile("" ::: "memory"); }
    }
};

struct EpiWo {
    static constexpr bool MIDHOOK = false;
    bf16_t* DL;
    __device__ __forceinline__ void mid(Acc&, const Unit&, int, int, int, int) const {}
    __device__ __forceinline__ void operator()(const Acc& acc, const Unit& u, int wr, int wc, int fr, int fq) const {
        const int row0 = u.pm * BM + wr * 64 + fr, c0 = u.pn * BM + wc * 32 + 8 * fq;
#pragma unroll
        for (int ai = 0; ai < 2; ++ai)
#pragma unroll
            for (int m = 0; m < 4; ++m)
#pragma unroll
                for (int bj = 0; bj < 2; ++bj) *(u32x4*)(DL + (size_t)(row0 + ai * HALF + m * 16) * D + c0 + bj * HALF) = pack8(acc[ai][bj][m][0], acc[ai][bj][m][1]);
    }
};

struct EpiUp {
    static constexpr bool MIDHOOK = false;
    const float* rs2; const LAS int* tok; const float* b_up; unsigned char* ACT;
    __device__ __forceinline__ void mid(Acc&, const Unit&, int, int, int, int) const {}
    __device__ __forceinline__ void operator()(const Acc& acc, const Unit& u, int wr, int wc, int fr, int fq) const {
        const int rl0 = wr * 64 + fr, c0 = u.pn * 128 + wc * 32 + 8 * fq;
        float rs[2][4];
#pragma unroll
        for (int ai = 0; ai < 2; ++ai)
#pragma unroll
            for (int m = 0; m < 4; ++m) rs[ai][m] = rs2[tok[u.ui * 256 + rl0 + ai * HALF + m * 16]] * W8_INV;
        const float* bp = b_up + (size_t)u.e * 4096 + c0;
        const f32x4 bg0 = *(const f32x4*)(bp), bg1 = *(const f32x4*)(bp + 4), bu0 = *(const f32x4*)(bp + 2048), bu1 = *(const f32x4*)(bp + 2052);
#pragma unroll
        for (int ai = 0; ai < 2; ++ai)
#pragma unroll
            for (int m = 0; m < 4; ++m) { const float r = rs[ai][m]; f32x4 a0, a1;
#pragma unroll
                for (int n = 0; n < 2; ++n)
#pragma unroll
                    for (int jp = 0; jp < 2; ++jp) {
                        const f32x4 ag = acc[ai][0][m][n], au = acc[ai][1][m][n], bgv = n ? bg1 : bg0, buv = n ? bu1 : bu0;
                        f32x2 g = (f32x2){ag[2 * jp], ag[2 * jp + 1]} * r + (f32x2){bgv[2 * jp], bgv[2 * jp + 1]};
                        f32x2 uu = (f32x2){au[2 * jp], au[2 * jp + 1]} * r + (f32x2){buv[2 * jp], buv[2 * jp + 1]};
                        g.x = fminf(g.x, 7.f); g.y = fminf(g.y, 7.f);
                        uu.x = __builtin_amdgcn_fmed3f(uu.x, -7.f, 7.f); uu.y = __builtin_amdgcn_fmed3f(uu.y, -7.f, 7.f);
                        const f32x2 t = g * (-1.702f * 1.44269504f);
                        f32x2 den; den.x = __builtin_amdgcn_exp2f(t.x); den.y = __builtin_amdgcn_exp2f(t.y); den = den + 1.f;
                        f32x2 s; s.x = __builtin_amdgcn_rcpf(den.x); s.y = __builtin_amdgcn_rcpf(den.y);
                        const f32x2 a = (uu + 1.f) * (g * s);
                        if (n == 0) { a0[2 * jp] = a.x; a0[2 * jp + 1] = a.y; } else { a1[2 * jp] = a.x; a1[2 * jp + 1] = a.y; }
                    }
                *(u32x2*)(ACT + (size_t)(u.pm * BM + rl0 + ai * HALF + m * 16) * DFF + c0) = pack8_fp8(a0, a1); }
    }
};

struct EpiDown {
    static constexpr bool MIDHOOK = false;
    const float* b_dn; unsigned char* YR;
    __device__ __forceinline__ void mid(Acc&, const Unit&, int, int, int, int) const {}
    __device__ __forceinline__ void operator()(const Acc& acc, const Unit& u, int wr, int wc, int fr, int fq) const {
        const int rl0 = wr * 64 + fr, c0 = u.pn * BM + wc * 32 + 8 * fq;
        const float* bp = b_dn + (size_t)u.e * D + c0;
        f32x4 bv[2][2];
#pragma unroll
        for (int bj = 0; bj < 2; ++bj)
#pragma unroll
            for (int n = 0; n < 2; ++n) bv[bj][n] = *(const f32x4*)(bp + bj * HALF + 4 * n);
#pragma unroll
        for (int ai = 0; ai < 2; ++ai)
#pragma unroll
            for (int m = 0; m < 4; ++m)
#pragma unroll
                for (int bj = 0; bj < 2; ++bj)
                    *(u32x2*)(YR + (size_t)(u.pm * BM + rl0 + ai * HALF + m * 16) * D + c0 + bj * HALF) = pack8_fp8(acc[ai][bj][m][0] * W8_INV + bv[bj][0], acc[ai][bj][m][1] * W8_INV + bv[bj][1]);
    }
};

struct EpiDummy {
    static constexpr bool MIDHOOK = false;
    bf16_t* O; int nostore;
    __device__ __forceinline__ void mid(Acc&, const Unit&, int, int, int, int) const {}
    __device__ __forceinline__ void operator()(const Acc& acc, const Unit& u, int wr, int wc, int fr, int fq) const {
        const int row0 = (u.pm & 63) * BM + wr * 64 + fr, c0 = (u.pn & 7) * BM + wc * 32 + 8 * fq;
        if (nostore) {
#pragma unroll
            for (int ai = 0; ai < 2; ++ai)
#pragma unroll
                for (int m = 0; m < 4; ++m)
#pragma unroll
                    for (int bj = 0; bj < 2; ++bj) asm volatile("" :: "v"(acc[ai][bj][m][0]), "v"(acc[ai][bj][m][1]));
            return; }
#pragma unroll
        for (int ai = 0; ai < 2; ++ai)
#pragma unroll
            for (int m = 0; m < 4; ++m)
#pragma unroll
                for (int bj = 0; bj < 2; ++bj) *(u32x4*)(O + (size_t)(row0 + ai * HALF + m * 16) * D + c0 + bj * HALF) = pack8(acc[ai][bj][m][0], acc[ai][bj][m][1]);
    }
};
struct ProbeOrder {
    StaticOrder S; int mode, c;
    __device__ __forceinline__ bool next(int i, Unit& u) const {
        if (mode == 3) { if (c & 1) return false; StaticOrder H = S; H.G = S.G / 2; H.c = c >> 1; H.nwg = S.nwg / 2; return H.next(i, u); }
        if (!S.next(i, u)) return false; if (mode >= 1) u.pn = 0; if (mode >= 2) u.pm = c & 63; return true; }
};

struct ProbeMoe {
    MoeOrder S; int mode;
    __device__ __forceinline__ bool next(int i, Unit& u) const { if (!S.next(i, u)) return false; if (mode & 1) { u.e = 0; u.pn = 0; } if (mode & 2) u.pm = 0; return true; }
};
struct Frame {
    LAS unsigned char* lds; volatile LAS unsigned* MISC; gu32* ctl; unsigned char* ws;
    int tid, lane, wave, vcu, G;
    const float *x, *meta, *nmw, *w_in, *lbl, *gnw, *w_ho, *cw, *w_co, *w_o, *nfw, *w_r, *b_r, *w_up, *b_up, *w_dn, *b_dn, *fnw; float* out;
};
template <class T> __device__ __forceinline__ T* wsp(const Frame& F, size_t off) { return (T*)(F.ws + off); }

__device__ __forceinline__ void tr_tile(const float* W, int ldw, int k0, int src0, int src1, bool perm0, bool perm1, const float* kscale, bf16_t* dst, int dpitch, int drow0, int dk0, LAS unsigned* T, int lane) {
    const int ln = lane & 15, kr = lane >> 4, srcc = (ln < 8 ? src0 : src1) + 4 * (ln & 7);
    const float* wp = W + (size_t)(k0 + 2 * kr) * ldw + srcc;
    f32x4 va[8], vb[8]; f32x2 sc[8];
#pragma unroll
    for (int s = 0; s < 8; ++s) { va[s] = __builtin_nontemporal_load((const GAS f32x4*)(wp + (size_t)(8 * s) * ldw)); vb[s] = __builtin_nontemporal_load((const GAS f32x4*)(wp + (size_t)(8 * s + 1) * ldw));
        sc[s] = kscale ? *(const GAS f32x2*)(kscale + k0 + 8 * s + 2 * kr) : (f32x2){1.f, 1.f}; }
    __builtin_amdgcn_sched_barrier(0);
#pragma unroll
    for (int s = 0; s < 8; ++s) { const int col = (4 * s + kr) ^ (2 * ln);
#pragma unroll
        for (int i = 0; i < 4; ++i) T[(4 * ln + i) * 32 + col] = cvt_pk_bf16(va[s][i] * sc[s].x, vb[s][i] * sc[s].y); }
    LDS_WAIT(); asm volatile("" ::: "memory");
    const int c = lane & 7;
#pragma unroll
    for (int j = 0; j < 8; ++j) { const int rho = (lane >> 3) + 8 * j, h = rho >> 5, r32 = rho & 31; const bool pm = h ? perm1 : perm0; const int n = h * 32 + (pm ? perm32(r32) : r32);
        u32x4 v = *(const LAS u32x4*)(T + n * 32 + 4 * (c ^ (n >> 3)));
        if ((n >> 2) & 1) v = (u32x4){v.z, v.w, v.x, v.y};
        *(GAS u32x4*)(dst + (size_t)(drow0 + rho) * dpitch + dk0 + k0 + 8 * c) = v; }
    LDS_WAIT(); asm volatile("" ::: "memory");
}
template <int PMODE = 0> __device__ __forceinline__ void tr_tile_fp8(const float* W, int ldw, int k0, int src0, int src1, const float* kscale, unsigned char* dst, int dpitch, int drow0, LAS unsigned* T, int lane, bool perm = true) {
    const int ln = lane & 15, kr = lane >> 4, srcc = (ln < 8 ? src0 : src1) + 4 * (ln & 7);
    f32x4 v[2][4][4];
#pragma unroll
    for (int half = 0; half < 2; ++half) {
        const float* wp = W + (size_t)(k0 + 64 * half + 4 * kr) * ldw + srcc;
#pragma unroll
        for (int s = 0; s < 4; ++s) {
#pragma unroll
            for (int q = 0; q < 4; ++q) v[half][s][q] = __builtin_nontemporal_load((const GAS f32x4*)(wp + (size_t)(16 * s + q) * ldw)); }
    }
    __builtin_amdgcn_sched_barrier(0);
    if (PMODE == 1) {
#pragma unroll
        for (int half = 0; half < 2; ++half)
#pragma unroll
            for (int s = 0; s < 4; ++s)
#pragma unroll
                for (int q = 0; q < 4; ++q) asm volatile("" :: "v"(v[half][s][q]));
        return; }
#pragma unroll
    for (int half = 0; half < 2; ++half)
#pragma unroll
        for (int s = 0; s < 4; ++s) { const int col = (16 * half + 4 * s + kr) ^ (2 * ln);
            const f32x4 sc = kscale ? *(const GAS f32x4*)(kscale + k0 + 64 * half + 16 * s + 4 * kr) * W8_SCALE : (f32x4){W8_SCALE, W8_SCALE, W8_SCALE, W8_SCALE};
#pragma unroll
            for (int i = 0; i < 4; ++i) T[(4 * ln + i) * 32 + col] = pk4_fp8(v[half][s][0][i] * sc[0], v[half][s][1][i] * sc[1], v[half][s][2][i] * sc[2], v[half][s][3][i] * sc[3]); }
    LDS_WAIT(); asm volatile("" ::: "memory");
    const int c = lane & 7;
#pragma unroll
    for (int j = 0; j < 8; ++j) { const int rho = (lane >> 3) + 8 * j, h = rho >> 5, r32 = rho & 31; const int n = h * 32 + (perm ? perm32(r32) : r32);
        u32x4 v4 = *(const LAS u32x4*)(T + n * 32 + 4 * (c ^ (n >> 3)));
        if ((n >> 2) & 1) v4 = (u32x4){v4.z, v4.w, v4.x, v4.y};
        if (PMODE == 2) asm volatile("" :: "v"(v4)); else *(GAS u32x4*)(dst + (size_t)(drow0 + rho) * dpitch + k0 + 16 * c) = v4; }
    LDS_WAIT(); asm volatile("" ::: "memory");
}
__device__ __forceinline__ int win_src(int G, bool& perm) {
    const int pn = G >> 3, gi = G & 7; perm = true;
    if (pn < 4) return C_Q + pn * 256 + gi * 32;
    if (pn < 8) { perm = false; return C_F + (pn - 4) * 256 + gi * 32; }
    if (pn < 12) return C_V + (pn - 8) * 256 + gi * 32;
    if (pn < 16) return C_G + (pn - 12) * 256 + gi * 32;
    if (pn < 24) return (gi < 4 ? C_SV : C_SC) + (pn - 16) * 128 + (gi & 3) * 32;
    if (pn < 28) return C_SB + (pn - 24) * 256 + gi * 32;
    return (gi < 4 ? C_GA : C_GB) + (pn - 28) * 128 + (gi & 3) * 32;
}
__device__ __forceinline__ void p0_prologue(Frame& F) {
    const int gw = F.vcu * NWAVES + F.wave, NGW = F.G * NWAVES, gt = F.vcu * NTHR + F.tid, NGT = F.G * NTHR;
    for (int i = gt; i < HF; i += NGT) wsp<float>(F, WS_LB)[i] = 1.f / (1.f + __expf(F.lbl[HF + i] - F.lbl[i]));
    for (int i = gt; i < D * NE; i += NGT) { const int k = i >> 5, e = i & 31; const float v = F.w_r[i] * F.nfw[k]; const unsigned h = f2bf(v); const float lo = v - bf2f((unsigned short)h);
        wsp<bf16_t>(F, WS_WRH)[e * D + k] = (bf16_t)h; wsp<bf16_t>(F, WS_WRL)[e * D + k] = (bf16_t)f2bf(lo); }
    for (int i = gt; i < 48 * HF; i += NGT) { wsp<h16_t>(F, WS_LFM)[i] = (h16_t)0.f; wsp<bf16_t>(F, WS_VVM)[i] = 0; }
    {
        LAS float* hnm = (LAS float*)F.lds;
        for (int r = F.wave * 2; r < F.wave * 2 + 2; ++r) {
            const f32x4* xr = (const f32x4*)(F.meta + (size_t)r * D) + F.lane; f32x4 v[8]; float s = 0.f;
#pragma unroll
            for (int j = 0; j < 8; ++j) { v[j] = xr[64 * j]; s += (v[j].x * v[j].x + v[j].y * v[j].y) + (v[j].z * v[j].z + v[j].w * v[j].w); }
            const float rs = rsqrtf(wave_sum(s) * (1.f / D) + EPS);
#pragma unroll
            for (int j = 0; j < 8; ++j) { const f32x4 w = ((const f32x4*)F.nmw)[F.lane + 64 * j]; *(LAS f32x4*)(hnm + r * D + 4 * F.lane + 256 * j) = v[j] * rs * w; }
        }
        __syncthreads();
        LAS float* red = (LAS float*)(F.lds + TOK_OFF);
        for (int cb = F.vcu; cb < 256; cb += F.G) {
            const int col = F.tid & 15, ks = F.tid >> 4;
            int gcol;
            if (cb < 64) gcol = C_F + 16 * cb + col; else if (cb < 128) gcol = C_V + 16 * (cb - 64) + col; else gcol = (col < 8 ? C_SV : C_SC) + 8 * (cb - 128) + (col & 7);
            float a[16];
#pragma unroll
            for (int r = 0; r < 16; ++r) a[r] = 0.f;
#pragma unroll 8
            for (int k = ks * 64; k < ks * 64 + 64; ++k) { const float w = F.w_in[(size_t)k * INC + gcol];
#pragma unroll
                for (int r = 0; r < 16; ++r) a[r] = fmaf(hnm[r * D + k], w, a[r]); }
#pragma unroll
            for (int r = 0; r < 16; ++r) { a[r] += __shfl_xor(a[r], 16); a[r] += __shfl_xor(a[r], 32); }
            if (F.lane < 16) {
#pragma unroll
                for (int r = 0; r < 16; ++r) red[(F.wave * 16 + r) * 16 + col] = a[r]; }
            __syncthreads();
            if (F.tid < 256) { const int r = F.tid >> 4, c = F.tid & 15; float v = 0.f;
#pragma unroll
                for (int w = 0; w < 8; ++w) v += red[(w * 16 + r) * 16 + c];
                if (cb < 64) { const int ch = 16 * cb + c; const float l = 1.f / (1.f + __expf(F.lbl[HF + ch] - F.lbl[ch])); wsp<h16_t>(F, WS_LFM)[(48 + r) * HF + ch] = (h16_t)__logf(l + (1.f - l) * sigmoidf_(v)); }
                else if (cb < 128) wsp<bf16_t>(F, WS_VVM)[(48 + r) * HF + 16 * (cb - 64) + c] = (bf16_t)f2bf(v);
                else red[2048 + r * 16 + c] = v; }
            __syncthreads();
            if (cb >= 128 && F.tid < 128) { const int r = F.tid >> 3, c = F.tid & 7; wsp<bf16_t>(F, WS_UUM)[r * HF + 8 * (cb - 128) + c] = (bf16_t)f2bf(red[2048 + r * 16 + c] * red[2048 + r * 16 + c + 8]); }
            __syncthreads();
        }
        __syncthreads();
    }
    {
        LAS unsigned* T = (LAS unsigned*)(F.lds + F.wave * 16384);
        constexpr int I_IN = 32 * 4 * N_INB, I_AB = 16 * 32, I_O = 32 * 32, I_UP1 = 16 * 64, I_DN1 = 16 * 32;
        constexpr int I_IN8 = 16 * 4 * N_IN8;
        constexpr int NIT = I_IN + I_IN8 + 2 * I_AB + I_O;
        for (int it = gw; it < NIT; it += NGW) {
            int r = it;
            if (r < I_IN) { const int kb = r / (4 * N_INB), ntl = r % (4 * N_INB), nt = 4 * nth_bit(INB_MASK, ntl >> 2) + (ntl & 3); bool p0, p1; const int s0 = win_src(2 * nt, p0), s1 = win_src(2 * nt + 1, p1); tr_tile(F.w_in, INC, kb * 64, s0, s1, p0, p1, F.nmw, wsp<bf16_t>(F, WS_WIN), D, nt * 64, 0, T, F.lane); continue; } r -= I_IN;
            if (r < I_IN8) { const int kb = r / (4 * N_IN8), ntl = r % (4 * N_IN8), nt = 4 * nth_bit(IN8_MASK, ntl >> 2) + (ntl & 3); bool p0, p1; const int s0 = win_src(2 * nt, p0), s1 = win_src(2 * nt + 1, p1);
                tr_tile_fp8<0>(F.w_in, INC, kb * 128, s0, s1, F.nmw, wsp<unsigned char>(F, WS_WIN8), D, nt * 64, T, F.lane, p0); continue; } r -= I_IN8;
            if (r < I_AB) { const int kb = r / 32, nt = r % 32; tr_tile(F.w_ho, D, kb * 64, nt * 64, nt * 64 + 32, true, true, nullptr, wsp<bf16_t>(F, WS_WAB), D, nt * 64, 0, T, F.lane); continue; } r -= I_AB;
            if (r < I_AB) { const int kb = r / 32, nt = r % 32; tr_tile(F.w_co, D, kb * 64, nt * 64, nt * 64 + 32, true, true, nullptr, wsp<bf16_t>(F, WS_WAB), D, nt * 64, HF, T, F.lane); continue; } r -= I_AB;
            if (r < I_O) { const int kb = r / 32, nt = r % 32; tr_tile(F.w_o, D, kb * 64, nt * 64, nt * 64 + 32, true, true, nullptr, wsp<bf16_t>(F, WS_WO), D, nt * 64, 0, T, F.lane); continue; } r -= I_O;
        }
    }
    for (int m = gw; m < M; m += NGW) {
        const GAS f32x4* xr = (const GAS f32x4*)(F.x + (size_t)m * D) + F.lane; f32x4 v[8]; float s = 0.f;
#pragma unroll
        for (int j = 0; j < 8; ++j) v[j] = xr[64 * j];
        __builtin_amdgcn_sched_barrier(0);
#pragma unroll
        for (int j = 0; j < 8; ++j) s += (v[j].x * v[j].x + v[j].y * v[j].y) + (v[j].z * v[j].z + v[j].w * v[j].w);
        s = wave_sum(s);
        GAS u32x2* o8 = (GAS u32x2*)(wsp<bf16_t>(F, WS_XB) + (size_t)m * D) + F.lane;
#pragma unroll
        for (int j = 0; j < 8; ++j) { u32x2 w; w.x = pk2(v[j].x, v[j].y); w.y = pk2(v[j].z, v[j].w); o8[64 * j] = w; }
        GAS unsigned* o4 = (GAS unsigned*)(wsp<unsigned char>(F, WS_XB8) + (size_t)m * D) + F.lane;
#pragma unroll
        for (int j = 0; j < 8; ++j) o4[64 * j] = pk4_fp8(v[j].x, v[j].y, v[j].z, v[j].w);
        if (F.lane == 0) wsp<float>(F, WS_RS1)[m] = rsqrtf(s * (1.f / D) + EPS);
    }
}

template <int PMODE = 0> __device__ __forceinline__ void p1_convert(Frame& F, int rank, int nconv) {
    LAS unsigned* T = (LAS unsigned*)(F.lds + F.wave * 16384);
    constexpr int I_UP1 = 16 * 64, I_DN1 = 16 * 32, NIT = NE * (I_UP1 + I_DN1);
    for (int it = rank * NWAVES + F.wave; it < NIT; it += nconv * NWAVES) {
        int r = it;
        if (r < NE * I_UP1) { const int e = r / I_UP1, q = r % I_UP1, kb = q / 64, nt = q % 64, G0 = 2 * nt, pn = G0 >> 3, gi = G0 & 7; const int s0 = (gi < 4 ? 0 : 2048) + pn * 128 + (gi & 3) * 32;
            tr_tile_fp8<PMODE>(F.w_up + (size_t)e * D * 4096, 4096, kb * 128, s0, s0 + 32, F.nfw, wsp<unsigned char>(F, WS_WUP) + (size_t)e * 4096 * D, D, nt * 64, T, F.lane); continue; } r -= NE * I_UP1;
        { const int e = r / I_DN1, q = r % I_DN1, kb = q / 32, nt = q % 32;
          tr_tile_fp8<PMODE>(F.w_dn + (size_t)e * DFF * D, D, kb * 128, nt * 64, nt * 64 + 32, nullptr, wsp<unsigned char>(F, WS_WDN) + (size_t)e * D * DFF, DFF, nt * 64, T, F.lane); }
    }
}

constexpr int KTP = 72;
constexpr int QP_ = 136;
__device__ __forceinline__ void vt_load(const Frame& F, const bf16_t* Vb, size_t row0, int h, u32x4 (&w)[2]) {
#pragma unroll
    for (int q = 0; q < 2; ++q) { const int id = F.tid + 512 * q, t = id >> 4, v8 = (id & 15) * 8; w[q] = *(const GAS u32x4*)(Vb + (row0 + t) * HF + h * 128 + v8); }
}
__device__ __forceinline__ void vt_store(const Frame& F, const u32x4 (&w)[2], LAS bf16_t* VT) {
#pragma unroll
    for (int q = 0; q < 2; ++q) { const int id = F.tid + 512 * q, t = id >> 4, v8 = (id & 15) * 8; const unsigned ww[4] = {w[q].x, w[q].y, w[q].z, w[q].w};
        const int ts = t ^ (v8 & 24);
#pragma unroll
        for (int i = 0; i < 4; ++i) { VT[(v8 + 2 * i) * KTP + ts] = (bf16_t)(ww[i] & 0xffffu); VT[(v8 + 2 * i + 1) * KTP + ts] = (bf16_t)(ww[i] >> 16); } }
}
__device__ __forceinline__ int vt_off(int v, int t0) { return v * KTP + (t0 ^ (v & 24)); }
struct P2aRegs { float L[16]; u32x4 vw[2]; };
__device__ __forceinline__ void p2a_where(const Frame& F, int u, const h16_t*& Lb, const bf16_t*& Vb, size_t& row0, int& h, int& slot) {
    if (u < 8) { Lb = wsp<h16_t>(F, WS_LFM); Vb = wsp<bf16_t>(F, WS_VVM); row0 = 0; h = u; slot = 32 * 64 + u; }
    else { const int bh = (u - 8) >> 6, c = (u - 8) & 63, b = bh >> 3; h = bh & 7; Lb = wsp<h16_t>(F, WS_LF); Vb = wsp<bf16_t>(F, WS_VV); row0 = (size_t)b * SEQ + 64 * c; slot = bh * 64 + c; }
}
__device__ __forceinline__ void p2a_load(const Frame& F, int u, P2aRegs& R) {
    const h16_t* Lb; const bf16_t* Vb; size_t row0; int h, slot; p2a_where(F, u, Lb, Vb, row0, h, slot);
    const int d = F.tid & 127, tq = F.tid >> 7;
#pragma unroll
    for (int i = 0; i < 16; ++i) R.L[i] = (float)Lb[(row0 + 16 * tq + i) * HF + h * 128 + d];
    vt_load(F, Vb, row0, h, R.vw);
}
__device__ __forceinline__ void p2a_compute(Frame& F, int u, const P2aRegs& R) {
    LAS bf16_t* KT = (LAS bf16_t*)F.lds; LAS bf16_t* VT = KT + 128 * KTP; LAS float* TOT = (LAS float*)(F.lds + 2 * 128 * KTP * 2);
    const h16_t* Lb; const bf16_t* Vb; size_t row0; int h, slot; p2a_where(F, u, Lb, Vb, row0, h, slot);
    const int d = F.tid & 127, tq = F.tid >> 7;
    float cs[16]; float run = 0.f;
#pragma unroll
    for (int i = 0; i < 16; ++i) { run += R.L[i]; cs[i] = run; }
    TOT[tq * 128 + d] = run;
    vt_store(F, R.vw, VT);
    __syncthreads();
    float off = 0.f, total = 0.f;
#pragma unroll
    for (int q = 0; q < 4; ++q) { const float tv = TOT[q * 128 + d]; total += tv; if (q < tq) off += tv; }
#pragma unroll
    for (int i = 0; i < 16; i += 2) { const float k0 = (1.f - __expf(R.L[i])) * __expf(total - off - cs[i]), k1 = (1.f - __expf(R.L[i + 1])) * __expf(total - off - cs[i + 1]);
        *(LAS unsigned*)(KT + d * KTP + 16 * tq + i) = pk2(k0, k1); }
    if (tq == 0) wsp<float>(F, WS_DEC)[(size_t)slot * 128 + d] = __expf(total);
    __syncthreads();
    {
        const int w = F.wave, fr = F.lane & 15, fq = F.lane >> 4;
        bf16x8 a[2];
#pragma unroll
        for (int ks = 0; ks < 2; ++ks) a[ks] = *(const LAS bf16x8*)(KT + (16 * w + fr) * KTP + 32 * ks + 8 * fq);
        bf16_t* Ub = wsp<bf16_t>(F, WS_UC) + (size_t)slot * 16384;
#pragma unroll
        for (int vb = 0; vb < 8; ++vb) { f32x4 c = (f32x4){0.f, 0.f, 0.f, 0.f};
#pragma unroll
            for (int ks = 0; ks < 2; ++ks) { const bf16x8 bv = *(const LAS bf16x8*)(VT + vt_off(16 * vb + fr, 32 * ks + 8 * fq)); c = __builtin_amdgcn_mfma_f32_16x16x32_bf16(a[ks], bv, c, 0, 0, 0); }
            u32x2 o; o.x = pk2(c[0], c[1]); o.y = pk2(c[2], c[3]);
            *(GAS u32x2*)(Ub + (16 * vb + fr) * 128 + 16 * w + 4 * fq) = o; }
    }
    __syncthreads();
}
__device__ __forceinline__ void p2a_units(Frame& F, int c) {
    constexpr int NU = 2048 + 8;
    if (c >= NU) return;
    P2aRegs R; p2a_load(F, c, R);
    for (int u = c; u < NU; u += F.G) {
        P2aRegs N; const int un = u + F.G; if (un < NU) p2a_load(F, un, N); else N = R;
        p2a_compute(F, u, R);
        R = N;
    }
}
__device__ __forceinline__ void p2a_conv(Frame& F, int item) {
    const int c8 = (F.tid & 127) * 8, tq = F.tid >> 7, r0 = item * 64 + tq * 16, p0 = r0 & (SEQ - 1);
    const bf16_t* UU = wsp<bf16_t>(F, WS_UU); const bf16_t* UUM = wsp<bf16_t>(F, WS_UUM); const bf16_t* SBb = wsp<bf16_t>(F, WS_SB); bf16_t* A2 = wsp<bf16_t>(F, WS_A2);
    f32x4 w0a = *(const f32x4*)(F.cw + c8), w0b = *(const f32x4*)(F.cw + c8 + 4), w1a = *(const f32x4*)(F.cw + HF + c8), w1b = *(const f32x4*)(F.cw + HF + c8 + 4), w2a = *(const f32x4*)(F.cw + 2 * HF + c8), w2b = *(const f32x4*)(F.cw + 2 * HF + c8 + 4);
    f32x4 um2a, um2b, um1a, um1b;
    { const u32x4 a = (p0 >= 2) ? *(const GAS u32x4*)(UU + (size_t)(r0 - 2) * HF + c8) : *(const GAS u32x4*)(UUM + (14 + p0) * HF + c8); unpack8(a, um2a, um2b);
      const u32x4 b = (p0 >= 1) ? *(const GAS u32x4*)(UU + (size_t)(r0 - 1) * HF + c8) : *(const GAS u32x4*)(UUM + 15 * HF + c8); unpack8(b, um1a, um1b); }
#pragma unroll 4
    for (int i = 0; i < 16; ++i) { f32x4 ua, ub, sa, sb; unpack8(*(const GAS u32x4*)(UU + (size_t)(r0 + i) * HF + c8), ua, ub); unpack8(*(const GAS u32x4*)(SBb + (size_t)(r0 + i) * HF + c8), sa, sb);
        const f32x4 oa = sa * (w0a * um2a + w1a * um1a + w2a * ua), ob = sb * (w0b * um2b + w1b * um1b + w2b * ub);
        *(GAS u32x4*)(A2 + (size_t)(r0 + i) * D + HF + c8) = pack8(oa, ob);
        um2a = um1a; um2b = um1b; um1a = ua; um1b = ub; }
}
__device__ __forceinline__ void p2b_scan(Frame& F) {
    const int gw = F.vcu * NWAVES + F.wave;
    for (int it = gw; it < 1024; it += F.G * NWAVES) {
        const int item = it * 64 + F.lane, bh = item >> 11, e8 = item & 2047, h = bh & 7, d0 = (e8 & 15) * 8;
        const bf16_t* Ub = wsp<bf16_t>(F, WS_UC) + (size_t)bh * 64 * 16384 + e8 * 8; bf16_t* Sb = wsp<bf16_t>(F, WS_SS) + (size_t)bh * 64 * 16384 + e8 * 8;
        const float* Db = wsp<float>(F, WS_DEC) + (size_t)bh * 64 * 128 + d0;
        f32x4 s0, s1; unpack8(*(const GAS u32x4*)(wsp<bf16_t>(F, WS_UC) + (size_t)(32 * 64 + h) * 16384 + e8 * 8), s0, s1);
#pragma unroll 8
        for (int c = 0; c < 64; ++c) {
            *(GAS u32x4*)(Sb + (size_t)c * 16384) = pack8(s0, s1);
            f32x4 u0, u1; unpack8(*(const GAS u32x4*)(Ub + (size_t)c * 16384), u0, u1);
            const f32x4 g0 = *(const GAS f32x4*)(Db + c * 128), g1 = *(const GAS f32x4*)(Db + c * 128 + 4);
            s0 = g0 * s0 + u0; s1 = g1 * s1 + u1;
        }
    }
}
struct P2cRegs { f32x2 L[8]; unsigned qw[8]; u32x4 vw[2]; bf16x8 sa[4]; u32x2 gv[4]; };
__device__ __forceinline__ void p2c_load(const Frame& F, int u, P2cRegs& R) {
    const int bh = u >> 6, c = u & 63, b = bh >> 3, h = bh & 7; const size_t row0 = (size_t)b * SEQ + 64 * c;
    const int dp = (F.tid & 63) * 2, t8 = F.tid >> 6, w = F.wave, fr = F.lane & 15, fq = F.lane >> 4;
    const h16_t* Lb = wsp<h16_t>(F, WS_LF) + (row0 + 8 * t8) * HF + h * 128 + dp; const bf16_t* Qb = wsp<bf16_t>(F, WS_QS) + (row0 + 8 * t8) * HF + h * 128 + dp;
#pragma unroll
    for (int i = 0; i < 8; ++i) { const h16x2 lh = *(const GAS h16x2*)(Lb + (size_t)i * HF); R.L[i] = (f32x2){(float)lh.x, (float)lh.y}; R.qw[i] = *(const GAS unsigned*)(Qb + (size_t)i * HF); }
    vt_load(F, wsp<bf16_t>(F, WS_VV), row0, h, R.vw);
    const bf16_t* Sb = wsp<bf16_t>(F, WS_SS) + ((size_t)bh * 64 + c) * 16384 + (16 * w + fr) * 128 + 8 * fq;
#pragma unroll
    for (int ks = 0; ks < 4; ++ks) R.sa[ks] = *(const GAS bf16x8*)(Sb + 32 * ks);
    const bf16_t* GSb = wsp<bf16_t>(F, WS_GS);
#pragma unroll
    for (int tb = 0; tb < 4; ++tb) R.gv[tb] = *(const GAS u32x2*)(GSb + (row0 + 16 * tb + fr) * HF + h * 128 + 16 * w + 4 * fq);
}
__device__ __forceinline__ void p2c_compute(Frame& F, int u, const P2cRegs& R) {
    const int bh = u >> 6, c = u & 63, b = bh >> 3, h = bh & 7; const size_t row0 = (size_t)b * SEQ + 64 * c;
    LAS bf16_t* QPl = (LAS bf16_t*)F.lds; LAS bf16_t* QD = QPl + 64 * QP_; LAS bf16_t* KI = QD + 64 * QP_; LAS bf16_t* VT = KI + 160 * QP_; LAS bf16_t* PL = VT + 128 * KTP;
    LAS float* TOT8 = (LAS float*)(PL + 64 * KTP); LAS float* SSQ = TOT8 + 8 * 128;
    const int dp = (F.tid & 63) * 2, t8 = F.tid >> 6;
    f32x2 L[8], cs[8], q[8]; f32x2 run = (f32x2){0.f, 0.f};
#pragma unroll
    for (int i = 0; i < 8; ++i) { L[i] = R.L[i]; q[i] = (f32x2){bflo(R.qw[i]), bfhi(R.qw[i])}; }
#pragma unroll
    for (int i = 0; i < 8; ++i) { run += L[i]; cs[i] = run; }
    *(LAS f32x2*)(TOT8 + t8 * 128 + dp) = run;
    vt_store(F, R.vw, VT);
    for (int i = F.tid; i < 64 * KTP / 2; i += NTHR) ((LAS unsigned*)PL)[i] = 0u;
    __syncthreads();
    {
        f32x2 pre[9]; pre[0] = (f32x2){0.f, 0.f};
#pragma unroll
        for (int j = 0; j < 8; ++j) pre[j + 1] = pre[j] + *(const LAS f32x2*)(TOT8 + j * 128 + dp);
        f32x2 off = (f32x2){0.f, 0.f};
#pragma unroll
        for (int j = 0; j < 8; ++j) if (j == t8) off = pre[j];
        const int si = t8 >> 1;
        f32x2 st[4];
#pragma unroll
        for (int j = 0; j < 4; ++j) st[j] = pre[2 * j];
        f32x2 sti = st[0];
#pragma unroll
        for (int j = 1; j < 4; ++j) if (j == si) sti = st[j];
#pragma unroll
        for (int i = 0; i < 8; ++i) { const int t = 8 * t8 + i; const f32x2 bc = off + cs[i];
            *(LAS unsigned*)(QPl + t * QP_ + dp) = pk2(q[i].x * __expf(bc.x), q[i].y * __expf(bc.y));
            *(LAS unsigned*)(QD + t * QP_ + dp) = pk2(q[i].x * __expf(bc.x - sti.x), q[i].y * __expf(bc.y - sti.y));
            const f32x2 k = (f32x2){1.f - __expf(L[i].x), 1.f - __expf(L[i].y)};
#pragma unroll
            for (int j = 0; j < 4; ++j) if (j >= si) {
                *(LAS unsigned*)(KI + (8 * j * (j + 1) + t) * QP_ + dp) = pk2(k.x * __expf(fminf(st[j].x - bc.x, 80.f)), k.y * __expf(fminf(st[j].y - bc.y, 80.f))); }
        }
    }
    __syncthreads();
    const int w = F.wave, fr = F.lane & 15, fq = F.lane >> 4;
    for (int bi = w; bi < 10; bi += 8) {
        const int i = bi < 1 ? 0 : bi < 3 ? 1 : bi < 6 ? 2 : 3, j = bi - (i * (i + 1)) / 2;
        f32x4 cacc = (f32x4){0.f, 0.f, 0.f, 0.f};
#pragma unroll
        for (int ks = 0; ks < 4; ++ks) { const bf16x8 a = *(const LAS bf16x8*)(KI + (8 * i * (i + 1) + 16 * j + fr) * QP_ + 32 * ks + 8 * fq), bq = *(const LAS bf16x8*)(QD + (16 * i + fr) * QP_ + 32 * ks + 8 * fq);
            cacc = __builtin_amdgcn_mfma_f32_16x16x32_bf16(a, bq, cacc, 0, 0, 0); }
        if (i == j) {
#pragma unroll
            for (int r = 0; r < 4; ++r) if (4 * fq + r > fr) cacc[r] = 0.f; }
        u32x2 o; o.x = pk2(cacc[0], cacc[1]); o.y = pk2(cacc[2], cacc[3]);
        *(LAS u32x2*)(PL + (16 * i + fr) * KTP + 16 * j + 4 * fq) = o;
    }
    __syncthreads();
    f32x4 acc[4];
#pragma unroll
    for (int tb = 0; tb < 4; ++tb) acc[tb] = (f32x4){0.f, 0.f, 0.f, 0.f};
    {
#pragma unroll
        for (int ks = 0; ks < 4; ++ks)
#pragma unroll
            for (int tb = 0; tb < 4; ++tb) { const bf16x8 bq = *(const LAS bf16x8*)(QPl + (16 * tb + fr) * QP_ + 32 * ks + 8 * fq); acc[tb] = __builtin_amdgcn_mfma_f32_16x16x32_bf16(R.sa[ks], bq, acc[tb], 0, 0, 0); }
#pragma unroll
        for (int ks = 0; ks < 2; ++ks) { const bf16x8 va = *(const LAS bf16x8*)(VT + vt_off(16 * w + fr, 32 * ks + 8 * fq));
#pragma unroll
            for (int tb = 0; tb < 4; ++tb) { const bf16x8 bp = *(const LAS bf16x8*)(PL + (16 * tb + fr) * KTP + 32 * ks + 8 * fq); acc[tb] = __builtin_amdgcn_mfma_f32_16x16x32_bf16(va, bp, acc[tb], 0, 0, 0); } }
    }
#pragma unroll
    for (int tb = 0; tb < 4; ++tb) { float p = (acc[tb][0] * acc[tb][0] + acc[tb][1] * acc[tb][1]) + (acc[tb][2] * acc[tb][2] + acc[tb][3] * acc[tb][3]); p += __shfl_xor(p, 16); p += __shfl_xor(p, 32);
        if (fq == 0) SSQ[w * 64 + 16 * tb + fr] = p; }
    __syncthreads();
    {
        const f32x4 gw4 = *(const f32x4*)(F.gnw + 16 * w + 4 * fq);
        bf16_t* A2 = wsp<bf16_t>(F, WS_A2);
#pragma unroll
        for (int tb = 0; tb < 4; ++tb) { const int t = 16 * tb + fr; float ss = 0.f;
#pragma unroll
            for (int ww = 0; ww < 8; ++ww) ss += SSQ[ww * 64 + t];
            const float rs = rsqrtf(ss * (1.f / 128.f) + EPS);
            const u32x2 gv = R.gv[tb];
            const f32x4 o = acc[tb] * rs * gw4 * (f32x4){bflo(gv.x), bfhi(gv.x), bflo(gv.y), bfhi(gv.y)};
            u32x2 ov; ov.x = pk2(o[0], o[1]); ov.y = pk2(o[2], o[3]);
            *(GAS u32x2*)(A2 + (row0 + t) * D + h * 128 + 16 * w + 4 * fq) = ov; }
    }
    __syncthreads();
}
__device__ __forceinline__ void p2c_units(Frame& F, int c) {
    constexpr int NU = 2048;
    if (c >= NU) return;
    P2cRegs R; p2c_load(F, c, R);
    for (int u = c; u < NU; u += F.G) {
        P2cRegs N; const int un = u + F.G; if (un < NU) p2c_load(F, un, N); else N = R;
        p2c_compute(F, u, R);
        R = N;
    }
}

__device__ __forceinline__ void split8(const f32x4 a, const f32x4 b, bf16x8& hi, bf16x8& lo) {
    u32x4 h, l;
    h.x = cvt_pk_bf16(a[0], a[1]); h.y = cvt_pk_bf16(a[2], a[3]); h.z = cvt_pk_bf16(b[0], b[1]); h.w = cvt_pk_bf16(b[2], b[3]);
    l.x = cvt_pk_bf16(a[0] - bflo(h.x), a[1] - bfhi(h.x)); l.y = cvt_pk_bf16(a[2] - bflo(h.y), a[3] - bfhi(h.y)); l.z = cvt_pk_bf16(b[0] - bflo(h.z), b[1] - bfhi(h.z)); l.w = cvt_pk_bf16(b[2] - bflo(h.w), b[3] - bfhi(h.w));
    hi = __builtin_bit_cast(bf16x8, h); lo = __builtin_bit_cast(bf16x8, l);
}
__device__ __forceinline__ void p5_router(Frame& F) {
    const int fr = F.lane & 15, fq = F.lane >> 4, wq = F.wave & 3, kh = F.wave >> 2;
    LAS float* lg = (LAS float*)(F.lds + F.wave * 4096);
    LAS float* pa = (LAS float*)(F.lds + 32768) + (wq * 64 + F.lane) * 9;
    const bf16_t* DL = wsp<bf16_t>(F, WS_H1); unsigned char* H1B = wsp<unsigned char>(F, WS_H1B); const bf16_t* WH = wsp<bf16_t>(F, WS_WRH); const bf16_t* WL = wsp<bf16_t>(F, WS_WRL);
    for (int it = F.vcu * 4 + wq; it < M / 16; it += F.G * 4) {
        const int row0 = it * 16, kofs = 1024 * kh;
        const float* hp = F.x + (size_t)(row0 + fr) * D + kofs + 8 * fq; const bf16_t* dp_ = DL + (size_t)(row0 + fr) * D + kofs + 8 * fq; unsigned char* qp = H1B + (size_t)(row0 + fr) * D + kofs + 8 * fq;
        const bf16_t* wh0 = WH + (size_t)fr * D + kofs + 8 * fq; const bf16_t* wl0 = WL + (size_t)fr * D + kofs + 8 * fq;
        f32x4 a0 = (f32x4){0.f, 0.f, 0.f, 0.f}, a1 = a0; float ss = 0.f;
#pragma unroll 4
        for (int ks = 0; ks < 32; ++ks) {
            f32x4 xa = *(const GAS f32x4*)(hp + 32 * ks), xb = *(const GAS f32x4*)(hp + 32 * ks + 4); { f32x4 da, db; unpack8(*(const GAS u32x4*)(dp_ + 32 * ks), da, db); xa += da; xb += db; }
            *(GAS u32x2*)(qp + 32 * ks) = pack8_fp8(xa, xb);
            *(GAS u32x4*)((bf16_t*)dp_ + 32 * ks) = pack8(xa, xb);
            ss += (xa[0] * xa[0] + xa[1] * xa[1]) + (xa[2] * xa[2] + xa[3] * xa[3]) + (xb[0] * xb[0] + xb[1] * xb[1]) + (xb[2] * xb[2] + xb[3] * xb[3]);
            bf16x8 xh, xl; split8(xa, xb, xh, xl);
            const bf16x8 bh0 = *(const GAS bf16x8*)(wh0 + 32 * ks), bl0 = *(const GAS bf16x8*)(wl0 + 32 * ks), bh1 = *(const GAS bf16x8*)(wh0 + 16 * D + 32 * ks), bl1 = *(const GAS bf16x8*)(wl0 + 16 * D + 32 * ks);
            a0 = __builtin_amdgcn_mfma_f32_16x16x32_bf16(xh, bh0, a0, 0, 0, 0); a0 = __builtin_amdgcn_mfma_f32_16x16x32_bf16(xh, bl0, a0, 0, 0, 0);
            a0 = __builtin_amdgcn_mfma_f32_16x16x32_bf16(xl, bh0, a0, 0, 0, 0); a0 = __builtin_amdgcn_mfma_f32_16x16x32_bf16(xl, bl0, a0, 0, 0, 0);
            a1 = __builtin_amdgcn_mfma_f32_16x16x32_bf16(xh, bh1, a1, 0, 0, 0); a1 = __builtin_amdgcn_mfma_f32_16x16x32_bf16(xh, bl1, a1, 0, 0, 0);
            a1 = __builtin_amdgcn_mfma_f32_16x16x32_bf16(xl, bh1, a1, 0, 0, 0); a1 = __builtin_amdgcn_mfma_f32_16x16x32_bf16(xl, bl1, a1, 0, 0, 0);
        }
        if (kh == 1) {
#pragma unroll
            for (int r = 0; r < 4; ++r) { pa[r] = a0[r]; pa[4 + r] = a1[r]; }
            pa[8] = ss; }
        __syncthreads();
        if (kh == 0) {
#pragma unroll
            for (int r = 0; r < 4; ++r) { a0[r] += pa[r]; a1[r] += pa[4 + r]; }
            ss += pa[8];
            ss += __shfl_xor(ss, 16); ss += __shfl_xor(ss, 32);
#pragma unroll
            for (int r = 0; r < 4; ++r) { lg[(4 * fq + r) * 33 + fr] = a0[r]; lg[(4 * fq + r) * 33 + 16 + fr] = a1[r]; }
            LDS_WAIT(); asm volatile("" ::: "memory");
            if (F.lane < 16) {
                const int tokn = row0 + F.lane; const float rs = rsqrtf(ss * (1.f / D) + EPS);
                float v[32];
#pragma unroll
                for (int e = 0; e < 32; ++e) v[e] = lg[F.lane * 33 + e] * rs + F.b_r[e];
                int idx[4]; float val[4];
#pragma unroll
                for (int k = 0; k < 4; ++k) { float bv = -3.0e38f; int bi = 0;
#pragma unroll
                    for (int e = 0; e < 32; ++e) { const bool tk = v[e] > bv; bv = tk ? v[e] : bv; bi = tk ? e : bi; }
                    idx[k] = bi; val[k] = bv;
#pragma unroll
                    for (int e = 0; e < 32; ++e) v[e] = (e == bi) ? -3.0e38f : v[e]; }
                float ex[4], den = 0.f;
#pragma unroll
                for (int k = 0; k < 4; ++k) { ex[k] = __expf(val[k] - val[0]); den += ex[k]; }
                const float inv = 1.f / den;
                wsp<float>(F, WS_RS2)[tokn] = rs;
                int pos[4];
#pragma unroll
                for (int k = 0; k < 4; ++k) pos[k] = (int)__hip_atomic_fetch_add(F.ctl + CW_CNT + 64 * idx[k], 1u, __ATOMIC_RELAXED, __HIP_MEMORY_SCOPE_AGENT);
#pragma unroll
                for (int k = 0; k < 4; ++k) {
                    wsp<int>(F, WS_TOPE)[tokn * 4 + k] = idx[k]; wsp<int>(F, WS_TOPP)[tokn * 4 + k] = pos[k]; wsp<float>(F, WS_TOPW)[tokn * 4 + k] = ex[k] * inv;
                    wsp<int>(F, WS_LIST)[(size_t)idx[k] * CAPF + pos[k]] = tokn; }
            }
        }
        __syncthreads();
    }
}
__device__ __forceinline__ void build_pref(Frame& F) {
    if (F.wave == 0) {
        int tl = 0;
        if (F.lane < NE) { const unsigned c = __hip_atomic_load(F.ctl + CW_CNT + 64 * F.lane, RLX_AGENT); tl = (int)((c + 255u) >> 8); }
        int s = tl;
#pragma unroll
        for (int d = 1; d < 32; d <<= 1) { const int v = __shfl_up(s, d); if (F.lane >= d) s += v; }
        if (F.lane < NE) F.MISC[16 + F.lane] = (unsigned)(s - tl);
        if (F.lane == NE - 1) F.MISC[16 + NE] = (unsigned)(s < MAXRT ? s : MAXRT); }
    __syncthreads();
}
__device__ __forceinline__ void build_tok(Frame& F, const MoeOrder& S) {
    LAS int* tokt = (LAS int*)(F.lds + TOK_OFF);
    volatile LAS int* um = (volatile LAS int*)(F.MISC + 64);
    if (F.tid < 18) { Unit u; int base = -1, nv = 0;
        if (S.template next<false>(F.tid, u)) { const int rt = u.pm - (int)F.MISC[16 + u.e]; const int cnt = (int)__hip_atomic_load(F.ctl + CW_CNT + 64 * u.e, RLX_AGENT);
            base = u.e * CAPF + rt * 256; nv = cnt - rt * 256; nv = nv < 0 ? 0 : (nv > 256 ? 256 : nv); }
        um[2 * F.tid] = base; um[2 * F.tid + 1] = nv; }
    __syncthreads();
    if (F.tid < 256) { int t[18]; const int* LIST = wsp<int>(F, WS_LIST);
#pragma unroll
        for (int i = 0; i < 18; ++i) { const int base = um[2 * i], nv = um[2 * i + 1]; t[i] = (base >= 0 && F.tid < nv) ? LIST[base + F.tid] : 0; }
#pragma unroll
        for (int i = 0; i < 18; ++i) if (um[2 * i] >= 0) tokt[i * 256 + F.tid] = t[i]; }
    __syncthreads();
}
struct P9Tok { f32x4 v[8]; unsigned y[4][8]; f32x4 tw; };
template <int PM> __device__ __forceinline__ void p9_issue(const Frame& F, int m, P9Tok& T) {
    typedef int i32x4 __attribute__((ext_vector_type(4)));
    const bf16_t* DL = wsp<bf16_t>(F, WS_H1); const unsigned char* YR = wsp<unsigned char>(F, WS_YR);
    const i32x4 te = *(const GAS i32x4*)(wsp<int>(F, WS_TOPE) + m * 4), tp = *(const GAS i32x4*)(wsp<int>(F, WS_TOPP) + m * 4); T.tw = *(const GAS f32x4*)(wsp<float>(F, WS_TOPW) + m * 4);
#pragma unroll
    for (int j = 0; j < 8; ++j) { const u32x2 dw = (PM == 4) ? (u32x2){(unsigned)m, 0u} : *(const GAS u32x2*)(DL + (size_t)m * D + 4 * F.lane + 256 * j);
        T.v[j] = (f32x4){bflo(dw.x), bfhi(dw.x), bflo(dw.y), bfhi(dw.y)}; }
#pragma unroll
    for (int k = 0; k < 4; ++k) { const size_t row = (size_t)((const LAS unsigned*)F.MISC)[16 + te[k]] * 256 + tp[k];
#pragma unroll
        for (int j = 0; j < 8; ++j) T.y[k][j] = (PM == 1) ? (unsigned)row : *(const GAS unsigned*)(YR + row * D + 4 * F.lane + 256 * j); }
}
template <int PM> __device__ __forceinline__ void p9_finish(const Frame& F, int m, P9Tok& T, float* outp) {
#pragma unroll
    for (int k = 0; k < 4; ++k)
#pragma unroll
        for (int j = 0; j < 8; ++j) { const f32x2 p0 = __builtin_amdgcn_cvt_pk_f32_fp8((int)T.y[k][j], false), p1 = __builtin_amdgcn_cvt_pk_f32_fp8((int)T.y[k][j], true); T.v[j] += (f32x4){p0.x, p0.y, p1.x, p1.y} * T.tw[k]; }
    float s = 0.f;
#pragma unroll
    for (int j = 0; j < 8; ++j) s += (T.v[j][0] * T.v[j][0] + T.v[j][1] * T.v[j][1]) + (T.v[j][2] * T.v[j][2] + T.v[j][3] * T.v[j][3]);
    const float rs = rsqrtf(wave_sum(s) * (1.f / D) + EPS);
#pragma unroll
    for (int j = 0; j < 8; ++j) { const f32x4 w = *(const f32x4*)(F.fnw + 4 * F.lane + 256 * j); const f32x4 o = T.v[j] * rs * w;
        if (PM == 2) asm volatile("" :: "v"(o)); else *(GAS f32x4*)(outp + (size_t)m * D + 4 * F.lane + 256 * j) = o; }
}
template <int PM> __device__ __forceinline__ void p9_combine_t(Frame& F, float* outp) {
    const int gw = F.vcu * NWAVES + F.wave, NGW9 = F.G * NWAVES;
    for (int m = gw; m < M; m += 2 * NGW9) {
        const int m2 = m + NGW9; const bool two = m2 < M;
        P9Tok A, B; p9_issue<PM>(F, m, A); p9_issue<PM>(F, two ? m2 : m, B);
        __builtin_amdgcn_sched_barrier(0);
        p9_finish<PM>(F, m, A, outp); if (two) p9_finish<PM>(F, m2, B, outp);
    }
}
__device__ __forceinline__ void p9_combine(Frame& F) { p9_combine_t<0>(F, F.out); }
constexpr int NPH = 11;
struct Args { const float* in[18]; float* out; unsigned char* ws; int ph_lo, ph_hi; };

__global__ void __launch_bounds__(NTHR, 2) fwd_kernel(Args args) {
    extern __shared__ __attribute__((aligned(16))) unsigned char lds_raw[];
    Frame F;
    F.lds = (LAS unsigned char*)lds_raw; F.MISC = (volatile LAS unsigned*)(F.lds + MISC_OFF);
    F.wave = __builtin_amdgcn_readfirstlane((int)threadIdx.x >> 6);
#define REFRESH() do { F.lane = lane_id(); F.tid = F.wave * 64 + F.lane; } while (0)
    REFRESH();
    F.G = gridDim.x; { const int bx = blockIdx.x; F.vcu = (F.G % 8 == 0) ? (bx % 8) * (F.G / 8) + bx / 8 : bx; }
    F.ws = args.ws; F.ctl = (gu32*)(args.ws + WS_CTL); F.out = args.out;
    F.x = args.in[0]; F.meta = args.in[1]; F.nmw = args.in[2]; F.w_in = args.in[3]; F.lbl = args.in[4]; F.gnw = args.in[5]; F.w_ho = args.in[6]; F.cw = args.in[7]; F.w_co = args.in[8]; F.w_o = args.in[9];
    F.nfw = args.in[10]; F.w_r = args.in[11]; F.b_r = args.in[12]; F.w_up = args.in[13]; F.b_up = args.in[14]; F.w_dn = args.in[15]; F.b_dn = args.in[16]; F.fnw = args.in[17];
    for (int u = F.tid; u < 256; u += NTHR) F.MISC[u] = 0u;
    __syncthreads();
    const int lo = args.ph_lo, hi = args.ph_hi;
    const bool multi = (hi - lo) > 1;
    XcdBarrier bar; bar.bar = (unsigned*)(F.ctl + CW_BAR); bar.x = 0; bar.st = nullptr;
    if (multi) bar = xcd_barrier_post((unsigned*)(F.ctl + CW_BAR), F.MISC, F.tid);
#define IN(k) (lo <= (k) && (k) < hi)
#if defined(FK_STAMP_A)
#define STAMP(k) do { if (blockIdx.x == 0 && F.tid == 0) __hip_atomic_store(F.ctl + CW_TS + (k), (unsigned)__builtin_amdgcn_s_memrealtime(), RLX_AGENT); } while (0)
#else
#define STAMP(k) do { } while (0)
#endif
#if defined(FK_PROBE_BAR)
#define SEAM(k) do { REFRESH(); if (IN(k) && IN((k) + 1)) { xcd_barrier(bar, F.tid); xcd_barrier(bar, F.tid); xcd_barrier(bar, F.tid); } STAMP((k) + 1); } while (0)
#else
#define SEAM(k) do { REFRESH(); if (IN(k) && IN((k) + 1)) xcd_barrier(bar, F.tid); STAMP((k) + 1); } while (0)
#endif
    STAMP(0);
    const int c = blockIdx.x;
#ifndef FK_DUP_MASK
#define FK_DUP_MASK 0
#endif
#ifndef FK_DUP_REPS
#define FK_DUP_REPS 1
#endif
#define DUP(k) for (int _rep = 0; _rep < 1 + FK_DUP_REPS * ((FK_DUP_MASK >> (k)) & 1); ++_rep)
#define REDO(k) do { if (((FK_DUP_MASK >> (k)) & 1) && _rep < FK_DUP_REPS) { REFRESH(); xcd_barrier(bar, F.tid); } } while (0)

    if (IN(0)) DUP(0) { p0_prologue(F); REDO(0); } SEAM(0);

    if (IN(1)) DUP(1) {
        constexpr int NCONV_PER8 = 3;
        const int cq = c >> 3; const bool conv = (F.G % 64 == 0) && ((cq & 7) < NCONV_PER8) && (_rep == 0);
        if (F.G % 64 != 0 && _rep == 0) { if (c == 0) p1_convert(F, 0, 1); }
        if (conv) { const int nconv = (F.G / 64) * 8 * NCONV_PER8, rank = ((cq >> 3) * NCONV_PER8 + (cq & 7)) * 8 + (c & 7); p1_convert(F, rank, nconv);
#if defined(FK_PROBE_CONV2)
            __syncthreads(); p1_convert<FK_PROBE_CONV2 - 1>(F, rank, nconv);
#endif
        }
        __syncthreads();
        EpiInproj E{wsp<float>(F, WS_RS1), wsp<float>(F, WS_LB), wsp<bf16_t>(F, WS_QS), wsp<bf16_t>(F, WS_VV), wsp<bf16_t>(F, WS_GS), wsp<bf16_t>(F, WS_UU), wsp<bf16_t>(F, WS_SB), wsp<bf16_t>(F, WS_RT), wsp<bf16_t>(F, WS_GBS), wsp<h16_t>(F, WS_LF), 1.f};
        if (N_INB > 0) {
            GemmDesc g{wsp<bf16_t>(F, WS_XB), wsp<bf16_t>(F, WS_WIN), D, INC / 256};
            DynOrder S; S.init(M, INB_MASK, N_INB, c, (unsigned*)(F.ctl + CW_Q + 64 * (c & 7) + 8 * _rep), F.MISC + 4, F.tid);
            gemm_phase<EpiInproj, DynOrder, false, true, false>(F.lds, g, S, E, nullptr, F.wave); }
        if (N_IN8 > 0) {
            REFRESH(); E.osc = 1.f / W8_SCALE;
            GemmDesc g{(const bf16_t*)wsp<unsigned char>(F, WS_XB8), (const bf16_t*)wsp<unsigned char>(F, WS_WIN8), D, INC / 256};
            DynOrder S; S.init(M, IN8_MASK, N_IN8, c, (unsigned*)(F.ctl + CW_Q + 64 * (c & 7) + 8 * _rep + 4), F.MISC + 6, F.tid);
            gemm_phase<EpiInproj, DynOrder, false, true, true>(F.lds, g, S, E, nullptr, F.wave); }
        REDO(1);
    } SEAM(1);

#if defined(FK_PROBE_GEMM)
    if (IN(1)) {
        GemmDesc g{wsp<bf16_t>(F, WS_XB), wsp<bf16_t>(F, WS_WIN), D, INC / 256}; ProbeOrder S; S.S.init(M, INC, F.G, c); S.mode = FK_PROBE_GEMM & 3; S.c = c;
        EpiDummy E{wsp<bf16_t>(F, WS_ACT), (FK_PROBE_GEMM >> 2) & 1};
        gemm_phase<EpiDummy, ProbeOrder, false, true, false>(F.lds, g, S, E, nullptr, F.wave);
        REFRESH(); xcd_barrier(bar, F.tid);
    }
#endif
    if (IN(2)) DUP(2) { p2a_units(F, c); for (int it = c; it < M / 64; it += F.G) p2a_conv(F, it); REDO(2); } SEAM(2);
    if (IN(3)) DUP(3) { p2b_scan(F); REDO(3); } SEAM(3);
    if (IN(4)) DUP(4) { p2c_units(F, c); REDO(4); } SEAM(4);

    if (IN(5)) DUP(5) {
        GemmDesc g{wsp<bf16_t>(F, WS_A2), wsp<bf16_t>(F, WS_WAB), D, D / 256}; StaticOrder S; S.init(M, D, F.G, c);
        EpiMerge E{wsp<bf16_t>(F, WS_RT), wsp<bf16_t>(F, WS_GBS), wsp<bf16_t>(F, WS_MG)};
        gemm_phase<EpiMerge, StaticOrder, false, true, false>(F.lds, g, S, E, nullptr, F.wave); REDO(5);
    } SEAM(5);

    if (IN(6)) DUP(6) {
        GemmDesc g{wsp<bf16_t>(F, WS_MG), wsp<bf16_t>(F, WS_WO), D, D / 256}; StaticOrder S; S.init(M, D, F.G, c);
        EpiWo E{wsp<bf16_t>(F, WS_H1)};
        gemm_phase<EpiWo, StaticOrder, false, true, false>(F.lds, g, S, E, nullptr, F.wave); REDO(6);
    } SEAM(6);

    if (IN(7)) { p5_router(F); } SEAM(7);

    if (IN(8)) DUP(8) {
        build_pref(F);
        MoeOrder S; S.init(16, F.G, c, (const volatile LAS int*)(F.MISC + 16));
        build_tok(F, S);
        GemmDesc g{wsp<bf16_t>(F, WS_H1B), wsp<bf16_t>(F, WS_WUP), D, 16};
        EpiUp E{wsp<float>(F, WS_RS2), (const LAS int*)(F.lds + TOK_OFF), F.b_up, wsp<unsigned char>(F, WS_ACT)};
        gemm_phase<EpiUp, MoeOrder, true, true, true>(F.lds, g, S, E, (const LAS int*)(F.lds + TOK_OFF), F.wave); REDO(8);
    } SEAM(8);

    if (IN(9)) DUP(9) {
        build_pref(F);
        MoeOrder S; S.init(8, F.G, c, (const volatile LAS int*)(F.MISC + 16));
        GemmDesc g{wsp<bf16_t>(F, WS_ACT), wsp<bf16_t>(F, WS_WDN), DFF, 8};
        EpiDown E{F.b_dn, wsp<unsigned char>(F, WS_YR)};
        gemm_phase<EpiDown, MoeOrder, false, true, true>(F.lds, g, S, E, nullptr, F.wave); REDO(9);
    } SEAM(9);

#if defined(FK_PROBE_P8)
    if (IN(10)) {
        build_pref(F);
        ProbeMoe S; S.S.init(8, F.G, c, (const volatile LAS int*)(F.MISC + 16)); S.mode = FK_PROBE_P8 & 3;
        GemmDesc g{wsp<bf16_t>(F, WS_ACT), wsp<bf16_t>(F, WS_WDN), DFF, 8};
        EpiDummy E{wsp<bf16_t>(F, WS_XB), 1};
        for (int r = 0; r < 2; ++r) { gemm_phase<EpiDummy, ProbeMoe, false, true, true>(F.lds, g, S, E, nullptr, F.wave); REFRESH(); xcd_barrier(bar, F.tid); }
    }
#endif
    if (IN(10)) DUP(10) { build_pref(F); p9_combine(F); REDO(10); }
#if defined(FK_PROBE_P9)
    if (IN(10)) { for (int r = 0; r < 4; ++r) { REFRESH(); xcd_barrier(bar, F.tid); p9_combine_t<FK_PROBE_P9 - 1>(F, wsp<float>(F, WS_XB)); } }
#endif
#undef IN
#undef DUP
#undef REDO
#undef SEAM
#undef STAMP
#undef REFRESH
}

inline void launch_fast(hipStream_t stream, void* const* d_in, float* out, unsigned char* ws, int n_launches) {
    static int grid = 0;
    if (grid == 0) {
        int dev = 0, cus = 0, per_cu = 0;
        if (hipGetDevice(&dev) != hipSuccess || hipDeviceGetAttribute(&cus, hipDeviceAttributeMultiprocessorCount, dev) != hipSuccess) { fprintf(stderr, "kernel_launch: device query failed\n"); grid = -1; return; }
        if (hipFuncSetAttribute((const void*)fwd_kernel, hipFuncAttributeMaxDynamicSharedMemorySize, LDS_BYTES) != hipSuccess) { fprintf(stderr, "kernel_launch: hipFuncSetAttribute failed\n"); grid = -1; return; }
        if (hipOccupancyMaxActiveBlocksPerMultiprocessor(&per_cu, (const void*)fwd_kernel, NTHR, LDS_BYTES) != hipSuccess || per_cu < 1) fprintf(stderr, "kernel_launch: note: occupancy query says %d blocks per CU\n", per_cu);
        (void)hipGetLastError();
        grid = cus;
    }
    if (grid < 0) return;
    (void)hipMemsetAsync(ws + WS_CTL, 0, CTL_BYTES, stream);
    Args a{};
    for (int i = 0; i < 18; ++i) a.in[i] = (const float*)d_in[i];
    a.out = out; a.ws = ws;
    for (int li = 0; li < n_launches; ++li) {
        a.ph_lo = (n_launches == 1) ? 0 : li; a.ph_hi = (n_launches == 1) ? NPH : li + 1;
        hipLaunchKernelGGL(fwd_kernel, dim3(grid), dim3(NTHR), LDS_BYTES, stream, a);
        const hipError_t le = hipPeekAtLastError();
        if (le != hipSuccess) { fprintf(stderr, "kernel_launch: launch %d failed: %s\n", li, hipGetErrorName(le)); break; }
    }
}
}
#ifndef FK_LAUNCHES
#define FK_LAUNCHES 1
#endif
extern "C" void kernel_launch(void* const* d_in, const int* in_sizes, int n_in, void* d_out, int out_size, void* d_ws, size_t ws_size, hipStream_t stream) {
    if (n_in != 18 || ws_size < fk::WS_FAST_END) { fprintf(stderr, "kernel_launch: n_in %d, ws %zu < %zu\n", n_in, ws_size, (size_t)fk::WS_FAST_END); return; }
    fk::launch_fast(stream, d_in, (float*)d_out, (unsigned char*)d_ws, FK_LAUNCHES);
}
```

```cpp
#include <hip/hip_runtime.h>
#include <cstdio>
#define FK_LAUNCHES 1
#define FK_IN8_MASK 0xFFFF000F0FFull
#define FK_WO8 0
namespace fk {
#define LAS __attribute__((address_space(3)))
#define GAS __attribute__((address_space(1)))
typedef unsigned short bf16_t;
typedef short bf16x8 __attribute__((ext_vector_type(8)));
typedef float f32x4 __attribute__((ext_vector_type(4)));
typedef float f32x2 __attribute__((ext_vector_type(2)));
typedef unsigned u32x4 __attribute__((ext_vector_type(4)));
typedef unsigned u32x2 __attribute__((ext_vector_type(2)));
typedef GAS unsigned gu32;
typedef _Float16 h16_t;
typedef _Float16 h16x4 __attribute__((ext_vector_type(4)));
typedef _Float16 h16x2 __attribute__((ext_vector_type(2)));
#define RLX_AGENT __ATOMIC_RELAXED, __HIP_MEMORY_SCOPE_AGENT
#define LDS_WAIT() asm volatile("s_waitcnt lgkmcnt(0)" ::: "memory")
#define VM_WAIT() asm volatile("s_waitcnt vmcnt(0)" ::: "memory")

constexpr int D = 2048, NB = 4, SEQ = 4096, M = NB * SEQ, NMETA = 16;
constexpr int HF = 1024, INC = 11264, NE = 32, DFF = 2048, NCH = SEQ / 64;
constexpr int C_Q = 0, C_F = 1024, C_V = 2048, C_G = 3072, C_SV = 4096, C_SB = 5120, C_SC = 6144, C_GA = 7168, C_GB = 9216;
constexpr float EPS = 1e-6f;
constexpr int CAPF = M;
constexpr int MAXRT = 288;
constexpr int NWAVES = 8, NTHR = 512;

constexpr size_t al(size_t x) { return (x + 0xFFFFF) & ~(size_t)0xFFFFF; }
constexpr size_t WS_CTL = 0, CTL_BYTES = 65536;
constexpr size_t WS_LB = 65536, WS_RS1 = WS_LB + 4096, WS_RS2 = WS_RS1 + 65536, WS_WRH = WS_RS2 + 65536, WS_WRL = WS_WRH + 131072;
constexpr size_t WS_LFM = WS_WRL + 131072, WS_VVM = WS_LFM + 64 * 1024 * 4, WS_UUM = WS_VVM + 64 * 1024 * 2, WS_SMALL_END = WS_UUM + 16 * 1024 * 2;
constexpr size_t WS_TOPE = al(WS_SMALL_END), WS_TOPP = WS_TOPE + (size_t)M * 16, WS_TOPW = WS_TOPP + (size_t)M * 16, WS_LIST = WS_TOPW + (size_t)M * 16;
constexpr size_t WS_DEC = al(WS_LIST + (size_t)NE * CAPF * 4);
constexpr size_t WS_WIN = al(WS_DEC + (size_t)33 * 64 * 128 * 4);
constexpr size_t WS_WAB = al(WS_WIN + (size_t)INC * D * 2);
constexpr size_t WS_WO = al(WS_WAB + (size_t)D * D * 2);
constexpr size_t WS_WUP = al(WS_WO + (size_t)D * D * 2);
constexpr size_t WS_WDN = al(WS_WUP + (size_t)NE * 4096 * D);
constexpr size_t WS_XB = al(WS_WDN + (size_t)NE * D * DFF);
constexpr size_t WS_QS = al(WS_XB + (size_t)M * D * 2);
constexpr size_t WS_LF = al(WS_QS + (size_t)M * HF * 2);
constexpr size_t WS_VV = al(WS_LF + (size_t)M * HF * 2);
constexpr size_t WS_GS = al(WS_VV + (size_t)M * HF * 2);
constexpr size_t WS_UU = al(WS_GS + (size_t)M * HF * 2);
constexpr size_t WS_SB = al(WS_UU + (size_t)M * HF * 2);
constexpr size_t WS_RT = al(WS_SB + (size_t)M * HF * 2);
constexpr size_t WS_GBS = al(WS_RT + (size_t)M * D * 2);
constexpr size_t WS_UC = al(WS_GBS + (size_t)M * D * 2);
constexpr size_t WS_SS = al(WS_UC + (size_t)(32 * 64 + 8) * 16384 * 2);
constexpr size_t WS_A2 = al(WS_SS + (size_t)32 * 64 * 16384 * 2);
constexpr size_t WS_MG = al(WS_A2 + (size_t)M * D * 2);
constexpr size_t WS_H1 = al(WS_MG + (size_t)M * D * 2);
constexpr size_t WS_H1B = al(WS_H1 + (size_t)M * D * 2);
constexpr size_t WS_ACT = al(WS_H1B + (size_t)M * D);
constexpr size_t WS_YR = al(WS_ACT + (size_t)MAXRT * 256 * DFF);
constexpr size_t WS_WIN8 = al(WS_YR + (size_t)MAXRT * 256 * D);
constexpr size_t WS_XB8 = al(WS_WIN8 + (size_t)INC * D);
constexpr size_t WS_FAST_END = al(WS_XB8 + (size_t)M * D);
#ifndef FK_IN8_MASK
#define FK_IN8_MASK 0xFFFF00000F0ull
#endif
constexpr unsigned long long IN8_MASK = FK_IN8_MASK;
constexpr unsigned long long INB_MASK = ((1ull << 44) - 1) & ~IN8_MASK;
constexpr int cpop(unsigned long long m) { int n = 0; while (m) { m &= m - 1; ++n; } return n; }
constexpr int N_IN8 = cpop(IN8_MASK), N_INB = 44 - N_IN8;
__device__ __forceinline__ int nth_bit(unsigned long long m, int n) { for (int i = 0; i < n; ++i) m &= m - 1; return __builtin_ctzll(m); }
constexpr int CW_TMO = 0;
constexpr int CW_CNT = 1024;
constexpr int CW_Q = 3400;
constexpr int CW_TS = 3200;
constexpr int CW_BAR = 4096;
constexpr int RING_BYTES = 131072;
constexpr int TOK_OFF = RING_BYTES, TOK_BYTES = 18 * 1024;
constexpr int MISC_OFF = TOK_OFF + TOK_BYTES;
constexpr int LDS_BYTES = MISC_OFF + 1024;
static_assert(LDS_BYTES <= 160 * 1024, "LDS");

__device__ __forceinline__ float sigmoidf_(float x) { return 1.f / (1.f + __expf(-x)); }
__device__ __forceinline__ unsigned f2bf(float f) { unsigned u = __builtin_bit_cast(unsigned, f); return (u + 0x7fffu + ((u >> 16) & 1u)) >> 16; }
__device__ __forceinline__ unsigned pk2(float lo, float hi) { return f2bf(lo) | (f2bf(hi) << 16); }
__device__ __forceinline__ float bf2f(unsigned short b) { return __builtin_bit_cast(float, ((unsigned)b) << 16); }
__device__ __forceinline__ float bflo(unsigned w) { return __builtin_bit_cast(float, w << 16); }
__device__ __forceinline__ float bfhi(unsigned w) { return __builtin_bit_cast(float, w & 0xffff0000u); }
__device__ __forceinline__ unsigned cvt_pk_bf16(float lo, float hi) { unsigned r; asm volatile("v_cvt_pk_bf16_f32 %0, %1, %2" : "=v"(r) : "v"(lo), "v"(hi)); return r; }
__device__ __forceinline__ unsigned pk4_fp8(float a, float b, float c, float d) { int w = 0; w = __builtin_amdgcn_cvt_pk_fp8_f32(a, b, w, false); w = __builtin_amdgcn_cvt_pk_fp8_f32(c, d, w, true); return (unsigned)w; }
constexpr float W8_SCALE = 64.f, W8_INV = 1.f / 64.f;
__device__ __forceinline__ int lane_id() { int l; asm volatile("v_mbcnt_lo_u32_b32 %0, -1, 0\n\tv_mbcnt_hi_u32_b32 %0, -1, %0" : "=v"(l)); return l; }
__device__ __forceinline__ float wave_sum(float v) {
#pragma unroll
    for (int o = 1; o < 64; o <<= 1) v += __shfl_xor(v, o);
    return v;
}

#define XB_TMO      128
#define XB_XCNT(j)  (256  + 64 * (j))
#define XB_XSUB(j)  (1280 + 64 * (j))
#define XB_XGEN(j)  (2304 + 64 * (j))
#define XB_TOP      3328
#define XB_TOPGEN   3392
#define XCD_BAR_WORDS 3456
#define XB_SPIN_CAP (1u << 18)
__device__ __forceinline__ unsigned xb_ld(unsigned* p)              { return __hip_atomic_load(p, __ATOMIC_RELAXED, __HIP_MEMORY_SCOPE_AGENT); }
__device__ __forceinline__ unsigned xb_add(unsigned* p, unsigned v) { return __hip_atomic_fetch_add(p, v, __ATOMIC_RELAXED, __HIP_MEMORY_SCOPE_AGENT); }
__device__ __forceinline__ unsigned xb_xcc_id() { return (unsigned)__builtin_amdgcn_s_getreg((3 << 11) | 20) & 0xFu; }
#define XB_SPIN(cond, bar) do { unsigned _sp = 0; while (cond) { __builtin_amdgcn_s_sleep(1); \
    if ((++_sp & 255u) == 0u) { if (xb_ld(&(bar)[XB_TMO])) break; if (_sp > XB_SPIN_CAP) { atomicAdd(&(bar)[XB_TMO], 1u); break; } } } } while (0)
struct XcdBarrier { unsigned* bar; unsigned x; volatile LAS unsigned* st; };
__device__ __forceinline__ XcdBarrier xcd_barrier_post(unsigned* bar, volatile LAS unsigned* st, int tid) {
    XcdBarrier b; b.bar = bar; b.x = xb_xcc_id(); b.st = st;
    if (tid == 0) (void)xb_add(&bar[XB_XCNT(b.x)], 1u);
    return b;
}
__device__ __forceinline__ void xcd_barrier_complete(unsigned* bar, unsigned x, unsigned& nloc, unsigned& nx) {
    const unsigned G = gridDim.x * gridDim.y * gridDim.z;
    unsigned sum, cnt, mine, sp = 0u;
    for (;;) {
        sum = 0u; cnt = 0u; mine = 0u;
#pragma unroll
        for (unsigned j = 0; j < 16; ++j) { const unsigned c = xb_ld(&bar[XB_XCNT(j)]); sum += c; cnt += (c > 0u) ? 1u : 0u; mine = (j == x) ? c : mine; }
        if (sum == G) break;
        __builtin_amdgcn_s_sleep(1);
        if ((++sp & 255u) == 0u) { if (xb_ld(&bar[XB_TMO])) break; if (sp > XB_SPIN_CAP) { atomicAdd(&bar[XB_TMO], 1u); break; } }
    }
    nloc = mine > 0u ? mine : 1u; nx = cnt > 0u ? cnt : 1u;
}
__device__ __forceinline__ void xcd_barrier(const XcdBarrier& b, int tid) {
    asm volatile("s_waitcnt vmcnt(0)" ::: "memory");
    __syncthreads();
    if (tid == 0) {
        unsigned* bar = b.bar;
        __builtin_amdgcn_s_waitcnt(0);
        unsigned nloc = b.st[0], nx = b.st[1];
        if (nloc == 0u) { xcd_barrier_complete(bar, b.x, nloc, nx); b.st[0] = nloc; b.st[1] = nx; }
        const unsigned old = xb_add(&bar[XB_XSUB(b.x)], 1u);
        const unsigned gen = old / nloc;
        if (old + 1u == (gen + 1u) * nloc) {
            __builtin_amdgcn_fence(__ATOMIC_RELEASE, "agent");
            asm volatile("s_waitcnt vmcnt(0)" ::: "memory");
            const unsigned og = xb_add(&bar[XB_TOP], 1u);
            const unsigned tg = og / nx;
            if (og + 1u == (tg + 1u) * nx) xb_add(&bar[XB_TOPGEN], 1u);
            else XB_SPIN(xb_ld(&bar[XB_TOPGEN]) == tg, bar);
            __builtin_amdgcn_fence(__ATOMIC_ACQUIRE, "agent");
            xb_add(&bar[XB_XGEN(b.x)], 1u);
            asm volatile("s_waitcnt vmcnt(0)" ::: "memory");
        } else {
            XB_SPIN(xb_ld(&bar[XB_XGEN(b.x)]) == gen, bar);
            __builtin_amdgcn_fence(__ATOMIC_ACQUIRE, "agent");
            asm volatile("s_waitcnt vmcnt(0)" ::: "memory");
        }
    }
    __syncthreads();
}

constexpr int BM = 256, BK = 64, HALF = 128, HTB = HALF * BK * 2, NXCD = 8, WGM = 8;
__host__ __device__ __forceinline__ int lds_byte(int r, int c) { const int st = (r >> 4) * 2 + (c >> 5), rr = r & 15, cc = c & 31, ob = rr * 64 + cc * 2; return st * 1024 + (ob ^ (((ob >> 9) & 1) << 5)); }
__host__ __device__ __forceinline__ void stage_rc(int b, int& R, int& C) { const int st = b / 1024, sb = b % 1024, swz = sb ^ (((sb >> 9) & 1) << 5); R = (st >> 1) * 16 + swz / 64; C = (st & 1) * 32 + (swz % 64) / 2; }
__host__ __device__ __forceinline__ int perm32(int rho) { const int n = rho >> 4, i = rho & 15; return 8 * (i >> 2) + 4 * n + (i & 3); }

typedef int i32x8 __attribute__((ext_vector_type(8)));
typedef int i32x4v __attribute__((ext_vector_type(4)));
__device__ __forceinline__ i32x8 cat8(const bf16x8 a, const bf16x8 b) { const i32x4v x = __builtin_bit_cast(i32x4v, a), y = __builtin_bit_cast(i32x4v, b); return __builtin_shufflevector(x, y, 0, 1, 2, 3, 4, 5, 6, 7); }
__device__ __forceinline__ void mfma8(f32x4& acc, const i32x8 a, const i32x8 b, const int sc) {
    asm volatile("s_nop 1\n\tv_mfma_scale_f32_16x16x128_f8f6f4 %0, %1, %2, %0, %3, %3 op_sel_hi:[0,0,0]" : "+v"(acc) : "v"(a), "v"(b), "v"(sc));
}
struct Unit { int pm, pn, e, ui; };

struct StaticOrder {
    int nM, nN, nwg, G, c;
    __device__ void init(int M_, int N_, int G_, int c_) { nM = M_ / BM; nN = N_ / BM; nwg = nM * nN; G = G_; c = c_; }
    __device__ __forceinline__ bool next(int i, Unit& u) const {
        const long L = (long)i * G + c; if (L >= nwg) return false;
        int wgid = (int)L; { const int q = nwg / NXCD, r = nwg % NXCD, xcd = wgid % NXCD, off = wgid / NXCD; wgid = (xcd < r ? xcd * (q + 1) : r * (q + 1) + (xcd - r) * q) + off; }
        const int nig = WGM * nN, gid = wgid / nig, fm = gid * WGM, gsz = (nM - fm) < WGM ? (nM - fm) : WGM;
        u.pm = fm + ((wgid % nig) % gsz); u.pn = (wgid % nig) / gsz; u.e = 0; u.ui = i; return true;
    }
};
struct DynOrder {
    int nM, nN, nwg, x; unsigned* head; volatile LAS unsigned* slot; int tid; unsigned long long mask;
    __device__ void init(int M_, unsigned long long mask_, int nN_, int c_, unsigned* head_, volatile LAS unsigned* slot_, int tid_) { nM = M_ / BM; nN = nN_; mask = mask_; nwg = nM * nN; x = c_ & 7; head = head_; slot = slot_; tid = tid_; }
    __device__ __forceinline__ bool next(int i, Unit& u) const {
        if (tid == 0) slot[i & 1] = __hip_atomic_fetch_add(head, 1u, __ATOMIC_RELAXED, __HIP_MEMORY_SCOPE_AGENT);
        asm volatile("s_waitcnt lgkmcnt(0)" ::: "memory"); __builtin_amdgcn_s_barrier(); asm volatile("" ::: "memory");
        const int j = (int)slot[i & 1], q = nwg / NXCD;
        if (j >= q) return false;
        const int wgid = x * q + j;
        const int nig = WGM * nN, gid = wgid / nig, fm = gid * WGM, gsz = (nM - fm) < WGM ? (nM - fm) : WGM;
        u.pm = fm + ((wgid % nig) % gsz); u.pn = nth_bit(mask, (wgid % nig) / gsz); u.e = 0; u.ui = i; return true;
    }
};
struct MoeOrder {
    int nct, NT, G, c; const volatile LAS int* pref;
    __device__ void init(int nct_, int G_, int c_, const volatile LAS int* pref_) { nct = nct_; G = G_; c = c_; pref = pref_; NT = pref_[NE]; }
    template <bool UNIFORM = true> __device__ __forceinline__ bool next(int i, Unit& u) const {
        int rtg, pn;
        if (G == 256) { const int x = c & 7, jj = c >> 3;
            if (nct == 16) { rtg = 16 * i + 8 * (x & 1) + (jj & 7); pn = 4 * (x >> 1) + (jj >> 3); }
            else           { rtg = 32 * i + 8 * (x & 3) + (jj & 7); pn = 4 * (x >> 2) + (jj >> 3); } }
        else { const int U = i * G + c; rtg = U / nct; pn = U - rtg * nct; }
        if (rtg >= NT) return false;
        u.pn = pn; u.pm = rtg; u.ui = i;
        int e = 0;
        if constexpr (UNIFORM) { const int l = lane_id(); const int pv = (l >= 1 && l < NE) ? pref[l] : 0x7fffffff; e = (int)__builtin_popcountll(__ballot(pv <= rtg)); }
        else {
#pragma unroll 1
            for (int j = 1; j < NE; ++j) e = (pref[j] <= rtg) ? j : e; }
        u.e = e; return true;
    }
};

struct GemmDesc { const bf16_t* A; const bf16_t* Bt; int K; int nct; };

template <class Epi, class Sched, bool GATHER, bool ALIGN_EPI, bool FP8>
__device__ __forceinline__ void gemm_phase(LAS unsigned char* lds, const GemmDesc g, const Sched& S, const Epi& E, const LAS int* tok, int wid) {
    const int lane = lane_id(), tid = wid * 64 + lane, wr = wid >> 2, wc = wid & 3, fr = lane & 15, fq = lane >> 4;
    const int K = g.K, KB = FP8 ? K : 2 * K  , nt = FP8 ? K / 128 : K / BK;
    int Rl[2], Cl[2];
    unsigned voffA[2], voffB[2];
#pragma unroll
    for (int i = 0; i < 2; ++i) { int Cc; stage_rc(tid * 16 + i * 8192, Rl[i], Cc); const int p = Cc >> 3; Cl[i] = FP8 ? 16 * (2 * (p & 3) + (p >> 2)) : 2 * Cc; voffA[i] = (unsigned)(Rl[i] * KB + Cl[i]); voffB[i] = voffA[i]; }
    const size_t kstep = (size_t)(BK * 2);
    const size_t hstep = (size_t)HALF * KB;
    const size_t tstep = 2 * hstep;
    const unsigned ldsw = (unsigned)wid * 1024u;
    const int aoff = lds_byte(wr * 64 + fr, fq * 8), boff = lds_byte(wc * 32 + fr, fq * 8);
#define PG8_SA(b, h) (((b) * 2 + (h)) * HTB)
#define PG8_SB(b, h) ((4 + (b) * 2 + (h)) * HTB)
#define PG8_STAGE(bufoff, gbase, voff) do { _Pragma("unroll") for (int _i = 0; _i < 2; ++_i) \
        __builtin_amdgcn_global_load_lds((const unsigned*)((const char*)(gbase) + (voff)[_i]), (LAS unsigned*)(lds + (bufoff) + ldsw + _i * 8192), 16, 0, 0); } while (0)
#define PG8_STAGE_A(bufoff, ptr, half, o0, o1) do { if constexpr (GATHER) { PG8_STAGE(bufoff, ptr, (half) ? o1 : o0); } else { PG8_STAGE(bufoff, (ptr) + (half) * hstep, voffA); } } while (0)
#define PG8_LDA(dst, b, h) do { _Pragma("unroll") for (int m = 0; m < 4; ++m) _Pragma("unroll") for (int k = 0; k < 2; ++k) dst[m][k] = *(const LAS bf16x8*)(lds + PG8_SA(b, h) + aoff + m * 2048 + k * 1024); } while (0)
#define PG8_LDB(dst, b, h) do { _Pragma("unroll") for (int n = 0; n < 2; ++n) _Pragma("unroll") for (int k = 0; k < 2; ++k) dst[n][k] = *(const LAS bf16x8*)(lds + PG8_SB(b, h) + boff + n * 2048 + k * 1024); } while (0)
#define PG8_MMA(ai, bj, At, Bt) do { __builtin_amdgcn_s_setprio(1); _Pragma("unroll") for (int m = 0; m < 4; ++m) _Pragma("unroll") for (int n = 0; n < 2; ++n) _Pragma("unroll") for (int k = 0; k < 2; ++k) \
        acc[ai][bj][m][n] = __builtin_amdgcn_mfma_f32_16x16x32_bf16(Bt[n][k], At[m][k], acc[ai][bj][m][n], 0, 0, 0); __builtin_amdgcn_s_setprio(0); } while (0)
#define PG8_MMA8(ai, bj, At, Bt) do { __builtin_amdgcn_s_setprio(1); _Pragma("unroll") for (int m = 0; m < 4; ++m) _Pragma("unroll") for (int n = 0; n < 2; ++n) \
        mfma8(acc[ai][bj][m][n], cat8(Bt[n][0], Bt[n][1]), cat8(At[m][0], At[m][1]), sc8); __builtin_amdgcn_s_setprio(0); } while (0)
#define PG8_MM(ai, bj, At, Bt) do { if constexpr (FP8) PG8_MMA8(ai, bj, At, Bt); else PG8_MMA(ai, bj, At, Bt); } while (0)
#define PG8_WAIT_V(n) asm volatile("s_waitcnt vmcnt(" #n ")" ::: "memory")
#define PG8_WAIT_L(n) asm volatile("s_waitcnt lgkmcnt(" #n ")" ::: "memory")
#define PG8_BAR __builtin_amdgcn_s_barrier()
#define PG8_SCHED __builtin_amdgcn_sched_barrier(0)
    Unit cur, nxt; int ui = 0;
    if (!S.next(0, cur)) return;
    const int sc8 = 0x7F7F7F7F;
    f32x4 acc[2][2][4][2];
#pragma unroll
    for (int a = 0; a < 2; ++a)
#pragma unroll
        for (int b = 0; b < 2; ++b)
#pragma unroll
            for (int m = 0; m < 4; ++m)
#pragma unroll
                for (int n = 0; n < 2; ++n) acc[a][b][m][n] = (f32x4){0.f, 0.f, 0.f, 0.f};
    bf16x8 At[4][2], B0[2][2], B1[2][2];
    unsigned vA0[2] = {0u, 0u}, vA1[2] = {0u, 0u}, nA0[2] = {0u, 0u}, nA1[2] = {0u, 0u};
    const char* cA; const char* cB = (const char*)g.Bt + (size_t)(cur.e * g.nct + cur.pn) * tstep;
    if constexpr (GATHER) {
        cA = (const char*)g.A;
#pragma unroll
        for (int i = 0; i < 2; ++i) { vA0[i] = (unsigned)((tok[cur.ui * 256 + Rl[i]] & 0xffff) * KB + Cl[i]); vA1[i] = (unsigned)((tok[cur.ui * 256 + 128 + Rl[i]] & 0xffff) * KB + Cl[i]); nA0[i] = vA0[i]; nA1[i] = vA1[i]; }
    } else cA = (const char*)g.A + (size_t)cur.pm * tstep;
    PG8_STAGE(PG8_SB(0, 0), cB, voffB); PG8_STAGE(PG8_SB(0, 1), cB + hstep, voffB); PG8_STAGE_A(PG8_SA(0, 0), cA, 0, vA0, vA1); PG8_STAGE_A(PG8_SA(0, 1), cA, 1, vA0, vA1);
    if (wr == 1) PG8_BAR;
    PG8_WAIT_V(2); PG8_BAR;
    PG8_STAGE(PG8_SB(1, 0), cB + kstep, voffB); PG8_STAGE_A(PG8_SA(1, 0), cA + kstep, 0, vA0, vA1); PG8_STAGE(PG8_SB(1, 1), cB + hstep + kstep, voffB);
    PG8_WAIT_V(6); PG8_BAR;
    for (;;) {
        const bool has_next = S.next(ui + 1, nxt);
        const char* nAp; const char* nB;
        if (has_next) {
            nB = (const char*)g.Bt + (size_t)(nxt.e * g.nct + nxt.pn) * tstep;
            if constexpr (GATHER) { nAp = cA;
#pragma unroll
                for (int i = 0; i < 2; ++i) { nA0[i] = (unsigned)((tok[nxt.ui * 256 + Rl[i]] & 0xffff) * KB + Cl[i]); nA1[i] = (unsigned)((tok[nxt.ui * 256 + 128 + Rl[i]] & 0xffff) * KB + Cl[i]); }
            } else nAp = (const char*)g.A + (size_t)nxt.pm * tstep;
        } else { nAp = cA; nB = cB; }
        for (int t = 0; t < nt; t += 2) {
            const bool last = (t == nt - 2);
            const char* a1 = cA + (size_t)(t + 1) * kstep;
            const char* a2 = last ? nAp : cA + (size_t)(t + 2) * kstep; const char* b2 = last ? nB : cB + (size_t)(t + 2) * kstep;
            const char* a3 = a2 + kstep; const char* b3 = b2 + kstep;
            unsigned w0[2] = {0u, 0u}, w1[2] = {0u, 0u};
            if constexpr (GATHER) {
#pragma unroll
                for (int i = 0; i < 2; ++i) { w0[i] = last ? nA0[i] : vA0[i]; w1[i] = last ? nA1[i] : vA1[i]; } }
            if constexpr (Epi::MIDHOOK) { if (t == nt / 2) E.mid(acc, cur, wr, wc, fr, fq); }
            PG8_LDB(B0, 0, 0); PG8_LDB(B1, 0, 1); PG8_SCHED; PG8_LDA(At, 0, 0); PG8_STAGE_A(PG8_SA(1, 1), a1, 1, vA0, vA1);
            PG8_WAIT_V(8); PG8_WAIT_L(0); PG8_BAR; PG8_MM(0, 0, At, B0); PG8_MM(0, 1, At, B1); PG8_BAR; PG8_SCHED;
            PG8_LDA(At, 0, 1); PG8_STAGE(PG8_SB(0, 0), b2, voffB); PG8_STAGE(PG8_SB(0, 1), b2 + hstep, voffB); PG8_STAGE_A(PG8_SA(0, 0), a2, 0, w0, w1);
            PG8_WAIT_V(8); PG8_WAIT_L(0); PG8_BAR; PG8_MM(1, 0, At, B0); PG8_MM(1, 1, At, B1); PG8_BAR; PG8_SCHED;
            PG8_LDB(B0, 1, 0); PG8_LDB(B1, 1, 1); PG8_SCHED; PG8_LDA(At, 1, 0); PG8_STAGE_A(PG8_SA(0, 1), a2, 1, w0, w1);
            PG8_WAIT_V(8); PG8_WAIT_L(0); PG8_BAR; PG8_MM(0, 0, At, B0); PG8_MM(0, 1, At, B1); PG8_BAR; PG8_SCHED;
            PG8_LDA(At, 1, 1); PG8_STAGE(PG8_SB(1, 0), b3, voffB); PG8_STAGE(PG8_SB(1, 1), b3 + hstep, voffB); PG8_STAGE_A(PG8_SA(1, 0), a3, 0, w0, w1);
            PG8_WAIT_V(8); PG8_WAIT_L(0); PG8_BAR; PG8_MM(1, 0, At, B0); PG8_MM(1, 1, At, B1); PG8_BAR; PG8_SCHED;
        }
        if constexpr (ALIGN_EPI) { if (wr == 0) PG8_BAR; }
        E(acc, cur, wr, wc, fr, fq);
        if (!has_next) break;
#pragma unroll
        for (int a = 0; a < 2; ++a)
#pragma unroll
            for (int b = 0; b < 2; ++b)
#pragma unroll
                for (int m = 0; m < 4; ++m)
#pragma unroll
                    for (int n = 0; n < 2; ++n) acc[a][b][m][n] = (f32x4){0.f, 0.f, 0.f, 0.f};
        cur = nxt; cA = nAp; cB = nB; ++ui;
        if constexpr (GATHER) {
#pragma unroll
            for (int i = 0; i < 2; ++i) { vA0[i] = nA0[i]; vA1[i] = nA1[i]; } }
        if constexpr (ALIGN_EPI) { if (wr == 1) PG8_BAR; }
    }
    PG8_WAIT_V(0);
    if constexpr (!ALIGN_EPI) { if (wr == 0) PG8_BAR; }
    PG8_BAR;
#undef PG8_SA
#undef PG8_SB
#undef PG8_STAGE
#undef PG8_STAGE_A
#undef PG8_LDA
#undef PG8_LDB
#undef PG8_MMA
#undef PG8_MMA8
#undef PG8_MM
#undef PG8_WAIT_V
#undef PG8_WAIT_L
#undef PG8_BAR
#undef PG8_SCHED
}
typedef f32x4 Acc[2][2][4][2];
__device__ __forceinline__ float silu_(float x) { return x * __builtin_amdgcn_rcpf(1.f + __expf(-x)); }
__device__ __forceinline__ float sigm_(float x) { return __builtin_amdgcn_rcpf(1.f + __expf(-x)); }
__device__ __forceinline__ u32x4 pack8(const f32x4 a, const f32x4 b) { u32x4 w; w.x = cvt_pk_bf16(a[0], a[1]); w.y = cvt_pk_bf16(a[2], a[3]); w.z = cvt_pk_bf16(b[0], b[1]); w.w = cvt_pk_bf16(b[2], b[3]); return w; }
__device__ __forceinline__ u32x2 pack8_fp8(const f32x4 a, const f32x4 b) { u32x2 w; w.x = pk4_fp8(a[0], a[1], a[2], a[3]); w.y = pk4_fp8(b[0], b[1], b[2], b[3]); return w; }
__device__ __forceinline__ void unpack8(const u32x4 w, f32x4& a, f32x4& b) { a = (f32x4){bflo(w.x), bfhi(w.x), bflo(w.y), bfhi(w.y)}; b = (f32x4){bflo(w.z), bfhi(w.z), bflo(w.w), bfhi(w.w)}; }

struct EpiInproj {
    static constexpr bool MIDHOOK = false;
    const float* rs1; const float* lb; bf16_t *QS, *VV, *GS, *UU, *SBb, *RT, *GBS; h16_t* LF; float osc;
    __device__ __forceinline__ void mid(Acc&, const Unit&, int, int, int, int) const {}
    template <int ACT> __device__ __forceinline__ void plain(const Acc& acc, const float (&rs)[2][4], bf16_t* O, int pt, int row0, int wc, int fq) const {
#pragma unroll
        for (int ai = 0; ai < 2; ++ai)
#pragma unroll
            for (int m = 0; m < 4; ++m) { bf16_t* rowp = O + (size_t)(row0 + ai * HALF + m * 16) * HF + pt * 256 + wc * 32 + 8 * fq; const float r = rs[ai][m];
#pragma unroll
                for (int bj = 0; bj < 2; ++bj) { f32x4 v0 = acc[ai][bj][m][0] * r, v1 = acc[ai][bj][m][1] * r;
                    if (ACT == 1) {
#pragma unroll
                        for (int j = 0; j < 4; ++j) { v0[j] = silu_(v0[j]); v1[j] = silu_(v1[j]); } }
                    *(u32x4*)(rowp + bj * HALF) = pack8(v0, v1); } }
    }
    __device__ __forceinline__ void operator()(const Acc& acc, const Unit& u, int wr, int wc, int fr, int fq) const {
        const int row0 = u.pm * BM + wr * 64 + fr, pn = u.pn;
        float rs[2][4];
#pragma unroll
        for (int ai = 0; ai < 2; ++ai)
#pragma unroll
            for (int m = 0; m < 4; ++m) rs[ai][m] = osc;
        if (pn < 4) plain<1>(acc, rs, QS, pn, row0, wc, fq);
        else if (pn < 8) {
            const int c0 = (pn - 4) * 256 + wc * 32 + 4 * fq;
            f32x4 lbv[2][2];
#pragma unroll
            for (int bj = 0; bj < 2; ++bj)
#pragma unroll
                for (int n = 0; n < 2; ++n) lbv[bj][n] = *(const f32x4*)(lb + c0 + bj * HALF + n * 16);
#pragma unroll
            for (int ai = 0; ai < 2; ++ai)
#pragma unroll
                for (int m = 0; m < 4; ++m) { h16_t* rowp = LF + (size_t)(row0 + ai * HALF + m * 16) * HF + c0; const float r = rs[ai][m];
#pragma unroll
                    for (int bj = 0; bj < 2; ++bj)
#pragma unroll
                        for (int n = 0; n < 2; ++n) { f32x4 v = acc[ai][bj][m][n] * r; const f32x4 l = lbv[bj][n];
#pragma unroll
                            for (int j = 0; j < 4; ++j) v[j] = __logf(l[j] + (1.f - l[j]) * sigm_(v[j]));
                            *(h16x4*)(rowp + bj * HALF + n * 16) = (h16x4){(h16_t)v[0], (h16_t)v[1], (h16_t)v[2], (h16_t)v[3]}; } }
        }
        else if (pn < 12) plain<0>(acc, rs, VV, pn - 8, row0, wc, fq);
        else if (pn < 16) plain<1>(acc, rs, GS, pn - 12, row0, wc, fq);
        else if (pn < 24) {
            const int c0 = (pn - 16) * 128 + wc * 32 + 8 * fq;
#pragma unroll
            for (int ai = 0; ai < 2; ++ai)
#pragma unroll
                for (int m = 0; m < 4; ++m) { const float r2 = rs[ai][m] * rs[ai][m];
                    const f32x4 v0 = acc[ai][0][m][0] * acc[ai][1][m][0] * r2, v1 = acc[ai][0][m][1] * acc[ai][1][m][1] * r2;
                    *(u32x4*)(UU + (size_t)(row0 + ai * HALF + m * 16) * HF + c0) = pack8(v0, v1); }
        }
        else if (pn < 28) plain<0>(acc, rs, SBb, pn - 24, row0, wc, fq);
        else {
            const int c0 = (pn - 28) * 128 + wc * 32 + 8 * fq;
#pragma unroll
            for (int ai = 0; ai < 2; ++ai)
#pragma unroll
                for (int m = 0; m < 4; ++m) { const float r = rs[ai][m]; f32x4 q0, q1, b0, b1;
#pragma unroll
                    for (int j = 0; j < 4; ++j) { const float ea = 1.f + __expf(-acc[ai][0][m][0][j] * r), eb = 1.f + __expf(-acc[ai][1][m][0][j] * r); b0[j] = __builtin_amdgcn_rcpf(eb); q0[j] = eb * __builtin_amdgcn_rcpf(ea);
                                                  const float fa = 1.f + __expf(-acc[ai][0][m][1][j] * r), fb = 1.f + __expf(-acc[ai][1][m][1][j] * r); b1[j] = __builtin_amdgcn_rcpf(fb); q1[j] = fb * __builtin_amdgcn_rcpf(fa); }
                    const size_t o = (size_t)(row0 + ai * HALF + m * 16) * D + c0;
                    *(u32x4*)(RT + o) = pack8(q0, q1); *(u32x4*)(GBS + o) = pack8(b0, b1); }
        }
    }
};

struct EpiMerge {
    static constexpr bool MIDHOOK = true;
    const bf16_t *RT, *GBS; bf16_t* MG;
    __device__ __forceinline__ void mid(Acc& acc, const Unit& u, int wr, int wc, int fr, int fq) const {
        unsigned o0 = ((unsigned)(u.pm * BM + wr * 64 + fr) * D + (unsigned)(u.pn * BM + wc * 32 + 8 * fq)) * 2u;
        asm volatile("" : "+v"(o0));
#pragma unroll
        for (int ai = 0; ai < 2; ++ai)
#pragma unroll
            for (int m = 0; m < 4; ++m)
#pragma unroll
                for (int bj = 0; bj < 2; ++bj) { const u32x4 w = *(const GAS u32x4*)((const GAS char*)RT + (o0 + (unsigned)((ai * HALF + m * 16) * D + bj * HALF) * 2u)); f32x4 a, b; unpack8(w, a, b);
                    acc[ai][bj][m][0] *= a; acc[ai][bj][m][1] *= b; }
    }
    __device__ __forceinline__ void operator()(const Acc& acc, const Unit& u, int wr, int wc, int fr, int fq) const {
        unsigned o0 = ((unsigned)(u.pm * BM + wr * 64 + fr) * D + (unsigned)(u.pn * BM + wc * 32 + 8 * fq)) * 2u;
        asm volatile("" : "+v"(o0));
#pragma unroll
        for (int ai = 0; ai < 2; ++ai)
#pragma unroll
            for (int m = 0; m < 4; ++m)
#pragma unroll
                for (int bj = 0; bj < 2; ++bj) { const unsigned o = o0 + (unsigned)((ai * HALF + m * 16) * D + bj * HALF) * 2u; const u32x4 w = *(const GAS u32x4*)((const GAS char*)GBS + o); f32x4 a, b; unpack8(w, a, b);
                    *(GAS u32x4*)((GAS char*)MG + o) = pack8(acc[ai][bj][m][0] * a, acc[ai][bj][m][1] * b); if (bj == 1 && m == 3) asm volatile("" ::: "memory"); }
    }
};

struct EpiWo {
    static constexpr bool MIDHOOK = false;
    bf16_t* DL;
    __device__ __forceinline__ void mid(Acc&, const Unit&, int, int, int, int) const {}
    __device__ __forceinline__ void operator()(const Acc& acc, const Unit& u, int wr, int wc, int fr, int fq) const {
        const int row0 = u.pm * BM + wr * 64 + fr, c0 = u.pn * BM + wc * 32 + 8 * fq;
#pragma unroll
        for (int ai = 0; ai < 2; ++ai)
#pragma unroll
            for (int m = 0; m < 4; ++m)
#pragma unroll
                for (int bj = 0; bj < 2; ++bj) *(u32x4*)(DL + (size_t)(row0 + ai * HALF + m * 16) * D + c0 + bj * HALF) = pack8(acc[ai][bj][m][0], acc[ai][bj][m][1]);
    }
};

struct EpiUp {
    static constexpr bool MIDHOOK = false;
    const float* rs2; const LAS int* tok; const float* b_up; unsigned char* ACT;
    __device__ __forceinline__ void mid(Acc&, const Unit&, int, int, int, int) const {}
    __device__ __forceinline__ void operator()(const Acc& acc, const Unit& u, int wr, int wc, int fr, int fq) const {
        const int rl0 = wr * 64 + fr, c0 = u.pn * 128 + wc * 32 + 8 * fq;
        float rs[2][4];
#pragma unroll
        for (int ai = 0; ai < 2; ++ai)
#pragma unroll
            for (int m = 0; m < 4; ++m) rs[ai][m] = __uint_as_float((unsigned)tok[u.ui * 256 + rl0 + ai * HALF + m * 16] & 0xffff0000u);
        const float* bp = b_up + (size_t)u.e * 4096 + c0;
        const f32x4 bg0 = *(const f32x4*)(bp), bg1 = *(const f32x4*)(bp + 4), bu0 = *(const f32x4*)(bp + 2048), bu1 = *(const f32x4*)(bp + 2052);
#pragma unroll
        for (int ai = 0; ai < 2; ++ai)
#pragma unroll
            for (int m = 0; m < 4; ++m) { const float r = rs[ai][m]; f32x4 a0, a1;
#pragma unroll
                for (int n = 0; n < 2; ++n)
#pragma unroll
                    for (int jp = 0; jp < 2; ++jp) {
                        const f32x4 ag = acc[ai][0][m][n], au = acc[ai][1][m][n], bgv = n ? bg1 : bg0, buv = n ? bu1 : bu0;
                        f32x2 g = (f32x2){ag[2 * jp], ag[2 * jp + 1]} * r + (f32x2){bgv[2 * jp], bgv[2 * jp + 1]};
                        f32x2 uu = (f32x2){au[2 * jp], au[2 * jp + 1]} * r + (f32x2){buv[2 * jp], buv[2 * jp + 1]};
                        g.x = fminf(g.x, 7.f); g.y = fminf(g.y, 7.f);
                        uu.x = __builtin_amdgcn_fmed3f(uu.x, -7.f, 7.f); uu.y = __builtin_amdgcn_fmed3f(uu.y, -7.f, 7.f);
                        const f32x2 t = g * (-1.702f * 1.44269504f);
                        f32x2 den; den.x = __builtin_amdgcn_exp2f(t.x); den.y = __builtin_amdgcn_exp2f(t.y); den = den + 1.f;
                        f32x2 s; s.x = __builtin_amdgcn_rcpf(den.x); s.y = __builtin_amdgcn_rcpf(den.y);
                        const f32x2 a = (uu + 1.f) * (g * s);
                        if (n == 0) { a0[2 * jp] = a.x; a0[2 * jp + 1] = a.y; } else { a1[2 * jp] = a.x; a1[2 * jp + 1] = a.y; }
                    }
                *(u32x2*)(ACT + (size_t)(u.pm * BM + rl0 + ai * HALF + m * 16) * DFF + c0) = pack8_fp8(a0, a1); }
    }
};

struct EpiDown {
    static constexpr bool MIDHOOK = false;
    const float* b_dn; unsigned char* YR;
    __device__ __forceinline__ void mid(Acc&, const Unit&, int, int, int, int) const {}
    __device__ __forceinline__ void operator()(const Acc& acc, const Unit& u, int wr, int wc, int fr, int fq) const {
        const int rl0 = wr * 64 + fr, c0 = u.pn * BM + wc * 32 + 8 * fq;
        const float* bp = b_dn + (size_t)u.e * D + c0;
        f32x4 bv[2][2];
#pragma unroll
        for (int bj = 0; bj < 2; ++bj)
#pragma unroll
            for (int n = 0; n < 2; ++n) bv[bj][n] = *(const f32x4*)(bp + bj * HALF + 4 * n);
#pragma unroll
        for (int ai = 0; ai < 2; ++ai)
#pragma unroll
            for (int m = 0; m < 4; ++m)
#pragma unroll
                for (int bj = 0; bj < 2; ++bj)
                    *(u32x2*)(YR + (size_t)(u.pm * BM + rl0 + ai * HALF + m * 16) * D + c0 + bj * HALF) = pack8_fp8(acc[ai][bj][m][0] * W8_INV + bv[bj][0], acc[ai][bj][m][1] * W8_INV + bv[bj][1]);
    }
};

struct EpiDummy {
    static constexpr bool MIDHOOK = false;
    bf16_t* O; int nostore;
    __device__ __forceinline__ void mid(Acc&, const Unit&, int, int, int, int) const {}
    __device__ __forceinline__ void operator()(const Acc& acc, const Unit& u, int wr, int wc, int fr, int fq) const {
        const int row0 = (u.pm & 63) * BM + wr * 64 + fr, c0 = (u.pn & 7) * BM + wc * 32 + 8 * fq;
        if (nostore) {
#pragma unroll
            for (int ai = 0; ai < 2; ++ai)
#pragma unroll
                for (int m = 0; m < 4; ++m)
#pragma unroll
                    for (int bj = 0; bj < 2; ++bj) asm volatile("" :: "v"(acc[ai][bj][m][0]), "v"(acc[ai][bj][m][1]));
            return; }
#pragma unroll
        for (int ai = 0; ai < 2; ++ai)
#pragma unroll
            for (int m = 0; m < 4; ++m)
#pragma unroll
                for (int bj = 0; bj < 2; ++bj) *(u32x4*)(O + (size_t)(row0 + ai * HALF + m * 16) * D + c0 + bj * HALF) = pack8(acc[ai][bj][m][0], acc[ai][bj][m][1]);
    }
};
struct ProbeOrder {
    StaticOrder S; int mode, c;
    __device__ __forceinline__ bool next(int i, Unit& u) const {
        if (mode == 3) { if (c & 1) return false; StaticOrder H = S; H.G = S.G / 2; H.c = c >> 1; H.nwg = S.nwg / 2; return H.next(i, u); }
        if (!S.next(i, u)) return false; if (mode >= 1) u.pn = 0; if (mode >= 2) u.pm = c & 63; return true; }
};

struct ProbeMoe {
    MoeOrder S; int mode;
    __device__ __forceinline__ bool next(int i, Unit& u) const { if (!S.next(i, u)) return false; if (mode & 1) { u.e = 0; u.pn = 0; } if (mode & 2) u.pm = 0; return true; }
};
struct Frame {
    LAS unsigned char* lds; volatile LAS unsigned* MISC; gu32* ctl; unsigned char* ws;
    int tid, lane, wave, vcu, G;
    const float *x, *meta, *nmw, *w_in, *lbl, *gnw, *w_ho, *cw, *w_co, *w_o, *nfw, *w_r, *b_r, *w_up, *b_up, *w_dn, *b_dn, *fnw; float* out;
};
template <class T> __device__ __forceinline__ T* wsp(const Frame& F, size_t off) { return (T*)(F.ws + off); }

__device__ __forceinline__ void tr_tile(const float* W, int ldw, int k0, int src0, int src1, bool perm0, bool perm1, const float* kscale, bf16_t* dst, int dpitch, int drow0, int dk0, LAS unsigned* T, int lane) {
    const int ln = lane & 15, kr = lane >> 4, srcc = (ln < 8 ? src0 : src1) + 4 * (ln & 7);
    const float* wp = W + (size_t)(k0 + 2 * kr) * ldw + srcc;
    f32x4 va[8], vb[8]; f32x2 sc[8];
#pragma unroll
    for (int s = 0; s < 8; ++s) { va[s] = __builtin_nontemporal_load((const GAS f32x4*)(wp + (size_t)(8 * s) * ldw)); vb[s] = __builtin_nontemporal_load((const GAS f32x4*)(wp + (size_t)(8 * s + 1) * ldw));
        sc[s] = kscale ? *(const GAS f32x2*)(kscale + k0 + 8 * s + 2 * kr) : (f32x2){1.f, 1.f}; }
    __builtin_amdgcn_sched_barrier(0);
#pragma unroll
    for (int s = 0; s < 8; ++s) { const int col = (4 * s + kr) ^ (2 * ln);
#pragma unroll
        for (int i = 0; i < 4; ++i) T[(4 * ln + i) * 32 + col] = cvt_pk_bf16(va[s][i] * sc[s].x, vb[s][i] * sc[s].y); }
    LDS_WAIT(); asm volatile("" ::: "memory");
    const int c = lane & 7;
#pragma unroll
    for (int j = 0; j < 8; ++j) { const int rho = (lane >> 3) + 8 * j, h = rho >> 5, r32 = rho & 31; const bool pm = h ? perm1 : perm0; const int n = h * 32 + (pm ? perm32(r32) : r32);
        u32x4 v = *(const LAS u32x4*)(T + n * 32 + 4 * (c ^ (n >> 3)));
        if ((n >> 2) & 1) v = (u32x4){v.z, v.w, v.x, v.y};
        *(GAS u32x4*)(dst + (size_t)(drow0 + rho) * dpitch + dk0 + k0 + 8 * c) = v; }
    LDS_WAIT(); asm volatile("" ::: "memory");
}
template <int PMODE = 0> __device__ __forceinline__ void tr_tile_fp8(const float* W, int ldw, int k0, int src0, int src1, const float* kscale, unsigned char* dst, int dpitch, int drow0, LAS unsigned* T, int lane, bool perm = true) {
    const int ln = lane & 15, kr = lane >> 4, srcc = (ln < 8 ? src0 : src1) + 4 * (ln & 7);
    f32x4 v[2][4][4];
#pragma unroll
    for (int half = 0; half < 2; ++half) {
        const float* wp = W + (size_t)(k0 + 64 * half + 4 * kr) * ldw + srcc;
#pragma unroll
        for (int s = 0; s < 4; ++s) {
#pragma unroll
            for (int q = 0; q < 4; ++q) v[half][s][q] = __builtin_nontemporal_load((const GAS f32x4*)(wp + (size_t)(16 * s + q) * ldw)); }
    }
    __builtin_amdgcn_sched_barrier(0);
    if (PMODE == 1) {
#pragma unroll
        for (int half = 0; half < 2; ++half)
#pragma unroll
            for (int s = 0; s < 4; ++s)
#pragma unroll
                for (int q = 0; q < 4; ++q) asm volatile("" :: "v"(v[half][s][q]));
        return; }
#pragma unroll
    for (int half = 0; half < 2; ++half)
#pragma unroll
        for (int s = 0; s < 4; ++s) { const int col = (16 * half + 4 * s + kr) ^ (2 * ln);
            const f32x4 sc = kscale ? *(const GAS f32x4*)(kscale + k0 + 64 * half + 16 * s + 4 * kr) * W8_SCALE : (f32x4){W8_SCALE, W8_SCALE, W8_SCALE, W8_SCALE};
#pragma unroll
            for (int i = 0; i < 4; ++i) T[(4 * ln + i) * 32 + col] = pk4_fp8(v[half][s][0][i] * sc[0], v[half][s][1][i] * sc[1], v[half][s][2][i] * sc[2], v[half][s][3][i] * sc[3]); }
    LDS_WAIT(); asm volatile("" ::: "memory");
    const int c = lane & 7;
#pragma unroll
    for (int j = 0; j < 8; ++j) { const int rho = (lane >> 3) + 8 * j, h = rho >> 5, r32 = rho & 31; const int n = h * 32 + (perm ? perm32(r32) : r32);
        u32x4 v4 = *(const LAS u32x4*)(T + n * 32 + 4 * (c ^ (n >> 3)));
        if ((n >> 2) & 1) v4 = (u32x4){v4.z, v4.w, v4.x, v4.y};
        if (PMODE == 2) asm volatile("" :: "v"(v4)); else *(GAS u32x4*)(dst + (size_t)(drow0 + rho) * dpitch + k0 + 16 * c) = v4; }
    LDS_WAIT(); asm volatile("" ::: "memory");
}
__device__ __forceinline__ int win_src(int G, bool& perm) {
    const int pn = G >> 3, gi = G & 7; perm = true;
    if (pn < 4) return C_Q + pn * 256 + gi * 32;
    if (pn < 8) { perm = false; return C_F + (pn - 4) * 256 + gi * 32; }
    if (pn < 12) return C_V + (pn - 8) * 256 + gi * 32;
    if (pn < 16) return C_G + (pn - 12) * 256 + gi * 32;
    if (pn < 24) return (gi < 4 ? C_SV : C_SC) + (pn - 16) * 128 + (gi & 3) * 32;
    if (pn < 28) return C_SB + (pn - 24) * 256 + gi * 32;
    return (gi < 4 ? C_GA : C_GB) + (pn - 28) * 128 + (gi & 3) * 32;
}
__device__ __forceinline__ void p0_prologue(Frame& F) {
    const int gw = F.vcu * NWAVES + F.wave, NGW = F.G * NWAVES, gt = F.vcu * NTHR + F.tid, NGT = F.G * NTHR;
    for (int i = gt; i < HF; i += NGT) wsp<float>(F, WS_LB)[i] = 1.f / (1.f + __expf(F.lbl[HF + i] - F.lbl[i]));
    for (int i = gt; i < D * NE; i += NGT) { const int k = i >> 5, e = i & 31; const float v = F.w_r[i] * F.nfw[k]; const unsigned h = f2bf(v); const float lo = v - bf2f((unsigned short)h);
        wsp<bf16_t>(F, WS_WRH)[e * D + k] = (bf16_t)h; wsp<bf16_t>(F, WS_WRL)[e * D + k] = (bf16_t)f2bf(lo); }
    for (int i = gt; i < 48 * HF; i += NGT) { wsp<h16_t>(F, WS_LFM)[i] = (h16_t)0.f; wsp<bf16_t>(F, WS_VVM)[i] = 0; }
    {
        LAS float* hnm = (LAS float*)F.lds;
        for (int r = F.wave * 2; r < F.wave * 2 + 2; ++r) {
            const f32x4* xr = (const f32x4*)(F.meta + (size_t)r * D) + F.lane; f32x4 v[8]; float s = 0.f;
#pragma unroll
            for (int j = 0; j < 8; ++j) { v[j] = xr[64 * j]; s += (v[j].x * v[j].x + v[j].y * v[j].y) + (v[j].z * v[j].z + v[j].w * v[j].w); }
            const float rs = rsqrtf(wave_sum(s) * (1.f / D) + EPS);
#pragma unroll
            for (int j = 0; j < 8; ++j) { const f32x4 w = ((const f32x4*)F.nmw)[F.lane + 64 * j]; *(LAS f32x4*)(hnm + r * D + 4 * F.lane + 256 * j) = v[j] * rs * w; }
        }
        __syncthreads();
        LAS float* red = (LAS float*)(F.lds + TOK_OFF);
        for (int cb = F.vcu; cb < 256; cb += F.G) {
            const int col = F.tid & 15, ks = F.tid >> 4;
            int gcol;
            if (cb < 64) gcol = C_F + 16 * cb + col; else if (cb < 128) gcol = C_V + 16 * (cb - 64) + col; else gcol = (col < 8 ? C_SV : C_SC) + 8 * (cb - 128) + (col & 7);
            float a[16];
#pragma unroll
            for (int r = 0; r < 16; ++r) a[r] = 0.f;
#pragma unroll 8
            for (int k = ks * 64; k < ks * 64 + 64; ++k) { const float w = F.w_in[(size_t)k * INC + gcol];
#pragma unroll
                for (int r = 0; r < 16; ++r) a[r] = fmaf(hnm[r * D + k], w, a[r]); }
#pragma unroll
            for (int r = 0; r < 16; ++r) { a[r] += __shfl_xor(a[r], 16); a[r] += __shfl_xor(a[r], 32); }
            if (F.lane < 16) {
#pragma unroll
                for (int r = 0; r < 16; ++r) red[(F.wave * 16 + r) * 16 + col] = a[r]; }
            __syncthreads();
            if (F.tid < 256) { const int r = F.tid >> 4, c = F.tid & 15; float v = 0.f;
#pragma unroll
                for (int w = 0; w < 8; ++w) v += red[(w * 16 + r) * 16 + c];
                if (cb < 64) { const int ch = 16 * cb + c; const float l = 1.f / (1.f + __expf(F.lbl[HF + ch] - F.lbl[ch])); wsp<h16_t>(F, WS_LFM)[(48 + r) * HF + ch] = (h16_t)__logf(l + (1.f - l) * sigmoidf_(v)); }
                else if (cb < 128) wsp<bf16_t>(F, WS_VVM)[(48 + r) * HF + 16 * (cb - 64) + c] = (bf16_t)f2bf(v);
                else red[2048 + r * 16 + c] = v; }
            __syncthreads();
            if (cb >= 128 && F.tid < 128) { const int r = F.tid >> 3, c = F.tid & 7; wsp<bf16_t>(F, WS_UUM)[r * HF + 8 * (cb - 128) + c] = (bf16_t)f2bf(red[2048 + r * 16 + c] * red[2048 + r * 16 + c + 8]); }
            __syncthreads();
        }
        __syncthreads();
    }
    {
        LAS unsigned* T = (LAS unsigned*)(F.lds + F.wave * 16384);
        constexpr int I_IN = 32 * 4 * N_INB, I_AB = 16 * 32, I_O = 32 * 32, I_UP1 = 16 * 64, I_DN1 = 16 * 32;
        constexpr int I_IN8 = 16 * 4 * N_IN8;
        constexpr int NIT = I_IN + I_IN8 + 2 * I_AB + I_O;
        for (int it = gw; it < NIT; it += NGW) {
            int r = it;
            if (r < I_IN) { const int kb = r / (4 * N_INB), ntl = r % (4 * N_INB), nt = 4 * nth_bit(INB_MASK, ntl >> 2) + (ntl & 3); bool p0, p1; const int s0 = win_src(2 * nt, p0), s1 = win_src(2 * nt + 1, p1); tr_tile(F.w_in, INC, kb * 64, s0, s1, p0, p1, F.nmw, wsp<bf16_t>(F, WS_WIN), D, nt * 64, 0, T, F.lane); continue; } r -= I_IN;
            if (r < I_IN8) { const int kb = r / (4 * N_IN8), ntl = r % (4 * N_IN8), nt = 4 * nth_bit(IN8_MASK, ntl >> 2) + (ntl & 3); bool p0, p1; const int s0 = win_src(2 * nt, p0), s1 = win_src(2 * nt + 1, p1);
                tr_tile_fp8<0>(F.w_in, INC, kb * 128, s0, s1, F.nmw, wsp<unsigned char>(F, WS_WIN8), D, nt * 64, T, F.lane, p0); continue; } r -= I_IN8;
            if (r < I_AB) { const int kb = r / 32, nt = r % 32; tr_tile(F.w_ho, D, kb * 64, nt * 64, nt * 64 + 32, true, true, nullptr, wsp<bf16_t>(F, WS_WAB), D, nt * 64, 0, T, F.lane); continue; } r -= I_AB;
            if (r < I_AB) { const int kb = r / 32, nt = r % 32; tr_tile(F.w_co, D, kb * 64, nt * 64, nt * 64 + 32, true, true, nullptr, wsp<bf16_t>(F, WS_WAB), D, nt * 64, HF, T, F.lane); continue; } r -= I_AB;
            if (r < I_O) { const int kb = r / 32, nt = r % 32; tr_tile(F.w_o, D, kb * 64, nt * 64, nt * 64 + 32, true, true, nullptr, wsp<bf16_t>(F, WS_WO), D, nt * 64, 0, T, F.lane); continue; } r -= I_O;
        }
    }
    for (int m = gw; m < M; m += NGW) {
        const GAS f32x4* xr = (const GAS f32x4*)(F.x + (size_t)m * D) + F.lane; f32x4 v[8]; float s = 0.f;
#pragma unroll
        for (int j = 0; j < 8; ++j) v[j] = xr[64 * j];
        __builtin_amdgcn_sched_barrier(0);
#pragma unroll
        for (int j = 0; j < 8; ++j) s += (v[j].x * v[j].x + v[j].y * v[j].y) + (v[j].z * v[j].z + v[j].w * v[j].w);
        s = wave_sum(s);
        const float rsx = rsqrtf(s * (1.f / D) + EPS);
#pragma unroll
        for (int j = 0; j < 8; ++j) v[j] *= rsx;
        GAS u32x2* o8 = (GAS u32x2*)(wsp<bf16_t>(F, WS_XB) + (size_t)m * D) + F.lane;
#pragma unroll
        for (int j = 0; j < 8; ++j) { u32x2 w; w.x = pk2(v[j].x, v[j].y); w.y = pk2(v[j].z, v[j].w); o8[64 * j] = w; }
        GAS unsigned* o4 = (GAS unsigned*)(wsp<unsigned char>(F, WS_XB8) + (size_t)m * D) + F.lane;
#pragma unroll
        for (int j = 0; j < 8; ++j) o4[64 * j] = pk4_fp8(v[j].x, v[j].y, v[j].z, v[j].w);
    }
}

template <int PMODE = 0> __device__ __forceinline__ void p1_convert(Frame& F, int rank, int nconv) {
    LAS unsigned* T = (LAS unsigned*)(F.lds + F.wave * 16384);
    constexpr int I_UP1 = 16 * 64, I_DN1 = 16 * 32, NIT = NE * (I_UP1 + I_DN1);
    for (int it = rank * NWAVES + F.wave; it < NIT; it += nconv * NWAVES) {
        int r = it;
        if (r < NE * I_UP1) { const int e = r / I_UP1, q = r % I_UP1, kb = q / 64, nt = q % 64, G0 = 2 * nt, pn = G0 >> 3, gi = G0 & 7; const int s0 = (gi < 4 ? 0 : 2048) + pn * 128 + (gi & 3) * 32;
            tr_tile_fp8<PMODE>(F.w_up + (size_t)e * D * 4096, 4096, kb * 128, s0, s0 + 32, F.nfw, wsp<unsigned char>(F, WS_WUP) + (size_t)e * 4096 * D, D, nt * 64, T, F.lane); continue; } r -= NE * I_UP1;
        { const int e = r / I_DN1, q = r % I_DN1, kb = q / 32, nt = q % 32;
          tr_tile_fp8<PMODE>(F.w_dn + (size_t)e * DFF * D, D, kb * 128, nt * 64, nt * 64 + 32, nullptr, wsp<unsigned char>(F, WS_WDN) + (size_t)e * D * DFF, DFF, nt * 64, T, F.lane); }
    }
}

constexpr int KTP = 72;
constexpr int QP_ = 136;
__device__ __forceinline__ void vt_load(const Frame& F, const bf16_t* Vb, size_t row0, int h, u32x4 (&w)[2]) {
#pragma unroll
    for (int q = 0; q < 2; ++q) { const int id = F.tid + 512 * q, t = id >> 4, v8 = (id & 15) * 8; w[q] = *(const GAS u32x4*)(Vb + (row0 + t) * HF + h * 128 + v8); }
}
__device__ __forceinline__ void vt_store(const Frame& F, const u32x4 (&w)[2], LAS bf16_t* VT) {
#pragma unroll
    for (int q = 0; q < 2; ++q) { const int id = F.tid + 512 * q, t = id >> 4, v8 = (id & 15) * 8; const unsigned ww[4] = {w[q].x, w[q].y, w[q].z, w[q].w};
        const int ts = t ^ (v8 & 24);
#pragma unroll
        for (int i = 0; i < 4; ++i) { VT[(v8 + 2 * i) * KTP + ts] = (bf16_t)(ww[i] & 0xffffu); VT[(v8 + 2 * i + 1) * KTP + ts] = (bf16_t)(ww[i] >> 16); } }
}
__device__ __forceinline__ int vt_off(int v, int t0) { return v * KTP + (t0 ^ (v & 24)); }
struct P2aRegs { float L[16]; u32x4 vw[2]; };
__device__ __forceinline__ void p2a_where(const Frame& F, int u, const h16_t*& Lb, const bf16_t*& Vb, size_t& row0, int& h, int& slot) {
    if (u < 8) { Lb = wsp<h16_t>(F, WS_LFM); Vb = wsp<bf16_t>(F, WS_VVM); row0 = 0; h = u; slot = 32 * 64 + u; }
    else { const int bh = (u - 8) >> 6, c = (u - 8) & 63, b = bh >> 3; h = bh & 7; Lb = wsp<h16_t>(F, WS_LF); Vb = wsp<bf16_t>(F, WS_VV); row0 = (size_t)b * SEQ + 64 * c; slot = bh * 64 + c; }
}
__device__ __forceinline__ void p2a_load(const Frame& F, int u, P2aRegs& R) {
    const h16_t* Lb; const bf16_t* Vb; size_t row0; int h, slot; p2a_where(F, u, Lb, Vb, row0, h, slot);
    const int d = F.tid & 127, tq = F.tid >> 7;
#pragma unroll
    for (int i = 0; i < 16; ++i) R.L[i] = (float)Lb[(row0 + 16 * tq + i) * HF + h * 128 + d];
    vt_load(F, Vb, row0, h, R.vw);
}
__device__ __forceinline__ void p2a_compute(Frame& F, int u, const P2aRegs& R) {
    LAS bf16_t* KT = (LAS bf16_t*)F.lds; LAS bf16_t* VT = KT + 128 * KTP; LAS float* TOT = (LAS float*)(F.lds + 2 * 128 * KTP * 2);
    const h16_t* Lb; const bf16_t* Vb; size_t row0; int h, slot; p2a_where(F, u, Lb, Vb, row0, h, slot);
    const int d = F.tid & 127, tq = F.tid >> 7;
    float cs[16]; float run = 0.f;
#pragma unroll
    for (int i = 0; i < 16; ++i) { run += R.L[i]; cs[i] = run; }
    TOT[tq * 128 + d] = run;
    vt_store(F, R.vw, VT);
    __syncthreads();
    float off = 0.f, total = 0.f;
#pragma unroll
    for (int q = 0; q < 4; ++q) { const float tv = TOT[q * 128 + d]; total += tv; if (q < tq) off += tv; }
#pragma unroll
    for (int i = 0; i < 16; i += 2) { const float k0 = (1.f - __expf(R.L[i])) * __expf(total - off - cs[i]), k1 = (1.f - __expf(R.L[i + 1])) * __expf(total - off - cs[i + 1]);
        *(LAS unsigned*)(KT + d * KTP + 16 * tq + i) = pk2(k0, k1); }
    if (tq == 0) wsp<float>(F, WS_DEC)[(size_t)slot * 128 + d] = __expf(total);
    __syncthreads();
    {
        const int w = F.wave, fr = F.lane & 15, fq = F.lane >> 4;
        bf16x8 a[2];
#pragma unroll
        for (int ks = 0; ks < 2; ++ks) a[ks] = *(const LAS bf16x8*)(KT + (16 * w + fr) * KTP + 32 * ks + 8 * fq);
        bf16_t* Ub = wsp<bf16_t>(F, WS_UC) + (size_t)slot * 16384;
#pragma unroll
        for (int vb = 0; vb < 8; ++vb) { f32x4 c = (f32x4){0.f, 0.f, 0.f, 0.f};
#pragma unroll
            for (int ks = 0; ks < 2; ++ks) { const bf16x8 bv = *(const LAS bf16x8*)(VT + vt_off(16 * vb + fr, 32 * ks + 8 * fq)); c = __builtin_amdgcn_mfma_f32_16x16x32_bf16(a[ks], bv, c, 0, 0, 0); }
            u32x2 o; o.x = pk2(c[0], c[1]); o.y = pk2(c[2], c[3]);
            *(GAS u32x2*)(Ub + (16 * vb + fr) * 128 + 16 * w + 4 * fq) = o; }
    }
    __syncthreads();
}
__device__ __forceinline__ void p2a_units(Frame& F, int c) {
    constexpr int NU = 2048 + 8;
    if (c >= NU) return;
    P2aRegs R; p2a_load(F, c, R);
    for (int u = c; u < NU; u += F.G) {
        P2aRegs N; const int un = u + F.G; if (un < NU) p2a_load(F, un, N); else N = R;
        p2a_compute(F, u, R);
        R = N;
    }
}
__device__ __forceinline__ void p2a_conv(Frame& F, int item) {
    const int c8 = (F.tid & 127) * 8, tq = F.tid >> 7, r0 = item * 64 + tq * 16, p0 = r0 & (SEQ - 1);
    const bf16_t* UU = wsp<bf16_t>(F, WS_UU); const bf16_t* UUM = wsp<bf16_t>(F, WS_UUM); const bf16_t* SBb = wsp<bf16_t>(F, WS_SB); bf16_t* A2 = wsp<bf16_t>(F, WS_A2);
    f32x4 w0a = *(const f32x4*)(F.cw + c8), w0b = *(const f32x4*)(F.cw + c8 + 4), w1a = *(const f32x4*)(F.cw + HF + c8), w1b = *(const f32x4*)(F.cw + HF + c8 + 4), w2a = *(const f32x4*)(F.cw + 2 * HF + c8), w2b = *(const f32x4*)(F.cw + 2 * HF + c8 + 4);
    f32x4 um2a, um2b, um1a, um1b;
    { const u32x4 a = (p0 >= 2) ? *(const GAS u32x4*)(UU + (size_t)(r0 - 2) * HF + c8) : *(const GAS u32x4*)(UUM + (14 + p0) * HF + c8); unpack8(a, um2a, um2b);
      const u32x4 b = (p0 >= 1) ? *(const GAS u32x4*)(UU + (size_t)(r0 - 1) * HF + c8) : *(const GAS u32x4*)(UUM + 15 * HF + c8); unpack8(b, um1a, um1b); }
#pragma unroll 4
    for (int i = 0; i < 16; ++i) { f32x4 ua, ub, sa, sb; unpack8(*(const GAS u32x4*)(UU + (size_t)(r0 + i) * HF + c8), ua, ub); unpack8(*(const GAS u32x4*)(SBb + (size_t)(r0 + i) * HF + c8), sa, sb);
        const f32x4 oa = sa * (w0a * um2a + w1a * um1a + w2a * ua), ob = sb * (w0b * um2b + w1b * um1b + w2b * ub);
        *(GAS u32x4*)(A2 + (size_t)(r0 + i) * D + HF + c8) = pack8(oa, ob);
        um2a = um1a; um2b = um1b; um1a = ua; um1b = ub; }
}
__device__ __forceinline__ void p2b_scan(Frame& F) {
    const int gw = F.vcu * NWAVES + F.wave;
    for (int it = gw; it < 1024; it += F.G * NWAVES) {
        const int item = it * 64 + F.lane, bh = item >> 11, e8 = item & 2047, h = bh & 7, d0 = (e8 & 15) * 8;
        const bf16_t* Ub = wsp<bf16_t>(F, WS_UC) + (size_t)bh * 64 * 16384 + e8 * 8; bf16_t* Sb = wsp<bf16_t>(F, WS_SS) + (size_t)bh * 64 * 16384 + e8 * 8;
        const float* Db = wsp<float>(F, WS_DEC) + (size_t)bh * 64 * 128 + d0;
        f32x4 s0, s1; unpack8(*(const GAS u32x4*)(wsp<bf16_t>(F, WS_UC) + (size_t)(32 * 64 + h) * 16384 + e8 * 8), s0, s1);
#pragma unroll 8
        for (int c = 0; c < 64; ++c) {
            *(GAS u32x4*)(Sb + (size_t)c * 16384) = pack8(s0, s1);
            f32x4 u0, u1; unpack8(*(const GAS u32x4*)(Ub + (size_t)c * 16384), u0, u1);
            const f32x4 g0 = *(const GAS f32x4*)(Db + c * 128), g1 = *(const GAS f32x4*)(Db + c * 128 + 4);
            s0 = g0 * s0 + u0; s1 = g1 * s1 + u1;
        }
    }
}
struct P2cRegs { f32x2 L[8]; unsigned qw[8]; u32x4 vw[2]; bf16x8 sa[4]; u32x2 gv[4]; };
__device__ __forceinline__ void p2c_load(const Frame& F, int u, P2cRegs& R) {
    const int bh = u >> 6, c = u & 63, b = bh >> 3, h = bh & 7; const size_t row0 = (size_t)b * SEQ + 64 * c;
    const int dp = (F.tid & 63) * 2, t8 = F.tid >> 6, w = F.wave, fr = F.lane & 15, fq = F.lane >> 4;
    const h16_t* Lb = wsp<h16_t>(F, WS_LF) + (row0 + 8 * t8) * HF + h * 128 + dp; const bf16_t* Qb = wsp<bf16_t>(F, WS_QS) + (row0 + 8 * t8) * HF + h * 128 + dp;
#pragma unroll
    for (int i = 0; i < 8; ++i) { const h16x2 lh = *(const GAS h16x2*)(Lb + (size_t)i * HF); R.L[i] = (f32x2){(float)lh.x, (float)lh.y}; R.qw[i] = *(const GAS unsigned*)(Qb + (size_t)i * HF); }
    vt_load(F, wsp<bf16_t>(F, WS_VV), row0, h, R.vw);
    const bf16_t* Sb = wsp<bf16_t>(F, WS_SS) + ((size_t)bh * 64 + c) * 16384 + (16 * w + fr) * 128 + 8 * fq;
#pragma unroll
    for (int ks = 0; ks < 4; ++ks) R.sa[ks] = *(const GAS bf16x8*)(Sb + 32 * ks);
    const bf16_t* GSb = wsp<bf16_t>(F, WS_GS);
#pragma unroll
    for (int tb = 0; tb < 4; ++tb) R.gv[tb] = *(const GAS u32x2*)(GSb + (row0 + 16 * tb + fr) * HF + h * 128 + 16 * w + 4 * fq);
}
__device__ __forceinline__ void p2c_compute(Frame& F, int u, const P2cRegs& R) {
    const int bh = u >> 6, c = u & 63, b = bh >> 3, h = bh & 7; const size_t row0 = (size_t)b * SEQ + 64 * c;
    LAS bf16_t* QPl = (LAS bf16_t*)F.lds; LAS bf16_t* QD = QPl + 64 * QP_; LAS bf16_t* KI = QD + 64 * QP_; LAS bf16_t* VT = KI + 160 * QP_; LAS bf16_t* PL = VT + 128 * KTP;
    LAS float* TOT8 = (LAS float*)(PL + 64 * KTP); LAS float* SSQ = TOT8 + 8 * 128;
    const int dp = (F.tid & 63) * 2, t8 = F.tid >> 6;
    f32x2 L[8], cs[8], q[8]; f32x2 run = (f32x2){0.f, 0.f};
#pragma unroll
    for (int i = 0; i < 8; ++i) { L[i] = R.L[i]; q[i] = (f32x2){bflo(R.qw[i]), bfhi(R.qw[i])}; }
#pragma unroll
    for (int i = 0; i < 8; ++i) { run += L[i]; cs[i] = run; }
    *(LAS f32x2*)(TOT8 + t8 * 128 + dp) = run;
    vt_store(F, R.vw, VT);
    for (int i = F.tid; i < 64 * KTP / 2; i += NTHR) ((LAS unsigned*)PL)[i] = 0u;
    __syncthreads();
    {
        f32x2 pre[9]; pre[0] = (f32x2){0.f, 0.f};
#pragma unroll
        for (int j = 0; j < 8; ++j) pre[j + 1] = pre[j] + *(const LAS f32x2*)(TOT8 + j * 128 + dp);
        f32x2 off = (f32x2){0.f, 0.f};
#pragma unroll
        for (int j = 0; j < 8; ++j) if (j == t8) off = pre[j];
        const int si = t8 >> 1;
        f32x2 st[4];
#pragma unroll
        for (int j = 0; j < 4; ++j) st[j] = pre[2 * j];
        f32x2 sti = st[0];
#pragma unroll
        for (int j = 1; j < 4; ++j) if (j == si) sti = st[j];
#pragma unroll
        for (int i = 0; i < 8; ++i) { const int t = 8 * t8 + i; const f32x2 bc = off + cs[i];
            *(LAS unsigned*)(QPl + t * QP_ + dp) = pk2(q[i].x * __expf(bc.x), q[i].y * __expf(bc.y));
            *(LAS unsigned*)(QD + t * QP_ + dp) = pk2(q[i].x * __expf(bc.x - sti.x), q[i].y * __expf(bc.y - sti.y));
            const f32x2 k = (f32x2){1.f - __expf(L[i].x), 1.f - __expf(L[i].y)};
#pragma unroll
            for (int j = 0; j < 4; ++j) if (j >= si) {
                *(LAS unsigned*)(KI + (8 * j * (j + 1) + t) * QP_ + dp) = pk2(k.x * __expf(fminf(st[j].x - bc.x, 80.f)), k.y * __expf(fminf(st[j].y - bc.y, 80.f))); }
        }
    }
    __syncthreads();
    const int w = F.wave, fr = F.lane & 15, fq = F.lane >> 4;
    for (int bi = w; bi < 10; bi += 8) {
        const int i = bi < 1 ? 0 : bi < 3 ? 1 : bi < 6 ? 2 : 3, j = bi - (i * (i + 1)) / 2;
        f32x4 cacc = (f32x4){0.f, 0.f, 0.f, 0.f};
#pragma unroll
        for (int ks = 0; ks < 4; ++ks) { const bf16x8 a = *(const LAS bf16x8*)(KI + (8 * i * (i + 1) + 16 * j + fr) * QP_ + 32 * ks + 8 * fq), bq = *(const LAS bf16x8*)(QD + (16 * i + fr) * QP_ + 32 * ks + 8 * fq);
            cacc = __builtin_amdgcn_mfma_f32_16x16x32_bf16(a, bq, cacc, 0, 0, 0); }
        if (i == j) {
#pragma unroll
            for (int r = 0; r < 4; ++r) if (4 * fq + r > fr) cacc[r] = 0.f; }
        u32x2 o; o.x = pk2(cacc[0], cacc[1]); o.y = pk2(cacc[2], cacc[3]);
        *(LAS u32x2*)(PL + (16 * i + fr) * KTP + 16 * j + 4 * fq) = o;
    }
    __syncthreads();
    f32x4 acc[4];
#pragma unroll
    for (int tb = 0; tb < 4; ++tb) acc[tb] = (f32x4){0.f, 0.f, 0.f, 0.f};
    {
#pragma unroll
        for (int ks = 0; ks < 4; ++ks)
#pragma unroll
            for (int tb = 0; tb < 4; ++tb) { const bf16x8 bq = *(const LAS bf16x8*)(QPl + (16 * tb + fr) * QP_ + 32 * ks + 8 * fq); acc[tb] = __builtin_amdgcn_mfma_f32_16x16x32_bf16(R.sa[ks], bq, acc[tb], 0, 0, 0); }
#pragma unroll
        for (int ks = 0; ks < 2; ++ks) { const bf16x8 va = *(const LAS bf16x8*)(VT + vt_off(16 * w + fr, 32 * ks + 8 * fq));
#pragma unroll
            for (int tb = 0; tb < 4; ++tb) { const bf16x8 bp = *(const LAS bf16x8*)(PL + (16 * tb + fr) * KTP + 32 * ks + 8 * fq); acc[tb] = __builtin_amdgcn_mfma_f32_16x16x32_bf16(va, bp, acc[tb], 0, 0, 0); } }
    }
#pragma unroll
    for (int tb = 0; tb < 4; ++tb) { float p = (acc[tb][0] * acc[tb][0] + acc[tb][1] * acc[tb][1]) + (acc[tb][2] * acc[tb][2] + acc[tb][3] * acc[tb][3]); p += __shfl_xor(p, 16); p += __shfl_xor(p, 32);
        if (fq == 0) SSQ[w * 64 + 16 * tb + fr] = p; }
    __syncthreads();
    {
        const f32x4 gw4 = *(const f32x4*)(F.gnw + 16 * w + 4 * fq);
        bf16_t* A2 = wsp<bf16_t>(F, WS_A2);
#pragma unroll
        for (int tb = 0; tb < 4; ++tb) { const int t = 16 * tb + fr; float ss = 0.f;
#pragma unroll
            for (int ww = 0; ww < 8; ++ww) ss += SSQ[ww * 64 + t];
            const float rs = rsqrtf(ss * (1.f / 128.f) + EPS);
            const u32x2 gv = R.gv[tb];
            const f32x4 o = acc[tb] * rs * gw4 * (f32x4){bflo(gv.x), bfhi(gv.x), bflo(gv.y), bfhi(gv.y)};
            u32x2 ov; ov.x = pk2(o[0], o[1]); ov.y = pk2(o[2], o[3]);
            *(GAS u32x2*)(A2 + (row0 + t) * D + h * 128 + 16 * w + 4 * fq) = ov; }
    }
    __syncthreads();
}
__device__ __forceinline__ void p2c_units(Frame& F, int c) {
    constexpr int NU = 2048;
    if (c >= NU) return;
    P2cRegs R; p2c_load(F, c, R);
    for (int u = c; u < NU; u += F.G) {
        P2cRegs N; const int un = u + F.G; if (un < NU) p2c_load(F, un, N); else N = R;
        p2c_compute(F, u, R);
        R = N;
    }
}

__device__ __forceinline__ void split8(const f32x4 a, const f32x4 b, bf16x8& hi, bf16x8& lo) {
    u32x4 h, l;
    h.x = cvt_pk_bf16(a[0], a[1]); h.y = cvt_pk_bf16(a[2], a[3]); h.z = cvt_pk_bf16(b[0], b[1]); h.w = cvt_pk_bf16(b[2], b[3]);
    l.x = cvt_pk_bf16(a[0] - bflo(h.x), a[1] - bfhi(h.x)); l.y = cvt_pk_bf16(a[2] - bflo(h.y), a[3] - bfhi(h.y)); l.z = cvt_pk_bf16(b[0] - bflo(h.z), b[1] - bfhi(h.z)); l.w = cvt_pk_bf16(b[2] - bflo(h.w), b[3] - bfhi(h.w));
    hi = __builtin_bit_cast(bf16x8, h); lo = __builtin_bit_cast(bf16x8, l);
}
__device__ __forceinline__ void p5_router(Frame& F) {
    const int fr = F.lane & 15, fq = F.lane >> 4, wq = F.wave & 3, kh = F.wave >> 2;
    LAS float* lg = (LAS float*)(F.lds + F.wave * 4096);
    LAS float* pa = (LAS float*)(F.lds + 32768) + (wq * 64 + F.lane) * 9;
    const bf16_t* DL = wsp<bf16_t>(F, WS_H1); unsigned char* H1B = wsp<unsigned char>(F, WS_H1B); const bf16_t* WH = wsp<bf16_t>(F, WS_WRH); const bf16_t* WL = wsp<bf16_t>(F, WS_WRL);
    for (int it = F.vcu * 4 + wq; it < M / 16; it += F.G * 4) {
        const int row0 = it * 16, kofs = 1024 * kh;
        const float* hp = F.x + (size_t)(row0 + fr) * D + kofs + 8 * fq; const bf16_t* dp_ = DL + (size_t)(row0 + fr) * D + kofs + 8 * fq; unsigned char* qp = H1B + (size_t)(row0 + fr) * D + kofs + 8 * fq;
        const bf16_t* wh0 = WH + (size_t)fr * D + kofs + 8 * fq; const bf16_t* wl0 = WL + (size_t)fr * D + kofs + 8 * fq;
        f32x4 a0 = (f32x4){0.f, 0.f, 0.f, 0.f}, a1 = a0; float ss = 0.f;
#pragma unroll 4
        for (int ks = 0; ks < 32; ++ks) {
            f32x4 xa = *(const GAS f32x4*)(hp + 32 * ks), xb = *(const GAS f32x4*)(hp + 32 * ks + 4); { f32x4 da, db; unpack8(*(const GAS u32x4*)(dp_ + 32 * ks), da, db); xa += da; xb += db; }
            *(GAS u32x2*)(qp + 32 * ks) = pack8_fp8(xa, xb);
            *(GAS u32x4*)((bf16_t*)dp_ + 32 * ks) = pack8(xa, xb);
            ss += (xa[0] * xa[0] + xa[1] * xa[1]) + (xa[2] * xa[2] + xa[3] * xa[3]) + (xb[0] * xb[0] + xb[1] * xb[1]) + (xb[2] * xb[2] + xb[3] * xb[3]);
            bf16x8 xh, xl; split8(xa, xb, xh, xl);
            const bf16x8 bh0 = *(const GAS bf16x8*)(wh0 + 32 * ks), bl0 = *(const GAS bf16x8*)(wl0 + 32 * ks), bh1 = *(const GAS bf16x8*)(wh0 + 16 * D + 32 * ks), bl1 = *(const GAS bf16x8*)(wl0 + 16 * D + 32 * ks);
            a0 = __builtin_amdgcn_mfma_f32_16x16x32_bf16(xh, bh0, a0, 0, 0, 0); a0 = __builtin_amdgcn_mfma_f32_16x16x32_bf16(xh, bl0, a0, 0, 0, 0);
            a0 = __builtin_amdgcn_mfma_f32_16x16x32_bf16(xl, bh0, a0, 0, 0, 0); a0 = __builtin_amdgcn_mfma_f32_16x16x32_bf16(xl, bl0, a0, 0, 0, 0);
            a1 = __builtin_amdgcn_mfma_f32_16x16x32_bf16(xh, bh1, a1, 0, 0, 0); a1 = __builtin_amdgcn_mfma_f32_16x16x32_bf16(xh, bl1, a1, 0, 0, 0);
            a1 = __builtin_amdgcn_mfma_f32_16x16x32_bf16(xl, bh1, a1, 0, 0, 0); a1 = __builtin_amdgcn_mfma_f32_16x16x32_bf16(xl, bl1, a1, 0, 0, 0);
        }
        if (kh == 1) {
#pragma unroll
            for (int r = 0; r < 4; ++r) { pa[r] = a0[r]; pa[4 + r] = a1[r]; }
            pa[8] = ss; }
        __syncthreads();
        if (kh == 0) {
#pragma unroll
            for (int r = 0; r < 4; ++r) { a0[r] += pa[r]; a1[r] += pa[4 + r]; }
            ss += pa[8];
            ss += __shfl_xor(ss, 16); ss += __shfl_xor(ss, 32);
#pragma unroll
            for (int r = 0; r < 4; ++r) { lg[(4 * fq + r) * 33 + fr] = a0[r]; lg[(4 * fq + r) * 33 + 16 + fr] = a1[r]; }
            LDS_WAIT(); asm volatile("" ::: "memory");
            if (F.lane < 16) {
                const int tokn = row0 + F.lane; const float rs = rsqrtf(ss * (1.f / D) + EPS);
                float v[32];
#pragma unroll
                for (int e = 0; e < 32; ++e) v[e] = lg[F.lane * 33 + e] * rs + F.b_r[e];
                int idx[4]; float val[4];
#pragma unroll
                for (int k = 0; k < 4; ++k) { float bv = -3.0e38f; int bi = 0;
#pragma unroll
                    for (int e = 0; e < 32; ++e) { const bool tk = v[e] > bv; bv = tk ? v[e] : bv; bi = tk ? e : bi; }
                    idx[k] = bi; val[k] = bv;
#pragma unroll
                    for (int e = 0; e < 32; ++e) v[e] = (e == bi) ? -3.0e38f : v[e]; }
                float ex[4], den = 0.f;
#pragma unroll
                for (int k = 0; k < 4; ++k) { ex[k] = __expf(val[k] - val[0]); den += ex[k]; }
                const float inv = 1.f / den;
                wsp<float>(F, WS_RS2)[tokn] = rs;
                int pos[4];
#pragma unroll
                for (int k = 0; k < 4; ++k) pos[k] = (int)__hip_atomic_fetch_add(F.ctl + CW_CNT + 64 * idx[k], 1u, __ATOMIC_RELAXED, __HIP_MEMORY_SCOPE_AGENT);
#pragma unroll
                for (int k = 0; k < 4; ++k) {
                    wsp<int>(F, WS_TOPE)[tokn * 4 + k] = idx[k]; wsp<int>(F, WS_TOPP)[tokn * 4 + k] = pos[k]; wsp<float>(F, WS_TOPW)[tokn * 4 + k] = ex[k] * inv;
                    wsp<int>(F, WS_LIST)[(size_t)idx[k] * CAPF + pos[k]] = tokn; }
            }
        }
        __syncthreads();
    }
}
__device__ __forceinline__ void build_pref(Frame& F) {
    if (F.wave == 0) {
        int tl = 0;
        if (F.lane < NE) { const unsigned c = __hip_atomic_load(F.ctl + CW_CNT + 64 * F.lane, RLX_AGENT); tl = (int)((c + 255u) >> 8); }
        int s = tl;
#pragma unroll
        for (int d = 1; d < 32; d <<= 1) { const int v = __shfl_up(s, d); if (F.lane >= d) s += v; }
        if (F.lane < NE) F.MISC[16 + F.lane] = (unsigned)(s - tl);
        if (F.lane == NE - 1) F.MISC[16 + NE] = (unsigned)(s < MAXRT ? s : MAXRT); }
    __syncthreads();
}
__device__ __forceinline__ void build_tok(Frame& F, const MoeOrder& S) {
    LAS int* tokt = (LAS int*)(F.lds + TOK_OFF);
    volatile LAS int* um = (volatile LAS int*)(F.MISC + 64);
    if (F.tid < 18) { Unit u; int base = -1, nv = 0;
        if (S.template next<false>(F.tid, u)) { const int rt = u.pm - (int)F.MISC[16 + u.e]; const int cnt = (int)__hip_atomic_load(F.ctl + CW_CNT + 64 * u.e, RLX_AGENT);
            base = u.e * CAPF + rt * 256; nv = cnt - rt * 256; nv = nv < 0 ? 0 : (nv > 256 ? 256 : nv); }
        um[2 * F.tid] = base; um[2 * F.tid + 1] = nv; }
    __syncthreads();
    if (F.tid < 256) { int t[18]; float r[18]; const int* LIST = wsp<int>(F, WS_LIST); const float* RS2 = wsp<float>(F, WS_RS2);
#pragma unroll
        for (int i = 0; i < 18; ++i) { const int base = um[2 * i], nv = um[2 * i + 1]; t[i] = (base >= 0 && F.tid < nv) ? LIST[base + F.tid] : -1; }
#pragma unroll
        for (int i = 0; i < 18; ++i) r[i] = (t[i] >= 0) ? RS2[t[i]] * W8_INV : 0.f;
#pragma unroll
        for (int i = 0; i < 18; ++i) if (um[2 * i] >= 0) tokt[i * 256 + F.tid] = (int)((f2bf(r[i]) << 16) | (unsigned)(t[i] < 0 ? 0 : t[i])); }
    __syncthreads();
}
struct P9Tok { f32x4 v[8]; unsigned y[4][8]; f32x4 tw; };
template <int PM> __device__ __forceinline__ void p9_issue(const Frame& F, int m, P9Tok& T) {
    typedef int i32x4 __attribute__((ext_vector_type(4)));
    const bf16_t* DL = wsp<bf16_t>(F, WS_H1); const unsigned char* YR = wsp<unsigned char>(F, WS_YR);
    const i32x4 te = *(const GAS i32x4*)(wsp<int>(F, WS_TOPE) + m * 4), tp = *(const GAS i32x4*)(wsp<int>(F, WS_TOPP) + m * 4); T.tw = *(const GAS f32x4*)(wsp<float>(F, WS_TOPW) + m * 4);
#pragma unroll
    for (int j = 0; j < 8; ++j) { const u32x2 dw = (PM == 4) ? (u32x2){(unsigned)m, 0u} : *(const GAS u32x2*)(DL + (size_t)m * D + 4 * F.lane + 256 * j);
        T.v[j] = (f32x4){bflo(dw.x), bfhi(dw.x), bflo(dw.y), bfhi(dw.y)}; }
#pragma unroll
    for (int k = 0; k < 4; ++k) { const size_t row = (size_t)((const LAS unsigned*)F.MISC)[16 + te[k]] * 256 + tp[k];
#pragma unroll
        for (int j = 0; j < 8; ++j) T.y[k][j] = (PM == 1) ? (unsigned)row : *(const GAS unsigned*)(YR + row * D + 4 * F.lane + 256 * j); }
}
template <int PM> __device__ __forceinline__ void p9_finish(const Frame& F, int m, P9Tok& T, float* outp) {
#pragma unroll
    for (int k = 0; k < 4; ++k)
#pragma unroll
        for (int j = 0; j < 8; ++j) { const f32x2 p0 = __builtin_amdgcn_cvt_pk_f32_fp8((int)T.y[k][j], false), p1 = __builtin_amdgcn_cvt_pk_f32_fp8((int)T.y[k][j], true); T.v[j] += (f32x4){p0.x, p0.y, p1.x, p1.y} * T.tw[k]; }
    float s = 0.f;
#pragma unroll
    for (int j = 0; j < 8; ++j) s += (T.v[j][0] * T.v[j][0] + T.v[j][1] * T.v[j][1]) + (T.v[j][2] * T.v[j][2] + T.v[j][3] * T.v[j][3]);
    const float rs = rsqrtf(wave_sum(s) * (1.f / D) + EPS);
#pragma unroll
    for (int j = 0; j < 8; ++j) { const f32x4 w = *(const f32x4*)(F.fnw + 4 * F.lane + 256 * j); const f32x4 o = T.v[j] * rs * w;
        if (PM == 2) asm volatile("" :: "v"(o)); else *(GAS f32x4*)(outp + (size_t)m * D + 4 * F.lane + 256 * j) = o; }
}
template <int PM> __device__ __forceinline__ void p9_combine_t(Frame& F, float* outp) {
    const int gw = F.vcu * NWAVES + F.wave, NGW9 = F.G * NWAVES;
    for (int m = gw; m < M; m += 2 * NGW9) {
        const int m2 = m + NGW9; const bool two = m2 < M;
        P9Tok A, B; p9_issue<PM>(F, m, A); p9_issue<PM>(F, two ? m2 : m, B);
        __builtin_amdgcn_sched_barrier(0);
        p9_finish<PM>(F, m, A, outp); if (two) p9_finish<PM>(F, m2, B, outp);
    }
}
__device__ __forceinline__ void p9_combine(Frame& F) { p9_combine_t<0>(F, F.out); }
constexpr int NPH = 11;
struct Args { const float* in[18]; float* out; unsigned char* ws; int ph_lo, ph_hi; };

__global__ void __launch_bounds__(NTHR, 2) fwd_kernel(Args args) {
    extern __shared__ __attribute__((aligned(16))) unsigned char lds_raw[];
    Frame F;
    F.lds = (LAS unsigned char*)lds_raw; F.MISC = (volatile LAS unsigned*)(F.lds + MISC_OFF);
    F.wave = __builtin_amdgcn_readfirstlane((int)threadIdx.x >> 6);
#define REFRESH() do { F.lane = lane_id(); F.tid = F.wave * 64 + F.lane; } while (0)
    REFRESH();
    F.G = gridDim.x; { const int bx = blockIdx.x; F.vcu = (F.G % 8 == 0) ? (bx % 8) * (F.G / 8) + bx / 8 : bx; }
    F.ws = args.ws; F.ctl = (gu32*)(args.ws + WS_CTL); F.out = args.out;
    F.x = args.in[0]; F.meta = args.in[1]; F.nmw = args.in[2]; F.w_in = args.in[3]; F.lbl = args.in[4]; F.gnw = args.in[5]; F.w_ho = args.in[6]; F.cw = args.in[7]; F.w_co = args.in[8]; F.w_o = args.in[9];
    F.nfw = args.in[10]; F.w_r = args.in[11]; F.b_r = args.in[12]; F.w_up = args.in[13]; F.b_up = args.in[14]; F.w_dn = args.in[15]; F.b_dn = args.in[16]; F.fnw = args.in[17];
    for (int u = F.tid; u < 256; u += NTHR) F.MISC[u] = 0u;
    __syncthreads();
    const int lo = args.ph_lo, hi = args.ph_hi;
    const bool multi = (hi - lo) > 1;
    XcdBarrier bar; bar.bar = (unsigned*)(F.ctl + CW_BAR); bar.x = 0; bar.st = nullptr;
    if (multi) bar = xcd_barrier_post((unsigned*)(F.ctl + CW_BAR), F.MISC, F.tid);
#define IN(k) (lo <= (k) && (k) < hi)
#if defined(FK_STAMP_A)
#define STAMP(k) do { if (blockIdx.x == 0 && F.tid == 0) __hip_atomic_store(F.ctl + CW_TS + (k), (unsigned)__builtin_amdgcn_s_memrealtime(), RLX_AGENT); } while (0)
#else
#define STAMP(k) do { } while (0)
#endif
#if defined(FK_PROBE_BAR)
#define SEAM(k) do { REFRESH(); if (IN(k) && IN((k) + 1)) { xcd_barrier(bar, F.tid); xcd_barrier(bar, F.tid); xcd_barrier(bar, F.tid); } STAMP((k) + 1); } while (0)
#else
#define SEAM(k) do { REFRESH(); if (IN(k) && IN((k) + 1)) xcd_barrier(bar, F.tid); STAMP((k) + 1); } while (0)
#endif
    STAMP(0);
    const int c = blockIdx.x;
#ifndef FK_DUP_MASK
#define FK_DUP_MASK 0
#endif
#ifndef FK_DUP_REPS
#define FK_DUP_REPS 1
#endif
#define DUP(k) for (int _rep = 0; _rep < 1 + FK_DUP_REPS * ((FK_DUP_MASK >> (k)) & 1); ++_rep)
#define REDO(k) do { if (((FK_DUP_MASK >> (k)) & 1) && _rep < FK_DUP_REPS) { REFRESH(); xcd_barrier(bar, F.tid); } } while (0)

    if (IN(0)) DUP(0) { p0_prologue(F); REDO(0); } SEAM(0);

    if (IN(1)) DUP(1) {
        constexpr int NCONV_PER8 = 3;
        const int cq = c >> 3; const bool conv = (F.G % 64 == 0) && ((cq & 7) < NCONV_PER8) && (_rep == 0);
        if (F.G % 64 != 0 && _rep == 0) { if (c == 0) p1_convert(F, 0, 1); }
        if (conv) { const int nconv = (F.G / 64) * 8 * NCONV_PER8, rank = ((cq >> 3) * NCONV_PER8 + (cq & 7)) * 8 + (c & 7); p1_convert(F, rank, nconv);
#if defined(FK_PROBE_CONV2)
            __syncthreads(); p1_convert<FK_PROBE_CONV2 - 1>(F, rank, nconv);
#endif
        }
        __syncthreads();
        EpiInproj E{wsp<float>(F, WS_RS1), wsp<float>(F, WS_LB), wsp<bf16_t>(F, WS_QS), wsp<bf16_t>(F, WS_VV), wsp<bf16_t>(F, WS_GS), wsp<bf16_t>(F, WS_UU), wsp<bf16_t>(F, WS_SB), wsp<bf16_t>(F, WS_RT), wsp<bf16_t>(F, WS_GBS), wsp<h16_t>(F, WS_LF), 1.f};
        if (N_INB > 0) {
            GemmDesc g{wsp<bf16_t>(F, WS_XB), wsp<bf16_t>(F, WS_WIN), D, INC / 256};
            DynOrder S; S.init(M, INB_MASK, N_INB, c, (unsigned*)(F.ctl + CW_Q + 64 * (c & 7) + 8 * _rep), F.MISC + 4, F.tid);
            gemm_phase<EpiInproj, DynOrder, false, true, false>(F.lds, g, S, E, nullptr, F.wave); }
        if (N_IN8 > 0) {
            REFRESH(); E.osc = 1.f / W8_SCALE;
            GemmDesc g{(const bf16_t*)wsp<unsigned char>(F, WS_XB8), (const bf16_t*)wsp<unsigned char>(F, WS_WIN8), D, INC / 256};
            DynOrder S; S.init(M, IN8_MASK, N_IN8, c, (unsigned*)(F.ctl + CW_Q + 64 * (c & 7) + 8 * _rep + 4), F.MISC + 6, F.tid);
            gemm_phase<EpiInproj, DynOrder, false, true, true>(F.lds, g, S, E, nullptr, F.wave); }
        REDO(1);
    } SEAM(1);

#if defined(FK_PROBE_GEMM)
    if (IN(1)) {
        GemmDesc g{wsp<bf16_t>(F, WS_XB), wsp<bf16_t>(F, WS_WIN), D, INC / 256}; ProbeOrder S; S.S.init(M, INC, F.G, c); S.mode = FK_PROBE_GEMM & 3; S.c = c;
        EpiDummy E{wsp<bf16_t>(F, WS_ACT), (FK_PROBE_GEMM >> 2) & 1};
        gemm_phase<EpiDummy, ProbeOrder, false, true, false>(F.lds, g, S, E, nullptr, F.wave);
        REFRESH(); xcd_barrier(bar, F.tid);
    }
#endif
    if (IN(2)) DUP(2) { p2a_units(F, c); for (int it = c; it < M / 64; it += F.G) p2a_conv(F, it); REDO(2); } SEAM(2);
    if (IN(3)) DUP(3) { p2b_scan(F); REDO(3); } SEAM(3);
    if (IN(4)) DUP(4) { p2c_units(F, c); REDO(4); } SEAM(4);

    if (IN(5)) DUP(5) {
        GemmDesc g{wsp<bf16_t>(F, WS_A2), wsp<bf16_t>(F, WS_WAB), D, D / 256}; StaticOrder S; S.init(M, D, F.G, c);
        EpiMerge E{wsp<bf16_t>(F, WS_RT), wsp<bf16_t>(F, WS_GBS), wsp<bf16_t>(F, WS_MG)};
        gemm_phase<EpiMerge, StaticOrder, false, true, false>(F.lds, g, S, E, nullptr, F.wave); REDO(5);
    } SEAM(5);

    if (IN(6)) DUP(6) {
        GemmDesc g{wsp<bf16_t>(F, WS_MG), wsp<bf16_t>(F, WS_WO), D, D / 256}; StaticOrder S; S.init(M, D, F.G, c);
        EpiWo E{wsp<bf16_t>(F, WS_H1)};
        gemm_phase<EpiWo, StaticOrder, false, true, false>(F.lds, g, S, E, nullptr, F.wave); REDO(6);
    } SEAM(6);

    if (IN(7)) { p5_router(F); } SEAM(7);

    if (IN(8)) DUP(8) {
        build_pref(F);
        MoeOrder S; S.init(16, F.G, c, (const volatile LAS int*)(F.MISC + 16));
        build_tok(F, S);
        GemmDesc g{wsp<bf16_t>(F, WS_H1B), wsp<bf16_t>(F, WS_WUP), D, 16};
        EpiUp E{wsp<float>(F, WS_RS2), (const LAS int*)(F.lds + TOK_OFF), F.b_up, wsp<unsigned char>(F, WS_ACT)};
        gemm_phase<EpiUp, MoeOrder, true, true, true>(F.lds, g, S, E, (const LAS int*)(F.lds + TOK_OFF), F.wave); REDO(8);
    } SEAM(8);

    if (IN(9)) DUP(9) {
        build_pref(F);
        MoeOrder S; S.init(8, F.G, c, (const volatile LAS int*)(F.MISC + 16));
        GemmDesc g{wsp<bf16_t>(F, WS_ACT), wsp<bf16_t>(F, WS_WDN), DFF, 8};
        EpiDown E{F.b_dn, wsp<unsigned char>(F, WS_YR)};
        gemm_phase<EpiDown, MoeOrder, false, true, true>(F.lds, g, S, E, nullptr, F.wave); REDO(9);
    } SEAM(9);

#if defined(FK_PROBE_P8)
    if (IN(10)) {
        build_pref(F);
        ProbeMoe S; S.S.init(8, F.G, c, (const volatile LAS int*)(F.MISC + 16)); S.mode = FK_PROBE_P8 & 3;
        GemmDesc g{wsp<bf16_t>(F, WS_ACT), wsp<bf16_t>(F, WS_WDN), DFF, 8};
        EpiDummy E{wsp<bf16_t>(F, WS_XB), 1};
        for (int r = 0; r < 2; ++r) { gemm_phase<EpiDummy, ProbeMoe, false, true, true>(F.lds, g, S, E, nullptr, F.wave); REFRESH(); xcd_barrier(bar, F.tid); }
    }
#endif
    if (IN(10)) DUP(10) { build_pref(F); p9_combine(F); REDO(10); }
#if defined(FK_PROBE_P9)
    if (IN(10)) { for (int r = 0; r < 4; ++r) { REFRESH(); xcd_barrier(bar, F.tid); p9_combine_t<FK_PROBE_P9 - 1>(F, wsp<float>(F, WS_XB)); } }
#endif
#undef IN
#undef DUP
#undef REDO
#undef SEAM
#undef STAMP
#undef REFRESH
}

inline void launch_fast(hipStream_t stream, void* const* d_in, float* out, unsigned char* ws, int n_launches) {
    static int grid = 0;
    if (grid == 0) {
        int dev = 0, cus = 0, per_cu = 0;
        if (hipGetDevice(&dev) != hipSuccess || hipDeviceGetAttribute(&cus, hipDeviceAttributeMultiprocessorCount, dev) != hipSuccess) { fprintf(stderr, "kernel_launch: device query failed\n"); grid = -1; return; }
        if (hipFuncSetAttribute((const void*)fwd_kernel, hipFuncAttributeMaxDynamicSharedMemorySize, LDS_BYTES) != hipSuccess) { fprintf(stderr, "kernel_launch: hipFuncSetAttribute failed\n"); grid = -1; return; }
        if (hipOccupancyMaxActiveBlocksPerMultiprocessor(&per_cu, (const void*)fwd_kernel, NTHR, LDS_BYTES) != hipSuccess || per_cu < 1) fprintf(stderr, "kernel_launch: note: occupancy query says %d blocks per CU\n", per_cu);
        (void)hipGetLastError();
        grid = cus;
    }
    if (grid < 0) return;
    (void)hipMemsetAsync(ws + WS_CTL, 0, CTL_BYTES, stream);
    Args a{};
    for (int i = 0; i < 18; ++i) a.in[i] = (const float*)d_in[i];
    a.out = out; a.ws = ws;
    for (int li = 0; li < n_launches; ++li) {
        a.ph_lo = (n_launches == 1) ? 0 : li; a.ph_hi = (n_launches == 1) ? NPH : li + 1;
        hipLaunchKernelGGL(fwd_kernel, dim3(grid), dim3(NTHR), LDS_BYTES, stream, a);
        const hipError_t le = hipPeekAtLastError();
        if (le != hipSuccess) { fprintf(stderr, "kernel_launch: launch %d failed: %s\n", li, hipGetErrorName(le)); break; }
    }
}
}
#ifndef FK_LAUNCHES
#define FK_LAUNCHES 1
#endif
extern "C" void kernel_launch(void* const* d_in, const int* in_sizes, int n_in, void* d_out, int out_size, void* d_ws, size_t ws_size, hipStream_t stream) {
    if (n_in != 18 || ws_size < fk::WS_FAST_END) { fprintf(stderr, "kernel_launch: n_in %d, ws %zu < %zu\n", n_in, ws_size, (size_t)fk::WS_FAST_END); return; }
    fk::launch_fast(stream, d_in, (float*)d_out, (unsigned char*)d_ws, FK_LAUNCHES);
}
```

```cpp
#include <hip/hip_runtime.h>
#include <cstdio>
#define FK_LAUNCHES 1
#define FK_IN8_MASK 0xFFFF000F0FFull
#define FK_WO8 0
namespace fk {
#define LAS __attribute__((address_space(3)))
#define GAS __attribute__((address_space(1)))
typedef unsigned short bf16_t;
typedef short bf16x8 __attribute__((ext_vector_type(8)));
typedef float f32x4 __attribute__((ext_vector_type(4)));
typedef float f32x2 __attribute__((ext_vector_type(2)));
typedef unsigned u32x4 __attribute__((ext_vector_type(4)));
typedef unsigned u32x2 __attribute__((ext_vector_type(2)));
typedef GAS unsigned gu32;
typedef _Float16 h16_t;
typedef _Float16 h16x4 __attribute__((ext_vector_type(4)));
typedef _Float16 h16x2 __attribute__((ext_vector_type(2)));
#define RLX_AGENT __ATOMIC_RELAXED, __HIP_MEMORY_SCOPE_AGENT
#define LDS_WAIT() asm volatile("s_waitcnt lgkmcnt(0)" ::: "memory")
#define VM_WAIT() asm volatile("s_waitcnt vmcnt(0)" ::: "memory")

constexpr int D = 2048, NB = 4, SEQ = 4096, M = NB * SEQ, NMETA = 16;
constexpr int HF = 1024, INC = 11264, NE = 32, DFF = 2048, NCH = SEQ / 64;
constexpr int C_Q = 0, C_F = 1024, C_V = 2048, C_G = 3072, C_SV = 4096, C_SB = 5120, C_SC = 6144, C_GA = 7168, C_GB = 9216;
constexpr float EPS = 1e-6f;
constexpr int CAPF = M;
constexpr int MAXRT = 288;
constexpr int NWAVES = 8, NTHR = 512;

constexpr size_t al(size_t x) { return (x + 0xFFFFF) & ~(size_t)0xFFFFF; }
constexpr size_t WS_CTL = 0, CTL_BYTES = 65536;
constexpr size_t WS_LB = 65536, WS_RS1 = WS_LB + 4096, WS_RS2 = WS_RS1 + 65536, WS_WRH = WS_RS2 + 65536, WS_WRL = WS_WRH + 131072;
constexpr size_t WS_LFM = WS_WRL + 131072, WS_VVM = WS_LFM + 64 * 1024 * 4, WS_UUM = WS_VVM + 64 * 1024 * 2, WS_SMALL_END = WS_UUM + 16 * 1024 * 2;
constexpr size_t WS_TOPE = al(WS_SMALL_END), WS_TOPP = WS_TOPE + (size_t)M * 16, WS_TOPW = WS_TOPP + (size_t)M * 16, WS_LIST = WS_TOPW + (size_t)M * 16;
constexpr size_t WS_DEC = al(WS_LIST + (size_t)NE * CAPF * 4);
constexpr size_t WS_WIN = al(WS_DEC + (size_t)33 * 64 * 128 * 4);
constexpr size_t WS_WAB = al(WS_WIN + (size_t)INC * D * 2);
constexpr size_t WS_WO = al(WS_WAB + (size_t)D * D * 2);
constexpr size_t WS_WUP = al(WS_WO + (size_t)D * D * 2);
constexpr size_t WS_WDN = al(WS_WUP + (size_t)NE * 4096 * D);
constexpr size_t WS_XB = al(WS_WDN + (size_t)NE * D * DFF);
constexpr size_t WS_QS = al(WS_XB + (size_t)M * D * 2);
constexpr size_t WS_LF = al(WS_QS + (size_t)M * HF * 2);
constexpr size_t WS_VV = al(WS_LF + (size_t)M * HF * 2);
constexpr size_t WS_GS = al(WS_VV + (size_t)M * HF * 2);
constexpr size_t WS_UU = al(WS_GS + (size_t)M * HF * 2);
constexpr size_t WS_SB = al(WS_UU + (size_t)M * HF * 2);
constexpr size_t WS_RT = al(WS_SB + (size_t)M * HF * 2);
constexpr size_t WS_GBS = al(WS_RT + (size_t)M * D * 2);
constexpr size_t WS_UC = al(WS_GBS + (size_t)M * D * 2);
constexpr size_t WS_SS = al(WS_UC + (size_t)(32 * 64 + 8) * 16384 * 2);
constexpr size_t WS_A2 = al(WS_SS + (size_t)32 * 64 * 16384 * 2);
constexpr size_t WS_MG = al(WS_A2 + (size_t)M * D * 2);
constexpr size_t WS_H1 = al(WS_MG + (size_t)M * D * 2);
constexpr size_t WS_H1B = al(WS_H1 + (size_t)M * D * 2);
constexpr size_t WS_ACT = al(WS_H1B + (size_t)M * D);
constexpr size_t WS_YR = al(WS_ACT + (size_t)MAXRT * 256 * DFF);
constexpr size_t WS_WIN8 = al(WS_YR + (size_t)MAXRT * 256 * D);
constexpr size_t WS_XB8 = al(WS_WIN8 + (size_t)INC * D);
constexpr size_t WS_FAST_END = al(WS_XB8 + (size_t)M * D);
#ifndef FK_IN8_MASK
#define FK_IN8_MASK 0xFFFF00000F0ull
#endif
constexpr unsigned long long IN8_MASK = FK_IN8_MASK;
constexpr unsigned long long INB_MASK = ((1ull << 44) - 1) & ~IN8_MASK;
constexpr int cpop(unsigned long long m) { int n = 0; while (m) { m &= m - 1; ++n; } return n; }
constexpr int N_IN8 = cpop(IN8_MASK), N_INB = 44 - N_IN8;
__device__ __forceinline__ int nth_bit(unsigned long long m, int n) { for (int i = 0; i < n; ++i) m &= m - 1; return __builtin_ctzll(m); }
constexpr int CW_TMO = 0;
constexpr int CW_CNT = 1024;
constexpr int CW_Q = 3400;
constexpr int CW_TS = 3200;
constexpr int CW_BAR = 4096;
constexpr int RING_BYTES = 131072;
constexpr int TOK_OFF = RING_BYTES, TOK_BYTES = 18 * 1024;
constexpr int MISC_OFF = TOK_OFF + TOK_BYTES;
constexpr int BIAS_OFF = MISC_OFF + 1024, BIAS_BYTES = 18 * 512;
constexpr int LDS_BYTES = BIAS_OFF + BIAS_BYTES;
static_assert(LDS_BYTES <= 160 * 1024, "LDS");

__device__ __forceinline__ float sigmoidf_(float x) { return 1.f / (1.f + __expf(-x)); }
__device__ __forceinline__ unsigned f2bf(float f) { unsigned u = __builtin_bit_cast(unsigned, f); return (u + 0x7fffu + ((u >> 16) & 1u)) >> 16; }
__device__ __forceinline__ unsigned pk2(float lo, float hi) { return f2bf(lo) | (f2bf(hi) << 16); }
__device__ __forceinline__ float bf2f(unsigned short b) { return __builtin_bit_cast(float, ((unsigned)b) << 16); }
__device__ __forceinline__ float bflo(unsigned w) { return __builtin_bit_cast(float, w << 16); }
__device__ __forceinline__ float bfhi(unsigned w) { return __builtin_bit_cast(float, w & 0xffff0000u); }
__device__ __forceinline__ unsigned cvt_pk_bf16(float lo, float hi) { unsigned r; asm volatile("v_cvt_pk_bf16_f32 %0, %1, %2" : "=v"(r) : "v"(lo), "v"(hi)); return r; }
__device__ __forceinline__ unsigned pk4_fp8(float a, float b, float c, float d) { int w = 0; w = __builtin_amdgcn_cvt_pk_fp8_f32(a, b, w, false); w = __builtin_amdgcn_cvt_pk_fp8_f32(c, d, w, true); return (unsigned)w; }
constexpr float W8_SCALE = 64.f, W8_INV = 1.f / 64.f;
__device__ __forceinline__ int lane_id() { int l; asm volatile("v_mbcnt_lo_u32_b32 %0, -1, 0\n\tv_mbcnt_hi_u32_b32 %0, -1, %0" : "=v"(l)); return l; }
__device__ __forceinline__ float wave_sum(float v) {
#pragma unroll
    for (int o = 1; o < 64; o <<= 1) v += __shfl_xor(v, o);
    return v;
}

#define XB_TMO      128
#define XB_XCNT(j)  (256  + 64 * (j))
#define XB_XSUB(j)  (1280 + 64 * (j))
#define XB_XGEN(j)  (2304 + 64 * (j))
#define XB_TOP      3328
#define XB_TOPGEN   3392
#define XCD_BAR_WORDS 3456
#define XB_SPIN_CAP (1u << 18)
__device__ __forceinline__ unsigned xb_ld(unsigned* p)              { return __hip_atomic_load(p, __ATOMIC_RELAXED, __HIP_MEMORY_SCOPE_AGENT); }
__device__ __forceinline__ unsigned xb_add(unsigned* p, unsigned v) { return __hip_atomic_fetch_add(p, v, __ATOMIC_RELAXED, __HIP_MEMORY_SCOPE_AGENT); }
__device__ __forceinline__ unsigned xb_xcc_id() { return (unsigned)__builtin_amdgcn_s_getreg((3 << 11) | 20) & 0xFu; }
#define XB_SPIN(cond, bar) do { unsigned _sp = 0; while (cond) { __builtin_amdgcn_s_sleep(1); \
    if ((++_sp & 255u) == 0u) { if (xb_ld(&(bar)[XB_TMO])) break; if (_sp > XB_SPIN_CAP) { atomicAdd(&(bar)[XB_TMO], 1u); break; } } } } while (0)
struct XcdBarrier { unsigned* bar; unsigned x; volatile LAS unsigned* st; };
__device__ __forceinline__ XcdBarrier xcd_barrier_post(unsigned* bar, volatile LAS unsigned* st, int tid) {
    XcdBarrier b; b.bar = bar; b.x = xb_xcc_id(); b.st = st;
    if (tid == 0) (void)xb_add(&bar[XB_XCNT(b.x)], 1u);
    return b;
}
__device__ __forceinline__ void xcd_barrier_complete(unsigned* bar, unsigned x, unsigned& nloc, unsigned& nx) {
    const unsigned G = gridDim.x * gridDim.y * gridDim.z;
    unsigned sum, cnt, mine, sp = 0u;
    for (;;) {
        sum = 0u; cnt = 0u; mine = 0u;
#pragma unroll
        for (unsigned j = 0; j < 16; ++j) { const unsigned c = xb_ld(&bar[XB_XCNT(j)]); sum += c; cnt += (c > 0u) ? 1u : 0u; mine = (j == x) ? c : mine; }
        if (sum == G) break;
        __builtin_amdgcn_s_sleep(1);
        if ((++sp & 255u) == 0u) { if (xb_ld(&bar[XB_TMO])) break; if (sp > XB_SPIN_CAP) { atomicAdd(&bar[XB_TMO], 1u); break; } }
    }
    nloc = mine > 0u ? mine : 1u; nx = cnt > 0u ? cnt : 1u;
}
__device__ __forceinline__ void xcd_barrier(const XcdBarrier& b, int tid) {
    asm volatile("s_waitcnt vmcnt(0)" ::: "memory");
    __syncthreads();
    if (tid == 0) {
        unsigned* bar = b.bar;
        __builtin_amdgcn_s_waitcnt(0);
        unsigned nloc = b.st[0], nx = b.st[1];
        if (nloc == 0u) { xcd_barrier_complete(bar, b.x, nloc, nx); b.st[0] = nloc; b.st[1] = nx; }
        const unsigned old = xb_add(&bar[XB_XSUB(b.x)], 1u);
        const unsigned gen = old / nloc;
        if (old + 1u == (gen + 1u) * nloc) {
            __builtin_amdgcn_fence(__ATOMIC_RELEASE, "agent");
            asm volatile("s_waitcnt vmcnt(0)" ::: "memory");
            const unsigned og = xb_add(&bar[XB_TOP], 1u);
            const unsigned tg = og / nx;
            if (og + 1u == (tg + 1u) * nx) xb_add(&bar[XB_TOPGEN], 1u);
            else XB_SPIN(xb_ld(&bar[XB_TOPGEN]) == tg, bar);
            __builtin_amdgcn_fence(__ATOMIC_ACQUIRE, "agent");
            xb_add(&bar[XB_XGEN(b.x)], 1u);
            asm volatile("s_waitcnt vmcnt(0)" ::: "memory");
        } else {
            XB_SPIN(xb_ld(&bar[XB_XGEN(b.x)]) == gen, bar);
            __builtin_amdgcn_fence(__ATOMIC_ACQUIRE, "agent");
            asm volatile("s_waitcnt vmcnt(0)" ::: "memory");
        }
    }
    __syncthreads();
}

constexpr int BM = 256, BK = 64, HALF = 128, HTB = HALF * BK * 2, NXCD = 8, WGM = 8;
__host__ __device__ __forceinline__ int lds_byte(int r, int c) { const int st = (r >> 4) * 2 + (c >> 5), rr = r & 15, cc = c & 31, ob = rr * 64 + cc * 2; return st * 1024 + (ob ^ (((ob >> 9) & 1) << 5)); }
__host__ __device__ __forceinline__ void stage_rc(int b, int& R, int& C) { const int st = b / 1024, sb = b % 1024, swz = sb ^ (((sb >> 9) & 1) << 5); R = (st >> 1) * 16 + swz / 64; C = (st & 1) * 32 + (swz % 64) / 2; }
__host__ __device__ __forceinline__ int perm32(int rho) { const int n = rho >> 4, i = rho & 15; return 8 * (i >> 2) + 4 * n + (i & 3); }

typedef int i32x8 __attribute__((ext_vector_type(8)));
typedef int i32x4v __attribute__((ext_vector_type(4)));
__device__ __forceinline__ i32x8 cat8(const bf16x8 a, const bf16x8 b) { const i32x4v x = __builtin_bit_cast(i32x4v, a), y = __builtin_bit_cast(i32x4v, b); return __builtin_shufflevector(x, y, 0, 1, 2, 3, 4, 5, 6, 7); }
__device__ __forceinline__ void mfma8(f32x4& acc, const i32x8 a, const i32x8 b, const int sc) {
    asm volatile("s_nop 1\n\tv_mfma_scale_f32_16x16x128_f8f6f4 %0, %1, %2, %0, %3, %3 op_sel_hi:[0,0,0]" : "+v"(acc) : "v"(a), "v"(b), "v"(sc));
}
struct Unit { int pm, pn, e, ui; };

struct StaticOrder {
    int nM, nN, nwg, G, c;
    __device__ void init(int M_, int N_, int G_, int c_) { nM = M_ / BM; nN = N_ / BM; nwg = nM * nN; G = G_; c = c_; }
    __device__ __forceinline__ bool next(int i, Unit& u) const {
        const long L = (long)i * G + c; if (L >= nwg) return false;
        int wgid = (int)L; { const int q = nwg / NXCD, r = nwg % NXCD, xcd = wgid % NXCD, off = wgid / NXCD; wgid = (xcd < r ? xcd * (q + 1) : r * (q + 1) + (xcd - r) * q) + off; }
        const int nig = WGM * nN, gid = wgid / nig, fm = gid * WGM, gsz = (nM - fm) < WGM ? (nM - fm) : WGM;
        u.pm = fm + ((wgid % nig) % gsz); u.pn = (wgid % nig) / gsz; u.e = 0; u.ui = i; return true;
    }
};
struct DynOrder {
    int nM, nN, nwg, x; unsigned* head; volatile LAS unsigned* slot; int tid; unsigned long long mask;
    __device__ void init(int M_, unsigned long long mask_, int nN_, int c_, unsigned* head_, volatile LAS unsigned* slot_, int tid_) { nM = M_ / BM; nN = nN_; mask = mask_; nwg = nM * nN; x = c_ & 7; head = head_; slot = slot_; tid = tid_; }
    __device__ __forceinline__ bool next(int i, Unit& u) const {
        if (tid == 0) slot[i & 1] = __hip_atomic_fetch_add(head, 1u, __ATOMIC_RELAXED, __HIP_MEMORY_SCOPE_AGENT);
        asm volatile("s_waitcnt lgkmcnt(0)" ::: "memory"); __builtin_amdgcn_s_barrier(); asm volatile("" ::: "memory");
        const int j = (int)slot[i & 1], q = nwg / NXCD;
        if (j >= q) return false;
        const int wgid = x * q + j;
        const int nig = WGM * nN, gid = wgid / nig, fm = gid * WGM, gsz = (nM - fm) < WGM ? (nM - fm) : WGM;
        u.pm = fm + ((wgid % nig) % gsz); u.pn = nth_bit(mask, (wgid % nig) / gsz); u.e = 0; u.ui = i; return true;
    }
};
struct MoeOrder {
    int nct, NT, G, c; const volatile LAS int* pref;
    __device__ void init(int nct_, int G_, int c_, const volatile LAS int* pref_) { nct = nct_; G = G_; c = c_; pref = pref_; NT = pref_[NE]; }
    template <bool UNIFORM = true> __device__ __forceinline__ bool next(int i, Unit& u) const {
        int rtg, pn;
        if (G == 256) { const int x = c & 7, jj = c >> 3;
            if (nct == 16) { rtg = 16 * i + 8 * (x & 1) + (jj & 7); pn = 4 * (x >> 1) + (jj >> 3); }
            else           { rtg = 32 * i + 8 * (x & 3) + (jj & 7); pn = 4 * (x >> 2) + (jj >> 3); } }
        else { const int U = i * G + c; rtg = U / nct; pn = U - rtg * nct; }
        if (rtg >= NT) return false;
        u.pn = pn; u.pm = rtg; u.ui = i;
        int e = 0;
        if constexpr (UNIFORM) { const int l = lane_id(); const int pv = (l >= 1 && l < NE) ? pref[l] : 0x7fffffff; e = (int)__builtin_popcountll(__ballot(pv <= rtg)); }
        else {
#pragma unroll 1
            for (int j = 1; j < NE; ++j) e = (pref[j] <= rtg) ? j : e; }
        u.e = e; return true;
    }
};

struct GemmDesc { const bf16_t* A; const bf16_t* Bt; int K; int nct; };

template <class Epi, class Sched, bool GATHER, bool ALIGN_EPI, bool FP8>
__device__ __forceinline__ void gemm_phase(LAS unsigned char* lds, const GemmDesc g, const Sched& S, const Epi& E, const LAS int* tok, int wid) {
    const int lane = lane_id(), tid = wid * 64 + lane, wr = wid >> 2, wc = wid & 3, fr = lane & 15, fq = lane >> 4;
    const int K = g.K, KB = FP8 ? K : 2 * K  , nt = FP8 ? K / 128 : K / BK;
    int Rl[2], Cl[2];
    unsigned voffA[2], voffB[2];
#pragma unroll
    for (int i = 0; i < 2; ++i) { int Cc; stage_rc(tid * 16 + i * 8192, Rl[i], Cc); const int p = Cc >> 3; Cl[i] = FP8 ? 16 * (2 * (p & 3) + (p >> 2)) : 2 * Cc; voffA[i] = (unsigned)(Rl[i] * KB + Cl[i]); voffB[i] = voffA[i]; }
    const size_t kstep = (size_t)(BK * 2);
    const size_t hstep = (size_t)HALF * KB;
    const size_t tstep = 2 * hstep;
    const unsigned ldsw = (unsigned)wid * 1024u;
    const int aoff = lds_byte(wr * 64 + fr, fq * 8), boff = lds_byte(wc * 32 + fr, fq * 8);
#define PG8_SA(b, h) (((b) * 2 + (h)) * HTB)
#define PG8_SB(b, h) ((4 + (b) * 2 + (h)) * HTB)
#define PG8_STAGE(bufoff, gbase, voff) do { _Pragma("unroll") for (int _i = 0; _i < 2; ++_i) \
        __builtin_amdgcn_global_load_lds((const unsigned*)((const char*)(gbase) + (voff)[_i]), (LAS unsigned*)(lds + (bufoff) + ldsw + _i * 8192), 16, 0, 0); } while (0)
#define PG8_STAGE_A(bufoff, ptr, half, o0, o1) do { if constexpr (GATHER) { PG8_STAGE(bufoff, ptr, (half) ? o1 : o0); } else { PG8_STAGE(bufoff, (ptr) + (half) * hstep, voffA); } } while (0)
#define PG8_LDA(dst, b, h) do { _Pragma("unroll") for (int m = 0; m < 4; ++m) _Pragma("unroll") for (int k = 0; k < 2; ++k) dst[m][k] = *(const LAS bf16x8*)(lds + PG8_SA(b, h) + aoff + m * 2048 + k * 1024); } while (0)
#define PG8_LDB(dst, b, h) do { _Pragma("unroll") for (int n = 0; n < 2; ++n) _Pragma("unroll") for (int k = 0; k < 2; ++k) dst[n][k] = *(const LAS bf16x8*)(lds + PG8_SB(b, h) + boff + n * 2048 + k * 1024); } while (0)
#define PG8_MMA(ai, bj, At, Bt) do { __builtin_amdgcn_s_setprio(1); _Pragma("unroll") for (int m = 0; m < 4; ++m) _Pragma("unroll") for (int n = 0; n < 2; ++n) _Pragma("unroll") for (int k = 0; k < 2; ++k) \
        acc[ai][bj][m][n] = __builtin_amdgcn_mfma_f32_16x16x32_bf16(Bt[n][k], At[m][k], acc[ai][bj][m][n], 0, 0, 0); __builtin_amdgcn_s_setprio(0); } while (0)
#define PG8_MMA8(ai, bj, At, Bt) do { __builtin_amdgcn_s_setprio(1); _Pragma("unroll") for (int m = 0; m < 4; ++m) _Pragma("unroll") for (int n = 0; n < 2; ++n) \
        mfma8(acc[ai][bj][m][n], cat8(Bt[n][0], Bt[n][1]), cat8(At[m][0], At[m][1]), sc8); __builtin_amdgcn_s_setprio(0); } while (0)
#define PG8_MM(ai, bj, At, Bt) do { if constexpr (FP8) PG8_MMA8(ai, bj, At, Bt); else PG8_MMA(ai, bj, At, Bt); } while (0)
#define PG8_WAIT_V(n) asm volatile("s_waitcnt vmcnt(" #n ")" ::: "memory")
#define PG8_WAIT_L(n) asm volatile("s_waitcnt lgkmcnt(" #n ")" ::: "memory")
#define PG8_BAR __builtin_amdgcn_s_barrier()
#define PG8_SCHED __builtin_amdgcn_sched_barrier(0)
    Unit cur, nxt; int ui = 0;
    if (!S.next(0, cur)) return;
    const int sc8 = 0x7F7F7F7F;
    f32x4 acc[2][2][4][2];
#pragma unroll
    for (int a = 0; a < 2; ++a)
#pragma unroll
        for (int b = 0; b < 2; ++b)
#pragma unroll
            for (int m = 0; m < 4; ++m)
#pragma unroll
                for (int n = 0; n < 2; ++n) acc[a][b][m][n] = (f32x4){0.f, 0.f, 0.f, 0.f};
    bf16x8 At[4][2], B0[2][2], B1[2][2];
    unsigned vA0[2] = {0u, 0u}, vA1[2] = {0u, 0u}, nA0[2] = {0u, 0u}, nA1[2] = {0u, 0u};
    const char* cA; const char* cB = (const char*)g.Bt + (size_t)(cur.e * g.nct + cur.pn) * tstep;
    if constexpr (GATHER) {
        cA = (const char*)g.A;
#pragma unroll
        for (int i = 0; i < 2; ++i) { vA0[i] = (unsigned)((tok[cur.ui * 256 + Rl[i]] & 0xffff) * KB + Cl[i]); vA1[i] = (unsigned)((tok[cur.ui * 256 + 128 + Rl[i]] & 0xffff) * KB + Cl[i]); nA0[i] = vA0[i]; nA1[i] = vA1[i]; }
    } else cA = (const char*)g.A + (size_t)cur.pm * tstep;
    PG8_STAGE(PG8_SB(0, 0), cB, voffB); PG8_STAGE(PG8_SB(0, 1), cB + hstep, voffB); PG8_STAGE_A(PG8_SA(0, 0), cA, 0, vA0, vA1); PG8_STAGE_A(PG8_SA(0, 1), cA, 1, vA0, vA1);
    if (wr == 1) PG8_BAR;
    PG8_WAIT_V(2); PG8_BAR;
    PG8_STAGE(PG8_SB(1, 0), cB + kstep, voffB); PG8_STAGE_A(PG8_SA(1, 0), cA + kstep, 0, vA0, vA1); PG8_STAGE(PG8_SB(1, 1), cB + hstep + kstep, voffB);
    PG8_WAIT_V(6); PG8_BAR;
    for (;;) {
        const bool has_next = S.next(ui + 1, nxt);
        const char* nAp; const char* nB;
        if (has_next) {
            nB = (const char*)g.Bt + (size_t)(nxt.e * g.nct + nxt.pn) * tstep;
            if constexpr (GATHER) { nAp = cA;
#pragma unroll
                for (int i = 0; i < 2; ++i) { nA0[i] = (unsigned)((tok[nxt.ui * 256 + Rl[i]] & 0xffff) * KB + Cl[i]); nA1[i] = (unsigned)((tok[nxt.ui * 256 + 128 + Rl[i]] & 0xffff) * KB + Cl[i]); }
            } else nAp = (const char*)g.A + (size_t)nxt.pm * tstep;
        } else { nAp = cA; nB = cB; }
        for (int t = 0; t < nt; t += 2) {
            const bool last = (t == nt - 2);
            const char* a1 = cA + (size_t)(t + 1) * kstep;
            const char* a2 = last ? nAp : cA + (size_t)(t + 2) * kstep; const char* b2 = last ? nB : cB + (size_t)(t + 2) * kstep;
            const char* a3 = a2 + kstep; const char* b3 = b2 + kstep;
            unsigned w0[2] = {0u, 0u}, w1[2] = {0u, 0u};
            if constexpr (GATHER) {
#pragma unroll
                for (int i = 0; i < 2; ++i) { w0[i] = last ? nA0[i] : vA0[i]; w1[i] = last ? nA1[i] : vA1[i]; } }
            if constexpr (Epi::MIDHOOK) { if (t == nt / 2) E.mid(acc, cur, wr, wc, fr, fq); }
            PG8_LDB(B0, 0, 0); PG8_LDB(B1, 0, 1); PG8_SCHED; PG8_LDA(At, 0, 0); PG8_STAGE_A(PG8_SA(1, 1), a1, 1, vA0, vA1);
            PG8_WAIT_V(8); PG8_WAIT_L(0); PG8_BAR; PG8_MM(0, 0, At, B0); PG8_MM(0, 1, At, B1); PG8_BAR; PG8_SCHED;
            PG8_LDA(At, 0, 1); PG8_STAGE(PG8_SB(0, 0), b2, voffB); PG8_STAGE(PG8_SB(0, 1), b2 + hstep, voffB); PG8_STAGE_A(PG8_SA(0, 0), a2, 0, w0, w1);
            PG8_WAIT_V(8); PG8_WAIT_L(0); PG8_BAR; PG8_MM(1, 0, At, B0); PG8_MM(1, 1, At, B1); PG8_BAR; PG8_SCHED;
            PG8_LDB(B0, 1, 0); PG8_LDB(B1, 1, 1); PG8_SCHED; PG8_LDA(At, 1, 0); PG8_STAGE_A(PG8_SA(0, 1), a2, 1, w0, w1);
            PG8_WAIT_V(8); PG8_WAIT_L(0); PG8_BAR; PG8_MM(0, 0, At, B0); PG8_MM(0, 1, At, B1); PG8_BAR; PG8_SCHED;
            PG8_LDA(At, 1, 1); PG8_STAGE(PG8_SB(1, 0), b3, voffB); PG8_STAGE(PG8_SB(1, 1), b3 + hstep, voffB); PG8_STAGE_A(PG8_SA(1, 0), a3, 0, w0, w1);
            PG8_WAIT_V(8); PG8_WAIT_L(0); PG8_BAR; PG8_MM(1, 0, At, B0); PG8_MM(1, 1, At, B1); PG8_BAR; PG8_SCHED;
        }
        if constexpr (ALIGN_EPI) { if (wr == 0) PG8_BAR; }
        E(acc, cur, wr, wc, fr, fq);
        if (!has_next) break;
#pragma unroll
        for (int a = 0; a < 2; ++a)
#pragma unroll
            for (int b = 0; b < 2; ++b)
#pragma unroll
                for (int m = 0; m < 4; ++m)
#pragma unroll
                    for (int n = 0; n < 2; ++n) acc[a][b][m][n] = (f32x4){0.f, 0.f, 0.f, 0.f};
        cur = nxt; cA = nAp; cB = nB; ++ui;
        if constexpr (GATHER) {
#pragma unroll
            for (int i = 0; i < 2; ++i) { vA0[i] = nA0[i]; vA1[i] = nA1[i]; } }
        if constexpr (ALIGN_EPI) { if (wr == 1) PG8_BAR; }
    }
    PG8_WAIT_V(0);
    if constexpr (!ALIGN_EPI) { if (wr == 0) PG8_BAR; }
    PG8_BAR;
#undef PG8_SA
#undef PG8_SB
#undef PG8_STAGE
#undef PG8_STAGE_A
#undef PG8_LDA
#undef PG8_LDB
#undef PG8_MMA
#undef PG8_MMA8
#undef PG8_MM
#undef PG8_WAIT_V
#undef PG8_WAIT_L
#undef PG8_BAR
#undef PG8_SCHED
}
typedef f32x4 Acc[2][2][4][2];
__device__ __forceinline__ float silu_(float x) { return x * __builtin_amdgcn_rcpf(1.f + __expf(-x)); }
__device__ __forceinline__ float sigm_(float x) { return __builtin_amdgcn_rcpf(1.f + __expf(-x)); }
__device__ __forceinline__ u32x4 pack8(const f32x4 a, const f32x4 b) { u32x4 w; w.x = cvt_pk_bf16(a[0], a[1]); w.y = cvt_pk_bf16(a[2], a[3]); w.z = cvt_pk_bf16(b[0], b[1]); w.w = cvt_pk_bf16(b[2], b[3]); return w; }
__device__ __forceinline__ u32x2 pack8_fp8(const f32x4 a, const f32x4 b) { u32x2 w; w.x = pk4_fp8(a[0], a[1], a[2], a[3]); w.y = pk4_fp8(b[0], b[1], b[2], b[3]); return w; }
__device__ __forceinline__ void unpack8(const u32x4 w, f32x4& a, f32x4& b) { a = (f32x4){bflo(w.x), bfhi(w.x), bflo(w.y), bfhi(w.y)}; b = (f32x4){bflo(w.z), bfhi(w.z), bflo(w.w), bfhi(w.w)}; }

struct EpiInproj {
    static constexpr bool MIDHOOK = false;
    const float* rs1; const float* lb; bf16_t *QS, *VV, *GS, *UU, *SBb, *RT, *GBS; h16_t* LF; float osc;
    __device__ __forceinline__ void mid(Acc&, const Unit&, int, int, int, int) const {}
    template <int ACT> __device__ __forceinline__ void plain(const Acc& acc, const float (&rs)[2][4], bf16_t* O, int pt, int row0, int wc, int fq) const {
#pragma unroll
        for (int ai = 0; ai < 2; ++ai)
#pragma unroll
            for (int m = 0; m < 4; ++m) { bf16_t* rowp = O + (size_t)(row0 + ai * HALF + m * 16) * HF + pt * 256 + wc * 32 + 8 * fq; const float r = rs[ai][m];
#pragma unroll
                for (int bj = 0; bj < 2; ++bj) { f32x4 v0 = acc[ai][bj][m][0] * r, v1 = acc[ai][bj][m][1] * r;
                    if (ACT == 1) {
#pragma unroll
                        for (int j = 0; j < 4; ++j) { v0[j] = silu_(v0[j]); v1[j] = silu_(v1[j]); } }
                    *(u32x4*)(rowp + bj * HALF) = pack8(v0, v1); } }
    }
    __device__ __forceinline__ void operator()(const Acc& acc, const Unit& u, int wr, int wc, int fr, int fq) const {
        const int row0 = u.pm * BM + wr * 64 + fr, pn = u.pn;
        float rs[2][4];
#pragma unroll
        for (int ai = 0; ai < 2; ++ai)
#pragma unroll
            for (int m = 0; m < 4; ++m) rs[ai][m] = osc;
        if (pn < 4) plain<1>(acc, rs, QS, pn, row0, wc, fq);
        else if (pn < 8) {
            const int c0 = (pn - 4) * 256 + wc * 32 + 4 * fq;
            f32x4 lbv[2][2];
#pragma unroll
            for (int bj = 0; bj < 2; ++bj)
#pragma unroll
                for (int n = 0; n < 2; ++n) lbv[bj][n] = *(const f32x4*)(lb + c0 + bj * HALF + n * 16);
#pragma unroll
            for (int ai = 0; ai < 2; ++ai)
#pragma unroll
                for (int m = 0; m < 4; ++m) { h16_t* rowp = LF + (size_t)(row0 + ai * HALF + m * 16) * HF + c0; const float r = rs[ai][m];
#pragma unroll
                    for (int bj = 0; bj < 2; ++bj)
#pragma unroll
                        for (int n = 0; n < 2; ++n) { f32x4 v = acc[ai][bj][m][n] * r; const f32x4 l = lbv[bj][n];
#pragma unroll
                            for (int j = 0; j < 4; ++j) v[j] = __logf(l[j] + (1.f - l[j]) * sigm_(v[j]));
                            *(h16x4*)(rowp + bj * HALF + n * 16) = (h16x4){(h16_t)v[0], (h16_t)v[1], (h16_t)v[2], (h16_t)v[3]}; } }
        }
        else if (pn < 12) plain<0>(acc, rs, VV, pn - 8, row0, wc, fq);
        else if (pn < 16) plain<1>(acc, rs, GS, pn - 12, row0, wc, fq);
        else if (pn < 24) {
            const int c0 = (pn - 16) * 128 + wc * 32 + 8 * fq;
#pragma unroll
            for (int ai = 0; ai < 2; ++ai)
#pragma unroll
                for (int m = 0; m < 4; ++m) { const float r2 = rs[ai][m] * rs[ai][m];
                    const f32x4 v0 = acc[ai][0][m][0] * acc[ai][1][m][0] * r2, v1 = acc[ai][0][m][1] * acc[ai][1][m][1] * r2;
                    *(u32x4*)(UU + (size_t)(row0 + ai * HALF + m * 16) * HF + c0) = pack8(v0, v1); }
        }
        else if (pn < 28) plain<0>(acc, rs, SBb, pn - 24, row0, wc, fq);
        else {
            const int c0 = (pn - 28) * 128 + wc * 32 + 8 * fq;
#pragma unroll
            for (int ai = 0; ai < 2; ++ai)
#pragma unroll
                for (int m = 0; m < 4; ++m) { const float r = rs[ai][m]; f32x4 q0, q1, b0, b1;
#pragma unroll
                    for (int j = 0; j < 4; ++j) { const float ea = 1.f + __expf(-acc[ai][0][m][0][j] * r), eb = 1.f + __expf(-acc[ai][1][m][0][j] * r); b0[j] = __builtin_amdgcn_rcpf(eb); q0[j] = eb * __builtin_amdgcn_rcpf(ea);
                                                  const float fa = 1.f + __expf(-acc[ai][0][m][1][j] * r), fb = 1.f + __expf(-acc[ai][1][m][1][j] * r); b1[j] = __builtin_amdgcn_rcpf(fb); q1[j] = fb * __builtin_amdgcn_rcpf(fa); }
                    const size_t o = (size_t)(row0 + ai * HALF + m * 16) * D + c0;
                    *(u32x4*)(RT + o) = pack8(q0, q1); *(u32x4*)(GBS + o) = pack8(b0, b1); }
        }
    }
};

struct EpiMerge {
    static constexpr bool MIDHOOK = true;
    const bf16_t *RT, *GBS; bf16_t* MG;
    __device__ __forceinline__ void mid(Acc& acc, const Unit& u, int wr, int wc, int fr, int fq) const {
        unsigned o0 = ((unsigned)(u.pm * BM + wr * 64 + fr) * D + (unsigned)(u.pn * BM + wc * 32 + 8 * fq)) * 2u;
        asm volatile("" : "+v"(o0));
#pragma unroll
        for (int ai = 0; ai < 2; ++ai)
#pragma unroll
            for (int m = 0; m < 4; ++m)
#pragma unroll
                for (int bj = 0; bj < 2; ++bj) { const u32x4 w = *(const GAS u32x4*)((const GAS char*)RT + (o0 + (unsigned)((ai * HALF + m * 16) * D + bj * HALF) * 2u)); f32x4 a, b; unpack8(w, a, b);
                    acc[ai][bj][m][0] *= a; acc[ai][bj][m][1] *= b; }
    }
    __device__ __forceinline__ void operator()(const Acc& acc, const Unit& u, int wr, int wc, int fr, int fq) const {
        unsigned o0 = ((unsigned)(u.pm * BM + wr * 64 + fr) * D + (unsigned)(u.pn * BM + wc * 32 + 8 * fq)) * 2u;
        asm volatile("" : "+v"(o0));
#pragma unroll
        for (int ai = 0; ai < 2; ++ai)
#pragma unroll
            for (int m = 0; m < 4; ++m)
#pragma unroll
                for (int bj = 0; bj < 2; ++bj) { const unsigned o = o0 + (unsigned)((ai * HALF + m * 16) * D + bj * HALF) * 2u; const u32x4 w = *(const GAS u32x4*)((const GAS char*)GBS + o); f32x4 a, b; unpack8(w, a, b);
                    *(GAS u32x4*)((GAS char*)MG + o) = pack8(acc[ai][bj][m][0] * a, acc[ai][bj][m][1] * b); if (bj == 1 && m == 3) asm volatile("" ::: "memory"); }
    }
};

struct EpiWo {
    static constexpr bool MIDHOOK = false;
    bf16_t* DL;
    __device__ __forceinline__ void mid(Acc&, const Unit&, int, int, int, int) const {}
    __device__ __forceinline__ void operator()(const Acc& acc, const Unit& u, int wr, int wc, int fr, int fq) const {
        const int row0 = u.pm * BM + wr * 64 + fr, c0 = u.pn * BM + wc * 32 + 8 * fq;
#pragma unroll
        for (int ai = 0; ai < 2; ++ai)
#pragma unroll
            for (int m = 0; m < 4; ++m)
#pragma unroll
                for (int bj = 0; bj < 2; ++bj) *(u32x4*)(DL + (size_t)(row0 + ai * HALF + m * 16) * D + c0 + bj * HALF) = pack8(acc[ai][bj][m][0], acc[ai][bj][m][1]);
    }
};

struct EpiUp {
    static constexpr bool MIDHOOK = false;
    const float* rs2; const LAS int* tok; const LAS bf16_t* bias; unsigned char* ACT;
    __device__ __forceinline__ void mid(Acc&, const Unit&, int, int, int, int) const {}
    __device__ __forceinline__ void operator()(const Acc& acc, const Unit& u, int wr, int wc, int fr, int fq) const {
        const int rl0 = wr * 64 + fr, c0 = u.pn * 128 + wc * 32 + 8 * fq;
        float rs[2][4];
#pragma unroll
        for (int ai = 0; ai < 2; ++ai)
#pragma unroll
            for (int m = 0; m < 4; ++m) rs[ai][m] = __uint_as_float((unsigned)tok[u.ui * 256 + rl0 + ai * HALF + m * 16] & 0xffff0000u);
        const LAS bf16_t* bp = bias + u.ui * 256 + wc * 32 + 8 * fq;
        f32x4 bg0, bg1, bu0, bu1; unpack8(*(const LAS u32x4*)(bp), bg0, bg1); unpack8(*(const LAS u32x4*)(bp + 128), bu0, bu1);
#pragma unroll
        for (int ai = 0; ai < 2; ++ai)
#pragma unroll
            for (int m = 0; m < 4; ++m) { const float r = rs[ai][m]; f32x4 a0, a1;
#pragma unroll
                for (int n = 0; n < 2; ++n)
#pragma unroll
                    for (int jp = 0; jp < 2; ++jp) {
                        const f32x4 ag = acc[ai][0][m][n], au = acc[ai][1][m][n], bgv = n ? bg1 : bg0, buv = n ? bu1 : bu0;
                        f32x2 g = (f32x2){ag[2 * jp], ag[2 * jp + 1]} * r + (f32x2){bgv[2 * jp], bgv[2 * jp + 1]};
                        f32x2 uu = (f32x2){au[2 * jp], au[2 * jp + 1]} * r + (f32x2){buv[2 * jp], buv[2 * jp + 1]};
                        g.x = fminf(g.x, 7.f); g.y = fminf(g.y, 7.f);
                        uu.x = __builtin_amdgcn_fmed3f(uu.x, -7.f, 7.f); uu.y = __builtin_amdgcn_fmed3f(uu.y, -7.f, 7.f);
                        const f32x2 t = g * (-1.702f * 1.44269504f);
                        f32x2 den; den.x = __builtin_amdgcn_exp2f(t.x); den.y = __builtin_amdgcn_exp2f(t.y); den = den + 1.f;
                        f32x2 s; s.x = __builtin_amdgcn_rcpf(den.x); s.y = __builtin_amdgcn_rcpf(den.y);
                        const f32x2 a = (uu + 1.f) * (g * s);
                        if (n == 0) { a0[2 * jp] = a.x; a0[2 * jp + 1] = a.y; } else { a1[2 * jp] = a.x; a1[2 * jp + 1] = a.y; }
                    }
                *(u32x2*)(ACT + (size_t)(u.pm * BM + rl0 + ai * HALF + m * 16) * DFF + c0) = pack8_fp8(a0, a1); }
    }
};

struct EpiDown {
    static constexpr bool MIDHOOK = false;
    const LAS float* bias; unsigned char* YR;
    __device__ __forceinline__ void mid(Acc&, const Unit&, int, int, int, int) const {}
    __device__ __forceinline__ void operator()(const Acc& acc, const Unit& u, int wr, int wc, int fr, int fq) const {
        const int rl0 = wr * 64 + fr, c0 = u.pn * BM + wc * 32 + 8 * fq;
        const LAS float* bp = bias + u.ui * 256 + wc * 32 + 8 * fq;
        f32x4 bv[2][2];
#pragma unroll
        for (int bj = 0; bj < 2; ++bj)
#pragma unroll
            for (int n = 0; n < 2; ++n) bv[bj][n] = *(const LAS f32x4*)(bp + bj * HALF + 4 * n);
#pragma unroll
        for (int ai = 0; ai < 2; ++ai)
#pragma unroll
            for (int m = 0; m < 4; ++m)
#pragma unroll
                for (int bj = 0; bj < 2; ++bj)
                    *(u32x2*)(YR + (size_t)(u.pm * BM + rl0 + ai * HALF + m * 16) * D + c0 + bj * HALF) = pack8_fp8(acc[ai][bj][m][0] * W8_INV + bv[bj][0], acc[ai][bj][m][1] * W8_INV + bv[bj][1]);
    }
};

struct EpiDummy {
    static constexpr bool MIDHOOK = false;
    bf16_t* O; int nostore;
    __device__ __forceinline__ void mid(Acc&, const Unit&, int, int, int, int) const {}
    __device__ __forceinline__ void operator()(const Acc& acc, const Unit& u, int wr, int wc, int fr, int fq) const {
        const int row0 = (u.pm & 63) * BM + wr * 64 + fr, c0 = (u.pn & 7) * BM + wc * 32 + 8 * fq;
        if (nostore) {
#pragma unroll
            for (int ai = 0; ai < 2; ++ai)
#pragma unroll
                for (int m = 0; m < 4; ++m)
#pragma unroll
                    for (int bj = 0; bj < 2; ++bj) asm volatile("" :: "v"(acc[ai][bj][m][0]), "v"(acc[ai][bj][m][1]));
            return; }
#pragma unroll
        for (int ai = 0; ai < 2; ++ai)
#pragma unroll
            for (int m = 0; m < 4; ++m)
#pragma unroll
                for (int bj = 0; bj < 2; ++bj) *(u32x4*)(O + (size_t)(row0 + ai * HALF + m * 16) * D + c0 + bj * HALF) = pack8(acc[ai][bj][m][0], acc[ai][bj][m][1]);
    }
};
struct ProbeOrder {
    StaticOrder S; int mode, c;
    __device__ __forceinline__ bool next(int i, Unit& u) const {
        if (mode == 3) { if (c & 1) return false; StaticOrder H = S; H.G = S.G / 2; H.c = c >> 1; H.nwg = S.nwg / 2; return H.next(i, u); }
        if (!S.next(i, u)) return false; if (mode >= 1) u.pn = 0; if (mode >= 2) u.pm = c & 63; return true; }
};

struct ProbeMoe {
    MoeOrder S; int mode;
    __device__ __forceinline__ bool next(int i, Unit& u) const { if (!S.next(i, u)) return false; if (mode & 1) { u.e = 0; u.pn = 0; } if (mode & 2) u.pm = 0; return true; }
};
struct Frame {
    LAS unsigned char* lds; volatile LAS unsigned* MISC; gu32* ctl; unsigned char* ws;
    int tid, lane, wave, vcu, G;
    const float *x, *meta, *nmw, *w_in, *lbl, *gnw, *w_ho, *cw, *w_co, *w_o, *nfw, *w_r, *b_r, *w_up, *b_up, *w_dn, *b_dn, *fnw; float* out;
};
template <class T> __device__ __forceinline__ T* wsp(const Frame& F, size_t off) { return (T*)(F.ws + off); }

__device__ __forceinline__ void tr_tile(const float* W, int ldw, int k0, int src0, int src1, bool perm0, bool perm1, const float* kscale, bf16_t* dst, int dpitch, int drow0, int dk0, LAS unsigned* T, int lane) {
    const int ln = lane & 15, kr = lane >> 4, srcc = (ln < 8 ? src0 : src1) + 4 * (ln & 7);
    const float* wp = W + (size_t)(k0 + 2 * kr) * ldw + srcc;
    f32x4 va[8], vb[8]; f32x2 sc[8];
#pragma unroll
    for (int s = 0; s < 8; ++s) { va[s] = __builtin_nontemporal_load((const GAS f32x4*)(wp + (size_t)(8 * s) * ldw)); vb[s] = __builtin_nontemporal_load((const GAS f32x4*)(wp + (size_t)(8 * s + 1) * ldw));
        sc[s] = kscale ? *(const GAS f32x2*)(kscale + k0 + 8 * s + 2 * kr) : (f32x2){1.f, 1.f}; }
    __builtin_amdgcn_sched_barrier(0);
#pragma unroll
    for (int s = 0; s < 8; ++s) { const int col = (4 * s + kr) ^ (2 * ln);
#pragma unroll
        for (int i = 0; i < 4; ++i) T[(4 * ln + i) * 32 + col] = cvt_pk_bf16(va[s][i] * sc[s].x, vb[s][i] * sc[s].y); }
    LDS_WAIT(); asm volatile("" ::: "memory");
    const int c = lane & 7;
#pragma unroll
    for (int j = 0; j < 8; ++j) { const int rho = (lane >> 3) + 8 * j, h = rho >> 5, r32 = rho & 31; const bool pm = h ? perm1 : perm0; const int n = h * 32 + (pm ? perm32(r32) : r32);
        u32x4 v = *(const LAS u32x4*)(T + n * 32 + 4 * (c ^ (n >> 3)));
        if ((n >> 2) & 1) v = (u32x4){v.z, v.w, v.x, v.y};
        *(GAS u32x4*)(dst + (size_t)(drow0 + rho) * dpitch + dk0 + k0 + 8 * c) = v; }
    LDS_WAIT(); asm volatile("" ::: "memory");
}
template <int PMODE = 0> __device__ __forceinline__ void tr_tile_fp8(const float* W, int ldw, int k0, int src0, int src1, const float* kscale, unsigned char* dst, int dpitch, int drow0, LAS unsigned* T, int lane, bool perm = true) {
    const int ln = lane & 15, kr = lane >> 4, srcc = (ln < 8 ? src0 : src1) + 4 * (ln & 7);
    f32x4 v[2][4][4];
#pragma unroll
    for (int half = 0; half < 2; ++half) {
        const float* wp = W + (size_t)(k0 + 64 * half + 4 * kr) * ldw + srcc;
#pragma unroll
        for (int s = 0; s < 4; ++s) {
#pragma unroll
            for (int q = 0; q < 4; ++q) v[half][s][q] = __builtin_nontemporal_load((const GAS f32x4*)(wp + (size_t)(16 * s + q) * ldw)); }
    }
    __builtin_amdgcn_sched_barrier(0);
    if (PMODE == 1) {
#pragma unroll
        for (int half = 0; half < 2; ++half)
#pragma unroll
            for (int s = 0; s < 4; ++s)
#pragma unroll
                for (int q = 0; q < 4; ++q) asm volatile("" :: "v"(v[half][s][q]));
        return; }
#pragma unroll
    for (int half = 0; half < 2; ++half)
#pragma unroll
        for (int s = 0; s < 4; ++s) { const int col = (16 * half + 4 * s + kr) ^ (2 * ln);
            const f32x4 sc = kscale ? *(const GAS f32x4*)(kscale + k0 + 64 * half + 16 * s + 4 * kr) * W8_SCALE : (f32x4){W8_SCALE, W8_SCALE, W8_SCALE, W8_SCALE};
#pragma unroll
            for (int i = 0; i < 4; ++i) T[(4 * ln + i) * 32 + col] = pk4_fp8(v[half][s][0][i] * sc[0], v[half][s][1][i] * sc[1], v[half][s][2][i] * sc[2], v[half][s][3][i] * sc[3]); }
    LDS_WAIT(); asm volatile("" ::: "memory");
    const int c = lane & 7;
#pragma unroll
    for (int j = 0; j < 8; ++j) { const int rho = (lane >> 3) + 8 * j, h = rho >> 5, r32 = rho & 31; const int n = h * 32 + (perm ? perm32(r32) : r32);
        u32x4 v4 = *(const LAS u32x4*)(T + n * 32 + 4 * (c ^ (n >> 3)));
        if ((n >> 2) & 1) v4 = (u32x4){v4.z, v4.w, v4.x, v4.y};
        if (PMODE == 2) asm volatile("" :: "v"(v4)); else *(GAS u32x4*)(dst + (size_t)(drow0 + rho) * dpitch + k0 + 16 * c) = v4; }
    LDS_WAIT(); asm volatile("" ::: "memory");
}
__device__ __forceinline__ int win_src(int G, bool& perm) {
    const int pn = G >> 3, gi = G & 7; perm = true;
    if (pn < 4) return C_Q + pn * 256 + gi * 32;
    if (pn < 8) { perm = false; return C_F + (pn - 4) * 256 + gi * 32; }
    if (pn < 12) return C_V + (pn - 8) * 256 + gi * 32;
    if (pn < 16) return C_G + (pn - 12) * 256 + gi * 32;
    if (pn < 24) return (gi < 4 ? C_SV : C_SC) + (pn - 16) * 128 + (gi & 3) * 32;
    if (pn < 28) return C_SB + (pn - 24) * 256 + gi * 32;
    return (gi < 4 ? C_GA : C_GB) + (pn - 28) * 128 + (gi & 3) * 32;
}
__device__ __forceinline__ void p0_prologue(Frame& F) {
    const int gw = F.vcu * NWAVES + F.wave, NGW = F.G * NWAVES, gt = F.vcu * NTHR + F.tid, NGT = F.G * NTHR;
    for (int i = gt; i < HF; i += NGT) wsp<float>(F, WS_LB)[i] = 1.f / (1.f + __expf(F.lbl[HF + i] - F.lbl[i]));
    for (int i = gt; i < D * NE; i += NGT) { const int k = i >> 5, e = i & 31; const float v = F.w_r[i] * F.nfw[k]; const unsigned h = f2bf(v); const float lo = v - bf2f((unsigned short)h);
        wsp<bf16_t>(F, WS_WRH)[e * D + k] = (bf16_t)h; wsp<bf16_t>(F, WS_WRL)[e * D + k] = (bf16_t)f2bf(lo); }
    for (int i = gt; i < 48 * HF; i += NGT) { wsp<h16_t>(F, WS_LFM)[i] = (h16_t)0.f; wsp<bf16_t>(F, WS_VVM)[i] = 0; }
    {
        LAS float* hnm = (LAS float*)F.lds;
        for (int r = F.wave * 2; r < F.wave * 2 + 2; ++r) {
            const f32x4* xr = (const f32x4*)(F.meta + (size_t)r * D) + F.lane; f32x4 v[8]; float s = 0.f;
#pragma unroll
            for (int j = 0; j < 8; ++j) { v[j] = xr[64 * j]; s += (v[j].x * v[j].x + v[j].y * v[j].y) + (v[j].z * v[j].z + v[j].w * v[j].w); }
            const float rs = rsqrtf(wave_sum(s) * (1.f / D) + EPS);
#pragma unroll
            for (int j = 0; j < 8; ++j) { const f32x4 w = ((const f32x4*)F.nmw)[F.lane + 64 * j]; *(LAS f32x4*)(hnm + r * D + 4 * F.lane + 256 * j) = v[j] * rs * w; }
        }
        __syncthreads();
        LAS float* red = (LAS float*)(F.lds + TOK_OFF);
        for (int cb = F.vcu; cb < 256; cb += F.G) {
            const int col = F.tid & 15, ks = F.tid >> 4;
            int gcol;
            if (cb < 64) gcol = C_F + 16 * cb + col; else if (cb < 128) gcol = C_V + 16 * (cb - 64) + col; else gcol = (col < 8 ? C_SV : C_SC) + 8 * (cb - 128) + (col & 7);
            float a[16];
#pragma unroll
            for (int r = 0; r < 16; ++r) a[r] = 0.f;
#pragma unroll 8
            for (int k = ks * 64; k < ks * 64 + 64; ++k) { const float w = F.w_in[(size_t)k * INC + gcol];
#pragma unroll
                for (int r = 0; r < 16; ++r) a[r] = fmaf(hnm[r * D + k], w, a[r]); }
#pragma unroll
            for (int r = 0; r < 16; ++r) { a[r] += __shfl_xor(a[r], 16); a[r] += __shfl_xor(a[r], 32); }
            if (F.lane < 16) {
#pragma unroll
                for (int r = 0; r < 16; ++r) red[(F.wave * 16 + r) * 16 + col] = a[r]; }
            __syncthreads();
            if (F.tid < 256) { const int r = F.tid >> 4, c = F.tid & 15; float v = 0.f;
#pragma unroll
                for (int w = 0; w < 8; ++w) v += red[(w * 16 + r) * 16 + c];
                if (cb < 64) { const int ch = 16 * cb + c; const float l = 1.f / (1.f + __expf(F.lbl[HF + ch] - F.lbl[ch])); wsp<h16_t>(F, WS_LFM)[(48 + r) * HF + ch] = (h16_t)__logf(l + (1.f - l) * sigmoidf_(v)); }
                else if (cb < 128) wsp<bf16_t>(F, WS_VVM)[(48 + r) * HF + 16 * (cb - 64) + c] = (bf16_t)f2bf(v);
                else red[2048 + r * 16 + c] = v; }
            __syncthreads();
            if (cb >= 128 && F.tid < 128) { const int r = F.tid >> 3, c = F.tid & 7; wsp<bf16_t>(F, WS_UUM)[r * HF + 8 * (cb - 128) + c] = (bf16_t)f2bf(red[2048 + r * 16 + c] * red[2048 + r * 16 + c + 8]); }
            __syncthreads();
        }
        __syncthreads();
    }
    {
        LAS unsigned* T = (LAS unsigned*)(F.lds + F.wave * 16384);
        constexpr int I_IN = 32 * 4 * N_INB, I_AB = 16 * 32, I_O = 32 * 32, I_UP1 = 16 * 64, I_DN1 = 16 * 32;
        constexpr int I_IN8 = 16 * 4 * N_IN8;
        constexpr int NIT = I_IN + I_IN8 + 2 * I_AB + I_O;
        for (int it = gw; it < NIT; it += NGW) {
            int r = it;
            if (r < I_IN) { const int kb = r / (4 * N_INB), ntl = r % (4 * N_INB), nt = 4 * nth_bit(INB_MASK, ntl >> 2) + (ntl & 3); bool p0, p1; const int s0 = win_src(2 * nt, p0), s1 = win_src(2 * nt + 1, p1); tr_tile(F.w_in, INC, kb * 64, s0, s1, p0, p1, F.nmw, wsp<bf16_t>(F, WS_WIN), D, nt * 64, 0, T, F.lane); continue; } r -= I_IN;
            if (r < I_IN8) { const int kb = r / (4 * N_IN8), ntl = r % (4 * N_IN8), nt = 4 * nth_bit(IN8_MASK, ntl >> 2) + (ntl & 3); bool p0, p1; const int s0 = win_src(2 * nt, p0), s1 = win_src(2 * nt + 1, p1);
                tr_tile_fp8<0>(F.w_in, INC, kb * 128, s0, s1, F.nmw, wsp<unsigned char>(F, WS_WIN8), D, nt * 64, T, F.lane, p0); continue; } r -= I_IN8;
            if (r < I_AB) { const int kb = r / 32, nt = r % 32; tr_tile(F.w_ho, D, kb * 64, nt * 64, nt * 64 + 32, true, true, nullptr, wsp<bf16_t>(F, WS_WAB), D, nt * 64, 0, T, F.lane); continue; } r -= I_AB;
            if (r < I_AB) { const int kb = r / 32, nt = r % 32; tr_tile(F.w_co, D, kb * 64, nt * 64, nt * 64 + 32, true, true, nullptr, wsp<bf16_t>(F, WS_WAB), D, nt * 64, HF, T, F.lane); continue; } r -= I_AB;
            if (r < I_O) { const int kb = r / 32, nt = r % 32; tr_tile(F.w_o, D, kb * 64, nt * 64, nt * 64 + 32, true, true, nullptr, wsp<bf16_t>(F, WS_WO), D, nt * 64, 0, T, F.lane); continue; } r -= I_O;
        }
    }
    for (int m = gw; m < M; m += NGW) {
        const GAS f32x4* xr = (const GAS f32x4*)(F.x + (size_t)m * D) + F.lane; f32x4 v[8]; float s = 0.f;
#pragma unroll
        for (int j = 0; j < 8; ++j) v[j] = xr[64 * j];
        __builtin_amdgcn_sched_barrier(0);
#pragma unroll
        for (int j = 0; j < 8; ++j) s += (v[j].x * v[j].x + v[j].y * v[j].y) + (v[j].z * v[j].z + v[j].w * v[j].w);
        s = wave_sum(s);
        const float rsx = rsqrtf(s * (1.f / D) + EPS);
#pragma unroll
        for (int j = 0; j < 8; ++j) v[j] *= rsx;
        GAS u32x2* o8 = (GAS u32x2*)(wsp<bf16_t>(F, WS_XB) + (size_t)m * D) + F.lane;
#pragma unroll
        for (int j = 0; j < 8; ++j) { u32x2 w; w.x = pk2(v[j].x, v[j].y); w.y = pk2(v[j].z, v[j].w); o8[64 * j] = w; }
        GAS unsigned* o4 = (GAS unsigned*)(wsp<unsigned char>(F, WS_XB8) + (size_t)m * D) + F.lane;
#pragma unroll
        for (int j = 0; j < 8; ++j) o4[64 * j] = pk4_fp8(v[j].x, v[j].y, v[j].z, v[j].w);
    }
}

template <int PMODE = 0> __device__ __forceinline__ void p1_convert(Frame& F, int rank, int nconv) {
    LAS unsigned* T = (LAS unsigned*)(F.lds + F.wave * 16384);
    constexpr int I_UP1 = 16 * 64, I_DN1 = 16 * 32, NIT = NE * (I_UP1 + I_DN1);
    for (int it = rank * NWAVES + F.wave; it < NIT; it += nconv * NWAVES) {
        int r = it;
        if (r < NE * I_UP1) { const int e = r / I_UP1, q = r % I_UP1, kb = q / 64, nt = q % 64, G0 = 2 * nt, pn = G0 >> 3, gi = G0 & 7; const int s0 = (gi < 4 ? 0 : 2048) + pn * 128 + (gi & 3) * 32;
            tr_tile_fp8<PMODE>(F.w_up + (size_t)e * D * 4096, 4096, kb * 128, s0, s0 + 32, F.nfw, wsp<unsigned char>(F, WS_WUP) + (size_t)e * 4096 * D, D, nt * 64, T, F.lane); continue; } r -= NE * I_UP1;
        { const int e = r / I_DN1, q = r % I_DN1, kb = q / 32, nt = q % 32;
          tr_tile_fp8<PMODE>(F.w_dn + (size_t)e * DFF * D, D, kb * 128, nt * 64, nt * 64 + 32, nullptr, wsp<unsigned char>(F, WS_WDN) + (size_t)e * D * DFF, DFF, nt * 64, T, F.lane); }
    }
}

constexpr int KTP = 72;
constexpr int QP_ = 136;
__device__ __forceinline__ void vt_load(const Frame& F, const bf16_t* Vb, size_t row0, int h, u32x4 (&w)[2]) {
#pragma unroll
    for (int q = 0; q < 2; ++q) { const int id = F.tid + 512 * q, t = id >> 4, v8 = (id & 15) * 8; w[q] = *(const GAS u32x4*)(Vb + (row0 + t) * HF + h * 128 + v8); }
}
__device__ __forceinline__ void vt_store(const Frame& F, const u32x4 (&w)[2], LAS bf16_t* VT) {
#pragma unroll
    for (int q = 0; q < 2; ++q) { const int id = F.tid + 512 * q, t = id >> 4, v8 = (id & 15) * 8; const unsigned ww[4] = {w[q].x, w[q].y, w[q].z, w[q].w};
        const int ts = t ^ (v8 & 24);
#pragma unroll
        for (int i = 0; i < 4; ++i) { VT[(v8 + 2 * i) * KTP + ts] = (bf16_t)(ww[i] & 0xffffu); VT[(v8 + 2 * i + 1) * KTP + ts] = (bf16_t)(ww[i] >> 16); } }
}
__device__ __forceinline__ int vt_off(int v, int t0) { return v * KTP + (t0 ^ (v & 24)); }
struct P2aRegs { float L[16]; u32x4 vw[2]; };
__device__ __forceinline__ void p2a_where(const Frame& F, int u, const h16_t*& Lb, const bf16_t*& Vb, size_t& row0, int& h, int& slot) {
    if (u < 8) { Lb = wsp<h16_t>(F, WS_LFM); Vb = wsp<bf16_t>(F, WS_VVM); row0 = 0; h = u; slot = 32 * 64 + u; }
    else { const int bh = (u - 8) >> 6, c = (u - 8) & 63, b = bh >> 3; h = bh & 7; Lb = wsp<h16_t>(F, WS_LF); Vb = wsp<bf16_t>(F, WS_VV); row0 = (size_t)b * SEQ + 64 * c; slot = bh * 64 + c; }
}
__device__ __forceinline__ void p2a_load(const Frame& F, int u, P2aRegs& R) {
    const h16_t* Lb; const bf16_t* Vb; size_t row0; int h, slot; p2a_where(F, u, Lb, Vb, row0, h, slot);
    const int d = F.tid & 127, tq = F.tid >> 7;
#pragma unroll
    for (int i = 0; i < 16; ++i) R.L[i] = (float)Lb[(row0 + 16 * tq + i) * HF + h * 128 + d];
    vt_load(F, Vb, row0, h, R.vw);
}
__device__ __forceinline__ void p2a_compute(Frame& F, int u, const P2aRegs& R) {
    LAS bf16_t* KT = (LAS bf16_t*)F.lds; LAS bf16_t* VT = KT + 128 * KTP; LAS float* TOT = (LAS float*)(F.lds + 2 * 128 * KTP * 2);
    const h16_t* Lb; const bf16_t* Vb; size_t row0; int h, slot; p2a_where(F, u, Lb, Vb, row0, h, slot);
    const int d = F.tid & 127, tq = F.tid >> 7;
    float cs[16]; float run = 0.f;
#pragma unroll
    for (int i = 0; i < 16; ++i) { run += R.L[i]; cs[i] = run; }
    TOT[tq * 128 + d] = run;
    vt_store(F, R.vw, VT);
    __syncthreads();
    float off = 0.f, total = 0.f;
#pragma unroll
    for (int q = 0; q < 4; ++q) { const float tv = TOT[q * 128 + d]; total += tv; if (q < tq) off += tv; }
#pragma unroll
    for (int i = 0; i < 16; i += 2) { const float k0 = (1.f - __expf(R.L[i])) * __expf(total - off - cs[i]), k1 = (1.f - __expf(R.L[i + 1])) * __expf(total - off - cs[i + 1]);
        *(LAS unsigned*)(KT + d * KTP + 16 * tq + i) = pk2(k0, k1); }
    if (tq == 0) wsp<float>(F, WS_DEC)[(size_t)slot * 128 + d] = __expf(total);
    __syncthreads();
    {
        const int w = F.wave, fr = F.lane & 15, fq = F.lane >> 4;
        bf16x8 a[2];
#pragma unroll
        for (int ks = 0; ks < 2; ++ks) a[ks] = *(const LAS bf16x8*)(KT + (16 * w + fr) * KTP + 32 * ks + 8 * fq);
        bf16_t* Ub = wsp<bf16_t>(F, WS_UC) + (size_t)slot * 16384;
#pragma unroll
        for (int vb = 0; vb < 8; ++vb) { f32x4 c = (f32x4){0.f, 0.f, 0.f, 0.f};
#pragma unroll
            for (int ks = 0; ks < 2; ++ks) { const bf16x8 bv = *(const LAS bf16x8*)(VT + vt_off(16 * vb + fr, 32 * ks + 8 * fq)); c = __builtin_amdgcn_mfma_f32_16x16x32_bf16(a[ks], bv, c, 0, 0, 0); }
            u32x2 o; o.x = pk2(c[0], c[1]); o.y = pk2(c[2], c[3]);
            *(GAS u32x2*)(Ub + (16 * vb + fr) * 128 + 16 * w + 4 * fq) = o; }
    }
    __syncthreads();
}
__device__ __forceinline__ void p2a_units(Frame& F, int c) {
    constexpr int NU = 2048 + 8;
    if (c >= NU) return;
    P2aRegs R; p2a_load(F, c, R);
    for (int u = c; u < NU; u += F.G) {
        P2aRegs N; const int un = u + F.G; if (un < NU) p2a_load(F, un, N); else N = R;
        p2a_compute(F, u, R);
        R = N;
    }
}
__device__ __forceinline__ void p2a_conv(Frame& F, int item) {
    const int c8 = (F.tid & 127) * 8, tq = F.tid >> 7, r0 = item * 64 + tq * 16, p0 = r0 & (SEQ - 1);
    const bf16_t* UU = wsp<bf16_t>(F, WS_UU); const bf16_t* UUM = wsp<bf16_t>(F, WS_UUM); const bf16_t* SBb = wsp<bf16_t>(F, WS_SB); bf16_t* A2 = wsp<bf16_t>(F, WS_A2);
    f32x4 w0a = *(const f32x4*)(F.cw + c8), w0b = *(const f32x4*)(F.cw + c8 + 4), w1a = *(const f32x4*)(F.cw + HF + c8), w1b = *(const f32x4*)(F.cw + HF + c8 + 4), w2a = *(const f32x4*)(F.cw + 2 * HF + c8), w2b = *(const f32x4*)(F.cw + 2 * HF + c8 + 4);
    f32x4 um2a, um2b, um1a, um1b;
    { const u32x4 a = (p0 >= 2) ? *(const GAS u32x4*)(UU + (size_t)(r0 - 2) * HF + c8) : *(const GAS u32x4*)(UUM + (14 + p0) * HF + c8); unpack8(a, um2a, um2b);
      const u32x4 b = (p0 >= 1) ? *(const GAS u32x4*)(UU + (size_t)(r0 - 1) * HF + c8) : *(const GAS u32x4*)(UUM + 15 * HF + c8); unpack8(b, um1a, um1b); }
#pragma unroll 4
    for (int i = 0; i < 16; ++i) { f32x4 ua, ub, sa, sb; unpack8(*(const GAS u32x4*)(UU + (size_t)(r0 + i) * HF + c8), ua, ub); unpack8(*(const GAS u32x4*)(SBb + (size_t)(r0 + i) * HF + c8), sa, sb);
        const f32x4 oa = sa * (w0a * um2a + w1a * um1a + w2a * ua), ob = sb * (w0b * um2b + w1b * um1b + w2b * ub);
        *(GAS u32x4*)(A2 + (size_t)(r0 + i) * D + HF + c8) = pack8(oa, ob);
        um2a = um1a; um2b = um1b; um1a = ua; um1b = ub; }
}
__device__ __forceinline__ void p2b_scan(Frame& F) {
    const int gw = F.vcu * NWAVES + F.wave;
    for (int it = gw; it < 1024; it += F.G * NWAVES) {
        const int item = it * 64 + F.lane, bh = item >> 11, e8 = item & 2047, h = bh & 7, d0 = (e8 & 15) * 8;
        const bf16_t* Ub = wsp<bf16_t>(F, WS_UC) + (size_t)bh * 64 * 16384 + e8 * 8; bf16_t* Sb = wsp<bf16_t>(F, WS_SS) + (size_t)bh * 64 * 16384 + e8 * 8;
        const float* Db = wsp<float>(F, WS_DEC) + (size_t)bh * 64 * 128 + d0;
        f32x4 s0, s1; unpack8(*(const GAS u32x4*)(wsp<bf16_t>(F, WS_UC) + (size_t)(32 * 64 + h) * 16384 + e8 * 8), s0, s1);
#pragma unroll 8
        for (int c = 0; c < 64; ++c) {
            *(GAS u32x4*)(Sb + (size_t)c * 16384) = pack8(s0, s1);
            f32x4 u0, u1; unpack8(*(const GAS u32x4*)(Ub + (size_t)c * 16384), u0, u1);
            const f32x4 g0 = *(const GAS f32x4*)(Db + c * 128), g1 = *(const GAS f32x4*)(Db + c * 128 + 4);
            s0 = g0 * s0 + u0; s1 = g1 * s1 + u1;
        }
    }
}
struct P2cRegs { f32x2 L[8]; unsigned qw[8]; u32x4 vw[2]; bf16x8 sa[4]; u32x2 gv[4]; };
__device__ __forceinline__ void p2c_load(const Frame& F, int u, P2cRegs& R) {
    const int bh = u >> 6, c = u & 63, b = bh >> 3, h = bh & 7; const size_t row0 = (size_t)b * SEQ + 64 * c;
    const int dp = (F.tid & 63) * 2, t8 = F.tid >> 6, w = F.wave, fr = F.lane & 15, fq = F.lane >> 4;
    const h16_t* Lb = wsp<h16_t>(F, WS_LF) + (row0 + 8 * t8) * HF + h * 128 + dp; const bf16_t* Qb = wsp<bf16_t>(F, WS_QS) + (row0 + 8 * t8) * HF + h * 128 + dp;
#pragma unroll
    for (int i = 0; i < 8; ++i) { const h16x2 lh = *(const GAS h16x2*)(Lb + (size_t)i * HF); R.L[i] = (f32x2){(float)lh.x, (float)lh.y}; R.qw[i] = *(const GAS unsigned*)(Qb + (size_t)i * HF); }
    vt_load(F, wsp<bf16_t>(F, WS_VV), row0, h, R.vw);
    const bf16_t* Sb = wsp<bf16_t>(F, WS_SS) + ((size_t)bh * 64 + c) * 16384 + (16 * w + fr) * 128 + 8 * fq;
#pragma unroll
    for (int ks = 0; ks < 4; ++ks) R.sa[ks] = *(const GAS bf16x8*)(Sb + 32 * ks);
    const bf16_t* GSb = wsp<bf16_t>(F, WS_GS);
#pragma unroll
    for (int tb = 0; tb < 4; ++tb) R.gv[tb] = *(const GAS u32x2*)(GSb + (row0 + 16 * tb + fr) * HF + h * 128 + 16 * w + 4 * fq);
}
__device__ __forceinline__ void p2c_compute(Frame& F, int u, const P2cRegs& R) {
    const int bh = u >> 6, c = u & 63, b = bh >> 3, h = bh & 7; const size_t row0 = (size_t)b * SEQ + 64 * c;
    LAS bf16_t* QPl = (LAS bf16_t*)F.lds; LAS bf16_t* QD = QPl + 64 * QP_; LAS bf16_t* KI = QD + 64 * QP_; LAS bf16_t* VT = KI + 160 * QP_; LAS bf16_t* PL = VT + 128 * KTP;
    LAS float* TOT8 = (LAS float*)(PL + 64 * KTP); LAS float* SSQ = TOT8 + 8 * 128;
    const int dp = (F.tid & 63) * 2, t8 = F.tid >> 6;
    f32x2 L[8], cs[8], q[8]; f32x2 run = (f32x2){0.f, 0.f};
#pragma unroll
    for (int i = 0; i < 8; ++i) { L[i] = R.L[i]; q[i] = (f32x2){bflo(R.qw[i]), bfhi(R.qw[i])}; }
#pragma unroll
    for (int i = 0; i < 8; ++i) { run += L[i]; cs[i] = run; }
    *(LAS f32x2*)(TOT8 + t8 * 128 + dp) = run;
    vt_store(F, R.vw, VT);
    for (int i = F.tid; i < 64 * KTP / 2; i += NTHR) ((LAS unsigned*)PL)[i] = 0u;
    __syncthreads();
    {
        f32x2 pre[9]; pre[0] = (f32x2){0.f, 0.f};
#pragma unroll
        for (int j = 0; j < 8; ++j) pre[j + 1] = pre[j] + *(const LAS f32x2*)(TOT8 + j * 128 + dp);
        f32x2 off = (f32x2){0.f, 0.f};
#pragma unroll
        for (int j = 0; j < 8; ++j) if (j == t8) off = pre[j];
        const int si = t8 >> 1;
        f32x2 st[4];
#pragma unroll
        for (int j = 0; j < 4; ++j) st[j] = pre[2 * j];
        f32x2 sti = st[0];
#pragma unroll
        for (int j = 1; j < 4; ++j) if (j == si) sti = st[j];
#pragma unroll
        for (int i = 0; i < 8; ++i) { const int t = 8 * t8 + i; const f32x2 bc = off + cs[i];
            *(LAS unsigned*)(QPl + t * QP_ + dp) = pk2(q[i].x * __expf(bc.x), q[i].y * __expf(bc.y));
            *(LAS unsigned*)(QD + t * QP_ + dp) = pk2(q[i].x * __expf(bc.x - sti.x), q[i].y * __expf(bc.y - sti.y));
            const f32x2 k = (f32x2){1.f - __expf(L[i].x), 1.f - __expf(L[i].y)};
#pragma unroll
            for (int j = 0; j < 4; ++j) if (j >= si) {
                *(LAS unsigned*)(KI + (8 * j * (j + 1) + t) * QP_ + dp) = pk2(k.x * __expf(fminf(st[j].x - bc.x, 80.f)), k.y * __expf(fminf(st[j].y - bc.y, 80.f))); }
        }
    }
    __syncthreads();
    const int w = F.wave, fr = F.lane & 15, fq = F.lane >> 4;
    for (int bi = w; bi < 10; bi += 8) {
        const int i = bi < 1 ? 0 : bi < 3 ? 1 : bi < 6 ? 2 : 3, j = bi - (i * (i + 1)) / 2;
        f32x4 cacc = (f32x4){0.f, 0.f, 0.f, 0.f};
#pragma unroll
        for (int ks = 0; ks < 4; ++ks) { const bf16x8 a = *(const LAS bf16x8*)(KI + (8 * i * (i + 1) + 16 * j + fr) * QP_ + 32 * ks + 8 * fq), bq = *(const LAS bf16x8*)(QD + (16 * i + fr) * QP_ + 32 * ks + 8 * fq);
            cacc = __builtin_amdgcn_mfma_f32_16x16x32_bf16(a, bq, cacc, 0, 0, 0); }
        if (i == j) {
#pragma unroll
            for (int r = 0; r < 4; ++r) if (4 * fq + r > fr) cacc[r] = 0.f; }
        u32x2 o; o.x = pk2(cacc[0], cacc[1]); o.y = pk2(cacc[2], cacc[3]);
        *(LAS u32x2*)(PL + (16 * i + fr) * KTP + 16 * j + 4 * fq) = o;
    }
    __syncthreads();
    f32x4 acc[4];
#pragma unroll
    for (int tb = 0; tb < 4; ++tb) acc[tb] = (f32x4){0.f, 0.f, 0.f, 0.f};
    {
#pragma unroll
        for (int ks = 0; ks < 4; ++ks)
#pragma unroll
            for (int tb = 0; tb < 4; ++tb) { const bf16x8 bq = *(const LAS bf16x8*)(QPl + (16 * tb + fr) * QP_ + 32 * ks + 8 * fq); acc[tb] = __builtin_amdgcn_mfma_f32_16x16x32_bf16(R.sa[ks], bq, acc[tb], 0, 0, 0); }
#pragma unroll
        for (int ks = 0; ks < 2; ++ks) { const bf16x8 va = *(const LAS bf16x8*)(VT + vt_off(16 * w + fr, 32 * ks + 8 * fq));
#pragma unroll
            for (int tb = 0; tb < 4; ++tb) { const bf16x8 bp = *(const LAS bf16x8*)(PL + (16 * tb + fr) * KTP + 32 * ks + 8 * fq); acc[tb] = __builtin_amdgcn_mfma_f32_16x16x32_bf16(va, bp, acc[tb], 0, 0, 0); } }
    }
#pragma unroll
    for (int tb = 0; tb < 4; ++tb) { float p = (acc[tb][0] * acc[tb][0] + acc[tb][1] * acc[tb][1]) + (acc[tb][2] * acc[tb][2] + acc[tb][3] * acc[tb][3]); p += __shfl_xor(p, 16); p += __shfl_xor(p, 32);
        if (fq == 0) SSQ[w * 64 + 16 * tb + fr] = p; }
    __syncthreads();
    {
        const f32x4 gw4 = *(const f32x4*)(F.gnw + 16 * w + 4 * fq);
        bf16_t* A2 = wsp<bf16_t>(F, WS_A2);
#pragma unroll
        for (int tb = 0; tb < 4; ++tb) { const int t = 16 * tb + fr; float ss = 0.f;
#pragma unroll
            for (int ww = 0; ww < 8; ++ww) ss += SSQ[ww * 64 + t];
            const float rs = rsqrtf(ss * (1.f / 128.f) + EPS);
            const u32x2 gv = R.gv[tb];
            const f32x4 o = acc[tb] * rs * gw4 * (f32x4){bflo(gv.x), bfhi(gv.x), bflo(gv.y), bfhi(gv.y)};
            u32x2 ov; ov.x = pk2(o[0], o[1]); ov.y = pk2(o[2], o[3]);
            *(GAS u32x2*)(A2 + (row0 + t) * D + h * 128 + 16 * w + 4 * fq) = ov; }
    }
    __syncthreads();
}
__device__ __forceinline__ void p2c_units(Frame& F, int c) {
    constexpr int NU = 2048;
    if (c >= NU) return;
    P2cRegs R; p2c_load(F, c, R);
    for (int u = c; u < NU; u += F.G) {
        P2cRegs N; const int un = u + F.G; if (un < NU) p2c_load(F, un, N); else N = R;
        p2c_compute(F, u, R);
        R = N;
    }
}

__device__ __forceinline__ void split8(const f32x4 a, const f32x4 b, bf16x8& hi, bf16x8& lo) {
    u32x4 h, l;
    h.x = cvt_pk_bf16(a[0], a[1]); h.y = cvt_pk_bf16(a[2], a[3]); h.z = cvt_pk_bf16(b[0], b[1]); h.w = cvt_pk_bf16(b[2], b[3]);
    l.x = cvt_pk_bf16(a[0] - bflo(h.x), a[1] - bfhi(h.x)); l.y = cvt_pk_bf16(a[2] - bflo(h.y), a[3] - bfhi(h.y)); l.z = cvt_pk_bf16(b[0] - bflo(h.z), b[1] - bfhi(h.z)); l.w = cvt_pk_bf16(b[2] - bflo(h.w), b[3] - bfhi(h.w));
    hi = __builtin_bit_cast(bf16x8, h); lo = __builtin_bit_cast(bf16x8, l);
}
__device__ __forceinline__ void p5_router(Frame& F) {
    const int fr = F.lane & 15, fq = F.lane >> 4, wq = F.wave & 3, kh = F.wave >> 2;
    LAS float* lg = (LAS float*)(F.lds + F.wave * 4096);
    LAS float* pa = (LAS float*)(F.lds + 32768) + (wq * 64 + F.lane) * 9;
    const bf16_t* DL = wsp<bf16_t>(F, WS_H1); unsigned char* H1B = wsp<unsigned char>(F, WS_H1B); const bf16_t* WH = wsp<bf16_t>(F, WS_WRH); const bf16_t* WL = wsp<bf16_t>(F, WS_WRL);
    for (int it = F.vcu * 4 + wq; it < M / 16; it += F.G * 4) {
        const int row0 = it * 16, kofs = 1024 * kh;
        const float* hp = F.x + (size_t)(row0 + fr) * D + kofs + 8 * fq; const bf16_t* dp_ = DL + (size_t)(row0 + fr) * D + kofs + 8 * fq; unsigned char* qp = H1B + (size_t)(row0 + fr) * D + kofs + 8 * fq;
        const bf16_t* wh0 = WH + (size_t)fr * D + kofs + 8 * fq; const bf16_t* wl0 = WL + (size_t)fr * D + kofs + 8 * fq;
        f32x4 a0 = (f32x4){0.f, 0.f, 0.f, 0.f}, a1 = a0; float ss = 0.f;
#pragma unroll 4
        for (int ks = 0; ks < 32; ++ks) {
            f32x4 xa = *(const GAS f32x4*)(hp + 32 * ks), xb = *(const GAS f32x4*)(hp + 32 * ks + 4); { f32x4 da, db; unpack8(*(const GAS u32x4*)(dp_ + 32 * ks), da, db); xa += da; xb += db; }
            *(GAS u32x2*)(qp + 32 * ks) = pack8_fp8(xa, xb);
            *(GAS u32x4*)((bf16_t*)dp_ + 32 * ks) = pack8(xa, xb);
            ss += (xa[0] * xa[0] + xa[1] * xa[1]) + (xa[2] * xa[2] + xa[3] * xa[3]) + (xb[0] * xb[0] + xb[1] * xb[1]) + (xb[2] * xb[2] + xb[3] * xb[3]);
            bf16x8 xh, xl; split8(xa, xb, xh, xl);
            const bf16x8 bh0 = *(const GAS bf16x8*)(wh0 + 32 * ks), bl0 = *(const GAS bf16x8*)(wl0 + 32 * ks), bh1 = *(const GAS bf16x8*)(wh0 + 16 * D + 32 * ks), bl1 = *(const GAS bf16x8*)(wl0 + 16 * D + 32 * ks);
            a0 = __builtin_amdgcn_mfma_f32_16x16x32_bf16(xh, bh0, a0, 0, 0, 0); a0 = __builtin_amdgcn_mfma_f32_16x16x32_bf16(xh, bl0, a0, 0, 0, 0);
            a0 = __builtin_amdgcn_mfma_f32_16x16x32_bf16(xl, bh0, a0, 0, 0, 0); a0 = __builtin_amdgcn_mfma_f32_16x16x32_bf16(xl, bl0, a0, 0, 0, 0);
            a1 = __builtin_amdgcn_mfma_f32_16x16x32_bf16(xh, bh1, a1, 0, 0, 0); a1 = __builtin_amdgcn_mfma_f32_16x16x32_bf16(xh, bl1, a1, 0, 0, 0);
            a1 = __builtin_amdgcn_mfma_f32_16x16x32_bf16(xl, bh1, a1, 0, 0, 0); a1 = __builtin_amdgcn_mfma_f32_16x16x32_bf16(xl, bl1, a1, 0, 0, 0);
        }
        if (kh == 1) {
#pragma unroll
            for (int r = 0; r < 4; ++r) { pa[r] = a0[r]; pa[4 + r] = a1[r]; }
            pa[8] = ss; }
        __syncthreads();
        if (kh == 0) {
#pragma unroll
            for (int r = 0; r < 4; ++r) { a0[r] += pa[r]; a1[r] += pa[4 + r]; }
            ss += pa[8];
            ss += __shfl_xor(ss, 16); ss += __shfl_xor(ss, 32);
#pragma unroll
            for (int r = 0; r < 4; ++r) { lg[(4 * fq + r) * 33 + fr] = a0[r]; lg[(4 * fq + r) * 33 + 16 + fr] = a1[r]; }
            LDS_WAIT(); asm volatile("" ::: "memory");
            if (F.lane < 16) {
                const int tokn = row0 + F.lane; const float rs = rsqrtf(ss * (1.f / D) + EPS);
                float v[32];
#pragma unroll
                for (int e = 0; e < 32; ++e) v[e] = lg[F.lane * 33 + e] * rs + F.b_r[e];
                int idx[4]; float val[4];
#pragma unroll
                for (int k = 0; k < 4; ++k) { float bv = -3.0e38f; int bi = 0;
#pragma unroll
                    for (int e = 0; e < 32; ++e) { const bool tk = v[e] > bv; bv = tk ? v[e] : bv; bi = tk ? e : bi; }
                    idx[k] = bi; val[k] = bv;
#pragma unroll
                    for (int e = 0; e < 32; ++e) v[e] = (e == bi) ? -3.0e38f : v[e]; }
                float ex[4], den = 0.f;
#pragma unroll
                for (int k = 0; k < 4; ++k) { ex[k] = __expf(val[k] - val[0]); den += ex[k]; }
                const float inv = 1.f / den;
                wsp<float>(F, WS_RS2)[tokn] = rs;
                int pos[4];
#pragma unroll
                for (int k = 0; k < 4; ++k) pos[k] = (int)__hip_atomic_fetch_add(F.ctl + CW_CNT + 64 * idx[k], 1u, __ATOMIC_RELAXED, __HIP_MEMORY_SCOPE_AGENT);
#pragma unroll
                for (int k = 0; k < 4; ++k) {
                    wsp<int>(F, WS_TOPE)[tokn * 4 + k] = idx[k]; wsp<int>(F, WS_TOPP)[tokn * 4 + k] = pos[k]; wsp<float>(F, WS_TOPW)[tokn * 4 + k] = ex[k] * inv;
                    wsp<int>(F, WS_LIST)[(size_t)idx[k] * CAPF + pos[k]] = tokn; }
            }
        }
        __syncthreads();
    }
}
__device__ __forceinline__ void build_pref(Frame& F) {
    if (F.wave == 0) {
        int tl = 0;
        if (F.lane < NE) { const unsigned c = __hip_atomic_load(F.ctl + CW_CNT + 64 * F.lane, RLX_AGENT); tl = (int)((c + 255u) >> 8); }
        int s = tl;
#pragma unroll
        for (int d = 1; d < 32; d <<= 1) { const int v = __shfl_up(s, d); if (F.lane >= d) s += v; }
        if (F.lane < NE) F.MISC[16 + F.lane] = (unsigned)(s - tl);
        if (F.lane == NE - 1) F.MISC[16 + NE] = (unsigned)(s < MAXRT ? s : MAXRT); }
    __syncthreads();
}
__device__ __forceinline__ void build_tok(Frame& F, const MoeOrder& S) {
    LAS int* tokt = (LAS int*)(F.lds + TOK_OFF); LAS bf16_t* bt = (LAS bf16_t*)(F.lds + BIAS_OFF);
    volatile LAS int* um = (volatile LAS int*)(F.MISC + 64);
    if (F.tid < 18) { Unit u; int base = -1, nv = 0, bo = 0;
        if (S.template next<false>(F.tid, u)) { const int rt = u.pm - (int)F.MISC[16 + u.e]; const int cnt = (int)__hip_atomic_load(F.ctl + CW_CNT + 64 * u.e, RLX_AGENT);
            base = u.e * CAPF + rt * 256; nv = cnt - rt * 256; nv = nv < 0 ? 0 : (nv > 256 ? 256 : nv); bo = u.e * 4096 + u.pn * 128; }
        um[4 * F.tid] = base; um[4 * F.tid + 1] = nv; um[4 * F.tid + 2] = bo; }
    __syncthreads();
    if (F.tid < 256) { int t[18]; float r[18]; const int* LIST = wsp<int>(F, WS_LIST); const float* RS2 = wsp<float>(F, WS_RS2);
#pragma unroll
        for (int i = 0; i < 18; ++i) { const int base = um[4 * i], nv = um[4 * i + 1]; t[i] = (base >= 0 && F.tid < nv) ? LIST[base + F.tid] : -1; }
#pragma unroll
        for (int i = 0; i < 18; ++i) r[i] = (t[i] >= 0) ? RS2[t[i]] * W8_INV : 0.f;
#pragma unroll
        for (int i = 0; i < 18; ++i) if (um[4 * i] >= 0) tokt[i * 256 + F.tid] = (int)((f2bf(r[i]) << 16) | (unsigned)(t[i] < 0 ? 0 : t[i])); }
    else {
        const int j = F.tid - 256, col = j < 128 ? j : 2048 + (j - 128); float bq[18];
#pragma unroll
        for (int i = 0; i < 18; ++i) bq[i] = (um[4 * i] >= 0) ? F.b_up[um[4 * i + 2] + col] : 0.f;
#pragma unroll
        for (int i = 0; i < 18; ++i) bt[i * 256 + j] = (bf16_t)f2bf(bq[i]); }
    __syncthreads();
}
__device__ __forceinline__ void build_bias_dn(Frame& F, const MoeOrder& S) {
    LAS float* bt = (LAS float*)(F.lds + TOK_OFF);
    volatile LAS int* um = (volatile LAS int*)(F.MISC + 64);
    if (F.tid < 9) { Unit u; int bo = -1; if (S.template next<false>(F.tid, u)) bo = u.e * D + u.pn * 256; um[F.tid] = bo; }
    __syncthreads();
    if (F.tid < 256) { float bq[9];
#pragma unroll
        for (int i = 0; i < 9; ++i) bq[i] = (um[i] >= 0) ? F.b_dn[um[i] + F.tid] : 0.f;
#pragma unroll
        for (int i = 0; i < 9; ++i) bt[i * 256 + F.tid] = bq[i]; }
    __syncthreads();
}
struct P9Tok { f32x4 v[8]; unsigned y[4][8]; f32x4 tw; };
template <int PM> __device__ __forceinline__ void p9_issue(const Frame& F, int m, P9Tok& T) {
    typedef int i32x4 __attribute__((ext_vector_type(4)));
    const bf16_t* DL = wsp<bf16_t>(F, WS_H1); const unsigned char* YR = wsp<unsigned char>(F, WS_YR);
    const i32x4 te = *(const GAS i32x4*)(wsp<int>(F, WS_TOPE) + m * 4), tp = *(const GAS i32x4*)(wsp<int>(F, WS_TOPP) + m * 4); T.tw = *(const GAS f32x4*)(wsp<float>(F, WS_TOPW) + m * 4);
#pragma unroll
    for (int j = 0; j < 8; ++j) { const u32x2 dw = (PM == 4) ? (u32x2){(unsigned)m, 0u} : *(const GAS u32x2*)(DL + (size_t)m * D + 4 * F.lane + 256 * j);
        T.v[j] = (f32x4){bflo(dw.x), bfhi(dw.x), bflo(dw.y), bfhi(dw.y)}; }
#pragma unroll
    for (int k = 0; k < 4; ++k) { const size_t row = (size_t)((const LAS unsigned*)F.MISC)[16 + te[k]] * 256 + tp[k];
#pragma unroll
        for (int j = 0; j < 8; ++j) T.y[k][j] = (PM == 1) ? (unsigned)row : *(const GAS unsigned*)(YR + row * D + 4 * F.lane + 256 * j); }
}
template <int PM> __device__ __forceinline__ void p9_finish(const Frame& F, int m, P9Tok& T, float* outp) {
#pragma unroll
    for (int k = 0; k < 4; ++k)
#pragma unroll
        for (int j = 0; j < 8; ++j) { const f32x2 p0 = __builtin_amdgcn_cvt_pk_f32_fp8((int)T.y[k][j], false), p1 = __builtin_amdgcn_cvt_pk_f32_fp8((int)T.y[k][j], true); T.v[j] += (f32x4){p0.x, p0.y, p1.x, p1.y} * T.tw[k]; }
    float s = 0.f;
#pragma unroll
    for (int j = 0; j < 8; ++j) s += (T.v[j][0] * T.v[j][0] + T.v[j][1] * T.v[j][1]) + (T.v[j][2] * T.v[j][2] + T.v[j][3] * T.v[j][3]);
    const float rs = rsqrtf(wave_sum(s) * (1.f / D) + EPS);
#pragma unroll
    for (int j = 0; j < 8; ++j) { const f32x4 w = *(const f32x4*)(F.fnw + 4 * F.lane + 256 * j); const f32x4 o = T.v[j] * rs * w;
        if (PM == 2) asm volatile("" :: "v"(o)); else *(GAS f32x4*)(outp + (size_t)m * D + 4 * F.lane + 256 * j) = o; }
}
template <int PM> __device__ __forceinline__ void p9_combine_t(Frame& F, float* outp) {
    const int gw = F.vcu * NWAVES + F.wave, NGW9 = F.G * NWAVES;
    for (int m = gw; m < M; m += 2 * NGW9) {
        const int m2 = m + NGW9; const bool two = m2 < M;
        P9Tok A, B; p9_issue<PM>(F, m, A); p9_issue<PM>(F, two ? m2 : m, B);
        __builtin_amdgcn_sched_barrier(0);
        p9_finish<PM>(F, m, A, outp); if (two) p9_finish<PM>(F, m2, B, outp);
    }
}
__device__ __forceinline__ void p9_combine(Frame& F) { p9_combine_t<0>(F, F.out); }
constexpr int NPH = 11;
struct Args { const float* in[18]; float* out; unsigned char* ws; int ph_lo, ph_hi; };

__global__ void __launch_bounds__(NTHR, 2) fwd_kernel(Args args) {
    extern __shared__ __attribute__((aligned(16))) unsigned char lds_raw[];
    Frame F;
    F.lds = (LAS unsigned char*)lds_raw; F.MISC = (volatile LAS unsigned*)(F.lds + MISC_OFF);
    F.wave = __builtin_amdgcn_readfirstlane((int)threadIdx.x >> 6);
#define REFRESH() do { F.lane = lane_id(); F.tid = F.wave * 64 + F.lane; } while (0)
    REFRESH();
    F.G = gridDim.x; { const int bx = blockIdx.x; F.vcu = (F.G % 8 == 0) ? (bx % 8) * (F.G / 8) + bx / 8 : bx; }
    F.ws = args.ws; F.ctl = (gu32*)(args.ws + WS_CTL); F.out = args.out;
    F.x = args.in[0]; F.meta = args.in[1]; F.nmw = args.in[2]; F.w_in = args.in[3]; F.lbl = args.in[4]; F.gnw = args.in[5]; F.w_ho = args.in[6]; F.cw = args.in[7]; F.w_co = args.in[8]; F.w_o = args.in[9];
    F.nfw = args.in[10]; F.w_r = args.in[11]; F.b_r = args.in[12]; F.w_up = args.in[13]; F.b_up = args.in[14]; F.w_dn = args.in[15]; F.b_dn = args.in[16]; F.fnw = args.in[17];
    for (int u = F.tid; u < 256; u += NTHR) F.MISC[u] = 0u;
    __syncthreads();
    const int lo = args.ph_lo, hi = args.ph_hi;
    const bool multi = (hi - lo) > 1;
    XcdBarrier bar; bar.bar = (unsigned*)(F.ctl + CW_BAR); bar.x = 0; bar.st = nullptr;
    if (multi) bar = xcd_barrier_post((unsigned*)(F.ctl + CW_BAR), F.MISC, F.tid);
#define IN(k) (lo <= (k) && (k) < hi)
#if defined(FK_STAMP_A)
#define STAMP(k) do { if (blockIdx.x == 0 && F.tid == 0) __hip_atomic_store(F.ctl + CW_TS + (k), (unsigned)__builtin_amdgcn_s_memrealtime(), RLX_AGENT); } while (0)
#else
#define STAMP(k) do { } while (0)
#endif
#if defined(FK_PROBE_BAR)
#define SEAM(k) do { REFRESH(); if (IN(k) && IN((k) + 1)) { xcd_barrier(bar, F.tid); xcd_barrier(bar, F.tid); xcd_barrier(bar, F.tid); } STAMP((k) + 1); } while (0)
#else
#define SEAM(k) do { REFRESH(); if (IN(k) && IN((k) + 1)) xcd_barrier(bar, F.tid); STAMP((k) + 1); } while (0)
#endif
    STAMP(0);
    const int c = blockIdx.x;
#ifndef FK_DUP_MASK
#define FK_DUP_MASK 0
#endif
#ifndef FK_DUP_REPS
#define FK_DUP_REPS 1
#endif
#define DUP(k) for (int _rep = 0; _rep < 1 + FK_DUP_REPS * ((FK_DUP_MASK >> (k)) & 1); ++_rep)
#define REDO(k) do { if (((FK_DUP_MASK >> (k)) & 1) && _rep < FK_DUP_REPS) { REFRESH(); xcd_barrier(bar, F.tid); } } while (0)

    if (IN(0)) DUP(0) { p0_prologue(F); REDO(0); } SEAM(0);

    if (IN(1)) DUP(1) {
        constexpr int NCONV_PER8 = 3;
        const int cq = c >> 3; const bool conv = (F.G % 64 == 0) && ((cq & 7) < NCONV_PER8) && (_rep == 0);
        if (F.G % 64 != 0 && _rep == 0) { if (c == 0) p1_convert(F, 0, 1); }
        if (conv) { const int nconv = (F.G / 64) * 8 * NCONV_PER8, rank = ((cq >> 3) * NCONV_PER8 + (cq & 7)) * 8 + (c & 7); p1_convert(F, rank, nconv);
#if defined(FK_PROBE_CONV2)
            __syncthreads(); p1_convert<FK_PROBE_CONV2 - 1>(F, rank, nconv);
#endif
        }
        __syncthreads();
        EpiInproj E{wsp<float>(F, WS_RS1), wsp<float>(F, WS_LB), wsp<bf16_t>(F, WS_QS), wsp<bf16_t>(F, WS_VV), wsp<bf16_t>(F, WS_GS), wsp<bf16_t>(F, WS_UU), wsp<bf16_t>(F, WS_SB), wsp<bf16_t>(F, WS_RT), wsp<bf16_t>(F, WS_GBS), wsp<h16_t>(F, WS_LF), 1.f};
        if (N_INB > 0) {
            GemmDesc g{wsp<bf16_t>(F, WS_XB), wsp<bf16_t>(F, WS_WIN), D, INC / 256};
            DynOrder S; S.init(M, INB_MASK, N_INB, c, (unsigned*)(F.ctl + CW_Q + 64 * (c & 7) + 8 * _rep), F.MISC + 4, F.tid);
            gemm_phase<EpiInproj, DynOrder, false, true, false>(F.lds, g, S, E, nullptr, F.wave); }
        if (N_IN8 > 0) {
            REFRESH(); E.osc = 1.f / W8_SCALE;
            GemmDesc g{(const bf16_t*)wsp<unsigned char>(F, WS_XB8), (const bf16_t*)wsp<unsigned char>(F, WS_WIN8), D, INC / 256};
            DynOrder S; S.init(M, IN8_MASK, N_IN8, c, (unsigned*)(F.ctl + CW_Q + 64 * (c & 7) + 8 * _rep + 4), F.MISC + 6, F.tid);
            gemm_phase<EpiInproj, DynOrder, false, true, true>(F.lds, g, S, E, nullptr, F.wave); }
        REDO(1);
    } SEAM(1);

#if defined(FK_PROBE_GEMM)
    if (IN(1)) {
        GemmDesc g{wsp<bf16_t>(F, WS_XB), wsp<bf16_t>(F, WS_WIN), D, INC / 256}; ProbeOrder S; S.S.init(M, INC, F.G, c); S.mode = FK_PROBE_GEMM & 3; S.c = c;
        EpiDummy E{wsp<bf16_t>(F, WS_ACT), (FK_PROBE_GEMM >> 2) & 1};
        gemm_phase<EpiDummy, ProbeOrder, false, true, false>(F.lds, g, S, E, nullptr, F.wave);
        REFRESH(); xcd_barrier(bar, F.tid);
    }
#endif
    if (IN(2)) DUP(2) { p2a_units(F, c); for (int it = c; it < M / 64; it += F.G) p2a_conv(F, it); REDO(2); } SEAM(2);
    if (IN(3)) DUP(3) { p2b_scan(F); REDO(3); } SEAM(3);
    if (IN(4)) DUP(4) { p2c_units(F, c); REDO(4); } SEAM(4);

    if (IN(5)) DUP(5) {
        GemmDesc g{wsp<bf16_t>(F, WS_A2), wsp<bf16_t>(F, WS_WAB), D, D / 256}; StaticOrder S; S.init(M, D, F.G, c);
        EpiMerge E{wsp<bf16_t>(F, WS_RT), wsp<bf16_t>(F, WS_GBS), wsp<bf16_t>(F, WS_MG)};
        gemm_phase<EpiMerge, StaticOrder, false, true, false>(F.lds, g, S, E, nullptr, F.wave); REDO(5);
    } SEAM(5);

    if (IN(6)) DUP(6) {
        GemmDesc g{wsp<bf16_t>(F, WS_MG), wsp<bf16_t>(F, WS_WO), D, D / 256}; StaticOrder S; S.init(M, D, F.G, c);
        EpiWo E{wsp<bf16_t>(F, WS_H1)};
        gemm_phase<EpiWo, StaticOrder, false, true, false>(F.lds, g, S, E, nullptr, F.wave); REDO(6);
    } SEAM(6);

    if (IN(7)) { p5_router(F); } SEAM(7);

    if (IN(8)) DUP(8) {
        build_pref(F);
        MoeOrder S; S.init(16, F.G, c, (const volatile LAS int*)(F.MISC + 16));
        build_tok(F, S);
        GemmDesc g{wsp<bf16_t>(F, WS_H1B), wsp<bf16_t>(F, WS_WUP), D, 16};
        EpiUp E{wsp<float>(F, WS_RS2), (const LAS int*)(F.lds + TOK_OFF), (const LAS bf16_t*)(F.lds + BIAS_OFF), wsp<unsigned char>(F, WS_ACT)};
        gemm_phase<EpiUp, MoeOrder, true, true, true>(F.lds, g, S, E, (const LAS int*)(F.lds + TOK_OFF), F.wave); REDO(8);
    } SEAM(8);

    if (IN(9)) DUP(9) {
        build_pref(F);
        MoeOrder S; S.init(8, F.G, c, (const volatile LAS int*)(F.MISC + 16));
        GemmDesc g{wsp<bf16_t>(F, WS_ACT), wsp<bf16_t>(F, WS_WDN), DFF, 8};
        build_bias_dn(F, S);
        EpiDown E{(const LAS float*)(F.lds + TOK_OFF), wsp<unsigned char>(F, WS_YR)};
        gemm_phase<EpiDown, MoeOrder, false, true, true>(F.lds, g, S, E, nullptr, F.wave); REDO(9);
    } SEAM(9);

#if defined(FK_PROBE_P8)
    if (IN(10)) {
        build_pref(F);
        ProbeMoe S; S.S.init(8, F.G, c, (const volatile LAS int*)(F.MISC + 16)); S.mode = FK_PROBE_P8 & 3;
        GemmDesc g{wsp<bf16_t>(F, WS_ACT), wsp<bf16_t>(F, WS_WDN), DFF, 8};
        EpiDummy E{wsp<bf16_t>(F, WS_XB), 1};
        for (int r = 0; r < 2; ++r) { gemm_phase<EpiDummy, ProbeMoe, false, true, true>(F.lds, g, S, E, nullptr, F.wave); REFRESH(); xcd_barrier(bar, F.tid); }
    }
#endif
    if (IN(10)) DUP(10) { build_pref(F); p9_combine(F); REDO(10); }
#if defined(FK_PROBE_P9)
    if (IN(10)) { for (int r = 0; r < 4; ++r) { REFRESH(); xcd_barrier(bar, F.tid); p9_combine_t<FK_PROBE_P9 - 1>(F, wsp<float>(F, WS_XB)); } }
#endif
#undef IN
#undef DUP
#undef REDO
#undef SEAM
#undef STAMP
#undef REFRESH
}

inline void launch_fast(hipStream_t stream, void* const* d_in, float* out, unsigned char* ws, int n_launches) {
    static int grid = 0;
    if (grid == 0) {
        int dev = 0, cus = 0, per_cu = 0;
        if (hipGetDevice(&dev) != hipSuccess || hipDeviceGetAttribute(&cus, hipDeviceAttributeMultiprocessorCount, dev) != hipSuccess) { fprintf(stderr, "kernel_launch: device query failed\n"); grid = -1; return; }
        if (hipFuncSetAttribute((const void*)fwd_kernel, hipFuncAttributeMaxDynamicSharedMemorySize, LDS_BYTES) != hipSuccess) { fprintf(stderr, "kernel_launch: hipFuncSetAttribute failed\n"); grid = -1; return; }
        if (hipOccupancyMaxActiveBlocksPerMultiprocessor(&per_cu, (const void*)fwd_kernel, NTHR, LDS_BYTES) != hipSuccess || per_cu < 1) fprintf(stderr, "kernel_launch: note: occupancy query says %d blocks per CU\n", per_cu);
        (void)hipGetLastError();
        grid = cus;
    }
    if (grid < 0) return;
    (void)hipMemsetAsync(ws + WS_CTL, 0, CTL_BYTES, stream);
    Args a{};
    for (int i = 0; i < 18; ++i) a.in[i] = (const float*)d_in[i];
    a.out = out; a.ws = ws;
    for (int li = 0; li < n_launches; ++li) {
        a.ph_lo = (n_launches == 1) ? 0 : li; a.ph_hi = (n_launches == 1) ? NPH : li + 1;
        hipLaunchKernelGGL(fwd_kernel, dim3(grid), dim3(NTHR), LDS_BYTES, stream, a);
        const hipError_t le = hipPeekAtLastError();
        if (le != hipSuccess) { fprintf(stderr, "kernel_launch: launch %d failed: %s\n", li, hipGetErrorName(le)); break; }
    }
}
}
#ifndef FK_LAUNCHES
#define FK_LAUNCHES 1
#endif
extern "C" void kernel_launch(void* const* d_in, const int* in_sizes, int n_in, void* d_out, int out_size, void* d_ws, size_t ws_size, hipStream_t stream) {
    if (n_in != 18 || ws_size < fk::WS_FAST_END) { fprintf(stderr, "kernel_launch: n_in %d, ws %zu < %zu\n", n_in, ws_size, (size_t)fk::WS_FAST_END); return; }
    fk::launch_fast(stream, d_in, (float*)d_out, (unsigned char*)d_ws, FK_LAUNCHES);
}
```

```cpp
#include <hip/hip_runtime.h>
#include <cstdio>
#define FK_LAUNCHES 1
#define FK_IN8_MASK 0xFFFF000F0FFull
#define FK_WO8 0
namespace fk {
#define LAS __attribute__((address_space(3)))
#define GAS __attribute__((address_space(1)))
typedef unsigned short bf16_t;
typedef short bf16x8 __attribute__((ext_vector_type(8)));
typedef float f32x4 __attribute__((ext_vector_type(4)));
typedef float f32x2 __attribute__((ext_vector_type(2)));
typedef unsigned u32x4 __attribute__((ext_vector_type(4)));
typedef unsigned u32x2 __attribute__((ext_vector_type(2)));
typedef GAS unsigned gu32;
typedef _Float16 h16_t;
typedef _Float16 h16x4 __attribute__((ext_vector_type(4)));
typedef _Float16 h16x2 __attribute__((ext_vector_type(2)));
#define RLX_AGENT __ATOMIC_RELAXED, __HIP_MEMORY_SCOPE_AGENT
#define LDS_WAIT() asm volatile("s_waitcnt lgkmcnt(0)" ::: "memory")
#define VM_WAIT() asm volatile("s_waitcnt vmcnt(0)" ::: "memory")

constexpr int D = 2048, NB = 4, SEQ = 4096, M = NB * SEQ, NMETA = 16;
constexpr int HF = 1024, INC = 11264, NE = 32, DFF = 2048, NCH = SEQ / 64;
constexpr int C_Q = 0, C_F = 1024, C_V = 2048, C_G = 3072, C_SV = 4096, C_SB = 5120, C_SC = 6144, C_GA = 7168, C_GB = 9216;
constexpr float EPS = 1e-6f;
constexpr int CAPF = M;
constexpr int MAXRT = 288;
constexpr int NWAVES = 8, NTHR = 512;

constexpr size_t al(size_t x) { return (x + 0xFFFFF) & ~(size_t)0xFFFFF; }
constexpr size_t WS_CTL = 0, CTL_BYTES = 65536;
constexpr size_t WS_LB = 65536, WS_RS1 = WS_LB + 4096, WS_RS2 = WS_RS1 + 65536, WS_WRH = WS_RS2 + 65536, WS_WRL = WS_WRH + 131072;
constexpr size_t WS_LFM = WS_WRL + 131072, WS_VVM = WS_LFM + 64 * 1024 * 4, WS_UUM = WS_VVM + 64 * 1024 * 2, WS_SMALL_END = WS_UUM + 16 * 1024 * 2;
constexpr size_t WS_TOPE = al(WS_SMALL_END), WS_TOPP = WS_TOPE + (size_t)M * 16, WS_TOPW = WS_TOPP + (size_t)M * 16, WS_LIST = WS_TOPW + (size_t)M * 16;
constexpr size_t WS_DEC = al(WS_LIST + (size_t)NE * CAPF * 4);
constexpr size_t WS_WIN = al(WS_DEC + (size_t)33 * 64 * 128 * 4);
constexpr size_t WS_WAB = al(WS_WIN + (size_t)INC * D * 2);
constexpr size_t WS_WO = al(WS_WAB + (size_t)D * D * 2);
constexpr size_t WS_WUP = al(WS_WO + (size_t)D * D * 2);
constexpr size_t WS_WDN = al(WS_WUP + (size_t)NE * 4096 * D);
constexpr size_t WS_XB = al(WS_WDN + (size_t)NE * D * DFF);
constexpr size_t WS_QS = al(WS_XB + (size_t)M * D * 2);
constexpr size_t WS_LF = al(WS_QS + (size_t)M * HF * 2);
constexpr size_t WS_VV = al(WS_LF + (size_t)M * HF * 2);
constexpr size_t WS_GS = al(WS_VV + (size_t)M * HF * 2);
constexpr size_t WS_UU = al(WS_GS + (size_t)M * HF * 2);
constexpr size_t WS_SB = al(WS_UU + (size_t)M * HF * 2);
constexpr size_t WS_RT = al(WS_SB + (size_t)M * HF * 2);
constexpr size_t WS_GBS = al(WS_RT + (size_t)M * D * 2);
constexpr size_t WS_UC = al(WS_GBS + (size_t)M * D * 2);
constexpr size_t WS_SS = al(WS_UC + (size_t)(32 * 64 + 8) * 16384 * 2);
constexpr size_t WS_A2 = al(WS_SS + (size_t)32 * 64 * 16384 * 2);
constexpr size_t WS_MG = al(WS_A2 + (size_t)M * D * 2);
constexpr size_t WS_H1 = al(WS_MG + (size_t)M * D * 2);
constexpr size_t WS_H1B = al(WS_H1 + (size_t)M * D * 2);
constexpr size_t WS_ACT = al(WS_H1B + (size_t)M * D);
constexpr size_t WS_YR = al(WS_ACT + (size_t)MAXRT * 256 * DFF);
constexpr size_t WS_WIN8 = al(WS_YR + (size_t)MAXRT * 256 * D);
constexpr size_t WS_XB8 = al(WS_WIN8 + (size_t)INC * D);
constexpr size_t WS_FAST_END = al(WS_XB8 + (size_t)M * D);
#ifndef FK_IN8_MASK
#define FK_IN8_MASK 0xFFFF00000F0ull
#endif
constexpr unsigned long long IN8_MASK = FK_IN8_MASK;
constexpr unsigned long long INB_MASK = ((1ull << 44) - 1) & ~IN8_MASK;
constexpr int cpop(unsigned long long m) { int n = 0; while (m) { m &= m - 1; ++n; } return n; }
constexpr int N_IN8 = cpop(IN8_MASK), N_INB = 44 - N_IN8;
__device__ __forceinline__ int nth_bit(unsigned long long m, int n) { for (int i = 0; i < n; ++i) m &= m - 1; return __builtin_ctzll(m); }
constexpr int CW_TMO = 0;
constexpr int CW_CNT = 1024;
constexpr int CW_Q = 3400;
constexpr int CW_TS = 3200;
constexpr int CW_BAR = 4096;
constexpr int RING_BYTES = 131072;
constexpr int TOK_OFF = RING_BYTES, TOK_BYTES = 18 * 1024;
constexpr int MISC_OFF = TOK_OFF + TOK_BYTES;
constexpr int BIAS_OFF = MISC_OFF + 1024, BIAS_BYTES = 18 * 512;
constexpr int LDS_BYTES = BIAS_OFF + BIAS_BYTES;
static_assert(LDS_BYTES <= 160 * 1024, "LDS");

__device__ __forceinline__ float sigmoidf_(float x) { return 1.f / (1.f + __expf(-x)); }
__device__ __forceinline__ unsigned f2bf(float f) { unsigned u = __builtin_bit_cast(unsigned, f); return (u + 0x7fffu + ((u >> 16) & 1u)) >> 16; }
__device__ __forceinline__ unsigned pk2(float lo, float hi) { return f2bf(lo) | (f2bf(hi) << 16); }
__device__ __forceinline__ float bf2f(unsigned short b) { return __builtin_bit_cast(float, ((unsigned)b) << 16); }
__device__ __forceinline__ float bflo(unsigned w) { return __builtin_bit_cast(float, w << 16); }
__device__ __forceinline__ float bfhi(unsigned w) { return __builtin_bit_cast(float, w & 0xffff0000u); }
__device__ __forceinline__ unsigned cvt_pk_bf16(float lo, float hi) { unsigned r; asm volatile("v_cvt_pk_bf16_f32 %0, %1, %2" : "=v"(r) : "v"(lo), "v"(hi)); return r; }
__device__ __forceinline__ unsigned pk4_fp8(float a, float b, float c, float d) { int w = 0; w = __builtin_amdgcn_cvt_pk_fp8_f32(a, b, w, false); w = __builtin_amdgcn_cvt_pk_fp8_f32(c, d, w, true); return (unsigned)w; }
constexpr float W8_SCALE = 64.f, W8_INV = 1.f / 64.f;
__device__ __forceinline__ int lane_id() { int l; asm volatile("v_mbcnt_lo_u32_b32 %0, -1, 0\n\tv_mbcnt_hi_u32_b32 %0, -1, %0" : "=v"(l)); return l; }
__device__ __forceinline__ float wave_sum(float v) {
#pragma unroll
    for (int o = 1; o < 64; o <<= 1) v += __shfl_xor(v, o);
    return v;
}

#define XB_TMO      128
#define XB_XCNT(j)  (256  + 64 * (j))
#define XB_XSUB(j)  (1280 + 64 * (j))
#define XB_XGEN(j)  (2304 + 64 * (j))
#define XB_TOP      3328
#define XB_TOPGEN   3392
#define XCD_BAR_WORDS 3456
#define XB_SPIN_CAP (1u << 18)
__device__ __forceinline__ unsigned xb_ld(unsigned* p)              { return __hip_atomic_load(p, __ATOMIC_RELAXED, __HIP_MEMORY_SCOPE_AGENT); }
__device__ __forceinline__ unsigned xb_add(unsigned* p, unsigned v) { return __hip_atomic_fetch_add(p, v, __ATOMIC_RELAXED, __HIP_MEMORY_SCOPE_AGENT); }
__device__ __forceinline__ unsigned xb_xcc_id() { return (unsigned)__builtin_amdgcn_s_getreg((3 << 11) | 20) & 0xFu; }
#define XB_SPIN(cond, bar) do { unsigned _sp = 0; while (cond) { __builtin_amdgcn_s_sleep(1); \
    if ((++_sp & 255u) == 0u) { if (xb_ld(&(bar)[XB_TMO])) break; if (_sp > XB_SPIN_CAP) { atomicAdd(&(bar)[XB_TMO], 1u); break; } } } } while (0)
struct XcdBarrier { unsigned* bar; unsigned x; volatile LAS unsigned* st; };
__device__ __forceinline__ XcdBarrier xcd_barrier_post(unsigned* bar, volatile LAS unsigned* st, int tid) {
    XcdBarrier b; b.bar = bar; b.x = xb_xcc_id(); b.st = st;
    if (tid == 0) (void)xb_add(&bar[XB_XCNT(b.x)], 1u);
    return b;
}
__device__ __forceinline__ void xcd_barrier_complete(unsigned* bar, unsigned x, unsigned& nloc, unsigned& nx) {
    const unsigned G = gridDim.x * gridDim.y * gridDim.z;
    unsigned sum, cnt, mine, sp = 0u;
    for (;;) {
        sum = 0u; cnt = 0u; mine = 0u;
#pragma unroll
        for (unsigned j = 0; j < 16; ++j) { const unsigned c = xb_ld(&bar[XB_XCNT(j)]); sum += c; cnt += (c > 0u) ? 1u : 0u; mine = (j == x) ? c : mine; }
        if (sum == G) break;
        __builtin_amdgcn_s_sleep(1);
        if ((++sp & 255u) == 0u) { if (xb_ld(&bar[XB_TMO])) break; if (sp > XB_SPIN_CAP) { atomicAdd(&bar[XB_TMO], 1u); break; } }
    }
    nloc = mine > 0u ? mine : 1u; nx = cnt > 0u ? cnt : 1u;
}
__device__ __forceinline__ void xcd_barrier(const XcdBarrier& b, int tid) {
    asm volatile("s_waitcnt vmcnt(0)" ::: "memory");
    __syncthreads();
    if (tid == 0) {
        unsigned* bar = b.bar;
        __builtin_amdgcn_s_waitcnt(0);
        unsigned nloc = b.st[0], nx = b.st[1];
        if (nloc == 0u) { xcd_barrier_complete(bar, b.x, nloc, nx); b.st[0] = nloc; b.st[1] = nx; }
        const unsigned old = xb_add(&bar[XB_XSUB(b.x)], 1u);
        const unsigned gen = old / nloc;
        if (old + 1u == (gen + 1u) * nloc) {
            __builtin_amdgcn_fence(__ATOMIC_RELEASE, "agent");
            asm volatile("s_waitcnt vmcnt(0)" ::: "memory");
            const unsigned og = xb_add(&bar[XB_TOP], 1u);
            const unsigned tg = og / nx;
            if (og + 1u == (tg + 1u) * nx) xb_add(&bar[XB_TOPGEN], 1u);
            else XB_SPIN(xb_ld(&bar[XB_TOPGEN]) == tg, bar);
            __builtin_amdgcn_fence(__ATOMIC_ACQUIRE, "agent");
            xb_add(&bar[XB_XGEN(b.x)], 1u);
            asm volatile("s_waitcnt vmcnt(0)" ::: "memory");
        } else {
            XB_SPIN(xb_ld(&bar[XB_XGEN(b.x)]) == gen, bar);
            __builtin_amdgcn_fence(__ATOMIC_ACQUIRE, "agent");
            asm volatile("s_waitcnt vmcnt(0)" ::: "memory");
        }
    }
    __syncthreads();
}

constexpr int BM = 256, BK = 64, HALF = 128, HTB = HALF * BK * 2, NXCD = 8, WGM = 8;
__host__ __device__ __forceinline__ int lds_byte(int r, int c) { const int st = (r >> 4) * 2 + (c >> 5), rr = r & 15, cc = c & 31, ob = rr * 64 + cc * 2; return st * 1024 + (ob ^ (((ob >> 9) & 1) << 5)); }
__host__ __device__ __forceinline__ void stage_rc(int b, int& R, int& C) { const int st = b / 1024, sb = b % 1024, swz = sb ^ (((sb >> 9) & 1) << 5); R = (st >> 1) * 16 + swz / 64; C = (st & 1) * 32 + (swz % 64) / 2; }
__host__ __device__ __forceinline__ int perm32(int rho) { const int n = rho >> 4, i = rho & 15; return 8 * (i >> 2) + 4 * n + (i & 3); }

typedef int i32x8 __attribute__((ext_vector_type(8)));
typedef int i32x4v __attribute__((ext_vector_type(4)));
__device__ __forceinline__ i32x8 cat8(const bf16x8 a, const bf16x8 b) { const i32x4v x = __builtin_bit_cast(i32x4v, a), y = __builtin_bit_cast(i32x4v, b); return __builtin_shufflevector(x, y, 0, 1, 2, 3, 4, 5, 6, 7); }
__device__ __forceinline__ void mfma8(f32x4& acc, const i32x8 a, const i32x8 b, const int sc) {
    asm volatile("s_nop 1\n\tv_mfma_scale_f32_16x16x128_f8f6f4 %0, %1, %2, %0, %3, %3 op_sel_hi:[0,0,0]" : "+v"(acc) : "v"(a), "v"(b), "v"(sc));
}
struct Unit { int pm, pn, e, ui; };

struct StaticOrder {
    int nM, nN, nwg, G, c;
    __device__ __forceinline__ void pre(int) const {}
    __device__ void init(int M_, int N_, int G_, int c_) { nM = M_ / BM; nN = N_ / BM; nwg = nM * nN; G = G_; c = c_; }
    __device__ __forceinline__ bool next(int i, Unit& u) const {
        const long L = (long)i * G + c; if (L >= nwg) return false;
        int wgid = (int)L; { const int q = nwg / NXCD, r = nwg % NXCD, xcd = wgid % NXCD, off = wgid / NXCD; wgid = (xcd < r ? xcd * (q + 1) : r * (q + 1) + (xcd - r) * q) + off; }
        const int nig = WGM * nN, gid = wgid / nig, fm = gid * WGM, gsz = (nM - fm) < WGM ? (nM - fm) : WGM;
        u.pm = fm + ((wgid % nig) % gsz); u.pn = (wgid % nig) / gsz; u.e = 0; u.ui = i; return true;
    }
};
struct DynOrder {
    int nM, nN, nwg, x; unsigned* head; volatile LAS unsigned* slot; int tid; unsigned long long mask;
    __device__ void init(int M_, unsigned long long mask_, int nN_, int c_, unsigned* head_, volatile LAS unsigned* slot_, int tid_) { nM = M_ / BM; nN = nN_; mask = mask_; nwg = nM * nN; x = c_ & 7; head = head_; slot = slot_; tid = tid_; }
    mutable unsigned pend;
    __device__ __forceinline__ void pre(int) const {
        if (tid == 0) { unsigned z; asm volatile("v_mov_b32 %0, 0" : "=v"(z));
            pend = __hip_atomic_fetch_add(head + z, 1u, __ATOMIC_RELAXED, __HIP_MEMORY_SCOPE_AGENT); } }
    __device__ __forceinline__ bool next(int i, Unit& u) const {
        if (tid == 0) slot[i & 1] = pend;
        asm volatile("s_waitcnt lgkmcnt(0)" ::: "memory"); __builtin_amdgcn_s_barrier(); asm volatile("" ::: "memory");
        const int j = (int)slot[i & 1], q = nwg / NXCD;
        if (j >= q) return false;
        const int wgid = x * q + j;
        const int nig = WGM * nN, gid = wgid / nig, fm = gid * WGM, gsz = (nM - fm) < WGM ? (nM - fm) : WGM;
        u.pm = fm + ((wgid % nig) % gsz); u.pn = nth_bit(mask, (wgid % nig) / gsz); u.e = 0; u.ui = i; return true;
    }
};
struct MoeOrder {
    int nct, NT, G, c; const volatile LAS int* pref;
    __device__ __forceinline__ void pre(int) const {}
    __device__ void init(int nct_, int G_, int c_, const volatile LAS int* pref_) { nct = nct_; G = G_; c = c_; pref = pref_; NT = pref_[NE]; }
    template <bool UNIFORM = true> __device__ __forceinline__ bool next(int i, Unit& u) const {
        int rtg, pn;
        if (G == 256) { const int x = c & 7, jj = c >> 3;
            if (nct == 16) { rtg = 16 * i + 8 * (x & 1) + (jj & 7); pn = 4 * (x >> 1) + (jj >> 3); }
            else           { rtg = 32 * i + 8 * (x & 3) + (jj & 7); pn = 4 * (x >> 2) + (jj >> 3); } }
        else { const int U = i * G + c; rtg = U / nct; pn = U - rtg * nct; }
        if (rtg >= NT) return false;
        u.pn = pn; u.pm = rtg; u.ui = i;
        int e = 0;
        if constexpr (UNIFORM) { const int l = lane_id(); const int pv = (l >= 1 && l < NE) ? pref[l] : 0x7fffffff; e = (int)__builtin_popcountll(__ballot(pv <= rtg)); }
        else {
#pragma unroll 1
            for (int j = 1; j < NE; ++j) e = (pref[j] <= rtg) ? j : e; }
        u.e = e; return true;
    }
};

struct GemmDesc { const bf16_t* A; const bf16_t* Bt; int K; int nct; };

template <class Epi, class Sched, bool GATHER, bool ALIGN_EPI, bool FP8>
__device__ __forceinline__ void gemm_phase(LAS unsigned char* lds, const GemmDesc g, const Sched& S, const Epi& E, const LAS int* tok, int wid) {
    const int lane = lane_id(), tid = wid * 64 + lane, wr = wid >> 2, wc = wid & 3, fr = lane & 15, fq = lane >> 4;
    const int K = g.K, KB = FP8 ? K : 2 * K  , nt = FP8 ? K / 128 : K / BK;
    int Rl[2], Cl[2];
    unsigned voffA[2], voffB[2];
#pragma unroll
    for (int i = 0; i < 2; ++i) { int Cc; stage_rc(tid * 16 + i * 8192, Rl[i], Cc); const int p = Cc >> 3; Cl[i] = FP8 ? 16 * (2 * (p & 3) + (p >> 2)) : 2 * Cc; voffA[i] = (unsigned)(Rl[i] * KB + Cl[i]); voffB[i] = voffA[i]; }
    const size_t kstep = (size_t)(BK * 2);
    const size_t hstep = (size_t)HALF * KB;
    const size_t tstep = 2 * hstep;
    const unsigned ldsw = (unsigned)wid * 1024u;
    const int aoff = lds_byte(wr * 64 + fr, fq * 8), boff = lds_byte(wc * 32 + fr, fq * 8);
#define PG8_SA(b, h) (((b) * 2 + (h)) * HTB)
#define PG8_SB(b, h) ((4 + (b) * 2 + (h)) * HTB)
#define PG8_STAGE(bufoff, gbase, voff) do { _Pragma("unroll") for (int _i = 0; _i < 2; ++_i) \
        __builtin_amdgcn_global_load_lds((const unsigned*)((const char*)(gbase) + (voff)[_i]), (LAS unsigned*)(lds + (bufoff) + ldsw + _i * 8192), 16, 0, 0); } while (0)
#define PG8_STAGE_A(bufoff, ptr, half, o0, o1) do { if constexpr (GATHER) { PG8_STAGE(bufoff, ptr, (half) ? o1 : o0); } else { PG8_STAGE(bufoff, (ptr) + (half) * hstep, voffA); } } while (0)
#define PG8_LDA(dst, b, h) do { _Pragma("unroll") for (int m = 0; m < 4; ++m) _Pragma("unroll") for (int k = 0; k < 2; ++k) dst[m][k] = *(const LAS bf16x8*)(lds + PG8_SA(b, h) + aoff + m * 2048 + k * 1024); } while (0)
#define PG8_LDB(dst, b, h) do { _Pragma("unroll") for (int n = 0; n < 2; ++n) _Pragma("unroll") for (int k = 0; k < 2; ++k) dst[n][k] = *(const LAS bf16x8*)(lds + PG8_SB(b, h) + boff + n * 2048 + k * 1024); } while (0)
#define PG8_MMA(ai, bj, At, Bt) do { __builtin_amdgcn_s_setprio(1); _Pragma("unroll") for (int m = 0; m < 4; ++m) _Pragma("unroll") for (int n = 0; n < 2; ++n) _Pragma("unroll") for (int k = 0; k < 2; ++k) \
        acc[ai][bj][m][n] = __builtin_amdgcn_mfma_f32_16x16x32_bf16(Bt[n][k], At[m][k], acc[ai][bj][m][n], 0, 0, 0); __builtin_amdgcn_s_setprio(0); } while (0)
#define PG8_MMA8(ai, bj, At, Bt) do { __builtin_amdgcn_s_setprio(1); _Pragma("unroll") for (int m = 0; m < 4; ++m) _Pragma("unroll") for (int n = 0; n < 2; ++n) \
        mfma8(acc[ai][bj][m][n], cat8(Bt[n][0], Bt[n][1]), cat8(At[m][0], At[m][1]), sc8); __builtin_amdgcn_s_setprio(0); } while (0)
#define PG8_MM(ai, bj, At, Bt) do { if constexpr (FP8) PG8_MMA8(ai, bj, At, Bt); else PG8_MMA(ai, bj, At, Bt); } while (0)
#define PG8_WAIT_V(n) asm volatile("s_waitcnt vmcnt(" #n ")" ::: "memory")
#define PG8_WAIT_L(n) asm volatile("s_waitcnt lgkmcnt(" #n ")" ::: "memory")
#define PG8_BAR __builtin_amdgcn_s_barrier()
#define PG8_SCHED __builtin_amdgcn_sched_barrier(0)
    Unit cur, nxt; int ui = 0;
    S.pre(0);
    if (!S.next(0, cur)) return;
    const int sc8 = 0x7F7F7F7F;
    f32x4 acc[2][2][4][2];
#pragma unroll
    for (int a = 0; a < 2; ++a)
#pragma unroll
        for (int b = 0; b < 2; ++b)
#pragma unroll
            for (int m = 0; m < 4; ++m)
#pragma unroll
                for (int n = 0; n < 2; ++n) acc[a][b][m][n] = (f32x4){0.f, 0.f, 0.f, 0.f};
    bf16x8 At[4][2], B0[2][2], B1[2][2];
    unsigned vA0[2] = {0u, 0u}, vA1[2] = {0u, 0u}, nA0[2] = {0u, 0u}, nA1[2] = {0u, 0u};
    const char* cA; const char* cB = (const char*)g.Bt + (size_t)(cur.e * g.nct + cur.pn) * tstep;
    if constexpr (GATHER) {
        cA = (const char*)g.A;
#pragma unroll
        for (int i = 0; i < 2; ++i) { vA0[i] = (unsigned)((tok[cur.ui * 256 + Rl[i]] & 0xffff) * KB + Cl[i]); vA1[i] = (unsigned)((tok[cur.ui * 256 + 128 + Rl[i]] & 0xffff) * KB + Cl[i]); nA0[i] = vA0[i]; nA1[i] = vA1[i]; }
    } else cA = (const char*)g.A + (size_t)cur.pm * tstep;
    PG8_STAGE(PG8_SB(0, 0), cB, voffB); PG8_STAGE(PG8_SB(0, 1), cB + hstep, voffB); PG8_STAGE_A(PG8_SA(0, 0), cA, 0, vA0, vA1); PG8_STAGE_A(PG8_SA(0, 1), cA, 1, vA0, vA1);
    if (wr == 1) PG8_BAR;
    PG8_WAIT_V(2); PG8_BAR;
    PG8_STAGE(PG8_SB(1, 0), cB + kstep, voffB); PG8_STAGE_A(PG8_SA(1, 0), cA + kstep, 0, vA0, vA1); PG8_STAGE(PG8_SB(1, 1), cB + hstep + kstep, voffB);
    PG8_WAIT_V(6); PG8_BAR;
    for (;;) {
        S.pre(ui + 1);
        bool has_next = false; const char* nAp = cA; const char* nB = cB;
        for (int t = 0; t < nt; t += 2) {
            const bool last = (t == nt - 2);
            const char* a1 = cA + (size_t)(t + 1) * kstep;
            const char* a2 = last ? nAp : cA + (size_t)(t + 2) * kstep; const char* b2 = last ? nB : cB + (size_t)(t + 2) * kstep;
            const char* a3 = a2 + kstep; const char* b3 = b2 + kstep;
            unsigned w0[2] = {0u, 0u}, w1[2] = {0u, 0u};
            if constexpr (GATHER) {
#pragma unroll
                for (int i = 0; i < 2; ++i) { w0[i] = last ? nA0[i] : vA0[i]; w1[i] = last ? nA1[i] : vA1[i]; } }
            if constexpr (Epi::MIDHOOK) { if (t == nt / 2) E.mid(acc, cur, wr, wc, fr, fq); }
            PG8_LDB(B0, 0, 0); PG8_LDB(B1, 0, 1); PG8_SCHED; PG8_LDA(At, 0, 0); PG8_STAGE_A(PG8_SA(1, 1), a1, 1, vA0, vA1);
            PG8_WAIT_V(8); PG8_WAIT_L(0); PG8_BAR; PG8_MM(0, 0, At, B0); PG8_MM(0, 1, At, B1); PG8_BAR; PG8_SCHED;
            PG8_LDA(At, 0, 1); PG8_STAGE(PG8_SB(0, 0), b2, voffB); PG8_STAGE(PG8_SB(0, 1), b2 + hstep, voffB); PG8_STAGE_A(PG8_SA(0, 0), a2, 0, w0, w1);
            PG8_WAIT_V(8); PG8_WAIT_L(0); PG8_BAR; PG8_MM(1, 0, At, B0); PG8_MM(1, 1, At, B1); PG8_BAR; PG8_SCHED;
            PG8_LDB(B0, 1, 0); PG8_LDB(B1, 1, 1); PG8_SCHED; PG8_LDA(At, 1, 0); PG8_STAGE_A(PG8_SA(0, 1), a2, 1, w0, w1);
            PG8_WAIT_V(8); PG8_WAIT_L(0); PG8_BAR; PG8_MM(0, 0, At, B0); PG8_MM(0, 1, At, B1); PG8_BAR; PG8_SCHED;
            PG8_LDA(At, 1, 1); PG8_STAGE(PG8_SB(1, 0), b3, voffB); PG8_STAGE(PG8_SB(1, 1), b3 + hstep, voffB); PG8_STAGE_A(PG8_SA(1, 0), a3, 0, w0, w1);
            PG8_WAIT_V(8); PG8_WAIT_L(0); PG8_BAR; PG8_MM(1, 0, At, B0); PG8_MM(1, 1, At, B1); PG8_BAR; PG8_SCHED;
            if (t == nt - 4) {
                has_next = S.next(ui + 1, nxt);
                if (has_next) {
                    nB = (const char*)g.Bt + (size_t)(nxt.e * g.nct + nxt.pn) * tstep;
                    if constexpr (GATHER) {
#pragma unroll
                        for (int i = 0; i < 2; ++i) { nA0[i] = (unsigned)((tok[nxt.ui * 256 + Rl[i]] & 0xffff) * KB + Cl[i]); nA1[i] = (unsigned)((tok[nxt.ui * 256 + 128 + Rl[i]] & 0xffff) * KB + Cl[i]); }
                    } else nAp = (const char*)g.A + (size_t)nxt.pm * tstep;
                }
            }
        }
        if constexpr (ALIGN_EPI) { if (wr == 0) PG8_BAR; }
        E(acc, cur, wr, wc, fr, fq);
        if (!has_next) break;
#pragma unroll
        for (int a = 0; a < 2; ++a)
#pragma unroll
            for (int b = 0; b < 2; ++b)
#pragma unroll
                for (int m = 0; m < 4; ++m)
#pragma unroll
                    for (int n = 0; n < 2; ++n) acc[a][b][m][n] = (f32x4){0.f, 0.f, 0.f, 0.f};
        cur = nxt; cA = nAp; cB = nB; ++ui;
        if constexpr (GATHER) {
#pragma unroll
            for (int i = 0; i < 2; ++i) { vA0[i] = nA0[i]; vA1[i] = nA1[i]; } }
        if constexpr (ALIGN_EPI) { if (wr == 1) PG8_BAR; }
    }
    PG8_WAIT_V(0);
    if constexpr (!ALIGN_EPI) { if (wr == 0) PG8_BAR; }
    PG8_BAR;
#undef PG8_SA
#undef PG8_SB
#undef PG8_STAGE
#undef PG8_STAGE_A
#undef PG8_LDA
#undef PG8_LDB
#undef PG8_MMA
#undef PG8_MMA8
#undef PG8_MM
#undef PG8_WAIT_V
#undef PG8_WAIT_L
#undef PG8_BAR
#undef PG8_SCHED
}
typedef f32x4 Acc[2][2][4][2];
__device__ __forceinline__ float silu_(float x) { return x * __builtin_amdgcn_rcpf(1.f + __expf(-x)); }
__device__ __forceinline__ float sigm_(float x) { return __builtin_amdgcn_rcpf(1.f + __expf(-x)); }
__device__ __forceinline__ u32x4 pack8(const f32x4 a, const f32x4 b) { u32x4 w; w.x = cvt_pk_bf16(a[0], a[1]); w.y = cvt_pk_bf16(a[2], a[3]); w.z = cvt_pk_bf16(b[0], b[1]); w.w = cvt_pk_bf16(b[2], b[3]); return w; }
__device__ __forceinline__ u32x2 pack8_fp8(const f32x4 a, const f32x4 b) { u32x2 w; w.x = pk4_fp8(a[0], a[1], a[2], a[3]); w.y = pk4_fp8(b[0], b[1], b[2], b[3]); return w; }
__device__ __forceinline__ void unpack8(const u32x4 w, f32x4& a, f32x4& b) { a = (f32x4){bflo(w.x), bfhi(w.x), bflo(w.y), bfhi(w.y)}; b = (f32x4){bflo(w.z), bfhi(w.z), bflo(w.w), bfhi(w.w)}; }

struct EpiInproj {
    static constexpr bool MIDHOOK = false;
    const float* rs1; const float* lb; bf16_t *QS, *VV, *GS, *UU, *SBb, *RT, *GBS; h16_t* LF; float osc;
    __device__ __forceinline__ void mid(Acc&, const Unit&, int, int, int, int) const {}
    template <int ACT> __device__ __forceinline__ void plain(const Acc& acc, const float (&rs)[2][4], bf16_t* O, int pt, int row0, int wc, int fq) const {
#pragma unroll
        for (int ai = 0; ai < 2; ++ai)
#pragma unroll
            for (int m = 0; m < 4; ++m) { bf16_t* rowp = O + (size_t)(row0 + ai * HALF + m * 16) * HF + pt * 256 + wc * 32 + 8 * fq; const float r = rs[ai][m];
#pragma unroll
                for (int bj = 0; bj < 2; ++bj) { f32x4 v0 = acc[ai][bj][m][0] * r, v1 = acc[ai][bj][m][1] * r;
                    if (ACT == 1) {
#pragma unroll
                        for (int j = 0; j < 4; ++j) { v0[j] = silu_(v0[j]); v1[j] = silu_(v1[j]); } }
                    *(u32x4*)(rowp + bj * HALF) = pack8(v0, v1); } }
    }
    __device__ __forceinline__ void operator()(const Acc& acc, const Unit& u, int wr, int wc, int fr, int fq) const {
        const int row0 = u.pm * BM + wr * 64 + fr, pn = u.pn;
        float rs[2][4];
#pragma unroll
        for (int ai = 0; ai < 2; ++ai)
#pragma unroll
            for (int m = 0; m < 4; ++m) rs[ai][m] = osc;
        if (pn < 4) plain<1>(acc, rs, QS, pn, row0, wc, fq);
        else if (pn < 8) {
            const int c0 = (pn - 4) * 256 + wc * 32 + 4 * fq;
            f32x4 lbv[2][2];
#pragma unroll
            for (int bj = 0; bj < 2; ++bj)
#pragma unroll
                for (int n = 0; n < 2; ++n) lbv[bj][n] = *(const f32x4*)(lb + c0 + bj * HALF + n * 16);
#pragma unroll
            for (int ai = 0; ai < 2; ++ai)
#pragma unroll
                for (int m = 0; m < 4; ++m) { h16_t* rowp = LF + (size_t)(row0 + ai * HALF + m * 16) * HF + c0; const float r = rs[ai][m];
#pragma unroll
                    for (int bj = 0; bj < 2; ++bj)
#pragma unroll
                        for (int n = 0; n < 2; ++n) { f32x4 v = acc[ai][bj][m][n] * r; const f32x4 l = lbv[bj][n];
#pragma unroll
                            for (int j = 0; j < 4; ++j) v[j] = __logf(l[j] + (1.f - l[j]) * sigm_(v[j]));
                            *(h16x4*)(rowp + bj * HALF + n * 16) = (h16x4){(h16_t)v[0], (h16_t)v[1], (h16_t)v[2], (h16_t)v[3]}; } }
        }
        else if (pn < 12) plain<0>(acc, rs, VV, pn - 8, row0, wc, fq);
        else if (pn < 16) plain<1>(acc, rs, GS, pn - 12, row0, wc, fq);
        else if (pn < 24) {
            const int c0 = (pn - 16) * 128 + wc * 32 + 8 * fq;
#pragma unroll
            for (int ai = 0; ai < 2; ++ai)
#pragma unroll
                for (int m = 0; m < 4; ++m) { const float r2 = rs[ai][m] * rs[ai][m];
                    const f32x4 v0 = acc[ai][0][m][0] * acc[ai][1][m][0] * r2, v1 = acc[ai][0][m][1] * acc[ai][1][m][1] * r2;
                    *(u32x4*)(UU + (size_t)(row0 + ai * HALF + m * 16) * HF + c0) = pack8(v0, v1); }
        }
        else if (pn < 28) plain<0>(acc, rs, SBb, pn - 24, row0, wc, fq);
        else {
            const int c0 = (pn - 28) * 128 + wc * 32 + 8 * fq;
#pragma unroll
            for (int ai = 0; ai < 2; ++ai)
#pragma unroll
                for (int m = 0; m < 4; ++m) { const float r = rs[ai][m]; f32x4 q0, q1, b0, b1;
#pragma unroll
                    for (int j = 0; j < 4; ++j) { const float ea = 1.f + __expf(-acc[ai][0][m][0][j] * r), eb = 1.f + __expf(-acc[ai][1][m][0][j] * r); b0[j] = __builtin_amdgcn_rcpf(eb); q0[j] = eb * __builtin_amdgcn_rcpf(ea);
                                                  const float fa = 1.f + __expf(-acc[ai][0][m][1][j] * r), fb = 1.f + __expf(-acc[ai][1][m][1][j] * r); b1[j] = __builtin_amdgcn_rcpf(fb); q1[j] = fb * __builtin_amdgcn_rcpf(fa); }
                    const size_t o = (size_t)(row0 + ai * HALF + m * 16) * D + c0;
                    *(u32x4*)(RT + o) = pack8(q0, q1); *(u32x4*)(GBS + o) = pack8(b0, b1); }
        }
    }
};

struct EpiMerge {
    static constexpr bool MIDHOOK = true;
    const bf16_t *RT, *GBS; bf16_t* MG;
    __device__ __forceinline__ void mid(Acc& acc, const Unit& u, int wr, int wc, int fr, int fq) const {
        unsigned o0 = ((unsigned)(u.pm * BM + wr * 64 + fr) * D + (unsigned)(u.pn * BM + wc * 32 + 8 * fq)) * 2u;
        asm volatile("" : "+v"(o0));
#pragma unroll
        for (int ai = 0; ai < 2; ++ai)
#pragma unroll
            for (int m = 0; m < 4; ++m)
#pragma unroll
                for (int bj = 0; bj < 2; ++bj) { const u32x4 w = *(const GAS u32x4*)((const GAS char*)RT + (o0 + (unsigned)((ai * HALF + m * 16) * D + bj * HALF) * 2u)); f32x4 a, b; unpack8(w, a, b);
                    acc[ai][bj][m][0] *= a; acc[ai][bj][m][1] *= b; }
    }
    __device__ __forceinline__ void operator()(const Acc& acc, const Unit& u, int wr, int wc, int fr, int fq) const {
        unsigned o0 = ((unsigned)(u.pm * BM + wr * 64 + fr) * D + (unsigned)(u.pn * BM + wc * 32 + 8 * fq)) * 2u;
        asm volatile("" : "+v"(o0));
#pragma unroll
        for (int ai = 0; ai < 2; ++ai)
#pragma unroll
            for (int m = 0; m < 4; ++m)
#pragma unroll
                for (int bj = 0; bj < 2; ++bj) { const unsigned o = o0 + (unsigned)((ai * HALF + m * 16) * D + bj * HALF) * 2u; const u32x4 w = *(const GAS u32x4*)((const GAS char*)GBS + o); f32x4 a, b; unpack8(w, a, b);
                    *(GAS u32x4*)((GAS char*)MG + o) = pack8(acc[ai][bj][m][0] * a, acc[ai][bj][m][1] * b); if (bj == 1 && m == 3) asm volatile("" ::: "memory"); }
    }
};

struct EpiWo {
    static constexpr bool MIDHOOK = false;
    bf16_t* DL;
    __device__ __forceinline__ void mid(Acc&, const Unit&, int, int, int, int) const {}
    __device__ __forceinline__ void operator()(const Acc& acc, const Unit& u, int wr, int wc, int fr, int fq) const {
        const int row0 = u.pm * BM + wr * 64 + fr, c0 = u.pn * BM + wc * 32 + 8 * fq;
#pragma unroll
        for (int ai = 0; ai < 2; ++ai)
#pragma unroll
            for (int m = 0; m < 4; ++m)
#pragma unroll
                for (int bj = 0; bj < 2; ++bj) *(u32x4*)(DL + (size_t)(row0 + ai * HALF + m * 16) * D + c0 + bj * HALF) = pack8(acc[ai][bj][m][0], acc[ai][bj][m][1]);
    }
};

struct EpiUp {
    static constexpr bool MIDHOOK = false;
    const float* rs2; const LAS int* tok; const LAS bf16_t* bias; unsigned char* ACT;
    __device__ __forceinline__ void mid(Acc&, const Unit&, int, int, int, int) const {}
    __device__ __forceinline__ void operator()(const Acc& acc, const Unit& u, int wr, int wc, int fr, int fq) const {
        const int rl0 = wr * 64 + fr, c0 = u.pn * 128 + wc * 32 + 8 * fq;
        float rs[2][4];
#pragma unroll
        for (int ai = 0; ai < 2; ++ai)
#pragma unroll
            for (int m = 0; m < 4; ++m) rs[ai][m] = __uint_as_float((unsigned)tok[u.ui * 256 + rl0 + ai * HALF + m * 16] & 0xffff0000u);
        const LAS bf16_t* bp = bias + u.ui * 256 + wc * 32 + 8 * fq;
        f32x4 bg0, bg1, bu0, bu1; unpack8(*(const LAS u32x4*)(bp), bg0, bg1); unpack8(*(const LAS u32x4*)(bp + 128), bu0, bu1);
#pragma unroll
        for (int ai = 0; ai < 2; ++ai)
#pragma unroll
            for (int m = 0; m < 4; ++m) { const float r = rs[ai][m]; f32x4 a0, a1;
#pragma unroll
                for (int n = 0; n < 2; ++n)
#pragma unroll
                    for (int jp = 0; jp < 2; ++jp) {
                        const f32x4 ag = acc[ai][0][m][n], au = acc[ai][1][m][n], bgv = n ? bg1 : bg0, buv = n ? bu1 : bu0;
                        f32x2 g = (f32x2){ag[2 * jp], ag[2 * jp + 1]} * r + (f32x2){bgv[2 * jp], bgv[2 * jp + 1]};
                        f32x2 uu = (f32x2){au[2 * jp], au[2 * jp + 1]} * r + (f32x2){buv[2 * jp], buv[2 * jp + 1]};
                        g.x = fminf(g.x, 7.f); g.y = fminf(g.y, 7.f);
                        uu.x = __builtin_amdgcn_fmed3f(uu.x, -7.f, 7.f); uu.y = __builtin_amdgcn_fmed3f(uu.y, -7.f, 7.f);
                        const f32x2 t = g * (-1.702f * 1.44269504f);
                        f32x2 den; den.x = __builtin_amdgcn_exp2f(t.x); den.y = __builtin_amdgcn_exp2f(t.y); den = den + 1.f;
                        f32x2 s; s.x = __builtin_amdgcn_rcpf(den.x); s.y = __builtin_amdgcn_rcpf(den.y);
                        const f32x2 a = (uu + 1.f) * (g * s);
                        if (n == 0) { a0[2 * jp] = a.x; a0[2 * jp + 1] = a.y; } else { a1[2 * jp] = a.x; a1[2 * jp + 1] = a.y; }
                    }
                *(u32x2*)(ACT + (size_t)(u.pm * BM + rl0 + ai * HALF + m * 16) * DFF + c0) = pack8_fp8(a0, a1); }
    }
};

struct EpiDown {
    static constexpr bool MIDHOOK = false;
    const LAS float* bias; unsigned char* YR;
    __device__ __forceinline__ void mid(Acc&, const Unit&, int, int, int, int) const {}
    __device__ __forceinline__ void operator()(const Acc& acc, const Unit& u, int wr, int wc, int fr, int fq) const {
        const int rl0 = wr * 64 + fr, c0 = u.pn * BM + wc * 32 + 8 * fq;
        const LAS float* bp = bias + u.ui * 256 + wc * 32 + 8 * fq;
        f32x4 bv[2][2];
#pragma unroll
        for (int bj = 0; bj < 2; ++bj)
#pragma unroll
            for (int n = 0; n < 2; ++n) bv[bj][n] = *(const LAS f32x4*)(bp + bj * HALF + 4 * n);
#pragma unroll
        for (int ai = 0; ai < 2; ++ai)
#pragma unroll
            for (int m = 0; m < 4; ++m)
#pragma unroll
                for (int bj = 0; bj < 2; ++bj)
                    *(u32x2*)(YR + (size_t)(u.pm * BM + rl0 + ai * HALF + m * 16) * D + c0 + bj * HALF) = pack8_fp8(acc[ai][bj][m][0] * W8_INV + bv[bj][0], acc[ai][bj][m][1] * W8_INV + bv[bj][1]);
    }
};

struct EpiDummy {
    static constexpr bool MIDHOOK = false;
    bf16_t* O; int nostore;
    __device__ __forceinline__ void mid(Acc&, const Unit&, int, int, int, int) const {}
    __device__ __forceinline__ void operator()(const Acc& acc, const Unit& u, int wr, int wc, int fr, int fq) const {
        const int row0 = (u.pm & 63) * BM + wr * 64 + fr, c0 = (u.pn & 7) * BM + wc * 32 + 8 * fq;
        if (nostore) {
#pragma unroll
            for (int ai = 0; ai < 2; ++ai)
#pragma unroll
                for (int m = 0; m < 4; ++m)
#pragma unroll
                    for (int bj = 0; bj < 2; ++bj) asm volatile("" :: "v"(acc[ai][bj][m][0]), "v"(acc[ai][bj][m][1]));
            return; }
#pragma unroll
        for (int ai = 0; ai < 2; ++ai)
#pragma unroll
            for (int m = 0; m < 4; ++m)
#pragma unroll
                for (int bj = 0; bj < 2; ++bj) *(u32x4*)(O + (size_t)(row0 + ai * HALF + m * 16) * D + c0 + bj * HALF) = pack8(acc[ai][bj][m][0], acc[ai][bj][m][1]);
    }
};
struct ProbeOrder {
    StaticOrder S; int mode, c;
    __device__ __forceinline__ void pre(int) const {}
    __device__ __forceinline__ bool next(int i, Unit& u) const {
        if (mode == 3) { if (c & 1) return false; StaticOrder H = S; H.G = S.G / 2; H.c = c >> 1; H.nwg = S.nwg / 2; return H.next(i, u); }
        if (!S.next(i, u)) return false; if (mode >= 1) u.pn = 0; if (mode >= 2) u.pm = c & 63; return true; }
};

struct ProbeMoe {
    MoeOrder S; int mode;
    __device__ __forceinline__ void pre(int) const {}
    __device__ __forceinline__ bool next(int i, Unit& u) const { if (!S.next(i, u)) return false; if (mode & 1) { u.e = 0; u.pn = 0; } if (mode & 2) u.pm = 0; return true; }
};
struct Frame {
    LAS unsigned char* lds; volatile LAS unsigned* MISC; gu32* ctl; unsigned char* ws;
    int tid, lane, wave, vcu, G;
    const float *x, *meta, *nmw, *w_in, *lbl, *gnw, *w_ho, *cw, *w_co, *w_o, *nfw, *w_r, *b_r, *w_up, *b_up, *w_dn, *b_dn, *fnw; float* out;
};
template <class T> __device__ __forceinline__ T* wsp(const Frame& F, size_t off) { return (T*)(F.ws + off); }

__device__ __forceinline__ void tr_tile(const float* W, int ldw, int k0, int src0, int src1, bool perm0, bool perm1, const float* kscale, bf16_t* dst, int dpitch, int drow0, int dk0, LAS unsigned* T, int lane) {
    const int ln = lane & 15, kr = lane >> 4, srcc = (ln < 8 ? src0 : src1) + 4 * (ln & 7);
    const float* wp = W + (size_t)(k0 + 2 * kr) * ldw + srcc;
    f32x4 va[8], vb[8]; f32x2 sc[8];
#pragma unroll
    for (int s = 0; s < 8; ++s) { va[s] = __builtin_nontemporal_load((const GAS f32x4*)(wp + (size_t)(8 * s) * ldw)); vb[s] = __builtin_nontemporal_load((const GAS f32x4*)(wp + (size_t)(8 * s + 1) * ldw));
        sc[s] = kscale ? *(const GAS f32x2*)(kscale + k0 + 8 * s + 2 * kr) : (f32x2){1.f, 1.f}; }
    __builtin_amdgcn_sched_barrier(0);
#pragma unroll
    for (int s = 0; s < 8; ++s) { const int col = (4 * s + kr) ^ (2 * ln);
#pragma unroll
        for (int i = 0; i < 4; ++i) T[(4 * ln + i) * 32 + col] = cvt_pk_bf16(va[s][i] * sc[s].x, vb[s][i] * sc[s].y); }
    LDS_WAIT(); asm volatile("" ::: "memory");
    const int c = lane & 7;
#pragma unroll
    for (int j = 0; j < 8; ++j) { const int rho = (lane >> 3) + 8 * j, h = rho >> 5, r32 = rho & 31; const bool pm = h ? perm1 : perm0; const int n = h * 32 + (pm ? perm32(r32) : r32);
        u32x4 v = *(const LAS u32x4*)(T + n * 32 + 4 * (c ^ (n >> 3)));
        if ((n >> 2) & 1) v = (u32x4){v.z, v.w, v.x, v.y};
        *(GAS u32x4*)(dst + (size_t)(drow0 + rho) * dpitch + dk0 + k0 + 8 * c) = v; }
    LDS_WAIT(); asm volatile("" ::: "memory");
}
template <int PMODE = 0> __device__ __forceinline__ void tr_tile_fp8(const float* W, int ldw, int k0, int src0, int src1, const float* kscale, unsigned char* dst, int dpitch, int drow0, LAS unsigned* T, int lane, bool perm = true) {
    const int ln = lane & 15, kr = lane >> 4, srcc = (ln < 8 ? src0 : src1) + 4 * (ln & 7);
    f32x4 v[2][4][4];
#pragma unroll
    for (int half = 0; half < 2; ++half) {
        const float* wp = W + (size_t)(k0 + 64 * half + 4 * kr) * ldw + srcc;
#pragma unroll
        for (int s = 0; s < 4; ++s) {
#pragma unroll
            for (int q = 0; q < 4; ++q) v[half][s][q] = __builtin_nontemporal_load((const GAS f32x4*)(wp + (size_t)(16 * s + q) * ldw)); }
    }
    __builtin_amdgcn_sched_barrier(0);
    if (PMODE == 1) {
#pragma unroll
        for (int half = 0; half < 2; ++half)
#pragma unroll
            for (int s = 0; s < 4; ++s)
#pragma unroll
                for (int q = 0; q < 4; ++q) asm volatile("" :: "v"(v[half][s][q]));
        return; }
#pragma unroll
    for (int half = 0; half < 2; ++half)
#pragma unroll
        for (int s = 0; s < 4; ++s) { const int col = (16 * half + 4 * s + kr) ^ (2 * ln);
            const f32x4 sc = kscale ? *(const GAS f32x4*)(kscale + k0 + 64 * half + 16 * s + 4 * kr) * W8_SCALE : (f32x4){W8_SCALE, W8_SCALE, W8_SCALE, W8_SCALE};
#pragma unroll
            for (int i = 0; i < 4; ++i) T[(4 * ln + i) * 32 + col] = pk4_fp8(v[half][s][0][i] * sc[0], v[half][s][1][i] * sc[1], v[half][s][2][i] * sc[2], v[half][s][3][i] * sc[3]); }
    LDS_WAIT(); asm volatile("" ::: "memory");
    const int c = lane & 7;
#pragma unroll
    for (int j = 0; j < 8; ++j) { const int rho = (lane >> 3) + 8 * j, h = rho >> 5, r32 = rho & 31; const int n = h * 32 + (perm ? perm32(r32) : r32);
        u32x4 v4 = *(const LAS u32x4*)(T + n * 32 + 4 * (c ^ (n >> 3)));
        if ((n >> 2) & 1) v4 = (u32x4){v4.z, v4.w, v4.x, v4.y};
        if (PMODE == 2) asm volatile("" :: "v"(v4)); else *(GAS u32x4*)(dst + (size_t)(drow0 + rho) * dpitch + k0 + 16 * c) = v4; }
    LDS_WAIT(); asm volatile("" ::: "memory");
}
__device__ __forceinline__ int win_src(int G, bool& perm) {
    const int pn = G >> 3, gi = G & 7; perm = true;
    if (pn < 4) return C_Q + pn * 256 + gi * 32;
    if (pn < 8) { perm = false; return C_F + (pn - 4) * 256 + gi * 32; }
    if (pn < 12) return C_V + (pn - 8) * 256 + gi * 32;
    if (pn < 16) return C_G + (pn - 12) * 256 + gi * 32;
    if (pn < 24) return (gi < 4 ? C_SV : C_SC) + (pn - 16) * 128 + (gi & 3) * 32;
    if (pn < 28) return C_SB + (pn - 24) * 256 + gi * 32;
    return (gi < 4 ? C_GA : C_GB) + (pn - 28) * 128 + (gi & 3) * 32;
}
__device__ __forceinline__ void p0_prologue(Frame& F) {
    const int gw = F.vcu * NWAVES + F.wave, NGW = F.G * NWAVES, gt = F.vcu * NTHR + F.tid, NGT = F.G * NTHR;
    for (int i = gt; i < HF; i += NGT) wsp<float>(F, WS_LB)[i] = 1.f / (1.f + __expf(F.lbl[HF + i] - F.lbl[i]));
    for (int i = gt; i < D * NE; i += NGT) { const int k = i >> 5, e = i & 31; const float v = F.w_r[i] * F.nfw[k]; const unsigned h = f2bf(v); const float lo = v - bf2f((unsigned short)h);
        wsp<bf16_t>(F, WS_WRH)[e * D + k] = (bf16_t)h; wsp<bf16_t>(F, WS_WRL)[e * D + k] = (bf16_t)f2bf(lo); }
    for (int i = gt; i < 48 * HF; i += NGT) { wsp<h16_t>(F, WS_LFM)[i] = (h16_t)0.f; wsp<bf16_t>(F, WS_VVM)[i] = 0; }
    {
        LAS float* hnm = (LAS float*)F.lds;
        for (int r = F.wave * 2; r < F.wave * 2 + 2; ++r) {
            const f32x4* xr = (const f32x4*)(F.meta + (size_t)r * D) + F.lane; f32x4 v[8]; float s = 0.f;
#pragma unroll
            for (int j = 0; j < 8; ++j) { v[j] = xr[64 * j]; s += (v[j].x * v[j].x + v[j].y * v[j].y) + (v[j].z * v[j].z + v[j].w * v[j].w); }
            const float rs = rsqrtf(wave_sum(s) * (1.f / D) + EPS);
#pragma unroll
            for (int j = 0; j < 8; ++j) { const f32x4 w = ((const f32x4*)F.nmw)[F.lane + 64 * j]; *(LAS f32x4*)(hnm + r * D + 4 * F.lane + 256 * j) = v[j] * rs * w; }
        }
        __syncthreads();
        LAS float* red = (LAS float*)(F.lds + TOK_OFF);
        for (int cb = F.vcu; cb < 256; cb += F.G) {
            const int col = F.tid & 15, ks = F.tid >> 4;
            int gcol;
            if (cb < 64) gcol = C_F + 16 * cb + col; else if (cb < 128) gcol = C_V + 16 * (cb - 64) + col; else gcol = (col < 8 ? C_SV : C_SC) + 8 * (cb - 128) + (col & 7);
            float a[16];
#pragma unroll
            for (int r = 0; r < 16; ++r) a[r] = 0.f;
#pragma unroll 8
            for (int k = ks * 64; k < ks * 64 + 64; ++k) { const float w = F.w_in[(size_t)k * INC + gcol];
#pragma unroll
                for (int r = 0; r < 16; ++r) a[r] = fmaf(hnm[r * D + k], w, a[r]); }
#pragma unroll
            for (int r = 0; r < 16; ++r) { a[r] += __shfl_xor(a[r], 16); a[r] += __shfl_xor(a[r], 32); }
            if (F.lane < 16) {
#pragma unroll
                for (int r = 0; r < 16; ++r) red[(F.wave * 16 + r) * 16 + col] = a[r]; }
            __syncthreads();
            if (F.tid < 256) { const int r = F.tid >> 4, c = F.tid & 15; float v = 0.f;
#pragma unroll
                for (int w = 0; w < 8; ++w) v += red[(w * 16 + r) * 16 + c];
                if (cb < 64) { const int ch = 16 * cb + c; const float l = 1.f / (1.f + __expf(F.lbl[HF + ch] - F.lbl[ch])); wsp<h16_t>(F, WS_LFM)[(48 + r) * HF + ch] = (h16_t)__logf(l + (1.f - l) * sigmoidf_(v)); }
                else if (cb < 128) wsp<bf16_t>(F, WS_VVM)[(48 + r) * HF + 16 * (cb - 64) + c] = (bf16_t)f2bf(v);
                else red[2048 + r * 16 + c] = v; }
            __syncthreads();
            if (cb >= 128 && F.tid < 128) { const int r = F.tid >> 3, c = F.tid & 7; wsp<bf16_t>(F, WS_UUM)[r * HF + 8 * (cb - 128) + c] = (bf16_t)f2bf(red[2048 + r * 16 + c] * red[2048 + r * 16 + c + 8]); }
            __syncthreads();
        }
        __syncthreads();
    }
    {
        LAS unsigned* T = (LAS unsigned*)(F.lds + F.wave * 16384);
        constexpr int I_IN = 32 * 4 * N_INB, I_AB = 16 * 32, I_O = 32 * 32, I_UP1 = 16 * 64, I_DN1 = 16 * 32;
        constexpr int I_IN8 = 16 * 4 * N_IN8;
        constexpr int NIT = I_IN + I_IN8 + 2 * I_AB + I_O;
        for (int it = gw; it < NIT; it += NGW) {
            int r = it;
            if (r < I_IN) { const int kb = r / (4 * N_INB), ntl = r % (4 * N_INB), nt = 4 * nth_bit(INB_MASK, ntl >> 2) + (ntl & 3); bool p0, p1; const int s0 = win_src(2 * nt, p0), s1 = win_src(2 * nt + 1, p1); tr_tile(F.w_in, INC, kb * 64, s0, s1, p0, p1, F.nmw, wsp<bf16_t>(F, WS_WIN), D, nt * 64, 0, T, F.lane); continue; } r -= I_IN;
            if (r < I_IN8) { const int kb = r / (4 * N_IN8), ntl = r % (4 * N_IN8), nt = 4 * nth_bit(IN8_MASK, ntl >> 2) + (ntl & 3); bool p0, p1; const int s0 = win_src(2 * nt, p0), s1 = win_src(2 * nt + 1, p1);
                tr_tile_fp8<0>(F.w_in, INC, kb * 128, s0, s1, F.nmw, wsp<unsigned char>(F, WS_WIN8), D, nt * 64, T, F.lane, p0); continue; } r -= I_IN8;
            if (r < I_AB) { const int kb = r / 32, nt = r % 32; tr_tile(F.w_ho, D, kb * 64, nt * 64, nt * 64 + 32, true, true, nullptr, wsp<bf16_t>(F, WS_WAB), D, nt * 64, 0, T, F.lane); continue; } r -= I_AB;
            if (r < I_AB) { const int kb = r / 32, nt = r % 32; tr_tile(F.w_co, D, kb * 64, nt * 64, nt * 64 + 32, true, true, nullptr, wsp<bf16_t>(F, WS_WAB), D, nt * 64, HF, T, F.lane); continue; } r -= I_AB;
            if (r < I_O) { const int kb = r / 32, nt = r % 32; tr_tile(F.w_o, D, kb * 64, nt * 64, nt * 64 + 32, true, true, nullptr, wsp<bf16_t>(F, WS_WO), D, nt * 64, 0, T, F.lane); continue; } r -= I_O;
        }
    }
    for (int m = gw; m < M; m += NGW) {
        const GAS f32x4* xr = (const GAS f32x4*)(F.x + (size_t)m * D) + F.lane; f32x4 v[8]; float s = 0.f;
#pragma unroll
        for (int j = 0; j < 8; ++j) v[j] = xr[64 * j];
        __builtin_amdgcn_sched_barrier(0);
#pragma unroll
        for (int j = 0; j < 8; ++j) s += (v[j].x * v[j].x + v[j].y * v[j].y) + (v[j].z * v[j].z + v[j].w * v[j].w);
        s = wave_sum(s);
        const float rsx = rsqrtf(s * (1.f / D) + EPS);
#pragma unroll
        for (int j = 0; j < 8; ++j) v[j] *= rsx;
        GAS u32x2* o8 = (GAS u32x2*)(wsp<bf16_t>(F, WS_XB) + (size_t)m * D) + F.lane;
#pragma unroll
        for (int j = 0; j < 8; ++j) { u32x2 w; w.x = pk2(v[j].x, v[j].y); w.y = pk2(v[j].z, v[j].w); o8[64 * j] = w; }
        GAS unsigned* o4 = (GAS unsigned*)(wsp<unsigned char>(F, WS_XB8) + (size_t)m * D) + F.lane;
#pragma unroll
        for (int j = 0; j < 8; ++j) o4[64 * j] = pk4_fp8(v[j].x, v[j].y, v[j].z, v[j].w);
    }
}

template <int PMODE = 0> __device__ __forceinline__ void p1_convert(Frame& F, int rank, int nconv) {
    LAS unsigned* T = (LAS unsigned*)(F.lds + F.wave * 16384);
    constexpr int I_UP1 = 16 * 64, I_DN1 = 16 * 32, NIT = NE * (I_UP1 + I_DN1);
    for (int it = rank * NWAVES + F.wave; it < NIT; it += nconv * NWAVES) {
        int r = it;
        if (r < NE * I_UP1) { const int e = r / I_UP1, q = r % I_UP1, kb = q / 64, nt = q % 64, G0 = 2 * nt, pn = G0 >> 3, gi = G0 & 7; const int s0 = (gi < 4 ? 0 : 2048) + pn * 128 + (gi & 3) * 32;
            tr_tile_fp8<PMODE>(F.w_up + (size_t)e * D * 4096, 4096, kb * 128, s0, s0 + 32, F.nfw, wsp<unsigned char>(F, WS_WUP) + (size_t)e * 4096 * D, D, nt * 64, T, F.lane); continue; } r -= NE * I_UP1;
        { const int e = r / I_DN1, q = r % I_DN1, kb = q / 32, nt = q % 32;
          tr_tile_fp8<PMODE>(F.w_dn + (size_t)e * DFF * D, D, kb * 128, nt * 64, nt * 64 + 32, nullptr, wsp<unsigned char>(F, WS_WDN) + (size_t)e * D * DFF, DFF, nt * 64, T, F.lane); }
    }
}

constexpr int KTP = 72;
constexpr int QP_ = 136;
__device__ __forceinline__ void vt_load(const Frame& F, const bf16_t* Vb, size_t row0, int h, u32x4 (&w)[2]) {
#pragma unroll
    for (int q = 0; q < 2; ++q) { const int id = F.tid + 512 * q, t = id >> 4, v8 = (id & 15) * 8; w[q] = *(const GAS u32x4*)(Vb + (row0 + t) * HF + h * 128 + v8); }
}
__device__ __forceinline__ void vt_store(const Frame& F, const u32x4 (&w)[2], LAS bf16_t* VT) {
#pragma unroll
    for (int q = 0; q < 2; ++q) { const int id = F.tid + 512 * q, t = id >> 4, v8 = (id & 15) * 8; const unsigned ww[4] = {w[q].x, w[q].y, w[q].z, w[q].w};
        const int ts = t ^ (v8 & 24);
#pragma unroll
        for (int i = 0; i < 4; ++i) { VT[(v8 + 2 * i) * KTP + ts] = (bf16_t)(ww[i] & 0xffffu); VT[(v8 + 2 * i + 1) * KTP + ts] = (bf16_t)(ww[i] >> 16); } }
}
__device__ __forceinline__ int vt_off(int v, int t0) { return v * KTP + (t0 ^ (v & 24)); }
struct P2aRegs { float L[16]; u32x4 vw[2]; };
__device__ __forceinline__ void p2a_where(const Frame& F, int u, const h16_t*& Lb, const bf16_t*& Vb, size_t& row0, int& h, int& slot) {
    if (u < 8) { Lb = wsp<h16_t>(F, WS_LFM); Vb = wsp<bf16_t>(F, WS_VVM); row0 = 0; h = u; slot = 32 * 64 + u; }
    else { const int bh = (u - 8) >> 6, c = (u - 8) & 63, b = bh >> 3; h = bh & 7; Lb = wsp<h16_t>(F, WS_LF); Vb = wsp<bf16_t>(F, WS_VV); row0 = (size_t)b * SEQ + 64 * c; slot = bh * 64 + c; }
}
__device__ __forceinline__ void p2a_load(const Frame& F, int u, P2aRegs& R) {
    const h16_t* Lb; const bf16_t* Vb; size_t row0; int h, slot; p2a_where(F, u, Lb, Vb, row0, h, slot);
    const int d = F.tid & 127, tq = F.tid >> 7;
#pragma unroll
    for (int i = 0; i < 16; ++i) R.L[i] = (float)Lb[(row0 + 16 * tq + i) * HF + h * 128 + d];
    vt_load(F, Vb, row0, h, R.vw);
}
__device__ __forceinline__ void p2a_compute(Frame& F, int u, const P2aRegs& R) {
    LAS bf16_t* KT = (LAS bf16_t*)F.lds; LAS bf16_t* VT = KT + 128 * KTP; LAS float* TOT = (LAS float*)(F.lds + 2 * 128 * KTP * 2);
    const h16_t* Lb; const bf16_t* Vb; size_t row0; int h, slot; p2a_where(F, u, Lb, Vb, row0, h, slot);
    const int d = F.tid & 127, tq = F.tid >> 7;
    float cs[16]; float run = 0.f;
#pragma unroll
    for (int i = 0; i < 16; ++i) { run += R.L[i]; cs[i] = run; }
    TOT[tq * 128 + d] = run;
    vt_store(F, R.vw, VT);
    __syncthreads();
    float off = 0.f, total = 0.f;
#pragma unroll
    for (int q = 0; q < 4; ++q) { const float tv = TOT[q * 128 + d]; total += tv; if (q < tq) off += tv; }
#pragma unroll
    for (int i = 0; i < 16; i += 2) { const float k0 = (1.f - __expf(R.L[i])) * __expf(total - off - cs[i]), k1 = (1.f - __expf(R.L[i + 1])) * __expf(total - off - cs[i + 1]);
        *(LAS unsigned*)(KT + d * KTP + 16 * tq + i) = pk2(k0, k1); }
    if (tq == 0) wsp<float>(F, WS_DEC)[(size_t)slot * 128 + d] = __expf(total);
    __syncthreads();
    {
        const int w = F.wave, fr = F.lane & 15, fq = F.lane >> 4;
        bf16x8 a[2];
#pragma unroll
        for (int ks = 0; ks < 2; ++ks) a[ks] = *(const LAS bf16x8*)(KT + (16 * w + fr) * KTP + 32 * ks + 8 * fq);
        bf16_t* Ub = wsp<bf16_t>(F, WS_UC) + (size_t)slot * 16384;
#pragma unroll
        for (int vb = 0; vb < 8; ++vb) { f32x4 c = (f32x4){0.f, 0.f, 0.f, 0.f};
#pragma unroll
            for (int ks = 0; ks < 2; ++ks) { const bf16x8 bv = *(const LAS bf16x8*)(VT + vt_off(16 * vb + fr, 32 * ks + 8 * fq)); c = __builtin_amdgcn_mfma_f32_16x16x32_bf16(a[ks], bv, c, 0, 0, 0); }
            u32x2 o; o.x = pk2(c[0], c[1]); o.y = pk2(c[2], c[3]);
            *(GAS u32x2*)(Ub + (16 * vb + fr) * 128 + 16 * w + 4 * fq) = o; }
    }
    __syncthreads();
}
__device__ __forceinline__ void p2a_units(Frame& F, int c) {
    constexpr int NU = 2048 + 8;
    if (c >= NU) return;
    P2aRegs R; p2a_load(F, c, R);
    for (int u = c; u < NU; u += F.G) {
        P2aRegs N; const int un = u + F.G; if (un < NU) p2a_load(F, un, N); else N = R;
        p2a_compute(F, u, R);
        R = N;
    }
}
__device__ __forceinline__ void p2a_conv(Frame& F, int item) {
    const int c8 = (F.tid & 127) * 8, tq = F.tid >> 7, r0 = item * 64 + tq * 16, p0 = r0 & (SEQ - 1);
    const bf16_t* UU = wsp<bf16_t>(F, WS_UU); const bf16_t* UUM = wsp<bf16_t>(F, WS_UUM); const bf16_t* SBb = wsp<bf16_t>(F, WS_SB); bf16_t* A2 = wsp<bf16_t>(F, WS_A2);
    f32x4 w0a = *(const f32x4*)(F.cw + c8), w0b = *(const f32x4*)(F.cw + c8 + 4), w1a = *(const f32x4*)(F.cw + HF + c8), w1b = *(const f32x4*)(F.cw + HF + c8 + 4), w2a = *(const f32x4*)(F.cw + 2 * HF + c8), w2b = *(const f32x4*)(F.cw + 2 * HF + c8 + 4);
    f32x4 um2a, um2b, um1a, um1b;
    { const u32x4 a = (p0 >= 2) ? *(const GAS u32x4*)(UU + (size_t)(r0 - 2) * HF + c8) : *(const GAS u32x4*)(UUM + (14 + p0) * HF + c8); unpack8(a, um2a, um2b);
      const u32x4 b = (p0 >= 1) ? *(const GAS u32x4*)(UU + (size_t)(r0 - 1) * HF + c8) : *(const GAS u32x4*)(UUM + 15 * HF + c8); unpack8(b, um1a, um1b); }
#pragma unroll 4
    for (int i = 0; i < 16; ++i) { f32x4 ua, ub, sa, sb; unpack8(*(const GAS u32x4*)(UU + (size_t)(r0 + i) * HF + c8), ua, ub); unpack8(*(const GAS u32x4*)(SBb + (size_t)(r0 + i) * HF + c8), sa, sb);
        const f32x4 oa = sa * (w0a * um2a + w1a * um1a + w2a * ua), ob = sb * (w0b * um2b + w1b * um1b + w2b * ub);
        *(GAS u32x4*)(A2 + (size_t)(r0 + i) * D + HF + c8) = pack8(oa, ob);
        um2a = um1a; um2b = um1b; um1a = ua; um1b = ub; }
}
__device__ __forceinline__ void p2b_scan(Frame& F) {
    const int gw = F.vcu * NWAVES + F.wave;
    for (int it = gw; it < 1024; it += F.G * NWAVES) {
        const int item = it * 64 + F.lane, bh = item >> 11, e8 = item & 2047, h = bh & 7, d0 = (e8 & 15) * 8;
        const bf16_t* Ub = wsp<bf16_t>(F, WS_UC) + (size_t)bh * 64 * 16384 + e8 * 8; bf16_t* Sb = wsp<bf16_t>(F, WS_SS) + (size_t)bh * 64 * 16384 + e8 * 8;
        const float* Db = wsp<float>(F, WS_DEC) + (size_t)bh * 64 * 128 + d0;
        f32x4 s0, s1; unpack8(*(const GAS u32x4*)(wsp<bf16_t>(F, WS_UC) + (size_t)(32 * 64 + h) * 16384 + e8 * 8), s0, s1);
#pragma unroll 8
        for (int c = 0; c < 64; ++c) {
            *(GAS u32x4*)(Sb + (size_t)c * 16384) = pack8(s0, s1);
            f32x4 u0, u1; unpack8(*(const GAS u32x4*)(Ub + (size_t)c * 16384), u0, u1);
            const f32x4 g0 = *(const GAS f32x4*)(Db + c * 128), g1 = *(const GAS f32x4*)(Db + c * 128 + 4);
            s0 = g0 * s0 + u0; s1 = g1 * s1 + u1;
        }
    }
}
struct P2cRegs { f32x2 L[8]; unsigned qw[8]; u32x4 vw[2]; bf16x8 sa[4]; u32x2 gv[4]; };
__device__ __forceinline__ void p2c_load(const Frame& F, int u, P2cRegs& R) {
    const int bh = u >> 6, c = u & 63, b = bh >> 3, h = bh & 7; const size_t row0 = (size_t)b * SEQ + 64 * c;
    const int dp = (F.tid & 63) * 2, t8 = F.tid >> 6, w = F.wave, fr = F.lane & 15, fq = F.lane >> 4;
    const h16_t* Lb = wsp<h16_t>(F, WS_LF) + (row0 + 8 * t8) * HF + h * 128 + dp; const bf16_t* Qb = wsp<bf16_t>(F, WS_QS) + (row0 + 8 * t8) * HF + h * 128 + dp;
#pragma unroll
    for (int i = 0; i < 8; ++i) { const h16x2 lh = *(const GAS h16x2*)(Lb + (size_t)i * HF); R.L[i] = (f32x2){(float)lh.x, (float)lh.y}; R.qw[i] = *(const GAS unsigned*)(Qb + (size_t)i * HF); }
    vt_load(F, wsp<bf16_t>(F, WS_VV), row0, h, R.vw);
    const bf16_t* Sb = wsp<bf16_t>(F, WS_SS) + ((size_t)bh * 64 + c) * 16384 + (16 * w + fr) * 128 + 8 * fq;
#pragma unroll
    for (int ks = 0; ks < 4; ++ks) R.sa[ks] = *(const GAS bf16x8*)(Sb + 32 * ks);
    const bf16_t* GSb = wsp<bf16_t>(F, WS_GS);
#pragma unroll
    for (int tb = 0; tb < 4; ++tb) R.gv[tb] = *(const GAS u32x2*)(GSb + (row0 + 16 * tb + fr) * HF + h * 128 + 16 * w + 4 * fq);
}
__device__ __forceinline__ void p2c_compute(Frame& F, int u, const P2cRegs& R) {
    const int bh = u >> 6, c = u & 63, b = bh >> 3, h = bh & 7; const size_t row0 = (size_t)b * SEQ + 64 * c;
    LAS bf16_t* QPl = (LAS bf16_t*)F.lds; LAS bf16_t* QD = QPl + 64 * QP_; LAS bf16_t* KI = QD + 64 * QP_; LAS bf16_t* VT = KI + 160 * QP_; LAS bf16_t* PL = VT + 128 * KTP;
    LAS float* TOT8 = (LAS float*)(PL + 64 * KTP); LAS float* SSQ = TOT8 + 8 * 128;
    const int dp = (F.tid & 63) * 2, t8 = F.tid >> 6;
    f32x2 L[8], cs[8], q[8]; f32x2 run = (f32x2){0.f, 0.f};
#pragma unroll
    for (int i = 0; i < 8; ++i) { L[i] = R.L[i]; q[i] = (f32x2){bflo(R.qw[i]), bfhi(R.qw[i])}; }
#pragma unroll
    for (int i = 0; i < 8; ++i) { run += L[i]; cs[i] = run; }
    *(LAS f32x2*)(TOT8 + t8 * 128 + dp) = run;
    vt_store(F, R.vw, VT);
    for (int i = F.tid; i < 64 * KTP / 2; i += NTHR) ((LAS unsigned*)PL)[i] = 0u;
    __syncthreads();
    {
        f32x2 pre[9]; pre[0] = (f32x2){0.f, 0.f};
#pragma unroll
        for (int j = 0; j < 8; ++j) pre[j + 1] = pre[j] + *(const LAS f32x2*)(TOT8 + j * 128 + dp);
        f32x2 off = (f32x2){0.f, 0.f};
#pragma unroll
        for (int j = 0; j < 8; ++j) if (j == t8) off = pre[j];
        const int si = t8 >> 1;
        f32x2 st[4];
#pragma unroll
        for (int j = 0; j < 4; ++j) st[j] = pre[2 * j];
        f32x2 sti = st[0];
#pragma unroll
        for (int j = 1; j < 4; ++j) if (j == si) sti = st[j];
#pragma unroll
        for (int i = 0; i < 8; ++i) { const int t = 8 * t8 + i; const f32x2 bc = off + cs[i];
            *(LAS unsigned*)(QPl + t * QP_ + dp) = pk2(q[i].x * __expf(bc.x), q[i].y * __expf(bc.y));
            *(LAS unsigned*)(QD + t * QP_ + dp) = pk2(q[i].x * __expf(bc.x - sti.x), q[i].y * __expf(bc.y - sti.y));
            const f32x2 k = (f32x2){1.f - __expf(L[i].x), 1.f - __expf(L[i].y)};
#pragma unroll
            for (int j = 0; j < 4; ++j) if (j >= si) {
                *(LAS unsigned*)(KI + (8 * j * (j + 1) + t) * QP_ + dp) = pk2(k.x * __expf(fminf(st[j].x - bc.x, 80.f)), k.y * __expf(fminf(st[j].y - bc.y, 80.f))); }
        }
    }
    __syncthreads();
    const int w = F.wave, fr = F.lane & 15, fq = F.lane >> 4;
    for (int bi = w; bi < 10; bi += 8) {
        const int i = bi < 1 ? 0 : bi < 3 ? 1 : bi < 6 ? 2 : 3, j = bi - (i * (i + 1)) / 2;
        f32x4 cacc = (f32x4){0.f, 0.f, 0.f, 0.f};
#pragma unroll
        for (int ks = 0; ks < 4; ++ks) { const bf16x8 a = *(const LAS bf16x8*)(KI + (8 * i * (i + 1) + 16 * j + fr) * QP_ + 32 * ks + 8 * fq), bq = *(const LAS bf16x8*)(QD + (16 * i + fr) * QP_ + 32 * ks + 8 * fq);
            cacc = __builtin_amdgcn_mfma_f32_16x16x32_bf16(a, bq, cacc, 0, 0, 0); }
        if (i == j) {
#pragma unroll
            for (int r = 0; r < 4; ++r) if (4 * fq + r > fr) cacc[r] = 0.f; }
        u32x2 o; o.x = pk2(cacc[0], cacc[1]); o.y = pk2(cacc[2], cacc[3]);
        *(LAS u32x2*)(PL + (16 * i + fr) * KTP + 16 * j + 4 * fq) = o;
    }
    __syncthreads();
    f32x4 acc[4];
#pragma unroll
    for (int tb = 0; tb < 4; ++tb) acc[tb] = (f32x4){0.f, 0.f, 0.f, 0.f};
    {
#pragma unroll
        for (int ks = 0; ks < 4; ++ks)
#pragma unroll
            for (int tb = 0; tb < 4; ++tb) { const bf16x8 bq = *(const LAS bf16x8*)(QPl + (16 * tb + fr) * QP_ + 32 * ks + 8 * fq); acc[tb] = __builtin_amdgcn_mfma_f32_16x16x32_bf16(R.sa[ks], bq, acc[tb], 0, 0, 0); }
#pragma unroll
        for (int ks = 0; ks < 2; ++ks) { const bf16x8 va = *(const LAS bf16x8*)(VT + vt_off(16 * w + fr, 32 * ks + 8 * fq));
#pragma unroll
            for (int tb = 0; tb < 4; ++tb) { const bf16x8 bp = *(const LAS bf16x8*)(PL + (16 * tb + fr) * KTP + 32 * ks + 8 * fq); acc[tb] = __builtin_amdgcn_mfma_f32_16x16x32_bf16(va, bp, acc[tb], 0, 0, 0); } }
    }
#pragma unroll
    for (int tb = 0; tb < 4; ++tb) { float p = (acc[tb][0] * acc[tb][0] + acc[tb][1] * acc[tb][1]) + (acc[tb][2] * acc[tb][2] + acc[tb][3] * acc[tb][3]); p += __shfl_xor(p, 16); p += __shfl_xor(p, 32);
        if (fq == 0) SSQ[w * 64 + 16 * tb + fr] = p; }
    __syncthreads();
    {
        const f32x4 gw4 = *(const f32x4*)(F.gnw + 16 * w + 4 * fq);
        bf16_t* A2 = wsp<bf16_t>(F, WS_A2);
#pragma unroll
        for (int tb = 0; tb < 4; ++tb) { const int t = 16 * tb + fr; float ss = 0.f;
#pragma unroll
            for (int ww = 0; ww < 8; ++ww) ss += SSQ[ww * 64 + t];
            const float rs = rsqrtf(ss * (1.f / 128.f) + EPS);
            const u32x2 gv = R.gv[tb];
            const f32x4 o = acc[tb] * rs * gw4 * (f32x4){bflo(gv.x), bfhi(gv.x), bflo(gv.y), bfhi(gv.y)};
            u32x2 ov; ov.x = pk2(o[0], o[1]); ov.y = pk2(o[2], o[3]);
            *(GAS u32x2*)(A2 + (row0 + t) * D + h * 128 + 16 * w + 4 * fq) = ov; }
    }
    __syncthreads();
}
__device__ __forceinline__ void p2c_units(Frame& F, int c) {
    constexpr int NU = 2048;
    if (c >= NU) return;
    P2cRegs R; p2c_load(F, c, R);
    for (int u = c; u < NU; u += F.G) {
        P2cRegs N; const int un = u + F.G; if (un < NU) p2c_load(F, un, N); else N = R;
        p2c_compute(F, u, R);
        R = N;
    }
}

__device__ __forceinline__ void split8(const f32x4 a, const f32x4 b, bf16x8& hi, bf16x8& lo) {
    u32x4 h, l;
    h.x = cvt_pk_bf16(a[0], a[1]); h.y = cvt_pk_bf16(a[2], a[3]); h.z = cvt_pk_bf16(b[0], b[1]); h.w = cvt_pk_bf16(b[2], b[3]);
    l.x = cvt_pk_bf16(a[0] - bflo(h.x), a[1] - bfhi(h.x)); l.y = cvt_pk_bf16(a[2] - bflo(h.y), a[3] - bfhi(h.y)); l.z = cvt_pk_bf16(b[0] - bflo(h.z), b[1] - bfhi(h.z)); l.w = cvt_pk_bf16(b[2] - bflo(h.w), b[3] - bfhi(h.w));
    hi = __builtin_bit_cast(bf16x8, h); lo = __builtin_bit_cast(bf16x8, l);
}
__device__ __forceinline__ void p5_router(Frame& F) {
    const int fr = F.lane & 15, fq = F.lane >> 4, wq = F.wave & 3, kh = F.wave >> 2;
    LAS float* lg = (LAS float*)(F.lds + F.wave * 4096);
    LAS float* pa = (LAS float*)(F.lds + 32768) + (wq * 64 + F.lane) * 9;
    const bf16_t* DL = wsp<bf16_t>(F, WS_H1); unsigned char* H1B = wsp<unsigned char>(F, WS_H1B); const bf16_t* WH = wsp<bf16_t>(F, WS_WRH); const bf16_t* WL = wsp<bf16_t>(F, WS_WRL);
    for (int it = F.vcu * 4 + wq; it < M / 16; it += F.G * 4) {
        const int row0 = it * 16, kofs = 1024 * kh;
        const float* hp = F.x + (size_t)(row0 + fr) * D + kofs + 8 * fq; const bf16_t* dp_ = DL + (size_t)(row0 + fr) * D + kofs + 8 * fq; unsigned char* qp = H1B + (size_t)(row0 + fr) * D + kofs + 8 * fq;
        const bf16_t* wh0 = WH + (size_t)fr * D + kofs + 8 * fq; const bf16_t* wl0 = WL + (size_t)fr * D + kofs + 8 * fq;
        f32x4 a0 = (f32x4){0.f, 0.f, 0.f, 0.f}, a1 = a0; float ss = 0.f;
#pragma unroll 4
        for (int ks = 0; ks < 32; ++ks) {
            f32x4 xa = *(const GAS f32x4*)(hp + 32 * ks), xb = *(const GAS f32x4*)(hp + 32 * ks + 4); { f32x4 da, db; unpack8(*(const GAS u32x4*)(dp_ + 32 * ks), da, db); xa += da; xb += db; }
            *(GAS u32x2*)(qp + 32 * ks) = pack8_fp8(xa, xb);
            *(GAS u32x4*)((bf16_t*)dp_ + 32 * ks) = pack8(xa, xb);
            ss += (xa[0] * xa[0] + xa[1] * xa[1]) + (xa[2] * xa[2] + xa[3] * xa[3]) + (xb[0] * xb[0] + xb[1] * xb[1]) + (xb[2] * xb[2] + xb[3] * xb[3]);
            bf16x8 xh, xl; split8(xa, xb, xh, xl);
            const bf16x8 bh0 = *(const GAS bf16x8*)(wh0 + 32 * ks), bl0 = *(const GAS bf16x8*)(wl0 + 32 * ks), bh1 = *(const GAS bf16x8*)(wh0 + 16 * D + 32 * ks), bl1 = *(const GAS bf16x8*)(wl0 + 16 * D + 32 * ks);
            a0 = __builtin_amdgcn_mfma_f32_16x16x32_bf16(xh, bh0, a0, 0, 0, 0); a0 = __builtin_amdgcn_mfma_f32_16x16x32_bf16(xh, bl0, a0, 0, 0, 0);
            a0 = __builtin_amdgcn_mfma_f32_16x16x32_bf16(xl, bh0, a0, 0, 0, 0); a0 = __builtin_amdgcn_mfma_f32_16x16x32_bf16(xl, bl0, a0, 0, 0, 0);
            a1 = __builtin_amdgcn_mfma_f32_16x16x32_bf16(xh, bh1, a1, 0, 0, 0); a1 = __builtin_amdgcn_mfma_f32_16x16x32_bf16(xh, bl1, a1, 0, 0, 0);
            a1 = __builtin_amdgcn_mfma_f32_16x16x32_bf16(xl, bh1, a1, 0, 0, 0); a1 = __builtin_amdgcn_mfma_f32_16x16x32_bf16(xl, bl1, a1, 0, 0, 0);
        }
        if (kh == 1) {
#pragma unroll
            for (int r = 0; r < 4; ++r) { pa[r] = a0[r]; pa[4 + r] = a1[r]; }
            pa[8] = ss; }
        __syncthreads();
        if (kh == 0) {
#pragma unroll
            for (int r = 0; r < 4; ++r) { a0[r] += pa[r]; a1[r] += pa[4 + r]; }
            ss += pa[8];
            ss += __shfl_xor(ss, 16); ss += __shfl_xor(ss, 32);
#pragma unroll
            for (int r = 0; r < 4; ++r) { lg[(4 * fq + r) * 33 + fr] = a0[r]; lg[(4 * fq + r) * 33 + 16 + fr] = a1[r]; }
            LDS_WAIT(); asm volatile("" ::: "memory");
            if (F.lane < 16) {
                const int tokn = row0 + F.lane; const float rs = rsqrtf(ss * (1.f / D) + EPS);
                float v[32];
#pragma unroll
                for (int e = 0; e < 32; ++e) v[e] = lg[F.lane * 33 + e] * rs + F.b_r[e];
                int idx[4]; float val[4];
#pragma unroll
                for (int k = 0; k < 4; ++k) { float bv = -3.0e38f; int bi = 0;
#pragma unroll
                    for (int e = 0; e < 32; ++e) { const bool tk = v[e] > bv; bv = tk ? v[e] : bv; bi = tk ? e : bi; }
                    idx[k] = bi; val[k] = bv;
#pragma unroll
                    for (int e = 0; e < 32; ++e) v[e] = (e == bi) ? -3.0e38f : v[e]; }
                float ex[4], den = 0.f;
#pragma unroll
                for (int k = 0; k < 4; ++k) { ex[k] = __expf(val[k] - val[0]); den += ex[k]; }
                const float inv = 1.f / den;
                wsp<float>(F, WS_RS2)[tokn] = rs;
                int pos[4];
#pragma unroll
                for (int k = 0; k < 4; ++k) pos[k] = (int)__hip_atomic_fetch_add(F.ctl + CW_CNT + 64 * idx[k], 1u, __ATOMIC_RELAXED, __HIP_MEMORY_SCOPE_AGENT);
#pragma unroll
                for (int k = 0; k < 4; ++k) {
                    wsp<int>(F, WS_TOPE)[tokn * 4 + k] = idx[k]; wsp<int>(F, WS_TOPP)[tokn * 4 + k] = pos[k]; wsp<float>(F, WS_TOPW)[tokn * 4 + k] = ex[k] * inv;
                    wsp<int>(F, WS_LIST)[(size_t)idx[k] * CAPF + pos[k]] = tokn; }
            }
        }
        __syncthreads();
    }
}
__device__ __forceinline__ void build_pref(Frame& F) {
    if (F.wave == 0) {
        int tl = 0;
        if (F.lane < NE) { const unsigned c = __hip_atomic_load(F.ctl + CW_CNT + 64 * F.lane, RLX_AGENT); tl = (int)((c + 255u) >> 8); }
        int s = tl;
#pragma unroll
        for (int d = 1; d < 32; d <<= 1) { const int v = __shfl_up(s, d); if (F.lane >= d) s += v; }
        if (F.lane < NE) F.MISC[16 + F.lane] = (unsigned)(s - tl);
        if (F.lane == NE - 1) F.MISC[16 + NE] = (unsigned)(s < MAXRT ? s : MAXRT); }
    __syncthreads();
}
__device__ __forceinline__ void build_tok(Frame& F, const MoeOrder& S) {
    LAS int* tokt = (LAS int*)(F.lds + TOK_OFF); LAS bf16_t* bt = (LAS bf16_t*)(F.lds + BIAS_OFF);
    volatile LAS int* um = (volatile LAS int*)(F.MISC + 64);
    if (F.tid < 18) { Unit u; int base = -1, nv = 0, bo = 0;
        if (S.template next<false>(F.tid, u)) { const int rt = u.pm - (int)F.MISC[16 + u.e]; const int cnt = (int)__hip_atomic_load(F.ctl + CW_CNT + 64 * u.e, RLX_AGENT);
            base = u.e * CAPF + rt * 256; nv = cnt - rt * 256; nv = nv < 0 ? 0 : (nv > 256 ? 256 : nv); bo = u.e * 4096 + u.pn * 128; }
        um[4 * F.tid] = base; um[4 * F.tid + 1] = nv; um[4 * F.tid + 2] = bo; }
    __syncthreads();
    if (F.tid < 256) { int t[18]; float r[18]; const int* LIST = wsp<int>(F, WS_LIST); const float* RS2 = wsp<float>(F, WS_RS2);
#pragma unroll
        for (int i = 0; i < 18; ++i) { const int base = um[4 * i], nv = um[4 * i + 1]; t[i] = (base >= 0 && F.tid < nv) ? LIST[base + F.tid] : -1; }
#pragma unroll
        for (int i = 0; i < 18; ++i) r[i] = (t[i] >= 0) ? RS2[t[i]] * W8_INV : 0.f;
#pragma unroll
        for (int i = 0; i < 18; ++i) if (um[4 * i] >= 0) tokt[i * 256 + F.tid] = (int)((f2bf(r[i]) << 16) | (unsigned)(t[i] < 0 ? 0 : t[i])); }
    else {
        const int j = F.tid - 256, col = j < 128 ? j : 2048 + (j - 128); float bq[18];
#pragma unroll
        for (int i = 0; i < 18; ++i) bq[i] = (um[4 * i] >= 0) ? F.b_up[um[4 * i + 2] + col] : 0.f;
#pragma unroll
        for (int i = 0; i < 18; ++i) bt[i * 256 + j] = (bf16_t)f2bf(bq[i]); }
    __syncthreads();
}
__device__ __forceinline__ void build_bias_dn(Frame& F, const MoeOrder& S) {
    LAS float* bt = (LAS float*)(F.lds + TOK_OFF);
    volatile LAS int* um = (volatile LAS int*)(F.MISC + 64);
    if (F.tid < 9) { Unit u; int bo = -1; if (S.template next<false>(F.tid, u)) bo = u.e * D + u.pn * 256; um[F.tid] = bo; }
    __syncthreads();
    if (F.tid < 256) { float bq[9];
#pragma unroll
        for (int i = 0; i < 9; ++i) bq[i] = (um[i] >= 0) ? F.b_dn[um[i] + F.tid] : 0.f;
#pragma unroll
        for (int i = 0; i < 9; ++i) bt[i * 256 + F.tid] = bq[i]; }
    __syncthreads();
}
struct P9Tok { f32x4 v[8]; unsigned y[4][8]; f32x4 tw; };
template <int PM> __device__ __forceinline__ void p9_issue(const Frame& F, int m, P9Tok& T) {
    typedef int i32x4 __attribute__((ext_vector_type(4)));
    const bf16_t* DL = wsp<bf16_t>(F, WS_H1); const unsigned char* YR = wsp<unsigned char>(F, WS_YR);
    const i32x4 te = *(const GAS i32x4*)(wsp<int>(F, WS_TOPE) + m * 4), tp = *(const GAS i32x4*)(wsp<int>(F, WS_TOPP) + m * 4); T.tw = *(const GAS f32x4*)(wsp<float>(F, WS_TOPW) + m * 4);
#pragma unroll
    for (int j = 0; j < 8; ++j) { const u32x2 dw = (PM == 4) ? (u32x2){(unsigned)m, 0u} : *(const GAS u32x2*)(DL + (size_t)m * D + 4 * F.lane + 256 * j);
        T.v[j] = (f32x4){bflo(dw.x), bfhi(dw.x), bflo(dw.y), bfhi(dw.y)}; }
#pragma unroll
    for (int k = 0; k < 4; ++k) { const size_t row = (size_t)((const LAS unsigned*)F.MISC)[16 + te[k]] * 256 + tp[k];
#pragma unroll
        for (int j = 0; j < 8; ++j) T.y[k][j] = (PM == 1) ? (unsigned)row : *(const GAS unsigned*)(YR + row * D + 4 * F.lane + 256 * j); }
}
template <int PM> __device__ __forceinline__ void p9_finish(const Frame& F, int m, P9Tok& T, float* outp) {
#pragma unroll
    for (int k = 0; k < 4; ++k)
#pragma unroll
        for (int j = 0; j < 8; ++j) { const f32x2 p0 = __builtin_amdgcn_cvt_pk_f32_fp8((int)T.y[k][j], false), p1 = __builtin_amdgcn_cvt_pk_f32_fp8((int)T.y[k][j], true); T.v[j] += (f32x4){p0.x, p0.y, p1.x, p1.y} * T.tw[k]; }
    float s = 0.f;
#pragma unroll
    for (int j = 0; j < 8; ++j) s += (T.v[j][0] * T.v[j][0] + T.v[j][1] * T.v[j][1]) + (T.v[j][2] * T.v[j][2] + T.v[j][3] * T.v[j][3]);
    const float rs = rsqrtf(wave_sum(s) * (1.f / D) + EPS);
#pragma unroll
    for (int j = 0; j < 8; ++j) { const f32x4 w = *(const f32x4*)(F.fnw + 4 * F.lane + 256 * j); const f32x4 o = T.v[j] * rs * w;
        if (PM == 2) asm volatile("" :: "v"(o)); else *(GAS f32x4*)(outp + (size_t)m * D + 4 * F.lane + 256 * j) = o; }
}
template <int PM> __device__ __forceinline__ void p9_combine_t(Frame& F, float* outp) {
    const int gw = F.vcu * NWAVES + F.wave, NGW9 = F.G * NWAVES;
    for (int m = gw; m < M; m += 2 * NGW9) {
        const int m2 = m + NGW9; const bool two = m2 < M;
        P9Tok A, B; p9_issue<PM>(F, m, A); p9_issue<PM>(F, two ? m2 : m, B);
        __builtin_amdgcn_sched_barrier(0);
        p9_finish<PM>(F, m, A, outp); if (two) p9_finish<PM>(F, m2, B, outp);
    }
}
__device__ __forceinline__ void p9_combine(Frame& F) { p9_combine_t<0>(F, F.out); }
constexpr int NPH = 11;
struct Args { const float* in[18]; float* out; unsigned char* ws; int ph_lo, ph_hi; };

__global__ void __launch_bounds__(NTHR, 2) fwd_kernel(Args args) {
    extern __shared__ __attribute__((aligned(16))) unsigned char lds_raw[];
    Frame F;
    F.lds = (LAS unsigned char*)lds_raw; F.MISC = (volatile LAS unsigned*)(F.lds + MISC_OFF);
    F.wave = __builtin_amdgcn_readfirstlane((int)threadIdx.x >> 6);
#define REFRESH() do { F.lane = lane_id(); F.tid = F.wave * 64 + F.lane; } while (0)
    REFRESH();
    F.G = gridDim.x; { const int bx = blockIdx.x; F.vcu = (F.G % 8 == 0) ? (bx % 8) * (F.G / 8) + bx / 8 : bx; }
    F.ws = args.ws; F.ctl = (gu32*)(args.ws + WS_CTL); F.out = args.out;
    F.x = args.in[0]; F.meta = args.in[1]; F.nmw = args.in[2]; F.w_in = args.in[3]; F.lbl = args.in[4]; F.gnw = args.in[5]; F.w_ho = args.in[6]; F.cw = args.in[7]; F.w_co = args.in[8]; F.w_o = args.in[9];
    F.nfw = args.in[10]; F.w_r = args.in[11]; F.b_r = args.in[12]; F.w_up = args.in[13]; F.b_up = args.in[14]; F.w_dn = args.in[15]; F.b_dn = args.in[16]; F.fnw = args.in[17];
    for (int u = F.tid; u < 256; u += NTHR) F.MISC[u] = 0u;
    __syncthreads();
    const int lo = args.ph_lo, hi = args.ph_hi;
    const bool multi = (hi - lo) > 1;
    XcdBarrier bar; bar.bar = (unsigned*)(F.ctl + CW_BAR); bar.x = 0; bar.st = nullptr;
    if (multi) bar = xcd_barrier_post((unsigned*)(F.ctl + CW_BAR), F.MISC, F.tid);
#define IN(k) (lo <= (k) && (k) < hi)
#if defined(FK_STAMP_A)
#define STAMP(k) do { if (blockIdx.x == 0 && F.tid == 0) __hip_atomic_store(F.ctl + CW_TS + (k), (unsigned)__builtin_amdgcn_s_memrealtime(), RLX_AGENT); } while (0)
#else
#define STAMP(k) do { } while (0)
#endif
#if defined(FK_PROBE_BAR)
#define SEAM(k) do { REFRESH(); if (IN(k) && IN((k) + 1)) { xcd_barrier(bar, F.tid); xcd_barrier(bar, F.tid); xcd_barrier(bar, F.tid); } STAMP((k) + 1); } while (0)
#else
#define SEAM(k) do { REFRESH(); if (IN(k) && IN((k) + 1)) xcd_barrier(bar, F.tid); STAMP((k) + 1); } while (0)
#endif
    STAMP(0);
    const int c = blockIdx.x;
#ifndef FK_DUP_MASK
#define FK_DUP_MASK 0
#endif
#ifndef FK_DUP_REPS
#define FK_DUP_REPS 1
#endif
#define DUP(k) for (int _rep = 0; _rep < 1 + FK_DUP_REPS * ((FK_DUP_MASK >> (k)) & 1); ++_rep)
#define REDO(k) do { if (((FK_DUP_MASK >> (k)) & 1) && _rep < FK_DUP_REPS) { REFRESH(); xcd_barrier(bar, F.tid); } } while (0)

    if (IN(0)) DUP(0) { p0_prologue(F); REDO(0); } SEAM(0);

    if (IN(1)) DUP(1) {
        constexpr int NCONV_PER8 = 3;
        const int cq = c >> 3; const bool conv = (F.G % 64 == 0) && ((cq & 7) < NCONV_PER8) && (_rep == 0);
        if (F.G % 64 != 0 && _rep == 0) { if (c == 0) p1_convert(F, 0, 1); }
        if (conv) { const int nconv = (F.G / 64) * 8 * NCONV_PER8, rank = ((cq >> 3) * NCONV_PER8 + (cq & 7)) * 8 + (c & 7); p1_convert(F, rank, nconv);
#if defined(FK_PROBE_CONV2)
            __syncthreads(); p1_convert<FK_PROBE_CONV2 - 1>(F, rank, nconv);
#endif
        }
        __syncthreads();
        EpiInproj E{wsp<float>(F, WS_RS1), wsp<float>(F, WS_LB), wsp<bf16_t>(F, WS_QS), wsp<bf16_t>(F, WS_VV), wsp<bf16_t>(F, WS_GS), wsp<bf16_t>(F, WS_UU), wsp<bf16_t>(F, WS_SB), wsp<bf16_t>(F, WS_RT), wsp<bf16_t>(F, WS_GBS), wsp<h16_t>(F, WS_LF), 1.f};
        if (N_INB > 0) {
            GemmDesc g{wsp<bf16_t>(F, WS_XB), wsp<bf16_t>(F, WS_WIN), D, INC / 256};
            DynOrder S; S.init(M, INB_MASK, N_INB, c, (unsigned*)(F.ctl + CW_Q + 64 * (c & 7) + 8 * _rep), F.MISC + 4, F.tid);
            gemm_phase<EpiInproj, DynOrder, false, true, false>(F.lds, g, S, E, nullptr, F.wave); }
        if (N_IN8 > 0) {
            REFRESH(); E.osc = 1.f / W8_SCALE;
            GemmDesc g{(const bf16_t*)wsp<unsigned char>(F, WS_XB8), (const bf16_t*)wsp<unsigned char>(F, WS_WIN8), D, INC / 256};
            DynOrder S; S.init(M, IN8_MASK, N_IN8, c, (unsigned*)(F.ctl + CW_Q + 64 * (c & 7) + 8 * _rep + 4), F.MISC + 6, F.tid);
            gemm_phase<EpiInproj, DynOrder, false, true, true>(F.lds, g, S, E, nullptr, F.wave); }
        REDO(1);
    } SEAM(1);

#if defined(FK_PROBE_GEMM)
    if (IN(1)) {
        GemmDesc g{wsp<bf16_t>(F, WS_XB), wsp<bf16_t>(F, WS_WIN), D, INC / 256}; ProbeOrder S; S.S.init(M, INC, F.G, c); S.mode = FK_PROBE_GEMM & 3; S.c = c;
        EpiDummy E{wsp<bf16_t>(F, WS_ACT), (FK_PROBE_GEMM >> 2) & 1};
        gemm_phase<EpiDummy, ProbeOrder, false, true, false>(F.lds, g, S, E, nullptr, F.wave);
        REFRESH(); xcd_barrier(bar, F.tid);
    }
#endif
    if (IN(2)) DUP(2) { p2a_units(F, c); for (int it = c; it < M / 64; it += F.G) p2a_conv(F, it); REDO(2); } SEAM(2);
    if (IN(3)) DUP(3) { p2b_scan(F); REDO(3); } SEAM(3);
    if (IN(4)) DUP(4) { p2c_units(F, c); REDO(4); } SEAM(4);

    if (IN(5)) DUP(5) {
        GemmDesc g{wsp<bf16_t>(F, WS_A2), wsp<bf16_t>(F, WS_WAB), D, D / 256}; StaticOrder S; S.init(M, D, F.G, c);
        EpiMerge E{wsp<bf16_t>(F, WS_RT), wsp<bf16_t>(F, WS_GBS), wsp<bf16_t>(F, WS_MG)};
        gemm_phase<EpiMerge, StaticOrder, false, true, false>(F.lds, g, S, E, nullptr, F.wave); REDO(5);
    } SEAM(5);

    if (IN(6)) DUP(6) {
        GemmDesc g{wsp<bf16_t>(F, WS_MG), wsp<bf16_t>(F, WS_WO), D, D / 256}; StaticOrder S; S.init(M, D, F.G, c);
        EpiWo E{wsp<bf16_t>(F, WS_H1)};
        gemm_phase<EpiWo, StaticOrder, false, true, false>(F.lds, g, S, E, nullptr, F.wave); REDO(6);
    } SEAM(6);

    if (IN(7)) { p5_router(F); } SEAM(7);

    if (IN(8)) DUP(8) {
        build_pref(F);
        MoeOrder S; S.init(16, F.G, c, (const volatile LAS int*)(F.MISC + 16));
        build_tok(F, S);
        GemmDesc g{wsp<bf16_t>(F, WS_H1B), wsp<bf16_t>(F, WS_WUP), D, 16};
        EpiUp E{wsp<float>(F, WS_RS2), (const LAS int*)(F.lds + TOK_OFF), (const LAS bf16_t*)(F.lds + BIAS_OFF), wsp<unsigned char>(F, WS_ACT)};
        gemm_phase<EpiUp, MoeOrder, true, true, true>(F.lds, g, S, E, (const LAS int*)(F.lds + TOK_OFF), F.wave); REDO(8);
    } SEAM(8);

    if (IN(9)) DUP(9) {
        build_pref(F);
        MoeOrder S; S.init(8, F.G, c, (const volatile LAS int*)(F.MISC + 16));
        GemmDesc g{wsp<bf16_t>(F, WS_ACT), wsp<bf16_t>(F, WS_WDN), DFF, 8};
        build_bias_dn(F, S);
        EpiDown E{(const LAS float*)(F.lds + TOK_OFF), wsp<unsigned char>(F, WS_YR)};
        gemm_phase<EpiDown, MoeOrder, false, true, true>(F.lds, g, S, E, nullptr, F.wave); REDO(9);
    } SEAM(9);

#if defined(FK_PROBE_P8)
    if (IN(10)) {
        build_pref(F);
        ProbeMoe S; S.S.init(8, F.G, c, (const volatile LAS int*)(F.MISC + 16)); S.mode = FK_PROBE_P8 & 3;
        GemmDesc g{wsp<bf16_t>(F, WS_ACT), wsp<bf16_t>(F, WS_WDN), DFF, 8};
        EpiDummy E{wsp<bf16_t>(F, WS_XB), 1};
        for (int r = 0; r < 2; ++r) { gemm_phase<EpiDummy, ProbeMoe, false, true, true>(F.lds, g, S, E, nullptr, F.wave); REFRESH(); xcd_barrier(bar, F.tid); }
    }
#endif
    if (IN(10)) DUP(10) { build_pref(F); p9_combine(F); REDO(10); }
#if defined(FK_PROBE_P9)
    if (IN(10)) { for (int r = 0; r < 4; ++r) { REFRESH(); xcd_barrier(bar, F.tid); p9_combine_t<FK_PROBE_P9 - 1>(F, wsp<float>(F, WS_XB)); } }
#endif
#undef IN
#undef DUP
#undef REDO
#undef SEAM
#undef STAMP
#undef REFRESH
}

inline void launch_fast(hipStream_t stream, void* const* d_in, float* out, unsigned char* ws, int n_launches) {
    static int grid = 0;
    if (grid == 0) {
        int dev = 0, cus = 0, per_cu = 0;
        if (hipGetDevice(&dev) != hipSuccess || hipDeviceGetAttribute(&cus, hipDeviceAttributeMultiprocessorCount, dev) != hipSuccess) { fprintf(stderr, "kernel_launch: device query failed\n"); grid = -1; return; }
        if (hipFuncSetAttribute((const void*)fwd_kernel, hipFuncAttributeMaxDynamicSharedMemorySize, LDS_BYTES) != hipSuccess) { fprintf(stderr, "kernel_launch: hipFuncSetAttribute failed\n"); grid = -1; return; }
        if (hipOccupancyMaxActiveBlocksPerMultiprocessor(&per_cu, (const void*)fwd_kernel, NTHR, LDS_BYTES) != hipSuccess || per_cu < 1) fprintf(stderr, "kernel_launch: note: occupancy query says %d blocks per CU\n", per_cu);
        (void)hipGetLastError();
        grid = cus;
    }
    if (grid < 0) return;
    (void)hipMemsetAsync(ws + WS_CTL, 0, CTL_BYTES, stream);
    Args a{};
    for (int i = 0; i < 18; ++i) a.in[i] = (const float*)d_in[i];
    a.out = out; a.ws = ws;
    for (int li = 0; li < n_launches; ++li) {
        a.ph_lo = (n_launches == 1) ? 0 : li; a.ph_hi = (n_launches == 1) ? NPH : li + 1;
        hipLaunchKernelGGL(fwd_kernel, dim3(grid), dim3(NTHR), LDS_BYTES, stream, a);
        const hipError_t le = hipPeekAtLastError();
        if (le != hipSuccess) { fprintf(stderr, "kernel_launch: launch %d failed: %s\n", li, hipGetErrorName(le)); break; }
    }
}
}
#ifndef FK_LAUNCHES
#define FK_LAUNCHES 1
#endif
extern "C" void kernel_launch(void* const* d_in, const int* in_sizes, int n_in, void* d_out, int out_size, void* d_ws, size_t ws_size, hipStream_t stream) {
    if (n_in != 18 || ws_size < fk::WS_FAST_END) { fprintf(stderr, "kernel_launch: n_in %d, ws %zu < %zu\n", n_in, ws_size, (size_t)fk::WS_FAST_END); return; }
    fk::launch_fast(stream, d_in, (float*)d_out, (unsigned char*)d_ws, FK_LAUNCHES);
}
```

```cpp
#include <hip/hip_runtime.h>
#include <cstdio>
#define FK_LAUNCHES 1
#define FK_IN8_MASK 0xFFFF000F0FFull
#define FK_WO8 0
namespace fk {
#define LAS __attribute__((address_space(3)))
#define GAS __attribute__((address_space(1)))
typedef unsigned short bf16_t;
typedef short bf16x8 __attribute__((ext_vector_type(8)));
typedef float f32x4 __attribute__((ext_vector_type(4)));
typedef float f32x2 __attribute__((ext_vector_type(2)));
typedef unsigned u32x4 __attribute__((ext_vector_type(4)));
typedef unsigned u32x2 __attribute__((ext_vector_type(2)));
typedef GAS unsigned gu32;
typedef _Float16 h16_t;
typedef _Float16 h16x4 __attribute__((ext_vector_type(4)));
typedef _Float16 h16x2 __attribute__((ext_vector_type(2)));
#define RLX_AGENT __ATOMIC_RELAXED, __HIP_MEMORY_SCOPE_AGENT
#define LDS_WAIT() asm volatile("s_waitcnt lgkmcnt(0)" ::: "memory")
#define VM_WAIT() asm volatile("s_waitcnt vmcnt(0)" ::: "memory")

constexpr int D = 2048, NB = 4, SEQ = 4096, M = NB * SEQ, NMETA = 16;
constexpr int HF = 1024, INC = 11264, NE = 32, DFF = 2048, NCH = SEQ / 64;
constexpr int C_Q = 0, C_F = 1024, C_V = 2048, C_G = 3072, C_SV = 4096, C_SB = 5120, C_SC = 6144, C_GA = 7168, C_GB = 9216;
constexpr float EPS = 1e-6f;
constexpr int CAPF = M;
constexpr int MAXRT = 288;
constexpr int NWAVES = 8, NTHR = 512;

constexpr size_t al(size_t x) { return (x + 0xFFFFF) & ~(size_t)0xFFFFF; }
constexpr size_t WS_CTL = 0, CTL_BYTES = 65536;
constexpr size_t WS_LB = 65536, WS_RS1 = WS_LB + 4096, WS_RS2 = WS_RS1 + 65536, WS_WRH = WS_RS2 + 65536, WS_WRL = WS_WRH + 131072;
constexpr size_t WS_LFM = WS_WRL + 131072, WS_VVM = WS_LFM + 64 * 1024 * 4, WS_UUM = WS_VVM + 64 * 1024 * 2, WS_SMALL_END = WS_UUM + 16 * 1024 * 2;
constexpr size_t WS_TOPE = al(WS_SMALL_END), WS_TOPP = WS_TOPE + (size_t)M * 16, WS_TOPW = WS_TOPP + (size_t)M * 16, WS_LIST = WS_TOPW + (size_t)M * 16;
constexpr size_t WS_DEC = al(WS_LIST + (size_t)NE * CAPF * 4);
constexpr size_t WS_WIN = al(WS_DEC + (size_t)33 * 64 * 128 * 4);
constexpr size_t WS_WAB = al(WS_WIN + (size_t)INC * D * 2);
constexpr size_t WS_WO = al(WS_WAB + (size_t)D * D * 2);
constexpr size_t WS_WUP = al(WS_WO + (size_t)D * D * 2);
constexpr size_t WS_WDN = al(WS_WUP + (size_t)NE * 4096 * D);
constexpr size_t WS_XB = al(WS_WDN + (size_t)NE * D * DFF);
constexpr size_t WS_QS = al(WS_XB + (size_t)M * D * 2);
constexpr size_t WS_LF = al(WS_QS + (size_t)M * HF * 2);
constexpr size_t WS_VV = al(WS_LF + (size_t)M * HF * 2);
constexpr size_t WS_GS = al(WS_VV + (size_t)M * HF * 2);
constexpr size_t WS_UU = al(WS_GS + (size_t)M * HF * 2);
constexpr size_t WS_SB = al(WS_UU + (size_t)M * HF * 2);
constexpr size_t WS_RT = al(WS_SB + (size_t)M * HF * 2);
constexpr size_t WS_GBS = al(WS_RT + (size_t)M * D * 2);
constexpr size_t WS_UC = al(WS_GBS + (size_t)M * D * 2);
constexpr size_t WS_SS = al(WS_UC + (size_t)(32 * 64 + 8) * 16384 * 2);
constexpr size_t WS_A2 = al(WS_SS + (size_t)32 * 64 * 16384 * 2);
constexpr size_t WS_MG = al(WS_A2 + (size_t)M * D * 2);
constexpr size_t WS_H1 = al(WS_MG + (size_t)M * D * 2);
constexpr size_t WS_H1B = al(WS_H1 + (size_t)M * D * 2);
constexpr size_t WS_ACT = al(WS_H1B + (size_t)M * D);
constexpr size_t WS_YR = al(WS_ACT + (size_t)MAXRT * 256 * DFF);
constexpr size_t WS_WIN8 = al(WS_YR + (size_t)MAXRT * 256 * D);
constexpr size_t WS_XB8 = al(WS_WIN8 + (size_t)INC * D);
constexpr size_t WS_FAST_END = al(WS_XB8 + (size_t)M * D);
#ifndef FK_IN8_MASK
#define FK_IN8_MASK 0xFFFF00000F0ull
#endif
constexpr unsigned long long IN8_MASK = FK_IN8_MASK;
constexpr unsigned long long INB_MASK = ((1ull << 44) - 1) & ~IN8_MASK;
constexpr int cpop(unsigned long long m) { int n = 0; while (m) { m &= m - 1; ++n; } return n; }
constexpr int N_IN8 = cpop(IN8_MASK), N_INB = 44 - N_IN8;
__device__ __forceinline__ int nth_bit(unsigned long long m, int n) { for (int i = 0; i < n; ++i) m &= m - 1; return __builtin_ctzll(m); }
constexpr int CW_TMO = 0;
constexpr int CW_CNT = 1024;
constexpr int CW_Q = 3400;
constexpr int CW_TS = 3200;
constexpr int CW_BAR = 4096;
constexpr int RING_BYTES = 131072;
constexpr int TOK_OFF = RING_BYTES, TOK_BYTES = 18 * 1024;
constexpr int MISC_OFF = TOK_OFF + TOK_BYTES;
constexpr int BIAS_OFF = MISC_OFF + 1024, BIAS_BYTES = 18 * 512;
constexpr int LDS_BYTES = BIAS_OFF + BIAS_BYTES;
static_assert(LDS_BYTES <= 160 * 1024, "LDS");

__device__ __forceinline__ float sigmoidf_(float x) { return 1.f / (1.f + __expf(-x)); }
__device__ __forceinline__ unsigned f2bf(float f) { unsigned u = __builtin_bit_cast(unsigned, f); return (u + 0x7fffu + ((u >> 16) & 1u)) >> 16; }
__device__ __forceinline__ unsigned pk2(float lo, float hi) { return f2bf(lo) | (f2bf(hi) << 16); }
__device__ __forceinline__ float bf2f(unsigned short b) { return __builtin_bit_cast(float, ((unsigned)b) << 16); }
__device__ __forceinline__ float bflo(unsigned w) { return __builtin_bit_cast(float, w << 16); }
__device__ __forceinline__ float bfhi(unsigned w) { return __builtin_bit_cast(float, w & 0xffff0000u); }
__device__ __forceinline__ unsigned cvt_pk_bf16(float lo, float hi) { unsigned r; asm volatile("v_cvt_pk_bf16_f32 %0, %1, %2" : "=v"(r) : "v"(lo), "v"(hi)); return r; }
__device__ __forceinline__ unsigned pk4_fp8(float a, float b, float c, float d) { int w = 0; w = __builtin_amdgcn_cvt_pk_fp8_f32(a, b, w, false); w = __builtin_amdgcn_cvt_pk_fp8_f32(c, d, w, true); return (unsigned)w; }
constexpr float W8_SCALE = 64.f, W8_INV = 1.f / 64.f;
__device__ __forceinline__ int lane_id() { int l; asm volatile("v_mbcnt_lo_u32_b32 %0, -1, 0\n\tv_mbcnt_hi_u32_b32 %0, -1, %0" : "=v"(l)); return l; }
__device__ __forceinline__ float wave_sum(float v) {
#pragma unroll
    for (int o = 1; o < 64; o <<= 1) v += __shfl_xor(v, o);
    return v;
}

#define XB_TMO      128
#define XB_XCNT(j)  (256  + 64 * (j))
#define XB_XSUB(j)  (1280 + 64 * (j))
#define XB_XGEN(j)  (2304 + 64 * (j))
#define XB_TOP      3328
#define XB_TOPGEN   3392
#define XCD_BAR_WORDS 3456
#define XB_SPIN_CAP (1u << 18)
__device__ __forceinline__ unsigned xb_ld(unsigned* p)              { return __hip_atomic_load(p, __ATOMIC_RELAXED, __HIP_MEMORY_SCOPE_AGENT); }
__device__ __forceinline__ unsigned xb_add(unsigned* p, unsigned v) { return __hip_atomic_fetch_add(p, v, __ATOMIC_RELAXED, __HIP_MEMORY_SCOPE_AGENT); }
__device__ __forceinline__ unsigned xb_xcc_id() { return (unsigned)__builtin_amdgcn_s_getreg((3 << 11) | 20) & 0xFu; }
#define XB_SPIN(cond, bar) do { unsigned _sp = 0; while (cond) { __builtin_amdgcn_s_sleep(1); \
    if ((++_sp & 255u) == 0u) { if (xb_ld(&(bar)[XB_TMO])) break; if (_sp > XB_SPIN_CAP) { atomicAdd(&(bar)[XB_TMO], 1u); break; } } } } while (0)
struct XcdBarrier { unsigned* bar; unsigned x; volatile LAS unsigned* st; };
__device__ __forceinline__ XcdBarrier xcd_barrier_post(unsigned* bar, volatile LAS unsigned* st, int tid) {
    XcdBarrier b; b.bar = bar; b.x = xb_xcc_id(); b.st = st;
    if (tid == 0) (void)xb_add(&bar[XB_XCNT(b.x)], 1u);
    return b;
}
__device__ __forceinline__ void xcd_barrier_complete(unsigned* bar, unsigned x, unsigned& nloc, unsigned& nx) {
    const unsigned G = gridDim.x * gridDim.y * gridDim.z;
    unsigned sum, cnt, mine, sp = 0u;
    for (;;) {
        sum = 0u; cnt = 0u; mine = 0u;
#pragma unroll
        for (unsigned j = 0; j < 16; ++j) { const unsigned c = xb_ld(&bar[XB_XCNT(j)]); sum += c; cnt += (c > 0u) ? 1u : 0u; mine = (j == x) ? c : mine; }
        if (sum == G) break;
        __builtin_amdgcn_s_sleep(1);
        if ((++sp & 255u) == 0u) { if (xb_ld(&bar[XB_TMO])) break; if (sp > XB_SPIN_CAP) { atomicAdd(&bar[XB_TMO], 1u); break; } }
    }
    nloc = mine > 0u ? mine : 1u; nx = cnt > 0u ? cnt : 1u;
}
__device__ __forceinline__ void xcd_barrier(const XcdBarrier& b, int tid) {
    asm volatile("s_waitcnt vmcnt(0)" ::: "memory");
    __syncthreads();
    if (tid == 0) {
        unsigned* bar = b.bar;
        __builtin_amdgcn_s_waitcnt(0);
        unsigned nloc = b.st[0], nx = b.st[1];
        if (nloc == 0u) { xcd_barrier_complete(bar, b.x, nloc, nx); b.st[0] = nloc; b.st[1] = nx; }
        const unsigned old = xb_add(&bar[XB_XSUB(b.x)], 1u);
        const unsigned gen = old / nloc;
        if (old + 1u == (gen + 1u) * nloc) {
            __builtin_amdgcn_fence(__ATOMIC_RELEASE, "agent");
            asm volatile("s_waitcnt vmcnt(0)" ::: "memory");
            const unsigned og = xb_add(&bar[XB_TOP], 1u);
            const unsigned tg = og / nx;
            if (og + 1u == (tg + 1u) * nx) xb_add(&bar[XB_TOPGEN], 1u);
            else XB_SPIN(xb_ld(&bar[XB_TOPGEN]) == tg, bar);
            __builtin_amdgcn_fence(__ATOMIC_ACQUIRE, "agent");
            xb_add(&bar[XB_XGEN(b.x)], 1u);
            asm volatile("s_waitcnt vmcnt(0)" ::: "memory");
        } else {
            XB_SPIN(xb_ld(&bar[XB_XGEN(b.x)]) == gen, bar);
            __builtin_amdgcn_fence(__ATOMIC_ACQUIRE, "agent");
            asm volatile("s_waitcnt vmcnt(0)" ::: "memory");
        }
    }
    __syncthreads();
}

constexpr int BM = 256, BK = 64, HALF = 128, HTB = HALF * BK * 2, NXCD = 8, WGM = 8;
__host__ __device__ __forceinline__ int lds_byte(int r, int c) { const int st = (r >> 4) * 2 + (c >> 5), rr = r & 15, cc = c & 31, ob = rr * 64 + cc * 2; return st * 1024 + (ob ^ (((ob >> 9) & 1) << 5)); }
__host__ __device__ __forceinline__ void stage_rc(int b, int& R, int& C) { const int st = b / 1024, sb = b % 1024, swz = sb ^ (((sb >> 9) & 1) << 5); R = (st >> 1) * 16 + swz / 64; C = (st & 1) * 32 + (swz % 64) / 2; }
__host__ __device__ __forceinline__ int perm32(int rho) { const int n = rho >> 4, i = rho & 15; return 8 * (i >> 2) + 4 * n + (i & 3); }

typedef int i32x8 __attribute__((ext_vector_type(8)));
typedef int i32x4v __attribute__((ext_vector_type(4)));
__device__ __forceinline__ i32x8 cat8(const bf16x8 a, const bf16x8 b) { const i32x4v x = __builtin_bit_cast(i32x4v, a), y = __builtin_bit_cast(i32x4v, b); return __builtin_shufflevector(x, y, 0, 1, 2, 3, 4, 5, 6, 7); }
__device__ __forceinline__ void mfma8(f32x4& acc, const i32x8 a, const i32x8 b, const int sc) {
    asm volatile("s_nop 1\n\tv_mfma_scale_f32_16x16x128_f8f6f4 %0, %1, %2, %0, %3, %3 op_sel_hi:[0,0,0]" : "+v"(acc) : "v"(a), "v"(b), "v"(sc));
}
struct Unit { int pm, pn, e, ui; };

struct StaticOrder {
    int nM, nN, nwg, G, c;
    __device__ void init(int M_, int N_, int G_, int c_) { nM = M_ / BM; nN = N_ / BM; nwg = nM * nN; G = G_; c = c_; }
    __device__ __forceinline__ bool next(int i, Unit& u) const {
        const long L = (long)i * G + c; if (L >= nwg) return false;
        int wgid = (int)L; { const int q = nwg / NXCD, r = nwg % NXCD, xcd = wgid % NXCD, off = wgid / NXCD; wgid = (xcd < r ? xcd * (q + 1) : r * (q + 1) + (xcd - r) * q) + off; }
        const int nig = WGM * nN, gid = wgid / nig, fm = gid * WGM, gsz = (nM - fm) < WGM ? (nM - fm) : WGM;
        u.pm = fm + ((wgid % nig) % gsz); u.pn = (wgid % nig) / gsz; u.e = 0; u.ui = i; return true;
    }
};
struct DynOrder {
    int nM, nN, nwg, x; unsigned* head; volatile LAS unsigned* slot; int tid; unsigned long long mask;
    __device__ void init(int M_, unsigned long long mask_, int nN_, int c_, unsigned* head_, volatile LAS unsigned* slot_, int tid_) { nM = M_ / BM; nN = nN_; mask = mask_; nwg = nM * nN; x = c_ & 7; head = head_; slot = slot_; tid = tid_; }
    __device__ __forceinline__ bool next(int i, Unit& u) const {
        if (tid == 0) slot[i & 1] = __hip_atomic_fetch_add(head, 1u, __ATOMIC_RELAXED, __HIP_MEMORY_SCOPE_AGENT);
        asm volatile("s_waitcnt lgkmcnt(0)" ::: "memory"); __builtin_amdgcn_s_barrier(); asm volatile("" ::: "memory");
        const int j = (int)slot[i & 1], q = nwg / NXCD;
        if (j >= q) return false;
        const int wgid = x * q + j;
        const int nig = WGM * nN, gid = wgid / nig, fm = gid * WGM, gsz = (nM - fm) < WGM ? (nM - fm) : WGM;
        u.pm = fm + ((wgid % nig) % gsz); u.pn = nth_bit(mask, (wgid % nig) / gsz); u.e = 0; u.ui = i; return true;
    }
};
struct MoeOrder {
    int nct, NT, G, c; const volatile LAS int* pref;
    __device__ void init(int nct_, int G_, int c_, const volatile LAS int* pref_) { nct = nct_; G = G_; c = c_; pref = pref_; NT = pref_[NE]; }
    template <bool UNIFORM = true> __device__ __forceinline__ bool next(int i, Unit& u) const {
        int rtg, pn;
        if (G == 256) { const int x = c & 7, jj = c >> 3;
            if (nct == 16) { rtg = 16 * i + 8 * (x & 1) + (jj & 7); pn = 4 * (x >> 1) + (jj >> 3); }
            else           { rtg = 32 * i + 8 * (x & 3) + (jj & 7); pn = 4 * (x >> 2) + (jj >> 3); } }
        else { const int U = i * G + c; rtg = U / nct; pn = U - rtg * nct; }
        if (rtg >= NT) return false;
        u.pn = pn; u.pm = rtg; u.ui = i;
        int e = 0;
        if constexpr (UNIFORM) { const int l = lane_id(); const int pv = (l >= 1 && l < NE) ? pref[l] : 0x7fffffff; e = (int)__builtin_popcountll(__ballot(pv <= rtg)); }
        else {
#pragma unroll 1
            for (int j = 1; j < NE; ++j) e = (pref[j] <= rtg) ? j : e; }
        u.e = e; return true;
    }
};

struct GemmDesc { const bf16_t* A; const bf16_t* Bt; int K; int nct; };

template <class Epi, class Sched, bool GATHER, bool ALIGN_EPI, bool FP8>
__device__ __forceinline__ void gemm_phase(LAS unsigned char* lds, const GemmDesc g, const Sched& S, const Epi& E, const LAS int* tok, int wid) {
    const int lane = lane_id(), tid = wid * 64 + lane, wr = wid >> 2, wc = wid & 3, fr = lane & 15, fq = lane >> 4;
    const int K = g.K, KB = FP8 ? K : 2 * K  , nt = FP8 ? K / 128 : K / BK;
    int Rl[2], Cl[2];
    unsigned voffA[2], voffB[2];
#pragma unroll
    for (int i = 0; i < 2; ++i) { int Cc; stage_rc(tid * 16 + i * 8192, Rl[i], Cc); const int p = Cc >> 3; Cl[i] = FP8 ? 16 * (2 * (p & 3) + (p >> 2)) : 2 * Cc; voffA[i] = (unsigned)(Rl[i] * KB + Cl[i]); voffB[i] = voffA[i]; }
    const size_t kstep = (size_t)(BK * 2);
    const size_t hstep = (size_t)HALF * KB;
    const size_t tstep = 2 * hstep;
    const unsigned ldsw = (unsigned)wid * 1024u;
    const int aoff = lds_byte(wr * 64 + fr, fq * 8), boff = lds_byte(wc * 32 + fr, fq * 8);
#define PG8_SA(b, h) (((b) * 2 + (h)) * HTB)
#define PG8_SB(b, h) ((4 + (b) * 2 + (h)) * HTB)
#define PG8_STAGE(bufoff, gbase, voff) do { _Pragma("unroll") for (int _i = 0; _i < 2; ++_i) \
        __builtin_amdgcn_global_load_lds((const unsigned*)((const char*)(gbase) + (voff)[_i]), (LAS unsigned*)(lds + (bufoff) + ldsw + _i * 8192), 16, 0, 0); } while (0)
#define PG8_STAGE_A(bufoff, ptr, half, o0, o1) do { if constexpr (GATHER) { PG8_STAGE(bufoff, ptr, (half) ? o1 : o0); } else { PG8_STAGE(bufoff, (ptr) + (half) * hstep, voffA); } } while (0)
#define PG8_LDA(dst, b, h) do { _Pragma("unroll") for (int m = 0; m < 4; ++m) _Pragma("unroll") for (int k = 0; k < 2; ++k) dst[m][k] = *(const LAS bf16x8*)(lds + PG8_SA(b, h) + aoff + m * 2048 + k * 1024); } while (0)
#define PG8_LDB(dst, b, h) do { _Pragma("unroll") for (int n = 0; n < 2; ++n) _Pragma("unroll") for (int k = 0; k < 2; ++k) dst[n][k] = *(const LAS bf16x8*)(lds + PG8_SB(b, h) + boff + n * 2048 + k * 1024); } while (0)
#define PG8_MMA(ai, bj, At, Bt) do { __builtin_amdgcn_s_setprio(1); _Pragma("unroll") for (int m = 0; m < 4; ++m) _Pragma("unroll") for (int n = 0; n < 2; ++n) _Pragma("unroll") for (int k = 0; k < 2; ++k) \
        acc[ai][bj][m][n] = __builtin_amdgcn_mfma_f32_16x16x32_bf16(Bt[n][k], At[m][k], acc[ai][bj][m][n], 0, 0, 0); __builtin_amdgcn_s_setprio(0); } while (0)
#define PG8_MMA8(ai, bj, At, Bt) do { __builtin_amdgcn_s_setprio(1); _Pragma("unroll") for (int m = 0; m < 4; ++m) _Pragma("unroll") for (int n = 0; n < 2; ++n) \
        mfma8(acc[ai][bj][m][n], cat8(Bt[n][0], Bt[n][1]), cat8(At[m][0], At[m][1]), sc8); __builtin_amdgcn_s_setprio(0); } while (0)
#define PG8_MM(ai, bj, At, Bt) do { if constexpr (FP8) PG8_MMA8(ai, bj, At, Bt); else PG8_MMA(ai, bj, At, Bt); } while (0)
#define PG8_WAIT_V(n) asm volatile("s_waitcnt vmcnt(" #n ")" ::: "memory")
#define PG8_WAIT_L(n) asm volatile("s_waitcnt lgkmcnt(" #n ")" ::: "memory")
#define PG8_BAR __builtin_amdgcn_s_barrier()
#define PG8_SCHED __builtin_amdgcn_sched_barrier(0)
    Unit cur, nxt; int ui = 0;
    if (!S.next(0, cur)) return;
    const int sc8 = 0x7F7F7F7F;
    f32x4 acc[2][2][4][2];
#pragma unroll
    for (int a = 0; a < 2; ++a)
#pragma unroll
        for (int b = 0; b < 2; ++b)
#pragma unroll
            for (int m = 0; m < 4; ++m)
#pragma unroll
                for (int n = 0; n < 2; ++n) acc[a][b][m][n] = (f32x4){0.f, 0.f, 0.f, 0.f};
    bf16x8 At[4][2], B0[2][2], B1[2][2];
    unsigned vA0[2] = {0u, 0u}, vA1[2] = {0u, 0u}, nA0[2] = {0u, 0u}, nA1[2] = {0u, 0u};
    const char* cA; const char* cB = (const char*)g.Bt + (size_t)(cur.e * g.nct + cur.pn) * tstep;
    if constexpr (GATHER) {
        cA = (const char*)g.A;
#pragma unroll
        for (int i = 0; i < 2; ++i) { vA0[i] = (unsigned)((tok[cur.ui * 256 + Rl[i]] & 0xffff) * KB + Cl[i]); vA1[i] = (unsigned)((tok[cur.ui * 256 + 128 + Rl[i]] & 0xffff) * KB + Cl[i]); nA0[i] = vA0[i]; nA1[i] = vA1[i]; }
    } else cA = (const char*)g.A + (size_t)cur.pm * tstep;
    PG8_STAGE(PG8_SB(0, 0), cB, voffB); PG8_STAGE(PG8_SB(0, 1), cB + hstep, voffB); PG8_STAGE_A(PG8_SA(0, 0), cA, 0, vA0, vA1); PG8_STAGE_A(PG8_SA(0, 1), cA, 1, vA0, vA1);
    if (wr == 1) PG8_BAR;
    PG8_WAIT_V(2); PG8_BAR;
    PG8_STAGE(PG8_SB(1, 0), cB + kstep, voffB); PG8_STAGE_A(PG8_SA(1, 0), cA + kstep, 0, vA0, vA1); PG8_STAGE(PG8_SB(1, 1), cB + hstep + kstep, voffB);
    PG8_WAIT_V(6); PG8_BAR;
    for (;;) {
        const bool has_next = S.next(ui + 1, nxt);
        const char* nAp; const char* nB;
        if (has_next) {
            nB = (const char*)g.Bt + (size_t)(nxt.e * g.nct + nxt.pn) * tstep;
            if constexpr (GATHER) { nAp = cA;
#pragma unroll
                for (int i = 0; i < 2; ++i) { nA0[i] = (unsigned)((tok[nxt.ui * 256 + Rl[i]] & 0xffff) * KB + Cl[i]); nA1[i] = (unsigned)((tok[nxt.ui * 256 + 128 + Rl[i]] & 0xffff) * KB + Cl[i]); }
            } else nAp = (const char*)g.A + (size_t)nxt.pm * tstep;
        } else { nAp = cA; nB = cB; }
        for (int t = 0; t < nt; t += 2) {
            const bool last = (t == nt - 2);
            const char* a1 = cA + (size_t)(t + 1) * kstep;
            const char* a2 = last ? nAp : cA + (size_t)(t + 2) * kstep; const char* b2 = last ? nB : cB + (size_t)(t + 2) * kstep;
            const char* a3 = a2 + kstep; const char* b3 = b2 + kstep;
            unsigned w0[2] = {0u, 0u}, w1[2] = {0u, 0u};
            if constexpr (GATHER) {
#pragma unroll
                for (int i = 0; i < 2; ++i) { w0[i] = last ? nA0[i] : vA0[i]; w1[i] = last ? nA1[i] : vA1[i]; } }
            if constexpr (Epi::MIDHOOK) { if (t == nt / 2) E.mid(acc, cur, wr, wc, fr, fq); }
            PG8_LDB(B0, 0, 0); PG8_LDB(B1, 0, 1); PG8_SCHED; PG8_LDA(At, 0, 0); PG8_STAGE_A(PG8_SA(1, 1), a1, 1, vA0, vA1);
            PG8_WAIT_V(8); PG8_WAIT_L(0); PG8_BAR; PG8_MM(0, 0, At, B0); PG8_MM(0, 1, At, B1); PG8_BAR; PG8_SCHED;
            PG8_LDA(At, 0, 1); PG8_STAGE(PG8_SB(0, 0), b2, voffB); PG8_STAGE(PG8_SB(0, 1), b2 + hstep, voffB); PG8_STAGE_A(PG8_SA(0, 0), a2, 0, w0, w1);
            PG8_WAIT_V(8); PG8_WAIT_L(0); PG8_BAR; PG8_MM(1, 0, At, B0); PG8_MM(1, 1, At, B1); PG8_BAR; PG8_SCHED;
            PG8_LDB(B0, 1, 0); PG8_LDB(B1, 1, 1); PG8_SCHED; PG8_LDA(At, 1, 0); PG8_STAGE_A(PG8_SA(0, 1), a2, 1, w0, w1);
            PG8_WAIT_V(8); PG8_WAIT_L(0); PG8_BAR; PG8_MM(0, 0, At, B0); PG8_MM(0, 1, At, B1); PG8_BAR; PG8_SCHED;
            PG8_LDA(At, 1, 1); PG8_STAGE(PG8_SB(1, 0), b3, voffB); PG8_STAGE(PG8_SB(1, 1), b3 + hstep, voffB); PG8_STAGE_A(PG8_SA(1, 0), a3, 0, w0, w1);
            PG8_WAIT_V(8); PG8_WAIT_L(0); PG8_BAR; PG8_MM(1, 0, At, B0); PG8_MM(1, 1, At, B1); PG8_BAR; PG8_SCHED;
        }
        if constexpr (ALIGN_EPI) { if (wr == 0) PG8_BAR; }
        E(acc, cur, wr, wc, fr, fq);
        if (!has_next) break;
#pragma unroll
        for (int a = 0; a < 2; ++a)
#pragma unroll
            for (int b = 0; b < 2; ++b)
#pragma unroll
                for (int m = 0; m < 4; ++m)
#pragma unroll
                    for (int n = 0; n < 2; ++n) acc[a][b][m][n] = (f32x4){0.f, 0.f, 0.f, 0.f};
        cur = nxt; cA = nAp; cB = nB; ++ui;
        if constexpr (GATHER) {
#pragma unroll
            for (int i = 0; i < 2; ++i) { vA0[i] = nA0[i]; vA1[i] = nA1[i]; } }
        if constexpr (ALIGN_EPI) { if (wr == 1) PG8_BAR; }
    }
    PG8_WAIT_V(0);
    if constexpr (!ALIGN_EPI) { if (wr == 0) PG8_BAR; }
    PG8_BAR;
#undef PG8_SA
#undef PG8_SB
#undef PG8_STAGE
#undef PG8_STAGE_A
#undef PG8_LDA
#undef PG8_LDB
#undef PG8_MMA
#undef PG8_MMA8
#undef PG8_MM
#undef PG8_WAIT_V
#undef PG8_WAIT_L
#undef PG8_BAR
#undef PG8_SCHED
}
typedef f32x4 Acc[2][2][4][2];
__device__ __forceinline__ float silu_(float x) { return x * __builtin_amdgcn_rcpf(1.f + __expf(-x)); }
__device__ __forceinline__ float sigm_(float x) { return __builtin_amdgcn_rcpf(1.f + __expf(-x)); }
__device__ __forceinline__ u32x4 pack8(const f32x4 a, const f32x4 b) { u32x4 w; w.x = cvt_pk_bf16(a[0], a[1]); w.y = cvt_pk_bf16(a[2], a[3]); w.z = cvt_pk_bf16(b[0], b[1]); w.w = cvt_pk_bf16(b[2], b[3]); return w; }
__device__ __forceinline__ u32x2 pack8_fp8(const f32x4 a, const f32x4 b) { u32x2 w; w.x = pk4_fp8(a[0], a[1], a[2], a[3]); w.y = pk4_fp8(b[0], b[1], b[2], b[3]); return w; }
__device__ __forceinline__ void unpack8(const u32x4 w, f32x4& a, f32x4& b) { a = (f32x4){bflo(w.x), bfhi(w.x), bflo(w.y), bfhi(w.y)}; b = (f32x4){bflo(w.z), bfhi(w.z), bflo(w.w), bfhi(w.w)}; }

struct EpiInproj {
    static constexpr bool MIDHOOK = false;
    const float* rs1; const float* lb; bf16_t *QS, *VV, *GS, *UU, *SBb, *RT, *GBS; h16_t* LF; float osc;
    __device__ __forceinline__ void mid(Acc&, const Unit&, int, int, int, int) const {}
    template <int ACT> __device__ __forceinline__ void plain(const Acc& acc, const float (&rs)[2][4], bf16_t* O, int pt, int row0, int wc, int fq) const {
#pragma unroll
        for (int ai = 0; ai < 2; ++ai)
#pragma unroll
            for (int m = 0; m < 4; ++m) { bf16_t* rowp = O + (size_t)(row0 + ai * HALF + m * 16) * HF + pt * 256 + wc * 32 + 8 * fq; const float r = rs[ai][m];
#pragma unroll
                for (int bj = 0; bj < 2; ++bj) { f32x4 v0 = acc[ai][bj][m][0] * r, v1 = acc[ai][bj][m][1] * r;
                    if (ACT == 1) {
#pragma unroll
                        for (int j = 0; j < 4; ++j) { v0[j] = silu_(v0[j]); v1[j] = silu_(v1[j]); } }
                    *(u32x4*)(rowp + bj * HALF) = pack8(v0, v1); } }
    }
    __device__ __forceinline__ void operator()(const Acc& acc, const Unit& u, int wr, int wc, int fr, int fq) const {
        const int row0 = u.pm * BM + wr * 64 + fr, pn = u.pn;
        float rs[2][4];
#pragma unroll
        for (int ai = 0; ai < 2; ++ai)
#pragma unroll
            for (int m = 0; m < 4; ++m) rs[ai][m] = osc;
        if (pn < 4) plain<1>(acc, rs, QS, pn, row0, wc, fq);
        else if (pn < 8) {
            const int c0 = (pn - 4) * 256 + wc * 32 + 4 * fq;
            f32x4 lbv[2][2];
#pragma unroll
            for (int bj = 0; bj < 2; ++bj)
#pragma unroll
                for (int n = 0; n < 2; ++n) lbv[bj][n] = *(const f32x4*)(lb + c0 + bj * HALF + n * 16);
#pragma unroll
            for (int ai = 0; ai < 2; ++ai)
#pragma unroll
                for (int m = 0; m < 4; ++m) { h16_t* rowp = LF + (size_t)(row0 + ai * HALF + m * 16) * HF + c0; const float r = rs[ai][m];
#pragma unroll
                    for (int bj = 0; bj < 2; ++bj)
#pragma unroll
                        for (int n = 0; n < 2; ++n) { f32x4 v = acc[ai][bj][m][n] * r; const f32x4 l = lbv[bj][n];
#pragma unroll
                            for (int j = 0; j < 4; ++j) v[j] = __logf(l[j] + (1.f - l[j]) * sigm_(v[j]));
                            *(h16x4*)(rowp + bj * HALF + n * 16) = (h16x4){(h16_t)v[0], (h16_t)v[1], (h16_t)v[2], (h16_t)v[3]}; } }
        }
        else if (pn < 12) plain<0>(acc, rs, VV, pn - 8, row0, wc, fq);
        else if (pn < 16) plain<1>(acc, rs, GS, pn - 12, row0, wc, fq);
        else if (pn < 24) {
            const int c0 = (pn - 16) * 128 + wc * 32 + 8 * fq;
#pragma unroll
            for (int ai = 0; ai < 2; ++ai)
#pragma unroll
                for (int m = 0; m < 4; ++m) { const float r2 = rs[ai][m] * rs[ai][m];
                    const f32x4 v0 = acc[ai][0][m][0] * acc[ai][1][m][0] * r2, v1 = acc[ai][0][m][1] * acc[ai][1][m][1] * r2;
                    *(u32x4*)(UU + (size_t)(row0 + ai * HALF + m * 16) * HF + c0) = pack8(v0, v1); }
        }
        else if (pn < 28) plain<0>(acc, rs, SBb, pn - 24, row0, wc, fq);
        else {
            const int c0 = (pn - 28) * 128 + wc * 32 + 8 * fq;
#pragma unroll
            for (int ai = 0; ai < 2; ++ai)
#pragma unroll
                for (int m = 0; m < 4; ++m) { const float r = rs[ai][m]; f32x4 q0, q1, b0, b1;
#pragma unroll
                    for (int j = 0; j < 4; ++j) { const float ea = 1.f + __expf(-acc[ai][0][m][0][j] * r), eb = 1.f + __expf(-acc[ai][1][m][0][j] * r); b0[j] = __builtin_amdgcn_rcpf(eb); q0[j] = eb * __builtin_amdgcn_rcpf(ea);
                                                  const float fa = 1.f + __expf(-acc[ai][0][m][1][j] * r), fb = 1.f + __expf(-acc[ai][1][m][1][j] * r); b1[j] = __builtin_amdgcn_rcpf(fb); q1[j] = fb * __builtin_amdgcn_rcpf(fa); }
                    const size_t o = (size_t)(row0 + ai * HALF + m * 16) * D + c0;
                    *(u32x4*)(RT + o) = pack8(q0, q1); *(u32x4*)(GBS + o) = pack8(b0, b1); }
        }
    }
};

struct EpiMerge {
    static constexpr bool MIDHOOK = true;
    const bf16_t *RT, *GBS; bf16_t* MG;
    __device__ __forceinline__ void mid(Acc& acc, const Unit& u, int wr, int wc, int fr, int fq) const {
        unsigned o0 = ((unsigned)(u.pm * BM + wr * 64 + fr) * D + (unsigned)(u.pn * BM + wc * 32 + 8 * fq)) * 2u;
        asm volatile("" : "+v"(o0));
#pragma unroll
        for (int ai = 0; ai < 2; ++ai)
#pragma unroll
            for (int m = 0; m < 4; ++m)
#pragma unroll
                for (int bj = 0; bj < 2; ++bj) { const u32x4 w = *(const GAS u32x4*)((const GAS char*)RT + (o0 + (unsigned)((ai * HALF + m * 16) * D + bj * HALF) * 2u)); f32x4 a, b; unpack8(w, a, b);
                    acc[ai][bj][m][0] *= a; acc[ai][bj][m][1] *= b; }
    }
    __device__ __forceinline__ void operator()(const Acc& acc, const Unit& u, int wr, int wc, int fr, int fq) const {
        unsigned o0 = ((unsigned)(u.pm * BM + wr * 64 + fr) * D + (unsigned)(u.pn * BM + wc * 32 + 8 * fq)) * 2u;
        asm volatile("" : "+v"(o0));
#pragma unroll
        for (int ai = 0; ai < 2; ++ai)
#pragma unroll
            for (int m = 0; m < 4; ++m)
#pragma unroll
                for (int bj = 0; bj < 2; ++bj) { const unsigned o = o0 + (unsigned)((ai * HALF + m * 16) * D + bj * HALF) * 2u; const u32x4 w = *(const GAS u32x4*)((const GAS char*)GBS + o); f32x4 a, b; unpack8(w, a, b);
                    *(GAS u32x4*)((GAS char*)MG + o) = pack8(acc[ai][bj][m][0] * a, acc[ai][bj][m][1] * b); if (bj == 1 && m == 3) asm volatile("" ::: "memory"); }
    }
};

struct EpiWo {
    static constexpr bool MIDHOOK = false;
    bf16_t* DL;
    __device__ __forceinline__ void mid(Acc&, const Unit&, int, int, int, int) const {}
    __device__ __forceinline__ void operator()(const Acc& acc, const Unit& u, int wr, int wc, int fr, int fq) const {
        const int row0 = u.pm * BM + wr * 64 + fr, c0 = u.pn * BM + wc * 32 + 8 * fq;
#pragma unroll
        for (int ai = 0; ai < 2; ++ai)
#pragma unroll
            for (int m = 0; m < 4; ++m)
#pragma unroll
                for (int bj = 0; bj < 2; ++bj) *(u32x4*)(DL + (size_t)(row0 + ai * HALF + m * 16) * D + c0 + bj * HALF) = pack8(acc[ai][bj][m][0], acc[ai][bj][m][1]);
    }
};

struct EpiUp {
    static constexpr bool MIDHOOK = false;
    const float* rs2; const LAS int* tok; const LAS bf16_t* bias; unsigned char* ACT;
    __device__ __forceinline__ void mid(Acc&, const Unit&, int, int, int, int) const {}
    __device__ __forceinline__ void operator()(const Acc& acc, const Unit& u, int wr, int wc, int fr, int fq) const {
        const int rl0 = wr * 64 + fr, c0 = u.pn * 128 + wc * 32 + 8 * fq;
        float rs[2][4];
#pragma unroll
        for (int ai = 0; ai < 2; ++ai)
#pragma unroll
            for (int m = 0; m < 4; ++m) rs[ai][m] = __uint_as_float((unsigned)tok[u.ui * 256 + rl0 + ai * HALF + m * 16] & 0xffff0000u);
        const LAS bf16_t* bp = bias + u.ui * 256 + wc * 32 + 8 * fq;
        f32x4 bg0, bg1, bu0, bu1; unpack8(*(const LAS u32x4*)(bp), bg0, bg1); unpack8(*(const LAS u32x4*)(bp + 128), bu0, bu1);
#pragma unroll
        for (int ai = 0; ai < 2; ++ai)
#pragma unroll
            for (int m = 0; m < 4; ++m) { const float r = rs[ai][m]; f32x4 a0, a1;
#pragma unroll
                for (int n = 0; n < 2; ++n)
#pragma unroll
                    for (int jp = 0; jp < 2; ++jp) {
                        const f32x4 ag = acc[ai][0][m][n], au = acc[ai][1][m][n], bgv = n ? bg1 : bg0, buv = n ? bu1 : bu0;
                        f32x2 g = (f32x2){ag[2 * jp], ag[2 * jp + 1]} * r + (f32x2){bgv[2 * jp], bgv[2 * jp + 1]};
                        f32x2 uu = (f32x2){au[2 * jp], au[2 * jp + 1]} * r + (f32x2){buv[2 * jp], buv[2 * jp + 1]};
                        g.x = fminf(g.x, 7.f); g.y = fminf(g.y, 7.f);
                        uu.x = __builtin_amdgcn_fmed3f(uu.x, -7.f, 7.f); uu.y = __builtin_amdgcn_fmed3f(uu.y, -7.f, 7.f);
                        const f32x2 t = g * (-1.702f * 1.44269504f);
                        f32x2 den; den.x = __builtin_amdgcn_exp2f(t.x); den.y = __builtin_amdgcn_exp2f(t.y); den = den + 1.f;
                        f32x2 s; s.x = __builtin_amdgcn_rcpf(den.x); s.y = __builtin_amdgcn_rcpf(den.y);
                        const f32x2 a = (uu + 1.f) * (g * s);
                        if (n == 0) { a0[2 * jp] = a.x; a0[2 * jp + 1] = a.y; } else { a1[2 * jp] = a.x; a1[2 * jp + 1] = a.y; }
                    }
                *(u32x2*)(ACT + (size_t)(u.pm * BM + rl0 + ai * HALF + m * 16) * DFF + c0) = pack8_fp8(a0, a1); }
    }
};

struct EpiDown {
    static constexpr bool MIDHOOK = false;
    const LAS float* bias; unsigned char* YR;
    __device__ __forceinline__ void mid(Acc&, const Unit&, int, int, int, int) const {}
    __device__ __forceinline__ void operator()(const Acc& acc, const Unit& u, int wr, int wc, int fr, int fq) const {
        const int rl0 = wr * 64 + fr, c0 = u.pn * BM + wc * 32 + 8 * fq;
        const LAS float* bp = bias + u.ui * 256 + wc * 32 + 8 * fq;
        f32x4 bv[2][2];
#pragma unroll
        for (int bj = 0; bj < 2; ++bj)
#pragma unroll
            for (int n = 0; n < 2; ++n) bv[bj][n] = *(const LAS f32x4*)(bp + bj * HALF + 4 * n);
#pragma unroll
        for (int ai = 0; ai < 2; ++ai)
#pragma unroll
            for (int m = 0; m < 4; ++m)
#pragma unroll
                for (int bj = 0; bj < 2; ++bj)
                    *(u32x2*)(YR + (size_t)(u.pm * BM + rl0 + ai * HALF + m * 16) * D + c0 + bj * HALF) = pack8_fp8(acc[ai][bj][m][0] * W8_INV + bv[bj][0], acc[ai][bj][m][1] * W8_INV + bv[bj][1]);
    }
};

struct EpiDummy {
    static constexpr bool MIDHOOK = false;
    bf16_t* O; int nostore;
    __device__ __forceinline__ void mid(Acc&, const Unit&, int, int, int, int) const {}
    __device__ __forceinline__ void operator()(const Acc& acc, const Unit& u, int wr, int wc, int fr, int fq) const {
        const int row0 = (u.pm & 63) * BM + wr * 64 + fr, c0 = (u.pn & 7) * BM + wc * 32 + 8 * fq;
        if (nostore) {
#pragma unroll
            for (int ai = 0; ai < 2; ++ai)
#pragma unroll
                for (int m = 0; m < 4; ++m)
#pragma unroll
                    for (int bj = 0; bj < 2; ++bj) asm volatile("" :: "v"(acc[ai][bj][m][0]), "v"(acc[ai][bj][m][1]));
            return; }
#pragma unroll
        for (int ai = 0; ai < 2; ++ai)
#pragma unroll
            for (int m = 0; m < 4; ++m)
#pragma unroll
                for (int bj = 0; bj < 2; ++bj) *(u32x4*)(O + (size_t)(row0 + ai * HALF + m * 16) * D + c0 + bj * HALF) = pack8(acc[ai][bj][m][0], acc[ai][bj][m][1]);
    }
};
struct ProbeOrder {
    StaticOrder S; int mode, c;
    __device__ __forceinline__ bool next(int i, Unit& u) const {
        if (mode == 3) { if (c & 1) return false; StaticOrder H = S; H.G = S.G / 2; H.c = c >> 1; H.nwg = S.nwg / 2; return H.next(i, u); }
        if (!S.next(i, u)) return false; if (mode >= 1) u.pn = 0; if (mode >= 2) u.pm = c & 63; return true; }
};

struct ProbeMoe {
    MoeOrder S; int mode;
    __device__ __forceinline__ bool next(int i, Unit& u) const { if (!S.next(i, u)) return false; if (mode & 1) { u.e = 0; u.pn = 0; } if (mode & 2) u.pm = 0; return true; }
};
struct Frame {
    LAS unsigned char* lds; volatile LAS unsigned* MISC; gu32* ctl; unsigned char* ws;
    int tid, lane, wave, vcu, G;
    const float *x, *meta, *nmw, *w_in, *lbl, *gnw, *w_ho, *cw, *w_co, *w_o, *nfw, *w_r, *b_r, *w_up, *b_up, *w_dn, *b_dn, *fnw; float* out;
};
template <class T> __device__ __forceinline__ T* wsp(const Frame& F, size_t off) { return (T*)(F.ws + off); }

__device__ __forceinline__ void tr_tile(const float* W, int ldw, int k0, int src0, int src1, bool perm0, bool perm1, const float* kscale, bf16_t* dst, int dpitch, int drow0, int dk0, LAS unsigned* T, int lane) {
    const int ln = lane & 15, kr = lane >> 4, srcc = (ln < 8 ? src0 : src1) + 4 * (ln & 7);
    const float* wp = W + (size_t)(k0 + 2 * kr) * ldw + srcc;
    f32x4 va[8], vb[8]; f32x2 sc[8];
#pragma unroll
    for (int s = 0; s < 8; ++s) { va[s] = __builtin_nontemporal_load((const GAS f32x4*)(wp + (size_t)(8 * s) * ldw)); vb[s] = __builtin_nontemporal_load((const GAS f32x4*)(wp + (size_t)(8 * s + 1) * ldw));
        sc[s] = kscale ? *(const GAS f32x2*)(kscale + k0 + 8 * s + 2 * kr) : (f32x2){1.f, 1.f}; }
    __builtin_amdgcn_sched_barrier(0);
#pragma unroll
    for (int s = 0; s < 8; ++s) { const int col = (4 * s + kr) ^ (2 * ln);
#pragma unroll
        for (int i = 0; i < 4; ++i) T[(4 * ln + i) * 32 + col] = cvt_pk_bf16(va[s][i] * sc[s].x, vb[s][i] * sc[s].y); }
    LDS_WAIT(); asm volatile("" ::: "memory");
    const int c = lane & 7;
#pragma unroll
    for (int j = 0; j < 8; ++j) { const int rho = (lane >> 3) + 8 * j, h = rho >> 5, r32 = rho & 31; const bool pm = h ? perm1 : perm0; const int n = h * 32 + (pm ? perm32(r32) : r32);
        u32x4 v = *(const LAS u32x4*)(T + n * 32 + 4 * (c ^ (n >> 3)));
        if ((n >> 2) & 1) v = (u32x4){v.z, v.w, v.x, v.y};
        *(GAS u32x4*)(dst + (size_t)(drow0 + rho) * dpitch + dk0 + k0 + 8 * c) = v; }
    LDS_WAIT(); asm volatile("" ::: "memory");
}
template <int PMODE = 0> __device__ __forceinline__ void tr_tile_fp8(const float* W, int ldw, int k0, int src0, int src1, const float* kscale, unsigned char* dst, int dpitch, int drow0, LAS unsigned* T, int lane, bool perm = true) {
    const int ln = lane & 15, kr = lane >> 4, srcc = (ln < 8 ? src0 : src1) + 4 * (ln & 7);
    f32x4 v[2][4][4];
#pragma unroll
    for (int half = 0; half < 2; ++half) {
        const float* wp = W + (size_t)(k0 + 64 * half + 4 * kr) * ldw + srcc;
#pragma unroll
        for (int s = 0; s < 4; ++s) {
#pragma unroll
            for (int q = 0; q < 4; ++q) v[half][s][q] = __builtin_nontemporal_load((const GAS f32x4*)(wp + (size_t)(16 * s + q) * ldw)); }
    }
    __builtin_amdgcn_sched_barrier(0);
    if (PMODE == 1) {
#pragma unroll
        for (int half = 0; half < 2; ++half)
#pragma unroll
            for (int s = 0; s < 4; ++s)
#pragma unroll
                for (int q = 0; q < 4; ++q) asm volatile("" :: "v"(v[half][s][q]));
        return; }
#pragma unroll
    for (int half = 0; half < 2; ++half)
#pragma unroll
        for (int s = 0; s < 4; ++s) { const int col = (16 * half + 4 * s + kr) ^ (2 * ln);
            const f32x4 sc = kscale ? *(const GAS f32x4*)(kscale + k0 + 64 * half + 16 * s + 4 * kr) * W8_SCALE : (f32x4){W8_SCALE, W8_SCALE, W8_SCALE, W8_SCALE};
#pragma unroll
            for (int i = 0; i < 4; ++i) T[(4 * ln + i) * 32 + col] = pk4_fp8(v[half][s][0][i] * sc[0], v[half][s][1][i] * sc[1], v[half][s][2][i] * sc[2], v[half][s][3][i] * sc[3]); }
    LDS_WAIT(); asm volatile("" ::: "memory");
    const int c = lane & 7;
#pragma unroll
    for (int j = 0; j < 8; ++j) { const int rho = (lane >> 3) + 8 * j, h = rho >> 5, r32 = rho & 31; const int n = h * 32 + (perm ? perm32(r32) : r32);
        u32x4 v4 = *(const LAS u32x4*)(T + n * 32 + 4 * (c ^ (n >> 3)));
        if ((n >> 2) & 1) v4 = (u32x4){v4.z, v4.w, v4.x, v4.y};
        if (PMODE == 2) asm volatile("" :: "v"(v4)); else *(GAS u32x4*)(dst + (size_t)(drow0 + rho) * dpitch + k0 + 16 * c) = v4; }
    LDS_WAIT(); asm volatile("" ::: "memory");
}
__device__ __forceinline__ int win_src(int G, bool& perm) {
    const int pn = G >> 3, gi = G & 7; perm = true;
    if (pn < 4) return C_Q + pn * 256 + gi * 32;
    if (pn < 8) { perm = false; return C_F + (pn - 4) * 256 + gi * 32; }
    if (pn < 12) return C_V + (pn - 8) * 256 + gi * 32;
    if (pn < 16) return C_G + (pn - 12) * 256 + gi * 32;
    if (pn < 24) return (gi < 4 ? C_SV : C_SC) + (pn - 16) * 128 + (gi & 3) * 32;
    if (pn < 28) return C_SB + (pn - 24) * 256 + gi * 32;
    return (gi < 4 ? C_GA : C_GB) + (pn - 28) * 128 + (gi & 3) * 32;
}
__device__ __forceinline__ void p0_prologue(Frame& F) {
    const int gw = F.vcu * NWAVES + F.wave, NGW = F.G * NWAVES, gt = F.vcu * NTHR + F.tid, NGT = F.G * NTHR;
    for (int i = gt; i < HF; i += NGT) wsp<float>(F, WS_LB)[i] = 1.f / (1.f + __expf(F.lbl[HF + i] - F.lbl[i]));
    for (int i = gt; i < D * NE; i += NGT) { const int k = i >> 5, e = i & 31; const float v = F.w_r[i] * F.nfw[k]; const unsigned h = f2bf(v); const float lo = v - bf2f((unsigned short)h);
        wsp<bf16_t>(F, WS_WRH)[e * D + k] = (bf16_t)h; wsp<bf16_t>(F, WS_WRL)[e * D + k] = (bf16_t)f2bf(lo); }
    for (int i = gt; i < 48 * HF; i += NGT) { wsp<h16_t>(F, WS_LFM)[i] = (h16_t)0.f; wsp<bf16_t>(F, WS_VVM)[i] = 0; }
    {
        LAS float* hnm = (LAS float*)F.lds;
        for (int r = F.wave * 2; r < F.wave * 2 + 2; ++r) {
            const f32x4* xr = (const f32x4*)(F.meta + (size_t)r * D) + F.lane; f32x4 v[8]; float s = 0.f;
#pragma unroll
            for (int j = 0; j < 8; ++j) { v[j] = xr[64 * j]; s += (v[j].x * v[j].x + v[j].y * v[j].y) + (v[j].z * v[j].z + v[j].w * v[j].w); }
            const float rs = rsqrtf(wave_sum(s) * (1.f / D) + EPS);
#pragma unroll
            for (int j = 0; j < 8; ++j) { const f32x4 w = ((const f32x4*)F.nmw)[F.lane + 64 * j]; *(LAS f32x4*)(hnm + r * D + 4 * F.lane + 256 * j) = v[j] * rs * w; }
        }
        __syncthreads();
        LAS float* red = (LAS float*)(F.lds + TOK_OFF);
        for (int cb = F.vcu; cb < 256; cb += F.G) {
            const int col = F.tid & 15, ks = F.tid >> 4;
            int gcol;
            if (cb < 64) gcol = C_F + 16 * cb + col; else if (cb < 128) gcol = C_V + 16 * (cb - 64) + col; else gcol = (col < 8 ? C_SV : C_SC) + 8 * (cb - 128) + (col & 7);
            float a[16];
#pragma unroll
            for (int r = 0; r < 16; ++r) a[r] = 0.f;
#pragma unroll 1
            for (int hf = 0; hf < 2; ++hf) {
                float w[32]; const int kb = ks * 64 + 32 * hf;
#pragma unroll
                for (int kk = 0; kk < 32; ++kk) w[kk] = F.w_in[(size_t)(kb + kk) * INC + gcol];
                __builtin_amdgcn_sched_barrier(0);
#pragma unroll
                for (int k4 = 0; k4 < 8; ++k4) {
#pragma unroll
                    for (int r = 0; r < 16; ++r) { const f32x4 h = *(const LAS f32x4*)(hnm + r * D + kb + 4 * k4);
                        a[r] = fmaf(h.x, w[4 * k4], a[r]); a[r] = fmaf(h.y, w[4 * k4 + 1], a[r]); a[r] = fmaf(h.z, w[4 * k4 + 2], a[r]); a[r] = fmaf(h.w, w[4 * k4 + 3], a[r]); }
                    __builtin_amdgcn_sched_barrier(0); } }
#pragma unroll
            for (int r = 0; r < 16; ++r) { a[r] += __shfl_xor(a[r], 16); a[r] += __shfl_xor(a[r], 32); }
            if (F.lane < 16) {
#pragma unroll
                for (int r = 0; r < 16; ++r) red[(F.wave * 16 + r) * 16 + col] = a[r]; }
            __syncthreads();
            if (F.tid < 256) { const int r = F.tid >> 4, c = F.tid & 15; float v = 0.f;
#pragma unroll
                for (int w = 0; w < 8; ++w) v += red[(w * 16 + r) * 16 + c];
                if (cb < 64) { const int ch = 16 * cb + c; const float l = 1.f / (1.f + __expf(F.lbl[HF + ch] - F.lbl[ch])); wsp<h16_t>(F, WS_LFM)[(48 + r) * HF + ch] = (h16_t)__logf(l + (1.f - l) * sigmoidf_(v)); }
                else if (cb < 128) wsp<bf16_t>(F, WS_VVM)[(48 + r) * HF + 16 * (cb - 64) + c] = (bf16_t)f2bf(v);
                else red[2048 + r * 16 + c] = v; }
            __syncthreads();
            if (cb >= 128 && F.tid < 128) { const int r = F.tid >> 3, c = F.tid & 7; wsp<bf16_t>(F, WS_UUM)[r * HF + 8 * (cb - 128) + c] = (bf16_t)f2bf(red[2048 + r * 16 + c] * red[2048 + r * 16 + c + 8]); }
            __syncthreads();
        }
        __syncthreads();
    }
    {
        LAS unsigned* T = (LAS unsigned*)(F.lds + F.wave * 16384);
        constexpr int I_IN = 32 * 4 * N_INB, I_AB = 16 * 32, I_O = 32 * 32, I_UP1 = 16 * 64, I_DN1 = 16 * 32;
        constexpr int I_IN8 = 16 * 4 * N_IN8;
        constexpr int NIT = I_IN + I_IN8 + 2 * I_AB + I_O;
        for (int it = gw; it < NIT; it += NGW) {
            int r = it;
            if (r < I_IN) { const int kb = r / (4 * N_INB), ntl = r % (4 * N_INB), nt = 4 * nth_bit(INB_MASK, ntl >> 2) + (ntl & 3); bool p0, p1; const int s0 = win_src(2 * nt, p0), s1 = win_src(2 * nt + 1, p1); tr_tile(F.w_in, INC, kb * 64, s0, s1, p0, p1, F.nmw, wsp<bf16_t>(F, WS_WIN), D, nt * 64, 0, T, F.lane); continue; } r -= I_IN;
            if (r < I_IN8) { const int kb = r / (4 * N_IN8), ntl = r % (4 * N_IN8), nt = 4 * nth_bit(IN8_MASK, ntl >> 2) + (ntl & 3); bool p0, p1; const int s0 = win_src(2 * nt, p0), s1 = win_src(2 * nt + 1, p1);
                tr_tile_fp8<0>(F.w_in, INC, kb * 128, s0, s1, F.nmw, wsp<unsigned char>(F, WS_WIN8), D, nt * 64, T, F.lane, p0); continue; } r -= I_IN8;
            if (r < I_AB) { const int kb = r / 32, nt = r % 32; tr_tile(F.w_ho, D, kb * 64, nt * 64, nt * 64 + 32, true, true, nullptr, wsp<bf16_t>(F, WS_WAB), D, nt * 64, 0, T, F.lane); continue; } r -= I_AB;
            if (r < I_AB) { const int kb = r / 32, nt = r % 32; tr_tile(F.w_co, D, kb * 64, nt * 64, nt * 64 + 32, true, true, nullptr, wsp<bf16_t>(F, WS_WAB), D, nt * 64, HF, T, F.lane); continue; } r -= I_AB;
            if (r < I_O) { const int kb = r / 32, nt = r % 32; tr_tile(F.w_o, D, kb * 64, nt * 64, nt * 64 + 32, true, true, nullptr, wsp<bf16_t>(F, WS_WO), D, nt * 64, 0, T, F.lane); continue; } r -= I_O;
        }
    }
    for (int m = gw; m < M; m += NGW) {
        const GAS f32x4* xr = (const GAS f32x4*)(F.x + (size_t)m * D) + F.lane; f32x4 v[8]; float s = 0.f;
#pragma unroll
        for (int j = 0; j < 8; ++j) v[j] = xr[64 * j];
        __builtin_amdgcn_sched_barrier(0);
#pragma unroll
        for (int j = 0; j < 8; ++j) s += (v[j].x * v[j].x + v[j].y * v[j].y) + (v[j].z * v[j].z + v[j].w * v[j].w);
        s = wave_sum(s);
        const float rsx = rsqrtf(s * (1.f / D) + EPS);
#pragma unroll
        for (int j = 0; j < 8; ++j) v[j] *= rsx;
        GAS u32x2* o8 = (GAS u32x2*)(wsp<bf16_t>(F, WS_XB) + (size_t)m * D) + F.lane;
#pragma unroll
        for (int j = 0; j < 8; ++j) { u32x2 w; w.x = pk2(v[j].x, v[j].y); w.y = pk2(v[j].z, v[j].w); o8[64 * j] = w; }
        GAS unsigned* o4 = (GAS unsigned*)(wsp<unsigned char>(F, WS_XB8) + (size_t)m * D) + F.lane;
#pragma unroll
        for (int j = 0; j < 8; ++j) o4[64 * j] = pk4_fp8(v[j].x, v[j].y, v[j].z, v[j].w);
    }
}

template <int PMODE = 0> __device__ __forceinline__ void p1_convert(Frame& F, int rank, int nconv) {
    LAS unsigned* T = (LAS unsigned*)(F.lds + F.wave * 16384);
    constexpr int I_UP1 = 16 * 64, I_DN1 = 16 * 32, NIT = NE * (I_UP1 + I_DN1);
    for (int it = rank * NWAVES + F.wave; it < NIT; it += nconv * NWAVES) {
        int r = it;
        if (r < NE * I_UP1) { const int e = r / I_UP1, q = r % I_UP1, kb = q / 64, nt = q % 64, G0 = 2 * nt, pn = G0 >> 3, gi = G0 & 7; const int s0 = (gi < 4 ? 0 : 2048) + pn * 128 + (gi & 3) * 32;
            tr_tile_fp8<PMODE>(F.w_up + (size_t)e * D * 4096, 4096, kb * 128, s0, s0 + 32, F.nfw, wsp<unsigned char>(F, WS_WUP) + (size_t)e * 4096 * D, D, nt * 64, T, F.lane); continue; } r -= NE * I_UP1;
        { const int e = r / I_DN1, q = r % I_DN1, kb = q / 32, nt = q % 32;
          tr_tile_fp8<PMODE>(F.w_dn + (size_t)e * DFF * D, D, kb * 128, nt * 64, nt * 64 + 32, nullptr, wsp<unsigned char>(F, WS_WDN) + (size_t)e * D * DFF, DFF, nt * 64, T, F.lane); }
    }
}

constexpr int KTP = 72;
constexpr int QP_ = 136;
__device__ __forceinline__ void vt_load(const Frame& F, const bf16_t* Vb, size_t row0, int h, u32x4 (&w)[2]) {
#pragma unroll
    for (int q = 0; q < 2; ++q) { const int id = F.tid + 512 * q, t = id >> 4, v8 = (id & 15) * 8; w[q] = *(const GAS u32x4*)(Vb + (row0 + t) * HF + h * 128 + v8); }
}
__device__ __forceinline__ void vt_store(const Frame& F, const u32x4 (&w)[2], LAS bf16_t* VT) {
#pragma unroll
    for (int q = 0; q < 2; ++q) { const int id = F.tid + 512 * q, t = id >> 4, v8 = (id & 15) * 8; const unsigned ww[4] = {w[q].x, w[q].y, w[q].z, w[q].w};
        const int ts = t ^ (v8 & 24);
#pragma unroll
        for (int i = 0; i < 4; ++i) { VT[(v8 + 2 * i) * KTP + ts] = (bf16_t)(ww[i] & 0xffffu); VT[(v8 + 2 * i + 1) * KTP + ts] = (bf16_t)(ww[i] >> 16); } }
}
__device__ __forceinline__ int vt_off(int v, int t0) { return v * KTP + (t0 ^ (v & 24)); }
struct P2aRegs { float L[16]; u32x4 vw[2]; };
__device__ __forceinline__ void p2a_where(const Frame& F, int u, const h16_t*& Lb, const bf16_t*& Vb, size_t& row0, int& h, int& slot) {
    if (u < 8) { Lb = wsp<h16_t>(F, WS_LFM); Vb = wsp<bf16_t>(F, WS_VVM); row0 = 0; h = u; slot = 32 * 64 + u; }
    else { const int bh = (u - 8) >> 6, c = (u - 8) & 63, b = bh >> 3; h = bh & 7; Lb = wsp<h16_t>(F, WS_LF); Vb = wsp<bf16_t>(F, WS_VV); row0 = (size_t)b * SEQ + 64 * c; slot = bh * 64 + c; }
}
__device__ __forceinline__ void p2a_load(const Frame& F, int u, P2aRegs& R) {
    const h16_t* Lb; const bf16_t* Vb; size_t row0; int h, slot; p2a_where(F, u, Lb, Vb, row0, h, slot);
    const int d = F.tid & 127, tq = F.tid >> 7;
#pragma unroll
    for (int i = 0; i < 16; ++i) R.L[i] = (float)Lb[(row0 + 16 * tq + i) * HF + h * 128 + d];
    vt_load(F, Vb, row0, h, R.vw);
}
__device__ __forceinline__ void p2a_compute(Frame& F, int u, const P2aRegs& R) {
    LAS bf16_t* KT = (LAS bf16_t*)F.lds; LAS bf16_t* VT = KT + 128 * KTP; LAS float* TOT = (LAS float*)(F.lds + 2 * 128 * KTP * 2);
    const h16_t* Lb; const bf16_t* Vb; size_t row0; int h, slot; p2a_where(F, u, Lb, Vb, row0, h, slot);
    const int d = F.tid & 127, tq = F.tid >> 7;
    float cs[16]; float run = 0.f;
#pragma unroll
    for (int i = 0; i < 16; ++i) { run += R.L[i]; cs[i] = run; }
    TOT[tq * 128 + d] = run;
    vt_store(F, R.vw, VT);
    __syncthreads();
    float off = 0.f, total = 0.f;
#pragma unroll
    for (int q = 0; q < 4; ++q) { const float tv = TOT[q * 128 + d]; total += tv; if (q < tq) off += tv; }
#pragma unroll
    for (int i = 0; i < 16; i += 2) { const float k0 = (1.f - __expf(R.L[i])) * __expf(total - off - cs[i]), k1 = (1.f - __expf(R.L[i + 1])) * __expf(total - off - cs[i + 1]);
        *(LAS unsigned*)(KT + d * KTP + 16 * tq + i) = pk2(k0, k1); }
    if (tq == 0) wsp<float>(F, WS_DEC)[(size_t)slot * 128 + d] = __expf(total);
    __syncthreads();
    {
        const int w = F.wave, fr = F.lane & 15, fq = F.lane >> 4;
        bf16x8 a[2];
#pragma unroll
        for (int ks = 0; ks < 2; ++ks) a[ks] = *(const LAS bf16x8*)(KT + (16 * w + fr) * KTP + 32 * ks + 8 * fq);
        bf16_t* Ub = wsp<bf16_t>(F, WS_UC) + (size_t)slot * 16384;
#pragma unroll
        for (int vb = 0; vb < 8; ++vb) { f32x4 c = (f32x4){0.f, 0.f, 0.f, 0.f};
#pragma unroll
            for (int ks = 0; ks < 2; ++ks) { const bf16x8 bv = *(const LAS bf16x8*)(VT + vt_off(16 * vb + fr, 32 * ks + 8 * fq)); c = __builtin_amdgcn_mfma_f32_16x16x32_bf16(a[ks], bv, c, 0, 0, 0); }
            u32x2 o; o.x = pk2(c[0], c[1]); o.y = pk2(c[2], c[3]);
            *(GAS u32x2*)(Ub + (16 * vb + fr) * 128 + 16 * w + 4 * fq) = o; }
    }
    __syncthreads();
}
__device__ __forceinline__ void p2a_units(Frame& F, int c) {
    constexpr int NU = 2048 + 8;
    if (c >= NU) return;
    P2aRegs R; p2a_load(F, c, R);
    for (int u = c; u < NU; u += F.G) {
        P2aRegs N; const int un = u + F.G; if (un < NU) p2a_load(F, un, N); else N = R;
        p2a_compute(F, u, R);
        R = N;
    }
}
__device__ __forceinline__ void p2a_conv(Frame& F, int item) {
    const int c8 = (F.tid & 127) * 8, tq = F.tid >> 7, r0 = item * 64 + tq * 16, p0 = r0 & (SEQ - 1);
    const bf16_t* UU = wsp<bf16_t>(F, WS_UU); const bf16_t* UUM = wsp<bf16_t>(F, WS_UUM); const bf16_t* SBb = wsp<bf16_t>(F, WS_SB); bf16_t* A2 = wsp<bf16_t>(F, WS_A2);
    f32x4 w0a = *(const f32x4*)(F.cw + c8), w0b = *(const f32x4*)(F.cw + c8 + 4), w1a = *(const f32x4*)(F.cw + HF + c8), w1b = *(const f32x4*)(F.cw + HF + c8 + 4), w2a = *(const f32x4*)(F.cw + 2 * HF + c8), w2b = *(const f32x4*)(F.cw + 2 * HF + c8 + 4);
    f32x4 um2a, um2b, um1a, um1b;
    { const u32x4 a = (p0 >= 2) ? *(const GAS u32x4*)(UU + (size_t)(r0 - 2) * HF + c8) : *(const GAS u32x4*)(UUM + (14 + p0) * HF + c8); unpack8(a, um2a, um2b);
      const u32x4 b = (p0 >= 1) ? *(const GAS u32x4*)(UU + (size_t)(r0 - 1) * HF + c8) : *(const GAS u32x4*)(UUM + 15 * HF + c8); unpack8(b, um1a, um1b); }
#pragma unroll 4
    for (int i = 0; i < 16; ++i) { f32x4 ua, ub, sa, sb; unpack8(*(const GAS u32x4*)(UU + (size_t)(r0 + i) * HF + c8), ua, ub); unpack8(*(const GAS u32x4*)(SBb + (size_t)(r0 + i) * HF + c8), sa, sb);
        const f32x4 oa = sa * (w0a * um2a + w1a * um1a + w2a * ua), ob = sb * (w0b * um2b + w1b * um1b + w2b * ub);
        *(GAS u32x4*)(A2 + (size_t)(r0 + i) * D + HF + c8) = pack8(oa, ob);
        um2a = um1a; um2b = um1b; um1a = ua; um1b = ub; }
}
__device__ __forceinline__ void p2b_scan(Frame& F) {
    const int gw = F.vcu * NWAVES + F.wave;
    for (int it = gw; it < 1024; it += F.G * NWAVES) {
        const int item = it * 64 + F.lane, bh = item >> 11, e8 = item & 2047, h = bh & 7, d0 = (e8 & 15) * 8;
        const bf16_t* Ub = wsp<bf16_t>(F, WS_UC) + (size_t)bh * 64 * 16384 + e8 * 8; bf16_t* Sb = wsp<bf16_t>(F, WS_SS) + (size_t)bh * 64 * 16384 + e8 * 8;
        const float* Db = wsp<float>(F, WS_DEC) + (size_t)bh * 64 * 128 + d0;
        f32x4 s0, s1; unpack8(*(const GAS u32x4*)(wsp<bf16_t>(F, WS_UC) + (size_t)(32 * 64 + h) * 16384 + e8 * 8), s0, s1);
#pragma unroll 8
        for (int c = 0; c < 64; ++c) {
            *(GAS u32x4*)(Sb + (size_t)c * 16384) = pack8(s0, s1);
            f32x4 u0, u1; unpack8(*(const GAS u32x4*)(Ub + (size_t)c * 16384), u0, u1);
            const f32x4 g0 = *(const GAS f32x4*)(Db + c * 128), g1 = *(const GAS f32x4*)(Db + c * 128 + 4);
            s0 = g0 * s0 + u0; s1 = g1 * s1 + u1;
        }
    }
}
struct P2cRegs { f32x2 L[8]; unsigned qw[8]; u32x4 vw[2]; bf16x8 sa[4]; u32x2 gv[4]; };
__device__ __forceinline__ void p2c_load(const Frame& F, int u, P2cRegs& R) {
    const int bh = u >> 6, c = u & 63, b = bh >> 3, h = bh & 7; const size_t row0 = (size_t)b * SEQ + 64 * c;
    const int dp = (F.tid & 63) * 2, t8 = F.tid >> 6, w = F.wave, fr = F.lane & 15, fq = F.lane >> 4;
    const h16_t* Lb = wsp<h16_t>(F, WS_LF) + (row0 + 8 * t8) * HF + h * 128 + dp; const bf16_t* Qb = wsp<bf16_t>(F, WS_QS) + (row0 + 8 * t8) * HF + h * 128 + dp;
#pragma unroll
    for (int i = 0; i < 8; ++i) { const h16x2 lh = *(const GAS h16x2*)(Lb + (size_t)i * HF); R.L[i] = (f32x2){(float)lh.x, (float)lh.y}; R.qw[i] = *(const GAS unsigned*)(Qb + (size_t)i * HF); }
    vt_load(F, wsp<bf16_t>(F, WS_VV), row0, h, R.vw);
    const bf16_t* Sb = wsp<bf16_t>(F, WS_SS) + ((size_t)bh * 64 + c) * 16384 + (16 * w + fr) * 128 + 8 * fq;
#pragma unroll
    for (int ks = 0; ks < 4; ++ks) R.sa[ks] = *(const GAS bf16x8*)(Sb + 32 * ks);
    const bf16_t* GSb = wsp<bf16_t>(F, WS_GS);
#pragma unroll
    for (int tb = 0; tb < 4; ++tb) R.gv[tb] = *(const GAS u32x2*)(GSb + (row0 + 16 * tb + fr) * HF + h * 128 + 16 * w + 4 * fq);
}
__device__ __forceinline__ void p2c_compute(Frame& F, int u, const P2cRegs& R) {
    const int bh = u >> 6, c = u & 63, b = bh >> 3, h = bh & 7; const size_t row0 = (size_t)b * SEQ + 64 * c;
    LAS bf16_t* QPl = (LAS bf16_t*)F.lds; LAS bf16_t* QD = QPl + 64 * QP_; LAS bf16_t* KI = QD + 64 * QP_; LAS bf16_t* VT = KI + 160 * QP_; LAS bf16_t* PL = VT + 128 * KTP;
    LAS float* TOT8 = (LAS float*)(PL + 64 * KTP); LAS float* SSQ = TOT8 + 8 * 128;
    const int dp = (F.tid & 63) * 2, t8 = F.tid >> 6;
    f32x2 L[8], cs[8], q[8]; f32x2 run = (f32x2){0.f, 0.f};
#pragma unroll
    for (int i = 0; i < 8; ++i) { L[i] = R.L[i]; q[i] = (f32x2){bflo(R.qw[i]), bfhi(R.qw[i])}; }
#pragma unroll
    for (int i = 0; i < 8; ++i) { run += L[i]; cs[i] = run; }
    *(LAS f32x2*)(TOT8 + t8 * 128 + dp) = run;
    vt_store(F, R.vw, VT);
    for (int i = F.tid; i < 64 * KTP / 2; i += NTHR) ((LAS unsigned*)PL)[i] = 0u;
    __syncthreads();
    {
        f32x2 pre[9]; pre[0] = (f32x2){0.f, 0.f};
#pragma unroll
        for (int j = 0; j < 8; ++j) pre[j + 1] = pre[j] + *(const LAS f32x2*)(TOT8 + j * 128 + dp);
        f32x2 off = (f32x2){0.f, 0.f};
#pragma unroll
        for (int j = 0; j < 8; ++j) if (j == t8) off = pre[j];
        const int si = t8 >> 1;
        f32x2 st[4];
#pragma unroll
        for (int j = 0; j < 4; ++j) st[j] = pre[2 * j];
        f32x2 sti = st[0];
#pragma unroll
        for (int j = 1; j < 4; ++j) if (j == si) sti = st[j];
#pragma unroll
        for (int i = 0; i < 8; ++i) { const int t = 8 * t8 + i; const f32x2 bc = off + cs[i];
            *(LAS unsigned*)(QPl + t * QP_ + dp) = pk2(q[i].x * __expf(bc.x), q[i].y * __expf(bc.y));
            *(LAS unsigned*)(QD + t * QP_ + dp) = pk2(q[i].x * __expf(bc.x - sti.x), q[i].y * __expf(bc.y - sti.y));
            const f32x2 k = (f32x2){1.f - __expf(L[i].x), 1.f - __expf(L[i].y)};
#pragma unroll
            for (int j = 0; j < 4; ++j) if (j >= si) {
                *(LAS unsigned*)(KI + (8 * j * (j + 1) + t) * QP_ + dp) = pk2(k.x * __expf(fminf(st[j].x - bc.x, 80.f)), k.y * __expf(fminf(st[j].y - bc.y, 80.f))); }
        }
    }
    __syncthreads();
    const int w = F.wave, fr = F.lane & 15, fq = F.lane >> 4;
    for (int bi = w; bi < 10; bi += 8) {
        const int i = bi < 1 ? 0 : bi < 3 ? 1 : bi < 6 ? 2 : 3, j = bi - (i * (i + 1)) / 2;
        f32x4 cacc = (f32x4){0.f, 0.f, 0.f, 0.f};
#pragma unroll
        for (int ks = 0; ks < 4; ++ks) { const bf16x8 a = *(const LAS bf16x8*)(KI + (8 * i * (i + 1) + 16 * j + fr) * QP_ + 32 * ks + 8 * fq), bq = *(const LAS bf16x8*)(QD + (16 * i + fr) * QP_ + 32 * ks + 8 * fq);
            cacc = __builtin_amdgcn_mfma_f32_16x16x32_bf16(a, bq, cacc, 0, 0, 0); }
        if (i == j) {
#pragma unroll
            for (int r = 0; r < 4; ++r) if (4 * fq + r > fr) cacc[r] = 0.f; }
        u32x2 o; o.x = pk2(cacc[0], cacc[1]); o.y = pk2(cacc[2], cacc[3]);
        *(LAS u32x2*)(PL + (16 * i + fr) * KTP + 16 * j + 4 * fq) = o;
    }
    __syncthreads();
    f32x4 acc[4];
#pragma unroll
    for (int tb = 0; tb < 4; ++tb) acc[tb] = (f32x4){0.f, 0.f, 0.f, 0.f};
    {
#pragma unroll
        for (int ks = 0; ks < 4; ++ks)
#pragma unroll
            for (int tb = 0; tb < 4; ++tb) { const bf16x8 bq = *(const LAS bf16x8*)(QPl + (16 * tb + fr) * QP_ + 32 * ks + 8 * fq); acc[tb] = __builtin_amdgcn_mfma_f32_16x16x32_bf16(R.sa[ks], bq, acc[tb], 0, 0, 0); }
#pragma unroll
        for (int ks = 0; ks < 2; ++ks) { const bf16x8 va = *(const LAS bf16x8*)(VT + vt_off(16 * w + fr, 32 * ks + 8 * fq));
#pragma unroll
            for (int tb = 0; tb < 4; ++tb) { const bf16x8 bp = *(const LAS bf16x8*)(PL + (16 * tb + fr) * KTP + 32 * ks + 8 * fq); acc[tb] = __builtin_amdgcn_mfma_f32_16x16x32_bf16(va, bp, acc[tb], 0, 0, 0); } }
    }
#pragma unroll
    for (int tb = 0; tb < 4; ++tb) { float p = (acc[tb][0] * acc[tb][0] + acc[tb][1] * acc[tb][1]) + (acc[tb][2] * acc[tb][2] + acc[tb][3] * acc[tb][3]); p += __shfl_xor(p, 16); p += __shfl_xor(p, 32);
        if (fq == 0) SSQ[w * 64 + 16 * tb + fr] = p; }
    __syncthreads();
    {
        const f32x4 gw4 = *(const f32x4*)(F.gnw + 16 * w + 4 * fq);
        bf16_t* A2 = wsp<bf16_t>(F, WS_A2);
#pragma unroll
        for (int tb = 0; tb < 4; ++tb) { const int t = 16 * tb + fr; float ss = 0.f;
#pragma unroll
            for (int ww = 0; ww < 8; ++ww) ss += SSQ[ww * 64 + t];
            const float rs = rsqrtf(ss * (1.f / 128.f) + EPS);
            const u32x2 gv = R.gv[tb];
            const f32x4 o = acc[tb] * rs * gw4 * (f32x4){bflo(gv.x), bfhi(gv.x), bflo(gv.y), bfhi(gv.y)};
            u32x2 ov; ov.x = pk2(o[0], o[1]); ov.y = pk2(o[2], o[3]);
            *(GAS u32x2*)(A2 + (row0 + t) * D + h * 128 + 16 * w + 4 * fq) = ov; }
    }
    __syncthreads();
}
__device__ __forceinline__ void p2c_units(Frame& F, int c) {
    constexpr int NU = 2048;
    if (c >= NU) return;
    P2cRegs R; p2c_load(F, c, R);
    for (int u = c; u < NU; u += F.G) {
        P2cRegs N; const int un = u + F.G; if (un < NU) p2c_load(F, un, N); else N = R;
        p2c_compute(F, u, R);
        R = N;
    }
}

__device__ __forceinline__ void split8(const f32x4 a, const f32x4 b, bf16x8& hi, bf16x8& lo) {
    u32x4 h, l;
    h.x = cvt_pk_bf16(a[0], a[1]); h.y = cvt_pk_bf16(a[2], a[3]); h.z = cvt_pk_bf16(b[0], b[1]); h.w = cvt_pk_bf16(b[2], b[3]);
    l.x = cvt_pk_bf16(a[0] - bflo(h.x), a[1] - bfhi(h.x)); l.y = cvt_pk_bf16(a[2] - bflo(h.y), a[3] - bfhi(h.y)); l.z = cvt_pk_bf16(b[0] - bflo(h.z), b[1] - bfhi(h.z)); l.w = cvt_pk_bf16(b[2] - bflo(h.w), b[3] - bfhi(h.w));
    hi = __builtin_bit_cast(bf16x8, h); lo = __builtin_bit_cast(bf16x8, l);
}
__device__ __forceinline__ void p5_router(Frame& F) {
    const int fr = F.lane & 15, fq = F.lane >> 4, wq = F.wave & 3, kh = F.wave >> 2;
    LAS float* lg = (LAS float*)(F.lds + F.wave * 4096);
    LAS float* pa = (LAS float*)(F.lds + 32768) + (wq * 64 + F.lane) * 9;
    const bf16_t* DL = wsp<bf16_t>(F, WS_H1); unsigned char* H1B = wsp<unsigned char>(F, WS_H1B); const bf16_t* WH = wsp<bf16_t>(F, WS_WRH); const bf16_t* WL = wsp<bf16_t>(F, WS_WRL);
    for (int it = F.vcu * 4 + wq; it < M / 16; it += F.G * 4) {
        const int row0 = it * 16, kofs = 1024 * kh;
        const float* hp = F.x + (size_t)(row0 + fr) * D + kofs + 8 * fq; const bf16_t* dp_ = DL + (size_t)(row0 + fr) * D + kofs + 8 * fq; unsigned char* qp = H1B + (size_t)(row0 + fr) * D + kofs + 8 * fq;
        const bf16_t* wh0 = WH + (size_t)fr * D + kofs + 8 * fq; const bf16_t* wl0 = WL + (size_t)fr * D + kofs + 8 * fq;
        f32x4 a0 = (f32x4){0.f, 0.f, 0.f, 0.f}, a1 = a0; float ss = 0.f;
#pragma unroll 4
        for (int ks = 0; ks < 32; ++ks) {
            f32x4 xa = *(const GAS f32x4*)(hp + 32 * ks), xb = *(const GAS f32x4*)(hp + 32 * ks + 4); { f32x4 da, db; unpack8(*(const GAS u32x4*)(dp_ + 32 * ks), da, db); xa += da; xb += db; }
            *(GAS u32x2*)(qp + 32 * ks) = pack8_fp8(xa, xb);
            *(GAS u32x4*)((bf16_t*)dp_ + 32 * ks) = pack8(xa, xb);
            ss += (xa[0] * xa[0] + xa[1] * xa[1]) + (xa[2] * xa[2] + xa[3] * xa[3]) + (xb[0] * xb[0] + xb[1] * xb[1]) + (xb[2] * xb[2] + xb[3] * xb[3]);
            bf16x8 xh, xl; split8(xa, xb, xh, xl);
            const bf16x8 bh0 = *(const GAS bf16x8*)(wh0 + 32 * ks), bl0 = *(const GAS bf16x8*)(wl0 + 32 * ks), bh1 = *(const GAS bf16x8*)(wh0 + 16 * D + 32 * ks), bl1 = *(const GAS bf16x8*)(wl0 + 16 * D + 32 * ks);
            a0 = __builtin_amdgcn_mfma_f32_16x16x32_bf16(xh, bh0, a0, 0, 0, 0); a0 = __builtin_amdgcn_mfma_f32_16x16x32_bf16(xh, bl0, a0, 0, 0, 0);
            a0 = __builtin_amdgcn_mfma_f32_16x16x32_bf16(xl, bh0, a0, 0, 0, 0); a0 = __builtin_amdgcn_mfma_f32_16x16x32_bf16(xl, bl0, a0, 0, 0, 0);
            a1 = __builtin_amdgcn_mfma_f32_16x16x32_bf16(xh, bh1, a1, 0, 0, 0); a1 = __builtin_amdgcn_mfma_f32_16x16x32_bf16(xh, bl1, a1, 0, 0, 0);
            a1 = __builtin_amdgcn_mfma_f32_16x16x32_bf16(xl, bh1, a1, 0, 0, 0); a1 = __builtin_amdgcn_mfma_f32_16x16x32_bf16(xl, bl1, a1, 0, 0, 0);
        }
        if (kh == 1) {
#pragma unroll
            for (int r = 0; r < 4; ++r) { pa[r] = a0[r]; pa[4 + r] = a1[r]; }
            pa[8] = ss; }
        __syncthreads();
        if (kh == 0) {
#pragma unroll
            for (int r = 0; r < 4; ++r) { a0[r] += pa[r]; a1[r] += pa[4 + r]; }
            ss += pa[8];
            ss += __shfl_xor(ss, 16); ss += __shfl_xor(ss, 32);
#pragma unroll
            for (int r = 0; r < 4; ++r) { lg[(4 * fq + r) * 33 + fr] = a0[r]; lg[(4 * fq + r) * 33 + 16 + fr] = a1[r]; }
            LDS_WAIT(); asm volatile("" ::: "memory");
            if (F.lane < 16) {
                const int tokn = row0 + F.lane; const float rs = rsqrtf(ss * (1.f / D) + EPS);
                float v[32];
#pragma unroll
                for (int e = 0; e < 32; ++e) v[e] = lg[F.lane * 33 + e] * rs + F.b_r[e];
                int idx[4]; float val[4];
#pragma unroll
                for (int k = 0; k < 4; ++k) { float bv = -3.0e38f; int bi = 0;
#pragma unroll
                    for (int e = 0; e < 32; ++e) { const bool tk = v[e] > bv; bv = tk ? v[e] : bv; bi = tk ? e : bi; }
                    idx[k] = bi; val[k] = bv;
#pragma unroll
                    for (int e = 0; e < 32; ++e) v[e] = (e == bi) ? -3.0e38f : v[e]; }
                float ex[4], den = 0.f;
#pragma unroll
                for (int k = 0; k < 4; ++k) { ex[k] = __expf(val[k] - val[0]); den += ex[k]; }
                const float inv = 1.f / den;
                wsp<float>(F, WS_RS2)[tokn] = rs;
                int pos[4];
#pragma unroll
                for (int k = 0; k < 4; ++k) pos[k] = (int)__hip_atomic_fetch_add(F.ctl + CW_CNT + 64 * idx[k], 1u, __ATOMIC_RELAXED, __HIP_MEMORY_SCOPE_AGENT);
#pragma unroll
                for (int k = 0; k < 4; ++k) {
                    wsp<int>(F, WS_TOPE)[tokn * 4 + k] = idx[k]; wsp<int>(F, WS_TOPP)[tokn * 4 + k] = pos[k]; wsp<float>(F, WS_TOPW)[tokn * 4 + k] = ex[k] * inv;
                    wsp<int>(F, WS_LIST)[(size_t)idx[k] * CAPF + pos[k]] = tokn; }
            }
        }
        __syncthreads();
    }
}
__device__ __forceinline__ void build_pref(Frame& F) {
    if (F.wave == 0) {
        int tl = 0;
        if (F.lane < NE) { const unsigned c = __hip_atomic_load(F.ctl + CW_CNT + 64 * F.lane, RLX_AGENT); tl = (int)((c + 255u) >> 8); }
        int s = tl;
#pragma unroll
        for (int d = 1; d < 32; d <<= 1) { const int v = __shfl_up(s, d); if (F.lane >= d) s += v; }
        if (F.lane < NE) F.MISC[16 + F.lane] = (unsigned)(s - tl);
        if (F.lane == NE - 1) F.MISC[16 + NE] = (unsigned)(s < MAXRT ? s : MAXRT); }
    __syncthreads();
}
__device__ __forceinline__ void build_tok(Frame& F, const MoeOrder& S) {
    LAS int* tokt = (LAS int*)(F.lds + TOK_OFF); LAS bf16_t* bt = (LAS bf16_t*)(F.lds + BIAS_OFF);
    volatile LAS int* um = (volatile LAS int*)(F.MISC + 64);
    if (F.tid < 18) { Unit u; int base = -1, nv = 0, bo = 0;
        if (S.template next<false>(F.tid, u)) { const int rt = u.pm - (int)F.MISC[16 + u.e]; const int cnt = (int)__hip_atomic_load(F.ctl + CW_CNT + 64 * u.e, RLX_AGENT);
            base = u.e * CAPF + rt * 256; nv = cnt - rt * 256; nv = nv < 0 ? 0 : (nv > 256 ? 256 : nv); bo = u.e * 4096 + u.pn * 128; }
        um[4 * F.tid] = base; um[4 * F.tid + 1] = nv; um[4 * F.tid + 2] = bo; }
    __syncthreads();
    if (F.tid < 256) { int t[18]; float r[18]; const int* LIST = wsp<int>(F, WS_LIST); const float* RS2 = wsp<float>(F, WS_RS2);
#pragma unroll
        for (int i = 0; i < 18; ++i) { const int base = um[4 * i], nv = um[4 * i + 1]; t[i] = (base >= 0 && F.tid < nv) ? LIST[base + F.tid] : -1; }
#pragma unroll
        for (int i = 0; i < 18; ++i) r[i] = (t[i] >= 0) ? RS2[t[i]] * W8_INV : 0.f;
#pragma unroll
        for (int i = 0; i < 18; ++i) if (um[4 * i] >= 0) tokt[i * 256 + F.tid] = (int)((f2bf(r[i]) << 16) | (unsigned)(t[i] < 0 ? 0 : t[i])); }
    else {
        const int j = F.tid - 256, col = j < 128 ? j : 2048 + (j - 128); float bq[18];
#pragma unroll
        for (int i = 0; i < 18; ++i) bq[i] = (um[4 * i] >= 0) ? F.b_up[um[4 * i + 2] + col] : 0.f;
#pragma unroll
        for (int i = 0; i < 18; ++i) bt[i * 256 + j] = (bf16_t)f2bf(bq[i]); }
    __syncthreads();
}
__device__ __forceinline__ void build_bias_dn(Frame& F, const MoeOrder& S) {
    LAS float* bt = (LAS float*)(F.lds + TOK_OFF);
    volatile LAS int* um = (volatile LAS int*)(F.MISC + 64);
    if (F.tid < 9) { Unit u; int bo = -1; if (S.template next<false>(F.tid, u)) bo = u.e * D + u.pn * 256; um[F.tid] = bo; }
    __syncthreads();
    if (F.tid < 256) { float bq[9];
#pragma unroll
        for (int i = 0; i < 9; ++i) bq[i] = (um[i] >= 0) ? F.b_dn[um[i] + F.tid] : 0.f;
#pragma unroll
        for (int i = 0; i < 9; ++i) bt[i * 256 + F.tid] = bq[i]; }
    __syncthreads();
}
struct P9Tok { f32x4 v[8]; unsigned y[4][8]; f32x4 tw; };
template <int PM> __device__ __forceinline__ void p9_issue(const Frame& F, int m, P9Tok& T) {
    typedef int i32x4 __attribute__((ext_vector_type(4)));
    const bf16_t* DL = wsp<bf16_t>(F, WS_H1); const unsigned char* YR = wsp<unsigned char>(F, WS_YR);
    const i32x4 te = *(const GAS i32x4*)(wsp<int>(F, WS_TOPE) + m * 4), tp = *(const GAS i32x4*)(wsp<int>(F, WS_TOPP) + m * 4); T.tw = *(const GAS f32x4*)(wsp<float>(F, WS_TOPW) + m * 4);
#pragma unroll
    for (int j = 0; j < 8; ++j) { const u32x2 dw = (PM == 4) ? (u32x2){(unsigned)m, 0u} : *(const GAS u32x2*)(DL + (size_t)m * D + 4 * F.lane + 256 * j);
        T.v[j] = (f32x4){bflo(dw.x), bfhi(dw.x), bflo(dw.y), bfhi(dw.y)}; }
#pragma unroll
    for (int k = 0; k < 4; ++k) { const size_t row = (size_t)((const LAS unsigned*)F.MISC)[16 + te[k]] * 256 + tp[k];
#pragma unroll
        for (int j = 0; j < 8; ++j) T.y[k][j] = (PM == 1) ? (unsigned)row : *(const GAS unsigned*)(YR + row * D + 4 * F.lane + 256 * j); }
}
template <int PM> __device__ __forceinline__ void p9_finish(const Frame& F, int m, P9Tok& T, float* outp) {
#pragma unroll
    for (int k = 0; k < 4; ++k)
#pragma unroll
        for (int j = 0; j < 8; ++j) { const f32x2 p0 = __builtin_amdgcn_cvt_pk_f32_fp8((int)T.y[k][j], false), p1 = __builtin_amdgcn_cvt_pk_f32_fp8((int)T.y[k][j], true); T.v[j] += (f32x4){p0.x, p0.y, p1.x, p1.y} * T.tw[k]; }
    float s = 0.f;
#pragma unroll
    for (int j = 0; j < 8; ++j) s += (T.v[j][0] * T.v[j][0] + T.v[j][1] * T.v[j][1]) + (T.v[j][2] * T.v[j][2] + T.v[j][3] * T.v[j][3]);
    const float rs = rsqrtf(wave_sum(s) * (1.f / D) + EPS);
#pragma unroll
    for (int j = 0; j < 8; ++j) { const f32x4 w = *(const f32x4*)(F.fnw + 4 * F.lane + 256 * j); const f32x4 o = T.v[j] * rs * w;
        if (PM == 2) asm volatile("" :: "v"(o)); else *(GAS f32x4*)(outp + (size_t)m * D + 4 * F.lane + 256 * j) = o; }
}
template <int PM> __device__ __forceinline__ void p9_combine_t(Frame& F, float* outp) {
    const int gw = F.vcu * NWAVES + F.wave, NGW9 = F.G * NWAVES;
    for (int m = gw; m < M; m += 2 * NGW9) {
        const int m2 = m + NGW9; const bool two = m2 < M;
        P9Tok A, B; p9_issue<PM>(F, m, A); p9_issue<PM>(F, two ? m2 : m, B);
        __builtin_amdgcn_sched_barrier(0);
        p9_finish<PM>(F, m, A, outp); if (two) p9_finish<PM>(F, m2, B, outp);
    }
}
__device__ __forceinline__ void p9_combine(Frame& F) { p9_combine_t<0>(F, F.out); }
constexpr int NPH = 11;
struct Args { const float* in[18]; float* out; unsigned char* ws; int ph_lo, ph_hi; };

__global__ void __launch_bounds__(NTHR, 2) fwd_kernel(Args args) {
    extern __shared__ __attribute__((aligned(16))) unsigned char lds_raw[];
    Frame F;
    F.lds = (LAS unsigned char*)lds_raw; F.MISC = (volatile LAS unsigned*)(F.lds + MISC_OFF);
    F.wave = __builtin_amdgcn_readfirstlane((int)threadIdx.x >> 6);
#define REFRESH() do { F.lane = lane_id(); F.tid = F.wave * 64 + F.lane; } while (0)
    REFRESH();
    F.G = gridDim.x; { const int bx = blockIdx.x; F.vcu = (F.G % 8 == 0) ? (bx % 8) * (F.G / 8) + bx / 8 : bx; }
    F.ws = args.ws; F.ctl = (gu32*)(args.ws + WS_CTL); F.out = args.out;
    F.x = args.in[0]; F.meta = args.in[1]; F.nmw = args.in[2]; F.w_in = args.in[3]; F.lbl = args.in[4]; F.gnw = args.in[5]; F.w_ho = args.in[6]; F.cw = args.in[7]; F.w_co = args.in[8]; F.w_o = args.in[9];
    F.nfw = args.in[10]; F.w_r = args.in[11]; F.b_r = args.in[12]; F.w_up = args.in[13]; F.b_up = args.in[14]; F.w_dn = args.in[15]; F.b_dn = args.in[16]; F.fnw = args.in[17];
    for (int u = F.tid; u < 256; u += NTHR) F.MISC[u] = 0u;
    __syncthreads();
    const int lo = args.ph_lo, hi = args.ph_hi;
    const bool multi = (hi - lo) > 1;
    XcdBarrier bar; bar.bar = (unsigned*)(F.ctl + CW_BAR); bar.x = 0; bar.st = nullptr;
    if (multi) bar = xcd_barrier_post((unsigned*)(F.ctl + CW_BAR), F.MISC, F.tid);
#define IN(k) (lo <= (k) && (k) < hi)
#if defined(FK_STAMP_A)
#define STAMP(k) do { if (blockIdx.x == 0 && F.tid == 0) __hip_atomic_store(F.ctl + CW_TS + (k), (unsigned)__builtin_amdgcn_s_memrealtime(), RLX_AGENT); } while (0)
#else
#define STAMP(k) do { } while (0)
#endif
#if defined(FK_PROBE_BAR)
#define SEAM(k) do { REFRESH(); if (IN(k) && IN((k) + 1)) { xcd_barrier(bar, F.tid); xcd_barrier(bar, F.tid); xcd_barrier(bar, F.tid); } STAMP((k) + 1); } while (0)
#else
#define SEAM(k) do { REFRESH(); if (IN(k) && IN((k) + 1)) xcd_barrier(bar, F.tid); STAMP((k) + 1); } while (0)
#endif
    STAMP(0);
    const int c = blockIdx.x;
#ifndef FK_DUP_MASK
#define FK_DUP_MASK 0
#endif
#ifndef FK_DUP_REPS
#define FK_DUP_REPS 1
#endif
#define DUP(k) for (int _rep = 0; _rep < 1 + FK_DUP_REPS * ((FK_DUP_MASK >> (k)) & 1); ++_rep)
#define REDO(k) do { if (((FK_DUP_MASK >> (k)) & 1) && _rep < FK_DUP_REPS) { REFRESH(); xcd_barrier(bar, F.tid); } } while (0)

    if (IN(0)) DUP(0) { p0_prologue(F); REDO(0); } SEAM(0);

    if (IN(1)) DUP(1) {
        constexpr int NCONV_PER8 = 3;
        const int cq = c >> 3; const bool conv = (F.G % 64 == 0) && ((cq & 7) < NCONV_PER8) && (_rep == 0);
        if (F.G % 64 != 0 && _rep == 0) { if (c == 0) p1_convert(F, 0, 1); }
        if (conv) { const int nconv = (F.G / 64) * 8 * NCONV_PER8, rank = ((cq >> 3) * NCONV_PER8 + (cq & 7)) * 8 + (c & 7); p1_convert(F, rank, nconv);
#if defined(FK_PROBE_CONV2)
            __syncthreads(); p1_convert<FK_PROBE_CONV2 - 1>(F, rank, nconv);
#endif
        }
        __syncthreads();
        EpiInproj E{wsp<float>(F, WS_RS1), wsp<float>(F, WS_LB), wsp<bf16_t>(F, WS_QS), wsp<bf16_t>(F, WS_VV), wsp<bf16_t>(F, WS_GS), wsp<bf16_t>(F, WS_UU), wsp<bf16_t>(F, WS_SB), wsp<bf16_t>(F, WS_RT), wsp<bf16_t>(F, WS_GBS), wsp<h16_t>(F, WS_LF), 1.f};
        if (N_INB > 0) {
            GemmDesc g{wsp<bf16_t>(F, WS_XB), wsp<bf16_t>(F, WS_WIN), D, INC / 256};
            DynOrder S; S.init(M, INB_MASK, N_INB, c, (unsigned*)(F.ctl + CW_Q + 64 * (c & 7) + 8 * _rep), F.MISC + 4, F.tid);
            gemm_phase<EpiInproj, DynOrder, false, true, false>(F.lds, g, S, E, nullptr, F.wave); }
        if (N_IN8 > 0) {
            REFRESH(); E.osc = 1.f / W8_SCALE;
            GemmDesc g{(const bf16_t*)wsp<unsigned char>(F, WS_XB8), (const bf16_t*)wsp<unsigned char>(F, WS_WIN8), D, INC / 256};
            DynOrder S; S.init(M, IN8_MASK, N_IN8, c, (unsigned*)(F.ctl + CW_Q + 64 * (c & 7) + 8 * _rep + 4), F.MISC + 6, F.tid);
            gemm_phase<EpiInproj, DynOrder, false, true, true>(F.lds, g, S, E, nullptr, F.wave); }
        REDO(1);
    } SEAM(1);

#if defined(FK_PROBE_GEMM)
    if (IN(1)) {
        GemmDesc g{wsp<bf16_t>(F, WS_XB), wsp<bf16_t>(F, WS_WIN), D, INC / 256}; ProbeOrder S; S.S.init(M, INC, F.G, c); S.mode = FK_PROBE_GEMM & 3; S.c = c;
        EpiDummy E{wsp<bf16_t>(F, WS_ACT), (FK_PROBE_GEMM >> 2) & 1};
        gemm_phase<EpiDummy, ProbeOrder, false, true, false>(F.lds, g, S, E, nullptr, F.wave);
        REFRESH(); xcd_barrier(bar, F.tid);
    }
#endif
    if (IN(2)) DUP(2) { p2a_units(F, c); for (int it = c; it < M / 64; it += F.G) p2a_conv(F, it); REDO(2); } SEAM(2);
    if (IN(3)) DUP(3) { p2b_scan(F); REDO(3); } SEAM(3);
    if (IN(4)) DUP(4) { p2c_units(F, c); REDO(4); } SEAM(4);

    if (IN(5)) DUP(5) {
        GemmDesc g{wsp<bf16_t>(F, WS_A2), wsp<bf16_t>(F, WS_WAB), D, D / 256}; StaticOrder S; S.init(M, D, F.G, c);
        EpiMerge E{wsp<bf16_t>(F, WS_RT), wsp<bf16_t>(F, WS_GBS), wsp<bf16_t>(F, WS_MG)};
        gemm_phase<EpiMerge, StaticOrder, false, true, false>(F.lds, g, S, E, nullptr, F.wave); REDO(5);
    } SEAM(5);

    if (IN(6)) DUP(6) {
        GemmDesc g{wsp<bf16_t>(F, WS_MG), wsp<bf16_t>(F, WS_WO), D, D / 256}; StaticOrder S; S.init(M, D, F.G, c);
        EpiWo E{wsp<bf16_t>(F, WS_H1)};
        gemm_phase<EpiWo, StaticOrder, false, true, false>(F.lds, g, S, E, nullptr, F.wave); REDO(6);
    } SEAM(6);

    if (IN(7)) { p5_router(F); } SEAM(7);

    if (IN(8)) DUP(8) {
        build_pref(F);
        MoeOrder S; S.init(16, F.G, c, (const volatile LAS int*)(F.MISC + 16));
        build_tok(F, S);
        GemmDesc g{wsp<bf16_t>(F, WS_H1B), wsp<bf16_t>(F, WS_WUP), D, 16};
        EpiUp E{wsp<float>(F, WS_RS2), (const LAS int*)(F.lds + TOK_OFF), (const LAS bf16_t*)(F.lds + BIAS_OFF), wsp<unsigned char>(F, WS_ACT)};
        gemm_phase<EpiUp, MoeOrder, true, true, true>(F.lds, g, S, E, (const LAS int*)(F.lds + TOK_OFF), F.wave); REDO(8);
    } SEAM(8);

    if (IN(9)) DUP(9) {
        build_pref(F);
        MoeOrder S; S.init(8, F.G, c, (const volatile LAS int*)(F.MISC + 16));
        GemmDesc g{wsp<bf16_t>(F, WS_ACT), wsp<bf16_t>(F, WS_WDN), DFF, 8};
        build_bias_dn(F, S);
        EpiDown E{(const LAS float*)(F.lds + TOK_OFF), wsp<unsigned char>(F, WS_YR)};
        gemm_phase<EpiDown, MoeOrder, false, true, true>(F.lds, g, S, E, nullptr, F.wave); REDO(9);
    } SEAM(9);

#if defined(FK_PROBE_P8)
    if (IN(10)) {
        build_pref(F);
        ProbeMoe S; S.S.init(8, F.G, c, (const volatile LAS int*)(F.MISC + 16)); S.mode = FK_PROBE_P8 & 3;
        GemmDesc g{wsp<bf16_t>(F, WS_ACT), wsp<bf16_t>(F, WS_WDN), DFF, 8};
        EpiDummy E{wsp<bf16_t>(F, WS_XB), 1};
        for (int r = 0; r < 2; ++r) { gemm_phase<EpiDummy, ProbeMoe, false, true, true>(F.lds, g, S, E, nullptr, F.wave); REFRESH(); xcd_barrier(bar, F.tid); }
    }
#endif
    if (IN(10)) DUP(10) { build_pref(F); p9_combine(F); REDO(10); }
#if defined(FK_PROBE_P9)
    if (IN(10)) { for (int r = 0; r < 4; ++r) { REFRESH(); xcd_barrier(bar, F.tid); p9_combine_t<FK_PROBE_P9 - 1>(F, wsp<float>(F, WS_XB)); } }
#endif
#undef IN
#undef DUP
#undef REDO
#undef SEAM
#undef STAMP
#undef REFRESH
}

inline void launch_fast(hipStream_t stream, void* const* d_in, float* out, unsigned char* ws, int n_launches) {
    static int grid = 0;
    if (grid == 0) {
        int dev = 0, cus = 0, per_cu = 0;
        if (hipGetDevice(&dev) != hipSuccess || hipDeviceGetAttribute(&cus, hipDeviceAttributeMultiprocessorCount, dev) != hipSuccess) { fprintf(stderr, "kernel_launch: device query failed\n"); grid = -1; return; }
        if (hipFuncSetAttribute((const void*)fwd_kernel, hipFuncAttributeMaxDynamicSharedMemorySize, LDS_BYTES) != hipSuccess) { fprintf(stderr, "kernel_launch: hipFuncSetAttribute failed\n"); grid = -1; return; }
        if (hipOccupancyMaxActiveBlocksPerMultiprocessor(&per_cu, (const void*)fwd_kernel, NTHR, LDS_BYTES) != hipSuccess || per_cu < 1) fprintf(stderr, "kernel_launch: note: occupancy query says %d blocks per CU\n", per_cu);
        (void)hipGetLastError();
        grid = cus;
    }
    if (grid < 0) return;
    (void)hipMemsetAsync(ws + WS_CTL, 0, CTL_BYTES, stream);
    Args a{};
    for (int i = 0; i < 18; ++i) a.in[i] = (const float*)d_in[i];
    a.out = out; a.ws = ws;
    for (int li = 0; li < n_launches; ++li) {
        a.ph_lo = (n_launches == 1) ? 0 : li; a.ph_hi = (n_launches == 1) ? NPH : li + 1;
        hipLaunchKernelGGL(fwd_kernel, dim3(grid), dim3(NTHR), LDS_BYTES, stream, a);
        const hipError_t le = hipPeekAtLastError();
        if (le != hipSuccess) { fprintf(stderr, "kernel_launch: launch %d failed: %s\n", li, hipGetErrorName(le)); break; }
    }
}
}
#ifndef FK_LAUNCHES
#define FK_LAUNCHES 1
#endif
extern "C" void kernel_launch(void* const* d_in, const int* in_sizes, int n_in, void* d_out, int out_size, void* d_ws, size_t ws_size, hipStream_t stream) {
    if (n_in != 18 || ws_size < fk::WS_FAST_END) { fprintf(stderr, "kernel_launch: n_in %d, ws %zu < %zu\n", n_in, ws_size, (size_t)fk::WS_FAST_END); return; }
    fk::launch_fast(stream, d_in, (float*)d_out, (unsigned char*)d_ws, FK_LAUNCHES);
}
```

```cpp
#include <hip/hip_runtime.h>
#include <cstdio>
#define FK_LAUNCHES 1
#define FK_IN8_MASK 0xFFFF000F0FFull
#define FK_WO8 0
namespace fk {
#define LAS __attribute__((address_space(3)))
#define GAS __attribute__((address_space(1)))
typedef unsigned short bf16_t;
typedef short bf16x8 __attribute__((ext_vector_type(8)));
typedef float f32x4 __attribute__((ext_vector_type(4)));
typedef float f32x2 __attribute__((ext_vector_type(2)));
typedef unsigned u32x4 __attribute__((ext_vector_type(4)));
typedef unsigned u32x2 __attribute__((ext_vector_type(2)));
typedef GAS unsigned gu32;
typedef _Float16 h16_t;
typedef _Float16 h16x4 __attribute__((ext_vector_type(4)));
typedef _Float16 h16x2 __attribute__((ext_vector_type(2)));
#define RLX_AGENT __ATOMIC_RELAXED, __HIP_MEMORY_SCOPE_AGENT
#define LDS_WAIT() asm volatile("s_waitcnt lgkmcnt(0)" ::: "memory")
#define VM_WAIT() asm volatile("s_waitcnt vmcnt(0)" ::: "memory")

constexpr int D = 2048, NB = 4, SEQ = 4096, M = NB * SEQ, NMETA = 16;
constexpr int HF = 1024, INC = 11264, NE = 32, DFF = 2048, NCH = SEQ / 64;
constexpr int C_Q = 0, C_F = 1024, C_V = 2048, C_G = 3072, C_SV = 4096, C_SB = 5120, C_SC = 6144, C_GA = 7168, C_GB = 9216;
constexpr float EPS = 1e-6f;
constexpr int CAPF = M;
constexpr int MAXRT = 288;
constexpr int NWAVES = 8, NTHR = 512;

constexpr size_t al(size_t x) { return (x + 0xFFFFF) & ~(size_t)0xFFFFF; }
constexpr size_t WS_CTL = 0, CTL_BYTES = 65536;
constexpr size_t WS_LB = 65536, WS_RS1 = WS_LB + 4096, WS_RS2 = WS_RS1 + 65536, WS_WRH = WS_RS2 + 65536, WS_WRL = WS_WRH + 131072;
constexpr size_t WS_LFM = WS_WRL + 131072, WS_VVM = WS_LFM + 64 * 1024 * 4, WS_UUM = WS_VVM + 64 * 1024 * 2, WS_SMALL_END = WS_UUM + 16 * 1024 * 2;
constexpr size_t WS_TOPE = al(WS_SMALL_END), WS_TOPP = WS_TOPE + (size_t)M * 16, WS_TOPW = WS_TOPP + (size_t)M * 16, WS_LIST = WS_TOPW + (size_t)M * 16;
constexpr size_t WS_DEC = al(WS_LIST + (size_t)NE * CAPF * 4);
constexpr size_t WS_WIN = al(WS_DEC + (size_t)33 * 64 * 128 * 4);
constexpr size_t WS_WAB = al(WS_WIN + (size_t)INC * D * 2);
constexpr size_t WS_WO = al(WS_WAB + (size_t)D * D * 2);
constexpr size_t WS_WUP = al(WS_WO + (size_t)D * D * 2);
constexpr size_t WS_WDN = al(WS_WUP + (size_t)NE * 4096 * D);
constexpr size_t WS_XB = al(WS_WDN + (size_t)NE * D * DFF);
constexpr size_t WS_QS = al(WS_XB + (size_t)M * D * 2);
constexpr size_t WS_LF = al(WS_QS + (size_t)M * HF * 2);
constexpr size_t WS_VV = al(WS_LF + (size_t)M * HF * 2);
constexpr size_t WS_GS = al(WS_VV + (size_t)M * HF * 2);
constexpr size_t WS_UU = al(WS_GS + (size_t)M * HF * 2);
constexpr size_t WS_SB = al(WS_UU + (size_t)M * HF * 2);
constexpr size_t WS_RT = al(WS_SB + (size_t)M * HF * 2);
constexpr size_t WS_GBS = al(WS_RT + (size_t)M * D * 2);
constexpr size_t WS_UC = al(WS_GBS + (size_t)M * D * 2);
constexpr size_t WS_SS = al(WS_UC + (size_t)(32 * 64 + 8) * 16384 * 2);
constexpr size_t WS_A2 = al(WS_SS + (size_t)32 * 64 * 16384 * 2);
constexpr size_t WS_MG = al(WS_A2 + (size_t)M * D * 2);
constexpr size_t WS_H1 = al(WS_MG + (size_t)M * D * 2);
constexpr size_t WS_H1B = al(WS_H1 + (size_t)M * D * 2);
constexpr size_t WS_ACT = al(WS_H1B + (size_t)M * D);
constexpr size_t WS_YR = al(WS_ACT + (size_t)MAXRT * 256 * DFF);
constexpr size_t WS_WIN8 = al(WS_YR + (size_t)MAXRT * 256 * D);
constexpr size_t WS_XB8 = al(WS_WIN8 + (size_t)INC * D);
constexpr size_t WS_FAST_END = al(WS_XB8 + (size_t)M * D);
#ifndef FK_IN8_MASK
#define FK_IN8_MASK 0xFFFF00000F0ull
#endif
constexpr unsigned long long IN8_MASK = FK_IN8_MASK;
constexpr unsigned long long INB_MASK = ((1ull << 44) - 1) & ~IN8_MASK;
constexpr int cpop(unsigned long long m) { int n = 0; while (m) { m &= m - 1; ++n; } return n; }
constexpr int N_IN8 = cpop(IN8_MASK), N_INB = 44 - N_IN8;
__device__ __forceinline__ int nth_bit(unsigned long long m, int n) { for (int i = 0; i < n; ++i) m &= m - 1; return __builtin_ctzll(m); }
constexpr int CW_TMO = 0;
constexpr int CW_CNT = 1024;
constexpr int CW_Q = 3400;
constexpr int CW_TS = 3200;
constexpr int CW_BAR = 4096;
constexpr int RING_BYTES = 131072;
constexpr int TOK_OFF = RING_BYTES, TOK_BYTES = 18 * 1024;
constexpr int MISC_OFF = TOK_OFF + TOK_BYTES;
constexpr int BIAS_OFF = MISC_OFF + 1024, BIAS_BYTES = 18 * 512;
constexpr int LDS_BYTES = BIAS_OFF + BIAS_BYTES;
static_assert(LDS_BYTES <= 160 * 1024, "LDS");

__device__ __forceinline__ float sigmoidf_(float x) { return 1.f / (1.f + __expf(-x)); }
__device__ __forceinline__ unsigned f2bf(float f) { unsigned u = __builtin_bit_cast(unsigned, f); return (u + 0x7fffu + ((u >> 16) & 1u)) >> 16; }
__device__ __forceinline__ unsigned pk2(float lo, float hi) { return f2bf(lo) | (f2bf(hi) << 16); }
__device__ __forceinline__ float bf2f(unsigned short b) { return __builtin_bit_cast(float, ((unsigned)b) << 16); }
__device__ __forceinline__ float bflo(unsigned w) { return __builtin_bit_cast(float, w << 16); }
__device__ __forceinline__ float bfhi(unsigned w) { return __builtin_bit_cast(float, w & 0xffff0000u); }
__device__ __forceinline__ unsigned cvt_pk_bf16(float lo, float hi) { unsigned r; asm volatile("v_cvt_pk_bf16_f32 %0, %1, %2" : "=v"(r) : "v"(lo), "v"(hi)); return r; }
__device__ __forceinline__ unsigned pk4_fp8(float a, float b, float c, float d) { int w = 0; w = __builtin_amdgcn_cvt_pk_fp8_f32(a, b, w, false); w = __builtin_amdgcn_cvt_pk_fp8_f32(c, d, w, true); return (unsigned)w; }
constexpr float W8_SCALE = 64.f, W8_INV = 1.f / 64.f;
__device__ __forceinline__ int lane_id() { int l; asm volatile("v_mbcnt_lo_u32_b32 %0, -1, 0\n\tv_mbcnt_hi_u32_b32 %0, -1, %0" : "=v"(l)); return l; }
__device__ __forceinline__ float wave_sum(float v) {
#pragma unroll
    for (int o = 1; o < 64; o <<= 1) v += __shfl_xor(v, o);
    return v;
}

#define XB_TMO      128
#define XB_XCNT(j)  (256  + 64 * (j))
#define XB_XSUB(j)  (1280 + 64 * (j))
#define XB_XGEN(j)  (2304 + 64 * (j))
#define XB_TOP      3328
#define XB_TOPGEN   3392
#define XCD_BAR_WORDS 3456
#define XB_SPIN_CAP (1u << 18)
__device__ __forceinline__ unsigned xb_ld(unsigned* p)              { return __hip_atomic_load(p, __ATOMIC_RELAXED, __HIP_MEMORY_SCOPE_AGENT); }
__device__ __forceinline__ unsigned xb_add(unsigned* p, unsigned v) { return __hip_atomic_fetch_add(p, v, __ATOMIC_RELAXED, __HIP_MEMORY_SCOPE_AGENT); }
__device__ __forceinline__ unsigned xb_xcc_id() { return (unsigned)__builtin_amdgcn_s_getreg((3 << 11) | 20) & 0xFu; }
#define XB_SPIN(cond, bar) do { unsigned _sp = 0; while (cond) { __builtin_amdgcn_s_sleep(1); \
    if ((++_sp & 255u) == 0u) { if (xb_ld(&(bar)[XB_TMO])) break; if (_sp > XB_SPIN_CAP) { atomicAdd(&(bar)[XB_TMO], 1u); break; } } } } while (0)
struct XcdBarrier { unsigned* bar; unsigned x; volatile LAS unsigned* st; };
__device__ __forceinline__ XcdBarrier xcd_barrier_post(unsigned* bar, volatile LAS unsigned* st, int tid) {
    XcdBarrier b; b.bar = bar; b.x = xb_xcc_id(); b.st = st;
    if (tid == 0) (void)xb_add(&bar[XB_XCNT(b.x)], 1u);
    return b;
}
__device__ __forceinline__ void xcd_barrier_complete(unsigned* bar, unsigned x, unsigned& nloc, unsigned& nx) {
    const unsigned G = gridDim.x * gridDim.y * gridDim.z;
    unsigned sum, cnt, mine, sp = 0u;
    for (;;) {
        sum = 0u; cnt = 0u; mine = 0u;
#pragma unroll
        for (unsigned j = 0; j < 16; ++j) { const unsigned c = xb_ld(&bar[XB_XCNT(j)]); sum += c; cnt += (c > 0u) ? 1u : 0u; mine = (j == x) ? c : mine; }
        if (sum == G) break;
        __builtin_amdgcn_s_sleep(1);
        if ((++sp & 255u) == 0u) { if (xb_ld(&bar[XB_TMO])) break; if (sp > XB_SPIN_CAP) { atomicAdd(&bar[XB_TMO], 1u); break; } }
    }
    nloc = mine > 0u ? mine : 1u; nx = cnt > 0u ? cnt : 1u;
}
__device__ __forceinline__ void xcd_barrier(const XcdBarrier& b, int tid) {
    asm volatile("s_waitcnt vmcnt(0)" ::: "memory");
    __syncthreads();
    if (tid == 0) {
        unsigned* bar = b.bar;
        __builtin_amdgcn_s_waitcnt(0);
        unsigned nloc = b.st[0], nx = b.st[1];
        if (nloc == 0u) { xcd_barrier_complete(bar, b.x, nloc, nx); b.st[0] = nloc; b.st[1] = nx; }
        const unsigned old = xb_add(&bar[XB_XSUB(b.x)], 1u);
        const unsigned gen = old / nloc;
        if (old + 1u == (gen + 1u) * nloc) {
            __builtin_amdgcn_fence(__ATOMIC_RELEASE, "agent");
            asm volatile("s_waitcnt vmcnt(0)" ::: "memory");
            const unsigned og = xb_add(&bar[XB_TOP], 1u);
            const unsigned tg = og / nx;
            if (og + 1u == (tg + 1u) * nx) xb_add(&bar[XB_TOPGEN], 1u);
            else XB_SPIN(xb_ld(&bar[XB_TOPGEN]) == tg, bar);
            __builtin_amdgcn_fence(__ATOMIC_ACQUIRE, "agent");
            xb_add(&bar[XB_XGEN(b.x)], 1u);
            asm volatile("s_waitcnt vmcnt(0)" ::: "memory");
        } else {
            XB_SPIN(xb_ld(&bar[XB_XGEN(b.x)]) == gen, bar);
            __builtin_amdgcn_fence(__ATOMIC_ACQUIRE, "agent");
            asm volatile("s_waitcnt vmcnt(0)" ::: "memory");
        }
    }
    __syncthreads();
}

constexpr int BM = 256, BK = 64, HALF = 128, HTB = HALF * BK * 2, NXCD = 8, WGM = 8;
__host__ __device__ __forceinline__ int lds_byte(int r, int c) { const int st = (r >> 4) * 2 + (c >> 5), rr = r & 15, cc = c & 31, ob = rr * 64 + cc * 2; return st * 1024 + (ob ^ (((ob >> 9) & 1) << 5)); }
__host__ __device__ __forceinline__ void stage_rc(int b, int& R, int& C) { const int st = b / 1024, sb = b % 1024, swz = sb ^ (((sb >> 9) & 1) << 5); R = (st >> 1) * 16 + swz / 64; C = (st & 1) * 32 + (swz % 64) / 2; }
__host__ __device__ __forceinline__ int perm32(int rho) { const int n = rho >> 4, i = rho & 15; return 8 * (i >> 2) + 4 * n + (i & 3); }

typedef int i32x8 __attribute__((ext_vector_type(8)));
typedef int i32x4v __attribute__((ext_vector_type(4)));
__device__ __forceinline__ i32x8 cat8(const bf16x8 a, const bf16x8 b) { const i32x4v x = __builtin_bit_cast(i32x4v, a), y = __builtin_bit_cast(i32x4v, b); return __builtin_shufflevector(x, y, 0, 1, 2, 3, 4, 5, 6, 7); }
__device__ __forceinline__ void mfma8(f32x4& acc, const i32x8 a, const i32x8 b, const int sc) {
    asm volatile("s_nop 1\n\tv_mfma_scale_f32_16x16x128_f8f6f4 %0, %1, %2, %0, %3, %3 op_sel_hi:[0,0,0]" : "+v"(acc) : "v"(a), "v"(b), "v"(sc));
}
struct Unit { int pm, pn, e, ui; };

struct StaticOrder {
    int nM, nN, nwg, G, c;
    __device__ void init(int M_, int N_, int G_, int c_) { nM = M_ / BM; nN = N_ / BM; nwg = nM * nN; G = G_; c = c_; }
    __device__ __forceinline__ bool next(int i, Unit& u) const {
        const long L = (long)i * G + c; if (L >= nwg) return false;
        int wgid = (int)L; { const int q = nwg / NXCD, r = nwg % NXCD, xcd = wgid % NXCD, off = wgid / NXCD; wgid = (xcd < r ? xcd * (q + 1) : r * (q + 1) + (xcd - r) * q) + off; }
        const int nig = WGM * nN, gid = wgid / nig, fm = gid * WGM, gsz = (nM - fm) < WGM ? (nM - fm) : WGM;
        u.pm = fm + ((wgid % nig) % gsz); u.pn = (wgid % nig) / gsz; u.e = 0; u.ui = i; return true;
    }
};
struct DynOrder {
    int nM, nN, nwg, x; unsigned* head; volatile LAS unsigned* slot; int tid; unsigned long long mask;
    __device__ void init(int M_, unsigned long long mask_, int nN_, int c_, unsigned* head_, volatile LAS unsigned* slot_, int tid_) { nM = M_ / BM; nN = nN_; mask = mask_; nwg = nM * nN; x = c_ & 7; head = head_; slot = slot_; tid = tid_; }
    __device__ __forceinline__ bool next(int i, Unit& u) const {
        if (tid == 0) slot[i & 1] = __hip_atomic_fetch_add(head, 1u, __ATOMIC_RELAXED, __HIP_MEMORY_SCOPE_AGENT);
        asm volatile("s_waitcnt lgkmcnt(0)" ::: "memory"); __builtin_amdgcn_s_barrier(); asm volatile("" ::: "memory");
        const int j = (int)slot[i & 1], q = nwg / NXCD;
        if (j >= q) return false;
        const int wgid = x * q + j;
        const int nig = WGM * nN, gid = wgid / nig, fm = gid * WGM, gsz = (nM - fm) < WGM ? (nM - fm) : WGM;
        u.pm = fm + ((wgid % nig) % gsz); u.pn = nth_bit(mask, (wgid % nig) / gsz); u.e = 0; u.ui = i; return true;
    }
};
struct MoeOrder {
    int nct, NT, G, c; const volatile LAS int* pref;
    __device__ void init(int nct_, int G_, int c_, const volatile LAS int* pref_) { nct = nct_; G = G_; c = c_; pref = pref_; NT = pref_[NE]; }
    template <bool UNIFORM = true> __device__ __forceinline__ bool next(int i, Unit& u) const {
        int rtg, pn;
        if (G == 256) { const int x = c & 7, jj = c >> 3;
            if (nct == 16) { rtg = 16 * i + 8 * (x & 1) + (jj & 7); pn = 4 * (x >> 1) + (jj >> 3); }
            else           { rtg = 32 * i + 8 * (x & 3) + (jj & 7); pn = 4 * (x >> 2) + (jj >> 3); } }
        else { const int U = i * G + c; rtg = U / nct; pn = U - rtg * nct; }
        if (rtg >= NT) return false;
        u.pn = pn; u.pm = rtg; u.ui = i;
        int e = 0;
        if constexpr (UNIFORM) { const int l = lane_id(); const int pv = (l >= 1 && l < NE) ? pref[l] : 0x7fffffff; e = (int)__builtin_popcountll(__ballot(pv <= rtg)); }
        else {
#pragma unroll 1
            for (int j = 1; j < NE; ++j) e = (pref[j] <= rtg) ? j : e; }
        u.e = e; return true;
    }
};

struct GemmDesc { const bf16_t* A; const bf16_t* Bt; int K; int nct; };

template <class Epi, class Sched, bool GATHER, bool ALIGN_EPI, bool FP8>
__device__ __forceinline__ void gemm_phase(LAS unsigned char* lds, const GemmDesc g, const Sched& S, const Epi& E, const LAS int* tok, int wid) {
    const int lane = lane_id(), tid = wid * 64 + lane, wr = wid >> 2, wc = wid & 3, fr = lane & 15, fq = lane >> 4;
    const int K = g.K, KB = FP8 ? K : 2 * K  , nt = FP8 ? K / 128 : K / BK;
    int Rl[2], Cl[2];
    unsigned voffA[2], voffB[2];
#pragma unroll
    for (int i = 0; i < 2; ++i) { int Cc; stage_rc(tid * 16 + i * 8192, Rl[i], Cc); const int p = Cc >> 3; Cl[i] = FP8 ? 16 * (2 * (p & 3) + (p >> 2)) : 2 * Cc; voffA[i] = (unsigned)(Rl[i] * KB + Cl[i]); voffB[i] = voffA[i]; }
    const size_t kstep = (size_t)(BK * 2);
    const size_t hstep = (size_t)HALF * KB;
    const size_t tstep = 2 * hstep;
    const unsigned ldsw = (unsigned)wid * 1024u;
    const int aoff = lds_byte(wr * 64 + fr, fq * 8), boff = lds_byte(wc * 32 + fr, fq * 8);
#define PG8_SA(b, h) (((b) * 2 + (h)) * HTB)
#define PG8_SB(b, h) ((4 + (b) * 2 + (h)) * HTB)
#define PG8_STAGE(bufoff, gbase, voff) do { _Pragma("unroll") for (int _i = 0; _i < 2; ++_i) \
        __builtin_amdgcn_global_load_lds((const unsigned*)((const char*)(gbase) + (voff)[_i]), (LAS unsigned*)(lds + (bufoff) + ldsw + _i * 8192), 16, 0, 0); } while (0)
#define PG8_STAGE_A(bufoff, ptr, half, o0, o1) do { if constexpr (GATHER) { PG8_STAGE(bufoff, ptr, (half) ? o1 : o0); } else { PG8_STAGE(bufoff, (ptr) + (half) * hstep, voffA); } } while (0)
#define PG8_LDA(dst, b, h) do { _Pragma("unroll") for (int m = 0; m < 4; ++m) _Pragma("unroll") for (int k = 0; k < 2; ++k) dst[m][k] = *(const LAS bf16x8*)(lds + PG8_SA(b, h) + aoff + m * 2048 + k * 1024); } while (0)
#define PG8_LDB(dst, b, h) do { _Pragma("unroll") for (int n = 0; n < 2; ++n) _Pragma("unroll") for (int k = 0; k < 2; ++k) dst[n][k] = *(const LAS bf16x8*)(lds + PG8_SB(b, h) + boff + n * 2048 + k * 1024); } while (0)
#define PG8_MMA(ai, bj, At, Bt) do { __builtin_amdgcn_s_setprio(1); _Pragma("unroll") for (int m = 0; m < 4; ++m) _Pragma("unroll") for (int n = 0; n < 2; ++n) _Pragma("unroll") for (int k = 0; k < 2; ++k) \
        acc[ai][bj][m][n] = __builtin_amdgcn_mfma_f32_16x16x32_bf16(Bt[n][k], At[m][k], acc[ai][bj][m][n], 0, 0, 0); __builtin_amdgcn_s_setprio(0); } while (0)
#define PG8_MMA8(ai, bj, At, Bt) do { __builtin_amdgcn_s_setprio(1); _Pragma("unroll") for (int m = 0; m < 4; ++m) _Pragma("unroll") for (int n = 0; n < 2; ++n) \
        mfma8(acc[ai][bj][m][n], cat8(Bt[n][0], Bt[n][1]), cat8(At[m][0], At[m][1]), sc8); __builtin_amdgcn_s_setprio(0); } while (0)
#define PG8_MM(ai, bj, At, Bt) do { if constexpr (FP8) PG8_MMA8(ai, bj, At, Bt); else PG8_MMA(ai, bj, At, Bt); } while (0)
#define PG8_WAIT_V(n) asm volatile("s_waitcnt vmcnt(" #n ")" ::: "memory")
#define PG8_WAIT_L(n) asm volatile("s_waitcnt lgkmcnt(" #n ")" ::: "memory")
#define PG8_BAR __builtin_amdgcn_s_barrier()
#define PG8_SCHED __builtin_amdgcn_sched_barrier(0)
    Unit cur, nxt; int ui = 0;
    if (!S.next(0, cur)) return;
    const int sc8 = 0x7F7F7F7F;
    f32x4 acc[2][2][4][2];
#pragma unroll
    for (int a = 0; a < 2; ++a)
#pragma unroll
        for (int b = 0; b < 2; ++b)
#pragma unroll
            for (int m = 0; m < 4; ++m)
#pragma unroll
                for (int n = 0; n < 2; ++n) acc[a][b][m][n] = (f32x4){0.f, 0.f, 0.f, 0.f};
    bf16x8 At[4][2], B0[2][2], B1[2][2];
    unsigned vA0[2] = {0u, 0u}, vA1[2] = {0u, 0u}, nA0[2] = {0u, 0u}, nA1[2] = {0u, 0u};
    const char* cA; const char* cB = (const char*)g.Bt + (size_t)(cur.e * g.nct + cur.pn) * tstep;
    if constexpr (GATHER) {
        cA = (const char*)g.A;
#pragma unroll
        for (int i = 0; i < 2; ++i) { vA0[i] = (unsigned)((tok[cur.ui * 256 + Rl[i]] & 0xffff) * KB + Cl[i]); vA1[i] = (unsigned)((tok[cur.ui * 256 + 128 + Rl[i]] & 0xffff) * KB + Cl[i]); nA0[i] = vA0[i]; nA1[i] = vA1[i]; }
    } else cA = (const char*)g.A + (size_t)cur.pm * tstep;
    PG8_STAGE(PG8_SB(0, 0), cB, voffB); PG8_STAGE(PG8_SB(0, 1), cB + hstep, voffB); PG8_STAGE_A(PG8_SA(0, 0), cA, 0, vA0, vA1); PG8_STAGE_A(PG8_SA(0, 1), cA, 1, vA0, vA1);
    if (wr == 1) PG8_BAR;
    PG8_WAIT_V(2); PG8_BAR;
    PG8_STAGE(PG8_SB(1, 0), cB + kstep, voffB); PG8_STAGE_A(PG8_SA(1, 0), cA + kstep, 0, vA0, vA1); PG8_STAGE(PG8_SB(1, 1), cB + hstep + kstep, voffB);
    PG8_WAIT_V(6); PG8_BAR;
    for (;;) {
        const bool has_next = S.next(ui + 1, nxt);
        const char* nAp; const char* nB;
        if (has_next) {
            nB = (const char*)g.Bt + (size_t)(nxt.e * g.nct + nxt.pn) * tstep;
            if constexpr (GATHER) { nAp = cA;
#pragma unroll
                for (int i = 0; i < 2; ++i) { nA0[i] = (unsigned)((tok[nxt.ui * 256 + Rl[i]] & 0xffff) * KB + Cl[i]); nA1[i] = (unsigned)((tok[nxt.ui * 256 + 128 + Rl[i]] & 0xffff) * KB + Cl[i]); }
            } else nAp = (const char*)g.A + (size_t)nxt.pm * tstep;
        } else { nAp = cA; nB = cB; }
        for (int t = 0; t < nt; t += 2) {
            const bool last = (t == nt - 2);
            const char* a1 = cA + (size_t)(t + 1) * kstep;
            const char* a2 = last ? nAp : cA + (size_t)(t + 2) * kstep; const char* b2 = last ? nB : cB + (size_t)(t + 2) * kstep;
            const char* a3 = a2 + kstep; const char* b3 = b2 + kstep;
            unsigned w0[2] = {0u, 0u}, w1[2] = {0u, 0u};
            if constexpr (GATHER) {
#pragma unroll
                for (int i = 0; i < 2; ++i) { w0[i] = last ? nA0[i] : vA0[i]; w1[i] = last ? nA1[i] : vA1[i]; } }
            if constexpr (Epi::MIDHOOK) { if (t == nt / 2) E.mid(acc, cur, wr, wc, fr, fq); }
            PG8_LDB(B0, 0, 0); PG8_LDB(B1, 0, 1); PG8_SCHED; PG8_LDA(At, 0, 0); PG8_STAGE_A(PG8_SA(1, 1), a1, 1, vA0, vA1);
            PG8_WAIT_V(8); PG8_WAIT_L(0); PG8_BAR; PG8_MM(0, 0, At, B0); PG8_MM(0, 1, At, B1); PG8_BAR; PG8_SCHED;
            PG8_LDA(At, 0, 1); PG8_STAGE(PG8_SB(0, 0), b2, voffB); PG8_STAGE(PG8_SB(0, 1), b2 + hstep, voffB); PG8_STAGE_A(PG8_SA(0, 0), a2, 0, w0, w1);
            PG8_WAIT_V(8); PG8_WAIT_L(0); PG8_BAR; PG8_MM(1, 0, At, B0); PG8_MM(1, 1, At, B1); PG8_BAR; PG8_SCHED;
            PG8_LDB(B0, 1, 0); PG8_LDB(B1, 1, 1); PG8_SCHED; PG8_LDA(At, 1, 0); PG8_STAGE_A(PG8_SA(0, 1), a2, 1, w0, w1);
            PG8_WAIT_V(8); PG8_WAIT_L(0); PG8_BAR; PG8_MM(0, 0, At, B0); PG8_MM(0, 1, At, B1); PG8_BAR; PG8_SCHED;
            PG8_LDA(At, 1, 1); PG8_STAGE(PG8_SB(1, 0), b3, voffB); PG8_STAGE(PG8_SB(1, 1), b3 + hstep, voffB); PG8_STAGE_A(PG8_SA(1, 0), a3, 0, w0, w1);
            PG8_WAIT_V(8); PG8_WAIT_L(0); PG8_BAR; PG8_MM(1, 0, At, B0); PG8_MM(1, 1, At, B1); PG8_BAR; PG8_SCHED;
        }
        if constexpr (ALIGN_EPI) { if (wr == 0) PG8_BAR; }
        E(acc, cur, wr, wc, fr, fq);
        if (!has_next) break;
#pragma unroll
        for (int a = 0; a < 2; ++a)
#pragma unroll
            for (int b = 0; b < 2; ++b)
#pragma unroll
                for (int m = 0; m < 4; ++m)
#pragma unroll
                    for (int n = 0; n < 2; ++n) acc[a][b][m][n] = (f32x4){0.f, 0.f, 0.f, 0.f};
        cur = nxt; cA = nAp; cB = nB; ++ui;
        if constexpr (GATHER) {
#pragma unroll
            for (int i = 0; i < 2; ++i) { vA0[i] = nA0[i]; vA1[i] = nA1[i]; } }
        if constexpr (ALIGN_EPI) { if (wr == 1) PG8_BAR; }
    }
    PG8_WAIT_V(0);
    if constexpr (!ALIGN_EPI) { if (wr == 0) PG8_BAR; }
    PG8_BAR;
#undef PG8_SA
#undef PG8_SB
#undef PG8_STAGE
#undef PG8_STAGE_A
#undef PG8_LDA
#undef PG8_LDB
#undef PG8_MMA
#undef PG8_MMA8
#undef PG8_MM
#undef PG8_WAIT_V
#undef PG8_WAIT_L
#undef PG8_BAR
#undef PG8_SCHED
}
typedef f32x4 Acc[2][2][4][2];
__device__ __forceinline__ float silu_(float x) { return x * __builtin_amdgcn_rcpf(1.f + __expf(-x)); }
__device__ __forceinline__ float sigm_(float x) { return __builtin_amdgcn_rcpf(1.f + __expf(-x)); }
__device__ __forceinline__ u32x4 pack8(const f32x4 a, const f32x4 b) { u32x4 w; w.x = cvt_pk_bf16(a[0], a[1]); w.y = cvt_pk_bf16(a[2], a[3]); w.z = cvt_pk_bf16(b[0], b[1]); w.w = cvt_pk_bf16(b[2], b[3]); return w; }
__device__ __forceinline__ u32x2 pack8_fp8(const f32x4 a, const f32x4 b) { u32x2 w; w.x = pk4_fp8(a[0], a[1], a[2], a[3]); w.y = pk4_fp8(b[0], b[1], b[2], b[3]); return w; }
__device__ __forceinline__ void unpack8(const u32x4 w, f32x4& a, f32x4& b) { a = (f32x4){bflo(w.x), bfhi(w.x), bflo(w.y), bfhi(w.y)}; b = (f32x4){bflo(w.z), bfhi(w.z), bflo(w.w), bfhi(w.w)}; }

struct EpiInproj {
    static constexpr bool MIDHOOK = false;
    const float* rs1; const float* lb; bf16_t *QS, *VV, *GS, *UU, *SBb, *RT, *GBS; h16_t* LF; float osc;
    __device__ __forceinline__ void mid(Acc&, const Unit&, int, int, int, int) const {}
    template <int ACT> __device__ __forceinline__ void plain(const Acc& acc, const float (&rs)[2][4], bf16_t* O, int pt, int row0, int wc, int fq) const {
#pragma unroll
        for (int ai = 0; ai < 2; ++ai)
#pragma unroll
            for (int m = 0; m < 4; ++m) { bf16_t* rowp = O + (size_t)(row0 + ai * HALF + m * 16) * HF + pt * 256 + wc * 32 + 8 * fq; const float r = rs[ai][m];
#pragma unroll
                for (int bj = 0; bj < 2; ++bj) { f32x4 v0 = acc[ai][bj][m][0] * r, v1 = acc[ai][bj][m][1] * r;
                    if (ACT == 1) {
#pragma unroll
                        for (int j = 0; j < 4; ++j) { v0[j] = silu_(v0[j]); v1[j] = silu_(v1[j]); } }
                    *(u32x4*)(rowp + bj * HALF) = pack8(v0, v1); } }
    }
    __device__ __forceinline__ void operator()(const Acc& acc, const Unit& u, int wr, int wc, int fr, int fq) const {
        const int row0 = u.pm * BM + wr * 64 + fr, pn = u.pn;
        float rs[2][4];
#pragma unroll
        for (int ai = 0; ai < 2; ++ai)
#pragma unroll
            for (int m = 0; m < 4; ++m) rs[ai][m] = osc;
        if (pn < 4) plain<1>(acc, rs, QS, pn, row0, wc, fq);
        else if (pn < 8) {
            const int c0 = (pn - 4) * 256 + wc * 32 + 4 * fq;
            f32x4 lbv[2][2];
#pragma unroll
            for (int bj = 0; bj < 2; ++bj)
#pragma unroll
                for (int n = 0; n < 2; ++n) lbv[bj][n] = *(const f32x4*)(lb + c0 + bj * HALF + n * 16);
#pragma unroll
            for (int ai = 0; ai < 2; ++ai)
#pragma unroll
                for (int m = 0; m < 4; ++m) { h16_t* rowp = LF + (size_t)(row0 + ai * HALF + m * 16) * HF + c0; const float r = rs[ai][m];
#pragma unroll
                    for (int bj = 0; bj < 2; ++bj)
#pragma unroll
                        for (int n = 0; n < 2; ++n) { f32x4 v = acc[ai][bj][m][n] * r; const f32x4 l = lbv[bj][n];
#pragma unroll
                            for (int j = 0; j < 4; ++j) v[j] = __logf(l[j] + (1.f - l[j]) * sigm_(v[j]));
                            *(h16x4*)(rowp + bj * HALF + n * 16) = (h16x4){(h16_t)v[0], (h16_t)v[1], (h16_t)v[2], (h16_t)v[3]}; } }
        }
        else if (pn < 12) plain<0>(acc, rs, VV, pn - 8, row0, wc, fq);
        else if (pn < 16) plain<1>(acc, rs, GS, pn - 12, row0, wc, fq);
        else if (pn < 24) {
            const int c0 = (pn - 16) * 128 + wc * 32 + 8 * fq;
#pragma unroll
            for (int ai = 0; ai < 2; ++ai)
#pragma unroll
                for (int m = 0; m < 4; ++m) { const float r2 = rs[ai][m] * rs[ai][m];
                    const f32x4 v0 = acc[ai][0][m][0] * acc[ai][1][m][0] * r2, v1 = acc[ai][0][m][1] * acc[ai][1][m][1] * r2;
                    *(u32x4*)(UU + (size_t)(row0 + ai * HALF + m * 16) * HF + c0) = pack8(v0, v1); }
        }
        else if (pn < 28) plain<0>(acc, rs, SBb, pn - 24, row0, wc, fq);
        else {
            const int c0 = (pn - 28) * 128 + wc * 32 + 8 * fq;
#pragma unroll
            for (int ai = 0; ai < 2; ++ai)
#pragma unroll
                for (int m = 0; m < 4; ++m) { const float r = rs[ai][m]; f32x4 q0, q1, b0, b1;
#pragma unroll
                    for (int j = 0; j < 4; ++j) { const float ea = 1.f + __expf(-acc[ai][0][m][0][j] * r), eb = 1.f + __expf(-acc[ai][1][m][0][j] * r); b0[j] = __builtin_amdgcn_rcpf(eb); q0[j] = eb * __builtin_amdgcn_rcpf(ea);
                                                  const float fa = 1.f + __expf(-acc[ai][0][m][1][j] * r), fb = 1.f + __expf(-acc[ai][1][m][1][j] * r); b1[j] = __builtin_amdgcn_rcpf(fb); q1[j] = fb * __builtin_amdgcn_rcpf(fa); }
                    const size_t o = (size_t)(row0 + ai * HALF + m * 16) * D + c0;
                    *(u32x4*)(RT + o) = pack8(q0, q1); *(u32x4*)(GBS + o) = pack8(b0, b1); }
        }
    }
};

struct EpiMerge {
    static constexpr bool MIDHOOK = true;
    const bf16_t *RT, *GBS; bf16_t* MG;
    __device__ __forceinline__ void mid(Acc& acc, const Unit& u, int wr, int wc, int fr, int fq) const {
        unsigned o0 = ((unsigned)(u.pm * BM + wr * 64 + fr) * D + (unsigned)(u.pn * BM + wc * 32 + 8 * fq)) * 2u;
        asm volatile("" : "+v"(o0));
#pragma unroll
        for (int ai = 0; ai < 2; ++ai)
#pragma unroll
            for (int m = 0; m < 4; ++m)
#pragma unroll
                for (int bj = 0; bj < 2; ++bj) { const u32x4 w = *(const GAS u32x4*)((const GAS char*)RT + (o0 + (unsigned)((ai * HALF + m * 16) * D + bj * HALF) * 2u)); f32x4 a, b; unpack8(w, a, b);
                    acc[ai][bj][m][0] *= a; acc[ai][bj][m][1] *= b; }
    }
    __device__ __forceinline__ void operator()(const Acc& acc, const Unit& u, int wr, int wc, int fr, int fq) const {
        unsigned o0 = ((unsigned)(u.pm * BM + wr * 64 + fr) * D + (unsigned)(u.pn * BM + wc * 32 + 8 * fq)) * 2u;
        asm volatile("" : "+v"(o0));
#pragma unroll
        for (int ai = 0; ai < 2; ++ai)
#pragma unroll
            for (int m = 0; m < 4; ++m)
#pragma unroll
                for (int bj = 0; bj < 2; ++bj) { const unsigned o = o0 + (unsigned)((ai * HALF + m * 16) * D + bj * HALF) * 2u; const u32x4 w = *(const GAS u32x4*)((const GAS char*)GBS + o); f32x4 a, b; unpack8(w, a, b);
                    *(GAS u32x4*)((GAS char*)MG + o) = pack8(acc[ai][bj][m][0] * a, acc[ai][bj][m][1] * b); if (bj == 1 && m == 3) asm volatile("" ::: "memory"); }
    }
};

struct EpiWo {
    static constexpr bool MIDHOOK = false;
    bf16_t* DL;
    __device__ __forceinline__ void mid(Acc&, const Unit&, int, int, int, int) const {}
    __device__ __forceinline__ void operator()(const Acc& acc, const Unit& u, int wr, int wc, int fr, int fq) const {
        const int row0 = u.pm * BM + wr * 64 + fr, c0 = u.pn * BM + wc * 32 + 8 * fq;
#pragma unroll
        for (int ai = 0; ai < 2; ++ai)
#pragma unroll
            for (int m = 0; m < 4; ++m)
#pragma unroll
                for (int bj = 0; bj < 2; ++bj) *(u32x4*)(DL + (size_t)(row0 + ai * HALF + m * 16) * D + c0 + bj * HALF) = pack8(acc[ai][bj][m][0], acc[ai][bj][m][1]);
    }
};

struct EpiUp {
    static constexpr bool MIDHOOK = false;
    const float* rs2; const LAS int* tok; const LAS bf16_t* bias; unsigned char* ACT;
    __device__ __forceinline__ void mid(Acc&, const Unit&, int, int, int, int) const {}
    __device__ __forceinline__ void operator()(const Acc& acc, const Unit& u, int wr, int wc, int fr, int fq) const {
        const int rl0 = wr * 64 + fr, c0 = u.pn * 128 + wc * 32 + 8 * fq;
        float rs[2][4];
#pragma unroll
        for (int ai = 0; ai < 2; ++ai)
#pragma unroll
            for (int m = 0; m < 4; ++m) rs[ai][m] = __uint_as_float((unsigned)tok[u.ui * 256 + rl0 + ai * HALF + m * 16] & 0xffff0000u);
        const LAS bf16_t* bp = bias + u.ui * 256 + wc * 32 + 8 * fq;
        f32x4 bg0, bg1, bu0, bu1; unpack8(*(const LAS u32x4*)(bp), bg0, bg1); unpack8(*(const LAS u32x4*)(bp + 128), bu0, bu1);
#pragma unroll
        for (int ai = 0; ai < 2; ++ai)
#pragma unroll
            for (int m = 0; m < 4; ++m) { const float r = rs[ai][m]; f32x4 a0, a1;
#pragma unroll
                for (int n = 0; n < 2; ++n)
#pragma unroll
                    for (int jp = 0; jp < 2; ++jp) {
                        const f32x4 ag = acc[ai][0][m][n], au = acc[ai][1][m][n], bgv = n ? bg1 : bg0, buv = n ? bu1 : bu0;
                        f32x2 g = (f32x2){ag[2 * jp], ag[2 * jp + 1]} * r + (f32x2){bgv[2 * jp], bgv[2 * jp + 1]};
                        f32x2 uu = (f32x2){au[2 * jp], au[2 * jp + 1]} * r + (f32x2){buv[2 * jp], buv[2 * jp + 1]};
                        g.x = fminf(g.x, 7.f); g.y = fminf(g.y, 7.f);
                        uu.x = __builtin_amdgcn_fmed3f(uu.x, -7.f, 7.f); uu.y = __builtin_amdgcn_fmed3f(uu.y, -7.f, 7.f);
                        const f32x2 t = g * (-1.702f * 1.44269504f);
                        f32x2 den; den.x = __builtin_amdgcn_exp2f(t.x); den.y = __builtin_amdgcn_exp2f(t.y); den = den + 1.f;
                        f32x2 s; s.x = __builtin_amdgcn_rcpf(den.x); s.y = __builtin_amdgcn_rcpf(den.y);
                        const f32x2 a = (uu + 1.f) * (g * s);
                        if (n == 0) { a0[2 * jp] = a.x; a0[2 * jp + 1] = a.y; } else { a1[2 * jp] = a.x; a1[2 * jp + 1] = a.y; }
                    }
                *(u32x2*)(ACT + (size_t)(u.pm * BM + rl0 + ai * HALF + m * 16) * DFF + c0) = pack8_fp8(a0, a1); }
    }
};

struct EpiDown {
    static constexpr bool MIDHOOK = false;
    const LAS float* bias; unsigned char* YR;
    __device__ __forceinline__ void mid(Acc&, const Unit&, int, int, int, int) const {}
    __device__ __forceinline__ void operator()(const Acc& acc, const Unit& u, int wr, int wc, int fr, int fq) const {
        const int rl0 = wr * 64 + fr, c0 = u.pn * BM + wc * 32 + 8 * fq;
        const LAS float* bp = bias + u.ui * 256 + wc * 32 + 8 * fq;
        f32x4 bv[2][2];
#pragma unroll
        for (int bj = 0; bj < 2; ++bj)
#pragma unroll
            for (int n = 0; n < 2; ++n) bv[bj][n] = *(const LAS f32x4*)(bp + bj * HALF + 4 * n);
#pragma unroll
        for (int ai = 0; ai < 2; ++ai)
#pragma unroll
            for (int m = 0; m < 4; ++m)
#pragma unroll
                for (int bj = 0; bj < 2; ++bj)
                    *(u32x2*)(YR + (size_t)(u.pm * BM + rl0 + ai * HALF + m * 16) * D + c0 + bj * HALF) = pack8_fp8(acc[ai][bj][m][0] * W8_INV + bv[bj][0], acc[ai][bj][m][1] * W8_INV + bv[bj][1]);
    }
};

struct EpiDummy {
    static constexpr bool MIDHOOK = false;
    bf16_t* O; int nostore;
    __device__ __forceinline__ void mid(Acc&, const Unit&, int, int, int, int) const {}
    __device__ __forceinline__ void operator()(const Acc& acc, const Unit& u, int wr, int wc, int fr, int fq) const {
        const int row0 = (u.pm & 63) * BM + wr * 64 + fr, c0 = (u.pn & 7) * BM + wc * 32 + 8 * fq;
        if (nostore) {
#pragma unroll
            for (int ai = 0; ai < 2; ++ai)
#pragma unroll
                for (int m = 0; m < 4; ++m)
#pragma unroll
                    for (int bj = 0; bj < 2; ++bj) asm volatile("" :: "v"(acc[ai][bj][m][0]), "v"(acc[ai][bj][m][1]));
            return; }
#pragma unroll
        for (int ai = 0; ai < 2; ++ai)
#pragma unroll
            for (int m = 0; m < 4; ++m)
#pragma unroll
                for (int bj = 0; bj < 2; ++bj) *(u32x4*)(O + (size_t)(row0 + ai * HALF + m * 16) * D + c0 + bj * HALF) = pack8(acc[ai][bj][m][0], acc[ai][bj][m][1]);
    }
};
struct ProbeOrder {
    StaticOrder S; int mode, c;
    __device__ __forceinline__ bool next(int i, Unit& u) const {
        if (mode == 3) { if (c & 1) return false; StaticOrder H = S; H.G = S.G / 2; H.c = c >> 1; H.nwg = S.nwg / 2; return H.next(i, u); }
        if (!S.next(i, u)) return false; if (mode >= 1) u.pn = 0; if (mode >= 2) u.pm = c & 63; return true; }
};

struct ProbeMoe {
    MoeOrder S; int mode;
    __device__ __forceinline__ bool next(int i, Unit& u) const { if (!S.next(i, u)) return false; if (mode & 1) { u.e = 0; u.pn = 0; } if (mode & 2) u.pm = 0; return true; }
};
struct Frame {
    LAS unsigned char* lds; volatile LAS unsigned* MISC; gu32* ctl; unsigned char* ws;
    int tid, lane, wave, vcu, G;
    const float *x, *meta, *nmw, *w_in, *lbl, *gnw, *w_ho, *cw, *w_co, *w_o, *nfw, *w_r, *b_r, *w_up, *b_up, *w_dn, *b_dn, *fnw; float* out;
};
template <class T> __device__ __forceinline__ T* wsp(const Frame& F, size_t off) { return (T*)(F.ws + off); }

__device__ __forceinline__ void tr_tile(const float* W, int ldw, int k0, int src0, int src1, bool perm0, bool perm1, const float* kscale, bf16_t* dst, int dpitch, int drow0, int dk0, LAS unsigned* T, int lane) {
    const int ln = lane & 15, kr = lane >> 4, srcc = (ln < 8 ? src0 : src1) + 4 * (ln & 7);
    const float* wp = W + (size_t)(k0 + 2 * kr) * ldw + srcc;
    f32x4 va[8], vb[8]; f32x2 sc[8];
#pragma unroll
    for (int s = 0; s < 8; ++s) { va[s] = __builtin_nontemporal_load((const GAS f32x4*)(wp + (size_t)(8 * s) * ldw)); vb[s] = __builtin_nontemporal_load((const GAS f32x4*)(wp + (size_t)(8 * s + 1) * ldw));
        sc[s] = kscale ? *(const GAS f32x2*)(kscale + k0 + 8 * s + 2 * kr) : (f32x2){1.f, 1.f}; }
    __builtin_amdgcn_sched_barrier(0);
#pragma unroll
    for (int s = 0; s < 8; ++s) { const int col = (4 * s + kr) ^ (2 * ln);
#pragma unroll
        for (int i = 0; i < 4; ++i) T[(4 * ln + i) * 32 + col] = cvt_pk_bf16(va[s][i] * sc[s].x, vb[s][i] * sc[s].y); }
    LDS_WAIT(); asm volatile("" ::: "memory");
    const int c = lane & 7;
#pragma unroll
    for (int j = 0; j < 8; ++j) { const int rho = (lane >> 3) + 8 * j, h = rho >> 5, r32 = rho & 31; const bool pm = h ? perm1 : perm0; const int n = h * 32 + (pm ? perm32(r32) : r32);
        u32x4 v = *(const LAS u32x4*)(T + n * 32 + 4 * (c ^ (n >> 3)));
        if ((n >> 2) & 1) v = (u32x4){v.z, v.w, v.x, v.y};
        *(GAS u32x4*)(dst + (size_t)(drow0 + rho) * dpitch + dk0 + k0 + 8 * c) = v; }
    LDS_WAIT(); asm volatile("" ::: "memory");
}
template <int PMODE = 0> __device__ __forceinline__ void tr_tile_fp8(const float* W, int ldw, int k0, int src0, int src1, const float* kscale, unsigned char* dst, int dpitch, int drow0, LAS unsigned* T, int lane, bool perm = true) {
    const int ln = lane & 15, kr = lane >> 4, srcc = (ln < 8 ? src0 : src1) + 4 * (ln & 7);
    f32x4 v[2][4][4];
#pragma unroll
    for (int half = 0; half < 2; ++half) {
        const float* wp = W + (size_t)(k0 + 64 * half + 4 * kr) * ldw + srcc;
#pragma unroll
        for (int s = 0; s < 4; ++s) {
#pragma unroll
            for (int q = 0; q < 4; ++q) v[half][s][q] = __builtin_nontemporal_load((const GAS f32x4*)(wp + (size_t)(16 * s + q) * ldw)); }
    }
    __builtin_amdgcn_sched_barrier(0);
    if (PMODE == 1) {
#pragma unroll
        for (int half = 0; half < 2; ++half)
#pragma unroll
            for (int s = 0; s < 4; ++s)
#pragma unroll
                for (int q = 0; q < 4; ++q) asm volatile("" :: "v"(v[half][s][q]));
        return; }
#pragma unroll
    for (int half = 0; half < 2; ++half)
#pragma unroll
        for (int s = 0; s < 4; ++s) { const int col = (16 * half + 4 * s + kr) ^ (2 * ln);
            const f32x4 sc = kscale ? *(const GAS f32x4*)(kscale + k0 + 64 * half + 16 * s + 4 * kr) * W8_SCALE : (f32x4){W8_SCALE, W8_SCALE, W8_SCALE, W8_SCALE};
#pragma unroll
            for (int i = 0; i < 4; ++i) T[(4 * ln + i) * 32 + col] = pk4_fp8(v[half][s][0][i] * sc[0], v[half][s][1][i] * sc[1], v[half][s][2][i] * sc[2], v[half][s][3][i] * sc[3]); }
    LDS_WAIT(); asm volatile("" ::: "memory");
    const int c = lane & 7;
#pragma unroll
    for (int j = 0; j < 8; ++j) { const int rho = (lane >> 3) + 8 * j, h = rho >> 5, r32 = rho & 31; const int n = h * 32 + (perm ? perm32(r32) : r32);
        u32x4 v4 = *(const LAS u32x4*)(T + n * 32 + 4 * (c ^ (n >> 3)));
        if ((n >> 2) & 1) v4 = (u32x4){v4.z, v4.w, v4.x, v4.y};
        if (PMODE == 2) asm volatile("" :: "v"(v4)); else *(GAS u32x4*)(dst + (size_t)(drow0 + rho) * dpitch + k0 + 16 * c) = v4; }
    LDS_WAIT(); asm volatile("" ::: "memory");
}
__device__ __forceinline__ int win_src(int G, bool& perm) {
    const int pn = G >> 3, gi = G & 7; perm = true;
    if (pn < 4) return C_Q + pn * 256 + gi * 32;
    if (pn < 8) { perm = false; return C_F + (pn - 4) * 256 + gi * 32; }
    if (pn < 12) return C_V + (pn - 8) * 256 + gi * 32;
    if (pn < 16) return C_G + (pn - 12) * 256 + gi * 32;
    if (pn < 24) return (gi < 4 ? C_SV : C_SC) + (pn - 16) * 128 + (gi & 3) * 32;
    if (pn < 28) return C_SB + (pn - 24) * 256 + gi * 32;
    return (gi < 4 ? C_GA : C_GB) + (pn - 28) * 128 + (gi & 3) * 32;
}
__device__ __forceinline__ void p0_prologue(Frame& F) {
    const int gw = F.vcu * NWAVES + F.wave, NGW = F.G * NWAVES, gt = F.vcu * NTHR + F.tid, NGT = F.G * NTHR;
    for (int i = gt; i < HF; i += NGT) wsp<float>(F, WS_LB)[i] = 1.f / (1.f + __expf(F.lbl[HF + i] - F.lbl[i]));
    for (int i = gt; i < D * NE; i += NGT) { const int k = i >> 5, e = i & 31; const float v = F.w_r[i] * F.nfw[k]; const unsigned h = f2bf(v); const float lo = v - bf2f((unsigned short)h);
        wsp<bf16_t>(F, WS_WRH)[e * D + k] = (bf16_t)h; wsp<bf16_t>(F, WS_WRL)[e * D + k] = (bf16_t)f2bf(lo); }
    for (int i = gt; i < 48 * HF; i += NGT) { wsp<h16_t>(F, WS_LFM)[i] = (h16_t)0.f; wsp<bf16_t>(F, WS_VVM)[i] = 0; }
    {
        LAS float* hnm = (LAS float*)F.lds;
        for (int r = F.wave * 2; r < F.wave * 2 + 2; ++r) {
            const f32x4* xr = (const f32x4*)(F.meta + (size_t)r * D) + F.lane; f32x4 v[8]; float s = 0.f;
#pragma unroll
            for (int j = 0; j < 8; ++j) { v[j] = xr[64 * j]; s += (v[j].x * v[j].x + v[j].y * v[j].y) + (v[j].z * v[j].z + v[j].w * v[j].w); }
            const float rs = rsqrtf(wave_sum(s) * (1.f / D) + EPS);
#pragma unroll
            for (int j = 0; j < 8; ++j) { const f32x4 w = ((const f32x4*)F.nmw)[F.lane + 64 * j]; *(LAS f32x4*)(hnm + r * D + 4 * F.lane + 256 * j) = v[j] * rs * w; }
        }
        __syncthreads();
        LAS float* red = (LAS float*)(F.lds + TOK_OFF);
        for (int cb = F.vcu; cb < 256; cb += F.G) {
            const int col = F.tid & 15, ks = F.tid >> 4;
            int gcol;
            if (cb < 64) gcol = C_F + 16 * cb + col; else if (cb < 128) gcol = C_V + 16 * (cb - 64) + col; else gcol = (col < 8 ? C_SV : C_SC) + 8 * (cb - 128) + (col & 7);
            float a[16];
#pragma unroll
            for (int r = 0; r < 16; ++r) a[r] = 0.f;
#pragma unroll 1
            for (int hf = 0; hf < 2; ++hf) {
                float w[32]; const int kb = ks * 64 + 32 * hf;
#pragma unroll
                for (int kk = 0; kk < 32; ++kk) w[kk] = F.w_in[(size_t)(kb + kk) * INC + gcol];
                __builtin_amdgcn_sched_barrier(0);
#pragma unroll
                for (int k4 = 0; k4 < 8; ++k4) {
#pragma unroll
                    for (int r = 0; r < 16; ++r) { const f32x4 h = *(const LAS f32x4*)(hnm + r * D + kb + 4 * k4);
                        a[r] = fmaf(h.x, w[4 * k4], a[r]); a[r] = fmaf(h.y, w[4 * k4 + 1], a[r]); a[r] = fmaf(h.z, w[4 * k4 + 2], a[r]); a[r] = fmaf(h.w, w[4 * k4 + 3], a[r]); }
                    __builtin_amdgcn_sched_barrier(0); } }
#pragma unroll
            for (int r = 0; r < 16; ++r) { a[r] += __shfl_xor(a[r], 16); a[r] += __shfl_xor(a[r], 32); }
            if (F.lane < 16) {
#pragma unroll
                for (int r = 0; r < 16; ++r) red[(F.wave * 16 + r) * 16 + col] = a[r]; }
            __syncthreads();
            if (F.tid < 256) { const int r = F.tid >> 4, c = F.tid & 15; float v = 0.f;
#pragma unroll
                for (int w = 0; w < 8; ++w) v += red[(w * 16 + r) * 16 + c];
                if (cb < 64) { const int ch = 16 * cb + c; const float l = 1.f / (1.f + __expf(F.lbl[HF + ch] - F.lbl[ch])); wsp<h16_t>(F, WS_LFM)[(48 + r) * HF + ch] = (h16_t)__logf(l + (1.f - l) * sigmoidf_(v)); }
                else if (cb < 128) wsp<bf16_t>(F, WS_VVM)[(48 + r) * HF + 16 * (cb - 64) + c] = (bf16_t)f2bf(v);
                else red[2048 + r * 16 + c] = v; }
            __syncthreads();
            if (cb >= 128 && F.tid < 128) { const int r = F.tid >> 3, c = F.tid & 7; wsp<bf16_t>(F, WS_UUM)[r * HF + 8 * (cb - 128) + c] = (bf16_t)f2bf(red[2048 + r * 16 + c] * red[2048 + r * 16 + c + 8]); }
            __syncthreads();
        }
        __syncthreads();
    }
    {
        LAS unsigned* T = (LAS unsigned*)(F.lds + F.wave * 16384);
        constexpr int I_IN = 32 * 4 * N_INB, I_AB = 16 * 32, I_O = 32 * 32, I_UP1 = 16 * 64, I_DN1 = 16 * 32;
        constexpr int I_IN8 = 16 * 4 * N_IN8;
        constexpr int NIT = I_IN + I_IN8 + 2 * I_AB + I_O;
        for (int it = gw; it < NIT; it += NGW) {
            int r = it;
            if (r < I_IN) { const int kb = r / (4 * N_INB), ntl = r % (4 * N_INB), nt = 4 * nth_bit(INB_MASK, ntl >> 2) + (ntl & 3); bool p0, p1; const int s0 = win_src(2 * nt, p0), s1 = win_src(2 * nt + 1, p1); tr_tile(F.w_in, INC, kb * 64, s0, s1, p0, p1, F.nmw, wsp<bf16_t>(F, WS_WIN), D, nt * 64, 0, T, F.lane); continue; } r -= I_IN;
            if (r < I_IN8) { const int kb = r / (4 * N_IN8), ntl = r % (4 * N_IN8), nt = 4 * nth_bit(IN8_MASK, ntl >> 2) + (ntl & 3); bool p0, p1; const int s0 = win_src(2 * nt, p0), s1 = win_src(2 * nt + 1, p1);
                tr_tile_fp8<0>(F.w_in, INC, kb * 128, s0, s1, F.nmw, wsp<unsigned char>(F, WS_WIN8), D, nt * 64, T, F.lane, p0); continue; } r -= I_IN8;
            if (r < I_AB) { const int kb = r / 32, nt = r % 32; tr_tile(F.w_ho, D, kb * 64, nt * 64, nt * 64 + 32, true, true, nullptr, wsp<bf16_t>(F, WS_WAB), D, nt * 64, 0, T, F.lane); continue; } r -= I_AB;
            if (r < I_AB) { const int kb = r / 32, nt = r % 32; tr_tile(F.w_co, D, kb * 64, nt * 64, nt * 64 + 32, true, true, nullptr, wsp<bf16_t>(F, WS_WAB), D, nt * 64, HF, T, F.lane); continue; } r -= I_AB;
            if (r < I_O) { const int kb = r / 32, nt = r % 32; tr_tile(F.w_o, D, kb * 64, nt * 64, nt * 64 + 32, true, true, nullptr, wsp<bf16_t>(F, WS_WO), D, nt * 64, 0, T, F.lane); continue; } r -= I_O;
        }
    }
    for (int m = gw; m < M; m += NGW) {
        const GAS f32x4* xr = (const GAS f32x4*)(F.x + (size_t)m * D) + F.lane; f32x4 v[8]; float s = 0.f;
#pragma unroll
        for (int j = 0; j < 8; ++j) v[j] = xr[64 * j];
        __builtin_amdgcn_sched_barrier(0);
#pragma unroll
        for (int j = 0; j < 8; ++j) s += (v[j].x * v[j].x + v[j].y * v[j].y) + (v[j].z * v[j].z + v[j].w * v[j].w);
        s = wave_sum(s);
        const float rsx = rsqrtf(s * (1.f / D) + EPS);
#pragma unroll
        for (int j = 0; j < 8; ++j) v[j] *= rsx;
        GAS u32x2* o8 = (GAS u32x2*)(wsp<bf16_t>(F, WS_XB) + (size_t)m * D) + F.lane;
#pragma unroll
        for (int j = 0; j < 8; ++j) { u32x2 w; w.x = pk2(v[j].x, v[j].y); w.y = pk2(v[j].z, v[j].w); o8[64 * j] = w; }
        GAS unsigned* o4 = (GAS unsigned*)(wsp<unsigned char>(F, WS_XB8) + (size_t)m * D) + F.lane;
#pragma unroll
        for (int j = 0; j < 8; ++j) o4[64 * j] = pk4_fp8(v[j].x, v[j].y, v[j].z, v[j].w);
    }
}

template <int PMODE = 0> __device__ __forceinline__ void p1_convert(Frame& F, int rank, int nconv) {
    LAS unsigned* T = (LAS unsigned*)(F.lds + F.wave * 16384);
    constexpr int I_UP1 = 16 * 64, I_DN1 = 16 * 32, NIT = NE * (I_UP1 + I_DN1);
    for (int it = rank * NWAVES + F.wave; it < NIT; it += nconv * NWAVES) {
        int r = it;
        if (r < NE * I_UP1) { const int e = r / I_UP1, q = r % I_UP1, kb = q / 64, nt = q % 64, G0 = 2 * nt, pn = G0 >> 3, gi = G0 & 7; const int s0 = (gi < 4 ? 0 : 2048) + pn * 128 + (gi & 3) * 32;
            tr_tile_fp8<PMODE>(F.w_up + (size_t)e * D * 4096, 4096, kb * 128, s0, s0 + 32, F.nfw, wsp<unsigned char>(F, WS_WUP) + (size_t)e * 4096 * D, D, nt * 64, T, F.lane); continue; } r -= NE * I_UP1;
        { const int e = r / I_DN1, q = r % I_DN1, kb = q / 32, nt = q % 32;
          tr_tile_fp8<PMODE>(F.w_dn + (size_t)e * DFF * D, D, kb * 128, nt * 64, nt * 64 + 32, nullptr, wsp<unsigned char>(F, WS_WDN) + (size_t)e * D * DFF, DFF, nt * 64, T, F.lane); }
    }
}

constexpr int KTP = 72;
constexpr int QP_ = 136;
__device__ __forceinline__ void vt_load(const Frame& F, const bf16_t* Vb, size_t row0, int h, u32x4 (&w)[2]) {
#pragma unroll
    for (int q = 0; q < 2; ++q) { const int id = F.tid + 512 * q, t = id >> 4, v8 = (id & 15) * 8; w[q] = *(const GAS u32x4*)(Vb + (row0 + t) * HF + h * 128 + v8); }
}
__device__ __forceinline__ void vt_store(const Frame& F, const u32x4 (&w)[2], LAS bf16_t* VT) {
#pragma unroll
    for (int q = 0; q < 2; ++q) { const int id = F.tid + 512 * q, t = id >> 4, v8 = (id & 15) * 8; const unsigned ww[4] = {w[q].x, w[q].y, w[q].z, w[q].w};
        const int ts = t ^ (v8 & 24);
#pragma unroll
        for (int i = 0; i < 4; ++i) { VT[(v8 + 2 * i) * KTP + ts] = (bf16_t)(ww[i] & 0xffffu); VT[(v8 + 2 * i + 1) * KTP + ts] = (bf16_t)(ww[i] >> 16); } }
}
__device__ __forceinline__ int vt_off(int v, int t0) { return v * KTP + (t0 ^ (v & 24)); }
struct P2aRegs { float L[16]; u32x4 vw[2]; };
__device__ __forceinline__ void p2a_where(const Frame& F, int u, const h16_t*& Lb, const bf16_t*& Vb, size_t& row0, int& h, int& slot) {
    if (u < 8) { Lb = wsp<h16_t>(F, WS_LFM); Vb = wsp<bf16_t>(F, WS_VVM); row0 = 0; h = u; slot = 32 * 64 + u; }
    else { const int bh = (u - 8) >> 6, c = (u - 8) & 63, b = bh >> 3; h = bh & 7; Lb = wsp<h16_t>(F, WS_LF); Vb = wsp<bf16_t>(F, WS_VV); row0 = (size_t)b * SEQ + 64 * c; slot = bh * 64 + c; }
}
__device__ __forceinline__ void p2a_load(const Frame& F, int u, P2aRegs& R) {
    const h16_t* Lb; const bf16_t* Vb; size_t row0; int h, slot; p2a_where(F, u, Lb, Vb, row0, h, slot);
    const int d = F.tid & 127, tq = F.tid >> 7;
#pragma unroll
    for (int i = 0; i < 16; ++i) R.L[i] = (float)Lb[(row0 + 16 * tq + i) * HF + h * 128 + d];
    vt_load(F, Vb, row0, h, R.vw);
}
__device__ __forceinline__ void p2a_compute(Frame& F, int u, const P2aRegs& R) {
    LAS bf16_t* KT = (LAS bf16_t*)F.lds; LAS bf16_t* VT = KT + 128 * KTP; LAS float* TOT = (LAS float*)(F.lds + 2 * 128 * KTP * 2);
    const h16_t* Lb; const bf16_t* Vb; size_t row0; int h, slot; p2a_where(F, u, Lb, Vb, row0, h, slot);
    const int d = F.tid & 127, tq = F.tid >> 7;
    float cs[16]; float run = 0.f;
#pragma unroll
    for (int i = 0; i < 16; ++i) { run += R.L[i]; cs[i] = run; }
    TOT[tq * 128 + d] = run;
    vt_store(F, R.vw, VT);
    __syncthreads();
    float off = 0.f, total = 0.f;
#pragma unroll
    for (int q = 0; q < 4; ++q) { const float tv = TOT[q * 128 + d]; total += tv; if (q < tq) off += tv; }
#pragma unroll
    for (int i = 0; i < 16; i += 2) { const float k0 = (1.f - __expf(R.L[i])) * __expf(total - off - cs[i]), k1 = (1.f - __expf(R.L[i + 1])) * __expf(total - off - cs[i + 1]);
        *(LAS unsigned*)(KT + d * KTP + 16 * tq + i) = pk2(k0, k1); }
    if (tq == 0) wsp<float>(F, WS_DEC)[(size_t)slot * 128 + d] = __expf(total);
    __syncthreads();
    {
        const int w = F.wave, fr = F.lane & 15, fq = F.lane >> 4;
        bf16x8 a[2];
#pragma unroll
        for (int ks = 0; ks < 2; ++ks) a[ks] = *(const LAS bf16x8*)(KT + (16 * w + fr) * KTP + 32 * ks + 8 * fq);
        bf16_t* Ub = wsp<bf16_t>(F, WS_UC) + (size_t)slot * 16384;
#pragma unroll
        for (int vb = 0; vb < 8; ++vb) { f32x4 c = (f32x4){0.f, 0.f, 0.f, 0.f};
#pragma unroll
            for (int ks = 0; ks < 2; ++ks) { const bf16x8 bv = *(const LAS bf16x8*)(VT + vt_off(16 * vb + fr, 32 * ks + 8 * fq)); c = __builtin_amdgcn_mfma_f32_16x16x32_bf16(a[ks], bv, c, 0, 0, 0); }
            u32x2 o; o.x = pk2(c[0], c[1]); o.y = pk2(c[2], c[3]);
            *(GAS u32x2*)(Ub + (16 * vb + fr) * 128 + 16 * w + 4 * fq) = o; }
    }
    __syncthreads();
}
__device__ __forceinline__ void p2a_units(Frame& F, int c) {
    constexpr int NU = 2048 + 8;
    if (c >= NU) return;
    P2aRegs R; p2a_load(F, c, R);
    for (int u = c; u < NU; u += F.G) {
        P2aRegs N; const int un = u + F.G; if (un < NU) p2a_load(F, un, N); else N = R;
        p2a_compute(F, u, R);
        R = N;
    }
}
__device__ __forceinline__ void p2a_conv(Frame& F, int item) {
    const int c8 = (F.tid & 127) * 8, tq = F.tid >> 7, r0 = item * 64 + tq * 16, p0 = r0 & (SEQ - 1);
    const bf16_t* UU = wsp<bf16_t>(F, WS_UU); const bf16_t* UUM = wsp<bf16_t>(F, WS_UUM); const bf16_t* SBb = wsp<bf16_t>(F, WS_SB); bf16_t* A2 = wsp<bf16_t>(F, WS_A2);
    f32x4 w0a = *(const f32x4*)(F.cw + c8), w0b = *(const f32x4*)(F.cw + c8 + 4), w1a = *(const f32x4*)(F.cw + HF + c8), w1b = *(const f32x4*)(F.cw + HF + c8 + 4), w2a = *(const f32x4*)(F.cw + 2 * HF + c8), w2b = *(const f32x4*)(F.cw + 2 * HF + c8 + 4);
    f32x4 um2a, um2b, um1a, um1b;
    { const u32x4 a = (p0 >= 2) ? *(const GAS u32x4*)(UU + (size_t)(r0 - 2) * HF + c8) : *(const GAS u32x4*)(UUM + (14 + p0) * HF + c8); unpack8(a, um2a, um2b);
      const u32x4 b = (p0 >= 1) ? *(const GAS u32x4*)(UU + (size_t)(r0 - 1) * HF + c8) : *(const GAS u32x4*)(UUM + 15 * HF + c8); unpack8(b, um1a, um1b); }
#pragma unroll
    for (int i = 0; i < 16; ++i) { f32x4 ua, ub, sa, sb; unpack8(*(const GAS u32x4*)(UU + (size_t)(r0 + i) * HF + c8), ua, ub); unpack8(*(const GAS u32x4*)(SBb + (size_t)(r0 + i) * HF + c8), sa, sb);
        const f32x4 oa = sa * (w0a * um2a + w1a * um1a + w2a * ua), ob = sb * (w0b * um2b + w1b * um1b + w2b * ub);
        *(GAS u32x4*)(A2 + (size_t)(r0 + i) * D + HF + c8) = pack8(oa, ob);
        um2a = um1a; um2b = um1b; um1a = ua; um1b = ub; }
}
__device__ __forceinline__ void p2b_scan(Frame& F) {
    const int gw = F.vcu * NWAVES + F.wave;
    for (int it = gw; it < 2048; it += F.G * NWAVES) {
        const int item = it * 64 + F.lane, bh = item >> 12, e4 = item & 4095, h = bh & 7, d0 = (e4 & 31) * 4;
        const bf16_t* Ub = wsp<bf16_t>(F, WS_UC) + (size_t)bh * 64 * 16384 + e4 * 4; bf16_t* Sb = wsp<bf16_t>(F, WS_SS) + (size_t)bh * 64 * 16384 + e4 * 4;
        const float* Db = wsp<float>(F, WS_DEC) + (size_t)bh * 64 * 128 + d0;
        f32x4 s; { const u32x2 w = *(const GAS u32x2*)(wsp<bf16_t>(F, WS_UC) + (size_t)(32 * 64 + h) * 16384 + e4 * 4); s = (f32x4){bflo(w.x), bfhi(w.x), bflo(w.y), bfhi(w.y)}; }
#pragma unroll 16
        for (int c = 0; c < 64; ++c) {
            { u32x2 o; o.x = pk2(s[0], s[1]); o.y = pk2(s[2], s[3]); *(GAS u32x2*)(Sb + (size_t)c * 16384) = o; }
            const u32x2 w = *(const GAS u32x2*)(Ub + (size_t)c * 16384);
            const f32x4 g = *(const GAS f32x4*)(Db + c * 128);
            s = g * s + (f32x4){bflo(w.x), bfhi(w.x), bflo(w.y), bfhi(w.y)};
        }
    }
}
struct P2cRegs { f32x2 L[8]; unsigned qw[8]; u32x4 vw[2]; bf16x8 sa[4]; u32x2 gv[4]; };
__device__ __forceinline__ void p2c_load(const Frame& F, int u, P2cRegs& R) {
    const int bh = u >> 6, c = u & 63, b = bh >> 3, h = bh & 7; const size_t row0 = (size_t)b * SEQ + 64 * c;
    const int dp = (F.tid & 63) * 2, t8 = F.tid >> 6, w = F.wave, fr = F.lane & 15, fq = F.lane >> 4;
    const h16_t* Lb = wsp<h16_t>(F, WS_LF) + (row0 + 8 * t8) * HF + h * 128 + dp; const bf16_t* Qb = wsp<bf16_t>(F, WS_QS) + (row0 + 8 * t8) * HF + h * 128 + dp;
#pragma unroll
    for (int i = 0; i < 8; ++i) { const h16x2 lh = *(const GAS h16x2*)(Lb + (size_t)i * HF); R.L[i] = (f32x2){(float)lh.x, (float)lh.y}; R.qw[i] = *(const GAS unsigned*)(Qb + (size_t)i * HF); }
    vt_load(F, wsp<bf16_t>(F, WS_VV), row0, h, R.vw);
    const bf16_t* Sb = wsp<bf16_t>(F, WS_SS) + ((size_t)bh * 64 + c) * 16384 + (16 * w + fr) * 128 + 8 * fq;
#pragma unroll
    for (int ks = 0; ks < 4; ++ks) R.sa[ks] = *(const GAS bf16x8*)(Sb + 32 * ks);
    const bf16_t* GSb = wsp<bf16_t>(F, WS_GS);
#pragma unroll
    for (int tb = 0; tb < 4; ++tb) R.gv[tb] = *(const GAS u32x2*)(GSb + (row0 + 16 * tb + fr) * HF + h * 128 + 16 * w + 4 * fq);
}
__device__ __forceinline__ void p2c_compute(Frame& F, int u, const P2cRegs& R) {
    const int bh = u >> 6, c = u & 63, b = bh >> 3, h = bh & 7; const size_t row0 = (size_t)b * SEQ + 64 * c;
    LAS bf16_t* QPl = (LAS bf16_t*)F.lds; LAS bf16_t* QD = QPl + 64 * QP_; LAS bf16_t* KI = QD + 64 * QP_; LAS bf16_t* VT = KI + 160 * QP_; LAS bf16_t* PL = VT + 128 * KTP;
    LAS float* TOT8 = (LAS float*)(PL + 64 * KTP); LAS float* SSQ = TOT8 + 8 * 128;
    const int dp = (F.tid & 63) * 2, t8 = F.tid >> 6;
    f32x2 L[8], cs[8], q[8]; f32x2 run = (f32x2){0.f, 0.f};
#pragma unroll
    for (int i = 0; i < 8; ++i) { L[i] = R.L[i]; q[i] = (f32x2){bflo(R.qw[i]), bfhi(R.qw[i])}; }
#pragma unroll
    for (int i = 0; i < 8; ++i) { run += L[i]; cs[i] = run; }
    *(LAS f32x2*)(TOT8 + t8 * 128 + dp) = run;
    vt_store(F, R.vw, VT);
    for (int i = F.tid; i < 64 * KTP / 2; i += NTHR) ((LAS unsigned*)PL)[i] = 0u;
    __syncthreads();
    {
        f32x2 pre[9]; pre[0] = (f32x2){0.f, 0.f};
#pragma unroll
        for (int j = 0; j < 8; ++j) pre[j + 1] = pre[j] + *(const LAS f32x2*)(TOT8 + j * 128 + dp);
        f32x2 off = (f32x2){0.f, 0.f};
#pragma unroll
        for (int j = 0; j < 8; ++j) if (j == t8) off = pre[j];
        const int si = t8 >> 1;
        f32x2 st[4];
#pragma unroll
        for (int j = 0; j < 4; ++j) st[j] = pre[2 * j];
        f32x2 sti = st[0];
#pragma unroll
        for (int j = 1; j < 4; ++j) if (j == si) sti = st[j];
#pragma unroll
        for (int i = 0; i < 8; ++i) { const int t = 8 * t8 + i; const f32x2 bc = off + cs[i];
            *(LAS unsigned*)(QPl + t * QP_ + dp) = pk2(q[i].x * __expf(bc.x), q[i].y * __expf(bc.y));
            *(LAS unsigned*)(QD + t * QP_ + dp) = pk2(q[i].x * __expf(bc.x - sti.x), q[i].y * __expf(bc.y - sti.y));
            const f32x2 k = (f32x2){1.f - __expf(L[i].x), 1.f - __expf(L[i].y)};
#pragma unroll
            for (int j = 0; j < 4; ++j) if (j >= si) {
                *(LAS unsigned*)(KI + (8 * j * (j + 1) + t) * QP_ + dp) = pk2(k.x * __expf(fminf(st[j].x - bc.x, 80.f)), k.y * __expf(fminf(st[j].y - bc.y, 80.f))); }
        }
    }
    __syncthreads();
    const int w = F.wave, fr = F.lane & 15, fq = F.lane >> 4;
    for (int bi = w; bi < 10; bi += 8) {
        const int i = bi < 1 ? 0 : bi < 3 ? 1 : bi < 6 ? 2 : 3, j = bi - (i * (i + 1)) / 2;
        f32x4 cacc = (f32x4){0.f, 0.f, 0.f, 0.f};
#pragma unroll
        for (int ks = 0; ks < 4; ++ks) { const bf16x8 a = *(const LAS bf16x8*)(KI + (8 * i * (i + 1) + 16 * j + fr) * QP_ + 32 * ks + 8 * fq), bq = *(const LAS bf16x8*)(QD + (16 * i + fr) * QP_ + 32 * ks + 8 * fq);
            cacc = __builtin_amdgcn_mfma_f32_16x16x32_bf16(a, bq, cacc, 0, 0, 0); }
        if (i == j) {
#pragma unroll
            for (int r = 0; r < 4; ++r) if (4 * fq + r > fr) cacc[r] = 0.f; }
        u32x2 o; o.x = pk2(cacc[0], cacc[1]); o.y = pk2(cacc[2], cacc[3]);
        *(LAS u32x2*)(PL + (16 * i + fr) * KTP + 16 * j + 4 * fq) = o;
    }
    __syncthreads();
    f32x4 acc[4];
#pragma unroll
    for (int tb = 0; tb < 4; ++tb) acc[tb] = (f32x4){0.f, 0.f, 0.f, 0.f};
    {
#pragma unroll
        for (int ks = 0; ks < 4; ++ks)
#pragma unroll
            for (int tb = 0; tb < 4; ++tb) { const bf16x8 bq = *(const LAS bf16x8*)(QPl + (16 * tb + fr) * QP_ + 32 * ks + 8 * fq); acc[tb] = __builtin_amdgcn_mfma_f32_16x16x32_bf16(R.sa[ks], bq, acc[tb], 0, 0, 0); }
#pragma unroll
        for (int ks = 0; ks < 2; ++ks) { const bf16x8 va = *(const LAS bf16x8*)(VT + vt_off(16 * w + fr, 32 * ks + 8 * fq));
#pragma unroll
            for (int tb = 0; tb < 4; ++tb) { const bf16x8 bp = *(const LAS bf16x8*)(PL + (16 * tb + fr) * KTP + 32 * ks + 8 * fq); acc[tb] = __builtin_amdgcn_mfma_f32_16x16x32_bf16(va, bp, acc[tb], 0, 0, 0); } }
    }
#pragma unroll
    for (int tb = 0; tb < 4; ++tb) { float p = (acc[tb][0] * acc[tb][0] + acc[tb][1] * acc[tb][1]) + (acc[tb][2] * acc[tb][2] + acc[tb][3] * acc[tb][3]); p += __shfl_xor(p, 16); p += __shfl_xor(p, 32);
        if (fq == 0) SSQ[w * 64 + 16 * tb + fr] = p; }
    __syncthreads();
    {
        const f32x4 gw4 = *(const f32x4*)(F.gnw + 16 * w + 4 * fq);
        bf16_t* A2 = wsp<bf16_t>(F, WS_A2);
#pragma unroll
        for (int tb = 0; tb < 4; ++tb) { const int t = 16 * tb + fr; float ss = 0.f;
#pragma unroll
            for (int ww = 0; ww < 8; ++ww) ss += SSQ[ww * 64 + t];
            const float rs = rsqrtf(ss * (1.f / 128.f) + EPS);
            const u32x2 gv = R.gv[tb];
            const f32x4 o = acc[tb] * rs * gw4 * (f32x4){bflo(gv.x), bfhi(gv.x), bflo(gv.y), bfhi(gv.y)};
            u32x2 ov; ov.x = pk2(o[0], o[1]); ov.y = pk2(o[2], o[3]);
            *(GAS u32x2*)(A2 + (row0 + t) * D + h * 128 + 16 * w + 4 * fq) = ov; }
    }
    __syncthreads();
}
__device__ __forceinline__ void p2c_units(Frame& F, int c) {
    constexpr int NU = 2048;
    if (c >= NU) return;
    P2cRegs R; p2c_load(F, c, R);
    for (int u = c; u < NU; u += F.G) {
        P2cRegs N; const int un = u + F.G; if (un < NU) p2c_load(F, un, N); else N = R;
        p2c_compute(F, u, R);
        R = N;
    }
}

__device__ __forceinline__ void split8(const f32x4 a, const f32x4 b, bf16x8& hi, bf16x8& lo) {
    u32x4 h, l;
    h.x = cvt_pk_bf16(a[0], a[1]); h.y = cvt_pk_bf16(a[2], a[3]); h.z = cvt_pk_bf16(b[0], b[1]); h.w = cvt_pk_bf16(b[2], b[3]);
    l.x = cvt_pk_bf16(a[0] - bflo(h.x), a[1] - bfhi(h.x)); l.y = cvt_pk_bf16(a[2] - bflo(h.y), a[3] - bfhi(h.y)); l.z = cvt_pk_bf16(b[0] - bflo(h.z), b[1] - bfhi(h.z)); l.w = cvt_pk_bf16(b[2] - bflo(h.w), b[3] - bfhi(h.w));
    hi = __builtin_bit_cast(bf16x8, h); lo = __builtin_bit_cast(bf16x8, l);
}
__device__ __forceinline__ void p5_router(Frame& F) {
    const int fr = F.lane & 15, fq = F.lane >> 4, wq = F.wave & 3, kh = F.wave >> 2;
    LAS float* lg = (LAS float*)(F.lds + F.wave * 4096);
    LAS float* pa = (LAS float*)(F.lds + 32768) + (wq * 64 + F.lane) * 9;
    const bf16_t* DL = wsp<bf16_t>(F, WS_H1); unsigned char* H1B = wsp<unsigned char>(F, WS_H1B); const bf16_t* WH = wsp<bf16_t>(F, WS_WRH); const bf16_t* WL = wsp<bf16_t>(F, WS_WRL);
    for (int it = F.vcu * 4 + wq; it < M / 16; it += F.G * 4) {
        const int row0 = it * 16, kofs = 1024 * kh;
        const float* hp = F.x + (size_t)(row0 + fr) * D + kofs + 8 * fq; const bf16_t* dp_ = DL + (size_t)(row0 + fr) * D + kofs + 8 * fq; unsigned char* qp = H1B + (size_t)(row0 + fr) * D + kofs + 8 * fq;
        const bf16_t* wh0 = WH + (size_t)fr * D + kofs + 8 * fq; const bf16_t* wl0 = WL + (size_t)fr * D + kofs + 8 * fq;
        f32x4 a0 = (f32x4){0.f, 0.f, 0.f, 0.f}, a1 = a0; float ss = 0.f;
#pragma unroll 4
        for (int ks = 0; ks < 32; ++ks) {
            f32x4 xa = *(const GAS f32x4*)(hp + 32 * ks), xb = *(const GAS f32x4*)(hp + 32 * ks + 4); { f32x4 da, db; unpack8(*(const GAS u32x4*)(dp_ + 32 * ks), da, db); xa += da; xb += db; }
            *(GAS u32x2*)(qp + 32 * ks) = pack8_fp8(xa, xb);
            *(GAS u32x4*)((bf16_t*)dp_ + 32 * ks) = pack8(xa, xb);
            ss += (xa[0] * xa[0] + xa[1] * xa[1]) + (xa[2] * xa[2] + xa[3] * xa[3]) + (xb[0] * xb[0] + xb[1] * xb[1]) + (xb[2] * xb[2] + xb[3] * xb[3]);
            bf16x8 xh, xl; split8(xa, xb, xh, xl);
            const bf16x8 bh0 = *(const GAS bf16x8*)(wh0 + 32 * ks), bl0 = *(const GAS bf16x8*)(wl0 + 32 * ks), bh1 = *(const GAS bf16x8*)(wh0 + 16 * D + 32 * ks), bl1 = *(const GAS bf16x8*)(wl0 + 16 * D + 32 * ks);
            a0 = __builtin_amdgcn_mfma_f32_16x16x32_bf16(xh, bh0, a0, 0, 0, 0); a0 = __builtin_amdgcn_mfma_f32_16x16x32_bf16(xh, bl0, a0, 0, 0, 0);
            a0 = __builtin_amdgcn_mfma_f32_16x16x32_bf16(xl, bh0, a0, 0, 0, 0); a0 = __builtin_amdgcn_mfma_f32_16x16x32_bf16(xl, bl0, a0, 0, 0, 0);
            a1 = __builtin_amdgcn_mfma_f32_16x16x32_bf16(xh, bh1, a1, 0, 0, 0); a1 = __builtin_amdgcn_mfma_f32_16x16x32_bf16(xh, bl1, a1, 0, 0, 0);
            a1 = __builtin_amdgcn_mfma_f32_16x16x32_bf16(xl, bh1, a1, 0, 0, 0); a1 = __builtin_amdgcn_mfma_f32_16x16x32_bf16(xl, bl1, a1, 0, 0, 0);
        }
        if (kh == 1) {
#pragma unroll
            for (int r = 0; r < 4; ++r) { pa[r] = a0[r]; pa[4 + r] = a1[r]; }
            pa[8] = ss; }
        __syncthreads();
        if (kh == 0) {
#pragma unroll
            for (int r = 0; r < 4; ++r) { a0[r] += pa[r]; a1[r] += pa[4 + r]; }
            ss += pa[8];
            ss += __shfl_xor(ss, 16); ss += __shfl_xor(ss, 32);
#pragma unroll
            for (int r = 0; r < 4; ++r) { lg[(4 * fq + r) * 33 + fr] = a0[r]; lg[(4 * fq + r) * 33 + 16 + fr] = a1[r]; }
            LDS_WAIT(); asm volatile("" ::: "memory");
            if (F.lane < 16) {
                const int tokn = row0 + F.lane; const float rs = rsqrtf(ss * (1.f / D) + EPS);
                float v[32];
#pragma unroll
                for (int e = 0; e < 32; ++e) v[e] = lg[F.lane * 33 + e] * rs + F.b_r[e];
                int idx[4]; float val[4];
#pragma unroll
                for (int k = 0; k < 4; ++k) { float bv = -3.0e38f; int bi = 0;
#pragma unroll
                    for (int e = 0; e < 32; ++e) { const bool tk = v[e] > bv; bv = tk ? v[e] : bv; bi = tk ? e : bi; }
                    idx[k] = bi; val[k] = bv;
#pragma unroll
                    for (int e = 0; e < 32; ++e) v[e] = (e == bi) ? -3.0e38f : v[e]; }
                float ex[4], den = 0.f;
#pragma unroll
                for (int k = 0; k < 4; ++k) { ex[k] = __expf(val[k] - val[0]); den += ex[k]; }
                const float inv = 1.f / den;
                wsp<float>(F, WS_RS2)[tokn] = rs;
                int pos[4];
#pragma unroll
                for (int k = 0; k < 4; ++k) pos[k] = (int)__hip_atomic_fetch_add(F.ctl + CW_CNT + 64 * idx[k], 1u, __ATOMIC_RELAXED, __HIP_MEMORY_SCOPE_AGENT);
#pragma unroll
                for (int k = 0; k < 4; ++k) {
                    wsp<int>(F, WS_TOPE)[tokn * 4 + k] = idx[k]; wsp<int>(F, WS_TOPP)[tokn * 4 + k] = pos[k]; wsp<float>(F, WS_TOPW)[tokn * 4 + k] = ex[k] * inv;
                    wsp<int>(F, WS_LIST)[(size_t)idx[k] * CAPF + pos[k]] = tokn; }
            }
        }
        __syncthreads();
    }
}
__device__ __forceinline__ void build_pref(Frame& F) {
    if (F.wave == 0) {
        int tl = 0;
        if (F.lane < NE) { const unsigned c = __hip_atomic_load(F.ctl + CW_CNT + 64 * F.lane, RLX_AGENT); tl = (int)((c + 255u) >> 8); }
        int s = tl;
#pragma unroll
        for (int d = 1; d < 32; d <<= 1) { const int v = __shfl_up(s, d); if (F.lane >= d) s += v; }
        if (F.lane < NE) F.MISC[16 + F.lane] = (unsigned)(s - tl);
        if (F.lane == NE - 1) F.MISC[16 + NE] = (unsigned)(s < MAXRT ? s : MAXRT); }
    __syncthreads();
}
__device__ __forceinline__ void build_tok(Frame& F, const MoeOrder& S) {
    LAS int* tokt = (LAS int*)(F.lds + TOK_OFF); LAS bf16_t* bt = (LAS bf16_t*)(F.lds + BIAS_OFF);
    volatile LAS int* um = (volatile LAS int*)(F.MISC + 64);
    if (F.tid < 18) { Unit u; int base = -1, nv = 0, bo = 0;
        if (S.template next<false>(F.tid, u)) { const int rt = u.pm - (int)F.MISC[16 + u.e]; const int cnt = (int)__hip_atomic_load(F.ctl + CW_CNT + 64 * u.e, RLX_AGENT);
            base = u.e * CAPF + rt * 256; nv = cnt - rt * 256; nv = nv < 0 ? 0 : (nv > 256 ? 256 : nv); bo = u.e * 4096 + u.pn * 128; }
        um[4 * F.tid] = base; um[4 * F.tid + 1] = nv; um[4 * F.tid + 2] = bo; }
    __syncthreads();
    if (F.tid < 256) { int t[18]; float r[18]; const int* LIST = wsp<int>(F, WS_LIST); const float* RS2 = wsp<float>(F, WS_RS2);
#pragma unroll
        for (int i = 0; i < 18; ++i) { const int base = um[4 * i], nv = um[4 * i + 1]; t[i] = (base >= 0 && F.tid < nv) ? LIST[base + F.tid] : -1; }
#pragma unroll
        for (int i = 0; i < 18; ++i) r[i] = (t[i] >= 0) ? RS2[t[i]] * W8_INV : 0.f;
#pragma unroll
        for (int i = 0; i < 18; ++i) if (um[4 * i] >= 0) tokt[i * 256 + F.tid] = (int)((f2bf(r[i]) << 16) | (unsigned)(t[i] < 0 ? 0 : t[i])); }
    else {
        const int j = F.tid - 256, col = j < 128 ? j : 2048 + (j - 128); float bq[18];
#pragma unroll
        for (int i = 0; i < 18; ++i) bq[i] = (um[4 * i] >= 0) ? F.b_up[um[4 * i + 2] + col] : 0.f;
#pragma unroll
        for (int i = 0; i < 18; ++i) bt[i * 256 + j] = (bf16_t)f2bf(bq[i]); }
    __syncthreads();
}
__device__ __forceinline__ void build_bias_dn(Frame& F, const MoeOrder& S) {
    LAS float* bt = (LAS float*)(F.lds + TOK_OFF);
    volatile LAS int* um = (volatile LAS int*)(F.MISC + 64);
    if (F.tid < 9) { Unit u; int bo = -1; if (S.template next<false>(F.tid, u)) bo = u.e * D + u.pn * 256; um[F.tid] = bo; }
    __syncthreads();
    if (F.tid < 256) { float bq[9];
#pragma unroll
        for (int i = 0; i < 9; ++i) bq[i] = (um[i] >= 0) ? F.b_dn[um[i] + F.tid] : 0.f;
#pragma unroll
        for (int i = 0; i < 9; ++i) bt[i * 256 + F.tid] = bq[i]; }
    __syncthreads();
}
struct P9Tok { f32x4 v[8]; unsigned y[4][8]; f32x4 tw; };
template <int PM> __device__ __forceinline__ void p9_issue(const Frame& F, int m, P9Tok& T) {
    typedef int i32x4 __attribute__((ext_vector_type(4)));
    const bf16_t* DL = wsp<bf16_t>(F, WS_H1); const unsigned char* YR = wsp<unsigned char>(F, WS_YR);
    const i32x4 te = *(const GAS i32x4*)(wsp<int>(F, WS_TOPE) + m * 4), tp = *(const GAS i32x4*)(wsp<int>(F, WS_TOPP) + m * 4); T.tw = *(const GAS f32x4*)(wsp<float>(F, WS_TOPW) + m * 4);
#pragma unroll
    for (int j = 0; j < 8; ++j) { const u32x2 dw = (PM == 4) ? (u32x2){(unsigned)m, 0u} : *(const GAS u32x2*)(DL + (size_t)m * D + 4 * F.lane + 256 * j);
        T.v[j] = (f32x4){bflo(dw.x), bfhi(dw.x), bflo(dw.y), bfhi(dw.y)}; }
#pragma unroll
    for (int k = 0; k < 4; ++k) { const size_t row = (size_t)((const LAS unsigned*)F.MISC)[16 + te[k]] * 256 + tp[k];
#pragma unroll
        for (int j = 0; j < 8; ++j) T.y[k][j] = (PM == 1) ? (unsigned)row : *(const GAS unsigned*)(YR + row * D + 4 * F.lane + 256 * j); }
}
template <int PM> __device__ __forceinline__ void p9_finish(const Frame& F, int m, P9Tok& T, float* outp) {
#pragma unroll
    for (int k = 0; k < 4; ++k)
#pragma unroll
        for (int j = 0; j < 8; ++j) { const f32x2 p0 = __builtin_amdgcn_cvt_pk_f32_fp8((int)T.y[k][j], false), p1 = __builtin_amdgcn_cvt_pk_f32_fp8((int)T.y[k][j], true); T.v[j] += (f32x4){p0.x, p0.y, p1.x, p1.y} * T.tw[k]; }
    float s = 0.f;
#pragma unroll
    for (int j = 0; j < 8; ++j) s += (T.v[j][0] * T.v[j][0] + T.v[j][1] * T.v[j][1]) + (T.v[j][2] * T.v[j][2] + T.v[j][3] * T.v[j][3]);
    const float rs = rsqrtf(wave_sum(s) * (1.f / D) + EPS);
#pragma unroll
    for (int j = 0; j < 8; ++j) { const f32x4 w = *(const f32x4*)(F.fnw + 4 * F.lane + 256 * j); const f32x4 o = T.v[j] * rs * w;
        if (PM == 2) asm volatile("" :: "v"(o)); else *(GAS f32x4*)(outp + (size_t)m * D + 4 * F.lane + 256 * j) = o; }
}
template <int PM> __device__ __forceinline__ void p9_combine_t(Frame& F, float* outp) {
    const int gw = F.vcu * NWAVES + F.wave, NGW9 = F.G * NWAVES;
    for (int m = gw; m < M; m += 2 * NGW9) {
        const int m2 = m + NGW9; const bool two = m2 < M;
        P9Tok A, B; p9_issue<PM>(F, m, A); p9_issue<PM>(F, two ? m2 : m, B);
        __builtin_amdgcn_sched_barrier(0);
        p9_finish<PM>(F, m, A, outp); if (two) p9_finish<PM>(F, m2, B, outp);
    }
}
__device__ __forceinline__ void p9_combine(Frame& F) { p9_combine_t<0>(F, F.out); }
constexpr int NPH = 11;
struct Args { const float* in[18]; float* out; unsigned char* ws; int ph_lo, ph_hi; };

__global__ void __launch_bounds__(NTHR, 2) fwd_kernel(Args args) {
    extern __shared__ __attribute__((aligned(16))) unsigned char lds_raw[];
    Frame F;
    F.lds = (LAS unsigned char*)lds_raw; F.MISC = (volatile LAS unsigned*)(F.lds + MISC_OFF);
    F.wave = __builtin_amdgcn_readfirstlane((int)threadIdx.x >> 6);
#define REFRESH() do { F.lane = lane_id(); F.tid = F.wave * 64 + F.lane; } while (0)
    REFRESH();
    F.G = gridDim.x; { const int bx = blockIdx.x; F.vcu = (F.G % 8 == 0) ? (bx % 8) * (F.G / 8) + bx / 8 : bx; }
    F.ws = args.ws; F.ctl = (gu32*)(args.ws + WS_CTL); F.out = args.out;
    F.x = args.in[0]; F.meta = args.in[1]; F.nmw = args.in[2]; F.w_in = args.in[3]; F.lbl = args.in[4]; F.gnw = args.in[5]; F.w_ho = args.in[6]; F.cw = args.in[7]; F.w_co = args.in[8]; F.w_o = args.in[9];
    F.nfw = args.in[10]; F.w_r = args.in[11]; F.b_r = args.in[12]; F.w_up = args.in[13]; F.b_up = args.in[14]; F.w_dn = args.in[15]; F.b_dn = args.in[16]; F.fnw = args.in[17];
    for (int u = F.tid; u < 256; u += NTHR) F.MISC[u] = 0u;
    __syncthreads();
    const int lo = args.ph_lo, hi = args.ph_hi;
    const bool multi = (hi - lo) > 1;
    XcdBarrier bar; bar.bar = (unsigned*)(F.ctl + CW_BAR); bar.x = 0; bar.st = nullptr;
    if (multi) bar = xcd_barrier_post((unsigned*)(F.ctl + CW_BAR), F.MISC, F.tid);
#define IN(k) (lo <= (k) && (k) < hi)
#if defined(FK_STAMP_A)
#define STAMP(k) do { if (blockIdx.x == 0 && F.tid == 0) __hip_atomic_store(F.ctl + CW_TS + (k), (unsigned)__builtin_amdgcn_s_memrealtime(), RLX_AGENT); } while (0)
#else
#define STAMP(k) do { } while (0)
#endif
#if defined(FK_PROBE_BAR)
#define SEAM(k) do { REFRESH(); if (IN(k) && IN((k) + 1)) { xcd_barrier(bar, F.tid); xcd_barrier(bar, F.tid); xcd_barrier(bar, F.tid); } STAMP((k) + 1); } while (0)
#else
#define SEAM(k) do { REFRESH(); if (IN(k) && IN((k) + 1)) xcd_barrier(bar, F.tid); STAMP((k) + 1); } while (0)
#endif
    STAMP(0);
    const int c = blockIdx.x;
#ifndef FK_DUP_MASK
#define FK_DUP_MASK 0
#endif
#ifndef FK_DUP_REPS
#define FK_DUP_REPS 1
#endif
#define DUP(k) for (int _rep = 0; _rep < 1 + FK_DUP_REPS * ((FK_DUP_MASK >> (k)) & 1); ++_rep)
#define REDO(k) do { if (((FK_DUP_MASK >> (k)) & 1) && _rep < FK_DUP_REPS) { REFRESH(); xcd_barrier(bar, F.tid); } } while (0)

    if (IN(0)) DUP(0) { p0_prologue(F); REDO(0); } SEAM(0);

    if (IN(1)) DUP(1) {
        constexpr int NCONV_PER8 = 3;
        const int cq = c >> 3; const bool conv = (F.G % 64 == 0) && ((cq & 7) < NCONV_PER8) && (_rep == 0);
        if (F.G % 64 != 0 && _rep == 0) { if (c == 0) p1_convert(F, 0, 1); }
        if (conv) { const int nconv = (F.G / 64) * 8 * NCONV_PER8, rank = ((cq >> 3) * NCONV_PER8 + (cq & 7)) * 8 + (c & 7); p1_convert(F, rank, nconv);
#if defined(FK_PROBE_CONV2)
            __syncthreads(); p1_convert<FK_PROBE_CONV2 - 1>(F, rank, nconv);
#endif
        }
        __syncthreads();
        EpiInproj E{wsp<float>(F, WS_RS1), wsp<float>(F, WS_LB), wsp<bf16_t>(F, WS_QS), wsp<bf16_t>(F, WS_VV), wsp<bf16_t>(F, WS_GS), wsp<bf16_t>(F, WS_UU), wsp<bf16_t>(F, WS_SB), wsp<bf16_t>(F, WS_RT), wsp<bf16_t>(F, WS_GBS), wsp<h16_t>(F, WS_LF), 1.f};
        if (N_INB > 0) {
            GemmDesc g{wsp<bf16_t>(F, WS_XB), wsp<bf16_t>(F, WS_WIN), D, INC / 256};
            DynOrder S; S.init(M, INB_MASK, N_INB, c, (unsigned*)(F.ctl + CW_Q + 64 * (c & 7) + 8 * _rep), F.MISC + 4, F.tid);
            gemm_phase<EpiInproj, DynOrder, false, true, false>(F.lds, g, S, E, nullptr, F.wave); }
        if (N_IN8 > 0) {
            REFRESH(); E.osc = 1.f / W8_SCALE;
            GemmDesc g{(const bf16_t*)wsp<unsigned char>(F, WS_XB8), (const bf16_t*)wsp<unsigned char>(F, WS_WIN8), D, INC / 256};
            DynOrder S; S.init(M, IN8_MASK, N_IN8, c, (unsigned*)(F.ctl + CW_Q + 64 * (c & 7) + 8 * _rep + 4), F.MISC + 6, F.tid);
            gemm_phase<EpiInproj, DynOrder, false, true, true>(F.lds, g, S, E, nullptr, F.wave); }
        REDO(1);
    } SEAM(1);

#if defined(FK_PROBE_GEMM)
    if (IN(1)) {
        GemmDesc g{wsp<bf16_t>(F, WS_XB), wsp<bf16_t>(F, WS_WIN), D, INC / 256}; ProbeOrder S; S.S.init(M, INC, F.G, c); S.mode = FK_PROBE_GEMM & 3; S.c = c;
        EpiDummy E{wsp<bf16_t>(F, WS_ACT), (FK_PROBE_GEMM >> 2) & 1};
        gemm_phase<EpiDummy, ProbeOrder, false, true, false>(F.lds, g, S, E, nullptr, F.wave);
        REFRESH(); xcd_barrier(bar, F.tid);
    }
#endif
    if (IN(2)) DUP(2) { p2a_units(F, c); for (int it = c; it < M / 64; it += F.G) p2a_conv(F, it); REDO(2); } SEAM(2);
    if (IN(3)) DUP(3) { p2b_scan(F); REDO(3); } SEAM(3);
    if (IN(4)) DUP(4) { p2c_units(F, c); REDO(4); } SEAM(4);

    if (IN(5)) DUP(5) {
        GemmDesc g{wsp<bf16_t>(F, WS_A2), wsp<bf16_t>(F, WS_WAB), D, D / 256}; StaticOrder S; S.init(M, D, F.G, c);
        EpiMerge E{wsp<bf16_t>(F, WS_RT), wsp<bf16_t>(F, WS_GBS), wsp<bf16_t>(F, WS_MG)};
        gemm_phase<EpiMerge, StaticOrder, false, true, false>(F.lds, g, S, E, nullptr, F.wave); REDO(5);
    } SEAM(5);

    if (IN(6)) DUP(6) {
        GemmDesc g{wsp<bf16_t>(F, WS_MG), wsp<bf16_t>(F, WS_WO), D, D / 256}; StaticOrder S; S.init(M, D, F.G, c);
        EpiWo E{wsp<bf16_t>(F, WS_H1)};
        gemm_phase<EpiWo, StaticOrder, false, true, false>(F.lds, g, S, E, nullptr, F.wave); REDO(6);
    } SEAM(6);

    if (IN(7)) { p5_router(F); } SEAM(7);

    if (IN(8)) DUP(8) {
        build_pref(F);
        MoeOrder S; S.init(16, F.G, c, (const volatile LAS int*)(F.MISC + 16));
        build_tok(F, S);
        GemmDesc g{wsp<bf16_t>(F, WS_H1B), wsp<bf16_t>(F, WS_WUP), D, 16};
        EpiUp E{wsp<float>(F, WS_RS2), (const LAS int*)(F.lds + TOK_OFF), (const LAS bf16_t*)(F.lds + BIAS_OFF), wsp<unsigned char>(F, WS_ACT)};
        gemm_phase<EpiUp, MoeOrder, true, true, true>(F.lds, g, S, E, (const LAS int*)(F.lds + TOK_OFF), F.wave); REDO(8);
    } SEAM(8);

    if (IN(9)) DUP(9) {
        build_pref(F);
        MoeOrder S; S.init(8, F.G, c, (const volatile LAS int*)(F.MISC + 16));
        GemmDesc g{wsp<bf16_t>(F, WS_ACT), wsp<bf16_t>(F, WS_WDN), DFF, 8};
        build_bias_dn(F, S);
        EpiDown E{(const LAS float*)(F.lds + TOK_OFF), wsp<unsigned char>(F, WS_YR)};
        gemm_phase<EpiDown, MoeOrder, false, true, true>(F.lds, g, S, E, nullptr, F.wave); REDO(9);
    } SEAM(9);

#if defined(FK_PROBE_P8)
    if (IN(10)) {
        build_pref(F);
        ProbeMoe S; S.S.init(8, F.G, c, (const volatile LAS int*)(F.MISC + 16)); S.mode = FK_PROBE_P8 & 3;
        GemmDesc g{wsp<bf16_t>(F, WS_ACT), wsp<bf16_t>(F, WS_WDN), DFF, 8};
        EpiDummy E{wsp<bf16_t>(F, WS_XB), 1};
        for (int r = 0; r < 2; ++r) { gemm_phase<EpiDummy, ProbeMoe, false, true, true>(F.lds, g, S, E, nullptr, F.wave); REFRESH(); xcd_barrier(bar, F.tid); }
    }
#endif
    if (IN(10)) DUP(10) { build_pref(F); p9_combine(F); REDO(10); }
#if defined(FK_PROBE_P9)
    if (IN(10)) { for (int r = 0; r < 4; ++r) { REFRESH(); xcd_barrier(bar, F.tid); p9_combine_t<FK_PROBE_P9 - 1>(F, wsp<float>(F, WS_XB)); } }
#endif
#undef IN
#undef DUP
#undef REDO
#undef SEAM
#undef STAMP
#undef REFRESH
}

inline void launch_fast(hipStream_t stream, void* const* d_in, float* out, unsigned char* ws, int n_launches) {
    static int grid = 0;
    if (grid == 0) {
        int dev = 0, cus = 0, per_cu = 0;
        if (hipGetDevice(&dev) != hipSuccess || hipDeviceGetAttribute(&cus, hipDeviceAttributeMultiprocessorCount, dev) != hipSuccess) { fprintf(stderr, "kernel_launch: device query failed\n"); grid = -1; return; }
        if (hipFuncSetAttribute((const void*)fwd_kernel, hipFuncAttributeMaxDynamicSharedMemorySize, LDS_BYTES) != hipSuccess) { fprintf(stderr, "kernel_launch: hipFuncSetAttribute failed\n"); grid = -1; return; }
        if (hipOccupancyMaxActiveBlocksPerMultiprocessor(&per_cu, (const void*)fwd_kernel, NTHR, LDS_BYTES) != hipSuccess || per_cu < 1) fprintf(stderr, "kernel_launch: note: occupancy query says %d blocks per CU\n", per_cu);
        (void)hipGetLastError();
        grid = cus;
    }
    if (grid < 0) return;
    (void)hipMemsetAsync(ws + WS_CTL, 0, CTL_BYTES, stream);
    Args a{};
    for (int i = 0; i < 18; ++i) a.in[i] = (const float*)d_in[i];
    a.out = out; a.ws = ws;
    for (int li = 0; li < n_launches; ++li) {
        a.ph_lo = (n_launches == 1) ? 0 : li; a.ph_hi = (n_launches == 1) ? NPH : li + 1;
        hipLaunchKernelGGL(fwd_kernel, dim3(grid), dim3(NTHR), LDS_BYTES, stream, a);
        const hipError_t le = hipPeekAtLastError();
        if (le != hipSuccess) { fprintf(stderr, "kernel_launch: launch %d failed: %s\n", li, hipGetErrorName(le)); break; }
    }
}
}
#ifndef FK_LAUNCHES
#define FK_LAUNCHES 1
#endif
extern "C" void kernel_launch(void* const* d_in, const int* in_sizes, int n_in, void* d_out, int out_size, void* d_ws, size_t ws_size, hipStream_t stream) {
    if (n_in != 18 || ws_size < fk::WS_FAST_END) { fprintf(stderr, "kernel_launch: n_in %d, ws %zu < %zu\n", n_in, ws_size, (size_t)fk::WS_FAST_END); return; }
    fk::launch_fast(stream, d_in, (float*)d_out, (unsigned char*)d_ws, FK_LAUNCHES);
}
```

```cpp
#include <hip/hip_runtime.h>
#include <cstdio>
#define FK_LAUNCHES 1
#define FK_IN8_MASK 0xFFFF000F0FFull
#define FK_WO8 0
namespace fk {
#define LAS __attribute__((address_space(3)))
#define GAS __attribute__((address_space(1)))
typedef unsigned short bf16_t;
typedef short bf16x8 __attribute__((ext_vector_type(8)));
typedef float f32x4 __attribute__((ext_vector_type(4)));
typedef float f32x2 __attribute__((ext_vector_type(2)));
typedef unsigned u32x4 __attribute__((ext_vector_type(4)));
typedef unsigned u32x2 __attribute__((ext_vector_type(2)));
typedef GAS unsigned gu32;
typedef _Float16 h16_t;
typedef _Float16 h16x4 __attribute__((ext_vector_type(4)));
typedef _Float16 h16x2 __attribute__((ext_vector_type(2)));
#define RLX_AGENT __ATOMIC_RELAXED, __HIP_MEMORY_SCOPE_AGENT
#define LDS_WAIT() asm volatile("s_waitcnt lgkmcnt(0)" ::: "memory")
#define VM_WAIT() asm volatile("s_waitcnt vmcnt(0)" ::: "memory")

constexpr int D = 2048, NB = 4, SEQ = 4096, M = NB * SEQ, NMETA = 16;
constexpr int HF = 1024, INC = 11264, NE = 32, DFF = 2048, NCH = SEQ / 64;
constexpr int C_Q = 0, C_F = 1024, C_V = 2048, C_G = 3072, C_SV = 4096, C_SB = 5120, C_SC = 6144, C_GA = 7168, C_GB = 9216;
constexpr float EPS = 1e-6f;
constexpr int CAPF = M;
constexpr int MAXRT = 288;
constexpr int NWAVES = 8, NTHR = 512;

constexpr size_t al(size_t x) { return (x + 0xFFFFF) & ~(size_t)0xFFFFF; }
constexpr size_t WS_CTL = 0, CTL_BYTES = 65536;
constexpr size_t WS_LB = 65536, WS_RS1 = WS_LB + 4096, WS_RS2 = WS_RS1 + 65536, WS_WRH = WS_RS2 + 65536, WS_WRL = WS_WRH + 131072;
constexpr size_t WS_LFM = WS_WRL + 131072, WS_VVM = WS_LFM + 64 * 1024 * 4, WS_UUM = WS_VVM + 64 * 1024 * 2, WS_SMALL_END = WS_UUM + 16 * 1024 * 2;
constexpr size_t WS_TOPE = al(WS_SMALL_END), WS_TOPP = WS_TOPE + (size_t)M * 16, WS_TOPW = WS_TOPP + (size_t)M * 16, WS_LIST = WS_TOPW + (size_t)M * 16;
constexpr size_t WS_DEC = al(WS_LIST + (size_t)NE * CAPF * 4);
constexpr size_t WS_WIN = al(WS_DEC + (size_t)33 * 64 * 128 * 4);
constexpr size_t WS_WAB = al(WS_WIN + (size_t)INC * D * 2);
constexpr size_t WS_WO = al(WS_WAB + (size_t)D * D * 2);
constexpr size_t WS_WUP = al(WS_WO + (size_t)D * D * 2);
constexpr size_t WS_WDN = al(WS_WUP + (size_t)NE * 4096 * D);
constexpr size_t WS_XB = al(WS_WDN + (size_t)NE * D * DFF);
constexpr size_t WS_QS = al(WS_XB + (size_t)M * D * 2);
constexpr size_t WS_LF = al(WS_QS + (size_t)M * HF * 2);
constexpr size_t WS_VV = al(WS_LF + (size_t)M * HF * 2);
constexpr size_t WS_GS = al(WS_VV + (size_t)M * HF * 2);
constexpr size_t WS_UU = al(WS_GS + (size_t)M * HF * 2);
constexpr size_t WS_SB = al(WS_UU + (size_t)M * HF * 2);
constexpr size_t WS_RT = al(WS_SB + (size_t)M * HF * 2);
constexpr size_t WS_GBS = al(WS_RT + (size_t)M * D * 2);
constexpr size_t WS_UC = al(WS_GBS + (size_t)M * D * 2);
constexpr size_t WS_SS = al(WS_UC + (size_t)(32 * 64 + 8) * 16384 * 2);
constexpr size_t WS_A2 = al(WS_SS + (size_t)32 * 64 * 16384 * 2);
constexpr size_t WS_MG = al(WS_A2 + (size_t)M * D * 2);
constexpr size_t WS_H1 = al(WS_MG + (size_t)M * D * 2);
constexpr size_t WS_H1B = al(WS_H1 + (size_t)M * D * 2);
constexpr size_t WS_ACT = al(WS_H1B + (size_t)M * D);
constexpr size_t WS_YR = al(WS_ACT + (size_t)MAXRT * 256 * DFF);
constexpr size_t WS_WIN8 = al(WS_YR + (size_t)MAXRT * 256 * D);
constexpr size_t WS_XB8 = al(WS_WIN8 + (size_t)INC * D);
constexpr size_t WS_FAST_END = al(WS_XB8 + (size_t)M * D);
#ifndef FK_IN8_MASK
#define FK_IN8_MASK 0xFFFF00000F0ull
#endif
constexpr unsigned long long IN8_MASK = FK_IN8_MASK;
constexpr unsigned long long INB_MASK = ((1ull << 44) - 1) & ~IN8_MASK;
constexpr int cpop(unsigned long long m) { int n = 0; while (m) { m &= m - 1; ++n; } return n; }
constexpr int N_IN8 = cpop(IN8_MASK), N_INB = 44 - N_IN8;
__device__ __forceinline__ int nth_bit(unsigned long long m, int n) { for (int i = 0; i < n; ++i) m &= m - 1; return __builtin_ctzll(m); }
constexpr int CW_TMO = 0;
constexpr int CW_CNT = 1024;
constexpr int CW_Q = 3400;
constexpr int CW_TS = 3200;
constexpr int CW_BAR = 4096;
constexpr int RING_BYTES = 131072;
constexpr int TOK_OFF = RING_BYTES, TOK_BYTES = 18 * 1024;
constexpr int MISC_OFF = TOK_OFF + TOK_BYTES;
constexpr int BIAS_OFF = MISC_OFF + 1024, BIAS_BYTES = 18 * 512;
constexpr int LDS_BYTES = BIAS_OFF + BIAS_BYTES;
static_assert(LDS_BYTES <= 160 * 1024, "LDS");

__device__ __forceinline__ float sigmoidf_(float x) { return 1.f / (1.f + __expf(-x)); }
__device__ __forceinline__ unsigned f2bf(float f) { unsigned u = __builtin_bit_cast(unsigned, f); return (u + 0x7fffu + ((u >> 16) & 1u)) >> 16; }
__device__ __forceinline__ unsigned pk2(float lo, float hi) { return f2bf(lo) | (f2bf(hi) << 16); }
__device__ __forceinline__ float bf2f(unsigned short b) { return __builtin_bit_cast(float, ((unsigned)b) << 16); }
__device__ __forceinline__ float bflo(unsigned w) { return __builtin_bit_cast(float, w << 16); }
__device__ __forceinline__ float bfhi(unsigned w) { return __builtin_bit_cast(float, w & 0xffff0000u); }
__device__ __forceinline__ unsigned cvt_pk_bf16(float lo, float hi) { unsigned r; asm volatile("v_cvt_pk_bf16_f32 %0, %1, %2" : "=v"(r) : "v"(lo), "v"(hi)); return r; }
__device__ __forceinline__ unsigned pk4_fp8(float a, float b, float c, float d) { int w = 0; w = __builtin_amdgcn_cvt_pk_fp8_f32(a, b, w, false); w = __builtin_amdgcn_cvt_pk_fp8_f32(c, d, w, true); return (unsigned)w; }
constexpr float W8_SCALE = 64.f, W8_INV = 1.f / 64.f;
__device__ __forceinline__ int lane_id() { int l; asm volatile("v_mbcnt_lo_u32_b32 %0, -1, 0\n\tv_mbcnt_hi_u32_b32 %0, -1, %0" : "=v"(l)); return l; }
__device__ __forceinline__ float wave_sum(float v) {
#pragma unroll
    for (int o = 1; o < 64; o <<= 1) v += __shfl_xor(v, o);
    return v;
}

#define XB_TMO      128
#define XB_XCNT(j)  (256  + 64 * (j))
#define XB_XSUB(j)  (1280 + 64 * (j))
#define XB_XGEN(j)  (2304 + 64 * (j))
#define XB_TOP      3328
#define XB_TOPGEN   3392
#define XCD_BAR_WORDS 3456
#define XB_SPIN_CAP (1u << 18)
__device__ __forceinline__ unsigned xb_ld(unsigned* p)              { return __hip_atomic_load(p, __ATOMIC_RELAXED, __HIP_MEMORY_SCOPE_AGENT); }
__device__ __forceinline__ unsigned xb_add(unsigned* p, unsigned v) { return __hip_atomic_fetch_add(p, v, __ATOMIC_RELAXED, __HIP_MEMORY_SCOPE_AGENT); }
__device__ __forceinline__ unsigned xb_xcc_id() { return (unsigned)__builtin_amdgcn_s_getreg((3 << 11) | 20) & 0xFu; }
#define XB_SPIN(cond, bar) do { unsigned _sp = 0; while (cond) { __builtin_amdgcn_s_sleep(1); \
    if ((++_sp & 255u) == 0u) { if (xb_ld(&(bar)[XB_TMO])) break; if (_sp > XB_SPIN_CAP) { atomicAdd(&(bar)[XB_TMO], 1u); break; } } } } while (0)
struct XcdBarrier { unsigned* bar; unsigned x; volatile LAS unsigned* st; };
__device__ __forceinline__ XcdBarrier xcd_barrier_post(unsigned* bar, volatile LAS unsigned* st, int tid) {
    XcdBarrier b; b.bar = bar; b.x = xb_xcc_id(); b.st = st;
    if (tid == 0) (void)xb_add(&bar[XB_XCNT(b.x)], 1u);
    return b;
}
__device__ __forceinline__ void xcd_barrier_complete(unsigned* bar, unsigned x, unsigned& nloc, unsigned& nx) {
    const unsigned G = gridDim.x * gridDim.y * gridDim.z;
    unsigned sum, cnt, mine, sp = 0u;
    for (;;) {
        sum = 0u; cnt = 0u; mine = 0u;
#pragma unroll
        for (unsigned j = 0; j < 16; ++j) { const unsigned c = xb_ld(&bar[XB_XCNT(j)]); sum += c; cnt += (c > 0u) ? 1u : 0u; mine = (j == x) ? c : mine; }
        if (sum == G) break;
        __builtin_amdgcn_s_sleep(1);
        if ((++sp & 255u) == 0u) { if (xb_ld(&bar[XB_TMO])) break; if (sp > XB_SPIN_CAP) { atomicAdd(&bar[XB_TMO], 1u); break; } }
    }
    nloc = mine > 0u ? mine : 1u; nx = cnt > 0u ? cnt : 1u;
}
__device__ __forceinline__ void xcd_barrier(const XcdBarrier& b, int tid) {
    asm volatile("s_waitcnt vmcnt(0)" ::: "memory");
    __syncthreads();
    if (tid == 0) {
        unsigned* bar = b.bar;
        __builtin_amdgcn_s_waitcnt(0);
        unsigned nloc = b.st[0], nx = b.st[1];
        if (nloc == 0u) { xcd_barrier_complete(bar, b.x, nloc, nx); b.st[0] = nloc; b.st[1] = nx; }
        const unsigned old = xb_add(&bar[XB_XSUB(b.x)], 1u);
        const unsigned gen = old / nloc;
        if (old + 1u == (gen + 1u) * nloc) {
            __builtin_amdgcn_fence(__ATOMIC_RELEASE, "agent");
            asm volatile("s_waitcnt vmcnt(0)" ::: "memory");
            const unsigned og = xb_add(&bar[XB_TOP], 1u);
            const unsigned tg = og / nx;
            if (og + 1u == (tg + 1u) * nx) xb_add(&bar[XB_TOPGEN], 1u);
            else XB_SPIN(xb_ld(&bar[XB_TOPGEN]) == tg, bar);
            __builtin_amdgcn_fence(__ATOMIC_ACQUIRE, "agent");
            xb_add(&bar[XB_XGEN(b.x)], 1u);
            asm volatile("s_waitcnt vmcnt(0)" ::: "memory");
        } else {
            XB_SPIN(xb_ld(&bar[XB_XGEN(b.x)]) == gen, bar);
            __builtin_amdgcn_fence(__ATOMIC_ACQUIRE, "agent");
            asm volatile("s_waitcnt vmcnt(0)" ::: "memory");
        }
    }
    __syncthreads();
}

constexpr int BM = 256, BK = 64, HALF = 128, HTB = HALF * BK * 2, NXCD = 8, WGM = 8;
__host__ __device__ __forceinline__ int lds_byte(int r, int c) { const int st = (r >> 4) * 2 + (c >> 5), rr = r & 15, cc = c & 31, ob = rr * 64 + cc * 2; return st * 1024 + (ob ^ (((ob >> 9) & 1) << 5)); }
__host__ __device__ __forceinline__ void stage_rc(int b, int& R, int& C) { const int st = b / 1024, sb = b % 1024, swz = sb ^ (((sb >> 9) & 1) << 5); R = (st >> 1) * 16 + swz / 64; C = (st & 1) * 32 + (swz % 64) / 2; }
__host__ __device__ __forceinline__ int perm32(int rho) { const int n = rho >> 4, i = rho & 15; return 8 * (i >> 2) + 4 * n + (i & 3); }

typedef int i32x8 __attribute__((ext_vector_type(8)));
typedef int i32x4v __attribute__((ext_vector_type(4)));
__device__ __forceinline__ i32x8 cat8(const bf16x8 a, const bf16x8 b) { const i32x4v x = __builtin_bit_cast(i32x4v, a), y = __builtin_bit_cast(i32x4v, b); return __builtin_shufflevector(x, y, 0, 1, 2, 3, 4, 5, 6, 7); }
__device__ __forceinline__ void mfma8(f32x4& acc, const i32x8 a, const i32x8 b, const int sc) {
    asm volatile("s_nop 1\n\tv_mfma_scale_f32_16x16x128_f8f6f4 %0, %1, %2, %0, %3, %3 op_sel_hi:[0,0,0]" : "+v"(acc) : "v"(a), "v"(b), "v"(sc));
}
struct Unit { int pm, pn, e, ui; };

struct StaticOrder {
    int nM, nN, nwg, G, c;
    __device__ void init(int M_, int N_, int G_, int c_) { nM = M_ / BM; nN = N_ / BM; nwg = nM * nN; G = G_; c = c_; }
    __device__ __forceinline__ bool next(int i, Unit& u) const {
        const long L = (long)i * G + c; if (L >= nwg) return false;
        int wgid = (int)L; { const int q = nwg / NXCD, r = nwg % NXCD, xcd = wgid % NXCD, off = wgid / NXCD; wgid = (xcd < r ? xcd * (q + 1) : r * (q + 1) + (xcd - r) * q) + off; }
        const int nig = WGM * nN, gid = wgid / nig, fm = gid * WGM, gsz = (nM - fm) < WGM ? (nM - fm) : WGM;
        u.pm = fm + ((wgid % nig) % gsz); u.pn = (wgid % nig) / gsz; u.e = 0; u.ui = i; return true;
    }
};
struct DynOrder {
    int nM, nN, nwg, x; unsigned* head; volatile LAS unsigned* slot; int tid; unsigned long long mask;
    __device__ void init(int M_, unsigned long long mask_, int nN_, int c_, unsigned* head_, volatile LAS unsigned* slot_, int tid_) { nM = M_ / BM; nN = nN_; mask = mask_; nwg = nM * nN; x = c_ & 7; head = head_; slot = slot_; tid = tid_; }
    __device__ __forceinline__ bool next(int i, Unit& u) const {
        if (tid == 0) slot[i & 1] = __hip_atomic_fetch_add(head, 1u, __ATOMIC_RELAXED, __HIP_MEMORY_SCOPE_AGENT);
        asm volatile("s_waitcnt lgkmcnt(0)" ::: "memory"); __builtin_amdgcn_s_barrier(); asm volatile("" ::: "memory");
        const int j = (int)slot[i & 1], q = nwg / NXCD;
        if (j >= q) return false;
        const int wgid = x * q + j;
        const int nig = WGM * nN, gid = wgid / nig, fm = gid * WGM, gsz = (nM - fm) < WGM ? (nM - fm) : WGM;
        u.pm = fm + ((wgid % nig) % gsz); u.pn = nth_bit(mask, (wgid % nig) / gsz); u.e = 0; u.ui = i; return true;
    }
};
struct MoeOrder {
    int nct, NT, G, c; const volatile LAS int* pref;
    __device__ void init(int nct_, int G_, int c_, const volatile LAS int* pref_) { nct = nct_; G = G_; c = c_; pref = pref_; NT = pref_[NE]; }
    template <bool UNIFORM = true> __device__ __forceinline__ bool next(int i, Unit& u) const {
        int rtg, pn;
        if (G == 256) { const int x = c & 7, jj = c >> 3;
            if (nct == 16) { rtg = 16 * i + 8 * (x & 1) + (jj & 7); pn = 4 * (x >> 1) + (jj >> 3); }
            else           { rtg = 32 * i + 8 * (x & 3) + (jj & 7); pn = 4 * (x >> 2) + (jj >> 3); } }
        else { const int U = i * G + c; rtg = U / nct; pn = U - rtg * nct; }
        if (rtg >= NT) return false;
        u.pn = pn; u.pm = rtg; u.ui = i;
        int e = 0;
        if constexpr (UNIFORM) { const int l = lane_id(); const int pv = (l >= 1 && l < NE) ? pref[l] : 0x7fffffff; e = (int)__builtin_popcountll(__ballot(pv <= rtg)); }
        else {
#pragma unroll 1
            for (int j = 1; j < NE; ++j) e = (pref[j] <= rtg) ? j : e; }
        u.e = e; return true;
    }
};

struct GemmDesc { const bf16_t* A; const bf16_t* Bt; int K; int nct; };

template <class Epi, class Sched, bool GATHER, bool ALIGN_EPI, bool FP8>
__device__ __forceinline__ void gemm_phase(LAS unsigned char* lds, const GemmDesc g, const Sched& S, const Epi& E, const LAS int* tok, int wid) {
    const int lane = lane_id(), tid = wid * 64 + lane, wr = wid >> 2, wc = wid & 3, fr = lane & 15, fq = lane >> 4;
    const int K = g.K, KB = FP8 ? K : 2 * K  , nt = FP8 ? K / 128 : K / BK;
    int Rl[2], Cl[2];
    unsigned voffA[2], voffB[2];
#pragma unroll
    for (int i = 0; i < 2; ++i) { int Cc; stage_rc(tid * 16 + i * 8192, Rl[i], Cc); const int p = Cc >> 3; Cl[i] = FP8 ? 16 * (2 * (p & 3) + (p >> 2)) : 2 * Cc; voffA[i] = (unsigned)(Rl[i] * KB + Cl[i]); voffB[i] = voffA[i]; }
    const size_t kstep = (size_t)(BK * 2);
    const size_t hstep = (size_t)HALF * KB;
    const size_t tstep = 2 * hstep;
    const unsigned ldsw = (unsigned)wid * 1024u;
    const int aoff = lds_byte(wr * 64 + fr, fq * 8), boff = lds_byte(wc * 32 + fr, fq * 8);
#define PG8_SA(b, h) (((b) * 2 + (h)) * HTB)
#define PG8_SB(b, h) ((4 + (b) * 2 + (h)) * HTB)
#define PG8_STAGE(bufoff, gbase, voff) do { _Pragma("unroll") for (int _i = 0; _i < 2; ++_i) \
        __builtin_amdgcn_global_load_lds((const unsigned*)((const char*)(gbase) + (voff)[_i]), (LAS unsigned*)(lds + (bufoff) + ldsw + _i * 8192), 16, 0, 0); } while (0)
#define PG8_STAGE_A(bufoff, ptr, half, o0, o1) do { if constexpr (GATHER) { PG8_STAGE(bufoff, ptr, (half) ? o1 : o0); } else { PG8_STAGE(bufoff, (ptr) + (half) * hstep, voffA); } } while (0)
#define PG8_LDA(dst, b, h) do { _Pragma("unroll") for (int m = 0; m < 4; ++m) _Pragma("unroll") for (int k = 0; k < 2; ++k) dst[m][k] = *(const LAS bf16x8*)(lds + PG8_SA(b, h) + aoff + m * 2048 + k * 1024); } while (0)
#define PG8_LDB(dst, b, h) do { _Pragma("unroll") for (int n = 0; n < 2; ++n) _Pragma("unroll") for (int k = 0; k < 2; ++k) dst[n][k] = *(const LAS bf16x8*)(lds + PG8_SB(b, h) + boff + n * 2048 + k * 1024); } while (0)
#define PG8_MMA(ai, bj, At, Bt) do { __builtin_amdgcn_s_setprio(1); _Pragma("unroll") for (int m = 0; m < 4; ++m) _Pragma("unroll") for (int n = 0; n < 2; ++n) _Pragma("unroll") for (int k = 0; k < 2; ++k) \
        acc[ai][bj][m][n] = __builtin_amdgcn_mfma_f32_16x16x32_bf16(Bt[n][k], At[m][k], acc[ai][bj][m][n], 0, 0, 0); __builtin_amdgcn_s_setprio(0); } while (0)
#define PG8_MMA8(ai, bj, At, Bt) do { __builtin_amdgcn_s_setprio(1); _Pragma("unroll") for (int m = 0; m < 4; ++m) _Pragma("unroll") for (int n = 0; n < 2; ++n) \
        mfma8(acc[ai][bj][m][n], cat8(Bt[n][0], Bt[n][1]), cat8(At[m][0], At[m][1]), sc8); __builtin_amdgcn_s_setprio(0); } while (0)
#define PG8_MM(ai, bj, At, Bt) do { if constexpr (FP8) PG8_MMA8(ai, bj, At, Bt); else PG8_MMA(ai, bj, At, Bt); } while (0)
#define PG8_WAIT_V(n) asm volatile("s_waitcnt vmcnt(" #n ")" ::: "memory")
#define PG8_WAIT_L(n) asm volatile("s_waitcnt lgkmcnt(" #n ")" ::: "memory")
#define PG8_BAR __builtin_amdgcn_s_barrier()
#define PG8_SCHED __builtin_amdgcn_sched_barrier(0)
    Unit cur, nxt; int ui = 0;
    if (!S.next(0, cur)) return;
    const int sc8 = 0x7F7F7F7F;
    f32x4 acc[2][2][4][2];
#pragma unroll
    for (int a = 0; a < 2; ++a)
#pragma unroll
        for (int b = 0; b < 2; ++b)
#pragma unroll
            for (int m = 0; m < 4; ++m)
#pragma unroll
                for (int n = 0; n < 2; ++n) acc[a][b][m][n] = (f32x4){0.f, 0.f, 0.f, 0.f};
    bf16x8 At[4][2], B0[2][2], B1[2][2];
    unsigned vA0[2] = {0u, 0u}, vA1[2] = {0u, 0u}, nA0[2] = {0u, 0u}, nA1[2] = {0u, 0u};
    const char* cA; const char* cB = (const char*)g.Bt + (size_t)(cur.e * g.nct + cur.pn) * tstep;
    if constexpr (GATHER) {
        cA = (const char*)g.A;
#pragma unroll
        for (int i = 0; i < 2; ++i) { vA0[i] = (unsigned)((tok[cur.ui * 256 + Rl[i]] & 0xffff) * KB + Cl[i]); vA1[i] = (unsigned)((tok[cur.ui * 256 + 128 + Rl[i]] & 0xffff) * KB + Cl[i]); nA0[i] = vA0[i]; nA1[i] = vA1[i]; }
    } else cA = (const char*)g.A + (size_t)cur.pm * tstep;
    PG8_STAGE(PG8_SB(0, 0), cB, voffB); PG8_STAGE(PG8_SB(0, 1), cB + hstep, voffB); PG8_STAGE_A(PG8_SA(0, 0), cA, 0, vA0, vA1); PG8_STAGE_A(PG8_SA(0, 1), cA, 1, vA0, vA1);
    if (wr == 1) PG8_BAR;
    PG8_WAIT_V(2); PG8_BAR;
    PG8_STAGE(PG8_SB(1, 0), cB + kstep, voffB); PG8_STAGE_A(PG8_SA(1, 0), cA + kstep, 0, vA0, vA1); PG8_STAGE(PG8_SB(1, 1), cB + hstep + kstep, voffB);
    PG8_WAIT_V(6); PG8_BAR;
    for (;;) {
        const bool has_next = S.next(ui + 1, nxt);
        const char* nAp; const char* nB;
        if (has_next) {
            nB = (const char*)g.Bt + (size_t)(nxt.e * g.nct + nxt.pn) * tstep;
            if constexpr (GATHER) { nAp = cA;
#pragma unroll
                for (int i = 0; i < 2; ++i) { nA0[i] = (unsigned)((tok[nxt.ui * 256 + Rl[i]] & 0xffff) * KB + Cl[i]); nA1[i] = (unsigned)((tok[nxt.ui * 256 + 128 + Rl[i]] & 0xffff) * KB + Cl[i]); }
            } else nAp = (const char*)g.A + (size_t)nxt.pm * tstep;
        } else { nAp = cA; nB = cB; }
        for (int t = 0; t < nt; t += 2) {
            const bool last = (t == nt - 2);
            const char* a1 = cA + (size_t)(t + 1) * kstep;
            const char* a2 = last ? nAp : cA + (size_t)(t + 2) * kstep; const char* b2 = last ? nB : cB + (size_t)(t + 2) * kstep;
            const char* a3 = a2 + kstep; const char* b3 = b2 + kstep;
            unsigned w0[2] = {0u, 0u}, w1[2] = {0u, 0u};
            if constexpr (GATHER) {
#pragma unroll
                for (int i = 0; i < 2; ++i) { w0[i] = last ? nA0[i] : vA0[i]; w1[i] = last ? nA1[i] : vA1[i]; } }
            if constexpr (Epi::MIDHOOK) { if (t == nt / 2) E.mid(acc, cur, wr, wc, fr, fq); }
            PG8_LDB(B0, 0, 0); PG8_LDB(B1, 0, 1); PG8_SCHED; PG8_LDA(At, 0, 0); PG8_STAGE_A(PG8_SA(1, 1), a1, 1, vA0, vA1);
            PG8_WAIT_V(8); PG8_WAIT_L(0); PG8_BAR; PG8_MM(0, 0, At, B0); PG8_MM(0, 1, At, B1); PG8_BAR; PG8_SCHED;
            PG8_LDA(At, 0, 1); PG8_STAGE(PG8_SB(0, 0), b2, voffB); PG8_STAGE(PG8_SB(0, 1), b2 + hstep, voffB); PG8_STAGE_A(PG8_SA(0, 0), a2, 0, w0, w1);
            PG8_WAIT_V(8); PG8_WAIT_L(0); PG8_BAR; PG8_MM(1, 0, At, B0); PG8_MM(1, 1, At, B1); PG8_BAR; PG8_SCHED;
            PG8_LDB(B0, 1, 0); PG8_LDB(B1, 1, 1); PG8_SCHED; PG8_LDA(At, 1, 0); PG8_STAGE_A(PG8_SA(0, 1), a2, 1, w0, w1);
            PG8_WAIT_V(8); PG8_WAIT_L(0); PG8_BAR; PG8_MM(0, 0, At, B0); PG8_MM(0, 1, At, B1); PG8_BAR; PG8_SCHED;
            PG8_LDA(At, 1, 1); PG8_STAGE(PG8_SB(1, 0), b3, voffB); PG8_STAGE(PG8_SB(1, 1), b3 + hstep, voffB); PG8_STAGE_A(PG8_SA(1, 0), a3, 0, w0, w1);
            PG8_WAIT_V(8); PG8_WAIT_L(0); PG8_BAR; PG8_MM(1, 0, At, B0); PG8_MM(1, 1, At, B1); PG8_BAR; PG8_SCHED;
        }
        if constexpr (ALIGN_EPI) { if (wr == 0) PG8_BAR; }
        E(acc, cur, wr, wc, fr, fq);
        if (!has_next) break;
#pragma unroll
        for (int a = 0; a < 2; ++a)
#pragma unroll
            for (int b = 0; b < 2; ++b)
#pragma unroll
                for (int m = 0; m < 4; ++m)
#pragma unroll
                    for (int n = 0; n < 2; ++n) acc[a][b][m][n] = (f32x4){0.f, 0.f, 0.f, 0.f};
        cur = nxt; cA = nAp; cB = nB; ++ui;
        if constexpr (GATHER) {
#pragma unroll
            for (int i = 0; i < 2; ++i) { vA0[i] = nA0[i]; vA1[i] = nA1[i]; } }
        if constexpr (ALIGN_EPI) { if (wr == 1) PG8_BAR; }
    }
    PG8_WAIT_V(0);
    if constexpr (!ALIGN_EPI) { if (wr == 0) PG8_BAR; }
    PG8_BAR;
#undef PG8_SA
#undef PG8_SB
#undef PG8_STAGE
#undef PG8_STAGE_A
#undef PG8_LDA
#undef PG8_LDB
#undef PG8_MMA
#undef PG8_MMA8
#undef PG8_MM
#undef PG8_WAIT_V
#undef PG8_WAIT_L
#undef PG8_BAR
#undef PG8_SCHED
}
typedef f32x4 Acc[2][2][4][2];
__device__ __forceinline__ float silu_(float x) { return x * __builtin_amdgcn_rcpf(1.f + __expf(-x)); }
__device__ __forceinline__ float sigm_(float x) { return __builtin_amdgcn_rcpf(1.f + __expf(-x)); }
__device__ __forceinline__ u32x4 pack8(const f32x4 a, const f32x4 b) { u32x4 w; w.x = cvt_pk_bf16(a[0], a[1]); w.y = cvt_pk_bf16(a[2], a[3]); w.z = cvt_pk_bf16(b[0], b[1]); w.w = cvt_pk_bf16(b[2], b[3]); return w; }
__device__ __forceinline__ u32x2 pack8_fp8(const f32x4 a, const f32x4 b) { u32x2 w; w.x = pk4_fp8(a[0], a[1], a[2], a[3]); w.y = pk4_fp8(b[0], b[1], b[2], b[3]); return w; }
__device__ __forceinline__ void unpack8(const u32x4 w, f32x4& a, f32x4& b) { a = (f32x4){bflo(w.x), bfhi(w.x), bflo(w.y), bfhi(w.y)}; b = (f32x4){bflo(w.z), bfhi(w.z), bflo(w.w), bfhi(w.w)}; }

struct EpiInproj {
    static constexpr bool MIDHOOK = false;
    const float* rs1; const float* lb; bf16_t *QS, *VV, *GS, *UU, *SBb, *RT, *GBS; h16_t* LF; float osc;
    __device__ __forceinline__ void mid(Acc&, const Unit&, int, int, int, int) const {}
    template <int ACT> __device__ __forceinline__ void plain(const Acc& acc, const float (&rs)[2][4], bf16_t* O, int pt, int row0, int wc, int fq) const {
#pragma unroll
        for (int ai = 0; ai < 2; ++ai)
#pragma unroll
            for (int m = 0; m < 4; ++m) { bf16_t* rowp = O + (size_t)(row0 + ai * HALF + m * 16) * HF + pt * 256 + wc * 32 + 8 * fq; const float r = rs[ai][m];
#pragma unroll
                for (int bj = 0; bj < 2; ++bj) { f32x4 v0 = acc[ai][bj][m][0] * r, v1 = acc[ai][bj][m][1] * r;
                    if (ACT == 1) {
#pragma unroll
                        for (int j = 0; j < 4; ++j) { v0[j] = silu_(v0[j]); v1[j] = silu_(v1[j]); } }
                    *(u32x4*)(rowp + bj * HALF) = pack8(v0, v1); } }
    }
    __device__ __forceinline__ void operator()(const Acc& acc, const Unit& u, int wr, int wc, int fr, int fq) const {
        const int row0 = u.pm * BM + wr * 64 + fr, pn = u.pn;
        float rs[2][4];
#pragma unroll
        for (int ai = 0; ai < 2; ++ai)
#pragma unroll
            for (int m = 0; m < 4; ++m) rs[ai][m] = osc;
        if (pn < 4) plain<1>(acc, rs, QS, pn, row0, wc, fq);
        else if (pn < 8) {
            const int c0 = (pn - 4) * 256 + wc * 32 + 4 * fq;
            f32x4 lbv[2][2];
#pragma unroll
            for (int bj = 0; bj < 2; ++bj)
#pragma unroll
                for (int n = 0; n < 2; ++n) lbv[bj][n] = *(const f32x4*)(lb + c0 + bj * HALF + n * 16);
#pragma unroll
            for (int ai = 0; ai < 2; ++ai)
#pragma unroll
                for (int m = 0; m < 4; ++m) { h16_t* rowp = LF + (size_t)(row0 + ai * HALF + m * 16) * HF + c0; const float r = rs[ai][m];
#pragma unroll
                    for (int bj = 0; bj < 2; ++bj)
#pragma unroll
                        for (int n = 0; n < 2; ++n) { f32x4 v = acc[ai][bj][m][n] * r; const f32x4 l = lbv[bj][n];
#pragma unroll
                            for (int j = 0; j < 4; ++j) v[j] = __logf(l[j] + (1.f - l[j]) * sigm_(v[j]));
                            *(h16x4*)(rowp + bj * HALF + n * 16) = (h16x4){(h16_t)v[0], (h16_t)v[1], (h16_t)v[2], (h16_t)v[3]}; } }
        }
        else if (pn < 12) plain<0>(acc, rs, VV, pn - 8, row0, wc, fq);
        else if (pn < 16) plain<1>(acc, rs, GS, pn - 12, row0, wc, fq);
        else if (pn < 24) {
            const int c0 = (pn - 16) * 128 + wc * 32 + 8 * fq;
#pragma unroll
            for (int ai = 0; ai < 2; ++ai)
#pragma unroll
                for (int m = 0; m < 4; ++m) { const float r2 = rs[ai][m] * rs[ai][m];
                    const f32x4 v0 = acc[ai][0][m][0] * acc[ai][1][m][0] * r2, v1 = acc[ai][0][m][1] * acc[ai][1][m][1] * r2;
                    *(u32x4*)(UU + (size_t)(row0 + ai * HALF + m * 16) * HF + c0) = pack8(v0, v1); }
        }
        else if (pn < 28) plain<0>(acc, rs, SBb, pn - 24, row0, wc, fq);
        else {
            const int c0 = (pn - 28) * 128 + wc * 32 + 8 * fq;
#pragma unroll
            for (int ai = 0; ai < 2; ++ai)
#pragma unroll
                for (int m = 0; m < 4; ++m) { const float r = rs[ai][m]; f32x4 q0, q1, b0, b1;
#pragma unroll
                    for (int j = 0; j < 4; ++j) { const float ea = 1.f + __expf(-acc[ai][0][m][0][j] * r), eb = 1.f + __expf(-acc[ai][1][m][0][j] * r); b0[j] = __builtin_amdgcn_rcpf(eb); q0[j] = eb * __builtin_amdgcn_rcpf(ea);
                                                  const float fa = 1.f + __expf(-acc[ai][0][m][1][j] * r), fb = 1.f + __expf(-acc[ai][1][m][1][j] * r); b1[j] = __builtin_amdgcn_rcpf(fb); q1[j] = fb * __builtin_amdgcn_rcpf(fa); }
                    const size_t o = (size_t)(row0 + ai * HALF + m * 16) * D + c0;
                    *(u32x4*)(RT + o) = pack8(q0, q1); *(u32x4*)(GBS + o) = pack8(b0, b1); }
        }
    }
};

struct EpiMerge {
    static constexpr bool MIDHOOK = true;
    const bf16_t *RT, *GBS; bf16_t* MG;
    __device__ __forceinline__ void mid(Acc& acc, const Unit& u, int wr, int wc, int fr, int fq) const {
        unsigned o0 = ((unsigned)(u.pm * BM + wr * 64 + fr) * D + (unsigned)(u.pn * BM + wc * 32 + 8 * fq)) * 2u;
        asm volatile("" : "+v"(o0));
#pragma unroll
        for (int ai = 0; ai < 2; ++ai)
#pragma unroll
            for (int m = 0; m < 4; ++m)
#pragma unroll
                for (int bj = 0; bj < 2; ++bj) { const u32x4 w = *(const GAS u32x4*)((const GAS char*)RT + (o0 + (unsigned)((ai * HALF + m * 16) * D + bj * HALF) * 2u)); f32x4 a, b; unpack8(w, a, b);
                    acc[ai][bj][m][0] *= a; acc[ai][bj][m][1] *= b; }
    }
    __device__ __forceinline__ void operator()(const Acc& acc, const Unit& u, int wr, int wc, int fr, int fq) const {
        unsigned o0 = ((unsigned)(u.pm * BM + wr * 64 + fr) * D + (unsigned)(u.pn * BM + wc * 32 + 8 * fq)) * 2u;
        asm volatile("" : "+v"(o0));
#pragma unroll
        for (int ai = 0; ai < 2; ++ai)
#pragma unroll
            for (int m = 0; m < 4; ++m)
#pragma unroll
                for (int bj = 0; bj < 2; ++bj) { const unsigned o = o0 + (unsigned)((ai * HALF + m * 16) * D + bj * HALF) * 2u; const u32x4 w = *(const GAS u32x4*)((const GAS char*)GBS + o); f32x4 a, b; unpack8(w, a, b);
                    *(GAS u32x4*)((GAS char*)MG + o) = pack8(acc[ai][bj][m][0] * a, acc[ai][bj][m][1] * b); if (bj == 1 && m == 3) asm volatile("" ::: "memory"); }
    }
};

struct EpiWo {
    static constexpr bool MIDHOOK = false;
    bf16_t* DL;
    __device__ __forceinline__ void mid(Acc&, const Unit&, int, int, int, int) const {}
    __device__ __forceinline__ void operator()(const Acc& acc, const Unit& u, int wr, int wc, int fr, int fq) const {
        const int row0 = u.pm * BM + wr * 64 + fr, c0 = u.pn * BM + wc * 32 + 8 * fq;
#pragma unroll
        for (int ai = 0; ai < 2; ++ai)
#pragma unroll
            for (int m = 0; m < 4; ++m)
#pragma unroll
                for (int bj = 0; bj < 2; ++bj) *(u32x4*)(DL + (size_t)(row0 + ai * HALF + m * 16) * D + c0 + bj * HALF) = pack8(acc[ai][bj][m][0], acc[ai][bj][m][1]);
    }
};

struct EpiUp {
    static constexpr bool MIDHOOK = false;
    const float* rs2; const LAS int* tok; const LAS bf16_t* bias; unsigned char* ACT;
    __device__ __forceinline__ void mid(Acc&, const Unit&, int, int, int, int) const {}
    __device__ __forceinline__ void operator()(const Acc& acc, const Unit& u, int wr, int wc, int fr, int fq) const {
        const int rl0 = wr * 64 + fr, c0 = u.pn * 128 + wc * 32 + 8 * fq;
        float rs[2][4];
#pragma unroll
        for (int ai = 0; ai < 2; ++ai)
#pragma unroll
            for (int m = 0; m < 4; ++m) rs[ai][m] = __uint_as_float((unsigned)tok[u.ui * 256 + rl0 + ai * HALF + m * 16] & 0xffff0000u);
        const LAS bf16_t* bp = bias + u.ui * 256 + wc * 32 + 8 * fq;
        f32x4 bg0, bg1, bu0, bu1; unpack8(*(const LAS u32x4*)(bp), bg0, bg1); unpack8(*(const LAS u32x4*)(bp + 128), bu0, bu1);
#pragma unroll
        for (int ai = 0; ai < 2; ++ai)
#pragma unroll
            for (int m = 0; m < 4; ++m) { const float r = rs[ai][m]; f32x4 a0, a1;
#pragma unroll
                for (int n = 0; n < 2; ++n)
#pragma unroll
                    for (int jp = 0; jp < 2; ++jp) {
                        const f32x4 ag = acc[ai][0][m][n], au = acc[ai][1][m][n], bgv = n ? bg1 : bg0, buv = n ? bu1 : bu0;
                        f32x2 g = (f32x2){ag[2 * jp], ag[2 * jp + 1]} * r + (f32x2){bgv[2 * jp], bgv[2 * jp + 1]};
                        f32x2 uu = (f32x2){au[2 * jp], au[2 * jp + 1]} * r + (f32x2){buv[2 * jp], buv[2 * jp + 1]};
                        g.x = fminf(g.x, 7.f); g.y = fminf(g.y, 7.f);
                        uu.x = __builtin_amdgcn_fmed3f(uu.x, -7.f, 7.f); uu.y = __builtin_amdgcn_fmed3f(uu.y, -7.f, 7.f);
                        const f32x2 t = g * (-1.702f * 1.44269504f);
                        f32x2 den; den.x = __builtin_amdgcn_exp2f(t.x); den.y = __builtin_amdgcn_exp2f(t.y); den = den + 1.f;
                        f32x2 s; s.x = __builtin_amdgcn_rcpf(den.x); s.y = __builtin_amdgcn_rcpf(den.y);
                        const f32x2 a = (uu + 1.f) * (g * s);
                        if (n == 0) { a0[2 * jp] = a.x; a0[2 * jp + 1] = a.y; } else { a1[2 * jp] = a.x; a1[2 * jp + 1] = a.y; }
                    }
                *(u32x2*)(ACT + (size_t)(u.pm * BM + rl0 + ai * HALF + m * 16) * DFF + c0) = pack8_fp8(a0, a1); }
    }
};

struct EpiDown {
    static constexpr bool MIDHOOK = false;
    const LAS float* bias; unsigned char* YR;
    __device__ __forceinline__ void mid(Acc&, const Unit&, int, int, int, int) const {}
    __device__ __forceinline__ void operator()(const Acc& acc, const Unit& u, int wr, int wc, int fr, int fq) const {
        const int rl0 = wr * 64 + fr, c0 = u.pn * BM + wc * 32 + 8 * fq;
        const LAS float* bp = bias + u.ui * 256 + wc * 32 + 8 * fq;
        f32x4 bv[2][2];
#pragma unroll
        for (int bj = 0; bj < 2; ++bj)
#pragma unroll
            for (int n = 0; n < 2; ++n) bv[bj][n] = *(const LAS f32x4*)(bp + bj * HALF + 4 * n);
#pragma unroll
        for (int ai = 0; ai < 2; ++ai)
#pragma unroll
            for (int m = 0; m < 4; ++m)
#pragma unroll
                for (int bj = 0; bj < 2; ++bj)
                    *(u32x2*)(YR + (size_t)(u.pm * BM + rl0 + ai * HALF + m * 16) * D + c0 + bj * HALF) = pack8_fp8(acc[ai][bj][m][0] * W8_INV + bv[bj][0], acc[ai][bj][m][1] * W8_INV + bv[bj][1]);
    }
};

struct EpiDummy {
    static constexpr bool MIDHOOK = false;
    bf16_t* O; int nostore;
    __device__ __forceinline__ void mid(Acc&, const Unit&, int, int, int, int) const {}
    __device__ __forceinline__ void operator()(const Acc& acc, const Unit& u, int wr, int wc, int fr, int fq) const {
        const int row0 = (u.pm & 63) * BM + wr * 64 + fr, c0 = (u.pn & 7) * BM + wc * 32 + 8 * fq;
        if (nostore) {
#pragma unroll
            for (int ai = 0; ai < 2; ++ai)
#pragma unroll
                for (int m = 0; m < 4; ++m)
#pragma unroll
                    for (int bj = 0; bj < 2; ++bj) asm volatile("" :: "v"(acc[ai][bj][m][0]), "v"(acc[ai][bj][m][1]));
            return; }
#pragma unroll
        for (int ai = 0; ai < 2; ++ai)
#pragma unroll
            for (int m = 0; m < 4; ++m)
#pragma unroll
                for (int bj = 0; bj < 2; ++bj) *(u32x4*)(O + (size_t)(row0 + ai * HALF + m * 16) * D + c0 + bj * HALF) = pack8(acc[ai][bj][m][0], acc[ai][bj][m][1]);
    }
};
struct ProbeOrder {
    StaticOrder S; int mode, c;
    __device__ __forceinline__ bool next(int i, Unit& u) const {
        if (mode == 3) { if (c & 1) return false; StaticOrder H = S; H.G = S.G / 2; H.c = c >> 1; H.nwg = S.nwg / 2; return H.next(i, u); }
        if (!S.next(i, u)) return false; if (mode >= 1) u.pn = 0; if (mode >= 2) u.pm = c & 63; return true; }
};

struct ProbeMoe {
    MoeOrder S; int mode;
    __device__ __forceinline__ bool next(int i, Unit& u) const { if (!S.next(i, u)) return false; if (mode & 1) { u.e = 0; u.pn = 0; } if (mode & 2) u.pm = 0; return true; }
};
struct Frame {
    LAS unsigned char* lds; volatile LAS unsigned* MISC; gu32* ctl; unsigned char* ws;
    int tid, lane, wave, vcu, G;
    const float *x, *meta, *nmw, *w_in, *lbl, *gnw, *w_ho, *cw, *w_co, *w_o, *nfw, *w_r, *b_r, *w_up, *b_up, *w_dn, *b_dn, *fnw; float* out;
};
template <class T> __device__ __forceinline__ T* wsp(const Frame& F, size_t off) { return (T*)(F.ws + off); }

__device__ __forceinline__ void tr_tile(const float* W, int ldw, int k0, int src0, int src1, bool perm0, bool perm1, const float* kscale, bf16_t* dst, int dpitch, int drow0, int dk0, LAS unsigned* T, int lane) {
    const int ln = lane & 15, kr = lane >> 4, srcc = (ln < 8 ? src0 : src1) + 4 * (ln & 7);
    const float* wp = W + (size_t)(k0 + 2 * kr) * ldw + srcc;
    f32x4 va[8], vb[8]; f32x2 sc[8];
#pragma unroll
    for (int s = 0; s < 8; ++s) { va[s] = __builtin_nontemporal_load((const GAS f32x4*)(wp + (size_t)(8 * s) * ldw)); vb[s] = __builtin_nontemporal_load((const GAS f32x4*)(wp + (size_t)(8 * s + 1) * ldw));
        sc[s] = kscale ? *(const GAS f32x2*)(kscale + k0 + 8 * s + 2 * kr) : (f32x2){1.f, 1.f}; }
    __builtin_amdgcn_sched_barrier(0);
#pragma unroll
    for (int s = 0; s < 8; ++s) { const int col = (4 * s + kr) ^ (2 * ln);
#pragma unroll
        for (int i = 0; i < 4; ++i) T[(4 * ln + i) * 32 + col] = cvt_pk_bf16(va[s][i] * sc[s].x, vb[s][i] * sc[s].y); }
    LDS_WAIT(); asm volatile("" ::: "memory");
    const int c = lane & 7;
#pragma unroll
    for (int j = 0; j < 8; ++j) { const int rho = (lane >> 3) + 8 * j, h = rho >> 5, r32 = rho & 31; const bool pm = h ? perm1 : perm0; const int n = h * 32 + (pm ? perm32(r32) : r32);
        u32x4 v = *(const LAS u32x4*)(T + n * 32 + 4 * (c ^ (n >> 3)));
        if ((n >> 2) & 1) v = (u32x4){v.z, v.w, v.x, v.y};
        *(GAS u32x4*)(dst + (size_t)(drow0 + rho) * dpitch + dk0 + k0 + 8 * c) = v; }
    LDS_WAIT(); asm volatile("" ::: "memory");
}
template <int PMODE = 0> __device__ __forceinline__ void tr_tile_fp8(const float* W, int ldw, int k0, int src0, int src1, const float* kscale, unsigned char* dst, int dpitch, int drow0, LAS unsigned* T, int lane, bool perm = true) {
    const int ln = lane & 15, kr = lane >> 4, srcc = (ln < 8 ? src0 : src1) + 4 * (ln & 7);
    f32x4 v[2][4][4];
#pragma unroll
    for (int half = 0; half < 2; ++half) {
        const float* wp = W + (size_t)(k0 + 64 * half + 4 * kr) * ldw + srcc;
#pragma unroll
        for (int s = 0; s < 4; ++s) {
#pragma unroll
            for (int q = 0; q < 4; ++q) v[half][s][q] = __builtin_nontemporal_load((const GAS f32x4*)(wp + (size_t)(16 * s + q) * ldw)); }
    }
    __builtin_amdgcn_sched_barrier(0);
    if (PMODE == 1) {
#pragma unroll
        for (int half = 0; half < 2; ++half)
#pragma unroll
            for (int s = 0; s < 4; ++s)
#pragma unroll
                for (int q = 0; q < 4; ++q) asm volatile("" :: "v"(v[half][s][q]));
        return; }
#pragma unroll
    for (int half = 0; half < 2; ++half)
#pragma unroll
        for (int s = 0; s < 4; ++s) { const int col = (16 * half + 4 * s + kr) ^ (2 * ln);
            const f32x4 sc = kscale ? *(const GAS f32x4*)(kscale + k0 + 64 * half + 16 * s + 4 * kr) * W8_SCALE : (f32x4){W8_SCALE, W8_SCALE, W8_SCALE, W8_SCALE};
#pragma unroll
            for (int i = 0; i < 4; ++i) T[(4 * ln + i) * 32 + col] = pk4_fp8(v[half][s][0][i] * sc[0], v[half][s][1][i] * sc[1], v[half][s][2][i] * sc[2], v[half][s][3][i] * sc[3]); }
    LDS_WAIT(); asm volatile("" ::: "memory");
    const int c = lane & 7;
#pragma unroll
    for (int j = 0; j < 8; ++j) { const int rho = (lane >> 3) + 8 * j, h = rho >> 5, r32 = rho & 31; const int n = h * 32 + (perm ? perm32(r32) : r32);
        u32x4 v4 = *(const LAS u32x4*)(T + n * 32 + 4 * (c ^ (n >> 3)));
        if ((n >> 2) & 1) v4 = (u32x4){v4.z, v4.w, v4.x, v4.y};
        if (PMODE == 2) asm volatile("" :: "v"(v4)); else *(GAS u32x4*)(dst + (size_t)(drow0 + rho) * dpitch + k0 + 16 * c) = v4; }
    LDS_WAIT(); asm volatile("" ::: "memory");
}
__device__ __forceinline__ int win_src(int G, bool& perm) {
    const int pn = G >> 3, gi = G & 7; perm = true;
    if (pn < 4) return C_Q + pn * 256 + gi * 32;
    if (pn < 8) { perm = false; return C_F + (pn - 4) * 256 + gi * 32; }
    if (pn < 12) return C_V + (pn - 8) * 256 + gi * 32;
    if (pn < 16) return C_G + (pn - 12) * 256 + gi * 32;
    if (pn < 24) return (gi < 4 ? C_SV : C_SC) + (pn - 16) * 128 + (gi & 3) * 32;
    if (pn < 28) return C_SB + (pn - 24) * 256 + gi * 32;
    return (gi < 4 ? C_GA : C_GB) + (pn - 28) * 128 + (gi & 3) * 32;
}
__device__ __forceinline__ void p0_prologue(Frame& F) {
    const int gw = F.vcu * NWAVES + F.wave, NGW = F.G * NWAVES, gt = F.vcu * NTHR + F.tid, NGT = F.G * NTHR;
    for (int i = gt; i < HF; i += NGT) wsp<float>(F, WS_LB)[i] = 1.f / (1.f + __expf(F.lbl[HF + i] - F.lbl[i]));
    for (int i = gt; i < D * NE; i += NGT) { const int k = i >> 5, e = i & 31; const float v = F.w_r[i] * F.nfw[k]; const unsigned h = f2bf(v); const float lo = v - bf2f((unsigned short)h);
        wsp<bf16_t>(F, WS_WRH)[e * D + k] = (bf16_t)h; wsp<bf16_t>(F, WS_WRL)[e * D + k] = (bf16_t)f2bf(lo); }
    for (int i = gt; i < 48 * HF; i += NGT) { wsp<h16_t>(F, WS_LFM)[i] = (h16_t)0.f; wsp<bf16_t>(F, WS_VVM)[i] = 0; }
    {
        LAS float* hnm = (LAS float*)F.lds;
        for (int r = F.wave * 2; r < F.wave * 2 + 2; ++r) {
            const f32x4* xr = (const f32x4*)(F.meta + (size_t)r * D) + F.lane; f32x4 v[8]; float s = 0.f;
#pragma unroll
            for (int j = 0; j < 8; ++j) { v[j] = xr[64 * j]; s += (v[j].x * v[j].x + v[j].y * v[j].y) + (v[j].z * v[j].z + v[j].w * v[j].w); }
            const float rs = rsqrtf(wave_sum(s) * (1.f / D) + EPS);
#pragma unroll
            for (int j = 0; j < 8; ++j) { const f32x4 w = ((const f32x4*)F.nmw)[F.lane + 64 * j]; *(LAS f32x4*)(hnm + r * D + 4 * F.lane + 256 * j) = v[j] * rs * w; }
        }
        __syncthreads();
        LAS float* red = (LAS float*)(F.lds + TOK_OFF);
        for (int cb = F.vcu; cb < 256; cb += F.G) {
            const int col = F.tid & 15, ks = F.tid >> 4;
            int gcol;
            if (cb < 64) gcol = C_F + 16 * cb + col; else if (cb < 128) gcol = C_V + 16 * (cb - 64) + col; else gcol = (col < 8 ? C_SV : C_SC) + 8 * (cb - 128) + (col & 7);
            float a[16];
#pragma unroll
            for (int r = 0; r < 16; ++r) a[r] = 0.f;
#pragma unroll 1
            for (int hf = 0; hf < 2; ++hf) {
                float w[32]; const int kb = ks * 64 + 32 * hf;
#pragma unroll
                for (int kk = 0; kk < 32; ++kk) w[kk] = F.w_in[(size_t)(kb + kk) * INC + gcol];
                __builtin_amdgcn_sched_barrier(0);
#pragma unroll
                for (int k4 = 0; k4 < 8; ++k4) {
#pragma unroll
                    for (int r = 0; r < 16; ++r) { const f32x4 h = *(const LAS f32x4*)(hnm + r * D + kb + 4 * k4);
                        a[r] = fmaf(h.x, w[4 * k4], a[r]); a[r] = fmaf(h.y, w[4 * k4 + 1], a[r]); a[r] = fmaf(h.z, w[4 * k4 + 2], a[r]); a[r] = fmaf(h.w, w[4 * k4 + 3], a[r]); }
                    __builtin_amdgcn_sched_barrier(0); } }
#pragma unroll
            for (int r = 0; r < 16; ++r) { a[r] += __shfl_xor(a[r], 16); a[r] += __shfl_xor(a[r], 32); }
            if (F.lane < 16) {
#pragma unroll
                for (int r = 0; r < 16; ++r) red[(F.wave * 16 + r) * 16 + col] = a[r]; }
            __syncthreads();
            if (F.tid < 256) { const int r = F.tid >> 4, c = F.tid & 15; float v = 0.f;
#pragma unroll
                for (int w = 0; w < 8; ++w) v += red[(w * 16 + r) * 16 + c];
                if (cb < 64) { const int ch = 16 * cb + c; const float l = 1.f / (1.f + __expf(F.lbl[HF + ch] - F.lbl[ch])); wsp<h16_t>(F, WS_LFM)[(48 + r) * HF + ch] = (h16_t)__logf(l + (1.f - l) * sigmoidf_(v)); }
                else if (cb < 128) wsp<bf16_t>(F, WS_VVM)[(48 + r) * HF + 16 * (cb - 64) + c] = (bf16_t)f2bf(v);
                else red[2048 + r * 16 + c] = v; }
            __syncthreads();
            if (cb >= 128 && F.tid < 128) { const int r = F.tid >> 3, c = F.tid & 7; wsp<bf16_t>(F, WS_UUM)[r * HF + 8 * (cb - 128) + c] = (bf16_t)f2bf(red[2048 + r * 16 + c] * red[2048 + r * 16 + c + 8]); }
            __syncthreads();
        }
        __syncthreads();
    }
    {
        LAS unsigned* T = (LAS unsigned*)(F.lds + F.wave * 16384);
        constexpr int I_IN = 32 * 4 * N_INB, I_AB = 16 * 32, I_O = 32 * 32, I_UP1 = 16 * 64, I_DN1 = 16 * 32;
        constexpr int I_IN8 = 16 * 4 * N_IN8;
        constexpr int NIT = I_IN + I_IN8 + 2 * I_AB + I_O;
        for (int it = gw; it < NIT; it += NGW) {
            int r = it;
            if (r < I_IN) { const int kb = r / (4 * N_INB), ntl = r % (4 * N_INB), nt = 4 * nth_bit(INB_MASK, ntl >> 2) + (ntl & 3); bool p0, p1; const int s0 = win_src(2 * nt, p0), s1 = win_src(2 * nt + 1, p1); tr_tile(F.w_in, INC, kb * 64, s0, s1, p0, p1, F.nmw, wsp<bf16_t>(F, WS_WIN), D, nt * 64, 0, T, F.lane); continue; } r -= I_IN;
            if (r < I_IN8) { const int kb = r / (4 * N_IN8), ntl = r % (4 * N_IN8), nt = 4 * nth_bit(IN8_MASK, ntl >> 2) + (ntl & 3); bool p0, p1; const int s0 = win_src(2 * nt, p0), s1 = win_src(2 * nt + 1, p1);
                tr_tile_fp8<0>(F.w_in, INC, kb * 128, s0, s1, F.nmw, wsp<unsigned char>(F, WS_WIN8), D, nt * 64, T, F.lane, p0); continue; } r -= I_IN8;
            if (r < I_AB) { const int kb = r / 32, nt = r % 32; tr_tile(F.w_ho, D, kb * 64, nt * 64, nt * 64 + 32, true, true, nullptr, wsp<bf16_t>(F, WS_WAB), D, nt * 64, 0, T, F.lane); continue; } r -= I_AB;
            if (r < I_AB) { const int kb = r / 32, nt = r % 32; tr_tile(F.w_co, D, kb * 64, nt * 64, nt * 64 + 32, true, true, nullptr, wsp<bf16_t>(F, WS_WAB), D, nt * 64, HF, T, F.lane); continue; } r -= I_AB;
            if (r < I_O) { const int kb = r / 32, nt = r % 32; tr_tile(F.w_o, D, kb * 64, nt * 64, nt * 64 + 32, true, true, nullptr, wsp<bf16_t>(F, WS_WO), D, nt * 64, 0, T, F.lane); continue; } r -= I_O;
        }
    }
    for (int m = gw; m < M; m += NGW) {
        const GAS f32x4* xr = (const GAS f32x4*)(F.x + (size_t)m * D) + F.lane; f32x4 v[8]; float s = 0.f;
#pragma unroll
        for (int j = 0; j < 8; ++j) v[j] = xr[64 * j];
        __builtin_amdgcn_sched_barrier(0);
#pragma unroll
        for (int j = 0; j < 8; ++j) s += (v[j].x * v[j].x + v[j].y * v[j].y) + (v[j].z * v[j].z + v[j].w * v[j].w);
        s = wave_sum(s);
        const float rsx = rsqrtf(s * (1.f / D) + EPS);
#pragma unroll
        for (int j = 0; j < 8; ++j) v[j] *= rsx;
        GAS u32x2* o8 = (GAS u32x2*)(wsp<bf16_t>(F, WS_XB) + (size_t)m * D) + F.lane;
#pragma unroll
        for (int j = 0; j < 8; ++j) { u32x2 w; w.x = pk2(v[j].x, v[j].y); w.y = pk2(v[j].z, v[j].w); o8[64 * j] = w; }
        GAS unsigned* o4 = (GAS unsigned*)(wsp<unsigned char>(F, WS_XB8) + (size_t)m * D) + F.lane;
#pragma unroll
        for (int j = 0; j < 8; ++j) o4[64 * j] = pk4_fp8(v[j].x, v[j].y, v[j].z, v[j].w);
    }
}

template <int PMODE = 0> __device__ __forceinline__ void p1_convert(Frame& F, int rank, int nconv) {
    LAS unsigned* T = (LAS unsigned*)(F.lds + F.wave * 16384);
    constexpr int I_UP1 = 16 * 64, I_DN1 = 16 * 32, NIT = NE * (I_UP1 + I_DN1);
    for (int it = rank * NWAVES + F.wave; it < NIT; it += nconv * NWAVES) {
        int r = it;
        if (r < NE * I_UP1) { const int e = r / I_UP1, q = r % I_UP1, kb = q / 64, nt = q % 64, G0 = 2 * nt, pn = G0 >> 3, gi = G0 & 7; const int s0 = (gi < 4 ? 0 : 2048) + pn * 128 + (gi & 3) * 32;
            tr_tile_fp8<PMODE>(F.w_up + (size_t)e * D * 4096, 4096, kb * 128, s0, s0 + 32, F.nfw, wsp<unsigned char>(F, WS_WUP) + (size_t)e * 4096 * D, D, nt * 64, T, F.lane); continue; } r -= NE * I_UP1;
        { const int e = r / I_DN1, q = r % I_DN1, kb = q / 32, nt = q % 32;
          tr_tile_fp8<PMODE>(F.w_dn + (size_t)e * DFF * D, D, kb * 128, nt * 64, nt * 64 + 32, nullptr, wsp<unsigned char>(F, WS_WDN) + (size_t)e * D * DFF, DFF, nt * 64, T, F.lane); }
    }
}

constexpr int KTP = 72;
constexpr int QP_ = 136;
__device__ __forceinline__ void vt_load(const Frame& F, const bf16_t* Vb, size_t row0, int h, u32x4 (&w)[2]) {
#pragma unroll
    for (int q = 0; q < 2; ++q) { const int id = F.tid + 512 * q, t = id >> 4, v8 = (id & 15) * 8; w[q] = *(const GAS u32x4*)(Vb + (row0 + t) * HF + h * 128 + v8); }
}
__device__ __forceinline__ void vt_store(const Frame& F, const u32x4 (&w)[2], LAS bf16_t* VT) {
#pragma unroll
    for (int q = 0; q < 2; ++q) { const int id = F.tid + 512 * q, t = id >> 4, v8 = (id & 15) * 8; const unsigned ww[4] = {w[q].x, w[q].y, w[q].z, w[q].w};
        const int ts = t ^ (v8 & 24);
#pragma unroll
        for (int i = 0; i < 4; ++i) { VT[(v8 + 2 * i) * KTP + ts] = (bf16_t)(ww[i] & 0xffffu); VT[(v8 + 2 * i + 1) * KTP + ts] = (bf16_t)(ww[i] >> 16); } }
}
__device__ __forceinline__ int vt_off(int v, int t0) { return v * KTP + (t0 ^ (v & 24)); }
struct P2aRegs { float L[16]; u32x4 vw[2]; };
__device__ __forceinline__ void p2a_where(const Frame& F, int u, const h16_t*& Lb, const bf16_t*& Vb, size_t& row0, int& h, int& slot) {
    if (u < 8) { Lb = wsp<h16_t>(F, WS_LFM); Vb = wsp<bf16_t>(F, WS_VVM); row0 = 0; h = u; slot = 32 * 64 + u; }
    else { const int bh = (u - 8) >> 6, c = (u - 8) & 63, b = bh >> 3; h = bh & 7; Lb = wsp<h16_t>(F, WS_LF); Vb = wsp<bf16_t>(F, WS_VV); row0 = (size_t)b * SEQ + 64 * c; slot = bh * 64 + c; }
}
__device__ __forceinline__ void p2a_load(const Frame& F, int u, P2aRegs& R) {
    const h16_t* Lb; const bf16_t* Vb; size_t row0; int h, slot; p2a_where(F, u, Lb, Vb, row0, h, slot);
    const int d = F.tid & 127, tq = F.tid >> 7;
#pragma unroll
    for (int i = 0; i < 16; ++i) R.L[i] = (float)Lb[(row0 + 16 * tq + i) * HF + h * 128 + d];
    vt_load(F, Vb, row0, h, R.vw);
}
__device__ __forceinline__ void p2a_compute(Frame& F, int u, const P2aRegs& R) {
    LAS bf16_t* KT = (LAS bf16_t*)F.lds; LAS bf16_t* VT = KT + 128 * KTP; LAS float* TOT = (LAS float*)(F.lds + 2 * 128 * KTP * 2);
    const h16_t* Lb; const bf16_t* Vb; size_t row0; int h, slot; p2a_where(F, u, Lb, Vb, row0, h, slot);
    const int d = F.tid & 127, tq = F.tid >> 7;
    float cs[16]; float run = 0.f;
#pragma unroll
    for (int i = 0; i < 16; ++i) { run += R.L[i]; cs[i] = run; }
    TOT[tq * 128 + d] = run;
    vt_store(F, R.vw, VT);
    __syncthreads();
    float off = 0.f, total = 0.f;
#pragma unroll
    for (int q = 0; q < 4; ++q) { const float tv = TOT[q * 128 + d]; total += tv; if (q < tq) off += tv; }
#pragma unroll
    for (int i = 0; i < 16; i += 2) { const float k0 = (1.f - __expf(R.L[i])) * __expf(total - off - cs[i]), k1 = (1.f - __expf(R.L[i + 1])) * __expf(total - off - cs[i + 1]);
        *(LAS unsigned*)(KT + d * KTP + 16 * tq + i) = pk2(k0, k1); }
    if (tq == 0) wsp<float>(F, WS_DEC)[(size_t)slot * 128 + d] = __expf(total);
    __syncthreads();
    {
        const int w = F.wave, fr = F.lane & 15, fq = F.lane >> 4;
        bf16x8 a[2];
#pragma unroll
        for (int ks = 0; ks < 2; ++ks) a[ks] = *(const LAS bf16x8*)(KT + (16 * w + fr) * KTP + 32 * ks + 8 * fq);
        bf16_t* Ub = wsp<bf16_t>(F, WS_UC) + (size_t)slot * 16384;
#pragma unroll
        for (int vb = 0; vb < 8; ++vb) { f32x4 c = (f32x4){0.f, 0.f, 0.f, 0.f};
#pragma unroll
            for (int ks = 0; ks < 2; ++ks) { const bf16x8 bv = *(const LAS bf16x8*)(VT + vt_off(16 * vb + fr, 32 * ks + 8 * fq)); c = __builtin_amdgcn_mfma_f32_16x16x32_bf16(a[ks], bv, c, 0, 0, 0); }
            u32x2 o; o.x = pk2(c[0], c[1]); o.y = pk2(c[2], c[3]);
            *(GAS u32x2*)(Ub + (16 * vb + fr) * 128 + 16 * w + 4 * fq) = o; }
    }
    __syncthreads();
}
__device__ __forceinline__ void p2a_units(Frame& F, int c) {
    constexpr int NU = 2048 + 8;
    if (8 + c >= NU) return;
    P2aRegs R; p2a_load(F, 8 + c, R);
    for (int u = 8 + c; u < NU; u += F.G) {
        P2aRegs N; const int un = u + F.G; if (un < NU) p2a_load(F, un, N); else N = R;
        p2a_compute(F, u, R);
        R = N;
    }
}
__device__ __forceinline__ void p2a_meta(Frame& F, int h) { P2aRegs R; p2a_load(F, h, R); p2a_compute(F, h, R); }
__device__ __forceinline__ void p2a_conv(Frame& F, int item) {
    const int c8 = (F.tid & 127) * 8, tq = F.tid >> 7, r0 = item * 64 + tq * 16, p0 = r0 & (SEQ - 1);
    const bf16_t* UU = wsp<bf16_t>(F, WS_UU); const bf16_t* UUM = wsp<bf16_t>(F, WS_UUM); const bf16_t* SBb = wsp<bf16_t>(F, WS_SB); bf16_t* A2 = wsp<bf16_t>(F, WS_A2);
    f32x4 w0a = *(const f32x4*)(F.cw + c8), w0b = *(const f32x4*)(F.cw + c8 + 4), w1a = *(const f32x4*)(F.cw + HF + c8), w1b = *(const f32x4*)(F.cw + HF + c8 + 4), w2a = *(const f32x4*)(F.cw + 2 * HF + c8), w2b = *(const f32x4*)(F.cw + 2 * HF + c8 + 4);
    f32x4 um2a, um2b, um1a, um1b;
    { const u32x4 a = (p0 >= 2) ? *(const GAS u32x4*)(UU + (size_t)(r0 - 2) * HF + c8) : *(const GAS u32x4*)(UUM + (14 + p0) * HF + c8); unpack8(a, um2a, um2b);
      const u32x4 b = (p0 >= 1) ? *(const GAS u32x4*)(UU + (size_t)(r0 - 1) * HF + c8) : *(const GAS u32x4*)(UUM + 15 * HF + c8); unpack8(b, um1a, um1b); }
#pragma unroll
    for (int i = 0; i < 16; ++i) { f32x4 ua, ub, sa, sb; unpack8(*(const GAS u32x4*)(UU + (size_t)(r0 + i) * HF + c8), ua, ub); unpack8(*(const GAS u32x4*)(SBb + (size_t)(r0 + i) * HF + c8), sa, sb);
        const f32x4 oa = sa * (w0a * um2a + w1a * um1a + w2a * ua), ob = sb * (w0b * um2b + w1b * um1b + w2b * ub);
        *(GAS u32x4*)(A2 + (size_t)(r0 + i) * D + HF + c8) = pack8(oa, ob);
        um2a = um1a; um2b = um1b; um1a = ua; um1b = ub; }
}
__device__ __forceinline__ void p2b_scan(Frame& F) {
    const int gw = F.vcu * NWAVES + F.wave;
    for (int it = gw; it < 2048; it += F.G * NWAVES) {
        const int item = it * 64 + F.lane, bh = item >> 12, e4 = item & 4095, h = bh & 7, d0 = (e4 & 31) * 4;
        const bf16_t* Ub = wsp<bf16_t>(F, WS_UC) + (size_t)bh * 64 * 16384 + e4 * 4; bf16_t* Sb = wsp<bf16_t>(F, WS_SS) + (size_t)bh * 64 * 16384 + e4 * 4;
        const float* Db = wsp<float>(F, WS_DEC) + (size_t)bh * 64 * 128 + d0;
        f32x4 s; { const u32x2 w = *(const GAS u32x2*)(wsp<bf16_t>(F, WS_UC) + (size_t)(32 * 64 + h) * 16384 + e4 * 4); s = (f32x4){bflo(w.x), bfhi(w.x), bflo(w.y), bfhi(w.y)}; }
#pragma unroll 16
        for (int c = 0; c < 64; ++c) {
            { u32x2 o; o.x = pk2(s[0], s[1]); o.y = pk2(s[2], s[3]); *(GAS u32x2*)(Sb + (size_t)c * 16384) = o; }
            const u32x2 w = *(const GAS u32x2*)(Ub + (size_t)c * 16384);
            const f32x4 g = *(const GAS f32x4*)(Db + c * 128);
            s = g * s + (f32x4){bflo(w.x), bfhi(w.x), bflo(w.y), bfhi(w.y)};
        }
    }
}
struct P2cRegs { f32x2 L[8]; unsigned qw[8]; u32x4 vw[2]; bf16x8 sa[4]; u32x2 gv[4]; };
__device__ __forceinline__ void p2c_load(const Frame& F, int u, P2cRegs& R) {
    const int bh = u >> 6, c = u & 63, b = bh >> 3, h = bh & 7; const size_t row0 = (size_t)b * SEQ + 64 * c;
    const int dp = (F.tid & 63) * 2, t8 = F.tid >> 6, w = F.wave, fr = F.lane & 15, fq = F.lane >> 4;
    const h16_t* Lb = wsp<h16_t>(F, WS_LF) + (row0 + 8 * t8) * HF + h * 128 + dp; const bf16_t* Qb = wsp<bf16_t>(F, WS_QS) + (row0 + 8 * t8) * HF + h * 128 + dp;
#pragma unroll
    for (int i = 0; i < 8; ++i) { const h16x2 lh = *(const GAS h16x2*)(Lb + (size_t)i * HF); R.L[i] = (f32x2){(float)lh.x, (float)lh.y}; R.qw[i] = *(const GAS unsigned*)(Qb + (size_t)i * HF); }
    vt_load(F, wsp<bf16_t>(F, WS_VV), row0, h, R.vw);
    const bf16_t* Sb = wsp<bf16_t>(F, WS_SS) + ((size_t)bh * 64 + c) * 16384 + (16 * w + fr) * 128 + 8 * fq;
#pragma unroll
    for (int ks = 0; ks < 4; ++ks) R.sa[ks] = *(const GAS bf16x8*)(Sb + 32 * ks);
    const bf16_t* GSb = wsp<bf16_t>(F, WS_GS);
#pragma unroll
    for (int tb = 0; tb < 4; ++tb) R.gv[tb] = *(const GAS u32x2*)(GSb + (row0 + 16 * tb + fr) * HF + h * 128 + 16 * w + 4 * fq);
}
__device__ __forceinline__ void p2c_compute(Frame& F, int u, const P2cRegs& R) {
    const int bh = u >> 6, c = u & 63, b = bh >> 3, h = bh & 7; const size_t row0 = (size_t)b * SEQ + 64 * c;
    LAS bf16_t* QPl = (LAS bf16_t*)F.lds; LAS bf16_t* QD = QPl + 64 * QP_; LAS bf16_t* KI = QD + 64 * QP_; LAS bf16_t* VT = KI + 160 * QP_; LAS bf16_t* PL = VT + 128 * KTP;
    LAS float* TOT8 = (LAS float*)(PL + 64 * KTP); LAS float* SSQ = TOT8 + 8 * 128;
    const int dp = (F.tid & 63) * 2, t8 = F.tid >> 6;
    f32x2 L[8], cs[8], q[8]; f32x2 run = (f32x2){0.f, 0.f};
#pragma unroll
    for (int i = 0; i < 8; ++i) { L[i] = R.L[i]; q[i] = (f32x2){bflo(R.qw[i]), bfhi(R.qw[i])}; }
#pragma unroll
    for (int i = 0; i < 8; ++i) { run += L[i]; cs[i] = run; }
    *(LAS f32x2*)(TOT8 + t8 * 128 + dp) = run;
    vt_store(F, R.vw, VT);
    for (int i = F.tid; i < 64 * KTP / 2; i += NTHR) ((LAS unsigned*)PL)[i] = 0u;
    __syncthreads();
    {
        f32x2 pre[9]; pre[0] = (f32x2){0.f, 0.f};
#pragma unroll
        for (int j = 0; j < 8; ++j) pre[j + 1] = pre[j] + *(const LAS f32x2*)(TOT8 + j * 128 + dp);
        f32x2 off = (f32x2){0.f, 0.f};
#pragma unroll
        for (int j = 0; j < 8; ++j) if (j == t8) off = pre[j];
        const int si = t8 >> 1;
        f32x2 st[4];
#pragma unroll
        for (int j = 0; j < 4; ++j) st[j] = pre[2 * j];
        f32x2 sti = st[0];
#pragma unroll
        for (int j = 1; j < 4; ++j) if (j == si) sti = st[j];
#pragma unroll
        for (int i = 0; i < 8; ++i) { const int t = 8 * t8 + i; const f32x2 bc = off + cs[i];
            *(LAS unsigned*)(QPl + t * QP_ + dp) = pk2(q[i].x * __expf(bc.x), q[i].y * __expf(bc.y));
            *(LAS unsigned*)(QD + t * QP_ + dp) = pk2(q[i].x * __expf(bc.x - sti.x), q[i].y * __expf(bc.y - sti.y));
            const f32x2 k = (f32x2){1.f - __expf(L[i].x), 1.f - __expf(L[i].y)};
#pragma unroll
            for (int j = 0; j < 4; ++j) if (j >= si) {
                *(LAS unsigned*)(KI + (8 * j * (j + 1) + t) * QP_ + dp) = pk2(k.x * __expf(fminf(st[j].x - bc.x, 80.f)), k.y * __expf(fminf(st[j].y - bc.y, 80.f))); }
        }
    }
    __syncthreads();
    const int w = F.wave, fr = F.lane & 15, fq = F.lane >> 4;
    for (int bi = w; bi < 10; bi += 8) {
        const int i = bi < 1 ? 0 : bi < 3 ? 1 : bi < 6 ? 2 : 3, j = bi - (i * (i + 1)) / 2;
        f32x4 cacc = (f32x4){0.f, 0.f, 0.f, 0.f};
#pragma unroll
        for (int ks = 0; ks < 4; ++ks) { const bf16x8 a = *(const LAS bf16x8*)(KI + (8 * i * (i + 1) + 16 * j + fr) * QP_ + 32 * ks + 8 * fq), bq = *(const LAS bf16x8*)(QD + (16 * i + fr) * QP_ + 32 * ks + 8 * fq);
            cacc = __builtin_amdgcn_mfma_f32_16x16x32_bf16(a, bq, cacc, 0, 0, 0); }
        if (i == j) {
#pragma unroll
            for (int r = 0; r < 4; ++r) if (4 * fq + r > fr) cacc[r] = 0.f; }
        u32x2 o; o.x = pk2(cacc[0], cacc[1]); o.y = pk2(cacc[2], cacc[3]);
        *(LAS u32x2*)(PL + (16 * i + fr) * KTP + 16 * j + 4 * fq) = o;
    }
    __syncthreads();
    f32x4 acc[4];
#pragma unroll
    for (int tb = 0; tb < 4; ++tb) acc[tb] = (f32x4){0.f, 0.f, 0.f, 0.f};
    {
#pragma unroll
        for (int ks = 0; ks < 4; ++ks)
#pragma unroll
            for (int tb = 0; tb < 4; ++tb) { const bf16x8 bq = *(const LAS bf16x8*)(QPl + (16 * tb + fr) * QP_ + 32 * ks + 8 * fq); acc[tb] = __builtin_amdgcn_mfma_f32_16x16x32_bf16(R.sa[ks], bq, acc[tb], 0, 0, 0); }
#pragma unroll
        for (int ks = 0; ks < 2; ++ks) { const bf16x8 va = *(const LAS bf16x8*)(VT + vt_off(16 * w + fr, 32 * ks + 8 * fq));
#pragma unroll
            for (int tb = 0; tb < 4; ++tb) { const bf16x8 bp = *(const LAS bf16x8*)(PL + (16 * tb + fr) * KTP + 32 * ks + 8 * fq); acc[tb] = __builtin_amdgcn_mfma_f32_16x16x32_bf16(va, bp, acc[tb], 0, 0, 0); } }
    }
#pragma unroll
    for (int tb = 0; tb < 4; ++tb) { float p = (acc[tb][0] * acc[tb][0] + acc[tb][1] * acc[tb][1]) + (acc[tb][2] * acc[tb][2] + acc[tb][3] * acc[tb][3]); p += __shfl_xor(p, 16); p += __shfl_xor(p, 32);
        if (fq == 0) SSQ[w * 64 + 16 * tb + fr] = p; }
    __syncthreads();
    {
        const f32x4 gw4 = *(const f32x4*)(F.gnw + 16 * w + 4 * fq);
        bf16_t* A2 = wsp<bf16_t>(F, WS_A2);
#pragma unroll
        for (int tb = 0; tb < 4; ++tb) { const int t = 16 * tb + fr; float ss = 0.f;
#pragma unroll
            for (int ww = 0; ww < 8; ++ww) ss += SSQ[ww * 64 + t];
            const float rs = rsqrtf(ss * (1.f / 128.f) + EPS);
            const u32x2 gv = R.gv[tb];
            const f32x4 o = acc[tb] * rs * gw4 * (f32x4){bflo(gv.x), bfhi(gv.x), bflo(gv.y), bfhi(gv.y)};
            u32x2 ov; ov.x = pk2(o[0], o[1]); ov.y = pk2(o[2], o[3]);
            *(GAS u32x2*)(A2 + (row0 + t) * D + h * 128 + 16 * w + 4 * fq) = ov; }
    }
    __syncthreads();
}
__device__ __forceinline__ void p2c_units(Frame& F, int c) {
    constexpr int NU = 2048;
    if (c >= NU) return;
    P2cRegs R; p2c_load(F, c, R);
    for (int u = c; u < NU; u += F.G) {
        P2cRegs N; const int un = u + F.G; if (un < NU) p2c_load(F, un, N); else N = R;
        p2c_compute(F, u, R);
        R = N;
    }
}

__device__ __forceinline__ void split8(const f32x4 a, const f32x4 b, bf16x8& hi, bf16x8& lo) {
    u32x4 h, l;
    h.x = cvt_pk_bf16(a[0], a[1]); h.y = cvt_pk_bf16(a[2], a[3]); h.z = cvt_pk_bf16(b[0], b[1]); h.w = cvt_pk_bf16(b[2], b[3]);
    l.x = cvt_pk_bf16(a[0] - bflo(h.x), a[1] - bfhi(h.x)); l.y = cvt_pk_bf16(a[2] - bflo(h.y), a[3] - bfhi(h.y)); l.z = cvt_pk_bf16(b[0] - bflo(h.z), b[1] - bfhi(h.z)); l.w = cvt_pk_bf16(b[2] - bflo(h.w), b[3] - bfhi(h.w));
    hi = __builtin_bit_cast(bf16x8, h); lo = __builtin_bit_cast(bf16x8, l);
}
__device__ __forceinline__ void p5_router(Frame& F) {
    const int fr = F.lane & 15, fq = F.lane >> 4, wq = F.wave & 3, kh = F.wave >> 2;
    LAS float* lg = (LAS float*)(F.lds + F.wave * 4096);
    LAS float* pa = (LAS float*)(F.lds + 32768) + (wq * 64 + F.lane) * 9;
    const bf16_t* DL = wsp<bf16_t>(F, WS_H1); unsigned char* H1B = wsp<unsigned char>(F, WS_H1B); const bf16_t* WH = wsp<bf16_t>(F, WS_WRH); const bf16_t* WL = wsp<bf16_t>(F, WS_WRL);
    for (int it = F.vcu * 4 + wq; it < M / 16; it += F.G * 4) {
        const int row0 = it * 16, kofs = 1024 * kh;
        const float* hp = F.x + (size_t)(row0 + fr) * D + kofs + 8 * fq; const bf16_t* dp_ = DL + (size_t)(row0 + fr) * D + kofs + 8 * fq; unsigned char* qp = H1B + (size_t)(row0 + fr) * D + kofs + 8 * fq;
        const bf16_t* wh0 = WH + (size_t)fr * D + kofs + 8 * fq; const bf16_t* wl0 = WL + (size_t)fr * D + kofs + 8 * fq;
        f32x4 a0 = (f32x4){0.f, 0.f, 0.f, 0.f}, a1 = a0; float ss = 0.f;
#pragma unroll 4
        for (int ks = 0; ks < 32; ++ks) {
            f32x4 xa = *(const GAS f32x4*)(hp + 32 * ks), xb = *(const GAS f32x4*)(hp + 32 * ks + 4); { f32x4 da, db; unpack8(*(const GAS u32x4*)(dp_ + 32 * ks), da, db); xa += da; xb += db; }
            *(GAS u32x2*)(qp + 32 * ks) = pack8_fp8(xa, xb);
            *(GAS u32x4*)((bf16_t*)dp_ + 32 * ks) = pack8(xa, xb);
            ss += (xa[0] * xa[0] + xa[1] * xa[1]) + (xa[2] * xa[2] + xa[3] * xa[3]) + (xb[0] * xb[0] + xb[1] * xb[1]) + (xb[2] * xb[2] + xb[3] * xb[3]);
            bf16x8 xh, xl; split8(xa, xb, xh, xl);
            const bf16x8 bh0 = *(const GAS bf16x8*)(wh0 + 32 * ks), bl0 = *(const GAS bf16x8*)(wl0 + 32 * ks), bh1 = *(const GAS bf16x8*)(wh0 + 16 * D + 32 * ks), bl1 = *(const GAS bf16x8*)(wl0 + 16 * D + 32 * ks);
            a0 = __builtin_amdgcn_mfma_f32_16x16x32_bf16(xh, bh0, a0, 0, 0, 0); a0 = __builtin_amdgcn_mfma_f32_16x16x32_bf16(xh, bl0, a0, 0, 0, 0);
            a0 = __builtin_amdgcn_mfma_f32_16x16x32_bf16(xl, bh0, a0, 0, 0, 0); a0 = __builtin_amdgcn_mfma_f32_16x16x32_bf16(xl, bl0, a0, 0, 0, 0);
            a1 = __builtin_amdgcn_mfma_f32_16x16x32_bf16(xh, bh1, a1, 0, 0, 0); a1 = __builtin_amdgcn_mfma_f32_16x16x32_bf16(xh, bl1, a1, 0, 0, 0);
            a1 = __builtin_amdgcn_mfma_f32_16x16x32_bf16(xl, bh1, a1, 0, 0, 0); a1 = __builtin_amdgcn_mfma_f32_16x16x32_bf16(xl, bl1, a1, 0, 0, 0);
        }
        if (kh == 1) {
#pragma unroll
            for (int r = 0; r < 4; ++r) { pa[r] = a0[r]; pa[4 + r] = a1[r]; }
            pa[8] = ss; }
        __syncthreads();
        if (kh == 0) {
#pragma unroll
            for (int r = 0; r < 4; ++r) { a0[r] += pa[r]; a1[r] += pa[4 + r]; }
            ss += pa[8];
            ss += __shfl_xor(ss, 16); ss += __shfl_xor(ss, 32);
#pragma unroll
            for (int r = 0; r < 4; ++r) { lg[(4 * fq + r) * 33 + fr] = a0[r]; lg[(4 * fq + r) * 33 + 16 + fr] = a1[r]; }
            LDS_WAIT(); asm volatile("" ::: "memory");
            if (F.lane < 16) {
                const int tokn = row0 + F.lane; const float rs = rsqrtf(ss * (1.f / D) + EPS);
                float v[32];
#pragma unroll
                for (int e = 0; e < 32; ++e) v[e] = lg[F.lane * 33 + e] * rs + F.b_r[e];
                int idx[4]; float val[4];
#pragma unroll
                for (int k = 0; k < 4; ++k) { float bv = -3.0e38f; int bi = 0;
#pragma unroll
                    for (int e = 0; e < 32; ++e) { const bool tk = v[e] > bv; bv = tk ? v[e] : bv; bi = tk ? e : bi; }
                    idx[k] = bi; val[k] = bv;
#pragma unroll
                    for (int e = 0; e < 32; ++e) v[e] = (e == bi) ? -3.0e38f : v[e]; }
                float ex[4], den = 0.f;
#pragma unroll
                for (int k = 0; k < 4; ++k) { ex[k] = __expf(val[k] - val[0]); den += ex[k]; }
                const float inv = 1.f / den;
                wsp<float>(F, WS_RS2)[tokn] = rs;
                int pos[4];
#pragma unroll
                for (int k = 0; k < 4; ++k) pos[k] = (int)__hip_atomic_fetch_add(F.ctl + CW_CNT + 64 * idx[k], 1u, __ATOMIC_RELAXED, __HIP_MEMORY_SCOPE_AGENT);
#pragma unroll
                for (int k = 0; k < 4; ++k) {
                    wsp<int>(F, WS_TOPE)[tokn * 4 + k] = idx[k]; wsp<int>(F, WS_TOPP)[tokn * 4 + k] = pos[k]; wsp<float>(F, WS_TOPW)[tokn * 4 + k] = ex[k] * inv;
                    wsp<int>(F, WS_LIST)[(size_t)idx[k] * CAPF + pos[k]] = tokn; }
            }
        }
        __syncthreads();
    }
}
__device__ __forceinline__ void build_pref(Frame& F) {
    if (F.wave == 0) {
        int tl = 0;
        if (F.lane < NE) { const unsigned c = __hip_atomic_load(F.ctl + CW_CNT + 64 * F.lane, RLX_AGENT); tl = (int)((c + 255u) >> 8); }
        int s = tl;
#pragma unroll
        for (int d = 1; d < 32; d <<= 1) { const int v = __shfl_up(s, d); if (F.lane >= d) s += v; }
        if (F.lane < NE) F.MISC[16 + F.lane] = (unsigned)(s - tl);
        if (F.lane == NE - 1) F.MISC[16 + NE] = (unsigned)(s < MAXRT ? s : MAXRT); }
    __syncthreads();
}
__device__ __forceinline__ void build_tok(Frame& F, const MoeOrder& S) {
    LAS int* tokt = (LAS int*)(F.lds + TOK_OFF); LAS bf16_t* bt = (LAS bf16_t*)(F.lds + BIAS_OFF);
    volatile LAS int* um = (volatile LAS int*)(F.MISC + 64);
    if (F.tid < 18) { Unit u; int base = -1, nv = 0, bo = 0;
        if (S.template next<false>(F.tid, u)) { const int rt = u.pm - (int)F.MISC[16 + u.e]; const int cnt = (int)__hip_atomic_load(F.ctl + CW_CNT + 64 * u.e, RLX_AGENT);
            base = u.e * CAPF + rt * 256; nv = cnt - rt * 256; nv = nv < 0 ? 0 : (nv > 256 ? 256 : nv); bo = u.e * 4096 + u.pn * 128; }
        um[4 * F.tid] = base; um[4 * F.tid + 1] = nv; um[4 * F.tid + 2] = bo; }
    __syncthreads();
    if (F.tid < 256) { int t[18]; float r[18]; const int* LIST = wsp<int>(F, WS_LIST); const float* RS2 = wsp<float>(F, WS_RS2);
#pragma unroll
        for (int i = 0; i < 18; ++i) { const int base = um[4 * i], nv = um[4 * i + 1]; t[i] = (base >= 0 && F.tid < nv) ? LIST[base + F.tid] : -1; }
#pragma unroll
        for (int i = 0; i < 18; ++i) r[i] = (t[i] >= 0) ? RS2[t[i]] * W8_INV : 0.f;
#pragma unroll
        for (int i = 0; i < 18; ++i) if (um[4 * i] >= 0) tokt[i * 256 + F.tid] = (int)((f2bf(r[i]) << 16) | (unsigned)(t[i] < 0 ? 0 : t[i])); }
    else {
        const int j = F.tid - 256, col = j < 128 ? j : 2048 + (j - 128); float bq[18];
#pragma unroll
        for (int i = 0; i < 18; ++i) bq[i] = (um[4 * i] >= 0) ? F.b_up[um[4 * i + 2] + col] : 0.f;
#pragma unroll
        for (int i = 0; i < 18; ++i) bt[i * 256 + j] = (bf16_t)f2bf(bq[i]); }
    __syncthreads();
}
__device__ __forceinline__ void build_bias_dn(Frame& F, const MoeOrder& S) {
    LAS float* bt = (LAS float*)(F.lds + TOK_OFF);
    volatile LAS int* um = (volatile LAS int*)(F.MISC + 64);
    if (F.tid < 9) { Unit u; int bo = -1; if (S.template next<false>(F.tid, u)) bo = u.e * D + u.pn * 256; um[F.tid] = bo; }
    __syncthreads();
    if (F.tid < 256) { float bq[9];
#pragma unroll
        for (int i = 0; i < 9; ++i) bq[i] = (um[i] >= 0) ? F.b_dn[um[i] + F.tid] : 0.f;
#pragma unroll
        for (int i = 0; i < 9; ++i) bt[i * 256 + F.tid] = bq[i]; }
    __syncthreads();
}
struct P9Tok { f32x4 v[8]; unsigned y[4][8]; f32x4 tw; };
template <int PM> __device__ __forceinline__ void p9_issue(const Frame& F, int m, P9Tok& T) {
    typedef int i32x4 __attribute__((ext_vector_type(4)));
    const bf16_t* DL = wsp<bf16_t>(F, WS_H1); const unsigned char* YR = wsp<unsigned char>(F, WS_YR);
    const i32x4 te = *(const GAS i32x4*)(wsp<int>(F, WS_TOPE) + m * 4), tp = *(const GAS i32x4*)(wsp<int>(F, WS_TOPP) + m * 4); T.tw = *(const GAS f32x4*)(wsp<float>(F, WS_TOPW) + m * 4);
#pragma unroll
    for (int j = 0; j < 8; ++j) { const u32x2 dw = (PM == 4) ? (u32x2){(unsigned)m, 0u} : *(const GAS u32x2*)(DL + (size_t)m * D + 4 * F.lane + 256 * j);
        T.v[j] = (f32x4){bflo(dw.x), bfhi(dw.x), bflo(dw.y), bfhi(dw.y)}; }
#pragma unroll
    for (int k = 0; k < 4; ++k) { const size_t row = (size_t)((const LAS unsigned*)F.MISC)[16 + te[k]] * 256 + tp[k];
#pragma unroll
        for (int j = 0; j < 8; ++j) T.y[k][j] = (PM == 1) ? (unsigned)row : *(const GAS unsigned*)(YR + row * D + 4 * F.lane + 256 * j); }
}
template <int PM> __device__ __forceinline__ void p9_finish(const Frame& F, int m, P9Tok& T, float* outp) {
#pragma unroll
    for (int k = 0; k < 4; ++k)
#pragma unroll
        for (int j = 0; j < 8; ++j) { const f32x2 p0 = __builtin_amdgcn_cvt_pk_f32_fp8((int)T.y[k][j], false), p1 = __builtin_amdgcn_cvt_pk_f32_fp8((int)T.y[k][j], true); T.v[j] += (f32x4){p0.x, p0.y, p1.x, p1.y} * T.tw[k]; }
    float s = 0.f;
#pragma unroll
    for (int j = 0; j < 8; ++j) s += (T.v[j][0] * T.v[j][0] + T.v[j][1] * T.v[j][1]) + (T.v[j][2] * T.v[j][2] + T.v[j][3] * T.v[j][3]);
    const float rs = rsqrtf(wave_sum(s) * (1.f / D) + EPS);
#pragma unroll
    for (int j = 0; j < 8; ++j) { const f32x4 w = *(const f32x4*)(F.fnw + 4 * F.lane + 256 * j); const f32x4 o = T.v[j] * rs * w;
        if (PM == 2) asm volatile("" :: "v"(o)); else *(GAS f32x4*)(outp + (size_t)m * D + 4 * F.lane + 256 * j) = o; }
}
template <int PM> __device__ __forceinline__ void p9_combine_t(Frame& F, float* outp) {
    const int gw = F.vcu * NWAVES + F.wave, NGW9 = F.G * NWAVES;
    for (int m = gw; m < M; m += 2 * NGW9) {
        const int m2 = m + NGW9; const bool two = m2 < M;
        P9Tok A, B; p9_issue<PM>(F, m, A); p9_issue<PM>(F, two ? m2 : m, B);
        __builtin_amdgcn_sched_barrier(0);
        p9_finish<PM>(F, m, A, outp); if (two) p9_finish<PM>(F, m2, B, outp);
    }
}
__device__ __forceinline__ void p9_combine(Frame& F) { p9_combine_t<0>(F, F.out); }
constexpr int NPH = 11;
struct Args { const float* in[18]; float* out; unsigned char* ws; int ph_lo, ph_hi; };

__global__ void __launch_bounds__(NTHR, 2) fwd_kernel(Args args) {
    extern __shared__ __attribute__((aligned(16))) unsigned char lds_raw[];
    Frame F;
    F.lds = (LAS unsigned char*)lds_raw; F.MISC = (volatile LAS unsigned*)(F.lds + MISC_OFF);
    F.wave = __builtin_amdgcn_readfirstlane((int)threadIdx.x >> 6);
#define REFRESH() do { F.lane = lane_id(); F.tid = F.wave * 64 + F.lane; } while (0)
    REFRESH();
    F.G = gridDim.x; { const int bx = blockIdx.x; F.vcu = (F.G % 8 == 0) ? (bx % 8) * (F.G / 8) + bx / 8 : bx; }
    F.ws = args.ws; F.ctl = (gu32*)(args.ws + WS_CTL); F.out = args.out;
    F.x = args.in[0]; F.meta = args.in[1]; F.nmw = args.in[2]; F.w_in = args.in[3]; F.lbl = args.in[4]; F.gnw = args.in[5]; F.w_ho = args.in[6]; F.cw = args.in[7]; F.w_co = args.in[8]; F.w_o = args.in[9];
    F.nfw = args.in[10]; F.w_r = args.in[11]; F.b_r = args.in[12]; F.w_up = args.in[13]; F.b_up = args.in[14]; F.w_dn = args.in[15]; F.b_dn = args.in[16]; F.fnw = args.in[17];
    for (int u = F.tid; u < 256; u += NTHR) F.MISC[u] = 0u;
    __syncthreads();
    const int lo = args.ph_lo, hi = args.ph_hi;
    const bool multi = (hi - lo) > 1;
    XcdBarrier bar; bar.bar = (unsigned*)(F.ctl + CW_BAR); bar.x = 0; bar.st = nullptr;
    if (multi) bar = xcd_barrier_post((unsigned*)(F.ctl + CW_BAR), F.MISC, F.tid);
#define IN(k) (lo <= (k) && (k) < hi)
#if defined(FK_STAMP_A)
#define STAMP(k) do { if (blockIdx.x == 0 && F.tid == 0) __hip_atomic_store(F.ctl + CW_TS + (k), (unsigned)__builtin_amdgcn_s_memrealtime(), RLX_AGENT); } while (0)
#else
#define STAMP(k) do { } while (0)
#endif
#if defined(FK_PROBE_BAR)
#define SEAM(k) do { REFRESH(); if (IN(k) && IN((k) + 1)) { xcd_barrier(bar, F.tid); xcd_barrier(bar, F.tid); xcd_barrier(bar, F.tid); } STAMP((k) + 1); } while (0)
#else
#define SEAM(k) do { REFRESH(); if (IN(k) && IN((k) + 1)) xcd_barrier(bar, F.tid); STAMP((k) + 1); } while (0)
#endif
    STAMP(0);
    const int c = blockIdx.x;
#ifndef FK_DUP_MASK
#define FK_DUP_MASK 0
#endif
#ifndef FK_DUP_REPS
#define FK_DUP_REPS 1
#endif
#define DUP(k) for (int _rep = 0; _rep < 1 + FK_DUP_REPS * ((FK_DUP_MASK >> (k)) & 1); ++_rep)
#define REDO(k) do { if (((FK_DUP_MASK >> (k)) & 1) && _rep < FK_DUP_REPS) { REFRESH(); xcd_barrier(bar, F.tid); } } while (0)

    if (IN(0)) DUP(0) { p0_prologue(F); REDO(0); } SEAM(0);

    if (IN(1)) DUP(1) {
        constexpr int NCONV_PER8 = 3;
        if (_rep == 0) { if (F.G >= 32) { if (c >= 24 && c < 32) p2a_meta(F, c - 24); } else for (int h = c; h < 8; h += F.G) p2a_meta(F, h); }
        const int cq = c >> 3; const bool conv = (F.G % 64 == 0) && ((cq & 7) < NCONV_PER8) && (_rep == 0);
        if (F.G % 64 != 0 && _rep == 0) { if (c == 0) p1_convert(F, 0, 1); }
        if (conv) { const int nconv = (F.G / 64) * 8 * NCONV_PER8, rank = ((cq >> 3) * NCONV_PER8 + (cq & 7)) * 8 + (c & 7); p1_convert(F, rank, nconv);
#if defined(FK_PROBE_CONV2)
            __syncthreads(); p1_convert<FK_PROBE_CONV2 - 1>(F, rank, nconv);
#endif
        }
        __syncthreads();
        EpiInproj E{wsp<float>(F, WS_RS1), wsp<float>(F, WS_LB), wsp<bf16_t>(F, WS_QS), wsp<bf16_t>(F, WS_VV), wsp<bf16_t>(F, WS_GS), wsp<bf16_t>(F, WS_UU), wsp<bf16_t>(F, WS_SB), wsp<bf16_t>(F, WS_RT), wsp<bf16_t>(F, WS_GBS), wsp<h16_t>(F, WS_LF), 1.f};
        if (N_INB > 0) {
            GemmDesc g{wsp<bf16_t>(F, WS_XB), wsp<bf16_t>(F, WS_WIN), D, INC / 256};
            DynOrder S; S.init(M, INB_MASK, N_INB, c, (unsigned*)(F.ctl + CW_Q + 64 * (c & 7) + 8 * _rep), F.MISC + 4, F.tid);
            gemm_phase<EpiInproj, DynOrder, false, true, false>(F.lds, g, S, E, nullptr, F.wave); }
        if (N_IN8 > 0) {
            REFRESH(); E.osc = 1.f / W8_SCALE;
            GemmDesc g{(const bf16_t*)wsp<unsigned char>(F, WS_XB8), (const bf16_t*)wsp<unsigned char>(F, WS_WIN8), D, INC / 256};
            DynOrder S; S.init(M, IN8_MASK, N_IN8, c, (unsigned*)(F.ctl + CW_Q + 64 * (c & 7) + 8 * _rep + 4), F.MISC + 6, F.tid);
            gemm_phase<EpiInproj, DynOrder, false, true, true>(F.lds, g, S, E, nullptr, F.wave); }
        REDO(1);
    } SEAM(1);

#if defined(FK_PROBE_GEMM)
    if (IN(1)) {
        GemmDesc g{wsp<bf16_t>(F, WS_XB), wsp<bf16_t>(F, WS_WIN), D, INC / 256}; ProbeOrder S; S.S.init(M, INC, F.G, c); S.mode = FK_PROBE_GEMM & 3; S.c = c;
        EpiDummy E{wsp<bf16_t>(F, WS_ACT), (FK_PROBE_GEMM >> 2) & 1};
        gemm_phase<EpiDummy, ProbeOrder, false, true, false>(F.lds, g, S, E, nullptr, F.wave);
        REFRESH(); xcd_barrier(bar, F.tid);
    }
#endif
    if (IN(2)) DUP(2) { p2a_units(F, c); for (int it = c; it < M / 64; it += F.G) p2a_conv(F, it); REDO(2); } SEAM(2);
    if (IN(3)) DUP(3) { p2b_scan(F); REDO(3); } SEAM(3);
    if (IN(4)) DUP(4) { p2c_units(F, c); REDO(4); } SEAM(4);

    if (IN(5)) DUP(5) {
        GemmDesc g{wsp<bf16_t>(F, WS_A2), wsp<bf16_t>(F, WS_WAB), D, D / 256}; StaticOrder S; S.init(M, D, F.G, c);
        EpiMerge E{wsp<bf16_t>(F, WS_RT), wsp<bf16_t>(F, WS_GBS), wsp<bf16_t>(F, WS_MG)};
        gemm_phase<EpiMerge, StaticOrder, false, true, false>(F.lds, g, S, E, nullptr, F.wave); REDO(5);
    } SEAM(5);

    if (IN(6)) DUP(6) {
        GemmDesc g{wsp<bf16_t>(F, WS_MG), wsp<bf16_t>(F, WS_WO), D, D / 256}; StaticOrder S; S.init(M, D, F.G, c);
        EpiWo E{wsp<bf16_t>(F, WS_H1)};
        gemm_phase<EpiWo, StaticOrder, false, true, false>(F.lds, g, S, E, nullptr, F.wave); REDO(6);
    } SEAM(6);

    if (IN(7)) { p5_router(F); } SEAM(7);

    if (IN(8)) DUP(8) {
        build_pref(F);
        MoeOrder S; S.init(16, F.G, c, (const volatile LAS int*)(F.MISC + 16));
        build_tok(F, S);
        GemmDesc g{wsp<bf16_t>(F, WS_H1B), wsp<bf16_t>(F, WS_WUP), D, 16};
        EpiUp E{wsp<float>(F, WS_RS2), (const LAS int*)(F.lds + TOK_OFF), (const LAS bf16_t*)(F.lds + BIAS_OFF), wsp<unsigned char>(F, WS_ACT)};
        gemm_phase<EpiUp, MoeOrder, true, true, true>(F.lds, g, S, E, (const LAS int*)(F.lds + TOK_OFF), F.wave); REDO(8);
    } SEAM(8);

    if (IN(9)) DUP(9) {
        build_pref(F);
        MoeOrder S; S.init(8, F.G, c, (const volatile LAS int*)(F.MISC + 16));
        GemmDesc g{wsp<bf16_t>(F, WS_ACT), wsp<bf16_t>(F, WS_WDN), DFF, 8};
        build_bias_dn(F, S);
        EpiDown E{(const LAS float*)(F.lds + TOK_OFF), wsp<unsigned char>(F, WS_YR)};
        gemm_phase<EpiDown, MoeOrder, false, true, true>(F.lds, g, S, E, nullptr, F.wave); REDO(9);
    } SEAM(9);

#if defined(FK_PROBE_P8)
    if (IN(10)) {
        build_pref(F);
        ProbeMoe S; S.S.init(8, F.G, c, (const volatile LAS int*)(F.MISC + 16)); S.mode = FK_PROBE_P8 & 3;
        GemmDesc g{wsp<bf16_t>(F, WS_ACT), wsp<bf16_t>(F, WS_WDN), DFF, 8};
        EpiDummy E{wsp<bf16_t>(F, WS_XB), 1};
        for (int r = 0; r < 2; ++r) { gemm_phase<EpiDummy, ProbeMoe, false, true, true>(F.lds, g, S, E, nullptr, F.wave); REFRESH(); xcd_barrier(bar, F.tid); }
    }
#endif
    if (IN(10)) DUP(10) { build_pref(F); p9_combine(F); REDO(10); }
#if defined(FK_PROBE_P9)
    if (IN(10)) { for (int r = 0; r < 4; ++r) { REFRESH(); xcd_barrier(bar, F.tid); p9_combine_t<FK_PROBE_P9 - 1>(F, wsp<float>(F, WS_XB)); } }
#endif
#undef IN
#undef DUP
#undef REDO
#undef SEAM
#undef STAMP
#undef REFRESH
}

inline void launch_fast(hipStream_t stream, void* const* d_in, float* out, unsigned char* ws, int n_launches) {
    static int grid = 0;
    if (grid == 0) {
        int dev = 0, cus = 0, per_cu = 0;
        if (hipGetDevice(&dev) != hipSuccess || hipDeviceGetAttribute(&cus, hipDeviceAttributeMultiprocessorCount, dev) != hipSuccess) { fprintf(stderr, "kernel_launch: device query failed\n"); grid = -1; return; }
        if (hipFuncSetAttribute((const void*)fwd_kernel, hipFuncAttributeMaxDynamicSharedMemorySize, LDS_BYTES) != hipSuccess) { fprintf(stderr, "kernel_launch: hipFuncSetAttribute failed\n"); grid = -1; return; }
        if (hipOccupancyMaxActiveBlocksPerMultiprocessor(&per_cu, (const void*)fwd_kernel, NTHR, LDS_BYTES) != hipSuccess || per_cu < 1) fprintf(stderr, "kernel_launch: note: occupancy query says %d blocks per CU\n", per_cu);
        (void)hipGetLastError();
        grid = cus;
    }
    if (grid < 0) return;
    (void)hipMemsetAsync(ws + WS_CTL, 0, CTL_BYTES, stream);
    Args a{};
    for (int i = 0; i < 18; ++i) a.in[i] = (const float*)d_in[i];
    a.out = out; a.ws = ws;
    for (int li = 0; li < n_launches; ++li) {
        a.ph_lo = (n_launches == 1) ? 0 : li; a.ph_hi = (n_launches == 1) ? NPH : li + 1;
        hipLaunchKernelGGL(fwd_kernel, dim3(grid), dim3(NTHR), LDS_BYTES, stream, a);
        const hipError_t le = hipPeekAtLastError();
        if (le != hipSuccess) { fprintf(stderr, "kernel_launch: launch %d failed: %s\n", li, hipGetErrorName(le)); break; }
    }
}
}
#ifndef FK_LAUNCHES
#define FK_LAUNCHES 1
#endif
extern "C" void kernel_launch(void* const* d_in, const int* in_sizes, int n_in, void* d_out, int out_size, void* d_ws, size_t ws_size, hipStream_t stream) {
    if (n_in != 18 || ws_size < fk::WS_FAST_END) { fprintf(stderr, "kernel_launch: n_in %d, ws %zu < %zu\n", n_in, ws_size, (size_t)fk::WS_FAST_END); return; }
    fk::launch_fast(stream, d_in, (float*)d_out, (unsigned char*)d_ws, FK_LAUNCHES);
}
```
